# Optimizing an MI355X kernel written in HIP

```python
import math
import jax, jax.numpy as jnp
from jax import lax
import numpy as np

D_MODEL = 1024
BATCH = 2
SEQ = 8192
DEPTH = 4

GRID_W = 64
N_HEADS = 16
HEAD_DIM = D_MODEL // N_HEADS
MAX_WIN_ROWS = 8
WIN_COLS = 16
COL_QBLOCK = 16
COL_BAND = COL_QBLOCK + WIN_COLS
NEG_INF = -1e30
CONV_WIDTH = 3
PEER_HEADS = 8
PEER_N_KEYS = 128
PEER_N_EXPERTS = PEER_N_KEYS * PEER_N_KEYS
PEER_TOPK = 16
PEER_KEY_DIM = 256
PEER_HALF_DIM = PEER_KEY_DIM // 2
PEER_TOK_CHUNK = 128
N_MIXERS = 2
RMS_EPS = 1e-6

kernel_name = "hybrid_natten_shortconv_peer_encoder"


def rms_norm(x, gain):
    x32 = x.astype(jnp.float32)
    y = x32 * lax.rsqrt(jnp.mean(x32 * x32, axis=-1, keepdims=True) + RMS_EPS)
    return (y * gain.astype(jnp.float32)).astype(x.dtype)


def _col_window_tables():
    n_blk = GRID_W // COL_QBLOCK
    qcol = np.arange(GRID_W).reshape(n_blk, COL_QBLOCK)
    band_start = np.clip(np.arange(n_blk) * COL_QBLOCK - WIN_COLS // 2, 0, GRID_W - COL_BAND)
    band_cols = band_start[:, None] + np.arange(COL_BAND)
    win_start = np.clip(qcol - WIN_COLS // 2, 0, GRID_W - WIN_COLS)
    kc = band_cols[:, None, :]
    mask = (kc >= win_start[..., None]) & (kc < win_start[..., None] + WIN_COLS)
    col_off = np.clip(kc - qcol[..., None] + WIN_COLS - 1, 0, 2 * WIN_COLS - 2)
    return (jnp.asarray(band_cols, jnp.int32), jnp.asarray(mask),
            jnp.asarray(col_off, jnp.int32))


def neighbourhood_attention(h, w_qkv, w_o, rel_bias):
    b, s, d = h.shape
    rows = s // GRID_W
    win_rows = min(MAX_WIN_ROWS, rows)
    n_cblk = GRID_W // COL_QBLOCK
    band_cols, col_mask, col_off = _col_window_tables()
    qkv = (h @ w_qkv).reshape(b, rows, GRID_W, 3, N_HEADS, HEAD_DIM)
    qkv = qkv.transpose(3, 0, 4, 1, 2, 5)
    q = qkv[0] * (1.0 / math.sqrt(HEAD_DIM))
    k = qkv[1]
    v = qkv[2]

    def one_row(r):
        rs = jnp.clip(r - win_rows // 2, 0, rows - win_rows)
        q_r = lax.dynamic_index_in_dim(q, r, axis=2, keepdims=False)
        q_r = q_r.reshape(b, N_HEADS, n_cblk, COL_QBLOCK, HEAD_DIM)
        k_band = lax.dynamic_slice_in_dim(k, rs, win_rows, axis=2)[:, :, :, band_cols]
        v_band = lax.dynamic_slice_in_dim(v, rs, win_rows, axis=2)[:, :, :, band_cols]
        scores = jnp.einsum('bhjqd,bhrjkd->bhjqrk', q_r.astype(jnp.float32),
                            k_band.astype(jnp.float32))
        row_off = rs + jnp.arange(win_rows) - r + MAX_WIN_ROWS - 1
        bias = rel_bias[:, row_off[None, None, :, None], col_off[:, :, None, :]]
        scores = jnp.where(col_mask[:, :, None, :], scores + bias.astype(jnp.float32), NEG_INF)
        p = jax.nn.softmax(scores, axis=(-2, -1)).astype(v.dtype)
        o = jnp.einsum('bhjqrk,bhrjkd->bhjqd', p, v_band)
        return o.reshape(b, N_HEADS, GRID_W, HEAD_DIM)

    out = lax.map(one_row, jnp.arange(rows))
    out = out.transpose(1, 0, 3, 2, 4).reshape(b, s, d)
    return out @ w_o


def short_conv_mixer(h, w_in, w_conv, w_out):
    s = h.shape[1]
    gate_b, gate_c, val = jnp.split(h @ w_in, 3, axis=-1)
    u = gate_c * val
    pad = CONV_WIDTH // 2
    up = jnp.pad(u, ((0, 0), (pad, CONV_WIDTH - 1 - pad), (0, 0)))
    conv = sum(up[:, j:j + s] * w_conv[j] for j in range(CONV_WIDTH))
    return (gate_b * conv) @ w_out


def peer_mixer(h, w_query, sub_keys, w_up, w_down):
    b, s, d = h.shape
    xt = h.reshape(-1, PEER_TOK_CHUNK, d)
    keys32 = sub_keys.astype(jnp.float32)

    def chunk(xc):
        c = xc.shape[0]
        q = (xc @ w_query).reshape(c, PEER_HEADS, 2, PEER_HALF_DIM).astype(jnp.float32)
        sc = jnp.einsum('chpd,hpnd->chpn', q, keys32)
        sv, si = lax.top_k(sc, PEER_TOPK)
        cand = (sv[:, :, 0, :, None] + sv[:, :, 1, None, :]).reshape(c, PEER_HEADS, -1)
        cidx = (si[:, :, 0, :, None] * PEER_N_KEYS + si[:, :, 1, None, :]).reshape(c, PEER_HEADS, -1)
        best, pos = lax.top_k(cand, PEER_TOPK)
        eidx = jnp.take_along_axis(cidx, pos, axis=-1)
        g = jax.nn.softmax(best, axis=-1)
        u = w_up[eidx]
        a = jnp.einsum('cd,chkd->chk', xc, u).astype(jnp.float32)
        act = (jax.nn.gelu(a, approximate=False) * g).astype(xc.dtype)
        vv = w_down[eidx]
        return jnp.einsum('chk,chkd->cd', act, vv)

    return lax.map(chunk, xt).reshape(b, s, d)


def setup_inputs(seed: int = 0) -> dict:
    key = jax.random.key(seed)
    ks = jax.random.split(key, 16)
    n_attn = (DEPTH + 1) // 2
    n_conv = DEPTH // 2
    d = D_MODEL
    nrm = jax.random.normal
    f32 = jnp.float32
    return {
        "x": nrm(ks[0], (BATCH, SEQ, d), f32),
        "norm_mix": 1.0 + 0.02 * nrm(ks[1], (DEPTH, d), f32),
        "norm_ffn": 1.0 + 0.02 * nrm(ks[2], (DEPTH, d), f32),
        "norm_final": 1.0 + 0.02 * nrm(ks[3], (d,), f32),
        "attn_w_qkv": nrm(ks[4], (n_attn, d, 3 * d), f32) * d ** -0.5,
        "attn_w_o": nrm(ks[5], (n_attn, d, d), f32) * d ** -0.5,
        "attn_rel_bias": 0.1 * nrm(ks[6], (n_attn, N_HEADS, 2 * MAX_WIN_ROWS - 1, 2 * WIN_COLS - 1), f32),
        "conv_w_in": nrm(ks[7], (n_conv, d, 3 * d), f32) * d ** -0.5,
        "conv_w_conv": nrm(ks[8], (n_conv, CONV_WIDTH, d), f32) * CONV_WIDTH ** -0.5,
        "conv_w_out": nrm(ks[9], (n_conv, d, d), f32) * d ** -0.5,
        "peer_w_query": nrm(ks[10], (DEPTH, d, PEER_HEADS * PEER_KEY_DIM), f32) * d ** -0.5,
        "peer_sub_keys": nrm(ks[11], (DEPTH, PEER_HEADS, 2, PEER_N_KEYS, PEER_HALF_DIM), f32) * PEER_HALF_DIM ** -0.5,
        "peer_w_up": nrm(ks[12], (DEPTH, PEER_N_EXPERTS, d), f32) * d ** -0.5,
        "peer_w_down": nrm(ks[13], (DEPTH, PEER_N_EXPERTS, d), f32) * (PEER_HEADS * PEER_TOPK) ** -0.5,
    }


def reference(x, norm_mix, norm_ffn, norm_final, attn_w_qkv, attn_w_o, attn_rel_bias,
              conv_w_in, conv_w_conv, conv_w_out, peer_w_query, peer_sub_keys,
              peer_w_up, peer_w_down):
    h = x
    for i in range(DEPTH):
        j = i // N_MIXERS
        hn = rms_norm(h, norm_mix[i])
        if i % N_MIXERS == 0:
            h = h + neighbourhood_attention(hn, attn_w_qkv[j], attn_w_o[j], attn_rel_bias[j])
        else:
            h = h + short_conv_mixer(hn, conv_w_in[j], conv_w_conv[j], conv_w_out[j])
        hn = rms_norm(h, norm_ffn[i])
        h = h + peer_mixer(hn, peer_w_query[i], peer_sub_keys[i], peer_w_up[i], peer_w_down[i])
    return rms_norm(h, norm_final)
```

```cpp
#include <hip/hip_runtime.h>
#include <cstdio>
#include <cstdint>
namespace pg8 {
#define PG8_LAS __attribute__((address_space(3)))
typedef unsigned short bf16_t;
typedef short bf16x8 __attribute__((ext_vector_type(8)));
typedef float f32x4 __attribute__((ext_vector_type(4)));
typedef unsigned u32x4 __attribute__((ext_vector_type(4)));
constexpr int BM = 256, BK = 64, HALF = 128, HTB = HALF * BK * 2  , STAGE_BYTES = 8 * HTB, NXCD = 8, WGM = 8;

__host__ __device__ __forceinline__ int lds_byte(int r, int c) { const int st = (r >> 4) * 2 + (c >> 5), rr = r & 15, cc = c & 31, ob = rr * 64 + cc * 2; return st * 1024 + (ob ^ (((ob >> 9) & 1) << 5)); }
__host__ __device__ __forceinline__ void stage_rc(int b, int& R, int& C) { const int st = b / 1024, sb = b % 1024, swz = sb ^ (((sb >> 9) & 1) << 5); R = (st >> 1) * 16 + swz / 64; C = (st & 1) * 32 + (swz % 64) / 2; }
__host__ __device__ __forceinline__ int perm32(int rho) { const int n = rho >> 4, i = rho & 15; return 8 * (i >> 2) + 4 * n + (i & 3); }

struct Unit { int pm, pn; };
struct Gemm { const bf16_t* A; const bf16_t* Bt; int M, N, K; };

struct StaticOrder {
    int nM, nN, nwg, G, c;
    __host__ __device__ void init(int M, int N, int G_, int c_) { nM = M / BM; nN = N / BM; nwg = nM * nN; G = G_; c = c_; }
    __host__ __device__ bool next(int i, Unit& u) const {
        const long L = (long)i * G + c; if (L >= nwg) return false;
        int wgid = (int)L; { const int q = nwg / NXCD, r = nwg % NXCD, xcd = wgid % NXCD, off = wgid / NXCD; wgid = (xcd < r ? xcd * (q + 1) : r * (q + 1) + (xcd - r) * q) + off; }
        const int nig = WGM * nN, gid = wgid / nig, fm = gid * WGM, gsz = (nM - fm) < WGM ? (nM - fm) : WGM;
        u.pm = fm + ((wgid % nig) % gsz); u.pn = (wgid % nig) / gsz; return true;
    }
    __device__ __forceinline__ void a_ready(const Unit&) const {}
    __device__ __forceinline__ void done(const Unit&) const {}
};

__device__ __forceinline__ unsigned cvt_pk_bf16(float lo, float hi) { unsigned r; asm volatile("v_cvt_pk_bf16_f32 %0, %1, %2" : "=v"(r) : "v"(lo), "v"(hi)); return r; }
typedef float f32x2 __attribute__((ext_vector_type(2)));
__device__ __forceinline__ f32x2 gelu_pk(f32x2 v) {
    const f32x2 av = __builtin_elementwise_abs(v), d = av * 0.2316418882f + 1.0f;
    f32x2 t; t.x = __builtin_amdgcn_rcpf(d.x); t.y = __builtin_amdgcn_rcpf(d.y);
    f32x2 q = t * 0.5307027145f + (-0.7265760135f); q = q * t + 0.7107068705f; q = q * t + (-0.142248368f); q = q * t + 0.127414796f; q = q * t;
    const f32x2 s = (v * v) * (-0.72134752044f);
    f32x2 e; e.x = __builtin_amdgcn_exp2f(s.x); e.y = __builtin_amdgcn_exp2f(s.y);
    const f32x2 m = v * (q * e), r = v - m;
    f32x2 o; o.x = v.x < 0.f ? m.x : r.x; o.y = v.y < 0.f ? m.y : r.y; return o;
}

template <int ACT  > struct EpiBf16 {
    static constexpr bool PERM = true, AFTER_DRAIN = false; static_assert(ACT == 0 || ACT == 1, "EpiBf16: ACT is 0 (none) or 1 (gelu_pk)");
    bf16_t* O; int ldc; const float* bias; int split_cols; size_t split_stride; float scale0;
    __device__ __forceinline__ void operator()(const f32x4 (&acc)[2][2][4][2], const Unit& u, int wr, int wc, int fr, int fq) const {
        const int row0 = u.pm * BM + wr * 64 + fr; int colt = u.pn * BM; bf16_t* base = O;
        float sc = 1.f; if (split_cols) { const int t = colt / split_cols; base += (size_t)t * split_stride; colt -= t * split_cols; if (t == 0) sc = scale0; }
        const int col0 = colt + wc * 32 + 8 * fq, bcol0 = u.pn * BM + wc * 32 + 8 * fq;
        f32x4 bv[2][2];
#pragma unroll
        for (int bj = 0; bj < 2; ++bj)
#pragma unroll
            for (int n = 0; n < 2; ++n) bv[bj][n] = bias ? *(const f32x4*)(bias + bcol0 + bj * HALF + 4 * n) : (f32x4){0.f, 0.f, 0.f, 0.f};
#pragma unroll
        for (int ai = 0; ai < 2; ++ai)
#pragma unroll
            for (int m = 0; m < 4; ++m) { bf16_t* rowp = base + (size_t)(row0 + ai * HALF + m * 16) * ldc + col0;
#pragma unroll
                for (int bj = 0; bj < 2; ++bj) { f32x4 v0 = acc[ai][bj][m][0] + bv[bj][0], v1 = acc[ai][bj][m][1] + bv[bj][1];
                    if (ACT == 1) { f32x2 a = gelu_pk((f32x2){v0[0], v0[1]}), b = gelu_pk((f32x2){v0[2], v0[3]}), c = gelu_pk((f32x2){v1[0], v1[1]}), d = gelu_pk((f32x2){v1[2], v1[3]});
                        v0 = (f32x4){a.x, a.y, b.x, b.y}; v1 = (f32x4){c.x, c.y, d.x, d.y}; }
                    v0 = v0 * sc; v1 = v1 * sc; u32x4 w; w.x = cvt_pk_bf16(v0[0], v0[1]); w.y = cvt_pk_bf16(v0[2], v0[3]); w.z = cvt_pk_bf16(v1[0], v1[1]); w.w = cvt_pk_bf16(v1[2], v1[3]);
                    *(u32x4*)(rowp + bj * HALF) = w; } }
    }
};

template <class Epi, class Sched, bool ALIGN_EPI = false, bool SP2 = false>
__device__ __forceinline__ void gemm_phase(PG8_LAS unsigned char* lds, const Gemm g, const Sched& S, const Epi& E) {
    int tid_l = threadIdx.x; asm volatile("" : "+v"(tid_l));
    const int tid = tid_l, wid = __builtin_amdgcn_readfirstlane(tid >> 6), lane = tid & 63, wr = wid >> 2, wc = wid & 3, fr = lane & 15, fq = lane >> 4;
    const int K = g.K, nt = K / BK;
    unsigned voffA[2], voffB[2];
#pragma unroll
    for (int i = 0; i < 2; ++i) { int R, C; stage_rc(tid * 16 + i * 8192, R, C); const int Rb = Epi::PERM ? ((R & ~31) + perm32(R & 31)) : R;
        voffA[i] = (unsigned)(R * K + C) * 2u; voffB[i] = (unsigned)(Rb * K + C) * 2u; }
    const size_t kstep = (size_t)(BK * 2);
    const size_t hstep = (size_t)HALF * K * 2;
    const size_t tstep = 2 * hstep;
    const unsigned ldsw = (unsigned)wid * 1024u;
    const int aoff = lds_byte(wr * 64 + fr, fq * 8), boff = lds_byte(wc * 32 + fr, fq * 8);
#define PG8_SA(b, h) (((b) * 2 + (h)) * HTB)
#define PG8_SB(b, h) ((4 + (b) * 2 + (h)) * HTB)
#define PG8_STAGE(bufoff, gbase, voff) do { _Pragma("unroll") for (int _i = 0; _i < 2; ++_i) \
        __builtin_amdgcn_global_load_lds((const unsigned*)((const char*)(gbase) + (voff)[_i]), (PG8_LAS unsigned*)(lds + (bufoff) + ldsw + _i * 8192), 16, 0, 0); } while (0)
#define PG8_LDA(dst, b, h) do { _Pragma("unroll") for (int m = 0; m < 4; ++m) _Pragma("unroll") for (int k = 0; k < 2; ++k) dst[m][k] = *(const PG8_LAS bf16x8*)(lds + PG8_SA(b, h) + aoff + m * 2048 + k * 1024); } while (0)
#define PG8_LDB(dst, b, h) do { _Pragma("unroll") for (int n = 0; n < 2; ++n) _Pragma("unroll") for (int k = 0; k < 2; ++k) dst[n][k] = *(const PG8_LAS bf16x8*)(lds + PG8_SB(b, h) + boff + n * 2048 + k * 1024); } while (0)
#define PG8_MMA(ai, bj, At, Bt) do { __builtin_amdgcn_s_setprio(1); _Pragma("unroll") for (int m = 0; m < 4; ++m) _Pragma("unroll") for (int n = 0; n < 2; ++n) _Pragma("unroll") for (int k = 0; k < 2; ++k) \
        acc[ai][bj][m][n] = __builtin_amdgcn_mfma_f32_16x16x32_bf16(Bt[n][k], At[m][k], acc[ai][bj][m][n], 0, 0, 0); __builtin_amdgcn_s_setprio(0); } while (0)
#define PG8_WAIT_V(n) asm volatile("s_waitcnt vmcnt(" #n ")" ::: "memory")
#define PG8_WAIT_L(n) asm volatile("s_waitcnt lgkmcnt(" #n ")" ::: "memory")
#define PG8_BAR __builtin_amdgcn_s_barrier()
#define PG8_SCHED __builtin_amdgcn_sched_barrier(0)
    Unit cur, nxt; int ui = 0;
    if (!S.next(0, cur)) return;
    f32x4 acc[2][2][4][2];
#pragma unroll
    for (int a = 0; a < 2; ++a)
#pragma unroll
        for (int b = 0; b < 2; ++b)
#pragma unroll
            for (int m = 0; m < 4; ++m)
#pragma unroll
                for (int n = 0; n < 2; ++n) acc[a][b][m][n] = (f32x4){0.f, 0.f, 0.f, 0.f};
    bf16x8 At[4][2], B0[2][2], B1[2][2];
    const char* cA = (const char*)g.A + (size_t)cur.pm * tstep; const char* cB = (const char*)g.Bt + (size_t)cur.pn * tstep;
    S.a_ready(cur);
    if constexpr (SP2) {
        PG8_STAGE(PG8_SB(0, 0), cB, voffB); PG8_STAGE(PG8_SB(0, 1), cB + hstep, voffB); PG8_STAGE(PG8_SA(0, 0), cA, voffA); PG8_STAGE(PG8_SA(0, 1), cA + hstep, voffA);
        if (wr == 1) PG8_BAR;
        PG8_WAIT_V(2); PG8_BAR;
        PG8_STAGE(PG8_SB(1, 0), cB + kstep, voffB); PG8_STAGE(PG8_SA(1, 0), cA + kstep, voffA); PG8_STAGE(PG8_SB(1, 1), cB + hstep + kstep, voffB);
        PG8_WAIT_V(6); PG8_BAR;
    } else {
        PG8_STAGE(PG8_SB(0, 0), cB, voffB); PG8_STAGE(PG8_SA(0, 0), cA, voffA); PG8_STAGE(PG8_SB(0, 1), cB + hstep, voffB); PG8_STAGE(PG8_SA(0, 1), cA + hstep, voffA);
        if (wr == 1) PG8_BAR;
        PG8_WAIT_V(4); PG8_BAR;
        PG8_STAGE(PG8_SB(1, 0), cB + kstep, voffB); PG8_STAGE(PG8_SA(1, 0), cA + kstep, voffA); PG8_STAGE(PG8_SB(1, 1), cB + hstep + kstep, voffB);
        PG8_WAIT_V(6); PG8_BAR;
    }
    for (;;) {
        const bool has_next = S.next(ui + 1, nxt);
        const char* nA = has_next ? (const char*)g.A + (size_t)nxt.pm * tstep : cA; const char* nB = has_next ? (const char*)g.Bt + (size_t)nxt.pn * tstep : cB;
        for (int t = 0; t < nt; t += 2) {
            const bool last = (t == nt - 2);
            const char* a1 = cA + (size_t)(t + 1) * kstep;
            const char* a2 = last ? nA : cA + (size_t)(t + 2) * kstep; const char* b2 = last ? nB : cB + (size_t)(t + 2) * kstep;
            const char* a3 = a2 + kstep; const char* b3 = b2 + kstep;
            if (last && has_next) S.a_ready(nxt);
            if constexpr (SP2) {
            PG8_LDB(B0, 0, 0); PG8_LDB(B1, 0, 1); PG8_SCHED; PG8_LDA(At, 0, 0); PG8_STAGE(PG8_SA(1, 1), a1 + hstep, voffA);
            PG8_WAIT_V(8); PG8_WAIT_L(0); PG8_BAR; PG8_MMA(0, 0, At, B0); PG8_MMA(0, 1, At, B1); PG8_BAR; PG8_SCHED;
            PG8_LDA(At, 0, 1); PG8_STAGE(PG8_SB(0, 0), b2, voffB); PG8_STAGE(PG8_SB(0, 1), b2 + hstep, voffB); PG8_STAGE(PG8_SA(0, 0), a2, voffA);
            PG8_WAIT_V(8); PG8_WAIT_L(0); PG8_BAR; PG8_MMA(1, 0, At, B0); PG8_MMA(1, 1, At, B1); PG8_BAR; PG8_SCHED;
            PG8_LDB(B0, 1, 0); PG8_LDB(B1, 1, 1); PG8_SCHED; PG8_LDA(At, 1, 0); PG8_STAGE(PG8_SA(0, 1), a2 + hstep, voffA);
            PG8_WAIT_V(8); PG8_WAIT_L(0); PG8_BAR; PG8_MMA(0, 0, At, B0); PG8_MMA(0, 1, At, B1); PG8_BAR; PG8_SCHED;
            PG8_LDA(At, 1, 1); PG8_STAGE(PG8_SB(1, 0), b3, voffB); PG8_STAGE(PG8_SB(1, 1), b3 + hstep, voffB); PG8_STAGE(PG8_SA(1, 0), a3, voffA);
            PG8_WAIT_V(8); PG8_WAIT_L(0); PG8_BAR; PG8_MMA(1, 0, At, B0); PG8_MMA(1, 1, At, B1); PG8_BAR; PG8_SCHED;
            } else {
            PG8_LDB(B0, 0, 0); PG8_SCHED; PG8_LDA(At, 0, 0); PG8_STAGE(PG8_SA(1, 1), a1 + hstep, voffA);
            PG8_WAIT_L(8); PG8_BAR; PG8_WAIT_L(0); PG8_MMA(0, 0, At, B0); PG8_BAR; PG8_SCHED;
            PG8_LDB(B1, 0, 1); PG8_STAGE(PG8_SB(0, 0), b2, voffB);
            PG8_BAR; PG8_WAIT_L(0); PG8_MMA(0, 1, At, B1); PG8_BAR;
            PG8_LDA(At, 0, 1); PG8_STAGE(PG8_SA(0, 0), a2, voffA);
            PG8_BAR; PG8_WAIT_L(0); PG8_MMA(1, 0, At, B0); PG8_BAR; PG8_SCHED;
            PG8_STAGE(PG8_SB(0, 1), b2 + hstep, voffB);
            PG8_WAIT_V(6); PG8_BAR; PG8_MMA(1, 1, At, B1); PG8_BAR;
            PG8_LDB(B0, 1, 0); PG8_SCHED; PG8_LDA(At, 1, 0); PG8_STAGE(PG8_SA(0, 1), a2 + hstep, voffA);
            PG8_WAIT_L(8); PG8_BAR; PG8_WAIT_L(0); PG8_MMA(0, 0, At, B0); PG8_BAR; PG8_SCHED;
            PG8_LDB(B1, 1, 1); PG8_STAGE(PG8_SB(1, 0), b3, voffB);
            PG8_BAR; PG8_WAIT_L(0); PG8_MMA(0, 1, At, B1); PG8_BAR;
            PG8_LDA(At, 1, 1); PG8_STAGE(PG8_SA(1, 0), a3, voffA);
            PG8_BAR; PG8_WAIT_L(0); PG8_MMA(1, 0, At, B0); PG8_BAR; PG8_SCHED;
            PG8_STAGE(PG8_SB(1, 1), b3 + hstep, voffB);
            PG8_WAIT_V(6); PG8_BAR; PG8_MMA(1, 1, At, B1); PG8_BAR;
            }
        }
        if constexpr (ALIGN_EPI) { if (wr == 0) PG8_BAR; }
        if constexpr (!Epi::AFTER_DRAIN) { E(acc, cur, wr, wc, fr, fq); S.done(cur); }
        if (!has_next) break;
#pragma unroll
        for (int a = 0; a < 2; ++a)
#pragma unroll
            for (int b = 0; b < 2; ++b)
#pragma unroll
                for (int m = 0; m < 4; ++m)
#pragma unroll
                    for (int n = 0; n < 2; ++n) acc[a][b][m][n] = (f32x4){0.f, 0.f, 0.f, 0.f};
        cur = nxt; cA = nA; cB = nB; ++ui;
        if constexpr (ALIGN_EPI) { if (wr == 1) PG8_BAR; }
    }
    PG8_WAIT_V(0);
    if constexpr (!ALIGN_EPI) { if (wr == 0) PG8_BAR; }
    PG8_BAR;
    if constexpr (Epi::AFTER_DRAIN) { E.fused(acc, cur, wr, wc, fr, fq, lds, wid, lane); S.done(cur); }
#undef PG8_SA
#undef PG8_SB
#undef PG8_STAGE
#undef PG8_LDA
#undef PG8_LDB
#undef PG8_MMA
#undef PG8_WAIT_V
#undef PG8_WAIT_L
#undef PG8_BAR
#undef PG8_SCHED
}
}
#ifndef HD
#define HD __host__ __device__ __forceinline__
#endif
HD int tk_map(float f) { int b = __builtin_bit_cast(int, f); return b ^ ((b >> 31) & 0x7fffffff); }
HD float tk_unmap(int k) { int b = k ^ ((k >> 31) & 0x7fffffff); return __builtin_bit_cast(float, b); }
HD void tk_cx(int& a, int& b) { const int hi = a > b ? a : b, lo = a > b ? b : a; a = hi; b = lo; }
template <int N> HD void tk_sort_desc(int (&v)[N]) {
#pragma unroll
    for (int k = 2; k <= N; k <<= 1)
#pragma unroll
        for (int j = k >> 1; j > 0; j >>= 1)
#pragma unroll
            for (int i = 0; i < N; ++i) { const int l = i ^ j; if (l > i) { if ((i & k) == 0) tk_cx(v[i], v[l]); else tk_cx(v[l], v[i]); } }
}
template <int N> HD void tk_merge_top(int (&a)[N], const int (&b)[N]) {
#pragma unroll
    for (int i = 0; i < N; ++i) a[i] = a[i] > b[N - 1 - i] ? a[i] : b[N - 1 - i];
#pragma unroll
    for (int j = N >> 1; j > 0; j >>= 1)
#pragma unroll
        for (int i = 0; i < N; ++i) { const int l = i ^ j; if (l > i) tk_cx(a[i], a[l]); }
}
template <int NCH, class FP> HD void tk_stage1(FP s, int n_base, int (&best)[16]) {
#pragma unroll
    for (int c = 0; c < NCH; ++c) {
        int x[16];
#pragma unroll
        for (int e = 0; e < 16; ++e) x[e] = (tk_map(s[c * 16 + e]) & ~127) | (127 - (n_base + c * 16 + e));
        tk_sort_desc(x);
        if (c == 0) {
#pragma unroll
            for (int e = 0; e < 16; ++e) best[e] = x[e];
        } else tk_merge_top(best, x);
    }
}
template <class IP, class OI, class OG> HD void tk_stage2(int (&a)[16], int (&b)[16], IP AB, OI out_idx, OG out_g, float vscale = 1.0f) {
    float va[16], vb[16];
#pragma unroll
    for (int i = 0; i < 16; ++i) { AB[i] = a[i]; AB[16 + i] = b[i]; va[i] = tk_unmap(a[i] & ~127); vb[i] = tk_unmap(b[i] & ~127); }
    int best[16];
#pragma unroll
    for (int c = 0; c < 4; ++c) {
        int x[16];
#pragma unroll
        for (int e = 0; e < 16; ++e) x[e] = (int)0x80000000;
        int n = 0;
#pragma unroll
        for (int i = 0; i < 16; ++i)
#pragma unroll
            for (int j = 0; j < 16; ++j)
                if ((i + 1) * (j + 1) <= 16) { if (n >= 16 * c && n < 16 * c + 16) x[n - 16 * c] = (tk_map(va[i] + vb[j]) & ~255) | (255 - (i * 16 + j)); ++n; }
        tk_sort_desc(x);
        if (c == 0) {
#pragma unroll
            for (int e = 0; e < 16; ++e) best[e] = x[e];
        } else tk_merge_top(best, x);
    }
    int ka[16], kb[16];
#pragma unroll
    for (int k = 0; k < 16; ++k) { const int flat = 255 - (best[k] & 255); ka[k] = AB[flat >> 4]; kb[k] = AB[16 + (flat & 15)]; }
    float sv[16]; int ei[16]; float sum = 0.f;
#pragma unroll
    for (int k = 0; k < 16; ++k) { ei[k] = (127 - (ka[k] & 127)) * 128 + (127 - (kb[k] & 127)); sv[k] = (tk_unmap(ka[k] & ~127) + tk_unmap(kb[k] & ~127)) * vscale; }
    const float m = sv[0];
#pragma unroll
    for (int k = 0; k < 16; ++k) { sv[k] = __expf(sv[k] - m); sum += sv[k]; }
    const float inv = 1.0f / sum;
#pragma unroll
    for (int k = 0; k < 16; ++k) { out_idx[k] = ei[k]; out_g[k] = sv[k] * inv; }
}
constexpr int NWAVES = 8, NTHR = 512;
constexpr int BATCH = 2, SEQ = 8192, D = 1024, M = BATCH * SEQ, DEPTH = 4;
constexpr int NH = 16, HDIM = 64, GRIDW = 64, NROWS = 128;
constexpr float RMS_EPS = 1e-6f;
#ifndef MK_N_LAUNCHES
#define MK_N_LAUNCHES 1
#endif
#ifndef NAIVE_ATTN
#define NAIVE_ATTN 0
#endif
#ifndef NAIVE_TOPK
#define NAIVE_TOPK 0
#endif
#ifndef EXPERT_FP4
#define EXPERT_FP4 1
#endif
constexpr int ROWB = EXPERT_FP4 ? 512 : 1024;
#ifndef PROBE_GMODE
#define PROBE_GMODE 0
#endif
#ifndef PROBE_PMODE
#define PROBE_PMODE 0
#endif
#ifndef PROBE_LMASK
#define PROBE_LMASK 15
#endif
#ifndef PROBE_REP
#define PROBE_REP -1
#endif
constexpr int PH_PER_LAYER = 7, N_PHASES = 1 + DEPTH * PH_PER_LAYER;

constexpr size_t MiB = 1u << 20;
constexpr size_t WS_CTL = 0, CTL_ZERO_BYTES = 32 * 1024;
constexpr size_t WS_WQK = 2 * MiB;
constexpr size_t WS_WV = 10 * MiB;
constexpr size_t WS_WO = 14 * MiB;
constexpr size_t WS_WIN = 18 * MiB;
constexpr size_t WS_WOUT = 30 * MiB;
constexpr size_t WS_WP = 34 * MiB;
constexpr size_t WS_H = 64 * MiB;
constexpr size_t WS_HN = 128 * MiB;
constexpr size_t WS_BIG = 160 * MiB;
constexpr size_t WS_VT = 224 * MiB;
constexpr size_t WS_MIX = 256 * MiB;
constexpr size_t WS_SELI = 288 * MiB;
constexpr size_t WS_SELG = 296 * MiB;
constexpr size_t WS_UP = 320 * MiB;
constexpr size_t WS_DN = 384 * MiB;
constexpr size_t WS_SUP = 448 * MiB;
constexpr size_t WS_SDN = 449 * MiB;
constexpr size_t WS_RSS = 450 * MiB;
constexpr size_t WS_SC = 576 * MiB;
constexpr size_t WS_END = 704 * MiB;
constexpr int CW_BAR = 4096;
static_assert((CW_BAR + 3456) * 4 <= (int)CTL_ZERO_BYTES, "barrier words inside the per-call memset");

constexpr int LDS_BYTES = 163840, MISC_OFF = LDS_BYTES - 256, PTAB_OFF = LDS_BYTES - 512;

#define LAS __attribute__((address_space(3)))
typedef unsigned short bf16;
typedef unsigned v4u __attribute__((ext_vector_type(4)));
typedef unsigned v2u __attribute__((ext_vector_type(2)));
typedef float f32x4 __attribute__((ext_vector_type(4)));
typedef short bf16x8 __attribute__((ext_vector_type(8)));
#define LDS_WAIT() asm volatile("s_waitcnt lgkmcnt(0)" ::: "memory")
#define BLOCK_BAR() do { asm volatile("s_waitcnt vmcnt(0) lgkmcnt(0)" ::: "memory"); __builtin_amdgcn_s_barrier(); asm volatile("" ::: "memory"); } while (0)
__device__ __forceinline__ unsigned f2bf(float f) { unsigned u = __builtin_bit_cast(unsigned, f); return (u + 0x7fffu + ((u >> 16) & 1u)) >> 16; }
typedef float f32x2p __attribute__((ext_vector_type(2))); typedef __bf16 bf16x2p __attribute__((ext_vector_type(2)));
__device__ __forceinline__ unsigned pk2(float lo, float hi) { const f32x2p v = {lo, hi}; return __builtin_bit_cast(unsigned, __builtin_convertvector(v, bf16x2p)); }
__device__ __forceinline__ float bflo(unsigned u) { return __builtin_bit_cast(float, u << 16); }
__device__ __forceinline__ float bfhi(unsigned u) { return __builtin_bit_cast(float, u & 0xffff0000u); }
__device__ __forceinline__ float wave_sum(float v) {
#pragma unroll
    for (int o = 1; o < 64; o <<= 1) v += __shfl_xor(v, o);
    return v;
}

#define XB_TMO      128
#define XB_XCNT(j)  (256  + 64 * (j))
#define XB_XSUB(j)  (1280 + 64 * (j))
#define XB_XGEN(j)  (2304 + 64 * (j))
#define XB_TOP      3328
#define XB_TOPGEN   3392
#define XCD_BAR_WORDS 3456
#define XB_SPIN_CAP (1u << 20)
__device__ __forceinline__ unsigned xb_ld(unsigned* p)              { return __hip_atomic_load(p, __ATOMIC_RELAXED, __HIP_MEMORY_SCOPE_AGENT); }
__device__ __forceinline__ unsigned xb_add(unsigned* p, unsigned v) { return __hip_atomic_fetch_add(p, v, __ATOMIC_RELAXED, __HIP_MEMORY_SCOPE_AGENT); }
__device__ __forceinline__ unsigned xb_xcc_id() { return (unsigned)__builtin_amdgcn_s_getreg((3 << 11) | 20) & 0xFu; }
#define XB_SPIN(cond, bar) do { unsigned _sp = 0; while (cond) { __builtin_amdgcn_s_sleep(1); \
    if ((++_sp & 255u) == 0u) { if (xb_ld(&(bar)[XB_TMO])) break; if (_sp > XB_SPIN_CAP) { atomicAdd(&(bar)[XB_TMO], 1u); break; } } } } while (0)
struct XcdBarrier { unsigned* bar; unsigned x; volatile LAS unsigned* st; };
__device__ __forceinline__ XcdBarrier xcd_barrier_post(unsigned* bar, volatile LAS unsigned* st) {
    XcdBarrier b; b.bar = bar; b.x = xb_xcc_id(); b.st = st;
    if (threadIdx.x == 0) (void)xb_add(&bar[XB_XCNT(b.x)], 1u);
    return b;
}
__device__ __forceinline__ void xcd_barrier_complete(unsigned* bar, unsigned x, unsigned& nloc, unsigned& nx) {
    const unsigned G = gridDim.x * gridDim.y * gridDim.z;
    unsigned sum, cnt, mine, sp = 0u;
    for (;;) {
        sum = 0u; cnt = 0u; mine = 0u;
#pragma unroll
        for (unsigned j = 0; j < 16; ++j) { const unsigned c = xb_ld(&bar[XB_XCNT(j)]); sum += c; cnt += (c > 0u) ? 1u : 0u; mine = (j == x) ? c : mine; }
        if (sum == G) break;
        __builtin_amdgcn_s_sleep(1);
        if ((++sp & 255u) == 0u) { if (xb_ld(&bar[XB_TMO])) break; if (sp > XB_SPIN_CAP) { atomicAdd(&bar[XB_TMO], 1u); break; } }
    }
    nloc = mine > 0u ? mine : 1u; nx = cnt > 0u ? cnt : 1u;
}
__device__ __forceinline__ void xcd_barrier(const XcdBarrier& b) {
    asm volatile("s_waitcnt vmcnt(0)" ::: "memory");
    __syncthreads();
    if (threadIdx.x == 0) {
        unsigned* bar = b.bar;
        __builtin_amdgcn_s_waitcnt(0);
        unsigned nloc = b.st[0], nx = b.st[1];
        if (nloc == 0u) { xcd_barrier_complete(bar, b.x, nloc, nx); b.st[0] = nloc; b.st[1] = nx; }
        const unsigned old = xb_add(&bar[XB_XSUB(b.x)], 1u);
        const unsigned gen = old / nloc;
        if (old + 1u == (gen + 1u) * nloc) {
            __builtin_amdgcn_fence(__ATOMIC_RELEASE, "agent");
            asm volatile("s_waitcnt vmcnt(0)" ::: "memory");
            const unsigned og = xb_add(&bar[XB_TOP], 1u);
            const unsigned tg = og / nx;
            if (og + 1u == (tg + 1u) * nx) xb_add(&bar[XB_TOPGEN], 1u);
            else XB_SPIN(xb_ld(&bar[XB_TOPGEN]) == tg, bar);
            __builtin_amdgcn_fence(__ATOMIC_ACQUIRE, "agent");
            xb_add(&bar[XB_XGEN(b.x)], 1u);
            asm volatile("s_waitcnt vmcnt(0)" ::: "memory");
        } else {
            XB_SPIN(xb_ld(&bar[XB_XGEN(b.x)]) == gen, bar);
            __builtin_amdgcn_fence(__ATOMIC_ACQUIRE, "agent");
            asm volatile("s_waitcnt vmcnt(0)" ::: "memory");
        }
    }
    __syncthreads();
}

struct Frame {
    LAS unsigned char* lds;
    int tid, lane, wave, vcu, G;
    unsigned char* ws;
    __device__ __forceinline__ const float* in(int i) const {
        const volatile LAS unsigned* t = (const volatile LAS unsigned*)(lds + PTAB_OFF);
        const unsigned lo = __builtin_amdgcn_readfirstlane(t[2 * i]), hi = __builtin_amdgcn_readfirstlane(t[2 * i + 1]);
        return (const float*)(const __attribute__((address_space(1))) float*)(((unsigned long long)hi << 32) | lo);
    }
    __device__ __forceinline__ float* out() const { return (float*)in(14); }
};

struct EpiRes {
    static constexpr bool PERM = false, AFTER_DRAIN = false;
    const float* hin; float* h; bf16* hn; const float* gain; float* rss;
    __device__ __forceinline__ void operator()(const pg8::f32x4 (&acc)[2][2][4][2], const pg8::Unit& u, int wr, int wc, int fr, int fq) const {
        const int col0 = u.pn * 256 + wc * 32 + 4 * fq;
        f32x4 gv[2][2];
#pragma unroll
        for (int bj = 0; bj < 2; ++bj)
#pragma unroll
            for (int n = 0; n < 2; ++n) gv[bj][n] = *(const f32x4*)(gain + col0 + bj * 128 + n * 16);
#pragma unroll
        for (int ai = 0; ai < 2; ++ai)
#pragma unroll
            for (int m = 0; m < 4; ++m) { const int row = u.pm * 256 + ai * 128 + wr * 64 + m * 16 + fr; float* rowp = h + (size_t)row * D + col0; const float* rowi = hin + (size_t)row * D + col0; bf16* hrow = hn + (size_t)row * D + col0;
                float ss = 0.f;
#pragma unroll
                for (int bj = 0; bj < 2; ++bj)
#pragma unroll
                    for (int n = 0; n < 2; ++n) { f32x4* p = (f32x4*)(rowp + bj * 128 + n * 16); f32x4 v = *(const f32x4*)(rowi + bj * 128 + n * 16); v += acc[ai][bj][m][n]; *p = v;
                        ss += (v.x * v.x + v.y * v.y) + (v.z * v.z + v.w * v.w);
                        const f32x4 y = v * gv[bj][n]; v2u w; w.x = pk2(y.x, y.y); w.y = pk2(y.z, y.w); *(v2u*)(hrow + bj * 128 + n * 16) = w; }
                ss += __shfl_xor(ss, 16); ss += __shfl_xor(ss, 32);
                if (fq == 0) rss[(size_t)row * 16 + u.pn * 4 + wc] = ss; }
    }
};
struct EpiConvIn {
    static constexpr bool PERM = true, AFTER_DRAIN = false;
    bf16* U; bf16* GB;
    __device__ __forceinline__ void operator()(const pg8::f32x4 (&acc)[2][2][4][2], const pg8::Unit& u, int wr, int wc, int fr, int fq) const {
        const int row0 = u.pm * 256 + wr * 64 + fr;
        if (u.pn < 8) {
            const int ch0 = u.pn * 128 + wc * 32 + 8 * fq;
#pragma unroll
            for (int ai = 0; ai < 2; ++ai)
#pragma unroll
                for (int m = 0; m < 4; ++m) { const f32x4 p0 = acc[ai][0][m][0] * acc[ai][1][m][0], p1 = acc[ai][0][m][1] * acc[ai][1][m][1];
                    v4u w; w.x = pk2(p0[0], p0[1]); w.y = pk2(p0[2], p0[3]); w.z = pk2(p1[0], p1[1]); w.w = pk2(p1[2], p1[3]);
                    *(v4u*)(U + (size_t)(row0 + ai * 128 + m * 16) * D + ch0) = w; }
        } else {
            const int col0 = (u.pn - 8) * 256 + wc * 32 + 8 * fq;
#pragma unroll
            for (int ai = 0; ai < 2; ++ai)
#pragma unroll
                for (int m = 0; m < 4; ++m)
#pragma unroll
                    for (int bj = 0; bj < 2; ++bj) { const f32x4 v0 = acc[ai][bj][m][0], v1 = acc[ai][bj][m][1];
                        v4u w; w.x = pk2(v0[0], v0[1]); w.y = pk2(v0[2], v0[3]); w.z = pk2(v1[0], v1[1]); w.w = pk2(v1[2], v1[3]);
                        *(v4u*)(GB + (size_t)(row0 + ai * 128 + m * 16) * D + col0 + bj * 128) = w; }
        }
    }
};
struct EpiF32 {
    static constexpr bool PERM = false, AFTER_DRAIN = false;
    float* O; int ldc;
    __device__ __forceinline__ void operator()(const pg8::f32x4 (&acc)[2][2][4][2], const pg8::Unit& u, int wr, int wc, int fr, int fq) const {
        const int col0 = u.pn * 256 + wc * 32 + 4 * fq;
#pragma unroll
        for (int ai = 0; ai < 2; ++ai)
#pragma unroll
            for (int m = 0; m < 4; ++m) { float* rowp = O + (size_t)(u.pm * 256 + ai * 128 + wr * 64 + m * 16 + fr) * ldc + col0;
#pragma unroll
                for (int bj = 0; bj < 2; ++bj)
#pragma unroll
                    for (int n = 0; n < 2; ++n) *(f32x4*)(rowp + bj * 128 + n * 16) = acc[ai][bj][m][n]; }
    }
};
struct EpiTopK {
    static constexpr bool PERM = false, AFTER_DRAIN = true;
    int* seli; float* selg; const float* rss;
    __device__ __forceinline__ void operator()(const pg8::f32x4 (&)[2][2][4][2], const pg8::Unit&, int, int, int, int) const {}
    __device__ __forceinline__ void fused(pg8::f32x4 (&acc)[2][2][4][2], const pg8::Unit& u, int wr, int wc, int fr, int fq, LAS unsigned char* lds, int wid, int lane) const {
        LAS float* S = (LAS float*)lds;
        LAS int* L = (LAS int*)lds;
        const int tid = wid * 64 + lane;
#pragma unroll 1
        for (int ai = 0; ai < 2; ++ai) {
#pragma unroll
            for (int m = 0; m < 4; ++m)
#pragma unroll
                for (int bj = 0; bj < 2; ++bj)
#pragma unroll
                    for (int n = 0; n < 2; ++n) {
                        const int row = wr * 64 + m * 16 + fr, col = bj * 128 + wc * 32 + n * 16 + 4 * fq;
                        *(LAS f32x4*)(S + row * 260 + col) = ai == 0 ? acc[0][bj][m][n] : acc[1][bj][m][n];
                    }
            BLOCK_BAR();
            const int row = tid & 127, q = tid >> 7;
            int best[16];
            {
                const LAS f32x4* sp = (const LAS f32x4*)(S + row * 260 + q * 64);
#pragma unroll
                for (int c = 0; c < 4; ++c) {
                    int x[16];
#pragma unroll
                    for (int e4 = 0; e4 < 4; ++e4) { const f32x4 v = sp[c * 4 + e4];
#pragma unroll
                        for (int e = 0; e < 4; ++e) x[e4 * 4 + e] = (tk_map(v[e]) & ~127) | (127 - ((q & 1) * 64 + c * 16 + e4 * 4 + e)); }
                    tk_sort_desc(x);
                    if (c == 0) {
#pragma unroll
                        for (int e = 0; e < 16; ++e) best[e] = x[e];
                    } else tk_merge_top(best, x);
                }
            }
            BLOCK_BAR();
#pragma unroll
            for (int e4 = 0; e4 < 4; ++e4) *(LAS v4u*)(L + row * 68 + q * 16 + e4 * 4) = (v4u){(unsigned)best[e4 * 4], (unsigned)best[e4 * 4 + 1], (unsigned)best[e4 * 4 + 2], (unsigned)best[e4 * 4 + 3]};
            BLOCK_BAR();
            if (tid < 128) {
                int a[16], b[16], t[16];
                LAS int* Lr = L + tid * 68;
#pragma unroll
                for (int e4 = 0; e4 < 4; ++e4) { const v4u va = *(LAS v4u*)(Lr + e4 * 4), vt = *(LAS v4u*)(Lr + 16 + e4 * 4);
#pragma unroll
                    for (int e = 0; e < 4; ++e) { a[e4 * 4 + e] = (int)va[e]; t[e4 * 4 + e] = (int)vt[e]; } }
                tk_merge_top(a, t);
#pragma unroll
                for (int e4 = 0; e4 < 4; ++e4) { const v4u vb = *(LAS v4u*)(Lr + 32 + e4 * 4), vt = *(LAS v4u*)(Lr + 48 + e4 * 4);
#pragma unroll
                    for (int e = 0; e < 4; ++e) { b[e4 * 4 + e] = (int)vb[e]; t[e4 * 4 + e] = (int)vt[e]; } }
                tk_merge_top(b, t);
                const int trow = u.pm * 256 + ai * 128 + tid;
                const f32x4 q0 = *(const f32x4*)(rss + (size_t)trow * 16), q1 = *(const f32x4*)(rss + (size_t)trow * 16 + 4), q2 = *(const f32x4*)(rss + (size_t)trow * 16 + 8), q3 = *(const f32x4*)(rss + (size_t)trow * 16 + 12);
                const float ssq = (((q0.x + q0.y) + (q0.z + q0.w)) + ((q1.x + q1.y) + (q1.z + q1.w))) + (((q2.x + q2.y) + (q2.z + q2.w)) + ((q3.x + q3.y) + (q3.z + q3.w)));
                const float rstd = 1.0f / sqrtf(ssq * (1.f / D) + RMS_EPS);
                const size_t o = ((size_t)trow * 8 + u.pn) * 16;
                tk_stage2(a, b, Lr, (__attribute__((address_space(1))) int*)(seli + o), (__attribute__((address_space(1))) float*)(selg + o), rstd);
            }
            BLOCK_BAR();
        }
    }
};
struct OneUnit {
    pg8::Unit u;
    __device__ __forceinline__ bool next(int i, pg8::Unit& o) const { if (i != 0) return false; o = u; return true; }
    __device__ __forceinline__ void a_ready(const pg8::Unit&) const {}
    __device__ __forceinline__ void done(const pg8::Unit&) const {}
};

__device__ __forceinline__ void p0_transpose_item(const float* W, int ldw, int ncols, bf16* WT, float scale, LAS float* scr, int item, int lane) {
    const int nblk = ncols / 64, kb = item / nblk, nb = item % nblk, k0 = 64 * kb, n0 = 64 * nb;
    f32x4 v[16];
#pragma unroll
    for (int i = 0; i < 16; ++i) v[i] = *(const f32x4*)(W + (size_t)(k0 + 4 * i + (lane >> 4)) * ldw + n0 + 4 * (lane & 15));
#pragma unroll
    for (int i = 0; i < 16; ++i) { LAS float* p = scr + (4 * i + (lane >> 4)) * 65 + 4 * (lane & 15); p[0] = v[i].x * scale; p[1] = v[i].y * scale; p[2] = v[i].z * scale; p[3] = v[i].w * scale; }
    LDS_WAIT(); asm volatile("" ::: "memory");
    const int c = lane & 7;
#pragma unroll
    for (int j = 0; j < 8; ++j) { const int n = (lane >> 3) + 8 * j; const LAS float* s = scr + (8 * c) * 65 + n;
        v4u o; o.x = pk2(s[0 * 65], s[1 * 65]); o.y = pk2(s[2 * 65], s[3 * 65]); o.z = pk2(s[4 * 65], s[5 * 65]); o.w = pk2(s[6 * 65], s[7 * 65]);
        *(v4u*)(WT + (size_t)(n0 + n) * 1024 + k0 + 8 * c) = o; }
    LDS_WAIT(); asm volatile("" ::: "memory");
}
__device__ __forceinline__ void rms_row_to_bf16(const float* xrow, const float* gain, bf16* orow, float* hcopy, int lane) {
    const f32x4* xr = (const f32x4*)xrow + lane; const f32x4* gr = (const f32x4*)gain + lane;
    f32x4 v[4]; float s = 0.f;
#pragma unroll
    for (int j = 0; j < 4; ++j) { v[j] = xr[64 * j]; s += (v[j].x * v[j].x + v[j].y * v[j].y) + (v[j].z * v[j].z + v[j].w * v[j].w); }
    if (hcopy) {
#pragma unroll
        for (int j = 0; j < 4; ++j) ((f32x4*)hcopy + lane)[64 * j] = v[j];
    }
    const float rstd = 1.0f / sqrtf(wave_sum(s) * (1.f / D) + RMS_EPS);
    unsigned long long* o8 = (unsigned long long*)orow + lane;
#pragma unroll
    for (int j = 0; j < 4; ++j) { const f32x4 g = gr[64 * j]; const f32x4 y = v[j] * rstd * g;
        o8[64 * j] = (unsigned long long)pk2(y.x, y.y) | ((unsigned long long)pk2(y.z, y.w) << 32); }
}
__device__ __forceinline__ void p0_prologue(Frame& F, bool dry) {
    if (!(dry && PROBE_PMODE == 1)) {
        LAS float* KL = (LAS float*)F.lds;
        LAS float* WL = (LAS float*)(F.lds + 128 * 132 * 4);
        const float* in10 = F.in(10); const float* in11 = F.in(11);
        f32x4 kreg[8], wreg[4];
#define FOLD_LOAD(it_) do { const int l_ = (it_) >> 8, hp_ = ((it_) >> 4) & 15, k0_ = ((it_) & 15) * 64; \
            const float* kg_ = in11 + (size_t)(l_ * 16 + hp_) * 128 * 128; const float* wg_ = in10 + (size_t)l_ * 1024 * 2048 + (size_t)k0_ * 2048 + hp_ * 128; \
            _Pragma("unroll") for (int i = 0; i < 8; ++i) kreg[i] = *(const f32x4*)(kg_ + 4 * (F.tid + 512 * i)); \
            _Pragma("unroll") for (int i = 0; i < 4; ++i) { const int e = 4 * (F.tid + 512 * i); wreg[i] = *(const f32x4*)(wg_ + (size_t)(e >> 7) * 2048 + (e & 127)); } } while (0)
        if (F.vcu < DEPTH * 16 * 16) FOLD_LOAD(F.vcu);
        for (int it = F.vcu; it < DEPTH * 16 * 16; it += F.G) {
            const int l = it >> 8, hp = (it >> 4) & 15, k0 = (it & 15) * 64;
#pragma unroll
            for (int i = 0; i < 8; ++i) { const int e = 4 * (F.tid + 512 * i), n = e >> 7, d = e & 127; *(LAS f32x4*)(KL + n * 132 + d) = kreg[i]; }
#pragma unroll
            for (int i = 0; i < 4; ++i) { const int e = 4 * (F.tid + 512 * i), kk = e >> 7, d = e & 127; *(LAS f32x4*)(WL + kk * 132 + d) = wreg[i]; }
            if (it + F.G < DEPTH * 16 * 16) FOLD_LOAD(it + F.G);
            BLOCK_BAR();
            {
                const int i16 = F.lane & 15, g4 = F.lane >> 4, nt = F.wave;
                f32x4 facc[4];
#pragma unroll
                for (int mt = 0; mt < 4; ++mt) facc[mt] = (f32x4){0.f, 0.f, 0.f, 0.f};
#pragma unroll 2
                for (int s8 = 0; s8 < 8; ++s8) {
                    const f32x4 bq = *(const LAS f32x4*)(KL + (nt * 16 + i16) * 132 + 16 * s8 + 4 * g4);
                    f32x4 aq[4];
#pragma unroll
                    for (int mt = 0; mt < 4; ++mt) aq[mt] = *(const LAS f32x4*)(WL + (mt * 16 + i16) * 132 + 16 * s8 + 4 * g4);
#pragma unroll
                    for (int t = 0; t < 4; ++t)
#pragma unroll
                        for (int mt = 0; mt < 4; ++mt) facc[mt] = __builtin_amdgcn_mfma_f32_16x16x4f32(aq[mt][t], bq[t], facc[mt], 0, 0, 0);
                }
                bf16* o = (bf16*)(F.ws + WS_WP) + (size_t)l * 2048 * 1024 + (size_t)(hp * 128 + nt * 16 + i16) * 1024 + k0 + 4 * g4;
#pragma unroll
                for (int mt = 0; mt < 4; ++mt) { v2u w; w.x = pk2(facc[mt][0], facc[mt][1]); w.y = pk2(facc[mt][2], facc[mt][3]); *(v2u*)(o + mt * 16) = w; }
            }
            BLOCK_BAR();
        }
#undef FOLD_LOAD
    }
    LAS float* scr = (LAS float*)(F.lds + F.wave * 16640);
    const int gw = F.vcu * NWAVES + F.wave, NGW = F.G * NWAVES;
    constexpr int I_SQ = 16 * 16, I_IN = 16 * 48, PER_J = 3 * I_SQ + I_SQ + I_IN + I_SQ;
    if (!(dry && PROBE_PMODE == 2)) for (int it = gw; it < 2 * PER_J; it += NGW) {
        const int j = it / PER_J; int r = it % PER_J;
        const float* wqkv = F.in(4) + (size_t)j * 1024 * 3072;
        if (r < I_SQ) { p0_transpose_item(wqkv, 3072, 1024, (bf16*)(F.ws + WS_WQK) + (size_t)j * 2048 * 1024, 0.125f, scr, r, F.lane); continue; } r -= I_SQ;
        if (r < I_SQ) { p0_transpose_item(wqkv + 1024, 3072, 1024, (bf16*)(F.ws + WS_WQK) + (size_t)j * 2048 * 1024 + (size_t)1024 * 1024, 1.f, scr, r, F.lane); continue; } r -= I_SQ;
        if (r < I_SQ) { p0_transpose_item(wqkv + 2048, 3072, 1024, (bf16*)(F.ws + WS_WV) + (size_t)j * 1024 * 1024, 1.f, scr, r, F.lane); continue; } r -= I_SQ;
        if (r < I_SQ) { p0_transpose_item(F.in(5) + (size_t)j * 1024 * 1024, 1024, 1024, (bf16*)(F.ws + WS_WO) + (size_t)j * 1024 * 1024, 1.f, scr, r, F.lane); continue; } r -= I_SQ;
        if (r < I_IN) {
            const float* win = F.in(7) + (size_t)j * 1024 * 3072; bf16* wt = (bf16*)(F.ws + WS_WIN) + (size_t)j * 3072 * 1024;
            if (r < 512) { const int blk = r >> 5, pn = blk >> 1, which = blk & 1; p0_transpose_item(win + (which ? 2048 : 1024) + 128 * pn, 3072, 128, wt + (size_t)(256 * pn + 128 * which) * 1024, 1.f, scr, r & 31, F.lane); }
            else p0_transpose_item(win, 3072, 1024, wt + (size_t)2048 * 1024, 1.f, scr, r - 512, F.lane);
            continue; } r -= I_IN;
        p0_transpose_item(F.in(9) + (size_t)j * 1024 * 1024, 1024, 1024, (bf16*)(F.ws + WS_WOUT) + (size_t)j * 1024 * 1024, 1.f, scr, r, F.lane);
    }
    if (!(dry && PROBE_PMODE == 3)) {
        constexpr int NROW = DEPTH * 16384;
        const float* in12 = F.in(12); const float* in13 = F.in(13);
#define XC_LOAD(v, r0_) do { const int tb_ = (r0_) >= NROW ? 1 : 0, rr_ = (r0_) - tb_ * NROW; const float* src_ = (tb_ ? in13 : in12) + (size_t)rr_ * 1024 + 16 * F.lane; \
            _Pragma("unroll") for (int u = 0; u < 4; ++u) _Pragma("unroll") for (int i = 0; i < 4; ++i) v[u][i] = *(const f32x4*)(src_ + (size_t)u * 1024 + 4 * i); } while (0)
#if EXPERT_FP4
#define XC_PACK(v, u, q, dstp) do { v2u w_; _Pragma("unroll") for (int jj = 0; jj < 2; ++jj) { unsigned t_ = 0u; \
                    t_ = __builtin_amdgcn_cvt_scalef32_pk_fp4_f32(t_, v[u][2 * jj].x * q, v[u][2 * jj].y * q, 1.0f, 0); t_ = __builtin_amdgcn_cvt_scalef32_pk_fp4_f32(t_, v[u][2 * jj].z * q, v[u][2 * jj].w * q, 1.0f, 1); \
                    t_ = __builtin_amdgcn_cvt_scalef32_pk_fp4_f32(t_, v[u][2 * jj + 1].x * q, v[u][2 * jj + 1].y * q, 1.0f, 2); t_ = __builtin_amdgcn_cvt_scalef32_pk_fp4_f32(t_, v[u][2 * jj + 1].z * q, v[u][2 * jj + 1].w * q, 1.0f, 3); w_[jj] = t_; } \
                *(v2u*)(dstp) = w_; } while (0)
        constexpr float QMAX = 6.0f;
#else
#define XC_PACK(v, u, q, dstp) do { v4u w_; _Pragma("unroll") for (int i = 0; i < 4; ++i) { unsigned t_ = 0u; t_ = __builtin_amdgcn_cvt_pk_fp8_f32(v[u][i].x * q, v[u][i].y * q, t_, false); t_ = __builtin_amdgcn_cvt_pk_fp8_f32(v[u][i].z * q, v[u][i].w * q, t_, true); w_[i] = t_; } \
                *(v4u*)(dstp) = w_; } while (0)
        constexpr float QMAX = 256.0f;
#endif
#define XC_CONV(v, r0_) do { const int tb_ = (r0_) >= NROW ? 1 : 0, rr_ = (r0_) - tb_ * NROW; \
            unsigned char* dst_ = F.ws + (tb_ ? WS_DN : WS_UP) + (size_t)rr_ * ROWB + (ROWB / 64) * F.lane; float* sc_ = (float*)(F.ws + (tb_ ? WS_SDN : WS_SUP)) + rr_; \
            _Pragma("unroll") for (int u = 0; u < 4; ++u) { float mx = 0.f; \
                _Pragma("unroll") for (int i = 0; i < 4; ++i) mx = fmaxf(fmaxf(mx, fmaxf(fabsf(v[u][i].x), fabsf(v[u][i].y))), fmaxf(fabsf(v[u][i].z), fabsf(v[u][i].w))); \
                _Pragma("unroll") for (int o = 1; o < 64; o <<= 1) mx = fmaxf(mx, __shfl_xor(mx, o)); \
                const float q = mx > 0.f ? QMAX / mx : 1.0f; \
                XC_PACK(v, u, q, dst_ + (size_t)u * ROWB); \
                if (F.lane == 0) sc_[u] = mx > 0.f ? mx * (1.0f / QMAX) : 1.0f; } } while (0)
        const int stepr = NGW * 4;
        f32x4 va[4][4], vb[4][4];
        int r0 = gw * 4;
        if (r0 < 2 * NROW) XC_LOAD(va, r0);
#pragma unroll 1
        for (; r0 < 2 * NROW; r0 += 2 * stepr) {
            if (r0 + stepr < 2 * NROW) XC_LOAD(vb, r0 + stepr);
            XC_CONV(va, r0);
            if (r0 + 2 * stepr < 2 * NROW) XC_LOAD(va, r0 + 2 * stepr);
            if (r0 + stepr < 2 * NROW) XC_CONV(vb, r0 + stepr);
        }
#undef XC_LOAD
#undef XC_PACK
#undef XC_CONV
    }
    if (!(dry && PROBE_PMODE == 4)) {
        const float* x0 = F.in(0); const f32x4* gr = (const f32x4*)F.in(1) + F.lane;
        f32x4 gq[4];
#pragma unroll
        for (int j = 0; j < 4; ++j) gq[j] = gr[64 * j];
#pragma unroll 1
        for (int m0 = gw; m0 < M; m0 += 4 * NGW) {
            f32x4 v[4][4];
#pragma unroll
            for (int u = 0; u < 4; ++u) { const int m = m0 + u * NGW; if (m < M) {
#pragma unroll
                for (int j = 0; j < 4; ++j) v[u][j] = ((const f32x4*)(x0 + (size_t)m * D) + F.lane)[64 * j]; } }
#pragma unroll
            for (int u = 0; u < 4; ++u) { const int m = m0 + u * NGW; if (m < M) {
                float sq = 0.f;
#pragma unroll
                for (int j = 0; j < 4; ++j) { sq += (v[u][j].x * v[u][j].x + v[u][j].y * v[u][j].y) + (v[u][j].z * v[u][j].z + v[u][j].w * v[u][j].w); }
                const float rstd = 1.0f / sqrtf(wave_sum(sq) * (1.f / D) + RMS_EPS);
                unsigned long long* o8 = (unsigned long long*)((bf16*)(F.ws + WS_HN) + (size_t)m * D) + F.lane;
#pragma unroll
                for (int j = 0; j < 4; ++j) { const f32x4 y = v[u][j] * rstd * gq[j]; o8[64 * j] = (unsigned long long)pk2(y.x, y.y) | ((unsigned long long)pk2(y.z, y.w) << 32); } } }
        }
    }
}

__device__ __forceinline__ void norm_phase(Frame& F, const float* gain) {
    const int gw = F.vcu * NWAVES + F.wave, NGW = F.G * NWAVES;
    for (int m = gw; m < M; m += NGW) rms_row_to_bf16((const float*)(F.ws + WS_H) + (size_t)m * D, gain, (bf16*)(F.ws + WS_HN) + (size_t)m * D, nullptr, F.lane);
}
__device__ __forceinline__ void conv_phase(Frame& F, int j) {
    const bf16* U = (const bf16*)(F.ws + WS_BIG); const bf16* GB = (const bf16*)(F.ws + WS_BIG + 32 * MiB); bf16* mix = (bf16*)(F.ws + WS_MIX);
    const float* wc = F.in(8) + (size_t)j * 3 * 1024;
    for (int idx = F.vcu * NTHR + F.tid; idx < M * 128; idx += F.G * NTHR) {
        const int t = idx >> 7, c8 = (idx & 127) * 8, s = t & (SEQ - 1);
        const v4u gb = *(const v4u*)(GB + (size_t)t * D + c8);
        float conv[8];
#pragma unroll
        for (int e = 0; e < 8; ++e) conv[e] = 0.f;
#pragma unroll
        for (int dj = -1; dj <= 1; ++dj) {
            if (s + dj >= 0 && s + dj < SEQ) {
                const v4u uu = *(const v4u*)(U + (size_t)(t + dj) * D + c8);
                const f32x4 w0 = *(const f32x4*)(wc + (dj + 1) * 1024 + c8), w1 = *(const f32x4*)(wc + (dj + 1) * 1024 + c8 + 4);
#pragma unroll
                for (int e2 = 0; e2 < 4; ++e2) {
                    const float wl = e2 < 2 ? w0[2 * e2] : w1[2 * e2 - 4], wh = e2 < 2 ? w0[2 * e2 + 1] : w1[2 * e2 - 3];
                    conv[2 * e2] += wl * bflo(uu[e2]); conv[2 * e2 + 1] += wh * bfhi(uu[e2]);
                }
            }
        }
        v4u o;
#pragma unroll
        for (int e2 = 0; e2 < 4; ++e2) o[e2] = pk2(bflo(gb[e2]) * conv[2 * e2], bfhi(gb[e2]) * conv[2 * e2 + 1]);
        *(v4u*)(mix + (size_t)t * 1024 + c8) = o;
    }
}

constexpr int AT_KSTR = 144, AT_VSTR = 1168, AT_KOFF = 0, AT_VOFF = 576 * AT_KSTR, AT_BOFF = AT_VOFF + 64 * AT_VSTR;
static_assert(AT_BOFF + 1860 <= PTAB_OFF, "attention LDS map");
__device__ __forceinline__ void attn_phase(Frame& F, int j) {
    const bf16* QK = (const bf16*)(F.ws + WS_BIG); const bf16* VT = (const bf16*)(F.ws + WS_VT); bf16* mix = (bf16*)(F.ws + WS_MIX);
    const float* biasl = F.in(6) + (size_t)j * NH * 15 * 31;
    const int lane = F.lane, q = lane & 15, g = lane >> 4, tid = F.tid;
    LAS unsigned char* KL = F.lds + AT_KOFF; LAS unsigned char* VL = F.lds + AT_VOFF; LAS float* btab = (LAS float*)(F.lds + AT_BOFF);
    v4u kreg[9], vreg[9];
    int cur_hh = -1;
#define AT_DECODE(it, b_, hh_, r0_, R0_) const int hh_ = (it) & 15, rp_##it = ((it) >> 4) & 63, b_ = (it) >> 10, r0_ = 2 * rp_##it; int R0_ = r0_ - 4; R0_ = R0_ < 0 ? 0 : (R0_ > NROWS - 8 ? NROWS - 8 : R0_);
#define AT_PREFETCH(it) do { AT_DECODE(it, pb, phh, pr0, pR0) \
        _Pragma("unroll") for (int i = 0; i < 9; ++i) { const int c = tid + 512 * i; \
            { const int key = c >> 3, ch = c & 7; int row = pR0 + (key >> 6); row = row > NROWS - 1 ? NROWS - 1 : row; \
              kreg[i] = *(const v4u*)(QK + ((size_t)pb * SEQ + row * 64 + (key & 63)) * 2048 + 1024 + phh * 64 + ch * 8); } \
            { const int d = c / 72, kch = c - d * 72; vreg[i] = *(const v4u*)(VT + (size_t)(phh * 64 + d) * M + (size_t)pb * SEQ + pR0 * 64 + kch * 8); } } } while (0)
    int it = F.vcu;
    if (it < 2048) AT_PREFETCH(it);
    for (; it < 2048; it += F.G) {
        AT_DECODE(it, b, hh, r0, R0)
        BLOCK_BAR();
#pragma unroll
        for (int i = 0; i < 9; ++i) { const int c = tid + 512 * i;
            *(LAS v4u*)(KL + (c >> 3) * AT_KSTR + (c & 7) * 16) = kreg[i];
            const int d = c / 72, kch = c - d * 72; *(LAS v4u*)(VL + d * AT_VSTR + kch * 16) = vreg[i]; }
        if (hh != cur_hh) { if (tid < 465) btab[tid] = biasl[(size_t)hh * 465 + tid]; cur_hh = hh; }
        BLOCK_BAR();
        const int r = r0 + (F.wave >> 2), jb = F.wave & 3;
        int rs = r - 4; rs = rs < 0 ? 0 : (rs > NROWS - 8 ? NROWS - 8 : rs);
        const int lr0 = rs - R0;
        int bs = 16 * jb - 8; bs = bs < 0 ? 0 : (bs > 32 ? 32 : bs);
        const int qc = 16 * jb + q; int wst = qc - 8; wst = wst < 0 ? 0 : (wst > 48 ? 48 : wst);
        const size_t tokq = (size_t)b * SEQ + r * 64 + qc;
        bf16x8 qf[2];
#pragma unroll
        for (int ks = 0; ks < 2; ++ks) qf[ks] = *(const bf16x8*)(QK + tokq * 2048 + hh * 64 + ks * 32 + 8 * g);
        f32x4 S[8][2];
        const int kcl_a = 8 * (q >> 2) + (q & 3);
#pragma unroll
        for (int wr = 0; wr < 8; ++wr)
#pragma unroll
            for (int T = 0; T < 2; ++T) {
                const LAS unsigned char* kp = KL + ((lr0 + wr) * 64 + bs + kcl_a + 4 * T) * AT_KSTR + 16 * g;
                const bf16x8 k0 = *(const LAS bf16x8*)kp, k1 = *(const LAS bf16x8*)(kp + 64);
                f32x4 c = (f32x4){0.f, 0.f, 0.f, 0.f};
                c = __builtin_amdgcn_mfma_f32_16x16x32_bf16(k0, qf[0], c, 0, 0, 0);
                c = __builtin_amdgcn_mfma_f32_16x16x32_bf16(k1, qf[1], c, 0, 0, 0);
                S[wr][T] = c;
            }
        float mx = -3.0e38f;
#pragma unroll
        for (int wr = 0; wr < 8; ++wr) {
            const LAS float* brow = btab + (rs + wr - r + 7) * 31;
#pragma unroll
            for (int T = 0; T < 2; ++T)
#pragma unroll
                for (int i = 0; i < 4; ++i) {
                    const int kc = bs + 8 * g + 4 * T + i;
                    int co = kc - qc + 15; co = co < 0 ? 0 : (co > 30 ? 30 : co);
                    const bool valid = (kc >= wst) && (kc < wst + 16);
                    const float v = valid ? S[wr][T][i] + brow[co] : -1e30f;
                    S[wr][T][i] = v; mx = fmaxf(mx, v);
                }
        }
        mx = fmaxf(mx, __shfl_xor(mx, 16)); mx = fmaxf(mx, __shfl_xor(mx, 32));
        float sum = 0.f;
        bf16x8 pf[8];
#pragma unroll
        for (int wr = 0; wr < 8; ++wr) {
            float p[8];
#pragma unroll
            for (int T = 0; T < 2; ++T)
#pragma unroll
                for (int i = 0; i < 4; ++i) { p[4 * T + i] = __expf(S[wr][T][i] - mx); sum += p[4 * T + i]; }
            v4u w; w.x = pk2(p[0], p[1]); w.y = pk2(p[2], p[3]); w.z = pk2(p[4], p[5]); w.w = pk2(p[6], p[7]);
            pf[wr] = __builtin_bit_cast(bf16x8, w);
        }
        sum += __shfl_xor(sum, 16); sum += __shfl_xor(sum, 32);
        if (it + F.G < 2048) { const int nit = it + F.G; AT_PREFETCH(nit); }
        f32x4 O[4];
#pragma unroll
        for (int dt = 0; dt < 4; ++dt) O[dt] = (f32x4){0.f, 0.f, 0.f, 0.f};
#pragma unroll
        for (int wr = 0; wr < 8; ++wr)
#pragma unroll
            for (int dt = 0; dt < 4; ++dt) {
                const bf16x8 vf = *(const LAS bf16x8*)(VL + (dt * 16 + q) * AT_VSTR + ((lr0 + wr) * 64 + bs + 8 * g) * 2);
                O[dt] = __builtin_amdgcn_mfma_f32_16x16x32_bf16(vf, pf[wr], O[dt], 0, 0, 0);
            }
        const float inv = 1.0f / sum;
#pragma unroll
        for (int dt = 0; dt < 4; ++dt) { v2u w; w.x = pk2(O[dt][0] * inv, O[dt][1] * inv); w.y = pk2(O[dt][2] * inv, O[dt][3] * inv);
            *(v2u*)(mix + tokq * 1024 + hh * 64 + dt * 16 + 4 * g) = w; }
    }
#undef AT_DECODE
#undef AT_PREFETCH
    BLOCK_BAR();
}
#if NAIVE_ATTN
__device__ __forceinline__ void attn_naive_phase(Frame& F, int j) {
    const bf16* QK = (const bf16*)(F.ws + WS_BIG); const bf16* VT = (const bf16*)(F.ws + WS_VT); bf16* mix = (bf16*)(F.ws + WS_MIX);
    const float* biasl = F.in(6) + (size_t)j * NH * 15 * 31;
    for (int idx = F.vcu * NTHR + F.tid; idx < M * NH; idx += F.G * NTHR) {
        const int hh = idx & 15, t = idx >> 4, b = t >> 13, s = t & (SEQ - 1), r = s >> 6, qc = s & 63;
        int rs = r - 4; rs = rs < 0 ? 0 : (rs > NROWS - 8 ? NROWS - 8 : rs);
        int wst = qc - 8; wst = wst < 0 ? 0 : (wst > 48 ? 48 : wst);
        float qv[64];
#pragma unroll
        for (int c = 0; c < 8; ++c) { const v4u w = *(const v4u*)(QK + (size_t)t * 2048 + hh * 64 + c * 8);
#pragma unroll
            for (int e = 0; e < 4; ++e) { qv[c * 8 + 2 * e] = bflo(w[e]); qv[c * 8 + 2 * e + 1] = bfhi(w[e]); } }
        float mrun = -3.0e38f, lrun = 0.f, o[64];
#pragma unroll
        for (int d = 0; d < 64; ++d) o[d] = 0.f;
        for (int wr = 0; wr < 8; ++wr)
            for (int kk = 0; kk < 16; ++kk) {
                const int kc = wst + kk; const size_t tk = (size_t)b * SEQ + (rs + wr) * 64 + kc;
                float sd = 0.f;
#pragma unroll
                for (int c = 0; c < 8; ++c) { const v4u w = *(const v4u*)(QK + tk * 2048 + 1024 + hh * 64 + c * 8);
#pragma unroll
                    for (int e = 0; e < 4; ++e) sd += qv[c * 8 + 2 * e] * bflo(w[e]) + qv[c * 8 + 2 * e + 1] * bfhi(w[e]); }
                int co = kc - qc + 15; co = co < 0 ? 0 : (co > 30 ? 30 : co);
                sd += biasl[(size_t)hh * 465 + (rs + wr - r + 7) * 31 + co];
                const float mn = fmaxf(mrun, sd), al = __expf(mrun - mn), p = __expf(sd - mn);
                lrun = lrun * al + p; mrun = mn;
#pragma unroll
                for (int d = 0; d < 64; ++d) o[d] = o[d] * al + p * bflo((unsigned)VT[(size_t)(hh * 64 + d) * M + tk]);
            }
        const float inv = 1.0f / lrun;
#pragma unroll
        for (int c = 0; c < 8; ++c) { v4u w;
#pragma unroll
            for (int e = 0; e < 4; ++e) w[e] = pk2(o[c * 8 + 2 * e] * inv, o[c * 8 + 2 * e + 1] * inv);
            *(v4u*)(mix + (size_t)t * 1024 + hh * 64 + c * 8) = w; }
    }
}
#endif
#if NAIVE_TOPK
__device__ __forceinline__ void select_naive_phase(Frame& F) {
    const float* SC = (const float*)(F.ws + WS_SC); int* seli = (int*)(F.ws + WS_SELI); float* selg = (float*)(F.ws + WS_SELG);
    LAS int* AB = (LAS int*)F.lds + F.tid * 33;
    for (int idx = F.vcu * NTHR + F.tid; idx < M * 8; idx += F.G * NTHR) {
        const float* s = SC + (size_t)idx * 256;
        int a[16], b[16], t[16];
        tk_stage1<4>(s, 0, a); tk_stage1<4>(s + 64, 64, t); tk_merge_top(a, t);
        tk_stage1<4>(s + 128, 0, b); tk_stage1<4>(s + 192, 64, t); tk_merge_top(b, t);
        tk_stage2(a, b, AB, seli + (size_t)idx * 16, selg + (size_t)idx * 16);
    }
}
#endif

__device__ __forceinline__ float gelu_erf(float a) { return 0.5f * a * (1.0f + erff(a * 0.70710678118654752f)); }
typedef float f32x2g __attribute__((ext_vector_type(2)));
#if EXPERT_FP4
typedef v2u rowv;
__device__ __forceinline__ rowv row_load(const unsigned char* T, int e, int lane) { return *(const v2u*)(T + (size_t)e * ROWB + 8 * lane); }
#define ROW_PAIR(r, m) __builtin_amdgcn_cvt_scalef32_pk_f32_fp4((r)[(m) >> 2], 1.0f, (m) & 3)
#else
typedef v4u rowv;
__device__ __forceinline__ rowv row_load(const unsigned char* T, int e, int lane) { return *(const v4u*)(T + (size_t)e * ROWB + 16 * lane); }
#define ROW_PAIR(r, m) __builtin_amdgcn_cvt_pk_f32_fp8((r)[(m) >> 1], ((m) & 1) != 0)
#endif
__device__ __forceinline__ void row_axpy(f32x2g (&out)[8], const rowv d, float ak) {
    const f32x2g a2 = (f32x2g){ak, ak};
    out[0] = __builtin_elementwise_fma(a2, ROW_PAIR(d, 0), out[0]); out[1] = __builtin_elementwise_fma(a2, ROW_PAIR(d, 1), out[1]); out[2] = __builtin_elementwise_fma(a2, ROW_PAIR(d, 2), out[2]); out[3] = __builtin_elementwise_fma(a2, ROW_PAIR(d, 3), out[3]);
    out[4] = __builtin_elementwise_fma(a2, ROW_PAIR(d, 4), out[4]); out[5] = __builtin_elementwise_fma(a2, ROW_PAIR(d, 5), out[5]); out[6] = __builtin_elementwise_fma(a2, ROW_PAIR(d, 6), out[6]); out[7] = __builtin_elementwise_fma(a2, ROW_PAIR(d, 7), out[7]);
}
typedef int v8i_g __attribute__((ext_vector_type(8)));
__device__ __forceinline__ void gather_phase(Frame& F, int layer, bool dry) {
    const unsigned char* UP = F.ws + WS_UP + (size_t)layer * 16384 * ROWB; const unsigned char* DN = F.ws + WS_DN + (size_t)layer * 16384 * ROWB;
    const float* SUP = (const float*)(F.ws + WS_SUP) + (size_t)layer * 16384; const float* SDN = (const float*)(F.ws + WS_SDN) + (size_t)layer * 16384;
    const float* gain = F.in(2) + (size_t)layer * D; const float* gnext = layer < DEPTH - 1 ? F.in(1) + (size_t)(layer + 1) * D : F.in(3);
    float* outp = F.out();
    const int* seli = (const int*)(F.ws + WS_SELI); const float* selg = (const float*)(F.ws + WS_SELG);
    float* H = (float*)(F.ws + WS_H); bf16* HN = (bf16*)(F.ws + (dry ? WS_SC + 64 * MiB : WS_HN)); float* HW = (float*)(F.ws + (dry ? WS_SC : WS_H)); if (dry) outp = HW;
    const int lane = F.lane, gw = F.vcu * NWAVES + F.wave, NGW = F.G * NWAVES;
    const bool b5 = lane & 32, b4 = lane & 16, b3 = lane & 8, b2 = lane & 4;
    constexpr int G_RS = 528, G_RB = 32 * G_RS, G_NSLOT = 4;
    LAS unsigned char* RB = F.lds + F.wave * G_RB;
    LAS float* ACT = (LAS float*)(F.lds + 8 * G_RB + F.wave * (G_NSLOT * 512));
    static_assert(8 * G_RB + 8 * G_NSLOT * 512 + 8 * 1024 <= PTAB_OFF, "gather LDS map");
#pragma unroll 1
    for (int base = gw; base < M; base += G_NSLOT * NGW) {
    LAS unsigned char* X8 = F.lds + 8 * G_RB + 8 * G_NSLOT * 512 + F.wave * 1024;
    const int n16 = lane & 15, g4 = lane >> 4;
    f32x4 nhv[4]; int nidx_lo = 0, nidx_hi = 0; float ng_lo = 0.f, ng_hi = 0.f;
#define TOK_LOAD(t_) do { const float* hr_ = H + (size_t)(t_) * D + 16 * lane; _Pragma("unroll") for (int i = 0; i < 4; ++i) nhv[i] = *(const f32x4*)(hr_ + 4 * i); \
        nidx_lo = seli[(size_t)(t_) * 128 + lane]; nidx_hi = seli[(size_t)(t_) * 128 + 64 + lane]; ng_lo = selg[(size_t)(t_) * 128 + lane]; ng_hi = selg[(size_t)(t_) * 128 + 64 + lane]; } while (0)
    if (base < M) TOK_LOAD(base);
#pragma unroll 1
    for (int slot = 0; slot < G_NSLOT; ++slot) {
        const int t = base + slot * NGW; if (t >= M) break;
        f32x4 hv[4];
#pragma unroll
        for (int i = 0; i < 4; ++i) hv[i] = nhv[i];
        const int idx_lo = nidx_lo, idx_hi = nidx_hi; const float g_lo = ng_lo, g_hi = ng_hi;
        if (slot + 1 < G_NSLOT && t + NGW < M) TOK_LOAD(t + NGW);
        float ss = 0.f;
#pragma unroll
        for (int i = 0; i < 4; ++i) ss += (hv[i].x * hv[i].x + hv[i].y * hv[i].y) + (hv[i].z * hv[i].z + hv[i].w * hv[i].w);
        const float rstd = 1.0f / sqrtf(wave_sum(ss) * (1.f / D) + RMS_EPS);
        float xmax = 0.f;
        f32x4 xv[4];
#pragma unroll
        for (int i = 0; i < 4; ++i) { const f32x4 g = *(const f32x4*)(gain + 16 * lane + 4 * i); xv[i] = hv[i] * rstd * g;
            xmax = fmaxf(fmaxf(xmax, fmaxf(fabsf(xv[i].x), fabsf(xv[i].y))), fmaxf(fabsf(xv[i].z), fabsf(xv[i].w))); }
#pragma unroll
        for (int o = 1; o < 64; o <<= 1) xmax = fmaxf(xmax, __shfl_xor(xmax, o));
        const float qx = xmax > 0.f ? 256.0f / xmax : 1.0f, xinv = xmax > 0.f ? xmax * (1.0f / 256.0f) : 1.0f;
        {
            v4u w;
#pragma unroll
            for (int i = 0; i < 4; ++i) { unsigned tt = 0u; tt = __builtin_amdgcn_cvt_pk_fp8_f32(xv[i].x * qx, xv[i].y * qx, tt, false); tt = __builtin_amdgcn_cvt_pk_fp8_f32(xv[i].z * qx, xv[i].w * qx, tt, true); w[i] = tt; }
            *(LAS v4u*)(X8 + 16 * lane) = w;
        }
        LDS_WAIT(); asm volatile("" ::: "memory");
        v8i_g bx[8];
#pragma unroll
        for (int s8 = 0; s8 < 8; ++s8) { const v4u b0 = *(const LAS v4u*)(X8 + 128 * s8 + 16 * g4), b1 = *(const LAS v4u*)(X8 + 128 * s8 + 64 + 16 * g4);
            bx[s8] = (v8i_g){(int)b0.x, (int)b0.y, (int)b0.z, (int)b0.w, (int)b1.x, (int)b1.y, (int)b1.z, (int)b1.w}; }
        LDS_WAIT(); asm volatile("" ::: "memory");
#define UP_LOAD(buf, hq) do { const int sel_ = (hq) < 2 ? idx_lo : idx_hi; _Pragma("unroll") for (int k = 0; k < 32; ++k) buf[k] = row_load(UP, __builtin_amdgcn_readlane(sel_, ((hq) & 1) * 32 + k), lane); } while (0)
#define DN_LOAD(buf, hq) do { const int sel_ = (hq) < 2 ? idx_lo : idx_hi; _Pragma("unroll") for (int k = 0; k < 32; ++k) buf[k] = row_load(DN, __builtin_amdgcn_readlane(sel_, ((hq) & 1) * 32 + k), lane); } while (0)
        rowv da[32];
        {
            rowv ur[32];
            UP_LOAD(ur, 0);
#define UP_NEXT UP_LOAD(ur, hq + 1)
#pragma unroll 1
            for (int hq = 0; hq < 3; ++hq) {
                const int sel = hq < 2 ? idx_lo : idx_hi; const float gsel = hq < 2 ? g_lo : g_hi; const int lb0 = (hq & 1) * 32;
#pragma unroll
                for (int k = 0; k < 32; ++k) *(LAS v2u*)(RB + k * G_RS + 8 * lane) = ur[k];
                float sc[4];
#pragma unroll
                for (int hh_ = 0; hh_ < 2; ++hh_) { const int ek_ = __shfl(sel, lb0 + hh_ * 16 + 4 * g4 + (n16 & 3)); sc[2 * hh_] = SUP[ek_]; sc[2 * hh_ + 1] = SDN[ek_]; }
                LDS_WAIT(); asm volatile("" ::: "memory");
                UP_NEXT;
#pragma unroll
                for (int hh_ = 0; hh_ < 2; ++hh_) { const int lb = lb0 + hh_ * 16;
                    f32x4 c = (f32x4){0.f, 0.f, 0.f, 0.f};
#pragma unroll
                    for (int s8 = 0; s8 < 8; ++s8) { const v4u a4 = *(const LAS v4u*)(RB + (hh_ * 16 + n16) * G_RS + 64 * s8 + 16 * g4); const v8i_g a8 = (v8i_g){(int)a4.x, (int)a4.y, (int)a4.z, (int)a4.w, 0, 0, 0, 0};
                        c = __builtin_amdgcn_mfma_scale_f32_16x16x128_f8f6f4(a8, bx[s8], c, 4, 0, 0, 0x7f7f7f7f, 0, 0x7f7f7f7f); }
                    const int r_ = n16 & 3, k_ = 4 * g4 + r_;
                    const float my = r_ == 0 ? c[0] : (r_ == 1 ? c[1] : (r_ == 2 ? c[2] : c[3]));
                    const float gate = __shfl(gsel, lb + k_);
                    const float act = gelu_erf(my * sc[2 * hh_] * xinv) * gate * sc[2 * hh_ + 1];
                    if (n16 < 4) ACT[slot * 128 + hq * 32 + hh_ * 16 + k_] = act; }
                LDS_WAIT(); asm volatile("" ::: "memory");
            }
#undef UP_NEXT
#define UP_NEXT DN_LOAD(da, 0)
            { const int hq = 3;
                const int sel = hq < 2 ? idx_lo : idx_hi; const float gsel = hq < 2 ? g_lo : g_hi; const int lb0 = (hq & 1) * 32;
#pragma unroll
                for (int k = 0; k < 32; ++k) *(LAS v2u*)(RB + k * G_RS + 8 * lane) = ur[k];
                float sc[4];
#pragma unroll
                for (int hh_ = 0; hh_ < 2; ++hh_) { const int ek_ = __shfl(sel, lb0 + hh_ * 16 + 4 * g4 + (n16 & 3)); sc[2 * hh_] = SUP[ek_]; sc[2 * hh_ + 1] = SDN[ek_]; }
                LDS_WAIT(); asm volatile("" ::: "memory");
                UP_NEXT;
#pragma unroll
                for (int hh_ = 0; hh_ < 2; ++hh_) { const int lb = lb0 + hh_ * 16;
                    f32x4 c = (f32x4){0.f, 0.f, 0.f, 0.f};
#pragma unroll
                    for (int s8 = 0; s8 < 8; ++s8) { const v4u a4 = *(const LAS v4u*)(RB + (hh_ * 16 + n16) * G_RS + 64 * s8 + 16 * g4); const v8i_g a8 = (v8i_g){(int)a4.x, (int)a4.y, (int)a4.z, (int)a4.w, 0, 0, 0, 0};
                        c = __builtin_amdgcn_mfma_scale_f32_16x16x128_f8f6f4(a8, bx[s8], c, 4, 0, 0, 0x7f7f7f7f, 0, 0x7f7f7f7f); }
                    const int r_ = n16 & 3, k_ = 4 * g4 + r_;
                    const float my = r_ == 0 ? c[0] : (r_ == 1 ? c[1] : (r_ == 2 ? c[2] : c[3]));
                    const float gate = __shfl(gsel, lb + k_);
                    const float act = gelu_erf(my * sc[2 * hh_] * xinv) * gate * sc[2 * hh_ + 1];
                    if (n16 < 4) ACT[slot * 128 + hq * 32 + hh_ * 16 + k_] = act; }
                LDS_WAIT(); asm volatile("" ::: "memory");
            }
#undef UP_NEXT
        }
#undef UP_LOAD
        LDS_WAIT(); asm volatile("" ::: "memory");
        const float a_lo = ACT[slot * 128 + lane], a_hi = ACT[slot * 128 + 64 + lane];
        f32x2g out[8];
#pragma unroll
        for (int e = 0; e < 8; ++e) out[e] = (f32x2g){0.f, 0.f};
#define DN_STEP(buf, hq) do { const float asel = (hq) < 2 ? a_lo : a_hi; \
            _Pragma("unroll") for (int k = 0; k < 32; ++k) row_axpy(out, buf[k], __builtin_bit_cast(float, __builtin_amdgcn_readlane(__builtin_bit_cast(int, asel), ((hq) & 1) * 32 + k))); } while (0)
        {
            rowv db[32];
            DN_LOAD(db, 1); DN_STEP(da, 0);
            DN_LOAD(da, 2); DN_STEP(db, 1);
            DN_LOAD(db, 3); DN_STEP(da, 2);
            DN_STEP(db, 3);
        }
#undef DN_LOAD
#undef DN_STEP
        float ss2 = 0.f;
#pragma unroll
        for (int i = 0; i < 4; ++i) { hv[i].x += out[2 * i].x; hv[i].y += out[2 * i].y; hv[i].z += out[2 * i + 1].x; hv[i].w += out[2 * i + 1].y;
            ss2 += (hv[i].x * hv[i].x + hv[i].y * hv[i].y) + (hv[i].z * hv[i].z + hv[i].w * hv[i].w); }
        const float rstd2 = 1.0f / sqrtf(wave_sum(ss2) * (1.f / D) + RMS_EPS);
        f32x4 y[4];
#pragma unroll
        for (int i = 0; i < 4; ++i) y[i] = hv[i] * rstd2 * *(const f32x4*)(gnext + 16 * lane + 4 * i);
        if (layer < DEPTH - 1) {
#pragma unroll
            for (int i = 0; i < 4; ++i) *(f32x4*)(HW + (size_t)t * D + 16 * lane + 4 * i) = hv[i];
            bf16* hn = HN + (size_t)t * D + 16 * lane;
            v4u o0, o1; o0.x = pk2(y[0].x, y[0].y); o0.y = pk2(y[0].z, y[0].w); o0.z = pk2(y[1].x, y[1].y); o0.w = pk2(y[1].z, y[1].w);
            o1.x = pk2(y[2].x, y[2].y); o1.y = pk2(y[2].z, y[2].w); o1.z = pk2(y[3].x, y[3].y); o1.w = pk2(y[3].z, y[3].w);
            *(v4u*)hn = o0; *(v4u*)(hn + 8) = o1;
        } else {
            float* orow = outp + (size_t)t * D + 16 * lane;
#pragma unroll
            for (int i = 0; i < 4; ++i) *(f32x4*)(orow + 4 * i) = y[i];
        }
    }
    LDS_WAIT(); asm volatile("" ::: "memory");
    }
#undef TOK_LOAD
}

struct Args { const float* in[14]; float* out; unsigned char* ws; int ph_lo, ph_hi; };
__global__ void __launch_bounds__(NTHR, 2) mega_fwd(Args args) {
    extern __shared__ __attribute__((aligned(16))) unsigned char lds[];
    Frame F;
    F.lds = (LAS unsigned char*)lds;
    F.tid = threadIdx.x; F.lane = F.tid & 63; F.wave = __builtin_amdgcn_readfirstlane(F.tid >> 6);
    F.G = gridDim.x; { const int bx = blockIdx.x; F.vcu = (F.G % 8 == 0) ? (bx % 8) * (F.G / 8) + bx / 8 : bx; }
    F.ws = args.ws;
    volatile LAS unsigned* MISC = (volatile LAS unsigned*)(F.lds + MISC_OFF);
    if (F.tid < 64) MISC[F.tid] = 0u;
    if (F.tid < 15) { const unsigned long long p = F.tid < 14 ? (unsigned long long)args.in[F.tid] : (unsigned long long)args.out;
        volatile LAS unsigned* t = (volatile LAS unsigned*)(F.lds + PTAB_OFF); t[2 * F.tid] = (unsigned)p; t[2 * F.tid + 1] = (unsigned)(p >> 32); }
    __syncthreads();
    XcdBarrier bar; bar.bar = (unsigned*)(F.ws + WS_CTL) + CW_BAR; bar.x = 0; bar.st = nullptr;
    if (MK_N_LAUNCHES == 1) bar = xcd_barrier_post((unsigned*)(F.ws + WS_CTL) + CW_BAR, MISC + 8);

#pragma unroll 1
    for (int ph = args.ph_lo; ph < args.ph_hi; ++ph) {
        bool did = true;
        const int kind_ = ph == 0 ? 7 : (ph - 1) % PH_PER_LAYER; const int nrep = (PROBE_REP >= 0 && kind_ == PROBE_REP && (ph == 0 || ((PROBE_LMASK >> ((ph - 1) / PH_PER_LAYER)) & 1))) ? 2 : 1;
#pragma unroll 1
        for (int rep = 0; rep < nrep; ++rep) {
        const bool dry = (nrep == 2 && rep == 0);
        { int t_ = threadIdx.x; asm volatile("" : "+v"(t_)); F.tid = t_; F.lane = t_ & 63; F.wave = __builtin_amdgcn_readfirstlane(t_ >> 6);
          unsigned long long ws_ = (unsigned long long)args.ws; asm volatile("" : "+s"(ws_)); F.ws = (unsigned char*)(__attribute__((address_space(1))) unsigned char*)ws_; }
#ifndef DIS_PRO
        if (ph == 0) p0_prologue(F, dry);
#else
        if (ph == 0) {}
#endif
        else {
            const int layer = (ph - 1) / PH_PER_LAYER, k = (ph - 1) % PH_PER_LAYER, j = layer >> 1; const bool is_attn = (layer & 1) == 0;
            if (k == 0) {
                if (!is_attn) {
                    pg8::Gemm g{(const pg8::bf16_t*)(F.ws + WS_HN), (const pg8::bf16_t*)(F.ws + WS_WIN) + (size_t)j * 3072 * 1024, M, 3072, D};
                    pg8::StaticOrder S; S.init(g.M, g.N, F.G, (int)blockIdx.x);
                    EpiConvIn E{(bf16*)(F.ws + WS_BIG), (bf16*)(F.ws + WS_BIG + 32 * MiB)};
                    pg8::gemm_phase<EpiConvIn, pg8::StaticOrder, true, true>(F.lds, g, S, E);
                }
                const int ng = is_attn ? 2 : 0;
#pragma unroll 1
                for (int gi = 0; gi < ng; ++gi) {
                    pg8::Gemm g; pg8::EpiBf16<0> E; E.bias = nullptr; E.split_cols = 0; E.split_stride = 0; E.scale0 = 1.f;
                    if (is_attn && gi == 0) { g = pg8::Gemm{(const pg8::bf16_t*)(F.ws + WS_HN), (const pg8::bf16_t*)(F.ws + WS_WQK) + (size_t)j * 2048 * 1024, M, 2048, D}; E.O = (pg8::bf16_t*)(F.ws + WS_BIG); E.ldc = 2048; }
                    else if (is_attn) { g = pg8::Gemm{(const pg8::bf16_t*)(F.ws + WS_WV) + (size_t)j * 1024 * 1024, (const pg8::bf16_t*)(F.ws + WS_HN), D, M, D}; E.O = (pg8::bf16_t*)(F.ws + WS_VT); E.ldc = M; }
                    else { g = pg8::Gemm{(const pg8::bf16_t*)(F.ws + WS_HN), (const pg8::bf16_t*)(F.ws + WS_WIN) + (size_t)j * 3072 * 1024, M, 3072, D}; E.O = (pg8::bf16_t*)(F.ws + WS_BIG); E.ldc = 3072; }
                    pg8::StaticOrder S; S.init(g.M, g.N, F.G, (int)blockIdx.x);
                    pg8::gemm_phase<pg8::EpiBf16<0>, pg8::StaticOrder, true, true>(F.lds, g, S, E);
                }
            } else if (k == 1) {
                if (is_attn) {
#if NAIVE_ATTN
                    attn_naive_phase(F, j);
#elif !defined(DIS_ATTN)
                    attn_phase(F, j);
#endif
                } else {
#ifndef DIS_CONV
                    conv_phase(F, j);
#endif
                }
            } else if (k == 2) {
                pg8::Gemm g{(const pg8::bf16_t*)(F.ws + WS_MIX), (const pg8::bf16_t*)(F.ws + (is_attn ? WS_WO : WS_WOUT)) + (size_t)j * 1024 * 1024, M, D, D};
                pg8::StaticOrder S; S.init(M, D, F.G, (int)blockIdx.x);
                EpiRes E{layer == 0 ? F.in(0) : (const float*)(F.ws + WS_H), (float*)(F.ws + (dry ? WS_SC : WS_H)), (bf16*)(F.ws + (dry ? WS_SC + 64 * MiB : WS_HN)), F.in(2) + (size_t)layer * D, (float*)(F.ws + (dry ? WS_SC + 96 * MiB : WS_RSS))};
                pg8::gemm_phase<EpiRes, pg8::StaticOrder, false, true>(F.lds, g, S, E);
            } else if (k == 3) {
                did = false;
            } else if (k == 4) {
                pg8::Gemm g{(const pg8::bf16_t*)(F.ws + WS_HN), (const pg8::bf16_t*)(F.ws + WS_WP) + (size_t)layer * 2048 * 1024, M, 2048, D};
                pg8::StaticOrder S; S.init(M, 2048, F.G, (int)blockIdx.x);
#if NAIVE_TOPK
                EpiF32 E{(float*)(F.ws + WS_SC), 2048};
                pg8::gemm_phase<EpiF32, pg8::StaticOrder, true, true>(F.lds, g, S, E);
#else
#ifndef DIS_TOPK
                EpiTopK E{(int*)(F.ws + WS_SELI), (float*)(F.ws + WS_SELG), (const float*)(F.ws + WS_RSS)};
#pragma unroll 1
                for (int i = 0;; ++i) { OneUnit O1; if (!S.next(i, O1.u)) break; pg8::gemm_phase<EpiTopK, OneUnit, false, true>(F.lds, g, O1, E); }
#endif
#endif
            } else if (k == 5) {
#if NAIVE_TOPK
                select_naive_phase(F);
#else
                did = false;
#endif
            } else {
#ifndef DIS_GATHER
                gather_phase(F, layer, dry);
#endif
            }
        }
        if (MK_N_LAUNCHES == 1 && dry) xcd_barrier(bar);
        }
        if (MK_N_LAUNCHES == 1 && did && ph + 1 < args.ph_hi) { xcd_barrier(bar);
#ifdef PROBE_BAR2
            xcd_barrier(bar);
#endif
        }
    }
}

extern "C" void kernel_launch(void* const* d_in, const int* in_sizes, int n_in, void* d_out, int out_size, void* d_ws, size_t ws_size, hipStream_t stream) {
    static int grid = 0;
    if (grid == 0) {
        if (n_in != 14 || out_size != M * D || ws_size < WS_END) { fprintf(stderr, "kernel_launch: unexpected shapes (n_in %d, out %d, ws %zu); nothing launched\n", n_in, out_size, ws_size); grid = -1; return; }
        int dev = 0, cus = 0, per_cu = 0;
        if (hipGetDevice(&dev) != hipSuccess || hipDeviceGetAttribute(&cus, hipDeviceAttributeMultiprocessorCount, dev) != hipSuccess) { grid = -1; return; }
        if (hipFuncSetAttribute((const void*)mega_fwd, hipFuncAttributeMaxDynamicSharedMemorySize, LDS_BYTES) != hipSuccess) { fprintf(stderr, "kernel_launch: hipFuncSetAttribute failed\n"); grid = -1; return; }
        if (hipOccupancyMaxActiveBlocksPerMultiprocessor(&per_cu, (const void*)mega_fwd, NTHR, LDS_BYTES) != hipSuccess || per_cu < 1) fprintf(stderr, "kernel_launch: note: occupancy query reports %d\n", per_cu);
        (void)hipGetLastError();
        grid = cus;
    }
    if (grid < 0) return;
    if (hipMemsetAsync((char*)d_ws + WS_CTL, 0, CTL_ZERO_BYTES, stream) != hipSuccess) return;
    Args a{};
    for (int i = 0; i < 14; ++i) a.in[i] = (const float*)d_in[i];
    a.out = (float*)d_out; a.ws = (unsigned char*)d_ws;
    if (MK_N_LAUNCHES == 1) { a.ph_lo = 0; a.ph_hi = N_PHASES; hipLaunchKernelGGL(mega_fwd, dim3(grid), dim3(NTHR), LDS_BYTES, stream, a); }
    else for (int ph = 0; ph < N_PHASES; ++ph) {
        if (ph > 0 && ((ph - 1) % PH_PER_LAYER == 3 || (!NAIVE_TOPK && (ph - 1) % PH_PER_LAYER == 5))) continue;
        a.ph_lo = ph; a.ph_hi = ph + 1; hipLaunchKernelGGL(mega_fwd, dim3(grid), dim3(NTHR), LDS_BYTES, stream, a);
    }
}
```

```cpp
#include <hip/hip_runtime.h>
#include <cstdio>
#include <cstdint>
namespace pg8 {
#define PG8_LAS __attribute__((address_space(3)))
typedef unsigned short bf16_t;
typedef short bf16x8 __attribute__((ext_vector_type(8)));
typedef float f32x4 __attribute__((ext_vector_type(4)));
typedef unsigned u32x4 __attribute__((ext_vector_type(4)));
constexpr int BM = 256, BK = 64, HALF = 128, HTB = HALF * BK * 2  , STAGE_BYTES = 8 * HTB, NXCD = 8, WGM = 8;

__host__ __device__ __forceinline__ int lds_byte(int r, int c) { const int st = (r >> 4) * 2 + (c >> 5), rr = r & 15, cc = c & 31, ob = rr * 64 + cc * 2; return st * 1024 + (ob ^ (((ob >> 9) & 1) << 5)); }
__host__ __device__ __forceinline__ void stage_rc(int b, int& R, int& C) { const int st = b / 1024, sb = b % 1024, swz = sb ^ (((sb >> 9) & 1) << 5); R = (st >> 1) * 16 + swz / 64; C = (st & 1) * 32 + (swz % 64) / 2; }
__host__ __device__ __forceinline__ int perm32(int rho) { const int n = rho >> 4, i = rho & 15; return 8 * (i >> 2) + 4 * n + (i & 3); }

struct Unit { int pm, pn; };
struct Gemm { const bf16_t* A; const bf16_t* Bt; int M, N, K; };

struct StaticOrder {
    int nM, nN, nwg, G, c;
    __host__ __device__ void init(int M, int N, int G_, int c_) { nM = M / BM; nN = N / BM; nwg = nM * nN; G = G_; c = c_; }
    __host__ __device__ bool next(int i, Unit& u) const {
        const long L = (long)i * G + c; if (L >= nwg) return false;
        int wgid = (int)L; { const int q = nwg / NXCD, r = nwg % NXCD, xcd = wgid % NXCD, off = wgid / NXCD; wgid = (xcd < r ? xcd * (q + 1) : r * (q + 1) + (xcd - r) * q) + off; }
        const int nig = WGM * nN, gid = wgid / nig, fm = gid * WGM, gsz = (nM - fm) < WGM ? (nM - fm) : WGM;
        u.pm = fm + ((wgid % nig) % gsz); u.pn = (wgid % nig) / gsz; return true;
    }
    __device__ __forceinline__ void a_ready(const Unit&) const {}
    __device__ __forceinline__ void done(const Unit&) const {}
};

__device__ __forceinline__ unsigned cvt_pk_bf16(float lo, float hi) { unsigned r; asm volatile("v_cvt_pk_bf16_f32 %0, %1, %2" : "=v"(r) : "v"(lo), "v"(hi)); return r; }
typedef float f32x2 __attribute__((ext_vector_type(2)));
__device__ __forceinline__ f32x2 gelu_pk(f32x2 v) {
    const f32x2 av = __builtin_elementwise_abs(v), d = av * 0.2316418882f + 1.0f;
    f32x2 t; t.x = __builtin_amdgcn_rcpf(d.x); t.y = __builtin_amdgcn_rcpf(d.y);
    f32x2 q = t * 0.5307027145f + (-0.7265760135f); q = q * t + 0.7107068705f; q = q * t + (-0.142248368f); q = q * t + 0.127414796f; q = q * t;
    const f32x2 s = (v * v) * (-0.72134752044f);
    f32x2 e; e.x = __builtin_amdgcn_exp2f(s.x); e.y = __builtin_amdgcn_exp2f(s.y);
    const f32x2 m = v * (q * e), r = v - m;
    f32x2 o; o.x = v.x < 0.f ? m.x : r.x; o.y = v.y < 0.f ? m.y : r.y; return o;
}

template <int ACT  > struct EpiBf16 {
    static constexpr bool PERM = true, AFTER_DRAIN = false; static_assert(ACT == 0 || ACT == 1, "EpiBf16: ACT is 0 (none) or 1 (gelu_pk)");
    bf16_t* O; int ldc; const float* bias; int split_cols; size_t split_stride; float scale0;
    __device__ __forceinline__ void operator()(const f32x4 (&acc)[2][2][4][2], const Unit& u, int wr, int wc, int fr, int fq) const {
        const int row0 = u.pm * BM + wr * 64 + fr; int colt = u.pn * BM; bf16_t* base = O;
        float sc = 1.f; if (split_cols) { const int t = colt / split_cols; base += (size_t)t * split_stride; colt -= t * split_cols; if (t == 0) sc = scale0; }
        const int col0 = colt + wc * 32 + 8 * fq, bcol0 = u.pn * BM + wc * 32 + 8 * fq;
        f32x4 bv[2][2];
#pragma unroll
        for (int bj = 0; bj < 2; ++bj)
#pragma unroll
            for (int n = 0; n < 2; ++n) bv[bj][n] = bias ? *(const f32x4*)(bias + bcol0 + bj * HALF + 4 * n) : (f32x4){0.f, 0.f, 0.f, 0.f};
#pragma unroll
        for (int ai = 0; ai < 2; ++ai)
#pragma unroll
            for (int m = 0; m < 4; ++m) { bf16_t* rowp = base + (size_t)(row0 + ai * HALF + m * 16) * ldc + col0;
#pragma unroll
                for (int bj = 0; bj < 2; ++bj) { f32x4 v0 = acc[ai][bj][m][0] + bv[bj][0], v1 = acc[ai][bj][m][1] + bv[bj][1];
                    if (ACT == 1) { f32x2 a = gelu_pk((f32x2){v0[0], v0[1]}), b = gelu_pk((f32x2){v0[2], v0[3]}), c = gelu_pk((f32x2){v1[0], v1[1]}), d = gelu_pk((f32x2){v1[2], v1[3]});
                        v0 = (f32x4){a.x, a.y, b.x, b.y}; v1 = (f32x4){c.x, c.y, d.x, d.y}; }
                    v0 = v0 * sc; v1 = v1 * sc; u32x4 w; w.x = cvt_pk_bf16(v0[0], v0[1]); w.y = cvt_pk_bf16(v0[2], v0[3]); w.z = cvt_pk_bf16(v1[0], v1[1]); w.w = cvt_pk_bf16(v1[2], v1[3]);
                    *(u32x4*)(rowp + bj * HALF) = w; } }
    }
};

template <class Epi, class Sched, bool ALIGN_EPI = false, bool SP2 = false>
__device__ __forceinline__ void gemm_phase(PG8_LAS unsigned char* lds, const Gemm g, const Sched& S, const Epi& E) {
    int tid_l = threadIdx.x; asm volatile("" : "+v"(tid_l));
    const int tid = tid_l, wid = __builtin_amdgcn_readfirstlane(tid >> 6), lane = tid & 63, wr = wid >> 2, wc = wid & 3, fr = lane & 15, fq = lane >> 4;
    const int K = g.K, nt = K / BK;
    unsigned voffA[2], voffB[2];
#pragma unroll
    for (int i = 0; i < 2; ++i) { int R, C; stage_rc(tid * 16 + i * 8192, R, C); const int Rb = Epi::PERM ? ((R & ~31) + perm32(R & 31)) : R;
        voffA[i] = (unsigned)(R * K + C) * 2u; voffB[i] = (unsigned)(Rb * K + C) * 2u; }
    const size_t kstep = (size_t)(BK * 2);
    const size_t hstep = (size_t)HALF * K * 2;
    const size_t tstep = 2 * hstep;
    const unsigned ldsw = (unsigned)wid * 1024u;
    const int aoff = lds_byte(wr * 64 + fr, fq * 8), boff = lds_byte(wc * 32 + fr, fq * 8);
#define PG8_SA(b, h) (((b) * 2 + (h)) * HTB)
#define PG8_SB(b, h) ((4 + (b) * 2 + (h)) * HTB)
#define PG8_STAGE(bufoff, gbase, voff) do { _Pragma("unroll") for (int _i = 0; _i < 2; ++_i) \
        __builtin_amdgcn_global_load_lds((const unsigned*)((const char*)(gbase) + (voff)[_i]), (PG8_LAS unsigned*)(lds + (bufoff) + ldsw + _i * 8192), 16, 0, 0); } while (0)
#define PG8_LDA(dst, b, h) do { _Pragma("unroll") for (int m = 0; m < 4; ++m) _Pragma("unroll") for (int k = 0; k < 2; ++k) dst[m][k] = *(const PG8_LAS bf16x8*)(lds + PG8_SA(b, h) + aoff + m * 2048 + k * 1024); } while (0)
#define PG8_LDB(dst, b, h) do { _Pragma("unroll") for (int n = 0; n < 2; ++n) _Pragma("unroll") for (int k = 0; k < 2; ++k) dst[n][k] = *(const PG8_LAS bf16x8*)(lds + PG8_SB(b, h) + boff + n * 2048 + k * 1024); } while (0)
#define PG8_MMA(ai, bj, At, Bt) do { __builtin_amdgcn_s_setprio(1); _Pragma("unroll") for (int m = 0; m < 4; ++m) _Pragma("unroll") for (int n = 0; n < 2; ++n) _Pragma("unroll") for (int k = 0; k < 2; ++k) \
        acc[ai][bj][m][n] = __builtin_amdgcn_mfma_f32_16x16x32_bf16(Bt[n][k], At[m][k], acc[ai][bj][m][n], 0, 0, 0); __builtin_amdgcn_s_setprio(0); } while (0)
#define PG8_WAIT_V(n) asm volatile("s_waitcnt vmcnt(" #n ")" ::: "memory")
#define PG8_WAIT_L(n) asm volatile("s_waitcnt lgkmcnt(" #n ")" ::: "memory")
#define PG8_BAR __builtin_amdgcn_s_barrier()
#define PG8_SCHED __builtin_amdgcn_sched_barrier(0)
    Unit cur, nxt; int ui = 0;
    if (!S.next(0, cur)) return;
    f32x4 acc[2][2][4][2];
#pragma unroll
    for (int a = 0; a < 2; ++a)
#pragma unroll
        for (int b = 0; b < 2; ++b)
#pragma unroll
            for (int m = 0; m < 4; ++m)
#pragma unroll
                for (int n = 0; n < 2; ++n) acc[a][b][m][n] = (f32x4){0.f, 0.f, 0.f, 0.f};
    bf16x8 At[4][2], B0[2][2], B1[2][2];
    const char* cA = (const char*)g.A + (size_t)cur.pm * tstep; const char* cB = (const char*)g.Bt + (size_t)cur.pn * tstep;
    S.a_ready(cur);
    if constexpr (SP2) {
        PG8_STAGE(PG8_SB(0, 0), cB, voffB); PG8_STAGE(PG8_SB(0, 1), cB + hstep, voffB); PG8_STAGE(PG8_SA(0, 0), cA, voffA); PG8_STAGE(PG8_SA(0, 1), cA + hstep, voffA);
        if (wr == 1) PG8_BAR;
        PG8_WAIT_V(2); PG8_BAR;
        PG8_STAGE(PG8_SB(1, 0), cB + kstep, voffB); PG8_STAGE(PG8_SA(1, 0), cA + kstep, voffA); PG8_STAGE(PG8_SB(1, 1), cB + hstep + kstep, voffB);
        PG8_WAIT_V(6); PG8_BAR;
    } else {
        PG8_STAGE(PG8_SB(0, 0), cB, voffB); PG8_STAGE(PG8_SA(0, 0), cA, voffA); PG8_STAGE(PG8_SB(0, 1), cB + hstep, voffB); PG8_STAGE(PG8_SA(0, 1), cA + hstep, voffA);
        if (wr == 1) PG8_BAR;
        PG8_WAIT_V(4); PG8_BAR;
        PG8_STAGE(PG8_SB(1, 0), cB + kstep, voffB); PG8_STAGE(PG8_SA(1, 0), cA + kstep, voffA); PG8_STAGE(PG8_SB(1, 1), cB + hstep + kstep, voffB);
        PG8_WAIT_V(6); PG8_BAR;
    }
    for (;;) {
        const bool has_next = S.next(ui + 1, nxt);
        const char* nA = has_next ? (const char*)g.A + (size_t)nxt.pm * tstep : cA; const char* nB = has_next ? (const char*)g.Bt + (size_t)nxt.pn * tstep : cB;
        for (int t = 0; t < nt; t += 2) {
            const bool last = (t == nt - 2);
            const char* a1 = cA + (size_t)(t + 1) * kstep;
            const char* a2 = last ? nA : cA + (size_t)(t + 2) * kstep; const char* b2 = last ? nB : cB + (size_t)(t + 2) * kstep;
            const char* a3 = a2 + kstep; const char* b3 = b2 + kstep;
            if (last && has_next) S.a_ready(nxt);
            if constexpr (SP2) {
            PG8_LDB(B0, 0, 0); PG8_LDB(B1, 0, 1); PG8_SCHED; PG8_LDA(At, 0, 0); PG8_STAGE(PG8_SA(1, 1), a1 + hstep, voffA);
            PG8_WAIT_V(8); PG8_WAIT_L(0); PG8_BAR; PG8_MMA(0, 0, At, B0); PG8_MMA(0, 1, At, B1); PG8_BAR; PG8_SCHED;
            PG8_LDA(At, 0, 1); PG8_STAGE(PG8_SB(0, 0), b2, voffB); PG8_STAGE(PG8_SB(0, 1), b2 + hstep, voffB); PG8_STAGE(PG8_SA(0, 0), a2, voffA);
            PG8_WAIT_V(8); PG8_WAIT_L(0); PG8_BAR; PG8_MMA(1, 0, At, B0); PG8_MMA(1, 1, At, B1); PG8_BAR; PG8_SCHED;
            PG8_LDB(B0, 1, 0); PG8_LDB(B1, 1, 1); PG8_SCHED; PG8_LDA(At, 1, 0); PG8_STAGE(PG8_SA(0, 1), a2 + hstep, voffA);
            PG8_WAIT_V(8); PG8_WAIT_L(0); PG8_BAR; PG8_MMA(0, 0, At, B0); PG8_MMA(0, 1, At, B1); PG8_BAR; PG8_SCHED;
            PG8_LDA(At, 1, 1); PG8_STAGE(PG8_SB(1, 0), b3, voffB); PG8_STAGE(PG8_SB(1, 1), b3 + hstep, voffB); PG8_STAGE(PG8_SA(1, 0), a3, voffA);
            PG8_WAIT_V(8); PG8_WAIT_L(0); PG8_BAR; PG8_MMA(1, 0, At, B0); PG8_MMA(1, 1, At, B1); PG8_BAR; PG8_SCHED;
            } else {
            PG8_LDB(B0, 0, 0); PG8_SCHED; PG8_LDA(At, 0, 0); PG8_STAGE(PG8_SA(1, 1), a1 + hstep, voffA);
            PG8_WAIT_L(8); PG8_BAR; PG8_WAIT_L(0); PG8_MMA(0, 0, At, B0); PG8_BAR; PG8_SCHED;
            PG8_LDB(B1, 0, 1); PG8_STAGE(PG8_SB(0, 0), b2, voffB);
            PG8_BAR; PG8_WAIT_L(0); PG8_MMA(0, 1, At, B1); PG8_BAR;
            PG8_LDA(At, 0, 1); PG8_STAGE(PG8_SA(0, 0), a2, voffA);
            PG8_BAR; PG8_WAIT_L(0); PG8_MMA(1, 0, At, B0); PG8_BAR; PG8_SCHED;
            PG8_STAGE(PG8_SB(0, 1), b2 + hstep, voffB);
            PG8_WAIT_V(6); PG8_BAR; PG8_MMA(1, 1, At, B1); PG8_BAR;
            PG8_LDB(B0, 1, 0); PG8_SCHED; PG8_LDA(At, 1, 0); PG8_STAGE(PG8_SA(0, 1), a2 + hstep, voffA);
            PG8_WAIT_L(8); PG8_BAR; PG8_WAIT_L(0); PG8_MMA(0, 0, At, B0); PG8_BAR; PG8_SCHED;
            PG8_LDB(B1, 1, 1); PG8_STAGE(PG8_SB(1, 0), b3, voffB);
            PG8_BAR; PG8_WAIT_L(0); PG8_MMA(0, 1, At, B1); PG8_BAR;
            PG8_LDA(At, 1, 1); PG8_STAGE(PG8_SA(1, 0), a3, voffA);
            PG8_BAR; PG8_WAIT_L(0); PG8_MMA(1, 0, At, B0); PG8_BAR; PG8_SCHED;
            PG8_STAGE(PG8_SB(1, 1), b3 + hstep, voffB);
            PG8_WAIT_V(6); PG8_BAR; PG8_MMA(1, 1, At, B1); PG8_BAR;
            }
        }
        if constexpr (ALIGN_EPI) { if (wr == 0) PG8_BAR; }
        if constexpr (!Epi::AFTER_DRAIN) { E(acc, cur, wr, wc, fr, fq); S.done(cur); }
        if (!has_next) break;
#pragma unroll
        for (int a = 0; a < 2; ++a)
#pragma unroll
            for (int b = 0; b < 2; ++b)
#pragma unroll
                for (int m = 0; m < 4; ++m)
#pragma unroll
                    for (int n = 0; n < 2; ++n) acc[a][b][m][n] = (f32x4){0.f, 0.f, 0.f, 0.f};
        cur = nxt; cA = nA; cB = nB; ++ui;
        if constexpr (ALIGN_EPI) { if (wr == 1) PG8_BAR; }
    }
    PG8_WAIT_V(0);
    if constexpr (!ALIGN_EPI) { if (wr == 0) PG8_BAR; }
    PG8_BAR;
    if constexpr (Epi::AFTER_DRAIN) { E.fused(acc, cur, wr, wc, fr, fq, lds, wid, lane); S.done(cur); }
#undef PG8_SA
#undef PG8_SB
#undef PG8_STAGE
#undef PG8_LDA
#undef PG8_LDB
#undef PG8_MMA
#undef PG8_WAIT_V
#undef PG8_WAIT_L
#undef PG8_BAR
#undef PG8_SCHED
}
}
#ifndef HD
#define HD __host__ __device__ __forceinline__
#endif
HD int tk_map(float f) { int b = __builtin_bit_cast(int, f); return b ^ ((b >> 31) & 0x7fffffff); }
HD float tk_unmap(int k) { int b = k ^ ((k >> 31) & 0x7fffffff); return __builtin_bit_cast(float, b); }
HD void tk_cx(int& a, int& b) { const int hi = a > b ? a : b, lo = a > b ? b : a; a = hi; b = lo; }
template <int N> HD void tk_sort_desc(int (&v)[N]) {
#pragma unroll
    for (int k = 2; k <= N; k <<= 1)
#pragma unroll
        for (int j = k >> 1; j > 0; j >>= 1)
#pragma unroll
            for (int i = 0; i < N; ++i) { const int l = i ^ j; if (l > i) { if ((i & k) == 0) tk_cx(v[i], v[l]); else tk_cx(v[l], v[i]); } }
}
template <int N> HD void tk_merge_top(int (&a)[N], const int (&b)[N]) {
#pragma unroll
    for (int i = 0; i < N; ++i) a[i] = a[i] > b[N - 1 - i] ? a[i] : b[N - 1 - i];
#pragma unroll
    for (int j = N >> 1; j > 0; j >>= 1)
#pragma unroll
        for (int i = 0; i < N; ++i) { const int l = i ^ j; if (l > i) tk_cx(a[i], a[l]); }
}
template <int NCH, class FP> HD void tk_stage1(FP s, int n_base, int (&best)[16]) {
#pragma unroll
    for (int c = 0; c < NCH; ++c) {
        int x[16];
#pragma unroll
        for (int e = 0; e < 16; ++e) x[e] = (tk_map(s[c * 16 + e]) & ~127) | (127 - (n_base + c * 16 + e));
        tk_sort_desc(x);
        if (c == 0) {
#pragma unroll
            for (int e = 0; e < 16; ++e) best[e] = x[e];
        } else tk_merge_top(best, x);
    }
}
template <class IP, class OI, class OG> HD void tk_stage2(int (&a)[16], int (&b)[16], IP AB, OI out_idx, OG out_g, float vscale = 1.0f) {
    float va[16], vb[16];
#pragma unroll
    for (int i = 0; i < 16; ++i) { AB[i] = a[i]; AB[16 + i] = b[i]; va[i] = tk_unmap(a[i] & ~127); vb[i] = tk_unmap(b[i] & ~127); }
    int best[16];
#pragma unroll
    for (int c = 0; c < 4; ++c) {
        int x[16];
#pragma unroll
        for (int e = 0; e < 16; ++e) x[e] = (int)0x80000000;
        int n = 0;
#pragma unroll
        for (int i = 0; i < 16; ++i)
#pragma unroll
            for (int j = 0; j < 16; ++j)
                if ((i + 1) * (j + 1) <= 16) { if (n >= 16 * c && n < 16 * c + 16) x[n - 16 * c] = (tk_map(va[i] + vb[j]) & ~255) | (255 - (i * 16 + j)); ++n; }
        tk_sort_desc(x);
        if (c == 0) {
#pragma unroll
            for (int e = 0; e < 16; ++e) best[e] = x[e];
        } else tk_merge_top(best, x);
    }
    int ka[16], kb[16];
#pragma unroll
    for (int k = 0; k < 16; ++k) { const int flat = 255 - (best[k] & 255); ka[k] = AB[flat >> 4]; kb[k] = AB[16 + (flat & 15)]; }
    float sv[16]; int ei[16]; float sum = 0.f;
#pragma unroll
    for (int k = 0; k < 16; ++k) { ei[k] = (127 - (ka[k] & 127)) * 128 + (127 - (kb[k] & 127)); sv[k] = (tk_unmap(ka[k] & ~127) + tk_unmap(kb[k] & ~127)) * vscale; }
    const float m = sv[0];
#pragma unroll
    for (int k = 0; k < 16; ++k) { sv[k] = __expf(sv[k] - m); sum += sv[k]; }
    const float inv = 1.0f / sum;
#pragma unroll
    for (int k = 0; k < 16; ++k) { out_idx[k] = ei[k]; out_g[k] = sv[k] * inv; }
}
constexpr int NWAVES = 8, NTHR = 512;
constexpr int BATCH = 2, SEQ = 8192, D = 1024, M = BATCH * SEQ, DEPTH = 4;
constexpr int NH = 16, HDIM = 64, GRIDW = 64, NROWS = 128;
constexpr float RMS_EPS = 1e-6f;
#ifndef MK_N_LAUNCHES
#define MK_N_LAUNCHES 1
#endif
#ifndef NAIVE_ATTN
#define NAIVE_ATTN 0
#endif
#ifndef NAIVE_TOPK
#define NAIVE_TOPK 0
#endif
#ifndef EXPERT_FP4
#define EXPERT_FP4 1
#endif
constexpr int ROWB = EXPERT_FP4 ? 512 : 1024;
#ifndef PROBE_GMODE
#define PROBE_GMODE 0
#endif
#ifndef PROBE_PMODE
#define PROBE_PMODE 0
#endif
#ifndef PROBE_LMASK
#define PROBE_LMASK 15
#endif
#ifndef PROBE_REP
#define PROBE_REP -1
#endif
constexpr int PH_PER_LAYER = 7, N_PHASES = 1 + DEPTH * PH_PER_LAYER;

constexpr size_t MiB = 1u << 20;
constexpr size_t WS_CTL = 0, CTL_ZERO_BYTES = 32 * 1024;
constexpr size_t WS_WQK = 2 * MiB;
constexpr size_t WS_WV = 10 * MiB;
constexpr size_t WS_WO = 14 * MiB;
constexpr size_t WS_WIN = 18 * MiB;
constexpr size_t WS_WOUT = 30 * MiB;
constexpr size_t WS_WP = 34 * MiB;
constexpr size_t WS_H = 64 * MiB;
constexpr size_t WS_HN = 128 * MiB;
constexpr size_t WS_BIG = 160 * MiB;
constexpr size_t WS_VT = 224 * MiB;
constexpr size_t WS_MIX = 256 * MiB;
constexpr size_t WS_SELI = 288 * MiB;
constexpr size_t WS_SELG = 296 * MiB;
constexpr size_t WS_UP = 320 * MiB;
constexpr size_t WS_DN = 384 * MiB;
constexpr size_t WS_SUP = 448 * MiB;
constexpr size_t WS_SDN = 449 * MiB;
constexpr size_t WS_RSS = 450 * MiB;
constexpr size_t WS_SC = 576 * MiB;
constexpr size_t WS_END = 704 * MiB;
constexpr int CW_BAR = 4096;
static_assert((CW_BAR + 3456) * 4 <= (int)CTL_ZERO_BYTES, "barrier words inside the per-call memset");

constexpr int LDS_BYTES = 163840, MISC_OFF = LDS_BYTES - 256, PTAB_OFF = LDS_BYTES - 512;

#define LAS __attribute__((address_space(3)))
typedef unsigned short bf16;
typedef unsigned v4u __attribute__((ext_vector_type(4)));
typedef unsigned v2u __attribute__((ext_vector_type(2)));
typedef float f32x4 __attribute__((ext_vector_type(4)));
typedef short bf16x8 __attribute__((ext_vector_type(8)));
#define LDS_WAIT() asm volatile("s_waitcnt lgkmcnt(0)" ::: "memory")
#define BLOCK_BAR() do { asm volatile("s_waitcnt vmcnt(0) lgkmcnt(0)" ::: "memory"); __builtin_amdgcn_s_barrier(); asm volatile("" ::: "memory"); } while (0)
__device__ __forceinline__ unsigned f2bf(float f) { unsigned u = __builtin_bit_cast(unsigned, f); return (u + 0x7fffu + ((u >> 16) & 1u)) >> 16; }
typedef float f32x2p __attribute__((ext_vector_type(2))); typedef __bf16 bf16x2p __attribute__((ext_vector_type(2)));
__device__ __forceinline__ unsigned pk2(float lo, float hi) { const f32x2p v = {lo, hi}; return __builtin_bit_cast(unsigned, __builtin_convertvector(v, bf16x2p)); }
__device__ __forceinline__ float bflo(unsigned u) { return __builtin_bit_cast(float, u << 16); }
__device__ __forceinline__ float bfhi(unsigned u) { return __builtin_bit_cast(float, u & 0xffff0000u); }
__device__ __forceinline__ float wave_sum(float v) {
#pragma unroll
    for (int o = 1; o < 64; o <<= 1) v += __shfl_xor(v, o);
    return v;
}

#define XB_TMO      128
#define XB_XCNT(j)  (256  + 64 * (j))
#define XB_XSUB(j)  (1280 + 64 * (j))
#define XB_XGEN(j)  (2304 + 64 * (j))
#define XB_TOP      3328
#define XB_TOPGEN   3392
#define XCD_BAR_WORDS 3456
#define XB_SPIN_CAP (1u << 20)
__device__ __forceinline__ unsigned xb_ld(unsigned* p)              { return __hip_atomic_load(p, __ATOMIC_RELAXED, __HIP_MEMORY_SCOPE_AGENT); }
__device__ __forceinline__ unsigned xb_add(unsigned* p, unsigned v) { return __hip_atomic_fetch_add(p, v, __ATOMIC_RELAXED, __HIP_MEMORY_SCOPE_AGENT); }
__device__ __forceinline__ unsigned xb_xcc_id() { return (unsigned)__builtin_amdgcn_s_getreg((3 << 11) | 20) & 0xFu; }
#define XB_SPIN(cond, bar) do { unsigned _sp = 0; while (cond) { __builtin_amdgcn_s_sleep(1); \
    if ((++_sp & 255u) == 0u) { if (xb_ld(&(bar)[XB_TMO])) break; if (_sp > XB_SPIN_CAP) { atomicAdd(&(bar)[XB_TMO], 1u); break; } } } } while (0)
struct XcdBarrier { unsigned* bar; unsigned x; volatile LAS unsigned* st; };
__device__ __forceinline__ XcdBarrier xcd_barrier_post(unsigned* bar, volatile LAS unsigned* st) {
    XcdBarrier b; b.bar = bar; b.x = xb_xcc_id(); b.st = st;
    if (threadIdx.x == 0) (void)xb_add(&bar[XB_XCNT(b.x)], 1u);
    return b;
}
__device__ __forceinline__ void xcd_barrier_complete(unsigned* bar, unsigned x, unsigned& nloc, unsigned& nx) {
    const unsigned G = gridDim.x * gridDim.y * gridDim.z;
    unsigned sum, cnt, mine, sp = 0u;
    for (;;) {
        sum = 0u; cnt = 0u; mine = 0u;
#pragma unroll
        for (unsigned j = 0; j < 16; ++j) { const unsigned c = xb_ld(&bar[XB_XCNT(j)]); sum += c; cnt += (c > 0u) ? 1u : 0u; mine = (j == x) ? c : mine; }
        if (sum == G) break;
        __builtin_amdgcn_s_sleep(1);
        if ((++sp & 255u) == 0u) { if (xb_ld(&bar[XB_TMO])) break; if (sp > XB_SPIN_CAP) { atomicAdd(&bar[XB_TMO], 1u); break; } }
    }
    nloc = mine > 0u ? mine : 1u; nx = cnt > 0u ? cnt : 1u;
}
__device__ __forceinline__ void xcd_barrier(const XcdBarrier& b) {
    asm volatile("s_waitcnt vmcnt(0)" ::: "memory");
    __syncthreads();
    if (threadIdx.x == 0) {
        unsigned* bar = b.bar;
        __builtin_amdgcn_s_waitcnt(0);
        unsigned nloc = b.st[0], nx = b.st[1];
        if (nloc == 0u) { xcd_barrier_complete(bar, b.x, nloc, nx); b.st[0] = nloc; b.st[1] = nx; }
        const unsigned old = xb_add(&bar[XB_XSUB(b.x)], 1u);
        const unsigned gen = old / nloc;
        if (old + 1u == (gen + 1u) * nloc) {
            __builtin_amdgcn_fence(__ATOMIC_RELEASE, "agent");
            asm volatile("s_waitcnt vmcnt(0)" ::: "memory");
            const unsigned og = xb_add(&bar[XB_TOP], 1u);
            const unsigned tg = og / nx;
            if (og + 1u == (tg + 1u) * nx) xb_add(&bar[XB_TOPGEN], 1u);
            else XB_SPIN(xb_ld(&bar[XB_TOPGEN]) == tg, bar);
            __builtin_amdgcn_fence(__ATOMIC_ACQUIRE, "agent");
            xb_add(&bar[XB_XGEN(b.x)], 1u);
            asm volatile("s_waitcnt vmcnt(0)" ::: "memory");
        } else {
            XB_SPIN(xb_ld(&bar[XB_XGEN(b.x)]) == gen, bar);
            __builtin_amdgcn_fence(__ATOMIC_ACQUIRE, "agent");
            asm volatile("s_waitcnt vmcnt(0)" ::: "memory");
        }
    }
    __syncthreads();
}

struct Frame {
    LAS unsigned char* lds;
    int tid, lane, wave, vcu, G;
    unsigned char* ws;
    __device__ __forceinline__ const float* in(int i) const {
        const volatile LAS unsigned* t = (const volatile LAS unsigned*)(lds + PTAB_OFF);
        const unsigned lo = __builtin_amdgcn_readfirstlane(t[2 * i]), hi = __builtin_amdgcn_readfirstlane(t[2 * i + 1]);
        return (const float*)(const __attribute__((address_space(1))) float*)(((unsigned long long)hi << 32) | lo);
    }
    __device__ __forceinline__ float* out() const { return (float*)in(14); }
};

struct EpiRes {
    static constexpr bool PERM = false, AFTER_DRAIN = false;
    const float* hin; float* h; bf16* hn; const float* gain; float* rss;
    __device__ __forceinline__ void operator()(const pg8::f32x4 (&acc)[2][2][4][2], const pg8::Unit& u, int wr, int wc, int fr, int fq) const {
        const int col0 = u.pn * 256 + wc * 32 + 4 * fq;
        f32x4 gv[2][2];
#pragma unroll
        for (int bj = 0; bj < 2; ++bj)
#pragma unroll
            for (int n = 0; n < 2; ++n) gv[bj][n] = *(const f32x4*)(gain + col0 + bj * 128 + n * 16);
#pragma unroll
        for (int ai = 0; ai < 2; ++ai)
#pragma unroll
            for (int m = 0; m < 4; ++m) { const int row = u.pm * 256 + ai * 128 + wr * 64 + m * 16 + fr; float* rowp = h + (size_t)row * D + col0; const float* rowi = hin + (size_t)row * D + col0; bf16* hrow = hn + (size_t)row * D + col0;
                float ss = 0.f;
#pragma unroll
                for (int bj = 0; bj < 2; ++bj)
#pragma unroll
                    for (int n = 0; n < 2; ++n) { f32x4* p = (f32x4*)(rowp + bj * 128 + n * 16); f32x4 v = *(const f32x4*)(rowi + bj * 128 + n * 16); v += acc[ai][bj][m][n]; *p = v;
                        ss += (v.x * v.x + v.y * v.y) + (v.z * v.z + v.w * v.w);
                        const f32x4 y = v * gv[bj][n]; v2u w; w.x = pk2(y.x, y.y); w.y = pk2(y.z, y.w); *(v2u*)(hrow + bj * 128 + n * 16) = w; }
                ss += __shfl_xor(ss, 16); ss += __shfl_xor(ss, 32);
                if (fq == 0) rss[(size_t)row * 16 + u.pn * 4 + wc] = ss; }
    }
};
struct EpiConvIn {
    static constexpr bool PERM = true, AFTER_DRAIN = false;
    bf16* U; bf16* GB;
    __device__ __forceinline__ void operator()(const pg8::f32x4 (&acc)[2][2][4][2], const pg8::Unit& u, int wr, int wc, int fr, int fq) const {
        const int row0 = u.pm * 256 + wr * 64 + fr;
        if (u.pn < 8) {
            const int ch0 = u.pn * 128 + wc * 32 + 8 * fq;
#pragma unroll
            for (int ai = 0; ai < 2; ++ai)
#pragma unroll
                for (int m = 0; m < 4; ++m) { const f32x4 p0 = acc[ai][0][m][0] * acc[ai][1][m][0], p1 = acc[ai][0][m][1] * acc[ai][1][m][1];
                    v4u w; w.x = pk2(p0[0], p0[1]); w.y = pk2(p0[2], p0[3]); w.z = pk2(p1[0], p1[1]); w.w = pk2(p1[2], p1[3]);
                    *(v4u*)(U + (size_t)(row0 + ai * 128 + m * 16) * D + ch0) = w; }
        } else {
            const int col0 = (u.pn - 8) * 256 + wc * 32 + 8 * fq;
#pragma unroll
            for (int ai = 0; ai < 2; ++ai)
#pragma unroll
                for (int m = 0; m < 4; ++m)
#pragma unroll
                    for (int bj = 0; bj < 2; ++bj) { const f32x4 v0 = acc[ai][bj][m][0], v1 = acc[ai][bj][m][1];
                        v4u w; w.x = pk2(v0[0], v0[1]); w.y = pk2(v0[2], v0[3]); w.z = pk2(v1[0], v1[1]); w.w = pk2(v1[2], v1[3]);
                        *(v4u*)(GB + (size_t)(row0 + ai * 128 + m * 16) * D + col0 + bj * 128) = w; }
        }
    }
};
struct EpiF32 {
    static constexpr bool PERM = false, AFTER_DRAIN = false;
    float* O; int ldc;
    __device__ __forceinline__ void operator()(const pg8::f32x4 (&acc)[2][2][4][2], const pg8::Unit& u, int wr, int wc, int fr, int fq) const {
        const int col0 = u.pn * 256 + wc * 32 + 4 * fq;
#pragma unroll
        for (int ai = 0; ai < 2; ++ai)
#pragma unroll
            for (int m = 0; m < 4; ++m) { float* rowp = O + (size_t)(u.pm * 256 + ai * 128 + wr * 64 + m * 16 + fr) * ldc + col0;
#pragma unroll
                for (int bj = 0; bj < 2; ++bj)
#pragma unroll
                    for (int n = 0; n < 2; ++n) *(f32x4*)(rowp + bj * 128 + n * 16) = acc[ai][bj][m][n]; }
    }
};
struct EpiTopK {
    static constexpr bool PERM = false, AFTER_DRAIN = true;
    int* seli; float* selg; const float* rss;
    __device__ __forceinline__ void operator()(const pg8::f32x4 (&)[2][2][4][2], const pg8::Unit&, int, int, int, int) const {}
    __device__ __forceinline__ void fused(pg8::f32x4 (&acc)[2][2][4][2], const pg8::Unit& u, int wr, int wc, int fr, int fq, LAS unsigned char* lds, int wid, int lane) const {
        LAS float* S = (LAS float*)lds;
        LAS int* L = (LAS int*)lds;
        const int tid = wid * 64 + lane;
#pragma unroll 1
        for (int ai = 0; ai < 2; ++ai) {
#pragma unroll
            for (int m = 0; m < 4; ++m)
#pragma unroll
                for (int bj = 0; bj < 2; ++bj)
#pragma unroll
                    for (int n = 0; n < 2; ++n) {
                        const int row = wr * 64 + m * 16 + fr, col = bj * 128 + wc * 32 + n * 16 + 4 * fq;
                        *(LAS f32x4*)(S + row * 260 + col) = ai == 0 ? acc[0][bj][m][n] : acc[1][bj][m][n];
                    }
            BLOCK_BAR();
            const int row = tid & 127, q = tid >> 7;
            int best[16];
            {
                const LAS f32x4* sp = (const LAS f32x4*)(S + row * 260 + q * 64);
#pragma unroll
                for (int c = 0; c < 4; ++c) {
                    int x[16];
#pragma unroll
                    for (int e4 = 0; e4 < 4; ++e4) { const f32x4 v = sp[c * 4 + e4];
#pragma unroll
                        for (int e = 0; e < 4; ++e) x[e4 * 4 + e] = (tk_map(v[e]) & ~127) | (127 - ((q & 1) * 64 + c * 16 + e4 * 4 + e)); }
                    tk_sort_desc(x);
                    if (c == 0) {
#pragma unroll
                        for (int e = 0; e < 16; ++e) best[e] = x[e];
                    } else tk_merge_top(best, x);
                }
            }
            BLOCK_BAR();
#pragma unroll
            for (int e4 = 0; e4 < 4; ++e4) *(LAS v4u*)(L + row * 68 + q * 16 + e4 * 4) = (v4u){(unsigned)best[e4 * 4], (unsigned)best[e4 * 4 + 1], (unsigned)best[e4 * 4 + 2], (unsigned)best[e4 * 4 + 3]};
            BLOCK_BAR();
            if (tid < 128) {
                int a[16], b[16], t[16];
                LAS int* Lr = L + tid * 68;
#pragma unroll
                for (int e4 = 0; e4 < 4; ++e4) { const v4u va = *(LAS v4u*)(Lr + e4 * 4), vt = *(LAS v4u*)(Lr + 16 + e4 * 4);
#pragma unroll
                    for (int e = 0; e < 4; ++e) { a[e4 * 4 + e] = (int)va[e]; t[e4 * 4 + e] = (int)vt[e]; } }
                tk_merge_top(a, t);
#pragma unroll
                for (int e4 = 0; e4 < 4; ++e4) { const v4u vb = *(LAS v4u*)(Lr + 32 + e4 * 4), vt = *(LAS v4u*)(Lr + 48 + e4 * 4);
#pragma unroll
                    for (int e = 0; e < 4; ++e) { b[e4 * 4 + e] = (int)vb[e]; t[e4 * 4 + e] = (int)vt[e]; } }
                tk_merge_top(b, t);
                const int trow = u.pm * 256 + ai * 128 + tid;
                const f32x4 q0 = *(const f32x4*)(rss + (size_t)trow * 16), q1 = *(const f32x4*)(rss + (size_t)trow * 16 + 4), q2 = *(const f32x4*)(rss + (size_t)trow * 16 + 8), q3 = *(const f32x4*)(rss + (size_t)trow * 16 + 12);
                const float ssq = (((q0.x + q0.y) + (q0.z + q0.w)) + ((q1.x + q1.y) + (q1.z + q1.w))) + (((q2.x + q2.y) + (q2.z + q2.w)) + ((q3.x + q3.y) + (q3.z + q3.w)));
                const float rstd = 1.0f / sqrtf(ssq * (1.f / D) + RMS_EPS);
                const size_t o = ((size_t)trow * 8 + u.pn) * 16;
                tk_stage2(a, b, Lr, (__attribute__((address_space(1))) int*)(seli + o), (__attribute__((address_space(1))) float*)(selg + o), rstd);
            }
            BLOCK_BAR();
        }
    }
};
struct OneUnit {
    pg8::Unit u;
    __device__ __forceinline__ bool next(int i, pg8::Unit& o) const { if (i != 0) return false; o = u; return true; }
    __device__ __forceinline__ void a_ready(const pg8::Unit&) const {}
    __device__ __forceinline__ void done(const pg8::Unit&) const {}
};

__device__ __forceinline__ void p0_transpose_item(const float* W, int ldw, int ncols, bf16* WT, float scale, LAS float* scr, int item, int lane) {
    const int nblk = ncols / 64, kb = item / nblk, nb = item % nblk, k0 = 64 * kb, n0 = 64 * nb;
    f32x4 v[16];
#pragma unroll
    for (int i = 0; i < 16; ++i) v[i] = *(const f32x4*)(W + (size_t)(k0 + 4 * i + (lane >> 4)) * ldw + n0 + 4 * (lane & 15));
#pragma unroll
    for (int i = 0; i < 16; ++i) { LAS float* p = scr + (4 * i + (lane >> 4)) * 65 + 4 * (lane & 15); p[0] = v[i].x * scale; p[1] = v[i].y * scale; p[2] = v[i].z * scale; p[3] = v[i].w * scale; }
    LDS_WAIT(); asm volatile("" ::: "memory");
    const int c = lane & 7;
#pragma unroll
    for (int j = 0; j < 8; ++j) { const int n = (lane >> 3) + 8 * j; const LAS float* s = scr + (8 * c) * 65 + n;
        v4u o; o.x = pk2(s[0 * 65], s[1 * 65]); o.y = pk2(s[2 * 65], s[3 * 65]); o.z = pk2(s[4 * 65], s[5 * 65]); o.w = pk2(s[6 * 65], s[7 * 65]);
        *(v4u*)(WT + (size_t)(n0 + n) * 1024 + k0 + 8 * c) = o; }
    LDS_WAIT(); asm volatile("" ::: "memory");
}
__device__ __forceinline__ void rms_row_to_bf16(const float* xrow, const float* gain, bf16* orow, float* hcopy, int lane) {
    const f32x4* xr = (const f32x4*)xrow + lane; const f32x4* gr = (const f32x4*)gain + lane;
    f32x4 v[4]; float s = 0.f;
#pragma unroll
    for (int j = 0; j < 4; ++j) { v[j] = xr[64 * j]; s += (v[j].x * v[j].x + v[j].y * v[j].y) + (v[j].z * v[j].z + v[j].w * v[j].w); }
    if (hcopy) {
#pragma unroll
        for (int j = 0; j < 4; ++j) ((f32x4*)hcopy + lane)[64 * j] = v[j];
    }
    const float rstd = 1.0f / sqrtf(wave_sum(s) * (1.f / D) + RMS_EPS);
    unsigned long long* o8 = (unsigned long long*)orow + lane;
#pragma unroll
    for (int j = 0; j < 4; ++j) { const f32x4 g = gr[64 * j]; const f32x4 y = v[j] * rstd * g;
        o8[64 * j] = (unsigned long long)pk2(y.x, y.y) | ((unsigned long long)pk2(y.z, y.w) << 32); }
}
__device__ __forceinline__ void p0_prologue(Frame& F, bool dry) {
    if (!(dry && PROBE_PMODE == 1)) {
        LAS float* KL = (LAS float*)F.lds;
        LAS float* WL = (LAS float*)(F.lds + 128 * 132 * 4);
        const float* in10 = F.in(10); const float* in11 = F.in(11);
        f32x4 kreg[8], wreg[4];
#define FOLD_LOAD(it_) do { const int l_ = (it_) >> 8, hp_ = ((it_) >> 4) & 15, k0_ = ((it_) & 15) * 64; \
            const float* kg_ = in11 + (size_t)(l_ * 16 + hp_) * 128 * 128; const float* wg_ = in10 + (size_t)l_ * 1024 * 2048 + (size_t)k0_ * 2048 + hp_ * 128; \
            _Pragma("unroll") for (int i = 0; i < 8; ++i) kreg[i] = *(const f32x4*)(kg_ + 4 * (F.tid + 512 * i)); \
            _Pragma("unroll") for (int i = 0; i < 4; ++i) { const int e = 4 * (F.tid + 512 * i); wreg[i] = *(const f32x4*)(wg_ + (size_t)(e >> 7) * 2048 + (e & 127)); } } while (0)
        if (F.vcu < DEPTH * 16 * 16) FOLD_LOAD(F.vcu);
        for (int it = F.vcu; it < DEPTH * 16 * 16; it += F.G) {
            const int l = it >> 8, hp = (it >> 4) & 15, k0 = (it & 15) * 64;
#pragma unroll
            for (int i = 0; i < 8; ++i) { const int e = 4 * (F.tid + 512 * i), n = e >> 7, d = e & 127; *(LAS f32x4*)(KL + n * 132 + d) = kreg[i]; }
#pragma unroll
            for (int i = 0; i < 4; ++i) { const int e = 4 * (F.tid + 512 * i), kk = e >> 7, d = e & 127; *(LAS f32x4*)(WL + kk * 132 + d) = wreg[i]; }
            if (it + F.G < DEPTH * 16 * 16) FOLD_LOAD(it + F.G);
            BLOCK_BAR();
            {
                const int i16 = F.lane & 15, g4 = F.lane >> 4, nt = F.wave;
                f32x4 facc[4];
#pragma unroll
                for (int mt = 0; mt < 4; ++mt) facc[mt] = (f32x4){0.f, 0.f, 0.f, 0.f};
#pragma unroll 2
                for (int s8 = 0; s8 < 8; ++s8) {
                    const f32x4 bq = *(const LAS f32x4*)(KL + (nt * 16 + i16) * 132 + 16 * s8 + 4 * g4);
                    f32x4 aq[4];
#pragma unroll
                    for (int mt = 0; mt < 4; ++mt) aq[mt] = *(const LAS f32x4*)(WL + (mt * 16 + i16) * 132 + 16 * s8 + 4 * g4);
#pragma unroll
                    for (int t = 0; t < 4; ++t)
#pragma unroll
                        for (int mt = 0; mt < 4; ++mt) facc[mt] = __builtin_amdgcn_mfma_f32_16x16x4f32(aq[mt][t], bq[t], facc[mt], 0, 0, 0);
                }
                bf16* o = (bf16*)(F.ws + WS_WP) + (size_t)l * 2048 * 1024 + (size_t)(hp * 128 + nt * 16 + i16) * 1024 + k0 + 4 * g4;
#pragma unroll
                for (int mt = 0; mt < 4; ++mt) { v2u w; w.x = pk2(facc[mt][0], facc[mt][1]); w.y = pk2(facc[mt][2], facc[mt][3]); *(v2u*)(o + mt * 16) = w; }
            }
            BLOCK_BAR();
        }
#undef FOLD_LOAD
    }
    LAS float* scr = (LAS float*)(F.lds + F.wave * 16640);
    const int gw = F.vcu * NWAVES + F.wave, NGW = F.G * NWAVES;
    constexpr int I_SQ = 16 * 16, I_IN = 16 * 48, PER_J = 3 * I_SQ + I_SQ + I_IN + I_SQ;
    if (!(dry && PROBE_PMODE == 2)) for (int it = gw; it < 2 * PER_J; it += NGW) {
        const int j = it / PER_J; int r = it % PER_J;
        const float* wqkv = F.in(4) + (size_t)j * 1024 * 3072;
        if (r < I_SQ) { p0_transpose_item(wqkv, 3072, 1024, (bf16*)(F.ws + WS_WQK) + (size_t)j * 2048 * 1024, 0.125f, scr, r, F.lane); continue; } r -= I_SQ;
        if (r < I_SQ) { p0_transpose_item(wqkv + 1024, 3072, 1024, (bf16*)(F.ws + WS_WQK) + (size_t)j * 2048 * 1024 + (size_t)1024 * 1024, 1.f, scr, r, F.lane); continue; } r -= I_SQ;
        if (r < I_SQ) { p0_transpose_item(wqkv + 2048, 3072, 1024, (bf16*)(F.ws + WS_WV) + (size_t)j * 1024 * 1024, 1.f, scr, r, F.lane); continue; } r -= I_SQ;
        if (r < I_SQ) { p0_transpose_item(F.in(5) + (size_t)j * 1024 * 1024, 1024, 1024, (bf16*)(F.ws + WS_WO) + (size_t)j * 1024 * 1024, 1.f, scr, r, F.lane); continue; } r -= I_SQ;
        if (r < I_IN) {
            const float* win = F.in(7) + (size_t)j * 1024 * 3072; bf16* wt = (bf16*)(F.ws + WS_WIN) + (size_t)j * 3072 * 1024;
            if (r < 512) { const int blk = r >> 5, pn = blk >> 1, which = blk & 1; p0_transpose_item(win + (which ? 2048 : 1024) + 128 * pn, 3072, 128, wt + (size_t)(256 * pn + 128 * which) * 1024, 1.f, scr, r & 31, F.lane); }
            else p0_transpose_item(win, 3072, 1024, wt + (size_t)2048 * 1024, 1.f, scr, r - 512, F.lane);
            continue; } r -= I_IN;
        p0_transpose_item(F.in(9) + (size_t)j * 1024 * 1024, 1024, 1024, (bf16*)(F.ws + WS_WOUT) + (size_t)j * 1024 * 1024, 1.f, scr, r, F.lane);
    }
    if (!(dry && PROBE_PMODE == 3)) {
        constexpr int NROW = DEPTH * 16384;
        const float* in12 = F.in(12); const float* in13 = F.in(13);
#define XC_LOAD(v, r0_) do { const int tb_ = (r0_) >= NROW ? 1 : 0, rr_ = (r0_) - tb_ * NROW; const float* src_ = (tb_ ? in13 : in12) + (size_t)rr_ * 1024 + 16 * F.lane; \
            _Pragma("unroll") for (int u = 0; u < 4; ++u) _Pragma("unroll") for (int i = 0; i < 4; ++i) v[u][i] = *(const f32x4*)(src_ + (size_t)u * 1024 + 4 * i); } while (0)
#if EXPERT_FP4
#define XC_PACK(v, u, q, dstp) do { v2u w_; _Pragma("unroll") for (int jj = 0; jj < 2; ++jj) { unsigned t_ = 0u; \
                    t_ = __builtin_amdgcn_cvt_scalef32_pk_fp4_f32(t_, v[u][2 * jj].x * q, v[u][2 * jj].y * q, 1.0f, 0); t_ = __builtin_amdgcn_cvt_scalef32_pk_fp4_f32(t_, v[u][2 * jj].z * q, v[u][2 * jj].w * q, 1.0f, 1); \
                    t_ = __builtin_amdgcn_cvt_scalef32_pk_fp4_f32(t_, v[u][2 * jj + 1].x * q, v[u][2 * jj + 1].y * q, 1.0f, 2); t_ = __builtin_amdgcn_cvt_scalef32_pk_fp4_f32(t_, v[u][2 * jj + 1].z * q, v[u][2 * jj + 1].w * q, 1.0f, 3); w_[jj] = t_; } \
                *(v2u*)(dstp) = w_; } while (0)
        constexpr float QMAX = 6.0f;
#else
#define XC_PACK(v, u, q, dstp) do { v4u w_; _Pragma("unroll") for (int i = 0; i < 4; ++i) { unsigned t_ = 0u; t_ = __builtin_amdgcn_cvt_pk_fp8_f32(v[u][i].x * q, v[u][i].y * q, t_, false); t_ = __builtin_amdgcn_cvt_pk_fp8_f32(v[u][i].z * q, v[u][i].w * q, t_, true); w_[i] = t_; } \
                *(v4u*)(dstp) = w_; } while (0)
        constexpr float QMAX = 256.0f;
#endif
#define XC_CONV(v, r0_) do { const int tb_ = (r0_) >= NROW ? 1 : 0, rr_ = (r0_) - tb_ * NROW; \
            unsigned char* dst_ = F.ws + (tb_ ? WS_DN : WS_UP) + (size_t)rr_ * ROWB + (ROWB / 64) * F.lane; float* sc_ = (float*)(F.ws + (tb_ ? WS_SDN : WS_SUP)) + rr_; \
            _Pragma("unroll") for (int u = 0; u < 4; ++u) { float mx = 0.f; \
                _Pragma("unroll") for (int i = 0; i < 4; ++i) mx = fmaxf(fmaxf(mx, fmaxf(fabsf(v[u][i].x), fabsf(v[u][i].y))), fmaxf(fabsf(v[u][i].z), fabsf(v[u][i].w))); \
                _Pragma("unroll") for (int o = 1; o < 64; o <<= 1) mx = fmaxf(mx, __shfl_xor(mx, o)); \
                const float q = mx > 0.f ? QMAX / mx : 1.0f; \
                XC_PACK(v, u, q, dst_ + (size_t)u * ROWB); \
                if (F.lane == 0) sc_[u] = mx > 0.f ? mx * (1.0f / QMAX) : 1.0f; } } while (0)
        const int stepr = NGW * 4;
        f32x4 va[4][4], vb[4][4];
        int r0 = gw * 4;
        if (r0 < 2 * NROW) XC_LOAD(va, r0);
#pragma unroll 1
        for (; r0 < 2 * NROW; r0 += 2 * stepr) {
            if (r0 + stepr < 2 * NROW) XC_LOAD(vb, r0 + stepr);
            XC_CONV(va, r0);
            if (r0 + 2 * stepr < 2 * NROW) XC_LOAD(va, r0 + 2 * stepr);
            if (r0 + stepr < 2 * NROW) XC_CONV(vb, r0 + stepr);
        }
#undef XC_LOAD
#undef XC_PACK
#undef XC_CONV
    }
    if (!(dry && PROBE_PMODE == 4)) {
        const float* x0 = F.in(0); const f32x4* gr = (const f32x4*)F.in(1) + F.lane;
        f32x4 gq[4];
#pragma unroll
        for (int j = 0; j < 4; ++j) gq[j] = gr[64 * j];
#pragma unroll 1
        for (int m0 = gw; m0 < M; m0 += 4 * NGW) {
            f32x4 v[4][4];
#pragma unroll
            for (int u = 0; u < 4; ++u) { const int m = m0 + u * NGW; if (m < M) {
#pragma unroll
                for (int j = 0; j < 4; ++j) v[u][j] = ((const f32x4*)(x0 + (size_t)m * D) + F.lane)[64 * j]; } }
#pragma unroll
            for (int u = 0; u < 4; ++u) { const int m = m0 + u * NGW; if (m < M) {
                float sq = 0.f;
#pragma unroll
                for (int j = 0; j < 4; ++j) { sq += (v[u][j].x * v[u][j].x + v[u][j].y * v[u][j].y) + (v[u][j].z * v[u][j].z + v[u][j].w * v[u][j].w); }
                const float rstd = 1.0f / sqrtf(wave_sum(sq) * (1.f / D) + RMS_EPS);
                unsigned long long* o8 = (unsigned long long*)((bf16*)(F.ws + WS_HN) + (size_t)m * D) + F.lane;
#pragma unroll
                for (int j = 0; j < 4; ++j) { const f32x4 y = v[u][j] * rstd * gq[j]; o8[64 * j] = (unsigned long long)pk2(y.x, y.y) | ((unsigned long long)pk2(y.z, y.w) << 32); } } }
        }
    }
}

__device__ __forceinline__ void norm_phase(Frame& F, const float* gain) {
    const int gw = F.vcu * NWAVES + F.wave, NGW = F.G * NWAVES;
    for (int m = gw; m < M; m += NGW) rms_row_to_bf16((const float*)(F.ws + WS_H) + (size_t)m * D, gain, (bf16*)(F.ws + WS_HN) + (size_t)m * D, nullptr, F.lane);
}
__device__ __forceinline__ void conv_phase(Frame& F, int j) {
    const bf16* U = (const bf16*)(F.ws + WS_BIG); const bf16* GB = (const bf16*)(F.ws + WS_BIG + 32 * MiB); bf16* mix = (bf16*)(F.ws + WS_MIX);
    const float* wc = F.in(8) + (size_t)j * 3 * 1024;
    for (int idx = F.vcu * NTHR + F.tid; idx < M * 128; idx += F.G * NTHR) {
        const int t = idx >> 7, c8 = (idx & 127) * 8, s = t & (SEQ - 1);
        const v4u gb = *(const v4u*)(GB + (size_t)t * D + c8);
        float conv[8];
#pragma unroll
        for (int e = 0; e < 8; ++e) conv[e] = 0.f;
#pragma unroll
        for (int dj = -1; dj <= 1; ++dj) {
            if (s + dj >= 0 && s + dj < SEQ) {
                const v4u uu = *(const v4u*)(U + (size_t)(t + dj) * D + c8);
                const f32x4 w0 = *(const f32x4*)(wc + (dj + 1) * 1024 + c8), w1 = *(const f32x4*)(wc + (dj + 1) * 1024 + c8 + 4);
#pragma unroll
                for (int e2 = 0; e2 < 4; ++e2) {
                    const float wl = e2 < 2 ? w0[2 * e2] : w1[2 * e2 - 4], wh = e2 < 2 ? w0[2 * e2 + 1] : w1[2 * e2 - 3];
                    conv[2 * e2] += wl * bflo(uu[e2]); conv[2 * e2 + 1] += wh * bfhi(uu[e2]);
                }
            }
        }
        v4u o;
#pragma unroll
        for (int e2 = 0; e2 < 4; ++e2) o[e2] = pk2(bflo(gb[e2]) * conv[2 * e2], bfhi(gb[e2]) * conv[2 * e2 + 1]);
        *(v4u*)(mix + (size_t)t * 1024 + c8) = o;
    }
}

constexpr int AT_KSTR = 144, AT_VSTR = 1168, AT_KOFF = 0, AT_VOFF = 576 * AT_KSTR, AT_BOFF = AT_VOFF + 64 * AT_VSTR;
static_assert(AT_BOFF + 1860 <= PTAB_OFF, "attention LDS map");
__device__ __forceinline__ void attn_phase(Frame& F, int j) {
    const bf16* QK = (const bf16*)(F.ws + WS_BIG); const bf16* VT = (const bf16*)(F.ws + WS_VT); bf16* mix = (bf16*)(F.ws + WS_MIX);
    const float* biasl = F.in(6) + (size_t)j * NH * 15 * 31;
    const int lane = F.lane, q = lane & 15, g = lane >> 4, tid = F.tid;
    LAS unsigned char* KL = F.lds + AT_KOFF; LAS unsigned char* VL = F.lds + AT_VOFF; LAS float* btab = (LAS float*)(F.lds + AT_BOFF);
    v4u kreg[9], vreg[9];
    int cur_hh = -1;
#define AT_DECODE(it, b_, hh_, r0_, R0_) const int hh_ = (it) & 15, rp_##it = ((it) >> 4) & 63, b_ = (it) >> 10, r0_ = 2 * rp_##it; int R0_ = r0_ - 4; R0_ = R0_ < 0 ? 0 : (R0_ > NROWS - 8 ? NROWS - 8 : R0_);
#define AT_PREFETCH(it) do { AT_DECODE(it, pb, phh, pr0, pR0) \
        _Pragma("unroll") for (int i = 0; i < 9; ++i) { const int c = tid + 512 * i; \
            { const int key = c >> 3, ch = c & 7; int row = pR0 + (key >> 6); row = row > NROWS - 1 ? NROWS - 1 : row; \
              kreg[i] = *(const v4u*)(QK + ((size_t)pb * SEQ + row * 64 + (key & 63)) * 2048 + 1024 + phh * 64 + ch * 8); } \
            { const int d = c / 72, kch = c - d * 72; vreg[i] = *(const v4u*)(VT + (size_t)(phh * 64 + d) * M + (size_t)pb * SEQ + pR0 * 64 + kch * 8); } } } while (0)
    int it = F.vcu;
    if (it < 2048) AT_PREFETCH(it);
    for (; it < 2048; it += F.G) {
        AT_DECODE(it, b, hh, r0, R0)
        BLOCK_BAR();
#pragma unroll
        for (int i = 0; i < 9; ++i) { const int c = tid + 512 * i;
            *(LAS v4u*)(KL + (c >> 3) * AT_KSTR + (c & 7) * 16) = kreg[i];
            const int d = c / 72, kch = c - d * 72; *(LAS v4u*)(VL + d * AT_VSTR + kch * 16) = vreg[i]; }
        if (hh != cur_hh) { if (tid < 465) btab[tid] = biasl[(size_t)hh * 465 + tid]; cur_hh = hh; }
        BLOCK_BAR();
        const int r = r0 + (F.wave >> 2), jb = F.wave & 3;
        int rs = r - 4; rs = rs < 0 ? 0 : (rs > NROWS - 8 ? NROWS - 8 : rs);
        const int lr0 = rs - R0;
        int bs = 16 * jb - 8; bs = bs < 0 ? 0 : (bs > 32 ? 32 : bs);
        const int qc = 16 * jb + q; int wst = qc - 8; wst = wst < 0 ? 0 : (wst > 48 ? 48 : wst);
        const size_t tokq = (size_t)b * SEQ + r * 64 + qc;
        bf16x8 qf[2];
#pragma unroll
        for (int ks = 0; ks < 2; ++ks) qf[ks] = *(const bf16x8*)(QK + tokq * 2048 + hh * 64 + ks * 32 + 8 * g);
        f32x4 S[8][2];
        const int kcl_a = 8 * (q >> 2) + (q & 3);
#pragma unroll
        for (int wr = 0; wr < 8; ++wr)
#pragma unroll
            for (int T = 0; T < 2; ++T) {
                const LAS unsigned char* kp = KL + ((lr0 + wr) * 64 + bs + kcl_a + 4 * T) * AT_KSTR + 16 * g;
                const bf16x8 k0 = *(const LAS bf16x8*)kp, k1 = *(const LAS bf16x8*)(kp + 64);
                f32x4 c = (f32x4){0.f, 0.f, 0.f, 0.f};
                c = __builtin_amdgcn_mfma_f32_16x16x32_bf16(k0, qf[0], c, 0, 0, 0);
                c = __builtin_amdgcn_mfma_f32_16x16x32_bf16(k1, qf[1], c, 0, 0, 0);
                S[wr][T] = c;
            }
        float mx = -3.0e38f;
#pragma unroll
        for (int wr = 0; wr < 8; ++wr) {
            const LAS float* brow = btab + (rs + wr - r + 7) * 31;
#pragma unroll
            for (int T = 0; T < 2; ++T)
#pragma unroll
                for (int i = 0; i < 4; ++i) {
                    const int kc = bs + 8 * g + 4 * T + i;
                    int co = kc - qc + 15; co = co < 0 ? 0 : (co > 30 ? 30 : co);
                    const bool valid = (kc >= wst) && (kc < wst + 16);
                    const float v = valid ? S[wr][T][i] + brow[co] : -1e30f;
                    S[wr][T][i] = v; mx = fmaxf(mx, v);
                }
        }
        mx = fmaxf(mx, __shfl_xor(mx, 16)); mx = fmaxf(mx, __shfl_xor(mx, 32));
        float sum = 0.f;
        bf16x8 pf[8];
#pragma unroll
        for (int wr = 0; wr < 8; ++wr) {
            float p[8];
#pragma unroll
            for (int T = 0; T < 2; ++T)
#pragma unroll
                for (int i = 0; i < 4; ++i) { p[4 * T + i] = __expf(S[wr][T][i] - mx); sum += p[4 * T + i]; }
            v4u w; w.x = pk2(p[0], p[1]); w.y = pk2(p[2], p[3]); w.z = pk2(p[4], p[5]); w.w = pk2(p[6], p[7]);
            pf[wr] = __builtin_bit_cast(bf16x8, w);
        }
        sum += __shfl_xor(sum, 16); sum += __shfl_xor(sum, 32);
        if (it + F.G < 2048) { const int nit = it + F.G; AT_PREFETCH(nit); }
        f32x4 O[4];
#pragma unroll
        for (int dt = 0; dt < 4; ++dt) O[dt] = (f32x4){0.f, 0.f, 0.f, 0.f};
#pragma unroll
        for (int wr = 0; wr < 8; ++wr)
#pragma unroll
            for (int dt = 0; dt < 4; ++dt) {
                const bf16x8 vf = *(const LAS bf16x8*)(VL + (dt * 16 + q) * AT_VSTR + ((lr0 + wr) * 64 + bs + 8 * g) * 2);
                O[dt] = __builtin_amdgcn_mfma_f32_16x16x32_bf16(vf, pf[wr], O[dt], 0, 0, 0);
            }
        const float inv = 1.0f / sum;
#pragma unroll
        for (int dt = 0; dt < 4; ++dt) { v2u w; w.x = pk2(O[dt][0] * inv, O[dt][1] * inv); w.y = pk2(O[dt][2] * inv, O[dt][3] * inv);
            *(v2u*)(mix + tokq * 1024 + hh * 64 + dt * 16 + 4 * g) = w; }
    }
#undef AT_DECODE
#undef AT_PREFETCH
    BLOCK_BAR();
}
#if NAIVE_ATTN
__device__ __forceinline__ void attn_naive_phase(Frame& F, int j) {
    const bf16* QK = (const bf16*)(F.ws + WS_BIG); const bf16* VT = (const bf16*)(F.ws + WS_VT); bf16* mix = (bf16*)(F.ws + WS_MIX);
    const float* biasl = F.in(6) + (size_t)j * NH * 15 * 31;
    for (int idx = F.vcu * NTHR + F.tid; idx < M * NH; idx += F.G * NTHR) {
        const int hh = idx & 15, t = idx >> 4, b = t >> 13, s = t & (SEQ - 1), r = s >> 6, qc = s & 63;
        int rs = r - 4; rs = rs < 0 ? 0 : (rs > NROWS - 8 ? NROWS - 8 : rs);
        int wst = qc - 8; wst = wst < 0 ? 0 : (wst > 48 ? 48 : wst);
        float qv[64];
#pragma unroll
        for (int c = 0; c < 8; ++c) { const v4u w = *(const v4u*)(QK + (size_t)t * 2048 + hh * 64 + c * 8);
#pragma unroll
            for (int e = 0; e < 4; ++e) { qv[c * 8 + 2 * e] = bflo(w[e]); qv[c * 8 + 2 * e + 1] = bfhi(w[e]); } }
        float mrun = -3.0e38f, lrun = 0.f, o[64];
#pragma unroll
        for (int d = 0; d < 64; ++d) o[d] = 0.f;
        for (int wr = 0; wr < 8; ++wr)
            for (int kk = 0; kk < 16; ++kk) {
                const int kc = wst + kk; const size_t tk = (size_t)b * SEQ + (rs + wr) * 64 + kc;
                float sd = 0.f;
#pragma unroll
                for (int c = 0; c < 8; ++c) { const v4u w = *(const v4u*)(QK + tk * 2048 + 1024 + hh * 64 + c * 8);
#pragma unroll
                    for (int e = 0; e < 4; ++e) sd += qv[c * 8 + 2 * e] * bflo(w[e]) + qv[c * 8 + 2 * e + 1] * bfhi(w[e]); }
                int co = kc - qc + 15; co = co < 0 ? 0 : (co > 30 ? 30 : co);
                sd += biasl[(size_t)hh * 465 + (rs + wr - r + 7) * 31 + co];
                const float mn = fmaxf(mrun, sd), al = __expf(mrun - mn), p = __expf(sd - mn);
                lrun = lrun * al + p; mrun = mn;
#pragma unroll
                for (int d = 0; d < 64; ++d) o[d] = o[d] * al + p * bflo((unsigned)VT[(size_t)(hh * 64 + d) * M + tk]);
            }
        const float inv = 1.0f / lrun;
#pragma unroll
        for (int c = 0; c < 8; ++c) { v4u w;
#pragma unroll
            for (int e = 0; e < 4; ++e) w[e] = pk2(o[c * 8 + 2 * e] * inv, o[c * 8 + 2 * e + 1] * inv);
            *(v4u*)(mix + (size_t)t * 1024 + hh * 64 + c * 8) = w; }
    }
}
#endif
#if NAIVE_TOPK
__device__ __forceinline__ void select_naive_phase(Frame& F) {
    const float* SC = (const float*)(F.ws + WS_SC); int* seli = (int*)(F.ws + WS_SELI); float* selg = (float*)(F.ws + WS_SELG);
    LAS int* AB = (LAS int*)F.lds + F.tid * 33;
    for (int idx = F.vcu * NTHR + F.tid; idx < M * 8; idx += F.G * NTHR) {
        const float* s = SC + (size_t)idx * 256;
        int a[16], b[16], t[16];
        tk_stage1<4>(s, 0, a); tk_stage1<4>(s + 64, 64, t); tk_merge_top(a, t);
        tk_stage1<4>(s + 128, 0, b); tk_stage1<4>(s + 192, 64, t); tk_merge_top(b, t);
        tk_stage2(a, b, AB, seli + (size_t)idx * 16, selg + (size_t)idx * 16);
    }
}
#endif

__device__ __forceinline__ float gelu_erf(float a) { return 0.5f * a * (1.0f + erff(a * 0.70710678118654752f)); }
typedef float f32x2g __attribute__((ext_vector_type(2)));
#if EXPERT_FP4
typedef v2u rowv;
__device__ __forceinline__ rowv row_load(const unsigned char* T, int e, int lane) { return *(const v2u*)(T + (size_t)e * ROWB + 8 * lane); }
#define ROW_PAIR(r, m) __builtin_amdgcn_cvt_scalef32_pk_f32_fp4((r)[(m) >> 2], 1.0f, (m) & 3)
#else
typedef v4u rowv;
__device__ __forceinline__ rowv row_load(const unsigned char* T, int e, int lane) { return *(const v4u*)(T + (size_t)e * ROWB + 16 * lane); }
#define ROW_PAIR(r, m) __builtin_amdgcn_cvt_pk_f32_fp8((r)[(m) >> 1], ((m) & 1) != 0)
#endif
__device__ __forceinline__ void row_axpy(f32x2g (&out)[8], const rowv d, float ak) {
    const f32x2g a2 = (f32x2g){ak, ak};
    out[0] = __builtin_elementwise_fma(a2, ROW_PAIR(d, 0), out[0]); out[1] = __builtin_elementwise_fma(a2, ROW_PAIR(d, 1), out[1]); out[2] = __builtin_elementwise_fma(a2, ROW_PAIR(d, 2), out[2]); out[3] = __builtin_elementwise_fma(a2, ROW_PAIR(d, 3), out[3]);
    out[4] = __builtin_elementwise_fma(a2, ROW_PAIR(d, 4), out[4]); out[5] = __builtin_elementwise_fma(a2, ROW_PAIR(d, 5), out[5]); out[6] = __builtin_elementwise_fma(a2, ROW_PAIR(d, 6), out[6]); out[7] = __builtin_elementwise_fma(a2, ROW_PAIR(d, 7), out[7]);
}
typedef int v8i_g __attribute__((ext_vector_type(8)));
__device__ __forceinline__ void gather_phase(Frame& F, int layer, bool dry) {
    const unsigned char* UP = F.ws + WS_UP + (size_t)layer * 16384 * ROWB; const unsigned char* DN = F.ws + WS_DN + (size_t)layer * 16384 * ROWB;
    const float* SUP = (const float*)(F.ws + WS_SUP) + (size_t)layer * 16384; const float* SDN = (const float*)(F.ws + WS_SDN) + (size_t)layer * 16384;
    const float* gain = F.in(2) + (size_t)layer * D; const float* gnext = layer < DEPTH - 1 ? F.in(1) + (size_t)(layer + 1) * D : F.in(3);
    float* outp = F.out();
    const int* seli = (const int*)(F.ws + WS_SELI); const float* selg = (const float*)(F.ws + WS_SELG);
    float* H = (float*)(F.ws + WS_H); bf16* HN = (bf16*)(F.ws + (dry ? WS_SC + 64 * MiB : WS_HN)); float* HW = (float*)(F.ws + (dry ? WS_SC : WS_H)); if (dry) outp = HW;
    const int lane = F.lane, gw = F.vcu * NWAVES + F.wave, NGW = F.G * NWAVES;
    const bool b5 = lane & 32, b4 = lane & 16, b3 = lane & 8, b2 = lane & 4;
    constexpr int G_RB = 16384, G_NSLOT = 4;
    LAS unsigned char* RB = F.lds + F.wave * G_RB;
    LAS float* ACT = (LAS float*)(F.lds + 8 * G_RB + F.wave * (G_NSLOT * 512));
    static_assert(8 * G_RB + 8 * G_NSLOT * 512 + 8 * 1024 <= PTAB_OFF, "gather LDS map");
#pragma unroll 1
    for (int base = gw; base < M; base += G_NSLOT * NGW) {
    LAS unsigned char* X8 = F.lds + 8 * G_RB + 8 * G_NSLOT * 512 + F.wave * 1024;
    const int n16 = lane & 15, g4 = lane >> 4;
    f32x4 nhv[4]; int nidx_lo = 0, nidx_hi = 0; float ng_lo = 0.f, ng_hi = 0.f;
#define TOK_LOAD(t_) do { const float* hr_ = H + (size_t)(t_) * D + 16 * lane; _Pragma("unroll") for (int i = 0; i < 4; ++i) nhv[i] = *(const f32x4*)(hr_ + 4 * i); \
        nidx_lo = seli[(size_t)(t_) * 128 + lane]; nidx_hi = seli[(size_t)(t_) * 128 + 64 + lane]; ng_lo = selg[(size_t)(t_) * 128 + lane]; ng_hi = selg[(size_t)(t_) * 128 + 64 + lane]; } while (0)
    if (base < M) TOK_LOAD(base);
#pragma unroll 1
    for (int slot = 0; slot < G_NSLOT; ++slot) {
        const int t = base + slot * NGW; if (t >= M) break;
        f32x4 hv[4];
#pragma unroll
        for (int i = 0; i < 4; ++i) hv[i] = nhv[i];
        const int idx_lo = nidx_lo, idx_hi = nidx_hi; const float g_lo = ng_lo, g_hi = ng_hi;
        if (slot + 1 < G_NSLOT && t + NGW < M) TOK_LOAD(t + NGW);
        float ss = 0.f;
#pragma unroll
        for (int i = 0; i < 4; ++i) ss += (hv[i].x * hv[i].x + hv[i].y * hv[i].y) + (hv[i].z * hv[i].z + hv[i].w * hv[i].w);
        const float rstd = 1.0f / sqrtf(wave_sum(ss) * (1.f / D) + RMS_EPS);
        float xmax = 0.f;
        f32x4 xv[4];
#pragma unroll
        for (int i = 0; i < 4; ++i) { const f32x4 g = *(const f32x4*)(gain + 16 * lane + 4 * i); xv[i] = hv[i] * rstd * g;
            xmax = fmaxf(fmaxf(xmax, fmaxf(fabsf(xv[i].x), fabsf(xv[i].y))), fmaxf(fabsf(xv[i].z), fabsf(xv[i].w))); }
#pragma unroll
        for (int o = 1; o < 64; o <<= 1) xmax = fmaxf(xmax, __shfl_xor(xmax, o));
        const float qx = xmax > 0.f ? 256.0f / xmax : 1.0f, xinv = xmax > 0.f ? xmax * (1.0f / 256.0f) : 1.0f;
        {
            v4u w;
#pragma unroll
            for (int i = 0; i < 4; ++i) { unsigned tt = 0u; tt = __builtin_amdgcn_cvt_pk_fp8_f32(xv[i].x * qx, xv[i].y * qx, tt, false); tt = __builtin_amdgcn_cvt_pk_fp8_f32(xv[i].z * qx, xv[i].w * qx, tt, true); w[i] = tt; }
            *(LAS v4u*)(X8 + 16 * lane) = w;
        }
        LDS_WAIT(); asm volatile("" ::: "memory");
        v8i_g bx[8];
#pragma unroll
        for (int s8 = 0; s8 < 8; ++s8) { const v4u b0 = *(const LAS v4u*)(X8 + 128 * s8 + 16 * g4), b1 = *(const LAS v4u*)(X8 + 128 * s8 + 64 + 16 * g4);
            bx[s8] = (v8i_g){(int)b0.x, (int)b0.y, (int)b0.z, (int)b0.w, (int)b1.x, (int)b1.y, (int)b1.z, (int)b1.w}; }
        LDS_WAIT(); asm volatile("" ::: "memory");
#define DN_LOAD(buf, hq) do { const int sel_ = (hq) < 2 ? idx_lo : idx_hi; _Pragma("unroll") for (int k = 0; k < 32; ++k) buf[k] = row_load(DN, __builtin_amdgcn_readlane(sel_, ((hq) & 1) * 32 + k), lane); } while (0)
#define UP_DMA(hb_, bufoff_) do { const int sel_ = (hb_) < 4 ? idx_lo : idx_hi; const int lb_ = ((hb_) & 3) * 16; \
            _Pragma("unroll") for (int k = 0; k < 8; ++k) { const int e0_ = __builtin_amdgcn_readlane(sel_, lb_ + 2 * k), e1_ = __builtin_amdgcn_readlane(sel_, lb_ + 2 * k + 1); \
                const int er_ = lane < 32 ? e0_ : e1_, r_ = 2 * k + (lane >> 5); \
                __builtin_amdgcn_global_load_lds((const unsigned*)(UP + (size_t)er_ * ROWB + 16 * ((lane & 31) ^ (r_ & 15))), (LAS unsigned*)(RB + (bufoff_) + k * 1024), 16, 0, 0); } } while (0)
#define UP_HEAD(hb_, NEXT_STMT) do { const int sel = (hb_) < 4 ? idx_lo : idx_hi; const float gsel = (hb_) < 4 ? g_lo : g_hi; const int lb = ((hb_) & 3) * 16; const int cur = ((hb_) & 1) * 8192; \
            const int ek_ = __shfl(sel, lb + 4 * g4 + (n16 & 3)); const float sc0 = SUP[ek_], sc1 = SDN[ek_]; \
            asm volatile("s_waitcnt vmcnt(0)" ::: "memory");                    \
            NEXT_STMT; \
            f32x4 c = (f32x4){0.f, 0.f, 0.f, 0.f}; \
            _Pragma("unroll") for (int s8 = 0; s8 < 8; ++s8) { const v4u a4 = *(const LAS v4u*)(RB + cur + n16 * 512 + 16 * ((4 * s8 + g4) ^ n16)); const v8i_g a8 = (v8i_g){(int)a4.x, (int)a4.y, (int)a4.z, (int)a4.w, 0, 0, 0, 0}; \
                c = __builtin_amdgcn_mfma_scale_f32_16x16x128_f8f6f4(a8, bx[s8], c, 4, 0, 0, 0x7f7f7f7f, 0, 0x7f7f7f7f); } \
            const int r_ = n16 & 3, k_ = 4 * g4 + r_; \
            const float my = r_ == 0 ? c[0] : (r_ == 1 ? c[1] : (r_ == 2 ? c[2] : c[3])); \
            const float gate = __shfl(gsel, lb + k_); \
            const float act = gelu_erf(my * sc0 * xinv) * gate * sc1; \
            if (n16 < 4) ACT[slot * 128 + (hb_) * 16 + k_] = act; \
            LDS_WAIT(); asm volatile("" ::: "memory"); } while (0)
        rowv da[32];
        {
            UP_DMA(0, 0);
#pragma unroll 1
            for (int hb = 0; hb < 8; ++hb) UP_HEAD(hb, if (hb < 7) UP_DMA(hb + 1, ((hb + 1) & 1) * 8192));
            DN_LOAD(da, 0);
        }
#undef UP_DMA
#undef UP_HEAD
        LDS_WAIT(); asm volatile("" ::: "memory");
        const float a_lo = ACT[slot * 128 + lane], a_hi = ACT[slot * 128 + 64 + lane];
        f32x2g out[8];
#pragma unroll
        for (int e = 0; e < 8; ++e) out[e] = (f32x2g){0.f, 0.f};
#define DN_STEP(buf, hq) do { const float asel = (hq) < 2 ? a_lo : a_hi; \
            _Pragma("unroll") for (int k = 0; k < 32; ++k) row_axpy(out, buf[k], __builtin_bit_cast(float, __builtin_amdgcn_readlane(__builtin_bit_cast(int, asel), ((hq) & 1) * 32 + k))); } while (0)
        {
            rowv db[32];
            DN_LOAD(db, 1); DN_STEP(da, 0);
            DN_LOAD(da, 2); DN_STEP(db, 1);
            DN_LOAD(db, 3); DN_STEP(da, 2);
            DN_STEP(db, 3);
        }
#undef DN_LOAD
#undef DN_STEP
        float ss2 = 0.f;
#pragma unroll
        for (int i = 0; i < 4; ++i) { hv[i].x += out[2 * i].x; hv[i].y += out[2 * i].y; hv[i].z += out[2 * i + 1].x; hv[i].w += out[2 * i + 1].y;
            ss2 += (hv[i].x * hv[i].x + hv[i].y * hv[i].y) + (hv[i].z * hv[i].z + hv[i].w * hv[i].w); }
        const float rstd2 = 1.0f / sqrtf(wave_sum(ss2) * (1.f / D) + RMS_EPS);
        f32x4 y[4];
#pragma unroll
        for (int i = 0; i < 4; ++i) y[i] = hv[i] * rstd2 * *(const f32x4*)(gnext + 16 * lane + 4 * i);
        if (layer < DEPTH - 1) {
#pragma unroll
            for (int i = 0; i < 4; ++i) *(f32x4*)(HW + (size_t)t * D + 16 * lane + 4 * i) = hv[i];
            bf16* hn = HN + (size_t)t * D + 16 * lane;
            v4u o0, o1; o0.x = pk2(y[0].x, y[0].y); o0.y = pk2(y[0].z, y[0].w); o0.z = pk2(y[1].x, y[1].y); o0.w = pk2(y[1].z, y[1].w);
            o1.x = pk2(y[2].x, y[2].y); o1.y = pk2(y[2].z, y[2].w); o1.z = pk2(y[3].x, y[3].y); o1.w = pk2(y[3].z, y[3].w);
            *(v4u*)hn = o0; *(v4u*)(hn + 8) = o1;
        } else {
            float* orow = outp + (size_t)t * D + 16 * lane;
#pragma unroll
            for (int i = 0; i < 4; ++i) *(f32x4*)(orow + 4 * i) = y[i];
        }
    }
    LDS_WAIT(); asm volatile("" ::: "memory");
    }
#undef TOK_LOAD
}

struct Args { const float* in[14]; float* out; unsigned char* ws; int ph_lo, ph_hi; };
__global__ void __launch_bounds__(NTHR, 2) mega_fwd(Args args) {
    extern __shared__ __attribute__((aligned(16))) unsigned char lds[];
    Frame F;
    F.lds = (LAS unsigned char*)lds;
    F.tid = threadIdx.x; F.lane = F.tid & 63; F.wave = __builtin_amdgcn_readfirstlane(F.tid >> 6);
    F.G = gridDim.x; { const int bx = blockIdx.x; F.vcu = (F.G % 8 == 0) ? (bx % 8) * (F.G / 8) + bx / 8 : bx; }
    F.ws = args.ws;
    volatile LAS unsigned* MISC = (volatile LAS unsigned*)(F.lds + MISC_OFF);
    if (F.tid < 64) MISC[F.tid] = 0u;
    if (F.tid < 15) { const unsigned long long p = F.tid < 14 ? (unsigned long long)args.in[F.tid] : (unsigned long long)args.out;
        volatile LAS unsigned* t = (volatile LAS unsigned*)(F.lds + PTAB_OFF); t[2 * F.tid] = (unsigned)p; t[2 * F.tid + 1] = (unsigned)(p >> 32); }
    __syncthreads();
    XcdBarrier bar; bar.bar = (unsigned*)(F.ws + WS_CTL) + CW_BAR; bar.x = 0; bar.st = nullptr;
    if (MK_N_LAUNCHES == 1) bar = xcd_barrier_post((unsigned*)(F.ws + WS_CTL) + CW_BAR, MISC + 8);

#pragma unroll 1
    for (int ph = args.ph_lo; ph < args.ph_hi; ++ph) {
        bool did = true;
        const int kind_ = ph == 0 ? 7 : (ph - 1) % PH_PER_LAYER; const int nrep = (PROBE_REP >= 0 && kind_ == PROBE_REP && (ph == 0 || ((PROBE_LMASK >> ((ph - 1) / PH_PER_LAYER)) & 1))) ? 2 : 1;
#pragma unroll 1
        for (int rep = 0; rep < nrep; ++rep) {
        const bool dry = (nrep == 2 && rep == 0);
        { int t_ = threadIdx.x; asm volatile("" : "+v"(t_)); F.tid = t_; F.lane = t_ & 63; F.wave = __builtin_amdgcn_readfirstlane(t_ >> 6);
          unsigned long long ws_ = (unsigned long long)args.ws; asm volatile("" : "+s"(ws_)); F.ws = (unsigned char*)(__attribute__((address_space(1))) unsigned char*)ws_; }
#ifndef DIS_PRO
        if (ph == 0) p0_prologue(F, dry);
#else
        if (ph == 0) {}
#endif
        else {
            const int layer = (ph - 1) / PH_PER_LAYER, k = (ph - 1) % PH_PER_LAYER, j = layer >> 1; const bool is_attn = (layer & 1) == 0;
            if (k == 0) {
                if (!is_attn) {
                    pg8::Gemm g{(const pg8::bf16_t*)(F.ws + WS_HN), (const pg8::bf16_t*)(F.ws + WS_WIN) + (size_t)j * 3072 * 1024, M, 3072, D};
                    pg8::StaticOrder S; S.init(g.M, g.N, F.G, (int)blockIdx.x);
                    EpiConvIn E{(bf16*)(F.ws + WS_BIG), (bf16*)(F.ws + WS_BIG + 32 * MiB)};
                    pg8::gemm_phase<EpiConvIn, pg8::StaticOrder, true, true>(F.lds, g, S, E);
                }
                const int ng = is_attn ? 2 : 0;
#pragma unroll 1
                for (int gi = 0; gi < ng; ++gi) {
                    pg8::Gemm g; pg8::EpiBf16<0> E; E.bias = nullptr; E.split_cols = 0; E.split_stride = 0; E.scale0 = 1.f;
                    if (is_attn && gi == 0) { g = pg8::Gemm{(const pg8::bf16_t*)(F.ws + WS_HN), (const pg8::bf16_t*)(F.ws + WS_WQK) + (size_t)j * 2048 * 1024, M, 2048, D}; E.O = (pg8::bf16_t*)(F.ws + WS_BIG); E.ldc = 2048; }
                    else if (is_attn) { g = pg8::Gemm{(const pg8::bf16_t*)(F.ws + WS_WV) + (size_t)j * 1024 * 1024, (const pg8::bf16_t*)(F.ws + WS_HN), D, M, D}; E.O = (pg8::bf16_t*)(F.ws + WS_VT); E.ldc = M; }
                    else { g = pg8::Gemm{(const pg8::bf16_t*)(F.ws + WS_HN), (const pg8::bf16_t*)(F.ws + WS_WIN) + (size_t)j * 3072 * 1024, M, 3072, D}; E.O = (pg8::bf16_t*)(F.ws + WS_BIG); E.ldc = 3072; }
                    pg8::StaticOrder S; S.init(g.M, g.N, F.G, (int)blockIdx.x);
                    pg8::gemm_phase<pg8::EpiBf16<0>, pg8::StaticOrder, true, true>(F.lds, g, S, E);
                }
            } else if (k == 1) {
                if (is_attn) {
#if NAIVE_ATTN
                    attn_naive_phase(F, j);
#elif !defined(DIS_ATTN)
                    attn_phase(F, j);
#endif
                } else {
#ifndef DIS_CONV
                    conv_phase(F, j);
#endif
                }
            } else if (k == 2) {
                pg8::Gemm g{(const pg8::bf16_t*)(F.ws + WS_MIX), (const pg8::bf16_t*)(F.ws + (is_attn ? WS_WO : WS_WOUT)) + (size_t)j * 1024 * 1024, M, D, D};
                pg8::StaticOrder S; S.init(M, D, F.G, (int)blockIdx.x);
                EpiRes E{layer == 0 ? F.in(0) : (const float*)(F.ws + WS_H), (float*)(F.ws + (dry ? WS_SC : WS_H)), (bf16*)(F.ws + (dry ? WS_SC + 64 * MiB : WS_HN)), F.in(2) + (size_t)layer * D, (float*)(F.ws + (dry ? WS_SC + 96 * MiB : WS_RSS))};
                pg8::gemm_phase<EpiRes, pg8::StaticOrder, false, true>(F.lds, g, S, E);
            } else if (k == 3) {
                did = false;
            } else if (k == 4) {
                pg8::Gemm g{(const pg8::bf16_t*)(F.ws + WS_HN), (const pg8::bf16_t*)(F.ws + WS_WP) + (size_t)layer * 2048 * 1024, M, 2048, D};
                pg8::StaticOrder S; S.init(M, 2048, F.G, (int)blockIdx.x);
#if NAIVE_TOPK
                EpiF32 E{(float*)(F.ws + WS_SC), 2048};
                pg8::gemm_phase<EpiF32, pg8::StaticOrder, true, true>(F.lds, g, S, E);
#else
#ifndef DIS_TOPK
                EpiTopK E{(int*)(F.ws + WS_SELI), (float*)(F.ws + WS_SELG), (const float*)(F.ws + WS_RSS)};
#pragma unroll 1
                for (int i = 0;; ++i) { OneUnit O1; if (!S.next(i, O1.u)) break; pg8::gemm_phase<EpiTopK, OneUnit, false, true>(F.lds, g, O1, E); }
#endif
#endif
            } else if (k == 5) {
#if NAIVE_TOPK
                select_naive_phase(F);
#else
                did = false;
#endif
            } else {
#ifndef DIS_GATHER
                gather_phase(F, layer, dry);
#endif
            }
        }
        if (MK_N_LAUNCHES == 1 && dry) xcd_barrier(bar);
        }
        if (MK_N_LAUNCHES == 1 && did && ph + 1 < args.ph_hi) { xcd_barrier(bar);
#ifdef PROBE_BAR2
            xcd_barrier(bar);
#endif
        }
    }
}

extern "C" void kernel_launch(void* const* d_in, const int* in_sizes, int n_in, void* d_out, int out_size, void* d_ws, size_t ws_size, hipStream_t stream) {
    static int grid = 0;
    if (grid == 0) {
        if (n_in != 14 || out_size != M * D || ws_size < WS_END) { fprintf(stderr, "kernel_launch: unexpected shapes (n_in %d, out %d, ws %zu); nothing launched\n", n_in, out_size, ws_size); grid = -1; return; }
        int dev = 0, cus = 0, per_cu = 0;
        if (hipGetDevice(&dev) != hipSuccess || hipDeviceGetAttribute(&cus, hipDeviceAttributeMultiprocessorCount, dev) != hipSuccess) { grid = -1; return; }
        if (hipFuncSetAttribute((const void*)mega_fwd, hipFuncAttributeMaxDynamicSharedMemorySize, LDS_BYTES) != hipSuccess) { fprintf(stderr, "kernel_launch: hipFuncSetAttribute failed\n"); grid = -1; return; }
        if (hipOccupancyMaxActiveBlocksPerMultiprocessor(&per_cu, (const void*)mega_fwd, NTHR, LDS_BYTES) != hipSuccess || per_cu < 1) fprintf(stderr, "kernel_launch: note: occupancy query reports %d\n", per_cu);
        (void)hipGetLastError();
        grid = cus;
    }
    if (grid < 0) return;
    if (hipMemsetAsync((char*)d_ws + WS_CTL, 0, CTL_ZERO_BYTES, stream) != hipSuccess) return;
    Args a{};
    for (int i = 0; i < 14; ++i) a.in[i] = (const float*)d_in[i];
    a.out = (float*)d_out; a.ws = (unsigned char*)d_ws;
    if (MK_N_LAUNCHES == 1) { a.ph_lo = 0; a.ph_hi = N_PHASES; hipLaunchKernelGGL(mega_fwd, dim3(grid), dim3(NTHR), LDS_BYTES, stream, a); }
    else for (int ph = 0; ph < N_PHASES; ++ph) {
        if (ph > 0 && ((ph - 1) % PH_PER_LAYER == 3 || (!NAIVE_TOPK && (ph - 1) % PH_PER_LAYER == 5))) continue;
        a.ph_lo = ph; a.ph_hi = ph + 1; hipLaunchKernelGGL(mega_fwd, dim3(grid), dim3(NTHR), LDS_BYTES, stream, a);
    }
}
```

```cpp
#include <hip/hip_runtime.h>
#include <cstdio>
#include <cstdint>
namespace pg8 {
#define PG8_LAS __attribute__((address_space(3)))
typedef unsigned short bf16_t;
typedef short bf16x8 __attribute__((ext_vector_type(8)));
typedef float f32x4 __attribute__((ext_vector_type(4)));
typedef unsigned u32x4 __attribute__((ext_vector_type(4)));
constexpr int BM = 256, BK = 64, HALF = 128, HTB = HALF * BK * 2  , STAGE_BYTES = 8 * HTB, NXCD = 8, WGM = 8;

__host__ __device__ __forceinline__ int lds_byte(int r, int c) { const int st = (r >> 4) * 2 + (c >> 5), rr = r & 15, cc = c & 31, ob = rr * 64 + cc * 2; return st * 1024 + (ob ^ (((ob >> 9) & 1) << 5)); }
__host__ __device__ __forceinline__ void stage_rc(int b, int& R, int& C) { const int st = b / 1024, sb = b % 1024, swz = sb ^ (((sb >> 9) & 1) << 5); R = (st >> 1) * 16 + swz / 64; C = (st & 1) * 32 + (swz % 64) / 2; }
__host__ __device__ __forceinline__ int perm32(int rho) { const int n = rho >> 4, i = rho & 15; return 8 * (i >> 2) + 4 * n + (i & 3); }

struct Unit { int pm, pn; };
struct Gemm { const bf16_t* A; const bf16_t* Bt; int M, N, K; };

struct StaticOrder {
    int nM, nN, nwg, G, c;
    __host__ __device__ void init(int M, int N, int G_, int c_) { nM = M / BM; nN = N / BM; nwg = nM * nN; G = G_; c = c_; }
    __host__ __device__ bool next(int i, Unit& u) const {
        const long L = (long)i * G + c; if (L >= nwg) return false;
        int wgid = (int)L; { const int q = nwg / NXCD, r = nwg % NXCD, xcd = wgid % NXCD, off = wgid / NXCD; wgid = (xcd < r ? xcd * (q + 1) : r * (q + 1) + (xcd - r) * q) + off; }
        const int nig = WGM * nN, gid = wgid / nig, fm = gid * WGM, gsz = (nM - fm) < WGM ? (nM - fm) : WGM;
        u.pm = fm + ((wgid % nig) % gsz); u.pn = (wgid % nig) / gsz; return true;
    }
    __device__ __forceinline__ void a_ready(const Unit&) const {}
    __device__ __forceinline__ void done(const Unit&) const {}
};

__device__ __forceinline__ unsigned cvt_pk_bf16(float lo, float hi) { unsigned r; asm volatile("v_cvt_pk_bf16_f32 %0, %1, %2" : "=v"(r) : "v"(lo), "v"(hi)); return r; }
typedef float f32x2 __attribute__((ext_vector_type(2)));
__device__ __forceinline__ f32x2 gelu_pk(f32x2 v) {
    const f32x2 av = __builtin_elementwise_abs(v), d = av * 0.2316418882f + 1.0f;
    f32x2 t; t.x = __builtin_amdgcn_rcpf(d.x); t.y = __builtin_amdgcn_rcpf(d.y);
    f32x2 q = t * 0.5307027145f + (-0.7265760135f); q = q * t + 0.7107068705f; q = q * t + (-0.142248368f); q = q * t + 0.127414796f; q = q * t;
    const f32x2 s = (v * v) * (-0.72134752044f);
    f32x2 e; e.x = __builtin_amdgcn_exp2f(s.x); e.y = __builtin_amdgcn_exp2f(s.y);
    const f32x2 m = v * (q * e), r = v - m;
    f32x2 o; o.x = v.x < 0.f ? m.x : r.x; o.y = v.y < 0.f ? m.y : r.y; return o;
}

template <int ACT  > struct EpiBf16 {
    static constexpr bool PERM = true, AFTER_DRAIN = false; static_assert(ACT == 0 || ACT == 1, "EpiBf16: ACT is 0 (none) or 1 (gelu_pk)");
    bf16_t* O; int ldc; const float* bias; int split_cols; size_t split_stride; float scale0;
    __device__ __forceinline__ void operator()(const f32x4 (&acc)[2][2][4][2], const Unit& u, int wr, int wc, int fr, int fq) const {
        const int row0 = u.pm * BM + wr * 64 + fr; int colt = u.pn * BM; bf16_t* base = O;
        float sc = 1.f; if (split_cols) { const int t = colt / split_cols; base += (size_t)t * split_stride; colt -= t * split_cols; if (t == 0) sc = scale0; }
        const int col0 = colt + wc * 32 + 8 * fq, bcol0 = u.pn * BM + wc * 32 + 8 * fq;
        f32x4 bv[2][2];
#pragma unroll
        for (int bj = 0; bj < 2; ++bj)
#pragma unroll
            for (int n = 0; n < 2; ++n) bv[bj][n] = bias ? *(const f32x4*)(bias + bcol0 + bj * HALF + 4 * n) : (f32x4){0.f, 0.f, 0.f, 0.f};
#pragma unroll
        for (int ai = 0; ai < 2; ++ai)
#pragma unroll
            for (int m = 0; m < 4; ++m) { bf16_t* rowp = base + (size_t)(row0 + ai * HALF + m * 16) * ldc + col0;
#pragma unroll
                for (int bj = 0; bj < 2; ++bj) { f32x4 v0 = acc[ai][bj][m][0] + bv[bj][0], v1 = acc[ai][bj][m][1] + bv[bj][1];
                    if (ACT == 1) { f32x2 a = gelu_pk((f32x2){v0[0], v0[1]}), b = gelu_pk((f32x2){v0[2], v0[3]}), c = gelu_pk((f32x2){v1[0], v1[1]}), d = gelu_pk((f32x2){v1[2], v1[3]});
                        v0 = (f32x4){a.x, a.y, b.x, b.y}; v1 = (f32x4){c.x, c.y, d.x, d.y}; }
                    v0 = v0 * sc; v1 = v1 * sc; u32x4 w; w.x = cvt_pk_bf16(v0[0], v0[1]); w.y = cvt_pk_bf16(v0[2], v0[3]); w.z = cvt_pk_bf16(v1[0], v1[1]); w.w = cvt_pk_bf16(v1[2], v1[3]);
                    *(u32x4*)(rowp + bj * HALF) = w; } }
    }
};

template <class Epi, class Sched, bool ALIGN_EPI = false, bool SP2 = false>
__device__ __forceinline__ void gemm_phase(PG8_LAS unsigned char* lds, const Gemm g, const Sched& S, const Epi& E) {
    int tid_l = threadIdx.x; asm volatile("" : "+v"(tid_l));
    const int tid = tid_l, wid = __builtin_amdgcn_readfirstlane(tid >> 6), lane = tid & 63, wr = wid >> 2, wc = wid & 3, fr = lane & 15, fq = lane >> 4;
    const int K = g.K, nt = K / BK;
    unsigned voffA[2], voffB[2];
#pragma unroll
    for (int i = 0; i < 2; ++i) { int R, C; stage_rc(tid * 16 + i * 8192, R, C); const int Rb = Epi::PERM ? ((R & ~31) + perm32(R & 31)) : R;
        voffA[i] = (unsigned)(R * K + C) * 2u; voffB[i] = (unsigned)(Rb * K + C) * 2u; }
    const size_t kstep = (size_t)(BK * 2);
    const size_t hstep = (size_t)HALF * K * 2;
    const size_t tstep = 2 * hstep;
    const unsigned ldsw = (unsigned)wid * 1024u;
    const int aoff = lds_byte(wr * 64 + fr, fq * 8), boff = lds_byte(wc * 32 + fr, fq * 8);
#define PG8_SA(b, h) (((b) * 2 + (h)) * HTB)
#define PG8_SB(b, h) ((4 + (b) * 2 + (h)) * HTB)
#define PG8_STAGE(bufoff, gbase, voff) do { _Pragma("unroll") for (int _i = 0; _i < 2; ++_i) \
        __builtin_amdgcn_global_load_lds((const unsigned*)((const char*)(gbase) + (voff)[_i]), (PG8_LAS unsigned*)(lds + (bufoff) + ldsw + _i * 8192), 16, 0, 0); } while (0)
#define PG8_LDA(dst, b, h) do { _Pragma("unroll") for (int m = 0; m < 4; ++m) _Pragma("unroll") for (int k = 0; k < 2; ++k) dst[m][k] = *(const PG8_LAS bf16x8*)(lds + PG8_SA(b, h) + aoff + m * 2048 + k * 1024); } while (0)
#define PG8_LDB(dst, b, h) do { _Pragma("unroll") for (int n = 0; n < 2; ++n) _Pragma("unroll") for (int k = 0; k < 2; ++k) dst[n][k] = *(const PG8_LAS bf16x8*)(lds + PG8_SB(b, h) + boff + n * 2048 + k * 1024); } while (0)
#define PG8_MMA(ai, bj, At, Bt) do { __builtin_amdgcn_s_setprio(1); _Pragma("unroll") for (int m = 0; m < 4; ++m) _Pragma("unroll") for (int n = 0; n < 2; ++n) _Pragma("unroll") for (int k = 0; k < 2; ++k) \
        acc[ai][bj][m][n] = __builtin_amdgcn_mfma_f32_16x16x32_bf16(Bt[n][k], At[m][k], acc[ai][bj][m][n], 0, 0, 0); __builtin_amdgcn_s_setprio(0); } while (0)
#define PG8_WAIT_V(n) asm volatile("s_waitcnt vmcnt(" #n ")" ::: "memory")
#define PG8_WAIT_L(n) asm volatile("s_waitcnt lgkmcnt(" #n ")" ::: "memory")
#define PG8_BAR __builtin_amdgcn_s_barrier()
#define PG8_SCHED __builtin_amdgcn_sched_barrier(0)
    Unit cur, nxt; int ui = 0;
    if (!S.next(0, cur)) return;
    f32x4 acc[2][2][4][2];
#pragma unroll
    for (int a = 0; a < 2; ++a)
#pragma unroll
        for (int b = 0; b < 2; ++b)
#pragma unroll
            for (int m = 0; m < 4; ++m)
#pragma unroll
                for (int n = 0; n < 2; ++n) acc[a][b][m][n] = (f32x4){0.f, 0.f, 0.f, 0.f};
    bf16x8 At[4][2], B0[2][2], B1[2][2];
    const char* cA = (const char*)g.A + (size_t)cur.pm * tstep; const char* cB = (const char*)g.Bt + (size_t)cur.pn * tstep;
    S.a_ready(cur);
    if constexpr (SP2) {
        PG8_STAGE(PG8_SB(0, 0), cB, voffB); PG8_STAGE(PG8_SB(0, 1), cB + hstep, voffB); PG8_STAGE(PG8_SA(0, 0), cA, voffA); PG8_STAGE(PG8_SA(0, 1), cA + hstep, voffA);
        if (wr == 1) PG8_BAR;
        PG8_WAIT_V(2); PG8_BAR;
        PG8_STAGE(PG8_SB(1, 0), cB + kstep, voffB); PG8_STAGE(PG8_SA(1, 0), cA + kstep, voffA); PG8_STAGE(PG8_SB(1, 1), cB + hstep + kstep, voffB);
        PG8_WAIT_V(6); PG8_BAR;
    } else {
        PG8_STAGE(PG8_SB(0, 0), cB, voffB); PG8_STAGE(PG8_SA(0, 0), cA, voffA); PG8_STAGE(PG8_SB(0, 1), cB + hstep, voffB); PG8_STAGE(PG8_SA(0, 1), cA + hstep, voffA);
        if (wr == 1) PG8_BAR;
        PG8_WAIT_V(4); PG8_BAR;
        PG8_STAGE(PG8_SB(1, 0), cB + kstep, voffB); PG8_STAGE(PG8_SA(1, 0), cA + kstep, voffA); PG8_STAGE(PG8_SB(1, 1), cB + hstep + kstep, voffB);
        PG8_WAIT_V(6); PG8_BAR;
    }
    for (;;) {
        const bool has_next = S.next(ui + 1, nxt);
        const char* nA = has_next ? (const char*)g.A + (size_t)nxt.pm * tstep : cA; const char* nB = has_next ? (const char*)g.Bt + (size_t)nxt.pn * tstep : cB;
        for (int t = 0; t < nt; t += 2) {
            const bool last = (t == nt - 2);
            const char* a1 = cA + (size_t)(t + 1) * kstep;
            const char* a2 = last ? nA : cA + (size_t)(t + 2) * kstep; const char* b2 = last ? nB : cB + (size_t)(t + 2) * kstep;
            const char* a3 = a2 + kstep; const char* b3 = b2 + kstep;
            if (last && has_next) S.a_ready(nxt);
            if constexpr (SP2) {
            PG8_LDB(B0, 0, 0); PG8_LDB(B1, 0, 1); PG8_SCHED; PG8_LDA(At, 0, 0); PG8_STAGE(PG8_SA(1, 1), a1 + hstep, voffA);
            PG8_WAIT_V(8); PG8_WAIT_L(0); PG8_BAR; PG8_MMA(0, 0, At, B0); PG8_MMA(0, 1, At, B1); PG8_BAR; PG8_SCHED;
            PG8_LDA(At, 0, 1); PG8_STAGE(PG8_SB(0, 0), b2, voffB); PG8_STAGE(PG8_SB(0, 1), b2 + hstep, voffB); PG8_STAGE(PG8_SA(0, 0), a2, voffA);
            PG8_WAIT_V(8); PG8_WAIT_L(0); PG8_BAR; PG8_MMA(1, 0, At, B0); PG8_MMA(1, 1, At, B1); PG8_BAR; PG8_SCHED;
            PG8_LDB(B0, 1, 0); PG8_LDB(B1, 1, 1); PG8_SCHED; PG8_LDA(At, 1, 0); PG8_STAGE(PG8_SA(0, 1), a2 + hstep, voffA);
            PG8_WAIT_V(8); PG8_WAIT_L(0); PG8_BAR; PG8_MMA(0, 0, At, B0); PG8_MMA(0, 1, At, B1); PG8_BAR; PG8_SCHED;
            PG8_LDA(At, 1, 1); PG8_STAGE(PG8_SB(1, 0), b3, voffB); PG8_STAGE(PG8_SB(1, 1), b3 + hstep, voffB); PG8_STAGE(PG8_SA(1, 0), a3, voffA);
            PG8_WAIT_V(8); PG8_WAIT_L(0); PG8_BAR; PG8_MMA(1, 0, At, B0); PG8_MMA(1, 1, At, B1); PG8_BAR; PG8_SCHED;
            } else {
            PG8_LDB(B0, 0, 0); PG8_SCHED; PG8_LDA(At, 0, 0); PG8_STAGE(PG8_SA(1, 1), a1 + hstep, voffA);
            PG8_WAIT_L(8); PG8_BAR; PG8_WAIT_L(0); PG8_MMA(0, 0, At, B0); PG8_BAR; PG8_SCHED;
            PG8_LDB(B1, 0, 1); PG8_STAGE(PG8_SB(0, 0), b2, voffB);
            PG8_BAR; PG8_WAIT_L(0); PG8_MMA(0, 1, At, B1); PG8_BAR;
            PG8_LDA(At, 0, 1); PG8_STAGE(PG8_SA(0, 0), a2, voffA);
            PG8_BAR; PG8_WAIT_L(0); PG8_MMA(1, 0, At, B0); PG8_BAR; PG8_SCHED;
            PG8_STAGE(PG8_SB(0, 1), b2 + hstep, voffB);
            PG8_WAIT_V(6); PG8_BAR; PG8_MMA(1, 1, At, B1); PG8_BAR;
            PG8_LDB(B0, 1, 0); PG8_SCHED; PG8_LDA(At, 1, 0); PG8_STAGE(PG8_SA(0, 1), a2 + hstep, voffA);
            PG8_WAIT_L(8); PG8_BAR; PG8_WAIT_L(0); PG8_MMA(0, 0, At, B0); PG8_BAR; PG8_SCHED;
            PG8_LDB(B1, 1, 1); PG8_STAGE(PG8_SB(1, 0), b3, voffB);
            PG8_BAR; PG8_WAIT_L(0); PG8_MMA(0, 1, At, B1); PG8_BAR;
            PG8_LDA(At, 1, 1); PG8_STAGE(PG8_SA(1, 0), a3, voffA);
            PG8_BAR; PG8_WAIT_L(0); PG8_MMA(1, 0, At, B0); PG8_BAR; PG8_SCHED;
            PG8_STAGE(PG8_SB(1, 1), b3 + hstep, voffB);
            PG8_WAIT_V(6); PG8_BAR; PG8_MMA(1, 1, At, B1); PG8_BAR;
            }
        }
        if constexpr (ALIGN_EPI) { if (wr == 0) PG8_BAR; }
        if constexpr (!Epi::AFTER_DRAIN) { E(acc, cur, wr, wc, fr, fq); S.done(cur); }
        if (!has_next) break;
#pragma unroll
        for (int a = 0; a < 2; ++a)
#pragma unroll
            for (int b = 0; b < 2; ++b)
#pragma unroll
                for (int m = 0; m < 4; ++m)
#pragma unroll
                    for (int n = 0; n < 2; ++n) acc[a][b][m][n] = (f32x4){0.f, 0.f, 0.f, 0.f};
        cur = nxt; cA = nA; cB = nB; ++ui;
        if constexpr (ALIGN_EPI) { if (wr == 1) PG8_BAR; }
    }
    PG8_WAIT_V(0);
    if constexpr (!ALIGN_EPI) { if (wr == 0) PG8_BAR; }
    PG8_BAR;
    if constexpr (Epi::AFTER_DRAIN) { E.fused(acc, cur, wr, wc, fr, fq, lds, wid, lane); S.done(cur); }
#undef PG8_SA
#undef PG8_SB
#undef PG8_STAGE
#undef PG8_LDA
#undef PG8_LDB
#undef PG8_MMA
#undef PG8_WAIT_V
#undef PG8_WAIT_L
#undef PG8_BAR
#undef PG8_SCHED
}
}
#ifndef HD
#define HD __host__ __device__ __forceinline__
#endif
HD int tk_map(float f) { int b = __builtin_bit_cast(int, f); return b ^ ((b >> 31) & 0x7fffffff); }
HD float tk_unmap(int k) { int b = k ^ ((k >> 31) & 0x7fffffff); return __builtin_bit_cast(float, b); }
HD void tk_cx(int& a, int& b) { const int hi = a > b ? a : b, lo = a > b ? b : a; a = hi; b = lo; }
template <int N> HD void tk_sort_desc(int (&v)[N]) {
#pragma unroll
    for (int k = 2; k <= N; k <<= 1)
#pragma unroll
        for (int j = k >> 1; j > 0; j >>= 1)
#pragma unroll
            for (int i = 0; i < N; ++i) { const int l = i ^ j; if (l > i) { if ((i & k) == 0) tk_cx(v[i], v[l]); else tk_cx(v[l], v[i]); } }
}
template <int N> HD void tk_merge_top(int (&a)[N], const int (&b)[N]) {
#pragma unroll
    for (int i = 0; i < N; ++i) a[i] = a[i] > b[N - 1 - i] ? a[i] : b[N - 1 - i];
#pragma unroll
    for (int j = N >> 1; j > 0; j >>= 1)
#pragma unroll
        for (int i = 0; i < N; ++i) { const int l = i ^ j; if (l > i) tk_cx(a[i], a[l]); }
}
template <int NCH, class FP> HD void tk_stage1(FP s, int n_base, int (&best)[16]) {
#pragma unroll
    for (int c = 0; c < NCH; ++c) {
        int x[16];
#pragma unroll
        for (int e = 0; e < 16; ++e) x[e] = (tk_map(s[c * 16 + e]) & ~127) | (127 - (n_base + c * 16 + e));
        tk_sort_desc(x);
        if (c == 0) {
#pragma unroll
            for (int e = 0; e < 16; ++e) best[e] = x[e];
        } else tk_merge_top(best, x);
    }
}
template <class IP, class OI, class OG> HD void tk_stage2(int (&a)[16], int (&b)[16], IP AB, OI out_idx, OG out_g, float vscale = 1.0f) {
    float va[16], vb[16];
#pragma unroll
    for (int i = 0; i < 16; ++i) { AB[i] = a[i]; AB[16 + i] = b[i]; va[i] = tk_unmap(a[i] & ~127); vb[i] = tk_unmap(b[i] & ~127); }
    int best[16];
#pragma unroll
    for (int c = 0; c < 4; ++c) {
        int x[16];
#pragma unroll
        for (int e = 0; e < 16; ++e) x[e] = (int)0x80000000;
        int n = 0;
#pragma unroll
        for (int i = 0; i < 16; ++i)
#pragma unroll
            for (int j = 0; j < 16; ++j)
                if ((i + 1) * (j + 1) <= 16) { if (n >= 16 * c && n < 16 * c + 16) x[n - 16 * c] = (tk_map(va[i] + vb[j]) & ~255) | (255 - (i * 16 + j)); ++n; }
        tk_sort_desc(x);
        if (c == 0) {
#pragma unroll
            for (int e = 0; e < 16; ++e) best[e] = x[e];
        } else tk_merge_top(best, x);
    }
    int ka[16], kb[16];
#pragma unroll
    for (int k = 0; k < 16; ++k) { const int flat = 255 - (best[k] & 255); ka[k] = AB[flat >> 4]; kb[k] = AB[16 + (flat & 15)]; }
    float sv[16]; int ei[16]; float sum = 0.f;
#pragma unroll
    for (int k = 0; k < 16; ++k) { ei[k] = (127 - (ka[k] & 127)) * 128 + (127 - (kb[k] & 127)); sv[k] = (tk_unmap(ka[k] & ~127) + tk_unmap(kb[k] & ~127)) * vscale; }
    const float m = sv[0];
#pragma unroll
    for (int k = 0; k < 16; ++k) { sv[k] = __expf(sv[k] - m); sum += sv[k]; }
    const float inv = 1.0f / sum;
#pragma unroll
    for (int k = 0; k < 16; ++k) { out_idx[k] = ei[k]; out_g[k] = sv[k] * inv; }
}
constexpr int NWAVES = 8, NTHR = 512;
constexpr int BATCH = 2, SEQ = 8192, D = 1024, M = BATCH * SEQ, DEPTH = 4;
constexpr int NH = 16, HDIM = 64, GRIDW = 64, NROWS = 128;
constexpr float RMS_EPS = 1e-6f;
#ifndef MK_N_LAUNCHES
#define MK_N_LAUNCHES 1
#endif
#ifndef NAIVE_ATTN
#define NAIVE_ATTN 0
#endif
#ifndef NAIVE_TOPK
#define NAIVE_TOPK 0
#endif
#ifndef EXPERT_FP4
#define EXPERT_FP4 1
#endif
constexpr int ROWB = EXPERT_FP4 ? 512 : 1024;
#ifndef PROBE_GMODE
#define PROBE_GMODE 0
#endif
#ifndef PROBE_PMODE
#define PROBE_PMODE 0
#endif
#ifndef PROBE_LMASK
#define PROBE_LMASK 15
#endif
#ifndef PROBE_REP
#define PROBE_REP -1
#endif
constexpr int PH_PER_LAYER = 7, N_PHASES = 1 + DEPTH * PH_PER_LAYER;

constexpr size_t MiB = 1u << 20;
constexpr size_t WS_CTL = 0, CTL_ZERO_BYTES = 32 * 1024;
constexpr size_t WS_WQK = 2 * MiB;
constexpr size_t WS_WV = 10 * MiB;
constexpr size_t WS_WO = 14 * MiB;
constexpr size_t WS_WIN = 18 * MiB;
constexpr size_t WS_WOUT = 30 * MiB;
constexpr size_t WS_WP = 34 * MiB;
constexpr size_t WS_H = 64 * MiB;
constexpr size_t WS_HN = 128 * MiB;
constexpr size_t WS_BIG = 160 * MiB;
constexpr size_t WS_VT = 224 * MiB;
constexpr size_t WS_MIX = 256 * MiB;
constexpr size_t WS_SELI = 288 * MiB;
constexpr size_t WS_SELG = 296 * MiB;
constexpr size_t WS_UP = 320 * MiB;
constexpr size_t WS_DN = 384 * MiB;
constexpr size_t WS_SUP = 448 * MiB;
constexpr size_t WS_SDN = 449 * MiB;
constexpr size_t WS_RSS = 450 * MiB;
constexpr size_t WS_SC = 576 * MiB;
constexpr size_t WS_END = 704 * MiB;
constexpr int CW_BAR = 4096;
static_assert((CW_BAR + 3456) * 4 <= (int)CTL_ZERO_BYTES, "barrier words inside the per-call memset");

constexpr int LDS_BYTES = 163840, MISC_OFF = LDS_BYTES - 256, PTAB_OFF = LDS_BYTES - 512;

#define LAS __attribute__((address_space(3)))
typedef unsigned short bf16;
typedef unsigned v4u __attribute__((ext_vector_type(4)));
typedef unsigned v2u __attribute__((ext_vector_type(2)));
typedef float f32x4 __attribute__((ext_vector_type(4)));
typedef short bf16x8 __attribute__((ext_vector_type(8)));
#define LDS_WAIT() asm volatile("s_waitcnt lgkmcnt(0)" ::: "memory")
#define BLOCK_BAR() do { asm volatile("s_waitcnt vmcnt(0) lgkmcnt(0)" ::: "memory"); __builtin_amdgcn_s_barrier(); asm volatile("" ::: "memory"); } while (0)
__device__ __forceinline__ unsigned f2bf(float f) { unsigned u = __builtin_bit_cast(unsigned, f); return (u + 0x7fffu + ((u >> 16) & 1u)) >> 16; }
typedef float f32x2p __attribute__((ext_vector_type(2))); typedef __bf16 bf16x2p __attribute__((ext_vector_type(2)));
__device__ __forceinline__ unsigned pk2(float lo, float hi) { const f32x2p v = {lo, hi}; return __builtin_bit_cast(unsigned, __builtin_convertvector(v, bf16x2p)); }
__device__ __forceinline__ float bflo(unsigned u) { return __builtin_bit_cast(float, u << 16); }
__device__ __forceinline__ float bfhi(unsigned u) { return __builtin_bit_cast(float, u & 0xffff0000u); }
__device__ __forceinline__ float wave_sum(float v) {
#pragma unroll
    for (int o = 1; o < 64; o <<= 1) v += __shfl_xor(v, o);
    return v;
}

#define XB_TMO      128
#define XB_XCNT(j)  (256  + 64 * (j))
#define XB_XSUB(j)  (1280 + 64 * (j))
#define XB_XGEN(j)  (2304 + 64 * (j))
#define XB_TOP      3328
#define XB_TOPGEN   3392
#define XCD_BAR_WORDS 3456
#define XB_SPIN_CAP (1u << 20)
__device__ __forceinline__ unsigned xb_ld(unsigned* p)              { return __hip_atomic_load(p, __ATOMIC_RELAXED, __HIP_MEMORY_SCOPE_AGENT); }
__device__ __forceinline__ unsigned xb_add(unsigned* p, unsigned v) { return __hip_atomic_fetch_add(p, v, __ATOMIC_RELAXED, __HIP_MEMORY_SCOPE_AGENT); }
__device__ __forceinline__ unsigned xb_xcc_id() { return (unsigned)__builtin_amdgcn_s_getreg((3 << 11) | 20) & 0xFu; }
#define XB_SPIN(cond, bar) do { unsigned _sp = 0; while (cond) { __builtin_amdgcn_s_sleep(1); \
    if ((++_sp & 255u) == 0u) { if (xb_ld(&(bar)[XB_TMO])) break; if (_sp > XB_SPIN_CAP) { atomicAdd(&(bar)[XB_TMO], 1u); break; } } } } while (0)
struct XcdBarrier { unsigned* bar; unsigned x; volatile LAS unsigned* st; };
__device__ __forceinline__ XcdBarrier xcd_barrier_post(unsigned* bar, volatile LAS unsigned* st) {
    XcdBarrier b; b.bar = bar; b.x = xb_xcc_id(); b.st = st;
    if (threadIdx.x == 0) (void)xb_add(&bar[XB_XCNT(b.x)], 1u);
    return b;
}
__device__ __forceinline__ void xcd_barrier_complete(unsigned* bar, unsigned x, unsigned& nloc, unsigned& nx) {
    const unsigned G = gridDim.x * gridDim.y * gridDim.z;
    unsigned sum, cnt, mine, sp = 0u;
    for (;;) {
        sum = 0u; cnt = 0u; mine = 0u;
#pragma unroll
        for (unsigned j = 0; j < 16; ++j) { const unsigned c = xb_ld(&bar[XB_XCNT(j)]); sum += c; cnt += (c > 0u) ? 1u : 0u; mine = (j == x) ? c : mine; }
        if (sum == G) break;
        __builtin_amdgcn_s_sleep(1);
        if ((++sp & 255u) == 0u) { if (xb_ld(&bar[XB_TMO])) break; if (sp > XB_SPIN_CAP) { atomicAdd(&bar[XB_TMO], 1u); break; } }
    }
    nloc = mine > 0u ? mine : 1u; nx = cnt > 0u ? cnt : 1u;
}
__device__ __forceinline__ void xcd_barrier(const XcdBarrier& b) {
    asm volatile("s_waitcnt vmcnt(0)" ::: "memory");
    __syncthreads();
    if (threadIdx.x == 0) {
        unsigned* bar = b.bar;
        __builtin_amdgcn_s_waitcnt(0);
        unsigned nloc = b.st[0], nx = b.st[1];
        if (nloc == 0u) { xcd_barrier_complete(bar, b.x, nloc, nx); b.st[0] = nloc; b.st[1] = nx; }
        const unsigned old = xb_add(&bar[XB_XSUB(b.x)], 1u);
        const unsigned gen = old / nloc;
        if (old + 1u == (gen + 1u) * nloc) {
            __builtin_amdgcn_fence(__ATOMIC_RELEASE, "agent");
            asm volatile("s_waitcnt vmcnt(0)" ::: "memory");
            const unsigned og = xb_add(&bar[XB_TOP], 1u);
            const unsigned tg = og / nx;
            if (og + 1u == (tg + 1u) * nx) xb_add(&bar[XB_TOPGEN], 1u);
            else XB_SPIN(xb_ld(&bar[XB_TOPGEN]) == tg, bar);
            __builtin_amdgcn_fence(__ATOMIC_ACQUIRE, "agent");
            xb_add(&bar[XB_XGEN(b.x)], 1u);
            asm volatile("s_waitcnt vmcnt(0)" ::: "memory");
        } else {
            XB_SPIN(xb_ld(&bar[XB_XGEN(b.x)]) == gen, bar);
            __builtin_amdgcn_fence(__ATOMIC_ACQUIRE, "agent");
            asm volatile("s_waitcnt vmcnt(0)" ::: "memory");
        }
    }
    __syncthreads();
}

struct Frame {
    LAS unsigned char* lds;
    int tid, lane, wave, vcu, G;
    unsigned char* ws;
    __device__ __forceinline__ const float* in(int i) const {
        const volatile LAS unsigned* t = (const volatile LAS unsigned*)(lds + PTAB_OFF);
        const unsigned lo = __builtin_amdgcn_readfirstlane(t[2 * i]), hi = __builtin_amdgcn_readfirstlane(t[2 * i + 1]);
        return (const float*)(const __attribute__((address_space(1))) float*)(((unsigned long long)hi << 32) | lo);
    }
    __device__ __forceinline__ float* out() const { return (float*)in(14); }
};

struct EpiRes {
    static constexpr bool PERM = false, AFTER_DRAIN = false;
    const float* hin; float* h; bf16* hn; const float* gain; float* rss;
    __device__ __forceinline__ void operator()(const pg8::f32x4 (&acc)[2][2][4][2], const pg8::Unit& u, int wr, int wc, int fr, int fq) const {
        const int col0 = u.pn * 256 + wc * 32 + 4 * fq;
        f32x4 gv[2][2];
#pragma unroll
        for (int bj = 0; bj < 2; ++bj)
#pragma unroll
            for (int n = 0; n < 2; ++n) gv[bj][n] = *(const f32x4*)(gain + col0 + bj * 128 + n * 16);
#pragma unroll
        for (int ai = 0; ai < 2; ++ai)
#pragma unroll
            for (int m = 0; m < 4; ++m) { const int row = u.pm * 256 + ai * 128 + wr * 64 + m * 16 + fr; float* rowp = h + (size_t)row * D + col0; const float* rowi = hin + (size_t)row * D + col0; bf16* hrow = hn + (size_t)row * D + col0;
                float ss = 0.f;
#pragma unroll
                for (int bj = 0; bj < 2; ++bj)
#pragma unroll
                    for (int n = 0; n < 2; ++n) { f32x4* p = (f32x4*)(rowp + bj * 128 + n * 16); f32x4 v = *(const f32x4*)(rowi + bj * 128 + n * 16); v += acc[ai][bj][m][n]; *p = v;
                        ss += (v.x * v.x + v.y * v.y) + (v.z * v.z + v.w * v.w);
                        const f32x4 y = v * gv[bj][n]; v2u w; w.x = pk2(y.x, y.y); w.y = pk2(y.z, y.w); *(v2u*)(hrow + bj * 128 + n * 16) = w; }
                ss += __shfl_xor(ss, 16); ss += __shfl_xor(ss, 32);
                if (fq == 0) rss[(size_t)row * 16 + u.pn * 4 + wc] = ss; }
    }
};
struct EpiConvIn {
    static constexpr bool PERM = true, AFTER_DRAIN = false;
    bf16* U; bf16* GB;
    __device__ __forceinline__ void operator()(const pg8::f32x4 (&acc)[2][2][4][2], const pg8::Unit& u, int wr, int wc, int fr, int fq) const {
        const int row0 = u.pm * 256 + wr * 64 + fr;
        if (u.pn < 8) {
            const int ch0 = u.pn * 128 + wc * 32 + 8 * fq;
#pragma unroll
            for (int ai = 0; ai < 2; ++ai)
#pragma unroll
                for (int m = 0; m < 4; ++m) { const f32x4 p0 = acc[ai][0][m][0] * acc[ai][1][m][0], p1 = acc[ai][0][m][1] * acc[ai][1][m][1];
                    v4u w; w.x = pk2(p0[0], p0[1]); w.y = pk2(p0[2], p0[3]); w.z = pk2(p1[0], p1[1]); w.w = pk2(p1[2], p1[3]);
                    *(v4u*)(U + (size_t)(row0 + ai * 128 + m * 16) * D + ch0) = w; }
        } else {
            const int col0 = (u.pn - 8) * 256 + wc * 32 + 8 * fq;
#pragma unroll
            for (int ai = 0; ai < 2; ++ai)
#pragma unroll
                for (int m = 0; m < 4; ++m)
#pragma unroll
                    for (int bj = 0; bj < 2; ++bj) { const f32x4 v0 = acc[ai][bj][m][0], v1 = acc[ai][bj][m][1];
                        v4u w; w.x = pk2(v0[0], v0[1]); w.y = pk2(v0[2], v0[3]); w.z = pk2(v1[0], v1[1]); w.w = pk2(v1[2], v1[3]);
                        *(v4u*)(GB + (size_t)(row0 + ai * 128 + m * 16) * D + col0 + bj * 128) = w; }
        }
    }
};
struct EpiF32 {
    static constexpr bool PERM = false, AFTER_DRAIN = false;
    float* O; int ldc;
    __device__ __forceinline__ void operator()(const pg8::f32x4 (&acc)[2][2][4][2], const pg8::Unit& u, int wr, int wc, int fr, int fq) const {
        const int col0 = u.pn * 256 + wc * 32 + 4 * fq;
#pragma unroll
        for (int ai = 0; ai < 2; ++ai)
#pragma unroll
            for (int m = 0; m < 4; ++m) { float* rowp = O + (size_t)(u.pm * 256 + ai * 128 + wr * 64 + m * 16 + fr) * ldc + col0;
#pragma unroll
                for (int bj = 0; bj < 2; ++bj)
#pragma unroll
                    for (int n = 0; n < 2; ++n) *(f32x4*)(rowp + bj * 128 + n * 16) = acc[ai][bj][m][n]; }
    }
};
struct EpiTopK {
    static constexpr bool PERM = false, AFTER_DRAIN = true;
    int* seli; float* selg; const float* rss;
    __device__ __forceinline__ void operator()(const pg8::f32x4 (&)[2][2][4][2], const pg8::Unit&, int, int, int, int) const {}
    __device__ __forceinline__ void fused(pg8::f32x4 (&acc)[2][2][4][2], const pg8::Unit& u, int wr, int wc, int fr, int fq, LAS unsigned char* lds, int wid, int lane) const {
        LAS float* S = (LAS float*)lds;
        LAS int* L = (LAS int*)lds;
        const int tid = wid * 64 + lane;
#pragma unroll 1
        for (int ai = 0; ai < 2; ++ai) {
#pragma unroll
            for (int m = 0; m < 4; ++m)
#pragma unroll
                for (int bj = 0; bj < 2; ++bj)
#pragma unroll
                    for (int n = 0; n < 2; ++n) {
                        const int row = wr * 64 + m * 16 + fr, col = bj * 128 + wc * 32 + n * 16 + 4 * fq;
                        *(LAS f32x4*)(S + row * 260 + col) = ai == 0 ? acc[0][bj][m][n] : acc[1][bj][m][n];
                    }
            BLOCK_BAR();
            const int row = tid & 127, q = tid >> 7;
            int best[16];
            {
                const LAS f32x4* sp = (const LAS f32x4*)(S + row * 260 + q * 64);
#pragma unroll
                for (int c = 0; c < 4; ++c) {
                    int x[16];
#pragma unroll
                    for (int e4 = 0; e4 < 4; ++e4) { const f32x4 v = sp[c * 4 + e4];
#pragma unroll
                        for (int e = 0; e < 4; ++e) x[e4 * 4 + e] = (tk_map(v[e]) & ~127) | (127 - ((q & 1) * 64 + c * 16 + e4 * 4 + e)); }
                    tk_sort_desc(x);
                    if (c == 0) {
#pragma unroll
                        for (int e = 0; e < 16; ++e) best[e] = x[e];
                    } else tk_merge_top(best, x);
                }
            }
            BLOCK_BAR();
#pragma unroll
            for (int e4 = 0; e4 < 4; ++e4) *(LAS v4u*)(L + row * 68 + q * 16 + e4 * 4) = (v4u){(unsigned)best[e4 * 4], (unsigned)best[e4 * 4 + 1], (unsigned)best[e4 * 4 + 2], (unsigned)best[e4 * 4 + 3]};
            BLOCK_BAR();
            if (tid < 128) {
                int a[16], b[16], t[16];
                LAS int* Lr = L + tid * 68;
#pragma unroll
                for (int e4 = 0; e4 < 4; ++e4) { const v4u va = *(LAS v4u*)(Lr + e4 * 4), vt = *(LAS v4u*)(Lr + 16 + e4 * 4);
#pragma unroll
                    for (int e = 0; e < 4; ++e) { a[e4 * 4 + e] = (int)va[e]; t[e4 * 4 + e] = (int)vt[e]; } }
                tk_merge_top(a, t);
#pragma unroll
                for (int e4 = 0; e4 < 4; ++e4) { const v4u vb = *(LAS v4u*)(Lr + 32 + e4 * 4), vt = *(LAS v4u*)(Lr + 48 + e4 * 4);
#pragma unroll
                    for (int e = 0; e < 4; ++e) { b[e4 * 4 + e] = (int)vb[e]; t[e4 * 4 + e] = (int)vt[e]; } }
                tk_merge_top(b, t);
                const int trow = u.pm * 256 + ai * 128 + tid;
                const f32x4 q0 = *(const f32x4*)(rss + (size_t)trow * 16), q1 = *(const f32x4*)(rss + (size_t)trow * 16 + 4), q2 = *(const f32x4*)(rss + (size_t)trow * 16 + 8), q3 = *(const f32x4*)(rss + (size_t)trow * 16 + 12);
                const float ssq = (((q0.x + q0.y) + (q0.z + q0.w)) + ((q1.x + q1.y) + (q1.z + q1.w))) + (((q2.x + q2.y) + (q2.z + q2.w)) + ((q3.x + q3.y) + (q3.z + q3.w)));
                const float rstd = 1.0f / sqrtf(ssq * (1.f / D) + RMS_EPS);
                const size_t o = ((size_t)trow * 8 + u.pn) * 16;
                tk_stage2(a, b, Lr, (__attribute__((address_space(1))) int*)(seli + o), (__attribute__((address_space(1))) float*)(selg + o), rstd);
            }
            BLOCK_BAR();
        }
    }
};
struct OneUnit {
    pg8::Unit u;
    __device__ __forceinline__ bool next(int i, pg8::Unit& o) const { if (i != 0) return false; o = u; return true; }
    __device__ __forceinline__ void a_ready(const pg8::Unit&) const {}
    __device__ __forceinline__ void done(const pg8::Unit&) const {}
};

__device__ __forceinline__ void p0_transpose_item(const float* W, int ldw, int ncols, bf16* WT, float scale, LAS float* scr, int item, int lane) {
    const int nblk = ncols / 64, kb = item / nblk, nb = item % nblk, k0 = 64 * kb, n0 = 64 * nb;
    f32x4 v[16];
#pragma unroll
    for (int i = 0; i < 16; ++i) v[i] = *(const f32x4*)(W + (size_t)(k0 + 4 * i + (lane >> 4)) * ldw + n0 + 4 * (lane & 15));
#pragma unroll
    for (int i = 0; i < 16; ++i) { LAS float* p = scr + (4 * i + (lane >> 4)) * 65 + 4 * (lane & 15); p[0] = v[i].x * scale; p[1] = v[i].y * scale; p[2] = v[i].z * scale; p[3] = v[i].w * scale; }
    LDS_WAIT(); asm volatile("" ::: "memory");
    const int c = lane & 7;
#pragma unroll
    for (int j = 0; j < 8; ++j) { const int n = (lane >> 3) + 8 * j; const LAS float* s = scr + (8 * c) * 65 + n;
        v4u o; o.x = pk2(s[0 * 65], s[1 * 65]); o.y = pk2(s[2 * 65], s[3 * 65]); o.z = pk2(s[4 * 65], s[5 * 65]); o.w = pk2(s[6 * 65], s[7 * 65]);
        *(v4u*)(WT + (size_t)(n0 + n) * 1024 + k0 + 8 * c) = o; }
    LDS_WAIT(); asm volatile("" ::: "memory");
}
__device__ __forceinline__ void rms_row_to_bf16(const float* xrow, const float* gain, bf16* orow, float* hcopy, int lane) {
    const f32x4* xr = (const f32x4*)xrow + lane; const f32x4* gr = (const f32x4*)gain + lane;
    f32x4 v[4]; float s = 0.f;
#pragma unroll
    for (int j = 0; j < 4; ++j) { v[j] = xr[64 * j]; s += (v[j].x * v[j].x + v[j].y * v[j].y) + (v[j].z * v[j].z + v[j].w * v[j].w); }
    if (hcopy) {
#pragma unroll
        for (int j = 0; j < 4; ++j) ((f32x4*)hcopy + lane)[64 * j] = v[j];
    }
    const float rstd = 1.0f / sqrtf(wave_sum(s) * (1.f / D) + RMS_EPS);
    unsigned long long* o8 = (unsigned long long*)orow + lane;
#pragma unroll
    for (int j = 0; j < 4; ++j) { const f32x4 g = gr[64 * j]; const f32x4 y = v[j] * rstd * g;
        o8[64 * j] = (unsigned long long)pk2(y.x, y.y) | ((unsigned long long)pk2(y.z, y.w) << 32); }
}
__device__ __forceinline__ void p0_prologue(Frame& F, bool dry) {
    if (!(dry && PROBE_PMODE == 1)) {
        LAS float* KL = (LAS float*)F.lds;
        LAS float* WL = (LAS float*)(F.lds + 128 * 132 * 4);
        const float* in10 = F.in(10); const float* in11 = F.in(11);
        f32x4 kreg[8], wreg[4];
#define FOLD_LOAD(it_) do { const int l_ = (it_) >> 8, hp_ = ((it_) >> 4) & 15, k0_ = ((it_) & 15) * 64; \
            const float* kg_ = in11 + (size_t)(l_ * 16 + hp_) * 128 * 128; const float* wg_ = in10 + (size_t)l_ * 1024 * 2048 + (size_t)k0_ * 2048 + hp_ * 128; \
            _Pragma("unroll") for (int i = 0; i < 8; ++i) kreg[i] = *(const f32x4*)(kg_ + 4 * (F.tid + 512 * i)); \
            _Pragma("unroll") for (int i = 0; i < 4; ++i) { const int e = 4 * (F.tid + 512 * i); wreg[i] = *(const f32x4*)(wg_ + (size_t)(e >> 7) * 2048 + (e & 127)); } } while (0)
        if (F.vcu < DEPTH * 16 * 16) FOLD_LOAD(F.vcu);
        for (int it = F.vcu; it < DEPTH * 16 * 16; it += F.G) {
            const int l = it >> 8, hp = (it >> 4) & 15, k0 = (it & 15) * 64;
#pragma unroll
            for (int i = 0; i < 8; ++i) { const int e = 4 * (F.tid + 512 * i), n = e >> 7, d = e & 127; *(LAS f32x4*)(KL + n * 132 + d) = kreg[i]; }
#pragma unroll
            for (int i = 0; i < 4; ++i) { const int e = 4 * (F.tid + 512 * i), kk = e >> 7, d = e & 127; *(LAS f32x4*)(WL + kk * 132 + d) = wreg[i]; }
            if (it + F.G < DEPTH * 16 * 16) FOLD_LOAD(it + F.G);
            BLOCK_BAR();
            {
                const int i16 = F.lane & 15, g4 = F.lane >> 4, nt = F.wave;
                f32x4 facc[4];
#pragma unroll
                for (int mt = 0; mt < 4; ++mt) facc[mt] = (f32x4){0.f, 0.f, 0.f, 0.f};
#pragma unroll 2
                for (int s8 = 0; s8 < 8; ++s8) {
                    const f32x4 bq = *(const LAS f32x4*)(KL + (nt * 16 + i16) * 132 + 16 * s8 + 4 * g4);
                    f32x4 aq[4];
#pragma unroll
                    for (int mt = 0; mt < 4; ++mt) aq[mt] = *(const LAS f32x4*)(WL + (mt * 16 + i16) * 132 + 16 * s8 + 4 * g4);
#pragma unroll
                    for (int t = 0; t < 4; ++t)
#pragma unroll
                        for (int mt = 0; mt < 4; ++mt) facc[mt] = __builtin_amdgcn_mfma_f32_16x16x4f32(aq[mt][t], bq[t], facc[mt], 0, 0, 0);
                }
                bf16* o = (bf16*)(F.ws + WS_WP) + (size_t)l * 2048 * 1024 + (size_t)(hp * 128 + nt * 16 + i16) * 1024 + k0 + 4 * g4;
#pragma unroll
                for (int mt = 0; mt < 4; ++mt) { v2u w; w.x = pk2(facc[mt][0], facc[mt][1]); w.y = pk2(facc[mt][2], facc[mt][3]); *(v2u*)(o + mt * 16) = w; }
            }
            BLOCK_BAR();
        }
#undef FOLD_LOAD
    }
    LAS float* scr = (LAS float*)(F.lds + F.wave * 16640);
    const int gw = F.vcu * NWAVES + F.wave, NGW = F.G * NWAVES;
    constexpr int I_SQ = 16 * 16, I_IN = 16 * 48, PER_J = 3 * I_SQ + I_SQ + I_IN + I_SQ;
    if (!(dry && PROBE_PMODE == 2)) for (int it = gw; it < 2 * PER_J; it += NGW) {
        const int j = it / PER_J; int r = it % PER_J;
        const float* wqkv = F.in(4) + (size_t)j * 1024 * 3072;
        if (r < I_SQ) { p0_transpose_item(wqkv, 3072, 1024, (bf16*)(F.ws + WS_WQK) + (size_t)j * 2048 * 1024, 0.125f, scr, r, F.lane); continue; } r -= I_SQ;
        if (r < I_SQ) { p0_transpose_item(wqkv + 1024, 3072, 1024, (bf16*)(F.ws + WS_WQK) + (size_t)j * 2048 * 1024 + (size_t)1024 * 1024, 1.f, scr, r, F.lane); continue; } r -= I_SQ;
        if (r < I_SQ) { p0_transpose_item(wqkv + 2048, 3072, 1024, (bf16*)(F.ws + WS_WV) + (size_t)j * 1024 * 1024, 1.f, scr, r, F.lane); continue; } r -= I_SQ;
        if (r < I_SQ) { p0_transpose_item(F.in(5) + (size_t)j * 1024 * 1024, 1024, 1024, (bf16*)(F.ws + WS_WO) + (size_t)j * 1024 * 1024, 1.f, scr, r, F.lane); continue; } r -= I_SQ;
        if (r < I_IN) {
            const float* win = F.in(7) + (size_t)j * 1024 * 3072; bf16* wt = (bf16*)(F.ws + WS_WIN) + (size_t)j * 3072 * 1024;
            if (r < 512) { const int blk = r >> 5, pn = blk >> 1, which = blk & 1; p0_transpose_item(win + (which ? 2048 : 1024) + 128 * pn, 3072, 128, wt + (size_t)(256 * pn + 128 * which) * 1024, 1.f, scr, r & 31, F.lane); }
            else p0_transpose_item(win, 3072, 1024, wt + (size_t)2048 * 1024, 1.f, scr, r - 512, F.lane);
            continue; } r -= I_IN;
        p0_transpose_item(F.in(9) + (size_t)j * 1024 * 1024, 1024, 1024, (bf16*)(F.ws + WS_WOUT) + (size_t)j * 1024 * 1024, 1.f, scr, r, F.lane);
    }
    if (!(dry && PROBE_PMODE == 3)) {
        constexpr int NROW = DEPTH * 16384;
        const float* in12 = F.in(12); const float* in13 = F.in(13);
#define XC_LOAD(v, r0_) do { const int tb_ = (r0_) >= NROW ? 1 : 0, rr_ = (r0_) - tb_ * NROW; const float* src_ = (tb_ ? in13 : in12) + (size_t)rr_ * 1024 + 16 * F.lane; \
            _Pragma("unroll") for (int u = 0; u < 4; ++u) _Pragma("unroll") for (int i = 0; i < 4; ++i) v[u][i] = *(const f32x4*)(src_ + (size_t)u * 1024 + 4 * i); } while (0)
#if EXPERT_FP4
#define XC_PACK(v, u, q, dstp) do { v2u w_; _Pragma("unroll") for (int jj = 0; jj < 2; ++jj) { unsigned t_ = 0u; \
                    t_ = __builtin_amdgcn_cvt_scalef32_pk_fp4_f32(t_, v[u][2 * jj].x * q, v[u][2 * jj].y * q, 1.0f, 0); t_ = __builtin_amdgcn_cvt_scalef32_pk_fp4_f32(t_, v[u][2 * jj].z * q, v[u][2 * jj].w * q, 1.0f, 1); \
                    t_ = __builtin_amdgcn_cvt_scalef32_pk_fp4_f32(t_, v[u][2 * jj + 1].x * q, v[u][2 * jj + 1].y * q, 1.0f, 2); t_ = __builtin_amdgcn_cvt_scalef32_pk_fp4_f32(t_, v[u][2 * jj + 1].z * q, v[u][2 * jj + 1].w * q, 1.0f, 3); w_[jj] = t_; } \
                *(v2u*)(dstp) = w_; } while (0)
        constexpr float QMAX = 6.0f;
#else
#define XC_PACK(v, u, q, dstp) do { v4u w_; _Pragma("unroll") for (int i = 0; i < 4; ++i) { unsigned t_ = 0u; t_ = __builtin_amdgcn_cvt_pk_fp8_f32(v[u][i].x * q, v[u][i].y * q, t_, false); t_ = __builtin_amdgcn_cvt_pk_fp8_f32(v[u][i].z * q, v[u][i].w * q, t_, true); w_[i] = t_; } \
                *(v4u*)(dstp) = w_; } while (0)
        constexpr float QMAX = 256.0f;
#endif
#define XC_I4(x_) ((unsigned)__float2int_rn(x_) & 15u)
#define XC_PACK_I4(v, u, q, dstp) do { v2u w_; _Pragma("unroll") for (int jj = 0; jj < 2; ++jj) { const f32x4 a_ = v[u][2 * jj] * q, b_ = v[u][2 * jj + 1] * q; \
                    w_[jj] = XC_I4(a_.x) | (XC_I4(a_.y) << 4) | (XC_I4(a_.z) << 8) | (XC_I4(a_.w) << 12) | (XC_I4(b_.x) << 16) | (XC_I4(b_.y) << 20) | (XC_I4(b_.z) << 24) | (XC_I4(b_.w) << 28); } \
                *(v2u*)(dstp) = w_; } while (0)
#define XC_CONV(v, r0_) do { const int tb_ = (r0_) >= NROW ? 1 : 0, rr_ = (r0_) - tb_ * NROW; \
            unsigned char* dst_ = F.ws + (tb_ ? WS_DN : WS_UP) + (size_t)rr_ * ROWB + (ROWB / 64) * F.lane; float* sc_ = (float*)(F.ws + (tb_ ? WS_SDN : WS_SUP)) + rr_; \
            _Pragma("unroll") for (int u = 0; u < 4; ++u) { float mx = 0.f; \
                _Pragma("unroll") for (int i = 0; i < 4; ++i) mx = fmaxf(fmaxf(mx, fmaxf(fabsf(v[u][i].x), fabsf(v[u][i].y))), fmaxf(fabsf(v[u][i].z), fabsf(v[u][i].w))); \
                _Pragma("unroll") for (int o = 1; o < 64; o <<= 1) mx = fmaxf(mx, __shfl_xor(mx, o)); \
                if (tb_) { const float q = mx > 0.f ? 7.0f / mx : 1.0f; XC_PACK_I4(v, u, q, dst_ + (size_t)u * ROWB); if (F.lane == 0) sc_[u] = mx > 0.f ? mx * (1.0f / 7.0f) : 1.0f; } \
                else { const float q = mx > 0.f ? QMAX / mx : 1.0f; XC_PACK(v, u, q, dst_ + (size_t)u * ROWB); if (F.lane == 0) sc_[u] = mx > 0.f ? mx * (1.0f / QMAX) : 1.0f; } } } while (0)
        const int stepr = NGW * 4;
        f32x4 va[4][4], vb[4][4];
        int r0 = gw * 4;
        if (r0 < 2 * NROW) XC_LOAD(va, r0);
#pragma unroll 1
        for (; r0 < 2 * NROW; r0 += 2 * stepr) {
            if (r0 + stepr < 2 * NROW) XC_LOAD(vb, r0 + stepr);
            XC_CONV(va, r0);
            if (r0 + 2 * stepr < 2 * NROW) XC_LOAD(va, r0 + 2 * stepr);
            if (r0 + stepr < 2 * NROW) XC_CONV(vb, r0 + stepr);
        }
#undef XC_LOAD
#undef XC_PACK
#undef XC_PACK_I4
#undef XC_I4
#undef XC_CONV
    }
    if (!(dry && PROBE_PMODE == 4)) {
        const float* x0 = F.in(0); const f32x4* gr = (const f32x4*)F.in(1) + F.lane;
        f32x4 gq[4];
#pragma unroll
        for (int j = 0; j < 4; ++j) gq[j] = gr[64 * j];
#pragma unroll 1
        for (int m0 = gw; m0 < M; m0 += 4 * NGW) {
            f32x4 v[4][4];
#pragma unroll
            for (int u = 0; u < 4; ++u) { const int m = m0 + u * NGW; if (m < M) {
#pragma unroll
                for (int j = 0; j < 4; ++j) v[u][j] = ((const f32x4*)(x0 + (size_t)m * D) + F.lane)[64 * j]; } }
#pragma unroll
            for (int u = 0; u < 4; ++u) { const int m = m0 + u * NGW; if (m < M) {
                float sq = 0.f;
#pragma unroll
                for (int j = 0; j < 4; ++j) { sq += (v[u][j].x * v[u][j].x + v[u][j].y * v[u][j].y) + (v[u][j].z * v[u][j].z + v[u][j].w * v[u][j].w); }
                const float rstd = 1.0f / sqrtf(wave_sum(sq) * (1.f / D) + RMS_EPS);
                unsigned long long* o8 = (unsigned long long*)((bf16*)(F.ws + WS_HN) + (size_t)m * D) + F.lane;
#pragma unroll
                for (int j = 0; j < 4; ++j) { const f32x4 y = v[u][j] * rstd * gq[j]; o8[64 * j] = (unsigned long long)pk2(y.x, y.y) | ((unsigned long long)pk2(y.z, y.w) << 32); } } }
        }
    }
}

__device__ __forceinline__ void norm_phase(Frame& F, const float* gain) {
    const int gw = F.vcu * NWAVES + F.wave, NGW = F.G * NWAVES;
    for (int m = gw; m < M; m += NGW) rms_row_to_bf16((const float*)(F.ws + WS_H) + (size_t)m * D, gain, (bf16*)(F.ws + WS_HN) + (size_t)m * D, nullptr, F.lane);
}
__device__ __forceinline__ void conv_phase(Frame& F, int j) {
    const bf16* U = (const bf16*)(F.ws + WS_BIG); const bf16* GB = (const bf16*)(F.ws + WS_BIG + 32 * MiB); bf16* mix = (bf16*)(F.ws + WS_MIX);
    const float* wc = F.in(8) + (size_t)j * 3 * 1024;
    for (int idx = F.vcu * NTHR + F.tid; idx < M * 128; idx += F.G * NTHR) {
        const int t = idx >> 7, c8 = (idx & 127) * 8, s = t & (SEQ - 1);
        const v4u gb = *(const v4u*)(GB + (size_t)t * D + c8);
        float conv[8];
#pragma unroll
        for (int e = 0; e < 8; ++e) conv[e] = 0.f;
#pragma unroll
        for (int dj = -1; dj <= 1; ++dj) {
            if (s + dj >= 0 && s + dj < SEQ) {
                const v4u uu = *(const v4u*)(U + (size_t)(t + dj) * D + c8);
                const f32x4 w0 = *(const f32x4*)(wc + (dj + 1) * 1024 + c8), w1 = *(const f32x4*)(wc + (dj + 1) * 1024 + c8 + 4);
#pragma unroll
                for (int e2 = 0; e2 < 4; ++e2) {
                    const float wl = e2 < 2 ? w0[2 * e2] : w1[2 * e2 - 4], wh = e2 < 2 ? w0[2 * e2 + 1] : w1[2 * e2 - 3];
                    conv[2 * e2] += wl * bflo(uu[e2]); conv[2 * e2 + 1] += wh * bfhi(uu[e2]);
                }
            }
        }
        v4u o;
#pragma unroll
        for (int e2 = 0; e2 < 4; ++e2) o[e2] = pk2(bflo(gb[e2]) * conv[2 * e2], bfhi(gb[e2]) * conv[2 * e2 + 1]);
        *(v4u*)(mix + (size_t)t * 1024 + c8) = o;
    }
}

constexpr int AT_KSTR = 144, AT_VSTR = 1168, AT_KOFF = 0, AT_VOFF = 576 * AT_KSTR, AT_BOFF = AT_VOFF + 64 * AT_VSTR;
static_assert(AT_BOFF + 1860 <= PTAB_OFF, "attention LDS map");
__device__ __forceinline__ void attn_phase(Frame& F, int j) {
    const bf16* QK = (const bf16*)(F.ws + WS_BIG); const bf16* VT = (const bf16*)(F.ws + WS_VT); bf16* mix = (bf16*)(F.ws + WS_MIX);
    const float* biasl = F.in(6) + (size_t)j * NH * 15 * 31;
    const int lane = F.lane, q = lane & 15, g = lane >> 4, tid = F.tid;
    LAS unsigned char* KL = F.lds + AT_KOFF; LAS unsigned char* VL = F.lds + AT_VOFF; LAS float* btab = (LAS float*)(F.lds + AT_BOFF);
    v4u kreg[9], vreg[9];
    int cur_hh = -1;
#define AT_DECODE(it, b_, hh_, r0_, R0_) const int hh_ = (it) & 15, rp_##it = ((it) >> 4) & 63, b_ = (it) >> 10, r0_ = 2 * rp_##it; int R0_ = r0_ - 4; R0_ = R0_ < 0 ? 0 : (R0_ > NROWS - 8 ? NROWS - 8 : R0_);
#define AT_PREFETCH(it) do { AT_DECODE(it, pb, phh, pr0, pR0) \
        _Pragma("unroll") for (int i = 0; i < 9; ++i) { const int c = tid + 512 * i; \
            { const int key = c >> 3, ch = c & 7; int row = pR0 + (key >> 6); row = row > NROWS - 1 ? NROWS - 1 : row; \
              kreg[i] = *(const v4u*)(QK + ((size_t)pb * SEQ + row * 64 + (key & 63)) * 2048 + 1024 + phh * 64 + ch * 8); } \
            { const int d = c / 72, kch = c - d * 72; vreg[i] = *(const v4u*)(VT + (size_t)(phh * 64 + d) * M + (size_t)pb * SEQ + pR0 * 64 + kch * 8); } } } while (0)
    int it = F.vcu;
    if (it < 2048) AT_PREFETCH(it);
    for (; it < 2048; it += F.G) {
        AT_DECODE(it, b, hh, r0, R0)
        BLOCK_BAR();
#pragma unroll
        for (int i = 0; i < 9; ++i) { const int c = tid + 512 * i;
            *(LAS v4u*)(KL + (c >> 3) * AT_KSTR + (c & 7) * 16) = kreg[i];
            const int d = c / 72, kch = c - d * 72; *(LAS v4u*)(VL + d * AT_VSTR + kch * 16) = vreg[i]; }
        if (hh != cur_hh) { if (tid < 465) btab[tid] = biasl[(size_t)hh * 465 + tid]; cur_hh = hh; }
        BLOCK_BAR();
        const int r = r0 + (F.wave >> 2), jb = F.wave & 3;
        int rs = r - 4; rs = rs < 0 ? 0 : (rs > NROWS - 8 ? NROWS - 8 : rs);
        const int lr0 = rs - R0;
        int bs = 16 * jb - 8; bs = bs < 0 ? 0 : (bs > 32 ? 32 : bs);
        const int qc = 16 * jb + q; int wst = qc - 8; wst = wst < 0 ? 0 : (wst > 48 ? 48 : wst);
        const size_t tokq = (size_t)b * SEQ + r * 64 + qc;
        bf16x8 qf[2];
#pragma unroll
        for (int ks = 0; ks < 2; ++ks) qf[ks] = *(const bf16x8*)(QK + tokq * 2048 + hh * 64 + ks * 32 + 8 * g);
        f32x4 S[8][2];
        const int kcl_a = 8 * (q >> 2) + (q & 3);
#pragma unroll
        for (int wr = 0; wr < 8; ++wr)
#pragma unroll
            for (int T = 0; T < 2; ++T) {
                const LAS unsigned char* kp = KL + ((lr0 + wr) * 64 + bs + kcl_a + 4 * T) * AT_KSTR + 16 * g;
                const bf16x8 k0 = *(const LAS bf16x8*)kp, k1 = *(const LAS bf16x8*)(kp + 64);
                f32x4 c = (f32x4){0.f, 0.f, 0.f, 0.f};
                c = __builtin_amdgcn_mfma_f32_16x16x32_bf16(k0, qf[0], c, 0, 0, 0);
                c = __builtin_amdgcn_mfma_f32_16x16x32_bf16(k1, qf[1], c, 0, 0, 0);
                S[wr][T] = c;
            }
        float mx = -3.0e38f;
#pragma unroll
        for (int wr = 0; wr < 8; ++wr) {
            const LAS float* brow = btab + (rs + wr - r + 7) * 31;
#pragma unroll
            for (int T = 0; T < 2; ++T)
#pragma unroll
                for (int i = 0; i < 4; ++i) {
                    const int kc = bs + 8 * g + 4 * T + i;
                    int co = kc - qc + 15; co = co < 0 ? 0 : (co > 30 ? 30 : co);
                    const bool valid = (kc >= wst) && (kc < wst + 16);
                    const float v = valid ? S[wr][T][i] + brow[co] : -1e30f;
                    S[wr][T][i] = v; mx = fmaxf(mx, v);
                }
        }
        mx = fmaxf(mx, __shfl_xor(mx, 16)); mx = fmaxf(mx, __shfl_xor(mx, 32));
        float sum = 0.f;
        bf16x8 pf[8];
#pragma unroll
        for (int wr = 0; wr < 8; ++wr) {
            float p[8];
#pragma unroll
            for (int T = 0; T < 2; ++T)
#pragma unroll
                for (int i = 0; i < 4; ++i) { p[4 * T + i] = __expf(S[wr][T][i] - mx); sum += p[4 * T + i]; }
            v4u w; w.x = pk2(p[0], p[1]); w.y = pk2(p[2], p[3]); w.z = pk2(p[4], p[5]); w.w = pk2(p[6], p[7]);
            pf[wr] = __builtin_bit_cast(bf16x8, w);
        }
        sum += __shfl_xor(sum, 16); sum += __shfl_xor(sum, 32);
        if (it + F.G < 2048) { const int nit = it + F.G; AT_PREFETCH(nit); }
        f32x4 O[4];
#pragma unroll
        for (int dt = 0; dt < 4; ++dt) O[dt] = (f32x4){0.f, 0.f, 0.f, 0.f};
#pragma unroll
        for (int wr = 0; wr < 8; ++wr)
#pragma unroll
            for (int dt = 0; dt < 4; ++dt) {
                const bf16x8 vf = *(const LAS bf16x8*)(VL + (dt * 16 + q) * AT_VSTR + ((lr0 + wr) * 64 + bs + 8 * g) * 2);
                O[dt] = __builtin_amdgcn_mfma_f32_16x16x32_bf16(vf, pf[wr], O[dt], 0, 0, 0);
            }
        const float inv = 1.0f / sum;
#pragma unroll
        for (int dt = 0; dt < 4; ++dt) { v2u w; w.x = pk2(O[dt][0] * inv, O[dt][1] * inv); w.y = pk2(O[dt][2] * inv, O[dt][3] * inv);
            *(v2u*)(mix + tokq * 1024 + hh * 64 + dt * 16 + 4 * g) = w; }
    }
#undef AT_DECODE
#undef AT_PREFETCH
    BLOCK_BAR();
}
#if NAIVE_ATTN
__device__ __forceinline__ void attn_naive_phase(Frame& F, int j) {
    const bf16* QK = (const bf16*)(F.ws + WS_BIG); const bf16* VT = (const bf16*)(F.ws + WS_VT); bf16* mix = (bf16*)(F.ws + WS_MIX);
    const float* biasl = F.in(6) + (size_t)j * NH * 15 * 31;
    for (int idx = F.vcu * NTHR + F.tid; idx < M * NH; idx += F.G * NTHR) {
        const int hh = idx & 15, t = idx >> 4, b = t >> 13, s = t & (SEQ - 1), r = s >> 6, qc = s & 63;
        int rs = r - 4; rs = rs < 0 ? 0 : (rs > NROWS - 8 ? NROWS - 8 : rs);
        int wst = qc - 8; wst = wst < 0 ? 0 : (wst > 48 ? 48 : wst);
        float qv[64];
#pragma unroll
        for (int c = 0; c < 8; ++c) { const v4u w = *(const v4u*)(QK + (size_t)t * 2048 + hh * 64 + c * 8);
#pragma unroll
            for (int e = 0; e < 4; ++e) { qv[c * 8 + 2 * e] = bflo(w[e]); qv[c * 8 + 2 * e + 1] = bfhi(w[e]); } }
        float mrun = -3.0e38f, lrun = 0.f, o[64];
#pragma unroll
        for (int d = 0; d < 64; ++d) o[d] = 0.f;
        for (int wr = 0; wr < 8; ++wr)
            for (int kk = 0; kk < 16; ++kk) {
                const int kc = wst + kk; const size_t tk = (size_t)b * SEQ + (rs + wr) * 64 + kc;
                float sd = 0.f;
#pragma unroll
                for (int c = 0; c < 8; ++c) { const v4u w = *(const v4u*)(QK + tk * 2048 + 1024 + hh * 64 + c * 8);
#pragma unroll
                    for (int e = 0; e < 4; ++e) sd += qv[c * 8 + 2 * e] * bflo(w[e]) + qv[c * 8 + 2 * e + 1] * bfhi(w[e]); }
                int co = kc - qc + 15; co = co < 0 ? 0 : (co > 30 ? 30 : co);
                sd += biasl[(size_t)hh * 465 + (rs + wr - r + 7) * 31 + co];
                const float mn = fmaxf(mrun, sd), al = __expf(mrun - mn), p = __expf(sd - mn);
                lrun = lrun * al + p; mrun = mn;
#pragma unroll
                for (int d = 0; d < 64; ++d) o[d] = o[d] * al + p * bflo((unsigned)VT[(size_t)(hh * 64 + d) * M + tk]);
            }
        const float inv = 1.0f / lrun;
#pragma unroll
        for (int c = 0; c < 8; ++c) { v4u w;
#pragma unroll
            for (int e = 0; e < 4; ++e) w[e] = pk2(o[c * 8 + 2 * e] * inv, o[c * 8 + 2 * e + 1] * inv);
            *(v4u*)(mix + (size_t)t * 1024 + hh * 64 + c * 8) = w; }
    }
}
#endif
#if NAIVE_TOPK
__device__ __forceinline__ void select_naive_phase(Frame& F) {
    const float* SC = (const float*)(F.ws + WS_SC); int* seli = (int*)(F.ws + WS_SELI); float* selg = (float*)(F.ws + WS_SELG);
    LAS int* AB = (LAS int*)F.lds + F.tid * 33;
    for (int idx = F.vcu * NTHR + F.tid; idx < M * 8; idx += F.G * NTHR) {
        const float* s = SC + (size_t)idx * 256;
        int a[16], b[16], t[16];
        tk_stage1<4>(s, 0, a); tk_stage1<4>(s + 64, 64, t); tk_merge_top(a, t);
        tk_stage1<4>(s + 128, 0, b); tk_stage1<4>(s + 192, 64, t); tk_merge_top(b, t);
        tk_stage2(a, b, AB, seli + (size_t)idx * 16, selg + (size_t)idx * 16);
    }
}
#endif

__device__ __forceinline__ float gelu_erf(float a) { return 0.5f * a * (1.0f + erff(a * 0.70710678118654752f)); }
typedef float f32x2g __attribute__((ext_vector_type(2)));
#if EXPERT_FP4
typedef v2u rowv;
__device__ __forceinline__ rowv row_load(const unsigned char* T, int e, int lane) { return *(const v2u*)(T + (size_t)e * ROWB + 8 * lane); }
#define ROW_PAIR(r, m) __builtin_amdgcn_cvt_scalef32_pk_f32_fp4((r)[(m) >> 2], 1.0f, (m) & 3)
#else
typedef v4u rowv;
__device__ __forceinline__ rowv row_load(const unsigned char* T, int e, int lane) { return *(const v4u*)(T + (size_t)e * ROWB + 16 * lane); }
#define ROW_PAIR(r, m) __builtin_amdgcn_cvt_pk_f32_fp8((r)[(m) >> 1], ((m) & 1) != 0)
#endif
__device__ __forceinline__ void row_axpy(f32x2g (&out)[8], const rowv d, float ak) {
    const f32x2g a2 = (f32x2g){ak, ak};
    out[0] = __builtin_elementwise_fma(a2, ROW_PAIR(d, 0), out[0]); out[1] = __builtin_elementwise_fma(a2, ROW_PAIR(d, 1), out[1]); out[2] = __builtin_elementwise_fma(a2, ROW_PAIR(d, 2), out[2]); out[3] = __builtin_elementwise_fma(a2, ROW_PAIR(d, 3), out[3]);
    out[4] = __builtin_elementwise_fma(a2, ROW_PAIR(d, 4), out[4]); out[5] = __builtin_elementwise_fma(a2, ROW_PAIR(d, 5), out[5]); out[6] = __builtin_elementwise_fma(a2, ROW_PAIR(d, 6), out[6]); out[7] = __builtin_elementwise_fma(a2, ROW_PAIR(d, 7), out[7]);
}
typedef int v8i_g __attribute__((ext_vector_type(8)));
typedef unsigned char u8x4g __attribute__((ext_vector_type(4)));
#define TR_SHUF(a, b, i0, i1, i2, i3) __builtin_amdgcn_perm((unsigned)(b), (unsigned)(a), (unsigned)((i0) | ((i1) << 8) | ((i2) << 16) | ((i3) << 24)))
__device__ __forceinline__ void tr8_nib(const unsigned (&w)[8], unsigned (&t)[8]) {
    unsigned x[8], y[8];
#pragma unroll
    for (int r = 0; r < 4; ++r) { x[r] = TR_SHUF(w[r], w[r + 4], 0, 1, 4, 5); x[r + 4] = TR_SHUF(w[r], w[r + 4], 2, 3, 6, 7); }
#pragma unroll
    for (int g = 0; g < 2; ++g)
#pragma unroll
        for (int r = 0; r < 2; ++r) { y[4 * g + r] = TR_SHUF(x[4 * g + r], x[4 * g + r + 2], 0, 4, 2, 6); y[4 * g + r + 2] = TR_SHUF(x[4 * g + r], x[4 * g + r + 2], 1, 5, 3, 7); }
#pragma unroll
    for (int p = 0; p < 4; ++p) { const unsigned e = y[2 * p], o = y[2 * p + 1];
        t[2 * p] = (e & 0x0F0F0F0Fu) | ((o << 4) & 0xF0F0F0F0u);
        t[2 * p + 1] = ((e >> 4) & 0x0F0F0F0Fu) | (o & 0xF0F0F0F0u); }
}
__device__ __forceinline__ void gather_phase(Frame& F, int layer, bool dry) {
    const unsigned char* UP = F.ws + WS_UP + (size_t)layer * 16384 * ROWB; const unsigned char* DN = F.ws + WS_DN + (size_t)layer * 16384 * ROWB;
    const float* SUP = (const float*)(F.ws + WS_SUP) + (size_t)layer * 16384; const float* SDN = (const float*)(F.ws + WS_SDN) + (size_t)layer * 16384;
    const float* gain = F.in(2) + (size_t)layer * D; const float* gnext = layer < DEPTH - 1 ? F.in(1) + (size_t)(layer + 1) * D : F.in(3);
    float* outp = F.out();
    const int* seli = (const int*)(F.ws + WS_SELI); const float* selg = (const float*)(F.ws + WS_SELG);
    float* H = (float*)(F.ws + WS_H); bf16* HN = (bf16*)(F.ws + (dry ? WS_SC + 64 * MiB : WS_HN)); float* HW = (float*)(F.ws + (dry ? WS_SC : WS_H)); if (dry) outp = HW;
    const int lane = F.lane, gw = F.vcu * NWAVES + F.wave, NGW = F.G * NWAVES;
    const bool b5 = lane & 32, b4 = lane & 16, b3 = lane & 8, b2 = lane & 4;
    constexpr int G_RS = 528, G_RB = 32 * G_RS, G_NSLOT = 4;
    LAS unsigned char* RB = F.lds + F.wave * G_RB;
    LAS float* ACT = (LAS float*)(F.lds + 8 * G_RB + F.wave * (G_NSLOT * 512));
    static_assert(8 * G_RB + 8 * G_NSLOT * 512 + 8 * 1024 <= PTAB_OFF, "gather LDS map");
#pragma unroll 1
    for (int base = gw; base < M; base += G_NSLOT * NGW) {
    LAS unsigned char* X8 = F.lds + 8 * G_RB + 8 * G_NSLOT * 512 + F.wave * 1024;
    const int n16 = lane & 15, g4 = lane >> 4;
    f32x4 nhv[4]; int nidx_lo = 0, nidx_hi = 0; float ng_lo = 0.f, ng_hi = 0.f;
#define TOK_LOAD(t_) do { const float* hr_ = H + (size_t)(t_) * D + 16 * lane; _Pragma("unroll") for (int i = 0; i < 4; ++i) nhv[i] = *(const f32x4*)(hr_ + 4 * i); \
        nidx_lo = seli[(size_t)(t_) * 128 + lane]; nidx_hi = seli[(size_t)(t_) * 128 + 64 + lane]; ng_lo = selg[(size_t)(t_) * 128 + lane]; ng_hi = selg[(size_t)(t_) * 128 + 64 + lane]; } while (0)
    if (base < M) TOK_LOAD(base);
#pragma unroll 1
    for (int slot = 0; slot < G_NSLOT; ++slot) {
        const int t = base + slot * NGW; if (t >= M) break;
        f32x4 hv[4];
#pragma unroll
        for (int i = 0; i < 4; ++i) hv[i] = nhv[i];
        const int idx_lo = nidx_lo, idx_hi = nidx_hi; const float g_lo = ng_lo, g_hi = ng_hi;
        if (slot + 1 < G_NSLOT && t + NGW < M) TOK_LOAD(t + NGW);
        float ss = 0.f;
#pragma unroll
        for (int i = 0; i < 4; ++i) ss += (hv[i].x * hv[i].x + hv[i].y * hv[i].y) + (hv[i].z * hv[i].z + hv[i].w * hv[i].w);
        const float rstd = 1.0f / sqrtf(wave_sum(ss) * (1.f / D) + RMS_EPS);
        float xmax = 0.f;
        f32x4 xv[4];
#pragma unroll
        for (int i = 0; i < 4; ++i) { const f32x4 g = *(const f32x4*)(gain + 16 * lane + 4 * i); xv[i] = hv[i] * rstd * g;
            xmax = fmaxf(fmaxf(xmax, fmaxf(fabsf(xv[i].x), fabsf(xv[i].y))), fmaxf(fabsf(xv[i].z), fabsf(xv[i].w))); }
#pragma unroll
        for (int o = 1; o < 64; o <<= 1) xmax = fmaxf(xmax, __shfl_xor(xmax, o));
        const float qx = xmax > 0.f ? 256.0f / xmax : 1.0f, xinv = xmax > 0.f ? xmax * (1.0f / 256.0f) : 1.0f;
        {
            v4u w;
#pragma unroll
            for (int i = 0; i < 4; ++i) { unsigned tt = 0u; tt = __builtin_amdgcn_cvt_pk_fp8_f32(xv[i].x * qx, xv[i].y * qx, tt, false); tt = __builtin_amdgcn_cvt_pk_fp8_f32(xv[i].z * qx, xv[i].w * qx, tt, true); w[i] = tt; }
            *(LAS v4u*)(X8 + 16 * lane) = w;
        }
        LDS_WAIT(); asm volatile("" ::: "memory");
        v8i_g bx[8];
#pragma unroll
        for (int s8 = 0; s8 < 8; ++s8) { const v4u b0 = *(const LAS v4u*)(X8 + 128 * s8 + 16 * g4), b1 = *(const LAS v4u*)(X8 + 128 * s8 + 64 + 16 * g4);
            bx[s8] = (v8i_g){(int)b0.x, (int)b0.y, (int)b0.z, (int)b0.w, (int)b1.x, (int)b1.y, (int)b1.z, (int)b1.w}; }
        LDS_WAIT(); asm volatile("" ::: "memory");
#define UP_LOAD(buf, hq) do { const int sel_ = (hq) < 2 ? idx_lo : idx_hi; _Pragma("unroll") for (int k = 0; k < 32; ++k) buf[k] = row_load(UP, __builtin_amdgcn_readlane(sel_, ((hq) & 1) * 32 + k), lane); } while (0)
#define DN_LOAD(buf, hb) do { const int sel_ = (hb) < 4 ? idx_lo : idx_hi; _Pragma("unroll") for (int k = 0; k < 16; ++k) buf[k] = row_load(DN, __builtin_amdgcn_readlane(sel_, ((hb) & 3) * 16 + k), lane); } while (0)
        rowv da[16];
        {
            rowv ur[32];
            UP_LOAD(ur, 0);
#define UP_NEXT UP_LOAD(ur, hq + 1)
#pragma unroll 1
            for (int hq = 0; hq < 3; ++hq) {
                const int sel = hq < 2 ? idx_lo : idx_hi; const float gsel = hq < 2 ? g_lo : g_hi; const int lb0 = (hq & 1) * 32;
#pragma unroll
                for (int k = 0; k < 32; ++k) *(LAS v2u*)(RB + k * G_RS + 8 * lane) = ur[k];
                float sc[4];
#pragma unroll
                for (int hh_ = 0; hh_ < 2; ++hh_) { const int ek_ = __shfl(sel, lb0 + hh_ * 16 + 4 * g4 + (n16 & 3)); sc[2 * hh_] = SUP[ek_]; sc[2 * hh_ + 1] = SDN[ek_]; }
                LDS_WAIT(); asm volatile("" ::: "memory");
                UP_NEXT;
#pragma unroll
                for (int hh_ = 0; hh_ < 2; ++hh_) { const int lb = lb0 + hh_ * 16;
                    f32x4 c = (f32x4){0.f, 0.f, 0.f, 0.f};
#pragma unroll
                    for (int s8 = 0; s8 < 8; ++s8) { const v4u a4 = *(const LAS v4u*)(RB + (hh_ * 16 + n16) * G_RS + 64 * s8 + 16 * g4); const v8i_g a8 = (v8i_g){(int)a4.x, (int)a4.y, (int)a4.z, (int)a4.w, 0, 0, 0, 0};
                        c = __builtin_amdgcn_mfma_scale_f32_16x16x128_f8f6f4(a8, bx[s8], c, 4, 0, 0, 0x7f7f7f7f, 0, 0x7f7f7f7f); }
                    const int r_ = n16 & 3, k_ = 4 * g4 + r_;
                    const float my = r_ == 0 ? c[0] : (r_ == 1 ? c[1] : (r_ == 2 ? c[2] : c[3]));
                    const float gate = __shfl(gsel, lb + k_);
                    const float act = gelu_erf(my * sc[2 * hh_] * xinv) * gate * sc[2 * hh_ + 1];
                    if (n16 < 4) ACT[slot * 128 + hq * 32 + hh_ * 16 + k_] = act; }
                LDS_WAIT(); asm volatile("" ::: "memory");
            }
#undef UP_NEXT
#define UP_NEXT DN_LOAD(da, 0)
            { const int hq = 3;
                const int sel = hq < 2 ? idx_lo : idx_hi; const float gsel = hq < 2 ? g_lo : g_hi; const int lb0 = (hq & 1) * 32;
#pragma unroll
                for (int k = 0; k < 32; ++k) *(LAS v2u*)(RB + k * G_RS + 8 * lane) = ur[k];
                float sc[4];
#pragma unroll
                for (int hh_ = 0; hh_ < 2; ++hh_) { const int ek_ = __shfl(sel, lb0 + hh_ * 16 + 4 * g4 + (n16 & 3)); sc[2 * hh_] = SUP[ek_]; sc[2 * hh_ + 1] = SDN[ek_]; }
                LDS_WAIT(); asm volatile("" ::: "memory");
                UP_NEXT;
#pragma unroll
                for (int hh_ = 0; hh_ < 2; ++hh_) { const int lb = lb0 + hh_ * 16;
                    f32x4 c = (f32x4){0.f, 0.f, 0.f, 0.f};
#pragma unroll
                    for (int s8 = 0; s8 < 8; ++s8) { const v4u a4 = *(const LAS v4u*)(RB + (hh_ * 16 + n16) * G_RS + 64 * s8 + 16 * g4); const v8i_g a8 = (v8i_g){(int)a4.x, (int)a4.y, (int)a4.z, (int)a4.w, 0, 0, 0, 0};
                        c = __builtin_amdgcn_mfma_scale_f32_16x16x128_f8f6f4(a8, bx[s8], c, 4, 0, 0, 0x7f7f7f7f, 0, 0x7f7f7f7f); }
                    const int r_ = n16 & 3, k_ = 4 * g4 + r_;
                    const float my = r_ == 0 ? c[0] : (r_ == 1 ? c[1] : (r_ == 2 ? c[2] : c[3]));
                    const float gate = __shfl(gsel, lb + k_);
                    const float act = gelu_erf(my * sc[2 * hh_] * xinv) * gate * sc[2 * hh_ + 1];
                    if (n16 < 4) ACT[slot * 128 + hq * 32 + hh_ * 16 + k_] = act; }
                LDS_WAIT(); asm volatile("" ::: "memory");
            }
#undef UP_NEXT
        }
#undef UP_LOAD
        LDS_WAIT(); asm volatile("" ::: "memory");
        const float a_lo = ACT[slot * 128 + lane], a_hi = ACT[slot * 128 + 64 + lane];
        float amax = fmaxf(fabsf(a_lo), fabsf(a_hi));
#pragma unroll
        for (int o = 1; o < 64; o <<= 1) amax = fmaxf(amax, __shfl_xor(amax, o));
        const float ainv = amax > 0.f ? 119.0f / amax : 0.f, tscale = amax * (1.0f / 119.0f);
        unsigned pd[4];
        {
            const int A0 = __float2int_rn(a_lo * ainv), A1 = __float2int_rn(a_hi * ainv);
            const int h0 = (A0 + 8) >> 4, l0 = A0 - 16 * h0, h1 = (A1 + 8) >> 4, l1 = A1 - 16 * h1;
            const int sh = 4 * (lane & 7);
            pd[0] = ((unsigned)l0 & 15u) << sh; pd[1] = ((unsigned)h0 & 15u) << sh; pd[2] = ((unsigned)l1 & 15u) << sh; pd[3] = ((unsigned)h1 & 15u) << sh;
#pragma unroll
            for (int q = 0; q < 4; ++q) { pd[q] |= (unsigned)__shfl_xor((int)pd[q], 1); pd[q] |= (unsigned)__shfl_xor((int)pd[q], 2); pd[q] |= (unsigned)__shfl_xor((int)pd[q], 4); }
        }
        int acc0[16], acc1[16];
#pragma unroll
        for (int e = 0; e < 16; ++e) { acc0[e] = 0; acc1[e] = 0; }
#define DN_STEP(buf, hb) do { const unsigned plo_ = (hb) < 4 ? pd[0] : pd[2], phi_ = (hb) < 4 ? pd[1] : pd[3]; \
            _Pragma("unroll") for (int gg = 0; gg < 2; ++gg) { \
                const int alo_ = __builtin_amdgcn_readlane((int)plo_, ((hb) & 3) * 16 + 8 * gg), ahi_ = __builtin_amdgcn_readlane((int)phi_, ((hb) & 3) * 16 + 8 * gg); \
                _Pragma("unroll") for (int jj = 0; jj < 2; ++jj) { unsigned w_[8], t_[8]; \
                    _Pragma("unroll") for (int r = 0; r < 8; ++r) w_[r] = buf[8 * gg + r][jj]; \
                    tr8_nib(w_, t_); \
                    _Pragma("unroll") for (int c = 0; c < 8; ++c) { acc0[8 * jj + c] = __builtin_amdgcn_sdot8((int)t_[c], alo_, acc0[8 * jj + c], false); acc1[8 * jj + c] = __builtin_amdgcn_sdot8((int)t_[c], ahi_, acc1[8 * jj + c], false); } } } } while (0)
        {
            rowv db[16];
            DN_LOAD(db, 1); DN_STEP(da, 0);
            DN_LOAD(da, 2); DN_STEP(db, 1);
            DN_LOAD(db, 3); DN_STEP(da, 2);
            DN_LOAD(da, 4); DN_STEP(db, 3);
            DN_LOAD(db, 5); DN_STEP(da, 4);
            DN_LOAD(da, 6); DN_STEP(db, 5);
            DN_LOAD(db, 7); DN_STEP(da, 6);
            DN_STEP(db, 7);
        }
#undef DN_LOAD
#undef DN_STEP
        f32x2g out[8];
#pragma unroll
        for (int e = 0; e < 8; ++e) out[e] = (f32x2g){((float)acc0[2 * e] + 16.0f * (float)acc1[2 * e]) * tscale, ((float)acc0[2 * e + 1] + 16.0f * (float)acc1[2 * e + 1]) * tscale};
        float ss2 = 0.f;
#pragma unroll
        for (int i = 0; i < 4; ++i) { hv[i].x += out[2 * i].x; hv[i].y += out[2 * i].y; hv[i].z += out[2 * i + 1].x; hv[i].w += out[2 * i + 1].y;
            ss2 += (hv[i].x * hv[i].x + hv[i].y * hv[i].y) + (hv[i].z * hv[i].z + hv[i].w * hv[i].w); }
        const float rstd2 = 1.0f / sqrtf(wave_sum(ss2) * (1.f / D) + RMS_EPS);
        f32x4 y[4];
#pragma unroll
        for (int i = 0; i < 4; ++i) y[i] = hv[i] * rstd2 * *(const f32x4*)(gnext + 16 * lane + 4 * i);
        if (layer < DEPTH - 1) {
#pragma unroll
            for (int i = 0; i < 4; ++i) *(f32x4*)(HW + (size_t)t * D + 16 * lane + 4 * i) = hv[i];
            bf16* hn = HN + (size_t)t * D + 16 * lane;
            v4u o0, o1; o0.x = pk2(y[0].x, y[0].y); o0.y = pk2(y[0].z, y[0].w); o0.z = pk2(y[1].x, y[1].y); o0.w = pk2(y[1].z, y[1].w);
            o1.x = pk2(y[2].x, y[2].y); o1.y = pk2(y[2].z, y[2].w); o1.z = pk2(y[3].x, y[3].y); o1.w = pk2(y[3].z, y[3].w);
            *(v4u*)hn = o0; *(v4u*)(hn + 8) = o1;
        } else {
            float* orow = outp + (size_t)t * D + 16 * lane;
#pragma unroll
            for (int i = 0; i < 4; ++i) *(f32x4*)(orow + 4 * i) = y[i];
        }
    }
    LDS_WAIT(); asm volatile("" ::: "memory");
    }
#undef TOK_LOAD
}

struct Args { const float* in[14]; float* out; unsigned char* ws; int ph_lo, ph_hi; };
__global__ void __launch_bounds__(NTHR, 2) mega_fwd(Args args) {
    extern __shared__ __attribute__((aligned(16))) unsigned char lds[];
    Frame F;
    F.lds = (LAS unsigned char*)lds;
    F.tid = threadIdx.x; F.lane = F.tid & 63; F.wave = __builtin_amdgcn_readfirstlane(F.tid >> 6);
    F.G = gridDim.x; { const int bx = blockIdx.x; F.vcu = (F.G % 8 == 0) ? (bx % 8) * (F.G / 8) + bx / 8 : bx; }
    F.ws = args.ws;
    volatile LAS unsigned* MISC = (volatile LAS unsigned*)(F.lds + MISC_OFF);
    if (F.tid < 64) MISC[F.tid] = 0u;
    if (F.tid < 15) { const unsigned long long p = F.tid < 14 ? (unsigned long long)args.in[F.tid] : (unsigned long long)args.out;
        volatile LAS unsigned* t = (volatile LAS unsigned*)(F.lds + PTAB_OFF); t[2 * F.tid] = (unsigned)p; t[2 * F.tid + 1] = (unsigned)(p >> 32); }
    __syncthreads();
    XcdBarrier bar; bar.bar = (unsigned*)(F.ws + WS_CTL) + CW_BAR; bar.x = 0; bar.st = nullptr;
    if (MK_N_LAUNCHES == 1) bar = xcd_barrier_post((unsigned*)(F.ws + WS_CTL) + CW_BAR, MISC + 8);

#pragma unroll 1
    for (int ph = args.ph_lo; ph < args.ph_hi; ++ph) {
        bool did = true;
        const int kind_ = ph == 0 ? 7 : (ph - 1) % PH_PER_LAYER; const int nrep = (PROBE_REP >= 0 && kind_ == PROBE_REP && (ph == 0 || ((PROBE_LMASK >> ((ph - 1) / PH_PER_LAYER)) & 1))) ? 2 : 1;
#pragma unroll 1
        for (int rep = 0; rep < nrep; ++rep) {
        const bool dry = (nrep == 2 && rep == 0);
        { int t_ = threadIdx.x; asm volatile("" : "+v"(t_)); F.tid = t_; F.lane = t_ & 63; F.wave = __builtin_amdgcn_readfirstlane(t_ >> 6);
          unsigned long long ws_ = (unsigned long long)args.ws; asm volatile("" : "+s"(ws_)); F.ws = (unsigned char*)(__attribute__((address_space(1))) unsigned char*)ws_; }
#ifndef DIS_PRO
        if (ph == 0) p0_prologue(F, dry);
#else
        if (ph == 0) {}
#endif
        else {
            const int layer = (ph - 1) / PH_PER_LAYER, k = (ph - 1) % PH_PER_LAYER, j = layer >> 1; const bool is_attn = (layer & 1) == 0;
            if (k == 0) {
                if (!is_attn) {
                    pg8::Gemm g{(const pg8::bf16_t*)(F.ws + WS_HN), (const pg8::bf16_t*)(F.ws + WS_WIN) + (size_t)j * 3072 * 1024, M, 3072, D};
                    pg8::StaticOrder S; S.init(g.M, g.N, F.G, (int)blockIdx.x);
                    EpiConvIn E{(bf16*)(F.ws + WS_BIG), (bf16*)(F.ws + WS_BIG + 32 * MiB)};
                    pg8::gemm_phase<EpiConvIn, pg8::StaticOrder, true, true>(F.lds, g, S, E);
                }
                const int ng = is_attn ? 2 : 0;
#pragma unroll 1
                for (int gi = 0; gi < ng; ++gi) {
                    pg8::Gemm g; pg8::EpiBf16<0> E; E.bias = nullptr; E.split_cols = 0; E.split_stride = 0; E.scale0 = 1.f;
                    if (is_attn && gi == 0) { g = pg8::Gemm{(const pg8::bf16_t*)(F.ws + WS_HN), (const pg8::bf16_t*)(F.ws + WS_WQK) + (size_t)j * 2048 * 1024, M, 2048, D}; E.O = (pg8::bf16_t*)(F.ws + WS_BIG); E.ldc = 2048; }
                    else if (is_attn) { g = pg8::Gemm{(const pg8::bf16_t*)(F.ws + WS_WV) + (size_t)j * 1024 * 1024, (const pg8::bf16_t*)(F.ws + WS_HN), D, M, D}; E.O = (pg8::bf16_t*)(F.ws + WS_VT); E.ldc = M; }
                    else { g = pg8::Gemm{(const pg8::bf16_t*)(F.ws + WS_HN), (const pg8::bf16_t*)(F.ws + WS_WIN) + (size_t)j * 3072 * 1024, M, 3072, D}; E.O = (pg8::bf16_t*)(F.ws + WS_BIG); E.ldc = 3072; }
                    pg8::StaticOrder S; S.init(g.M, g.N, F.G, (int)blockIdx.x);
                    pg8::gemm_phase<pg8::EpiBf16<0>, pg8::StaticOrder, true, true>(F.lds, g, S, E);
                }
            } else if (k == 1) {
                if (is_attn) {
#if NAIVE_ATTN
                    attn_naive_phase(F, j);
#elif !defined(DIS_ATTN)
                    attn_phase(F, j);
#endif
                } else {
#ifndef DIS_CONV
                    conv_phase(F, j);
#endif
                }
            } else if (k == 2) {
                pg8::Gemm g{(const pg8::bf16_t*)(F.ws + WS_MIX), (const pg8::bf16_t*)(F.ws + (is_attn ? WS_WO : WS_WOUT)) + (size_t)j * 1024 * 1024, M, D, D};
                pg8::StaticOrder S; S.init(M, D, F.G, (int)blockIdx.x);
                EpiRes E{layer == 0 ? F.in(0) : (const float*)(F.ws + WS_H), (float*)(F.ws + (dry ? WS_SC : WS_H)), (bf16*)(F.ws + (dry ? WS_SC + 64 * MiB : WS_HN)), F.in(2) + (size_t)layer * D, (float*)(F.ws + (dry ? WS_SC + 96 * MiB : WS_RSS))};
                pg8::gemm_phase<EpiRes, pg8::StaticOrder, false, true>(F.lds, g, S, E);
            } else if (k == 3) {
                did = false;
            } else if (k == 4) {
                pg8::Gemm g{(const pg8::bf16_t*)(F.ws + WS_HN), (const pg8::bf16_t*)(F.ws + WS_WP) + (size_t)layer * 2048 * 1024, M, 2048, D};
                pg8::StaticOrder S; S.init(M, 2048, F.G, (int)blockIdx.x);
#if NAIVE_TOPK
                EpiF32 E{(float*)(F.ws + WS_SC), 2048};
                pg8::gemm_phase<EpiF32, pg8::StaticOrder, true, true>(F.lds, g, S, E);
#else
#ifndef DIS_TOPK
                EpiTopK E{(int*)(F.ws + WS_SELI), (float*)(F.ws + WS_SELG), (const float*)(F.ws + WS_RSS)};
#pragma unroll 1
                for (int i = 0;; ++i) { OneUnit O1; if (!S.next(i, O1.u)) break; pg8::gemm_phase<EpiTopK, OneUnit, false, true>(F.lds, g, O1, E); }
#endif
#endif
            } else if (k == 5) {
#if NAIVE_TOPK
                select_naive_phase(F);
#else
                did = false;
#endif
            } else {
#ifndef DIS_GATHER
                gather_phase(F, layer, dry);
#endif
            }
        }
        if (MK_N_LAUNCHES == 1 && dry) xcd_barrier(bar);
        }
        if (MK_N_LAUNCHES == 1 && did && ph + 1 < args.ph_hi) { xcd_barrier(bar);
#ifdef PROBE_BAR2
            xcd_barrier(bar);
#endif
        }
    }
}

extern "C" void kernel_launch(void* const* d_in, const int* in_sizes, int n_in, void* d_out, int out_size, void* d_ws, size_t ws_size, hipStream_t stream) {
    static int grid = 0;
    if (grid == 0) {
        if (n_in != 14 || out_size != M * D || ws_size < WS_END) { fprintf(stderr, "kernel_launch: unexpected shapes (n_in %d, out %d, ws %zu); nothing launched\n", n_in, out_size, ws_size); grid = -1; return; }
        int dev = 0, cus = 0, per_cu = 0;
        if (hipGetDevice(&dev) != hipSuccess || hipDeviceGetAttribute(&cus, hipDeviceAttributeMultiprocessorCount, dev) != hipSuccess) { grid = -1; return; }
        if (hipFuncSetAttribute((const void*)mega_fwd, hipFuncAttributeMaxDynamicSharedMemorySize, LDS_BYTES) != hipSuccess) { fprintf(stderr, "kernel_launch: hipFuncSetAttribute failed\n"); grid = -1; return; }
        if (hipOccupancyMaxActiveBlocksPerMultiprocessor(&per_cu, (const void*)mega_fwd, NTHR, LDS_BYTES) != hipSuccess || per_cu < 1) fprintf(stderr, "kernel_launch: note: occupancy query reports %d\n", per_cu);
        (void)hipGetLastError();
        grid = cus;
    }
    if (grid < 0) return;
    if (hipMemsetAsync((char*)d_ws + WS_CTL, 0, CTL_ZERO_BYTES, stream) != hipSuccess) return;
    Args a{};
    for (int i = 0; i < 14; ++i) a.in[i] = (const float*)d_in[i];
    a.out = (float*)d_out; a.ws = (unsigned char*)d_ws;
    if (MK_N_LAUNCHES == 1) { a.ph_lo = 0; a.ph_hi = N_PHASES; hipLaunchKernelGGL(mega_fwd, dim3(grid), dim3(NTHR), LDS_BYTES, stream, a); }
    else for (int ph = 0; ph < N_PHASES; ++ph) {
        if (ph > 0 && ((ph - 1) % PH_PER_LAYER == 3 || (!NAIVE_TOPK && (ph - 1) % PH_PER_LAYER == 5))) continue;
        a.ph_lo = ph; a.ph_hi = ph + 1; hipLaunchKernelGGL(mega_fwd, dim3(grid), dim3(NTHR), LDS_BYTES, stream, a);
    }
}
```

```cpp
#include <hip/hip_runtime.h>
#include <cstdio>
#include <cstdint>
namespace pg8 {
#define PG8_LAS __attribute__((address_space(3)))
typedef unsigned short bf16_t;
typedef short bf16x8 __attribute__((ext_vector_type(8)));
typedef float f32x4 __attribute__((ext_vector_type(4)));
typedef unsigned u32x4 __attribute__((ext_vector_type(4)));
constexpr int BM = 256, BK = 64, HALF = 128, HTB = HALF * BK * 2  , STAGE_BYTES = 8 * HTB, NXCD = 8, WGM = 8;

__host__ __device__ __forceinline__ int lds_byte(int r, int c) { const int st = (r >> 4) * 2 + (c >> 5), rr = r & 15, cc = c & 31, ob = rr * 64 + cc * 2; return st * 1024 + (ob ^ (((ob >> 9) & 1) << 5)); }
__host__ __device__ __forceinline__ void stage_rc(int b, int& R, int& C) { const int st = b / 1024, sb = b % 1024, swz = sb ^ (((sb >> 9) & 1) << 5); R = (st >> 1) * 16 + swz / 64; C = (st & 1) * 32 + (swz % 64) / 2; }
__host__ __device__ __forceinline__ int perm32(int rho) { const int n = rho >> 4, i = rho & 15; return 8 * (i >> 2) + 4 * n + (i & 3); }

struct Unit { int pm, pn; };
struct Gemm { const bf16_t* A; const bf16_t* Bt; int M, N, K; };

struct StaticOrder {
    int nM, nN, nwg, G, c;
    __host__ __device__ void init(int M, int N, int G_, int c_) { nM = M / BM; nN = N / BM; nwg = nM * nN; G = G_; c = c_; }
    __host__ __device__ bool next(int i, Unit& u) const {
        const long L = (long)i * G + c; if (L >= nwg) return false;
        int wgid = (int)L; { const int q = nwg / NXCD, r = nwg % NXCD, xcd = wgid % NXCD, off = wgid / NXCD; wgid = (xcd < r ? xcd * (q + 1) : r * (q + 1) + (xcd - r) * q) + off; }
        const int nig = WGM * nN, gid = wgid / nig, fm = gid * WGM, gsz = (nM - fm) < WGM ? (nM - fm) : WGM;
        u.pm = fm + ((wgid % nig) % gsz); u.pn = (wgid % nig) / gsz; return true;
    }
    __device__ __forceinline__ void a_ready(const Unit&) const {}
    __device__ __forceinline__ void done(const Unit&) const {}
};

__device__ __forceinline__ unsigned cvt_pk_bf16(float lo, float hi) { unsigned r; asm volatile("v_cvt_pk_bf16_f32 %0, %1, %2" : "=v"(r) : "v"(lo), "v"(hi)); return r; }
typedef float f32x2 __attribute__((ext_vector_type(2)));
__device__ __forceinline__ f32x2 gelu_pk(f32x2 v) {
    const f32x2 av = __builtin_elementwise_abs(v), d = av * 0.2316418882f + 1.0f;
    f32x2 t; t.x = __builtin_amdgcn_rcpf(d.x); t.y = __builtin_amdgcn_rcpf(d.y);
    f32x2 q = t * 0.5307027145f + (-0.7265760135f); q = q * t + 0.7107068705f; q = q * t + (-0.142248368f); q = q * t + 0.127414796f; q = q * t;
    const f32x2 s = (v * v) * (-0.72134752044f);
    f32x2 e; e.x = __builtin_amdgcn_exp2f(s.x); e.y = __builtin_amdgcn_exp2f(s.y);
    const f32x2 m = v * (q * e), r = v - m;
    f32x2 o; o.x = v.x < 0.f ? m.x : r.x; o.y = v.y < 0.f ? m.y : r.y; return o;
}

template <int ACT  > struct EpiBf16 {
    static constexpr bool PERM = true, AFTER_DRAIN = false; static_assert(ACT == 0 || ACT == 1, "EpiBf16: ACT is 0 (none) or 1 (gelu_pk)");
    bf16_t* O; int ldc; const float* bias; int split_cols; size_t split_stride; float scale0;
    __device__ __forceinline__ void operator()(const f32x4 (&acc)[2][2][4][2], const Unit& u, int wr, int wc, int fr, int fq) const {
        const int row0 = u.pm * BM + wr * 64 + fr; int colt = u.pn * BM; bf16_t* base = O;
        float sc = 1.f; if (split_cols) { const int t = colt / split_cols; base += (size_t)t * split_stride; colt -= t * split_cols; if (t == 0) sc = scale0; }
        const int col0 = colt + wc * 32 + 8 * fq, bcol0 = u.pn * BM + wc * 32 + 8 * fq;
        f32x4 bv[2][2];
#pragma unroll
        for (int bj = 0; bj < 2; ++bj)
#pragma unroll
            for (int n = 0; n < 2; ++n) bv[bj][n] = bias ? *(const f32x4*)(bias + bcol0 + bj * HALF + 4 * n) : (f32x4){0.f, 0.f, 0.f, 0.f};
#pragma unroll
        for (int ai = 0; ai < 2; ++ai)
#pragma unroll
            for (int m = 0; m < 4; ++m) { bf16_t* rowp = base + (size_t)(row0 + ai * HALF + m * 16) * ldc + col0;
#pragma unroll
                for (int bj = 0; bj < 2; ++bj) { f32x4 v0 = acc[ai][bj][m][0] + bv[bj][0], v1 = acc[ai][bj][m][1] + bv[bj][1];
                    if (ACT == 1) { f32x2 a = gelu_pk((f32x2){v0[0], v0[1]}), b = gelu_pk((f32x2){v0[2], v0[3]}), c = gelu_pk((f32x2){v1[0], v1[1]}), d = gelu_pk((f32x2){v1[2], v1[3]});
                        v0 = (f32x4){a.x, a.y, b.x, b.y}; v1 = (f32x4){c.x, c.y, d.x, d.y}; }
                    v0 = v0 * sc; v1 = v1 * sc; u32x4 w; w.x = cvt_pk_bf16(v0[0], v0[1]); w.y = cvt_pk_bf16(v0[2], v0[3]); w.z = cvt_pk_bf16(v1[0], v1[1]); w.w = cvt_pk_bf16(v1[2], v1[3]);
                    *(u32x4*)(rowp + bj * HALF) = w; } }
    }
};

template <class Epi, class Sched, bool ALIGN_EPI = false, bool SP2 = false>
__device__ __forceinline__ void gemm_phase(PG8_LAS unsigned char* lds, const Gemm g, const Sched& S, const Epi& E) {
    int tid_l = threadIdx.x; asm volatile("" : "+v"(tid_l));
    const int tid = tid_l, wid = __builtin_amdgcn_readfirstlane(tid >> 6), lane = tid & 63, wr = wid >> 2, wc = wid & 3, fr = lane & 15, fq = lane >> 4;
    const int K = g.K, nt = K / BK;
    unsigned voffA[2], voffB[2];
#pragma unroll
    for (int i = 0; i < 2; ++i) { int R, C; stage_rc(tid * 16 + i * 8192, R, C); const int Rb = Epi::PERM ? ((R & ~31) + perm32(R & 31)) : R;
        voffA[i] = (unsigned)(R * K + C) * 2u; voffB[i] = (unsigned)(Rb * K + C) * 2u; }
    const size_t kstep = (size_t)(BK * 2);
    const size_t hstep = (size_t)HALF * K * 2;
    const size_t tstep = 2 * hstep;
    const unsigned ldsw = (unsigned)wid * 1024u;
    const int aoff = lds_byte(wr * 64 + fr, fq * 8), boff = lds_byte(wc * 32 + fr, fq * 8);
#define PG8_SA(b, h) (((b) * 2 + (h)) * HTB)
#define PG8_SB(b, h) ((4 + (b) * 2 + (h)) * HTB)
#define PG8_STAGE(bufoff, gbase, voff) do { _Pragma("unroll") for (int _i = 0; _i < 2; ++_i) \
        __builtin_amdgcn_global_load_lds((const unsigned*)((const char*)(gbase) + (voff)[_i]), (PG8_LAS unsigned*)(lds + (bufoff) + ldsw + _i * 8192), 16, 0, 0); } while (0)
#define PG8_LDA(dst, b, h) do { _Pragma("unroll") for (int m = 0; m < 4; ++m) _Pragma("unroll") for (int k = 0; k < 2; ++k) dst[m][k] = *(const PG8_LAS bf16x8*)(lds + PG8_SA(b, h) + aoff + m * 2048 + k * 1024); } while (0)
#define PG8_LDB(dst, b, h) do { _Pragma("unroll") for (int n = 0; n < 2; ++n) _Pragma("unroll") for (int k = 0; k < 2; ++k) dst[n][k] = *(const PG8_LAS bf16x8*)(lds + PG8_SB(b, h) + boff + n * 2048 + k * 1024); } while (0)
#define PG8_MMA(ai, bj, At, Bt) do { __builtin_amdgcn_s_setprio(1); _Pragma("unroll") for (int m = 0; m < 4; ++m) _Pragma("unroll") for (int n = 0; n < 2; ++n) _Pragma("unroll") for (int k = 0; k < 2; ++k) \
        acc[ai][bj][m][n] = __builtin_amdgcn_mfma_f32_16x16x32_bf16(Bt[n][k], At[m][k], acc[ai][bj][m][n], 0, 0, 0); __builtin_amdgcn_s_setprio(0); } while (0)
#define PG8_WAIT_V(n) asm volatile("s_waitcnt vmcnt(" #n ")" ::: "memory")
#define PG8_WAIT_L(n) asm volatile("s_waitcnt lgkmcnt(" #n ")" ::: "memory")
#define PG8_BAR __builtin_amdgcn_s_barrier()
#define PG8_SCHED __builtin_amdgcn_sched_barrier(0)
    Unit cur, nxt; int ui = 0;
    if (!S.next(0, cur)) return;
    f32x4 acc[2][2][4][2];
#pragma unroll
    for (int a = 0; a < 2; ++a)
#pragma unroll
        for (int b = 0; b < 2; ++b)
#pragma unroll
            for (int m = 0; m < 4; ++m)
#pragma unroll
                for (int n = 0; n < 2; ++n) acc[a][b][m][n] = (f32x4){0.f, 0.f, 0.f, 0.f};
    bf16x8 At[4][2], B0[2][2], B1[2][2];
    const char* cA = (const char*)g.A + (size_t)cur.pm * tstep; const char* cB = (const char*)g.Bt + (size_t)cur.pn * tstep;
    S.a_ready(cur);
    if constexpr (SP2) {
        PG8_STAGE(PG8_SB(0, 0), cB, voffB); PG8_STAGE(PG8_SB(0, 1), cB + hstep, voffB); PG8_STAGE(PG8_SA(0, 0), cA, voffA); PG8_STAGE(PG8_SA(0, 1), cA + hstep, voffA);
        if (wr == 1) PG8_BAR;
        PG8_WAIT_V(2); PG8_BAR;
        PG8_STAGE(PG8_SB(1, 0), cB + kstep, voffB); PG8_STAGE(PG8_SA(1, 0), cA + kstep, voffA); PG8_STAGE(PG8_SB(1, 1), cB + hstep + kstep, voffB);
        PG8_WAIT_V(6); PG8_BAR;
    } else {
        PG8_STAGE(PG8_SB(0, 0), cB, voffB); PG8_STAGE(PG8_SA(0, 0), cA, voffA); PG8_STAGE(PG8_SB(0, 1), cB + hstep, voffB); PG8_STAGE(PG8_SA(0, 1), cA + hstep, voffA);
        if (wr == 1) PG8_BAR;
        PG8_WAIT_V(4); PG8_BAR;
        PG8_STAGE(PG8_SB(1, 0), cB + kstep, voffB); PG8_STAGE(PG8_SA(1, 0), cA + kstep, voffA); PG8_STAGE(PG8_SB(1, 1), cB + hstep + kstep, voffB);
        PG8_WAIT_V(6); PG8_BAR;
    }
    for (;;) {
        const bool has_next = S.next(ui + 1, nxt);
        const char* nA = has_next ? (const char*)g.A + (size_t)nxt.pm * tstep : cA; const char* nB = has_next ? (const char*)g.Bt + (size_t)nxt.pn * tstep : cB;
        for (int t = 0; t < nt; t += 2) {
            const bool last = (t == nt - 2);
            const char* a1 = cA + (size_t)(t + 1) * kstep;
            const char* a2 = last ? nA : cA + (size_t)(t + 2) * kstep; const char* b2 = last ? nB : cB + (size_t)(t + 2) * kstep;
            const char* a3 = a2 + kstep; const char* b3 = b2 + kstep;
            if (last && has_next) S.a_ready(nxt);
            if constexpr (SP2) {
            PG8_LDB(B0, 0, 0); PG8_LDB(B1, 0, 1); PG8_SCHED; PG8_LDA(At, 0, 0); PG8_STAGE(PG8_SA(1, 1), a1 + hstep, voffA);
            PG8_WAIT_V(8); PG8_WAIT_L(0); PG8_BAR; PG8_MMA(0, 0, At, B0); PG8_MMA(0, 1, At, B1); PG8_BAR; PG8_SCHED;
            PG8_LDA(At, 0, 1); PG8_STAGE(PG8_SB(0, 0), b2, voffB); PG8_STAGE(PG8_SB(0, 1), b2 + hstep, voffB); PG8_STAGE(PG8_SA(0, 0), a2, voffA);
            PG8_WAIT_V(8); PG8_WAIT_L(0); PG8_BAR; PG8_MMA(1, 0, At, B0); PG8_MMA(1, 1, At, B1); PG8_BAR; PG8_SCHED;
            PG8_LDB(B0, 1, 0); PG8_LDB(B1, 1, 1); PG8_SCHED; PG8_LDA(At, 1, 0); PG8_STAGE(PG8_SA(0, 1), a2 + hstep, voffA);
            PG8_WAIT_V(8); PG8_WAIT_L(0); PG8_BAR; PG8_MMA(0, 0, At, B0); PG8_MMA(0, 1, At, B1); PG8_BAR; PG8_SCHED;
            PG8_LDA(At, 1, 1); PG8_STAGE(PG8_SB(1, 0), b3, voffB); PG8_STAGE(PG8_SB(1, 1), b3 + hstep, voffB); PG8_STAGE(PG8_SA(1, 0), a3, voffA);
            PG8_WAIT_V(8); PG8_WAIT_L(0); PG8_BAR; PG8_MMA(1, 0, At, B0); PG8_MMA(1, 1, At, B1); PG8_BAR; PG8_SCHED;
            } else {
            PG8_LDB(B0, 0, 0); PG8_SCHED; PG8_LDA(At, 0, 0); PG8_STAGE(PG8_SA(1, 1), a1 + hstep, voffA);
            PG8_WAIT_L(8); PG8_BAR; PG8_WAIT_L(0); PG8_MMA(0, 0, At, B0); PG8_BAR; PG8_SCHED;
            PG8_LDB(B1, 0, 1); PG8_STAGE(PG8_SB(0, 0), b2, voffB);
            PG8_BAR; PG8_WAIT_L(0); PG8_MMA(0, 1, At, B1); PG8_BAR;
            PG8_LDA(At, 0, 1); PG8_STAGE(PG8_SA(0, 0), a2, voffA);
            PG8_BAR; PG8_WAIT_L(0); PG8_MMA(1, 0, At, B0); PG8_BAR; PG8_SCHED;
            PG8_STAGE(PG8_SB(0, 1), b2 + hstep, voffB);
            PG8_WAIT_V(6); PG8_BAR; PG8_MMA(1, 1, At, B1); PG8_BAR;
            PG8_LDB(B0, 1, 0); PG8_SCHED; PG8_LDA(At, 1, 0); PG8_STAGE(PG8_SA(0, 1), a2 + hstep, voffA);
            PG8_WAIT_L(8); PG8_BAR; PG8_WAIT_L(0); PG8_MMA(0, 0, At, B0); PG8_BAR; PG8_SCHED;
            PG8_LDB(B1, 1, 1); PG8_STAGE(PG8_SB(1, 0), b3, voffB);
            PG8_BAR; PG8_WAIT_L(0); PG8_MMA(0, 1, At, B1); PG8_BAR;
            PG8_LDA(At, 1, 1); PG8_STAGE(PG8_SA(1, 0), a3, voffA);
            PG8_BAR; PG8_WAIT_L(0); PG8_MMA(1, 0, At, B0); PG8_BAR; PG8_SCHED;
            PG8_STAGE(PG8_SB(1, 1), b3 + hstep, voffB);
            PG8_WAIT_V(6); PG8_BAR; PG8_MMA(1, 1, At, B1); PG8_BAR;
            }
        }
        if constexpr (ALIGN_EPI) { if (wr == 0) PG8_BAR; }
        if constexpr (!Epi::AFTER_DRAIN) { E(acc, cur, wr, wc, fr, fq); S.done(cur); }
        if (!has_next) break;
#pragma unroll
        for (int a = 0; a < 2; ++a)
#pragma unroll
            for (int b = 0; b < 2; ++b)
#pragma unroll
                for (int m = 0; m < 4; ++m)
#pragma unroll
                    for (int n = 0; n < 2; ++n) acc[a][b][m][n] = (f32x4){0.f, 0.f, 0.f, 0.f};
        cur = nxt; cA = nA; cB = nB; ++ui;
        if constexpr (ALIGN_EPI) { if (wr == 1) PG8_BAR; }
    }
    PG8_WAIT_V(0);
    if constexpr (!ALIGN_EPI) { if (wr == 0) PG8_BAR; }
    PG8_BAR;
    if constexpr (Epi::AFTER_DRAIN) { E.fused(acc, cur, wr, wc, fr, fq, lds, wid, lane); S.done(cur); }
#undef PG8_SA
#undef PG8_SB
#undef PG8_STAGE
#undef PG8_LDA
#undef PG8_LDB
#undef PG8_MMA
#undef PG8_WAIT_V
#undef PG8_WAIT_L
#undef PG8_BAR
#undef PG8_SCHED
}
}
#ifndef HD
#define HD __host__ __device__ __forceinline__
#endif
HD int tk_map(float f) { int b = __builtin_bit_cast(int, f); return b ^ ((b >> 31) & 0x7fffffff); }
HD float tk_unmap(int k) { int b = k ^ ((k >> 31) & 0x7fffffff); return __builtin_bit_cast(float, b); }
HD void tk_cx(int& a, int& b) { const int hi = a > b ? a : b, lo = a > b ? b : a; a = hi; b = lo; }
template <int N> HD void tk_sort_desc(int (&v)[N]) {
#pragma unroll
    for (int k = 2; k <= N; k <<= 1)
#pragma unroll
        for (int j = k >> 1; j > 0; j >>= 1)
#pragma unroll
            for (int i = 0; i < N; ++i) { const int l = i ^ j; if (l > i) { if ((i & k) == 0) tk_cx(v[i], v[l]); else tk_cx(v[l], v[i]); } }
}
template <int N> HD void tk_merge_top(int (&a)[N], const int (&b)[N]) {
#pragma unroll
    for (int i = 0; i < N; ++i) a[i] = a[i] > b[N - 1 - i] ? a[i] : b[N - 1 - i];
#pragma unroll
    for (int j = N >> 1; j > 0; j >>= 1)
#pragma unroll
        for (int i = 0; i < N; ++i) { const int l = i ^ j; if (l > i) tk_cx(a[i], a[l]); }
}
template <int NCH, class FP> HD void tk_stage1(FP s, int n_base, int (&best)[16]) {
#pragma unroll
    for (int c = 0; c < NCH; ++c) {
        int x[16];
#pragma unroll
        for (int e = 0; e < 16; ++e) x[e] = (tk_map(s[c * 16 + e]) & ~127) | (127 - (n_base + c * 16 + e));
        tk_sort_desc(x);
        if (c == 0) {
#pragma unroll
            for (int e = 0; e < 16; ++e) best[e] = x[e];
        } else tk_merge_top(best, x);
    }
}
template <class IP, class OI, class OG> HD void tk_stage2(int (&a)[16], int (&b)[16], IP AB, OI out_idx, OG out_g, float vscale = 1.0f) {
    float va[16], vb[16];
#pragma unroll
    for (int i = 0; i < 16; ++i) { AB[i] = a[i]; AB[16 + i] = b[i]; va[i] = tk_unmap(a[i] & ~127); vb[i] = tk_unmap(b[i] & ~127); }
    int best[16];
#pragma unroll
    for (int c = 0; c < 4; ++c) {
        int x[16];
#pragma unroll
        for (int e = 0; e < 16; ++e) x[e] = (int)0x80000000;
        int n = 0;
#pragma unroll
        for (int i = 0; i < 16; ++i)
#pragma unroll
            for (int j = 0; j < 16; ++j)
                if ((i + 1) * (j + 1) <= 16) { if (n >= 16 * c && n < 16 * c + 16) x[n - 16 * c] = (tk_map(va[i] + vb[j]) & ~255) | (255 - (i * 16 + j)); ++n; }
        tk_sort_desc(x);
        if (c == 0) {
#pragma unroll
            for (int e = 0; e < 16; ++e) best[e] = x[e];
        } else tk_merge_top(best, x);
    }
    int ka[16], kb[16];
#pragma unroll
    for (int k = 0; k < 16; ++k) { const int flat = 255 - (best[k] & 255); ka[k] = AB[flat >> 4]; kb[k] = AB[16 + (flat & 15)]; }
    float sv[16]; int ei[16]; float sum = 0.f;
#pragma unroll
    for (int k = 0; k < 16; ++k) { ei[k] = (127 - (ka[k] & 127)) * 128 + (127 - (kb[k] & 127)); sv[k] = (tk_unmap(ka[k] & ~127) + tk_unmap(kb[k] & ~127)) * vscale; }
    const float m = sv[0];
#pragma unroll
    for (int k = 0; k < 16; ++k) { sv[k] = __expf(sv[k] - m); sum += sv[k]; }
    const float inv = 1.0f / sum;
#pragma unroll
    for (int k = 0; k < 16; ++k) { out_idx[k] = ei[k]; out_g[k] = sv[k] * inv; }
}
constexpr int NWAVES = 8, NTHR = 512;
constexpr int BATCH = 2, SEQ = 8192, D = 1024, M = BATCH * SEQ, DEPTH = 4;
constexpr int NH = 16, HDIM = 64, GRIDW = 64, NROWS = 128;
constexpr float RMS_EPS = 1e-6f;
#ifndef MK_N_LAUNCHES
#define MK_N_LAUNCHES 1
#endif
#ifndef NAIVE_ATTN
#define NAIVE_ATTN 0
#endif
#ifndef NAIVE_TOPK
#define NAIVE_TOPK 0
#endif
#ifndef EXPERT_FP4
#define EXPERT_FP4 1
#endif
constexpr int ROWB = EXPERT_FP4 ? 512 : 1024;
#ifndef PROBE_GMODE
#define PROBE_GMODE 0
#endif
#ifndef PROBE_PMODE
#define PROBE_PMODE 0
#endif
#ifndef PROBE_LMASK
#define PROBE_LMASK 15
#endif
#ifndef PROBE_REP
#define PROBE_REP -1
#endif
constexpr int PH_PER_LAYER = 7, N_PHASES = 1 + DEPTH * PH_PER_LAYER;

constexpr size_t MiB = 1u << 20;
constexpr size_t WS_CTL = 0, CTL_ZERO_BYTES = 32 * 1024;
constexpr size_t WS_WQK = 2 * MiB;
constexpr size_t WS_WV = 10 * MiB;
constexpr size_t WS_WO = 14 * MiB;
constexpr size_t WS_WIN = 18 * MiB;
constexpr size_t WS_WOUT = 30 * MiB;
constexpr size_t WS_WP = 34 * MiB;
constexpr size_t WS_H = 64 * MiB;
constexpr size_t WS_HN = 128 * MiB;
constexpr size_t WS_BIG = 160 * MiB;
constexpr size_t WS_VT = 224 * MiB;
constexpr size_t WS_MIX = 256 * MiB;
constexpr size_t WS_SELI = 288 * MiB;
constexpr size_t WS_SELG = 296 * MiB;
constexpr size_t WS_UP = 320 * MiB;
constexpr size_t WS_DN = 384 * MiB;
constexpr size_t WS_SUP = 448 * MiB;
constexpr size_t WS_SDN = 449 * MiB;
constexpr size_t WS_RSS = 450 * MiB;
constexpr size_t WS_SC = 576 * MiB;
constexpr size_t WS_END = 704 * MiB;
constexpr int CW_BAR = 4096;
static_assert((CW_BAR + 3456) * 4 <= (int)CTL_ZERO_BYTES, "barrier words inside the per-call memset");

constexpr int LDS_BYTES = 163840, MISC_OFF = LDS_BYTES - 256, PTAB_OFF = LDS_BYTES - 512;

#define LAS __attribute__((address_space(3)))
typedef unsigned short bf16;
typedef unsigned v4u __attribute__((ext_vector_type(4)));
typedef unsigned v2u __attribute__((ext_vector_type(2)));
typedef float f32x4 __attribute__((ext_vector_type(4)));
typedef short bf16x8 __attribute__((ext_vector_type(8)));
#define LDS_WAIT() asm volatile("s_waitcnt lgkmcnt(0)" ::: "memory")
#define BLOCK_BAR() do { asm volatile("s_waitcnt vmcnt(0) lgkmcnt(0)" ::: "memory"); __builtin_amdgcn_s_barrier(); asm volatile("" ::: "memory"); } while (0)
__device__ __forceinline__ unsigned f2bf(float f) { unsigned u = __builtin_bit_cast(unsigned, f); return (u + 0x7fffu + ((u >> 16) & 1u)) >> 16; }
typedef float f32x2p __attribute__((ext_vector_type(2))); typedef __bf16 bf16x2p __attribute__((ext_vector_type(2)));
__device__ __forceinline__ unsigned pk2(float lo, float hi) { const f32x2p v = {lo, hi}; return __builtin_bit_cast(unsigned, __builtin_convertvector(v, bf16x2p)); }
__device__ __forceinline__ float bflo(unsigned u) { return __builtin_bit_cast(float, u << 16); }
__device__ __forceinline__ float bfhi(unsigned u) { return __builtin_bit_cast(float, u & 0xffff0000u); }
__device__ __forceinline__ float wave_sum(float v) {
#pragma unroll
    for (int o = 1; o < 64; o <<= 1) v += __shfl_xor(v, o);
    return v;
}

#define XB_TMO      128
#define XB_XCNT(j)  (256  + 64 * (j))
#define XB_XSUB(j)  (1280 + 64 * (j))
#define XB_XGEN(j)  (2304 + 64 * (j))
#define XB_TOP      3328
#define XB_TOPGEN   3392
#define XCD_BAR_WORDS 3456
#define XB_SPIN_CAP (1u << 20)
__device__ __forceinline__ unsigned xb_ld(unsigned* p)              { return __hip_atomic_load(p, __ATOMIC_RELAXED, __HIP_MEMORY_SCOPE_AGENT); }
__device__ __forceinline__ unsigned xb_add(unsigned* p, unsigned v) { return __hip_atomic_fetch_add(p, v, __ATOMIC_RELAXED, __HIP_MEMORY_SCOPE_AGENT); }
__device__ __forceinline__ unsigned xb_xcc_id() { return (unsigned)__builtin_amdgcn_s_getreg((3 << 11) | 20) & 0xFu; }
#define XB_SPIN(cond, bar) do { unsigned _sp = 0; while (cond) { __builtin_amdgcn_s_sleep(1); \
    if ((++_sp & 255u) == 0u) { if (xb_ld(&(bar)[XB_TMO])) break; if (_sp > XB_SPIN_CAP) { atomicAdd(&(bar)[XB_TMO], 1u); break; } } } } while (0)
struct XcdBarrier { unsigned* bar; unsigned x; volatile LAS unsigned* st; };
__device__ __forceinline__ XcdBarrier xcd_barrier_post(unsigned* bar, volatile LAS unsigned* st) {
    XcdBarrier b; b.bar = bar; b.x = xb_xcc_id(); b.st = st;
    if (threadIdx.x == 0) (void)xb_add(&bar[XB_XCNT(b.x)], 1u);
    return b;
}
__device__ __forceinline__ void xcd_barrier_complete(unsigned* bar, unsigned x, unsigned& nloc, unsigned& nx) {
    const unsigned G = gridDim.x * gridDim.y * gridDim.z;
    unsigned sum, cnt, mine, sp = 0u;
    for (;;) {
        sum = 0u; cnt = 0u; mine = 0u;
#pragma unroll
        for (unsigned j = 0; j < 16; ++j) { const unsigned c = xb_ld(&bar[XB_XCNT(j)]); sum += c; cnt += (c > 0u) ? 1u : 0u; mine = (j == x) ? c : mine; }
        if (sum == G) break;
        __builtin_amdgcn_s_sleep(1);
        if ((++sp & 255u) == 0u) { if (xb_ld(&bar[XB_TMO])) break; if (sp > XB_SPIN_CAP) { atomicAdd(&bar[XB_TMO], 1u); break; } }
    }
    nloc = mine > 0u ? mine : 1u; nx = cnt > 0u ? cnt : 1u;
}
__device__ __forceinline__ void xcd_barrier(const XcdBarrier& b) {
    asm volatile("s_waitcnt vmcnt(0)" ::: "memory");
    __syncthreads();
    if (threadIdx.x == 0) {
        unsigned* bar = b.bar;
        __builtin_amdgcn_s_waitcnt(0);
        unsigned nloc = b.st[0], nx = b.st[1];
        if (nloc == 0u) { xcd_barrier_complete(bar, b.x, nloc, nx); b.st[0] = nloc; b.st[1] = nx; }
        const unsigned old = xb_add(&bar[XB_XSUB(b.x)], 1u);
        const unsigned gen = old / nloc;
        if (old + 1u == (gen + 1u) * nloc) {
            __builtin_amdgcn_fence(__ATOMIC_RELEASE, "agent");
            asm volatile("s_waitcnt vmcnt(0)" ::: "memory");
            const unsigned og = xb_add(&bar[XB_TOP], 1u);
            const unsigned tg = og / nx;
            if (og + 1u == (tg + 1u) * nx) xb_add(&bar[XB_TOPGEN], 1u);
            else XB_SPIN(xb_ld(&bar[XB_TOPGEN]) == tg, bar);
            __builtin_amdgcn_fence(__ATOMIC_ACQUIRE, "agent");
            xb_add(&bar[XB_XGEN(b.x)], 1u);
            asm volatile("s_waitcnt vmcnt(0)" ::: "memory");
        } else {
            XB_SPIN(xb_ld(&bar[XB_XGEN(b.x)]) == gen, bar);
            __builtin_amdgcn_fence(__ATOMIC_ACQUIRE, "agent");
            asm volatile("s_waitcnt vmcnt(0)" ::: "memory");
        }
    }
    __syncthreads();
}

struct Frame {
    LAS unsigned char* lds;
    int tid, lane, wave, vcu, G;
    unsigned char* ws;
    __device__ __forceinline__ const float* in(int i) const {
        const volatile LAS unsigned* t = (const volatile LAS unsigned*)(lds + PTAB_OFF);
        const unsigned lo = __builtin_amdgcn_readfirstlane(t[2 * i]), hi = __builtin_amdgcn_readfirstlane(t[2 * i + 1]);
        return (const float*)(const __attribute__((address_space(1))) float*)(((unsigned long long)hi << 32) | lo);
    }
    __device__ __forceinline__ float* out() const { return (float*)in(14); }
};

template <bool FIRST> struct EpiRes {
    static constexpr bool PERM = false, AFTER_DRAIN = false;
    const void* hin; bf16* h; float* rss;
    __device__ __forceinline__ void operator()(const pg8::f32x4 (&acc)[2][2][4][2], const pg8::Unit& u, int wr, int wc, int fr, int fq) const {
        const int col0 = u.pn * 256 + wc * 32 + 4 * fq;
#pragma unroll
        for (int ai = 0; ai < 2; ++ai)
#pragma unroll
            for (int m = 0; m < 4; ++m) { const int row = u.pm * 256 + ai * 128 + wr * 64 + m * 16 + fr; bf16* rowp = h + (size_t)row * D + col0;
                float ss = 0.f;
#pragma unroll
                for (int bj = 0; bj < 2; ++bj)
#pragma unroll
                    for (int n = 0; n < 2; ++n) { f32x4 v;
                        if (FIRST) v = *(const f32x4*)((const float*)hin + (size_t)row * D + col0 + bj * 128 + n * 16);
                        else { const v2u hw = *(const v2u*)((const bf16*)hin + (size_t)row * D + col0 + bj * 128 + n * 16); v = (f32x4){bflo(hw.x), bfhi(hw.x), bflo(hw.y), bfhi(hw.y)}; }
                        v += acc[ai][bj][m][n];
                        ss += (v.x * v.x + v.y * v.y) + (v.z * v.z + v.w * v.w);
                        v2u w; w.x = pk2(v.x, v.y); w.y = pk2(v.z, v.w); *(v2u*)(rowp + bj * 128 + n * 16) = w; }
                ss += __shfl_xor(ss, 16); ss += __shfl_xor(ss, 32);
                if (fq == 0) rss[(size_t)row * 16 + u.pn * 4 + wc] = ss; }
    }
};
struct EpiConvIn {
    static constexpr bool PERM = true, AFTER_DRAIN = false;
    bf16* U; bf16* GB;
    __device__ __forceinline__ void operator()(const pg8::f32x4 (&acc)[2][2][4][2], const pg8::Unit& u, int wr, int wc, int fr, int fq) const {
        const int row0 = u.pm * 256 + wr * 64 + fr;
        if (u.pn < 8) {
            const int ch0 = u.pn * 128 + wc * 32 + 8 * fq;
#pragma unroll
            for (int ai = 0; ai < 2; ++ai)
#pragma unroll
                for (int m = 0; m < 4; ++m) { const f32x4 p0 = acc[ai][0][m][0] * acc[ai][1][m][0], p1 = acc[ai][0][m][1] * acc[ai][1][m][1];
                    v4u w; w.x = pk2(p0[0], p0[1]); w.y = pk2(p0[2], p0[3]); w.z = pk2(p1[0], p1[1]); w.w = pk2(p1[2], p1[3]);
                    *(v4u*)(U + (size_t)(row0 + ai * 128 + m * 16) * D + ch0) = w; }
        } else {
            const int col0 = (u.pn - 8) * 256 + wc * 32 + 8 * fq;
#pragma unroll
            for (int ai = 0; ai < 2; ++ai)
#pragma unroll
                for (int m = 0; m < 4; ++m)
#pragma unroll
                    for (int bj = 0; bj < 2; ++bj) { const f32x4 v0 = acc[ai][bj][m][0], v1 = acc[ai][bj][m][1];
                        v4u w; w.x = pk2(v0[0], v0[1]); w.y = pk2(v0[2], v0[3]); w.z = pk2(v1[0], v1[1]); w.w = pk2(v1[2], v1[3]);
                        *(v4u*)(GB + (size_t)(row0 + ai * 128 + m * 16) * D + col0 + bj * 128) = w; }
        }
    }
};
struct EpiF32 {
    static constexpr bool PERM = false, AFTER_DRAIN = false;
    float* O; int ldc;
    __device__ __forceinline__ void operator()(const pg8::f32x4 (&acc)[2][2][4][2], const pg8::Unit& u, int wr, int wc, int fr, int fq) const {
        const int col0 = u.pn * 256 + wc * 32 + 4 * fq;
#pragma unroll
        for (int ai = 0; ai < 2; ++ai)
#pragma unroll
            for (int m = 0; m < 4; ++m) { float* rowp = O + (size_t)(u.pm * 256 + ai * 128 + wr * 64 + m * 16 + fr) * ldc + col0;
#pragma unroll
                for (int bj = 0; bj < 2; ++bj)
#pragma unroll
                    for (int n = 0; n < 2; ++n) *(f32x4*)(rowp + bj * 128 + n * 16) = acc[ai][bj][m][n]; }
    }
};
struct EpiTopK {
    static constexpr bool PERM = false, AFTER_DRAIN = true;
    int* seli; float* selg; const float* rss;
    __device__ __forceinline__ void operator()(const pg8::f32x4 (&)[2][2][4][2], const pg8::Unit&, int, int, int, int) const {}
    __device__ __forceinline__ void fused(pg8::f32x4 (&acc)[2][2][4][2], const pg8::Unit& u, int wr, int wc, int fr, int fq, LAS unsigned char* lds, int wid, int lane) const {
        LAS float* S = (LAS float*)lds;
        LAS int* L = (LAS int*)lds;
        const int tid = wid * 64 + lane;
#pragma unroll 1
        for (int ai = 0; ai < 2; ++ai) {
#pragma unroll
            for (int m = 0; m < 4; ++m)
#pragma unroll
                for (int bj = 0; bj < 2; ++bj)
#pragma unroll
                    for (int n = 0; n < 2; ++n) {
                        const int row = wr * 64 + m * 16 + fr, col = bj * 128 + wc * 32 + n * 16 + 4 * fq;
                        *(LAS f32x4*)(S + row * 260 + col) = ai == 0 ? acc[0][bj][m][n] : acc[1][bj][m][n];
                    }
            BLOCK_BAR();
            const int row = tid & 127, q = tid >> 7;
            int best[16];
            {
                const LAS f32x4* sp = (const LAS f32x4*)(S + row * 260 + q * 64);
#pragma unroll
                for (int c = 0; c < 4; ++c) {
                    int x[16];
#pragma unroll
                    for (int e4 = 0; e4 < 4; ++e4) { const f32x4 v = sp[c * 4 + e4];
#pragma unroll
                        for (int e = 0; e < 4; ++e) x[e4 * 4 + e] = (tk_map(v[e]) & ~127) | (127 - ((q & 1) * 64 + c * 16 + e4 * 4 + e)); }
                    tk_sort_desc(x);
                    if (c == 0) {
#pragma unroll
                        for (int e = 0; e < 16; ++e) best[e] = x[e];
                    } else tk_merge_top(best, x);
                }
            }
            BLOCK_BAR();
#pragma unroll
            for (int e4 = 0; e4 < 4; ++e4) *(LAS v4u*)(L + row * 68 + q * 16 + e4 * 4) = (v4u){(unsigned)best[e4 * 4], (unsigned)best[e4 * 4 + 1], (unsigned)best[e4 * 4 + 2], (unsigned)best[e4 * 4 + 3]};
            BLOCK_BAR();
            if (tid < 128) {
                int a[16], b[16], t[16];
                LAS int* Lr = L + tid * 68;
#pragma unroll
                for (int e4 = 0; e4 < 4; ++e4) { const v4u va = *(LAS v4u*)(Lr + e4 * 4), vt = *(LAS v4u*)(Lr + 16 + e4 * 4);
#pragma unroll
                    for (int e = 0; e < 4; ++e) { a[e4 * 4 + e] = (int)va[e]; t[e4 * 4 + e] = (int)vt[e]; } }
                tk_merge_top(a, t);
#pragma unroll
                for (int e4 = 0; e4 < 4; ++e4) { const v4u vb = *(LAS v4u*)(Lr + 32 + e4 * 4), vt = *(LAS v4u*)(Lr + 48 + e4 * 4);
#pragma unroll
                    for (int e = 0; e < 4; ++e) { b[e4 * 4 + e] = (int)vb[e]; t[e4 * 4 + e] = (int)vt[e]; } }
                tk_merge_top(b, t);
                const int trow = u.pm * 256 + ai * 128 + tid;
                const f32x4 q0 = *(const f32x4*)(rss + (size_t)trow * 16), q1 = *(const f32x4*)(rss + (size_t)trow * 16 + 4), q2 = *(const f32x4*)(rss + (size_t)trow * 16 + 8), q3 = *(const f32x4*)(rss + (size_t)trow * 16 + 12);
                const float ssq = (((q0.x + q0.y) + (q0.z + q0.w)) + ((q1.x + q1.y) + (q1.z + q1.w))) + (((q2.x + q2.y) + (q2.z + q2.w)) + ((q3.x + q3.y) + (q3.z + q3.w)));
                const float rstd = 1.0f / sqrtf(ssq * (1.f / D) + RMS_EPS);
                const size_t o = ((size_t)trow * 8 + u.pn) * 16;
                tk_stage2(a, b, Lr, (__attribute__((address_space(1))) int*)(seli + o), (__attribute__((address_space(1))) float*)(selg + o), rstd);
            }
            BLOCK_BAR();
        }
    }
};
struct OneUnit {
    pg8::Unit u;
    __device__ __forceinline__ bool next(int i, pg8::Unit& o) const { if (i != 0) return false; o = u; return true; }
    __device__ __forceinline__ void a_ready(const pg8::Unit&) const {}
    __device__ __forceinline__ void done(const pg8::Unit&) const {}
};

__device__ __forceinline__ void p0_transpose_item(const float* W, int ldw, int ncols, bf16* WT, float scale, LAS float* scr, int item, int lane) {
    const int nblk = ncols / 64, kb = item / nblk, nb = item % nblk, k0 = 64 * kb, n0 = 64 * nb;
    f32x4 v[16];
#pragma unroll
    for (int i = 0; i < 16; ++i) v[i] = *(const f32x4*)(W + (size_t)(k0 + 4 * i + (lane >> 4)) * ldw + n0 + 4 * (lane & 15));
#pragma unroll
    for (int i = 0; i < 16; ++i) { LAS float* p = scr + (4 * i + (lane >> 4)) * 65 + 4 * (lane & 15); p[0] = v[i].x * scale; p[1] = v[i].y * scale; p[2] = v[i].z * scale; p[3] = v[i].w * scale; }
    LDS_WAIT(); asm volatile("" ::: "memory");
    const int c = lane & 7;
#pragma unroll
    for (int j = 0; j < 8; ++j) { const int n = (lane >> 3) + 8 * j; const LAS float* s = scr + (8 * c) * 65 + n;
        v4u o; o.x = pk2(s[0 * 65], s[1 * 65]); o.y = pk2(s[2 * 65], s[3 * 65]); o.z = pk2(s[4 * 65], s[5 * 65]); o.w = pk2(s[6 * 65], s[7 * 65]);
        *(v4u*)(WT + (size_t)(n0 + n) * 1024 + k0 + 8 * c) = o; }
    LDS_WAIT(); asm volatile("" ::: "memory");
}
__device__ __forceinline__ void rms_row_to_bf16(const float* xrow, const float* gain, bf16* orow, float* hcopy, int lane) {
    const f32x4* xr = (const f32x4*)xrow + lane; const f32x4* gr = (const f32x4*)gain + lane;
    f32x4 v[4]; float s = 0.f;
#pragma unroll
    for (int j = 0; j < 4; ++j) { v[j] = xr[64 * j]; s += (v[j].x * v[j].x + v[j].y * v[j].y) + (v[j].z * v[j].z + v[j].w * v[j].w); }
    if (hcopy) {
#pragma unroll
        for (int j = 0; j < 4; ++j) ((f32x4*)hcopy + lane)[64 * j] = v[j];
    }
    const float rstd = 1.0f / sqrtf(wave_sum(s) * (1.f / D) + RMS_EPS);
    unsigned long long* o8 = (unsigned long long*)orow + lane;
#pragma unroll
    for (int j = 0; j < 4; ++j) { const f32x4 g = gr[64 * j]; const f32x4 y = v[j] * rstd * g;
        o8[64 * j] = (unsigned long long)pk2(y.x, y.y) | ((unsigned long long)pk2(y.z, y.w) << 32); }
}
__device__ __forceinline__ void p0_prologue(Frame& F, bool dry) {
    if (!(dry && PROBE_PMODE == 1)) {
        LAS float* KL = (LAS float*)F.lds;
        LAS float* WL = (LAS float*)(F.lds + 128 * 132 * 4);
        const float* in10 = F.in(10); const float* in11 = F.in(11); const float* in2 = F.in(2);
        f32x4 kreg[8], wreg[4];
#define FOLD_LOAD(it_) do { const int l_ = (it_) >> 8, hp_ = ((it_) >> 4) & 15, k0_ = ((it_) & 15) * 64; \
            const float* kg_ = in11 + (size_t)(l_ * 16 + hp_) * 128 * 128; const float* wg_ = in10 + (size_t)l_ * 1024 * 2048 + (size_t)k0_ * 2048 + hp_ * 128; \
            _Pragma("unroll") for (int i = 0; i < 8; ++i) kreg[i] = *(const f32x4*)(kg_ + 4 * (F.tid + 512 * i)); \
            _Pragma("unroll") for (int i = 0; i < 4; ++i) { const int e = 4 * (F.tid + 512 * i); wreg[i] = *(const f32x4*)(wg_ + (size_t)(e >> 7) * 2048 + (e & 127)); } } while (0)
        if (F.vcu < DEPTH * 16 * 16) FOLD_LOAD(F.vcu);
        for (int it = F.vcu; it < DEPTH * 16 * 16; it += F.G) {
            const int l = it >> 8, hp = (it >> 4) & 15, k0 = (it & 15) * 64;
#pragma unroll
            for (int i = 0; i < 8; ++i) { const int e = 4 * (F.tid + 512 * i), n = e >> 7, d = e & 127; *(LAS f32x4*)(KL + n * 132 + d) = kreg[i]; }
#pragma unroll
            for (int i = 0; i < 4; ++i) { const int e = 4 * (F.tid + 512 * i), kk = e >> 7, d = e & 127; *(LAS f32x4*)(WL + kk * 132 + d) = wreg[i]; }
            if (it + F.G < DEPTH * 16 * 16) FOLD_LOAD(it + F.G);
            BLOCK_BAR();
            {
                const int i16 = F.lane & 15, g4 = F.lane >> 4, nt = F.wave;
                f32x4 facc[4];
#pragma unroll
                for (int mt = 0; mt < 4; ++mt) facc[mt] = (f32x4){0.f, 0.f, 0.f, 0.f};
#pragma unroll 2
                for (int s8 = 0; s8 < 8; ++s8) {
                    const f32x4 bq = *(const LAS f32x4*)(KL + (nt * 16 + i16) * 132 + 16 * s8 + 4 * g4);
                    f32x4 aq[4];
#pragma unroll
                    for (int mt = 0; mt < 4; ++mt) aq[mt] = *(const LAS f32x4*)(WL + (mt * 16 + i16) * 132 + 16 * s8 + 4 * g4);
#pragma unroll
                    for (int t = 0; t < 4; ++t)
#pragma unroll
                        for (int mt = 0; mt < 4; ++mt) facc[mt] = __builtin_amdgcn_mfma_f32_16x16x4f32(aq[mt][t], bq[t], facc[mt], 0, 0, 0);
                }
                bf16* o = (bf16*)(F.ws + WS_WP) + (size_t)l * 2048 * 1024 + (size_t)(hp * 128 + nt * 16 + i16) * 1024 + k0 + 4 * g4;
#pragma unroll
                for (int mt = 0; mt < 4; ++mt) { const f32x4 gf = *(const f32x4*)(in2 + (size_t)l * D + k0 + mt * 16 + 4 * g4); v2u w; w.x = pk2(facc[mt][0] * gf.x, facc[mt][1] * gf.y); w.y = pk2(facc[mt][2] * gf.z, facc[mt][3] * gf.w); *(v2u*)(o + mt * 16) = w; }
            }
            BLOCK_BAR();
        }
#undef FOLD_LOAD
    }
    LAS float* scr = (LAS float*)(F.lds + F.wave * 16640);
    const int gw = F.vcu * NWAVES + F.wave, NGW = F.G * NWAVES;
    constexpr int I_SQ = 16 * 16, I_IN = 16 * 48, PER_J = 3 * I_SQ + I_SQ + I_IN + I_SQ;
    if (!(dry && PROBE_PMODE == 2)) for (int it = gw; it < 2 * PER_J; it += NGW) {
        const int j = it / PER_J; int r = it % PER_J;
        const float* wqkv = F.in(4) + (size_t)j * 1024 * 3072;
        if (r < I_SQ) { p0_transpose_item(wqkv, 3072, 1024, (bf16*)(F.ws + WS_WQK) + (size_t)j * 2048 * 1024, 0.125f, scr, r, F.lane); continue; } r -= I_SQ;
        if (r < I_SQ) { p0_transpose_item(wqkv + 1024, 3072, 1024, (bf16*)(F.ws + WS_WQK) + (size_t)j * 2048 * 1024 + (size_t)1024 * 1024, 1.f, scr, r, F.lane); continue; } r -= I_SQ;
        if (r < I_SQ) { p0_transpose_item(wqkv + 2048, 3072, 1024, (bf16*)(F.ws + WS_WV) + (size_t)j * 1024 * 1024, 1.f, scr, r, F.lane); continue; } r -= I_SQ;
        if (r < I_SQ) { p0_transpose_item(F.in(5) + (size_t)j * 1024 * 1024, 1024, 1024, (bf16*)(F.ws + WS_WO) + (size_t)j * 1024 * 1024, 1.f, scr, r, F.lane); continue; } r -= I_SQ;
        if (r < I_IN) {
            const float* win = F.in(7) + (size_t)j * 1024 * 3072; bf16* wt = (bf16*)(F.ws + WS_WIN) + (size_t)j * 3072 * 1024;
            if (r < 512) { const int blk = r >> 5, pn = blk >> 1, which = blk & 1; p0_transpose_item(win + (which ? 2048 : 1024) + 128 * pn, 3072, 128, wt + (size_t)(256 * pn + 128 * which) * 1024, 1.f, scr, r & 31, F.lane); }
            else p0_transpose_item(win, 3072, 1024, wt + (size_t)2048 * 1024, 1.f, scr, r - 512, F.lane);
            continue; } r -= I_IN;
        p0_transpose_item(F.in(9) + (size_t)j * 1024 * 1024, 1024, 1024, (bf16*)(F.ws + WS_WOUT) + (size_t)j * 1024 * 1024, 1.f, scr, r, F.lane);
    }
    if (!(dry && PROBE_PMODE == 3)) {
        constexpr int NROW = DEPTH * 16384;
        const float* in12 = F.in(12); const float* in13 = F.in(13);
#define XC_LOAD(v, r0_) do { const int tb_ = (r0_) >= NROW ? 1 : 0, rr_ = (r0_) - tb_ * NROW; const float* src_ = (tb_ ? in13 : in12) + (size_t)rr_ * 1024 + 16 * F.lane; \
            _Pragma("unroll") for (int u = 0; u < 4; ++u) _Pragma("unroll") for (int i = 0; i < 4; ++i) v[u][i] = *(const f32x4*)(src_ + (size_t)u * 1024 + 4 * i); } while (0)
#if EXPERT_FP4
#define XC_PACK(v, u, q, dstp) do { v2u w_; _Pragma("unroll") for (int jj = 0; jj < 2; ++jj) { unsigned t_ = 0u; \
                    t_ = __builtin_amdgcn_cvt_scalef32_pk_fp4_f32(t_, v[u][2 * jj].x * q, v[u][2 * jj].y * q, 1.0f, 0); t_ = __builtin_amdgcn_cvt_scalef32_pk_fp4_f32(t_, v[u][2 * jj].z * q, v[u][2 * jj].w * q, 1.0f, 1); \
                    t_ = __builtin_amdgcn_cvt_scalef32_pk_fp4_f32(t_, v[u][2 * jj + 1].x * q, v[u][2 * jj + 1].y * q, 1.0f, 2); t_ = __builtin_amdgcn_cvt_scalef32_pk_fp4_f32(t_, v[u][2 * jj + 1].z * q, v[u][2 * jj + 1].w * q, 1.0f, 3); w_[jj] = t_; } \
                *(v2u*)(dstp) = w_; } while (0)
        constexpr float QMAX = 6.0f;
#else
#define XC_PACK(v, u, q, dstp) do { v4u w_; _Pragma("unroll") for (int i = 0; i < 4; ++i) { unsigned t_ = 0u; t_ = __builtin_amdgcn_cvt_pk_fp8_f32(v[u][i].x * q, v[u][i].y * q, t_, false); t_ = __builtin_amdgcn_cvt_pk_fp8_f32(v[u][i].z * q, v[u][i].w * q, t_, true); w_[i] = t_; } \
                *(v4u*)(dstp) = w_; } while (0)
        constexpr float QMAX = 256.0f;
#endif
#define XC_I4(x_) ((unsigned)__float2int_rn(x_) & 15u)
#define XC_PACK_I4(v, u, q, dstp) do { v2u w_; _Pragma("unroll") for (int jj = 0; jj < 2; ++jj) { const f32x4 a_ = v[u][2 * jj] * q, b_ = v[u][2 * jj + 1] * q; \
                    w_[jj] = XC_I4(a_.x) | (XC_I4(a_.y) << 4) | (XC_I4(a_.z) << 8) | (XC_I4(a_.w) << 12) | (XC_I4(b_.x) << 16) | (XC_I4(b_.y) << 20) | (XC_I4(b_.z) << 24) | (XC_I4(b_.w) << 28); } \
                *(v2u*)(dstp) = w_; } while (0)
#define XC_CONV(v, r0_) do { const int tb_ = (r0_) >= NROW ? 1 : 0, rr_ = (r0_) - tb_ * NROW; \
            unsigned char* dst_ = F.ws + (tb_ ? WS_DN : WS_UP) + (size_t)rr_ * ROWB + (ROWB / 64) * F.lane; float* sc_ = (float*)(F.ws + (tb_ ? WS_SDN : WS_SUP)) + rr_; \
            _Pragma("unroll") for (int u = 0; u < 4; ++u) { float mx = 0.f; \
                _Pragma("unroll") for (int i = 0; i < 4; ++i) mx = fmaxf(fmaxf(mx, fmaxf(fabsf(v[u][i].x), fabsf(v[u][i].y))), fmaxf(fabsf(v[u][i].z), fabsf(v[u][i].w))); \
                _Pragma("unroll") for (int o = 1; o < 64; o <<= 1) mx = fmaxf(mx, __shfl_xor(mx, o)); \
                if (tb_) { const float q = mx > 0.f ? 7.0f / mx : 1.0f; XC_PACK_I4(v, u, q, dst_ + (size_t)u * ROWB); if (F.lane == 0) sc_[u] = mx > 0.f ? mx * (1.0f / 7.0f) : 1.0f; } \
                else { const float q = mx > 0.f ? QMAX / mx : 1.0f; XC_PACK(v, u, q, dst_ + (size_t)u * ROWB); if (F.lane == 0) sc_[u] = mx > 0.f ? mx * (1.0f / QMAX) : 1.0f; } } } while (0)
        const int stepr = NGW * 4;
        f32x4 va[4][4], vb[4][4];
        int r0 = gw * 4;
        if (r0 < 2 * NROW) XC_LOAD(va, r0);
#pragma unroll 1
        for (; r0 < 2 * NROW; r0 += 2 * stepr) {
            if (r0 + stepr < 2 * NROW) XC_LOAD(vb, r0 + stepr);
            XC_CONV(va, r0);
            if (r0 + 2 * stepr < 2 * NROW) XC_LOAD(va, r0 + 2 * stepr);
            if (r0 + stepr < 2 * NROW) XC_CONV(vb, r0 + stepr);
        }
#undef XC_LOAD
#undef XC_PACK
#undef XC_PACK_I4
#undef XC_I4
#undef XC_CONV
    }
    if (!(dry && PROBE_PMODE == 4)) {
        const float* x0 = F.in(0); const f32x4* gr = (const f32x4*)F.in(1) + F.lane;
        f32x4 gq[4];
#pragma unroll
        for (int j = 0; j < 4; ++j) gq[j] = gr[64 * j];
#pragma unroll 1
        for (int m0 = gw; m0 < M; m0 += 4 * NGW) {
            f32x4 v[4][4];
#pragma unroll
            for (int u = 0; u < 4; ++u) { const int m = m0 + u * NGW; if (m < M) {
#pragma unroll
                for (int j = 0; j < 4; ++j) v[u][j] = ((const f32x4*)(x0 + (size_t)m * D) + F.lane)[64 * j]; } }
#pragma unroll
            for (int u = 0; u < 4; ++u) { const int m = m0 + u * NGW; if (m < M) {
                float sq = 0.f;
#pragma unroll
                for (int j = 0; j < 4; ++j) { sq += (v[u][j].x * v[u][j].x + v[u][j].y * v[u][j].y) + (v[u][j].z * v[u][j].z + v[u][j].w * v[u][j].w); }
                const float rstd = 1.0f / sqrtf(wave_sum(sq) * (1.f / D) + RMS_EPS);
                unsigned long long* o8 = (unsigned long long*)((bf16*)(F.ws + WS_HN) + (size_t)m * D) + F.lane;
#pragma unroll
                for (int j = 0; j < 4; ++j) { const f32x4 y = v[u][j] * rstd * gq[j]; o8[64 * j] = (unsigned long long)pk2(y.x, y.y) | ((unsigned long long)pk2(y.z, y.w) << 32); } } }
        }
    }
}

__device__ __forceinline__ void conv_phase(Frame& F, int j) {
    const bf16* U = (const bf16*)(F.ws + WS_BIG); const bf16* GB = (const bf16*)(F.ws + WS_BIG + 32 * MiB); bf16* mix = (bf16*)(F.ws + WS_MIX);
    const float* wc = F.in(8) + (size_t)j * 3 * 1024;
    for (int idx = F.vcu * NTHR + F.tid; idx < M * 128; idx += F.G * NTHR) {
        const int t = idx >> 7, c8 = (idx & 127) * 8, s = t & (SEQ - 1);
        const v4u gb = *(const v4u*)(GB + (size_t)t * D + c8);
        float conv[8];
#pragma unroll
        for (int e = 0; e < 8; ++e) conv[e] = 0.f;
#pragma unroll
        for (int dj = -1; dj <= 1; ++dj) {
            if (s + dj >= 0 && s + dj < SEQ) {
                const v4u uu = *(const v4u*)(U + (size_t)(t + dj) * D + c8);
                const f32x4 w0 = *(const f32x4*)(wc + (dj + 1) * 1024 + c8), w1 = *(const f32x4*)(wc + (dj + 1) * 1024 + c8 + 4);
#pragma unroll
                for (int e2 = 0; e2 < 4; ++e2) {
                    const float wl = e2 < 2 ? w0[2 * e2] : w1[2 * e2 - 4], wh = e2 < 2 ? w0[2 * e2 + 1] : w1[2 * e2 - 3];
                    conv[2 * e2] += wl * bflo(uu[e2]); conv[2 * e2 + 1] += wh * bfhi(uu[e2]);
                }
            }
        }
        v4u o;
#pragma unroll
        for (int e2 = 0; e2 < 4; ++e2) o[e2] = pk2(bflo(gb[e2]) * conv[2 * e2], bfhi(gb[e2]) * conv[2 * e2 + 1]);
        *(v4u*)(mix + (size_t)t * 1024 + c8) = o;
    }
}

constexpr int AT_KSTR = 144, AT_VSTR = 1168, AT_KOFF = 0, AT_VOFF = 576 * AT_KSTR, AT_BOFF = AT_VOFF + 64 * AT_VSTR;
static_assert(AT_BOFF + 1860 <= PTAB_OFF, "attention LDS map");
__device__ __forceinline__ void attn_phase(Frame& F, int j) {
    const bf16* QK = (const bf16*)(F.ws + WS_BIG); const bf16* VT = (const bf16*)(F.ws + WS_VT); bf16* mix = (bf16*)(F.ws + WS_MIX);
    const float* biasl = F.in(6) + (size_t)j * NH * 15 * 31;
    const int lane = F.lane, q = lane & 15, g = lane >> 4, tid = F.tid;
    LAS unsigned char* KL = F.lds + AT_KOFF; LAS unsigned char* VL = F.lds + AT_VOFF; LAS float* btab = (LAS float*)(F.lds + AT_BOFF);
    v4u kreg[9], vreg[9];
    int cur_hh = -1;
#define AT_DECODE(it, b_, hh_, r0_, R0_) const int hh_ = (it) & 15, rp_##it = ((it) >> 4) & 63, b_ = (it) >> 10, r0_ = 2 * rp_##it; int R0_ = r0_ - 4; R0_ = R0_ < 0 ? 0 : (R0_ > NROWS - 8 ? NROWS - 8 : R0_);
#define AT_PREFETCH(it) do { AT_DECODE(it, pb, phh, pr0, pR0) \
        _Pragma("unroll") for (int i = 0; i < 9; ++i) { const int c = tid + 512 * i; \
            { const int key = c >> 3, ch = c & 7; int row = pR0 + (key >> 6); row = row > NROWS - 1 ? NROWS - 1 : row; \
              kreg[i] = *(const v4u*)(QK + ((size_t)pb * SEQ + row * 64 + (key & 63)) * 2048 + 1024 + phh * 64 + ch * 8); } \
            { const int d = c / 72, kch = c - d * 72; vreg[i] = *(const v4u*)(VT + (size_t)(phh * 64 + d) * M + (size_t)pb * SEQ + pR0 * 64 + kch * 8); } } } while (0)
    int it = F.vcu;
    if (it < 2048) AT_PREFETCH(it);
    for (; it < 2048; it += F.G) {
        AT_DECODE(it, b, hh, r0, R0)
        BLOCK_BAR();
#pragma unroll
        for (int i = 0; i < 9; ++i) { const int c = tid + 512 * i;
            *(LAS v4u*)(KL + (c >> 3) * AT_KSTR + (c & 7) * 16) = kreg[i];
            const int d = c / 72, kch = c - d * 72; *(LAS v4u*)(VL + d * AT_VSTR + kch * 16) = vreg[i]; }
        if (hh != cur_hh) { if (tid < 465) btab[tid] = biasl[(size_t)hh * 465 + tid]; cur_hh = hh; }
        BLOCK_BAR();
        const int r = r0 + (F.wave >> 2), jb = F.wave & 3;
        int rs = r - 4; rs = rs < 0 ? 0 : (rs > NROWS - 8 ? NROWS - 8 : rs);
        const int lr0 = rs - R0;
        int bs = 16 * jb - 8; bs = bs < 0 ? 0 : (bs > 32 ? 32 : bs);
        const int qc = 16 * jb + q; int wst = qc - 8; wst = wst < 0 ? 0 : (wst > 48 ? 48 : wst);
        const size_t tokq = (size_t)b * SEQ + r * 64 + qc;
        bf16x8 qf[2];
#pragma unroll
        for (int ks = 0; ks < 2; ++ks) qf[ks] = *(const bf16x8*)(QK + tokq * 2048 + hh * 64 + ks * 32 + 8 * g);
        f32x4 S[8][2];
        const int kcl_a = 8 * (q >> 2) + (q & 3);
#pragma unroll
        for (int wr = 0; wr < 8; ++wr)
#pragma unroll
            for (int T = 0; T < 2; ++T) {
                const LAS unsigned char* kp = KL + ((lr0 + wr) * 64 + bs + kcl_a + 4 * T) * AT_KSTR + 16 * g;
                const bf16x8 k0 = *(const LAS bf16x8*)kp, k1 = *(const LAS bf16x8*)(kp + 64);
                f32x4 c = (f32x4){0.f, 0.f, 0.f, 0.f};
                c = __builtin_amdgcn_mfma_f32_16x16x32_bf16(k0, qf[0], c, 0, 0, 0);
                c = __builtin_amdgcn_mfma_f32_16x16x32_bf16(k1, qf[1], c, 0, 0, 0);
                S[wr][T] = c;
            }
        float mx = -3.0e38f;
#pragma unroll
        for (int wr = 0; wr < 8; ++wr) {
            const LAS float* brow = btab + (rs + wr - r + 7) * 31;
#pragma unroll
            for (int T = 0; T < 2; ++T)
#pragma unroll
                for (int i = 0; i < 4; ++i) {
                    const int kc = bs + 8 * g + 4 * T + i;
                    int co = kc - qc + 15; co = co < 0 ? 0 : (co > 30 ? 30 : co);
                    const bool valid = (kc >= wst) && (kc < wst + 16);
                    const float v = valid ? S[wr][T][i] + brow[co] : -1e30f;
                    S[wr][T][i] = v; mx = fmaxf(mx, v);
                }
        }
        mx = fmaxf(mx, __shfl_xor(mx, 16)); mx = fmaxf(mx, __shfl_xor(mx, 32));
        float sum = 0.f;
        bf16x8 pf[8];
#pragma unroll
        for (int wr = 0; wr < 8; ++wr) {
            float p[8];
#pragma unroll
            for (int T = 0; T < 2; ++T)
#pragma unroll
                for (int i = 0; i < 4; ++i) { p[4 * T + i] = __expf(S[wr][T][i] - mx); sum += p[4 * T + i]; }
            v4u w; w.x = pk2(p[0], p[1]); w.y = pk2(p[2], p[3]); w.z = pk2(p[4], p[5]); w.w = pk2(p[6], p[7]);
            pf[wr] = __builtin_bit_cast(bf16x8, w);
        }
        sum += __shfl_xor(sum, 16); sum += __shfl_xor(sum, 32);
        if (it + F.G < 2048) { const int nit = it + F.G; AT_PREFETCH(nit); }
        f32x4 O[4];
#pragma unroll
        for (int dt = 0; dt < 4; ++dt) O[dt] = (f32x4){0.f, 0.f, 0.f, 0.f};
#pragma unroll
        for (int wr = 0; wr < 8; ++wr)
#pragma unroll
            for (int dt = 0; dt < 4; ++dt) {
                const bf16x8 vf = *(const LAS bf16x8*)(VL + (dt * 16 + q) * AT_VSTR + ((lr0 + wr) * 64 + bs + 8 * g) * 2);
                O[dt] = __builtin_amdgcn_mfma_f32_16x16x32_bf16(vf, pf[wr], O[dt], 0, 0, 0);
            }
        const float inv = 1.0f / sum;
#pragma unroll
        for (int dt = 0; dt < 4; ++dt) { v2u w; w.x = pk2(O[dt][0] * inv, O[dt][1] * inv); w.y = pk2(O[dt][2] * inv, O[dt][3] * inv);
            *(v2u*)(mix + tokq * 1024 + hh * 64 + dt * 16 + 4 * g) = w; }
    }
#undef AT_DECODE
#undef AT_PREFETCH
    BLOCK_BAR();
}
#if NAIVE_ATTN
__device__ __forceinline__ void attn_naive_phase(Frame& F, int j) {
    const bf16* QK = (const bf16*)(F.ws + WS_BIG); const bf16* VT = (const bf16*)(F.ws + WS_VT); bf16* mix = (bf16*)(F.ws + WS_MIX);
    const float* biasl = F.in(6) + (size_t)j * NH * 15 * 31;
    for (int idx = F.vcu * NTHR + F.tid; idx < M * NH; idx += F.G * NTHR) {
        const int hh = idx & 15, t = idx >> 4, b = t >> 13, s = t & (SEQ - 1), r = s >> 6, qc = s & 63;
        int rs = r - 4; rs = rs < 0 ? 0 : (rs > NROWS - 8 ? NROWS - 8 : rs);
        int wst = qc - 8; wst = wst < 0 ? 0 : (wst > 48 ? 48 : wst);
        float qv[64];
#pragma unroll
        for (int c = 0; c < 8; ++c) { const v4u w = *(const v4u*)(QK + (size_t)t * 2048 + hh * 64 + c * 8);
#pragma unroll
            for (int e = 0; e < 4; ++e) { qv[c * 8 + 2 * e] = bflo(w[e]); qv[c * 8 + 2 * e + 1] = bfhi(w[e]); } }
        float mrun = -3.0e38f, lrun = 0.f, o[64];
#pragma unroll
        for (int d = 0; d < 64; ++d) o[d] = 0.f;
        for (int wr = 0; wr < 8; ++wr)
            for (int kk = 0; kk < 16; ++kk) {
                const int kc = wst + kk; const size_t tk = (size_t)b * SEQ + (rs + wr) * 64 + kc;
                float sd = 0.f;
#pragma unroll
                for (int c = 0; c < 8; ++c) { const v4u w = *(const v4u*)(QK + tk * 2048 + 1024 + hh * 64 + c * 8);
#pragma unroll
                    for (int e = 0; e < 4; ++e) sd += qv[c * 8 + 2 * e] * bflo(w[e]) + qv[c * 8 + 2 * e + 1] * bfhi(w[e]); }
                int co = kc - qc + 15; co = co < 0 ? 0 : (co > 30 ? 30 : co);
                sd += biasl[(size_t)hh * 465 + (rs + wr - r + 7) * 31 + co];
                const float mn = fmaxf(mrun, sd), al = __expf(mrun - mn), p = __expf(sd - mn);
                lrun = lrun * al + p; mrun = mn;
#pragma unroll
                for (int d = 0; d < 64; ++d) o[d] = o[d] * al + p * bflo((unsigned)VT[(size_t)(hh * 64 + d) * M + tk]);
            }
        const float inv = 1.0f / lrun;
#pragma unroll
        for (int c = 0; c < 8; ++c) { v4u w;
#pragma unroll
            for (int e = 0; e < 4; ++e) w[e] = pk2(o[c * 8 + 2 * e] * inv, o[c * 8 + 2 * e + 1] * inv);
            *(v4u*)(mix + (size_t)t * 1024 + hh * 64 + c * 8) = w; }
    }
}
#endif
#if NAIVE_TOPK
__device__ __forceinline__ void select_naive_phase(Frame& F) {
    const float* SC = (const float*)(F.ws + WS_SC); int* seli = (int*)(F.ws + WS_SELI); float* selg = (float*)(F.ws + WS_SELG);
    LAS int* AB = (LAS int*)F.lds + F.tid * 33;
    for (int idx = F.vcu * NTHR + F.tid; idx < M * 8; idx += F.G * NTHR) {
        const float* s = SC + (size_t)idx * 256;
        int a[16], b[16], t[16];
        tk_stage1<4>(s, 0, a); tk_stage1<4>(s + 64, 64, t); tk_merge_top(a, t);
        tk_stage1<4>(s + 128, 0, b); tk_stage1<4>(s + 192, 64, t); tk_merge_top(b, t);
        tk_stage2(a, b, AB, seli + (size_t)idx * 16, selg + (size_t)idx * 16);
    }
}
#endif

__device__ __forceinline__ float gelu_erf(float a) { return 0.5f * a * (1.0f + erff(a * 0.70710678118654752f)); }
typedef float f32x2g __attribute__((ext_vector_type(2)));
#if EXPERT_FP4
typedef v2u rowv;
__device__ __forceinline__ rowv row_load(const unsigned char* T, int e, int lane) { return *(const v2u*)(T + (size_t)e * ROWB + 8 * lane); }
#define ROW_PAIR(r, m) __builtin_amdgcn_cvt_scalef32_pk_f32_fp4((r)[(m) >> 2], 1.0f, (m) & 3)
#else
typedef v4u rowv;
__device__ __forceinline__ rowv row_load(const unsigned char* T, int e, int lane) { return *(const v4u*)(T + (size_t)e * ROWB + 16 * lane); }
#define ROW_PAIR(r, m) __builtin_amdgcn_cvt_pk_f32_fp8((r)[(m) >> 1], ((m) & 1) != 0)
#endif
__device__ __forceinline__ void row_axpy(f32x2g (&out)[8], const rowv d, float ak) {
    const f32x2g a2 = (f32x2g){ak, ak};
    out[0] = __builtin_elementwise_fma(a2, ROW_PAIR(d, 0), out[0]); out[1] = __builtin_elementwise_fma(a2, ROW_PAIR(d, 1), out[1]); out[2] = __builtin_elementwise_fma(a2, ROW_PAIR(d, 2), out[2]); out[3] = __builtin_elementwise_fma(a2, ROW_PAIR(d, 3), out[3]);
    out[4] = __builtin_elementwise_fma(a2, ROW_PAIR(d, 4), out[4]); out[5] = __builtin_elementwise_fma(a2, ROW_PAIR(d, 5), out[5]); out[6] = __builtin_elementwise_fma(a2, ROW_PAIR(d, 6), out[6]); out[7] = __builtin_elementwise_fma(a2, ROW_PAIR(d, 7), out[7]);
}
typedef int v8i_g __attribute__((ext_vector_type(8)));
typedef unsigned char u8x4g __attribute__((ext_vector_type(4)));
#define TR_SHUF(a, b, i0, i1, i2, i3) __builtin_amdgcn_perm((unsigned)(b), (unsigned)(a), (unsigned)((i0) | ((i1) << 8) | ((i2) << 16) | ((i3) << 24)))
__device__ __forceinline__ void tr8_nib(const unsigned (&w)[8], unsigned (&t)[8]) {
    unsigned x[8], y[8];
#pragma unroll
    for (int r = 0; r < 4; ++r) { x[r] = TR_SHUF(w[r], w[r + 4], 0, 1, 4, 5); x[r + 4] = TR_SHUF(w[r], w[r + 4], 2, 3, 6, 7); }
#pragma unroll
    for (int g = 0; g < 2; ++g)
#pragma unroll
        for (int r = 0; r < 2; ++r) { y[4 * g + r] = TR_SHUF(x[4 * g + r], x[4 * g + r + 2], 0, 4, 2, 6); y[4 * g + r + 2] = TR_SHUF(x[4 * g + r], x[4 * g + r + 2], 1, 5, 3, 7); }
#pragma unroll
    for (int p = 0; p < 4; ++p) { const unsigned e = y[2 * p], o = y[2 * p + 1];
        t[2 * p] = (e & 0x0F0F0F0Fu) | ((o << 4) & 0xF0F0F0F0u);
        t[2 * p + 1] = ((e >> 4) & 0x0F0F0F0Fu) | (o & 0xF0F0F0F0u); }
}
__device__ __forceinline__ void gather_phase(Frame& F, int layer, bool dry) {
    const unsigned char* UP = F.ws + WS_UP + (size_t)layer * 16384 * ROWB; const unsigned char* DN = F.ws + WS_DN + (size_t)layer * 16384 * ROWB;
    const float* SUP = (const float*)(F.ws + WS_SUP) + (size_t)layer * 16384; const float* SDN = (const float*)(F.ws + WS_SDN) + (size_t)layer * 16384;
    const float* gain = F.in(2) + (size_t)layer * D; const float* gnext = layer < DEPTH - 1 ? F.in(1) + (size_t)(layer + 1) * D : F.in(3);
    float* outp = F.out();
    const int* seli = (const int*)(F.ws + WS_SELI); const float* selg = (const float*)(F.ws + WS_SELG);
    const bf16* H = (const bf16*)(F.ws + WS_H); bf16* HN = (bf16*)(F.ws + (dry ? WS_SC + 64 * MiB : WS_HN)); bf16* HW = (bf16*)(F.ws + (dry ? WS_SC : WS_H)); if (dry) outp = (float*)(F.ws + WS_SC);
    const int lane = F.lane, gw = F.vcu * NWAVES + F.wave, NGW = F.G * NWAVES;
    const bool b5 = lane & 32, b4 = lane & 16, b3 = lane & 8, b2 = lane & 4;
    constexpr int G_RS = 528, G_RB = 32 * G_RS, G_NSLOT = 4;
    LAS unsigned char* RB = F.lds + F.wave * G_RB;
    LAS float* ACT = (LAS float*)(F.lds + 8 * G_RB + F.wave * (G_NSLOT * 512));
    static_assert(8 * G_RB + 8 * G_NSLOT * 512 + 8 * 1024 <= PTAB_OFF, "gather LDS map");
#pragma unroll 1
    for (int base = gw; base < M; base += G_NSLOT * NGW) {
    LAS unsigned char* X8 = F.lds + 8 * G_RB + 8 * G_NSLOT * 512 + F.wave * 1024;
    const int n16 = lane & 15, g4 = lane >> 4;
    v4u nhb[2]; int nidx_lo = 0, nidx_hi = 0; float ng_lo = 0.f, ng_hi = 0.f;
#define TOK_LOAD(t_) do { const bf16* hr_ = H + (size_t)(t_) * D + 16 * lane; nhb[0] = *(const v4u*)hr_; nhb[1] = *(const v4u*)(hr_ + 8); \
        nidx_lo = seli[(size_t)(t_) * 128 + lane]; nidx_hi = seli[(size_t)(t_) * 128 + 64 + lane]; ng_lo = selg[(size_t)(t_) * 128 + lane]; ng_hi = selg[(size_t)(t_) * 128 + 64 + lane]; } while (0)
    if (base < M) TOK_LOAD(base);
#pragma unroll 1
    for (int slot = 0; slot < G_NSLOT; ++slot) {
        const int t = base + slot * NGW; if (t >= M) break;
        f32x4 hv[4];
#pragma unroll
        for (int i = 0; i < 4; ++i) { const unsigned w0_ = nhb[i >> 1][2 * (i & 1)], w1_ = nhb[i >> 1][2 * (i & 1) + 1]; hv[i] = (f32x4){bflo(w0_), bfhi(w0_), bflo(w1_), bfhi(w1_)}; }
        const int idx_lo = nidx_lo, idx_hi = nidx_hi; const float g_lo = ng_lo, g_hi = ng_hi;
        if (slot + 1 < G_NSLOT && t + NGW < M) TOK_LOAD(t + NGW);
        float ss = 0.f;
#pragma unroll
        for (int i = 0; i < 4; ++i) ss += (hv[i].x * hv[i].x + hv[i].y * hv[i].y) + (hv[i].z * hv[i].z + hv[i].w * hv[i].w);
        const float rstd = 1.0f / sqrtf(wave_sum(ss) * (1.f / D) + RMS_EPS);
        float xmax = 0.f;
        f32x4 xv[4];
#pragma unroll
        for (int i = 0; i < 4; ++i) { const f32x4 g = *(const f32x4*)(gain + 16 * lane + 4 * i); xv[i] = hv[i] * rstd * g;
            xmax = fmaxf(fmaxf(xmax, fmaxf(fabsf(xv[i].x), fabsf(xv[i].y))), fmaxf(fabsf(xv[i].z), fabsf(xv[i].w))); }
#pragma unroll
        for (int o = 1; o < 64; o <<= 1) xmax = fmaxf(xmax, __shfl_xor(xmax, o));
        const float qx = xmax > 0.f ? 256.0f / xmax : 1.0f, xinv = xmax > 0.f ? xmax * (1.0f / 256.0f) : 1.0f;
        {
            v4u w;
#pragma unroll
            for (int i = 0; i < 4; ++i) { unsigned tt = 0u; tt = __builtin_amdgcn_cvt_pk_fp8_f32(xv[i].x * qx, xv[i].y * qx, tt, false); tt = __builtin_amdgcn_cvt_pk_fp8_f32(xv[i].z * qx, xv[i].w * qx, tt, true); w[i] = tt; }
            *(LAS v4u*)(X8 + 16 * lane) = w;
        }
        LDS_WAIT(); asm volatile("" ::: "memory");
        v8i_g bx[8];
#pragma unroll
        for (int s8 = 0; s8 < 8; ++s8) { const v4u b0 = *(const LAS v4u*)(X8 + 128 * s8 + 16 * g4), b1 = *(const LAS v4u*)(X8 + 128 * s8 + 64 + 16 * g4);
            bx[s8] = (v8i_g){(int)b0.x, (int)b0.y, (int)b0.z, (int)b0.w, (int)b1.x, (int)b1.y, (int)b1.z, (int)b1.w}; }
        LDS_WAIT(); asm volatile("" ::: "memory");
#define UP_LOAD(buf, hq) do { const int sel_ = (hq) < 2 ? idx_lo : idx_hi; _Pragma("unroll") for (int k = 0; k < 32; ++k) buf[k] = row_load(UP, __builtin_amdgcn_readlane(sel_, ((hq) & 1) * 32 + k), lane); } while (0)
#define DN_LOAD(buf, hb) do { const int sel_ = (hb) < 4 ? idx_lo : idx_hi; _Pragma("unroll") for (int k = 0; k < 16; ++k) buf[k] = row_load(DN, __builtin_amdgcn_readlane(sel_, ((hb) & 3) * 16 + k), lane); } while (0)
        rowv da[16];
        {
            rowv ur[32];
            UP_LOAD(ur, 0);
#define UP_NEXT UP_LOAD(ur, hq + 1)
#pragma unroll 1
            for (int hq = 0; hq < 3; ++hq) {
                const int sel = hq < 2 ? idx_lo : idx_hi; const float gsel = hq < 2 ? g_lo : g_hi; const int lb0 = (hq & 1) * 32;
#pragma unroll
                for (int k = 0; k < 32; ++k) *(LAS v2u*)(RB + k * G_RS + 8 * lane) = ur[k];
                float sc[4];
#pragma unroll
                for (int hh_ = 0; hh_ < 2; ++hh_) { const int ek_ = __shfl(sel, lb0 + hh_ * 16 + 4 * g4 + (n16 & 3)); sc[2 * hh_] = SUP[ek_]; sc[2 * hh_ + 1] = SDN[ek_]; }
                LDS_WAIT(); asm volatile("" ::: "memory");
                UP_NEXT;
#pragma unroll
                for (int hh_ = 0; hh_ < 2; ++hh_) { const int lb = lb0 + hh_ * 16;
                    f32x4 c = (f32x4){0.f, 0.f, 0.f, 0.f};
#pragma unroll
                    for (int s8 = 0; s8 < 8; ++s8) { const v4u a4 = *(const LAS v4u*)(RB + (hh_ * 16 + n16) * G_RS + 64 * s8 + 16 * g4); const v8i_g a8 = (v8i_g){(int)a4.x, (int)a4.y, (int)a4.z, (int)a4.w, 0, 0, 0, 0};
                        c = __builtin_amdgcn_mfma_scale_f32_16x16x128_f8f6f4(a8, bx[s8], c, 4, 0, 0, 0x7f7f7f7f, 0, 0x7f7f7f7f); }
                    const int r_ = n16 & 3, k_ = 4 * g4 + r_;
                    const float my = r_ == 0 ? c[0] : (r_ == 1 ? c[1] : (r_ == 2 ? c[2] : c[3]));
                    const float gate = __shfl(gsel, lb + k_);
                    const float act = gelu_erf(my * sc[2 * hh_] * xinv) * gate * sc[2 * hh_ + 1];
                    if (n16 < 4) ACT[slot * 128 + hq * 32 + hh_ * 16 + k_] = act; }
                LDS_WAIT(); asm volatile("" ::: "memory");
            }
#undef UP_NEXT
#define UP_NEXT DN_LOAD(da, 0)
            { const int hq = 3;
                const int sel = hq < 2 ? idx_lo : idx_hi; const float gsel = hq < 2 ? g_lo : g_hi; const int lb0 = (hq & 1) * 32;
#pragma unroll
                for (int k = 0; k < 32; ++k) *(LAS v2u*)(RB + k * G_RS + 8 * lane) = ur[k];
                float sc[4];
#pragma unroll
                for (int hh_ = 0; hh_ < 2; ++hh_) { const int ek_ = __shfl(sel, lb0 + hh_ * 16 + 4 * g4 + (n16 & 3)); sc[2 * hh_] = SUP[ek_]; sc[2 * hh_ + 1] = SDN[ek_]; }
                LDS_WAIT(); asm volatile("" ::: "memory");
                UP_NEXT;
#pragma unroll
                for (int hh_ = 0; hh_ < 2; ++hh_) { const int lb = lb0 + hh_ * 16;
                    f32x4 c = (f32x4){0.f, 0.f, 0.f, 0.f};
#pragma unroll
                    for (int s8 = 0; s8 < 8; ++s8) { const v4u a4 = *(const LAS v4u*)(RB + (hh_ * 16 + n16) * G_RS + 64 * s8 + 16 * g4); const v8i_g a8 = (v8i_g){(int)a4.x, (int)a4.y, (int)a4.z, (int)a4.w, 0, 0, 0, 0};
                        c = __builtin_amdgcn_mfma_scale_f32_16x16x128_f8f6f4(a8, bx[s8], c, 4, 0, 0, 0x7f7f7f7f, 0, 0x7f7f7f7f); }
                    const int r_ = n16 & 3, k_ = 4 * g4 + r_;
                    const float my = r_ == 0 ? c[0] : (r_ == 1 ? c[1] : (r_ == 2 ? c[2] : c[3]));
                    const float gate = __shfl(gsel, lb + k_);
                    const float act = gelu_erf(my * sc[2 * hh_] * xinv) * gate * sc[2 * hh_ + 1];
                    if (n16 < 4) ACT[slot * 128 + hq * 32 + hh_ * 16 + k_] = act; }
                LDS_WAIT(); asm volatile("" ::: "memory");
            }
#undef UP_NEXT
        }
#undef UP_LOAD
        LDS_WAIT(); asm volatile("" ::: "memory");
        const float a_lo = ACT[slot * 128 + lane], a_hi = ACT[slot * 128 + 64 + lane];
        float amax = fmaxf(fabsf(a_lo), fabsf(a_hi));
#pragma unroll
        for (int o = 1; o < 64; o <<= 1) amax = fmaxf(amax, __shfl_xor(amax, o));
        const float ainv = amax > 0.f ? 119.0f / amax : 0.f, tscale = amax * (1.0f / 119.0f);
        unsigned pd[4];
        {
            const int A0 = __float2int_rn(a_lo * ainv), A1 = __float2int_rn(a_hi * ainv);
            const int h0 = (A0 + 8) >> 4, l0 = A0 - 16 * h0, h1 = (A1 + 8) >> 4, l1 = A1 - 16 * h1;
            const int sh = 4 * (lane & 7);
            pd[0] = ((unsigned)l0 & 15u) << sh; pd[1] = ((unsigned)h0 & 15u) << sh; pd[2] = ((unsigned)l1 & 15u) << sh; pd[3] = ((unsigned)h1 & 15u) << sh;
#pragma unroll
            for (int q = 0; q < 4; ++q) { pd[q] |= (unsigned)__shfl_xor((int)pd[q], 1); pd[q] |= (unsigned)__shfl_xor((int)pd[q], 2); pd[q] |= (unsigned)__shfl_xor((int)pd[q], 4); }
        }
        int acc0[16], acc1[16];
#pragma unroll
        for (int e = 0; e < 16; ++e) { acc0[e] = 0; acc1[e] = 0; }
#define DN_STEP(buf, hb) do { const unsigned plo_ = (hb) < 4 ? pd[0] : pd[2], phi_ = (hb) < 4 ? pd[1] : pd[3]; \
            _Pragma("unroll") for (int gg = 0; gg < 2; ++gg) { \
                const int alo_ = __builtin_amdgcn_readlane((int)plo_, ((hb) & 3) * 16 + 8 * gg), ahi_ = __builtin_amdgcn_readlane((int)phi_, ((hb) & 3) * 16 + 8 * gg); \
                _Pragma("unroll") for (int jj = 0; jj < 2; ++jj) { unsigned w_[8], t_[8]; \
                    _Pragma("unroll") for (int r = 0; r < 8; ++r) w_[r] = buf[8 * gg + r][jj]; \
                    tr8_nib(w_, t_); \
                    _Pragma("unroll") for (int c = 0; c < 8; ++c) { acc0[8 * jj + c] = __builtin_amdgcn_sdot8((int)t_[c], alo_, acc0[8 * jj + c], false); acc1[8 * jj + c] = __builtin_amdgcn_sdot8((int)t_[c], ahi_, acc1[8 * jj + c], false); } } } } while (0)
        {
            rowv db[16];
            DN_LOAD(db, 1); DN_STEP(da, 0);
            DN_LOAD(da, 2); DN_STEP(db, 1);
            DN_LOAD(db, 3); DN_STEP(da, 2);
            DN_LOAD(da, 4); DN_STEP(db, 3);
            DN_LOAD(db, 5); DN_STEP(da, 4);
            DN_LOAD(da, 6); DN_STEP(db, 5);
            DN_LOAD(db, 7); DN_STEP(da, 6);
            DN_STEP(db, 7);
        }
#undef DN_LOAD
#undef DN_STEP
        f32x2g out[8];
#pragma unroll
        for (int e = 0; e < 8; ++e) out[e] = (f32x2g){((float)acc0[2 * e] + 16.0f * (float)acc1[2 * e]) * tscale, ((float)acc0[2 * e + 1] + 16.0f * (float)acc1[2 * e + 1]) * tscale};
        float ss2 = 0.f;
#pragma unroll
        for (int i = 0; i < 4; ++i) { hv[i].x += out[2 * i].x; hv[i].y += out[2 * i].y; hv[i].z += out[2 * i + 1].x; hv[i].w += out[2 * i + 1].y;
            ss2 += (hv[i].x * hv[i].x + hv[i].y * hv[i].y) + (hv[i].z * hv[i].z + hv[i].w * hv[i].w); }
        const float rstd2 = 1.0f / sqrtf(wave_sum(ss2) * (1.f / D) + RMS_EPS);
        f32x4 y[4];
#pragma unroll
        for (int i = 0; i < 4; ++i) y[i] = hv[i] * rstd2 * *(const f32x4*)(gnext + 16 * lane + 4 * i);
        if (layer < DEPTH - 1) {
            { v4u h0, h1; h0.x = pk2(hv[0].x, hv[0].y); h0.y = pk2(hv[0].z, hv[0].w); h0.z = pk2(hv[1].x, hv[1].y); h0.w = pk2(hv[1].z, hv[1].w);
              h1.x = pk2(hv[2].x, hv[2].y); h1.y = pk2(hv[2].z, hv[2].w); h1.z = pk2(hv[3].x, hv[3].y); h1.w = pk2(hv[3].z, hv[3].w);
              bf16* hw_ = HW + (size_t)t * D + 16 * lane; *(v4u*)hw_ = h0; *(v4u*)(hw_ + 8) = h1; }
            bf16* hn = HN + (size_t)t * D + 16 * lane;
            v4u o0, o1; o0.x = pk2(y[0].x, y[0].y); o0.y = pk2(y[0].z, y[0].w); o0.z = pk2(y[1].x, y[1].y); o0.w = pk2(y[1].z, y[1].w);
            o1.x = pk2(y[2].x, y[2].y); o1.y = pk2(y[2].z, y[2].w); o1.z = pk2(y[3].x, y[3].y); o1.w = pk2(y[3].z, y[3].w);
            *(v4u*)hn = o0; *(v4u*)(hn + 8) = o1;
        } else {
            float* orow = outp + (size_t)t * D + 16 * lane;
#pragma unroll
            for (int i = 0; i < 4; ++i) *(f32x4*)(orow + 4 * i) = y[i];
        }
    }
    LDS_WAIT(); asm volatile("" ::: "memory");
    }
#undef TOK_LOAD
}

struct Args { const float* in[14]; float* out; unsigned char* ws; int ph_lo, ph_hi; };
__global__ void __launch_bounds__(NTHR, 2) mega_fwd(Args args) {
    extern __shared__ __attribute__((aligned(16))) unsigned char lds[];
    Frame F;
    F.lds = (LAS unsigned char*)lds;
    F.tid = threadIdx.x; F.lane = F.tid & 63; F.wave = __builtin_amdgcn_readfirstlane(F.tid >> 6);
    F.G = gridDim.x; { const int bx = blockIdx.x; F.vcu = (F.G % 8 == 0) ? (bx % 8) * (F.G / 8) + bx / 8 : bx; }
    F.ws = args.ws;
    volatile LAS unsigned* MISC = (volatile LAS unsigned*)(F.lds + MISC_OFF);
    if (F.tid < 64) MISC[F.tid] = 0u;
    if (F.tid < 15) { const unsigned long long p = F.tid < 14 ? (unsigned long long)args.in[F.tid] : (unsigned long long)args.out;
        volatile LAS unsigned* t = (volatile LAS unsigned*)(F.lds + PTAB_OFF); t[2 * F.tid] = (unsigned)p; t[2 * F.tid + 1] = (unsigned)(p >> 32); }
    __syncthreads();
    XcdBarrier bar; bar.bar = (unsigned*)(F.ws + WS_CTL) + CW_BAR; bar.x = 0; bar.st = nullptr;
    if (MK_N_LAUNCHES == 1) bar = xcd_barrier_post((unsigned*)(F.ws + WS_CTL) + CW_BAR, MISC + 8);

#pragma unroll 1
    for (int ph = args.ph_lo; ph < args.ph_hi; ++ph) {
        bool did = true;
        const int kind_ = ph == 0 ? 7 : (ph - 1) % PH_PER_LAYER; const int nrep = (PROBE_REP >= 0 && kind_ == PROBE_REP && (ph == 0 || ((PROBE_LMASK >> ((ph - 1) / PH_PER_LAYER)) & 1))) ? 2 : 1;
#pragma unroll 1
        for (int rep = 0; rep < nrep; ++rep) {
        const bool dry = (nrep == 2 && rep == 0);
        { int t_ = threadIdx.x; asm volatile("" : "+v"(t_)); F.tid = t_; F.lane = t_ & 63; F.wave = __builtin_amdgcn_readfirstlane(t_ >> 6);
          unsigned long long ws_ = (unsigned long long)args.ws; asm volatile("" : "+s"(ws_)); F.ws = (unsigned char*)(__attribute__((address_space(1))) unsigned char*)ws_; }
#ifndef DIS_PRO
        if (ph == 0) p0_prologue(F, dry);
#else
        if (ph == 0) {}
#endif
        else {
            const int layer = (ph - 1) / PH_PER_LAYER, k = (ph - 1) % PH_PER_LAYER, j = layer >> 1; const bool is_attn = (layer & 1) == 0;
            if (k == 0) {
                if (!is_attn) {
                    pg8::Gemm g{(const pg8::bf16_t*)(F.ws + WS_HN), (const pg8::bf16_t*)(F.ws + WS_WIN) + (size_t)j * 3072 * 1024, M, 3072, D};
                    pg8::StaticOrder S; S.init(g.M, g.N, F.G, (int)blockIdx.x);
                    EpiConvIn E{(bf16*)(F.ws + WS_BIG), (bf16*)(F.ws + WS_BIG + 32 * MiB)};
                    pg8::gemm_phase<EpiConvIn, pg8::StaticOrder, true, true>(F.lds, g, S, E);
                }
                const int ng = is_attn ? 2 : 0;
#pragma unroll 1
                for (int gi = 0; gi < ng; ++gi) {
                    pg8::Gemm g; pg8::EpiBf16<0> E; E.bias = nullptr; E.split_cols = 0; E.split_stride = 0; E.scale0 = 1.f;
                    if (is_attn && gi == 0) { g = pg8::Gemm{(const pg8::bf16_t*)(F.ws + WS_HN), (const pg8::bf16_t*)(F.ws + WS_WQK) + (size_t)j * 2048 * 1024, M, 2048, D}; E.O = (pg8::bf16_t*)(F.ws + WS_BIG); E.ldc = 2048; }
                    else if (is_attn) { g = pg8::Gemm{(const pg8::bf16_t*)(F.ws + WS_WV) + (size_t)j * 1024 * 1024, (const pg8::bf16_t*)(F.ws + WS_HN), D, M, D}; E.O = (pg8::bf16_t*)(F.ws + WS_VT); E.ldc = M; }
                    else { g = pg8::Gemm{(const pg8::bf16_t*)(F.ws + WS_HN), (const pg8::bf16_t*)(F.ws + WS_WIN) + (size_t)j * 3072 * 1024, M, 3072, D}; E.O = (pg8::bf16_t*)(F.ws + WS_BIG); E.ldc = 3072; }
                    pg8::StaticOrder S; S.init(g.M, g.N, F.G, (int)blockIdx.x);
                    pg8::gemm_phase<pg8::EpiBf16<0>, pg8::StaticOrder, true, true>(F.lds, g, S, E);
                }
            } else if (k == 1) {
                if (is_attn) {
#if NAIVE_ATTN
                    attn_naive_phase(F, j);
#elif !defined(DIS_ATTN)
                    attn_phase(F, j);
#endif
                } else {
#ifndef DIS_CONV
                    conv_phase(F, j);
#endif
                }
            } else if (k == 2) {
                pg8::Gemm g{(const pg8::bf16_t*)(F.ws + WS_MIX), (const pg8::bf16_t*)(F.ws + (is_attn ? WS_WO : WS_WOUT)) + (size_t)j * 1024 * 1024, M, D, D};
                pg8::StaticOrder S; S.init(M, D, F.G, (int)blockIdx.x);
                float* rssp = (float*)(F.ws + (dry ? WS_SC + 96 * MiB : WS_RSS)); bf16* hout = (bf16*)(F.ws + (dry ? WS_SC : WS_H));
                if (layer == 0) { EpiRes<true> E{(const void*)F.in(0), hout, rssp}; pg8::gemm_phase<EpiRes<true>, pg8::StaticOrder, false, true>(F.lds, g, S, E); }
                else { EpiRes<false> E{(const void*)(F.ws + WS_H), hout, rssp}; pg8::gemm_phase<EpiRes<false>, pg8::StaticOrder, false, true>(F.lds, g, S, E); }
            } else if (k == 3) {
                did = false;
            } else if (k == 4) {
                pg8::Gemm g{(const pg8::bf16_t*)(F.ws + WS_H), (const pg8::bf16_t*)(F.ws + WS_WP) + (size_t)layer * 2048 * 1024, M, 2048, D};
                pg8::StaticOrder S; S.init(M, 2048, F.G, (int)blockIdx.x);
#if NAIVE_TOPK
                EpiF32 E{(float*)(F.ws + WS_SC), 2048};
                pg8::gemm_phase<EpiF32, pg8::StaticOrder, true, true>(F.lds, g, S, E);
#else
#ifndef DIS_TOPK
                EpiTopK E{(int*)(F.ws + WS_SELI), (float*)(F.ws + WS_SELG), (const float*)(F.ws + WS_RSS)};
#pragma unroll 1
                for (int i = 0;; ++i) { OneUnit O1; if (!S.next(i, O1.u)) break; pg8::gemm_phase<EpiTopK, OneUnit, false, true>(F.lds, g, O1, E); }
#endif
#endif
            } else if (k == 5) {
#if NAIVE_TOPK
                select_naive_phase(F);
#else
                did = false;
#endif
            } else {
#ifndef DIS_GATHER
                gather_phase(F, layer, dry);
#endif
            }
        }
        if (MK_N_LAUNCHES == 1 && dry) xcd_barrier(bar);
        }
        if (MK_N_LAUNCHES == 1 && did && ph + 1 < args.ph_hi) { xcd_barrier(bar);
#ifdef PROBE_BAR2
            xcd_barrier(bar);
#endif
        }
    }
}

extern "C" void kernel_launch(void* const* d_in, const int* in_sizes, int n_in, void* d_out, int out_size, void* d_ws, size_t ws_size, hipStream_t stream) {
    static int grid = 0;
    if (grid == 0) {
        if (n_in != 14 || out_size != M * D || ws_size < WS_END) { fprintf(stderr, "kernel_launch: unexpected shapes (n_in %d, out %d, ws %zu); nothing launched\n", n_in, out_size, ws_size); grid = -1; return; }
        int dev = 0, cus = 0, per_cu = 0;
        if (hipGetDevice(&dev) != hipSuccess || hipDeviceGetAttribute(&cus, hipDeviceAttributeMultiprocessorCount, dev) != hipSuccess) { grid = -1; return; }
        if (hipFuncSetAttribute((const void*)mega_fwd, hipFuncAttributeMaxDynamicSharedMemorySize, LDS_BYTES) != hipSuccess) { fprintf(stderr, "kernel_launch: hipFuncSetAttribute failed\n"); grid = -1; return; }
        if (hipOccupancyMaxActiveBlocksPerMultiprocessor(&per_cu, (const void*)mega_fwd, NTHR, LDS_BYTES) != hipSuccess || per_cu < 1) fprintf(stderr, "kernel_launch: note: occupancy query reports %d\n", per_cu);
        (void)hipGetLastError();
        grid = cus;
    }
    if (grid < 0) return;
    if (hipMemsetAsync((char*)d_ws + WS_CTL, 0, CTL_ZERO_BYTES, stream) != hipSuccess) return;
    Args a{};
    for (int i = 0; i < 14; ++i) a.in[i] = (const float*)d_in[i];
    a.out = (float*)d_out; a.ws = (unsigned char*)d_ws;
    if (MK_N_LAUNCHES == 1) { a.ph_lo = 0; a.ph_hi = N_PHASES; hipLaunchKernelGGL(mega_fwd, dim3(grid), dim3(NTHR), LDS_BYTES, stream, a); }
    else for (int ph = 0; ph < N_PHASES; ++ph) {
        if (ph > 0 && ((ph - 1) % PH_PER_LAYER == 3 || (!NAIVE_TOPK && (ph - 1) % PH_PER_LAYER == 5))) continue;
        a.ph_lo = ph; a.ph_hi = ph + 1; hipLaunchKernelGGL(mega_fwd, dim3(grid), dim3(NTHR), LDS_BYTES, stream, a);
    }
}
```

```cpp
#include <hip/hip_runtime.h>
#include <cstdio>
#include <cstdint>
namespace pg8 {
#define PG8_LAS __attribute__((address_space(3)))
typedef unsigned short bf16_t;
typedef short bf16x8 __attribute__((ext_vector_type(8)));
typedef float f32x4 __attribute__((ext_vector_type(4)));
typedef unsigned u32x4 __attribute__((ext_vector_type(4)));
constexpr int BM = 256, BK = 64, HALF = 128, HTB = HALF * BK * 2  , STAGE_BYTES = 8 * HTB, NXCD = 8, WGM = 8;

__host__ __device__ __forceinline__ int lds_byte(int r, int c) { const int st = (r >> 4) * 2 + (c >> 5), rr = r & 15, cc = c & 31, ob = rr * 64 + cc * 2; return st * 1024 + (ob ^ (((ob >> 9) & 1) << 5)); }
__host__ __device__ __forceinline__ void stage_rc(int b, int& R, int& C) { const int st = b / 1024, sb = b % 1024, swz = sb ^ (((sb >> 9) & 1) << 5); R = (st >> 1) * 16 + swz / 64; C = (st & 1) * 32 + (swz % 64) / 2; }
__host__ __device__ __forceinline__ int perm32(int rho) { const int n = rho >> 4, i = rho & 15; return 8 * (i >> 2) + 4 * n + (i & 3); }

struct Unit { int pm, pn; };
struct Gemm { const bf16_t* A; const bf16_t* Bt; int M, N, K; };

struct StaticOrder {
    int nM, nN, nwg, G, c;
    __host__ __device__ void init(int M, int N, int G_, int c_) { nM = M / BM; nN = N / BM; nwg = nM * nN; G = G_; c = c_; }
    __host__ __device__ bool next(int i, Unit& u) const {
        const long L = (long)i * G + c; if (L >= nwg) return false;
        int wgid = (int)L; { const int q = nwg / NXCD, r = nwg % NXCD, xcd = wgid % NXCD, off = wgid / NXCD; wgid = (xcd < r ? xcd * (q + 1) : r * (q + 1) + (xcd - r) * q) + off; }
        const int nig = WGM * nN, gid = wgid / nig, fm = gid * WGM, gsz = (nM - fm) < WGM ? (nM - fm) : WGM;
        u.pm = fm + ((wgid % nig) % gsz); u.pn = (wgid % nig) / gsz; return true;
    }
    __device__ __forceinline__ void a_ready(const Unit&) const {}
    __device__ __forceinline__ void done(const Unit&) const {}
};

__device__ __forceinline__ unsigned cvt_pk_bf16(float lo, float hi) { unsigned r; asm volatile("v_cvt_pk_bf16_f32 %0, %1, %2" : "=v"(r) : "v"(lo), "v"(hi)); return r; }
typedef float f32x2 __attribute__((ext_vector_type(2)));
__device__ __forceinline__ f32x2 gelu_pk(f32x2 v) {
    const f32x2 av = __builtin_elementwise_abs(v), d = av * 0.2316418882f + 1.0f;
    f32x2 t; t.x = __builtin_amdgcn_rcpf(d.x); t.y = __builtin_amdgcn_rcpf(d.y);
    f32x2 q = t * 0.5307027145f + (-0.7265760135f); q = q * t + 0.7107068705f; q = q * t + (-0.142248368f); q = q * t + 0.127414796f; q = q * t;
    const f32x2 s = (v * v) * (-0.72134752044f);
    f32x2 e; e.x = __builtin_amdgcn_exp2f(s.x); e.y = __builtin_amdgcn_exp2f(s.y);
    const f32x2 m = v * (q * e), r = v - m;
    f32x2 o; o.x = v.x < 0.f ? m.x : r.x; o.y = v.y < 0.f ? m.y : r.y; return o;
}

template <int ACT  > struct EpiBf16 {
    static constexpr bool PERM = true, AFTER_DRAIN = false; static_assert(ACT == 0 || ACT == 1, "EpiBf16: ACT is 0 (none) or 1 (gelu_pk)");
    bf16_t* O; int ldc; const float* bias; int split_cols; size_t split_stride; float scale0;
    __device__ __forceinline__ void operator()(const f32x4 (&acc)[2][2][4][2], const Unit& u, int wr, int wc, int fr, int fq) const {
        const int row0 = u.pm * BM + wr * 64 + fr; int colt = u.pn * BM; bf16_t* base = O;
        float sc = 1.f; if (split_cols) { const int t = colt / split_cols; base += (size_t)t * split_stride; colt -= t * split_cols; if (t == 0) sc = scale0; }
        const int col0 = colt + wc * 32 + 8 * fq, bcol0 = u.pn * BM + wc * 32 + 8 * fq;
        f32x4 bv[2][2];
#pragma unroll
        for (int bj = 0; bj < 2; ++bj)
#pragma unroll
            for (int n = 0; n < 2; ++n) bv[bj][n] = bias ? *(const f32x4*)(bias + bcol0 + bj * HALF + 4 * n) : (f32x4){0.f, 0.f, 0.f, 0.f};
#pragma unroll
        for (int ai = 0; ai < 2; ++ai)
#pragma unroll
            for (int m = 0; m < 4; ++m) { bf16_t* rowp = base + (size_t)(row0 + ai * HALF + m * 16) * ldc + col0;
#pragma unroll
                for (int bj = 0; bj < 2; ++bj) { f32x4 v0 = acc[ai][bj][m][0] + bv[bj][0], v1 = acc[ai][bj][m][1] + bv[bj][1];
                    if (ACT == 1) { f32x2 a = gelu_pk((f32x2){v0[0], v0[1]}), b = gelu_pk((f32x2){v0[2], v0[3]}), c = gelu_pk((f32x2){v1[0], v1[1]}), d = gelu_pk((f32x2){v1[2], v1[3]});
                        v0 = (f32x4){a.x, a.y, b.x, b.y}; v1 = (f32x4){c.x, c.y, d.x, d.y}; }
                    v0 = v0 * sc; v1 = v1 * sc; u32x4 w; w.x = cvt_pk_bf16(v0[0], v0[1]); w.y = cvt_pk_bf16(v0[2], v0[3]); w.z = cvt_pk_bf16(v1[0], v1[1]); w.w = cvt_pk_bf16(v1[2], v1[3]);
                    *(u32x4*)(rowp + bj * HALF) = w; } }
    }
};

template <class Epi, class Sched, bool ALIGN_EPI = false, bool SP2 = false>
__device__ __forceinline__ void gemm_phase(PG8_LAS unsigned char* lds, const Gemm g, const Sched& S, const Epi& E) {
    int tid_l = threadIdx.x; asm volatile("" : "+v"(tid_l));
    const int tid = tid_l, wid = __builtin_amdgcn_readfirstlane(tid >> 6), lane = tid & 63, wr = wid >> 2, wc = wid & 3, fr = lane & 15, fq = lane >> 4;
    const int K = g.K, nt = K / BK;
    unsigned voffA[2], voffB[2];
#pragma unroll
    for (int i = 0; i < 2; ++i) { int R, C; stage_rc(tid * 16 + i * 8192, R, C); const int Rb = Epi::PERM ? ((R & ~31) + perm32(R & 31)) : R;
        voffA[i] = (unsigned)(R * K + C) * 2u; voffB[i] = (unsigned)(Rb * K + C) * 2u; }
    const size_t kstep = (size_t)(BK * 2);
    const size_t hstep = (size_t)HALF * K * 2;
    const size_t tstep = 2 * hstep;
    const unsigned ldsw = (unsigned)wid * 1024u;
    const int aoff = lds_byte(wr * 64 + fr, fq * 8), boff = lds_byte(wc * 32 + fr, fq * 8);
#define PG8_SA(b, h) (((b) * 2 + (h)) * HTB)
#define PG8_SB(b, h) ((4 + (b) * 2 + (h)) * HTB)
#define PG8_STAGE(bufoff, gbase, voff) do { _Pragma("unroll") for (int _i = 0; _i < 2; ++_i) \
        __builtin_amdgcn_global_load_lds((const unsigned*)((const char*)(gbase) + (voff)[_i]), (PG8_LAS unsigned*)(lds + (bufoff) + ldsw + _i * 8192), 16, 0, 0); } while (0)
#define PG8_LDA(dst, b, h) do { _Pragma("unroll") for (int m = 0; m < 4; ++m) _Pragma("unroll") for (int k = 0; k < 2; ++k) dst[m][k] = *(const PG8_LAS bf16x8*)(lds + PG8_SA(b, h) + aoff + m * 2048 + k * 1024); } while (0)
#define PG8_LDB(dst, b, h) do { _Pragma("unroll") for (int n = 0; n < 2; ++n) _Pragma("unroll") for (int k = 0; k < 2; ++k) dst[n][k] = *(const PG8_LAS bf16x8*)(lds + PG8_SB(b, h) + boff + n * 2048 + k * 1024); } while (0)
#define PG8_MMA(ai, bj, At, Bt) do { __builtin_amdgcn_s_setprio(1); _Pragma("unroll") for (int m = 0; m < 4; ++m) _Pragma("unroll") for (int n = 0; n < 2; ++n) _Pragma("unroll") for (int k = 0; k < 2; ++k) \
        acc[ai][bj][m][n] = __builtin_amdgcn_mfma_f32_16x16x32_bf16(Bt[n][k], At[m][k], acc[ai][bj][m][n], 0, 0, 0); __builtin_amdgcn_s_setprio(0); } while (0)
#define PG8_WAIT_V(n) asm volatile("s_waitcnt vmcnt(" #n ")" ::: "memory")
#define PG8_WAIT_L(n) asm volatile("s_waitcnt lgkmcnt(" #n ")" ::: "memory")
#define PG8_BAR __builtin_amdgcn_s_barrier()
#define PG8_SCHED __builtin_amdgcn_sched_barrier(0)
    Unit cur, nxt; int ui = 0;
    if (!S.next(0, cur)) return;
    f32x4 acc[2][2][4][2];
#pragma unroll
    for (int a = 0; a < 2; ++a)
#pragma unroll
        for (int b = 0; b < 2; ++b)
#pragma unroll
            for (int m = 0; m < 4; ++m)
#pragma unroll
                for (int n = 0; n < 2; ++n) acc[a][b][m][n] = (f32x4){0.f, 0.f, 0.f, 0.f};
    bf16x8 At[4][2], B0[2][2], B1[2][2];
    const char* cA = (const char*)g.A + (size_t)cur.pm * tstep; const char* cB = (const char*)g.Bt + (size_t)cur.pn * tstep;
    S.a_ready(cur);
    if constexpr (SP2) {
        PG8_STAGE(PG8_SB(0, 0), cB, voffB); PG8_STAGE(PG8_SB(0, 1), cB + hstep, voffB); PG8_STAGE(PG8_SA(0, 0), cA, voffA); PG8_STAGE(PG8_SA(0, 1), cA + hstep, voffA);
        if (wr == 1) PG8_BAR;
        PG8_WAIT_V(2); PG8_BAR;
        PG8_STAGE(PG8_SB(1, 0), cB + kstep, voffB); PG8_STAGE(PG8_SA(1, 0), cA + kstep, voffA); PG8_STAGE(PG8_SB(1, 1), cB + hstep + kstep, voffB);
        PG8_WAIT_V(6); PG8_BAR;
    } else {
        PG8_STAGE(PG8_SB(0, 0), cB, voffB); PG8_STAGE(PG8_SA(0, 0), cA, voffA); PG8_STAGE(PG8_SB(0, 1), cB + hstep, voffB); PG8_STAGE(PG8_SA(0, 1), cA + hstep, voffA);
        if (wr == 1) PG8_BAR;
        PG8_WAIT_V(4); PG8_BAR;
        PG8_STAGE(PG8_SB(1, 0), cB + kstep, voffB); PG8_STAGE(PG8_SA(1, 0), cA + kstep, voffA); PG8_STAGE(PG8_SB(1, 1), cB + hstep + kstep, voffB);
        PG8_WAIT_V(6); PG8_BAR;
    }
    for (;;) {
        const bool has_next = S.next(ui + 1, nxt);
        const char* nA = has_next ? (const char*)g.A + (size_t)nxt.pm * tstep : cA; const char* nB = has_next ? (const char*)g.Bt + (size_t)nxt.pn * tstep : cB;
        for (int t = 0; t < nt; t += 2) {
            const bool last = (t == nt - 2);
            const char* a1 = cA + (size_t)(t + 1) * kstep;
            const char* a2 = last ? nA : cA + (size_t)(t + 2) * kstep; const char* b2 = last ? nB : cB + (size_t)(t + 2) * kstep;
            const char* a3 = a2 + kstep; const char* b3 = b2 + kstep;
            if (last && has_next) S.a_ready(nxt);
            if constexpr (SP2) {
            PG8_LDB(B0, 0, 0); PG8_LDB(B1, 0, 1); PG8_SCHED; PG8_LDA(At, 0, 0); PG8_STAGE(PG8_SA(1, 1), a1 + hstep, voffA);
            PG8_WAIT_V(8); PG8_WAIT_L(0); PG8_BAR; PG8_MMA(0, 0, At, B0); PG8_MMA(0, 1, At, B1); PG8_BAR; PG8_SCHED;
            PG8_LDA(At, 0, 1); PG8_STAGE(PG8_SB(0, 0), b2, voffB); PG8_STAGE(PG8_SB(0, 1), b2 + hstep, voffB); PG8_STAGE(PG8_SA(0, 0), a2, voffA);
            PG8_WAIT_V(8); PG8_WAIT_L(0); PG8_BAR; PG8_MMA(1, 0, At, B0); PG8_MMA(1, 1, At, B1); PG8_BAR; PG8_SCHED;
            PG8_LDB(B0, 1, 0); PG8_LDB(B1, 1, 1); PG8_SCHED; PG8_LDA(At, 1, 0); PG8_STAGE(PG8_SA(0, 1), a2 + hstep, voffA);
            PG8_WAIT_V(8); PG8_WAIT_L(0); PG8_BAR; PG8_MMA(0, 0, At, B0); PG8_MMA(0, 1, At, B1); PG8_BAR; PG8_SCHED;
            PG8_LDA(At, 1, 1); PG8_STAGE(PG8_SB(1, 0), b3, voffB); PG8_STAGE(PG8_SB(1, 1), b3 + hstep, voffB); PG8_STAGE(PG8_SA(1, 0), a3, voffA);
            PG8_WAIT_V(8); PG8_WAIT_L(0); PG8_BAR; PG8_MMA(1, 0, At, B0); PG8_MMA(1, 1, At, B1); PG8_BAR; PG8_SCHED;
            } else {
            PG8_LDB(B0, 0, 0); PG8_SCHED; PG8_LDA(At, 0, 0); PG8_STAGE(PG8_SA(1, 1), a1 + hstep, voffA);
            PG8_WAIT_L(8); PG8_BAR; PG8_WAIT_L(0); PG8_MMA(0, 0, At, B0); PG8_BAR; PG8_SCHED;
            PG8_LDB(B1, 0, 1); PG8_STAGE(PG8_SB(0, 0), b2, voffB);
            PG8_BAR; PG8_WAIT_L(0); PG8_MMA(0, 1, At, B1); PG8_BAR;
            PG8_LDA(At, 0, 1); PG8_STAGE(PG8_SA(0, 0), a2, voffA);
            PG8_BAR; PG8_WAIT_L(0); PG8_MMA(1, 0, At, B0); PG8_BAR; PG8_SCHED;
            PG8_STAGE(PG8_SB(0, 1), b2 + hstep, voffB);
            PG8_WAIT_V(6); PG8_BAR; PG8_MMA(1, 1, At, B1); PG8_BAR;
            PG8_LDB(B0, 1, 0); PG8_SCHED; PG8_LDA(At, 1, 0); PG8_STAGE(PG8_SA(0, 1), a2 + hstep, voffA);
            PG8_WAIT_L(8); PG8_BAR; PG8_WAIT_L(0); PG8_MMA(0, 0, At, B0); PG8_BAR; PG8_SCHED;
            PG8_LDB(B1, 1, 1); PG8_STAGE(PG8_SB(1, 0), b3, voffB);
            PG8_BAR; PG8_WAIT_L(0); PG8_MMA(0, 1, At, B1); PG8_BAR;
            PG8_LDA(At, 1, 1); PG8_STAGE(PG8_SA(1, 0), a3, voffA);
            PG8_BAR; PG8_WAIT_L(0); PG8_MMA(1, 0, At, B0); PG8_BAR; PG8_SCHED;
            PG8_STAGE(PG8_SB(1, 1), b3 + hstep, voffB);
            PG8_WAIT_V(6); PG8_BAR; PG8_MMA(1, 1, At, B1); PG8_BAR;
            }
        }
        if constexpr (ALIGN_EPI) { if (wr == 0) PG8_BAR; }
        if constexpr (!Epi::AFTER_DRAIN) { E(acc, cur, wr, wc, fr, fq); S.done(cur); }
        if (!has_next) break;
#pragma unroll
        for (int a = 0; a < 2; ++a)
#pragma unroll
            for (int b = 0; b < 2; ++b)
#pragma unroll
                for (int m = 0; m < 4; ++m)
#pragma unroll
                    for (int n = 0; n < 2; ++n) acc[a][b][m][n] = (f32x4){0.f, 0.f, 0.f, 0.f};
        cur = nxt; cA = nA; cB = nB; ++ui;
        if constexpr (ALIGN_EPI) { if (wr == 1) PG8_BAR; }
    }
    PG8_WAIT_V(0);
    if constexpr (!ALIGN_EPI) { if (wr == 0) PG8_BAR; }
    PG8_BAR;
    if constexpr (Epi::AFTER_DRAIN) { E.fused(acc, cur, wr, wc, fr, fq, lds, wid, lane); S.done(cur); }
#undef PG8_SA
#undef PG8_SB
#undef PG8_STAGE
#undef PG8_LDA
#undef PG8_LDB
#undef PG8_MMA
#undef PG8_WAIT_V
#undef PG8_WAIT_L
#undef PG8_BAR
#undef PG8_SCHED
}
}
#ifndef HD
#define HD __host__ __device__ __forceinline__
#endif
HD int tk_map(float f) { int b = __builtin_bit_cast(int, f); return b ^ ((b >> 31) & 0x7fffffff); }
HD float tk_unmap(int k) { int b = k ^ ((k >> 31) & 0x7fffffff); return __builtin_bit_cast(float, b); }
HD void tk_cx(int& a, int& b) { const int hi = a > b ? a : b, lo = a > b ? b : a; a = hi; b = lo; }
template <int N> HD void tk_sort_desc(int (&v)[N]) {
#pragma unroll
    for (int k = 2; k <= N; k <<= 1)
#pragma unroll
        for (int j = k >> 1; j > 0; j >>= 1)
#pragma unroll
            for (int i = 0; i < N; ++i) { const int l = i ^ j; if (l > i) { if ((i & k) == 0) tk_cx(v[i], v[l]); else tk_cx(v[l], v[i]); } }
}
template <int N> HD void tk_merge_top(int (&a)[N], const int (&b)[N]) {
#pragma unroll
    for (int i = 0; i < N; ++i) a[i] = a[i] > b[N - 1 - i] ? a[i] : b[N - 1 - i];
#pragma unroll
    for (int j = N >> 1; j > 0; j >>= 1)
#pragma unroll
        for (int i = 0; i < N; ++i) { const int l = i ^ j; if (l > i) tk_cx(a[i], a[l]); }
}
template <int NCH, class FP> HD void tk_stage1(FP s, int n_base, int (&best)[16]) {
#pragma unroll
    for (int c = 0; c < NCH; ++c) {
        int x[16];
#pragma unroll
        for (int e = 0; e < 16; ++e) x[e] = (tk_map(s[c * 16 + e]) & ~127) | (127 - (n_base + c * 16 + e));
        tk_sort_desc(x);
        if (c == 0) {
#pragma unroll
            for (int e = 0; e < 16; ++e) best[e] = x[e];
        } else tk_merge_top(best, x);
    }
}
template <class IP, class OI, class OG> HD void tk_stage2(int (&a)[16], int (&b)[16], IP AB, OI out_idx, OG out_g, float vscale = 1.0f) {
    float va[16], vb[16];
#pragma unroll
    for (int i = 0; i < 16; ++i) { AB[i] = a[i]; AB[16 + i] = b[i]; va[i] = tk_unmap(a[i] & ~127); vb[i] = tk_unmap(b[i] & ~127); }
    int best[16];
#pragma unroll
    for (int c = 0; c < 4; ++c) {
        int x[16];
#pragma unroll
        for (int e = 0; e < 16; ++e) x[e] = (int)0x80000000;
        int n = 0;
#pragma unroll
        for (int i = 0; i < 16; ++i)
#pragma unroll
            for (int j = 0; j < 16; ++j)
                if ((i + 1) * (j + 1) <= 16) { if (n >= 16 * c && n < 16 * c + 16) x[n - 16 * c] = (tk_map(va[i] + vb[j]) & ~255) | (255 - (i * 16 + j)); ++n; }
        tk_sort_desc(x);
        if (c == 0) {
#pragma unroll
            for (int e = 0; e < 16; ++e) best[e] = x[e];
        } else tk_merge_top(best, x);
    }
    int ka[16], kb[16];
#pragma unroll
    for (int k = 0; k < 16; ++k) { const int flat = 255 - (best[k] & 255); ka[k] = AB[flat >> 4]; kb[k] = AB[16 + (flat & 15)]; }
    float sv[16]; int ei[16]; float sum = 0.f;
#pragma unroll
    for (int k = 0; k < 16; ++k) { ei[k] = (127 - (ka[k] & 127)) * 128 + (127 - (kb[k] & 127)); sv[k] = (tk_unmap(ka[k] & ~127) + tk_unmap(kb[k] & ~127)) * vscale; }
    const float m = sv[0];
#pragma unroll
    for (int k = 0; k < 16; ++k) { sv[k] = __expf(sv[k] - m); sum += sv[k]; }
    const float inv = 1.0f / sum;
#pragma unroll
    for (int k = 0; k < 16; ++k) { out_idx[k] = ei[k]; out_g[k] = sv[k] * inv; }
}
constexpr int NWAVES = 8, NTHR = 512;
constexpr int BATCH = 2, SEQ = 8192, D = 1024, M = BATCH * SEQ, DEPTH = 4;
constexpr int NH = 16, HDIM = 64, GRIDW = 64, NROWS = 128;
constexpr float RMS_EPS = 1e-6f;
#ifndef MK_N_LAUNCHES
#define MK_N_LAUNCHES 1
#endif
#ifndef NAIVE_ATTN
#define NAIVE_ATTN 0
#endif
#ifndef NAIVE_TOPK
#define NAIVE_TOPK 0
#endif
#ifndef EXPERT_FP4
#define EXPERT_FP4 1
#endif
constexpr int ROWB = EXPERT_FP4 ? 512 : 1024;
#ifndef PROBE_GMODE
#define PROBE_GMODE 0
#endif
#ifndef PROBE_PMODE
#define PROBE_PMODE 0
#endif
#ifndef PROBE_LMASK
#define PROBE_LMASK 15
#endif
#ifndef PROBE_REP
#define PROBE_REP -1
#endif
constexpr int PH_PER_LAYER = 7, N_PHASES = 1 + DEPTH * PH_PER_LAYER;

constexpr size_t MiB = 1u << 20;
constexpr size_t WS_CTL = 0, CTL_ZERO_BYTES = 32 * 1024;
constexpr size_t WS_WQK = 2 * MiB;
constexpr size_t WS_WV = 10 * MiB;
constexpr size_t WS_WO = 14 * MiB;
constexpr size_t WS_WIN = 18 * MiB;
constexpr size_t WS_WOUT = 30 * MiB;
constexpr size_t WS_WP = 34 * MiB;
constexpr size_t WS_H = 64 * MiB;
constexpr size_t WS_HN = 128 * MiB;
constexpr size_t WS_BIG = 160 * MiB;
constexpr size_t WS_VT = 224 * MiB;
constexpr size_t WS_MIX = 256 * MiB;
constexpr size_t WS_SELI = 288 * MiB;
constexpr size_t WS_SELG = 296 * MiB;
constexpr size_t WS_UP = 320 * MiB;
constexpr size_t WS_DN = 384 * MiB;
constexpr size_t WS_SUP = 448 * MiB;
constexpr size_t WS_RSS = 450 * MiB;
constexpr size_t WS_SC = 576 * MiB;
constexpr size_t WS_END = 704 * MiB;
constexpr int CW_BAR = 4096;
static_assert((CW_BAR + 3456) * 4 <= (int)CTL_ZERO_BYTES, "barrier words inside the per-call memset");

constexpr int LDS_BYTES = 163840, MISC_OFF = LDS_BYTES - 256, PTAB_OFF = LDS_BYTES - 512;

#define LAS __attribute__((address_space(3)))
typedef unsigned short bf16;
typedef unsigned v4u __attribute__((ext_vector_type(4)));
typedef unsigned v2u __attribute__((ext_vector_type(2)));
typedef float f32x4 __attribute__((ext_vector_type(4)));
typedef short bf16x8 __attribute__((ext_vector_type(8)));
#define LDS_WAIT() asm volatile("s_waitcnt lgkmcnt(0)" ::: "memory")
#define BLOCK_BAR() do { asm volatile("s_waitcnt vmcnt(0) lgkmcnt(0)" ::: "memory"); __builtin_amdgcn_s_barrier(); asm volatile("" ::: "memory"); } while (0)
__device__ __forceinline__ unsigned f2bf(float f) { unsigned u = __builtin_bit_cast(unsigned, f); return (u + 0x7fffu + ((u >> 16) & 1u)) >> 16; }
typedef float f32x2p __attribute__((ext_vector_type(2))); typedef __bf16 bf16x2p __attribute__((ext_vector_type(2)));
__device__ __forceinline__ unsigned pk2(float lo, float hi) { const f32x2p v = {lo, hi}; return __builtin_bit_cast(unsigned, __builtin_convertvector(v, bf16x2p)); }
__device__ __forceinline__ float bflo(unsigned u) { return __builtin_bit_cast(float, u << 16); }
__device__ __forceinline__ float bfhi(unsigned u) { return __builtin_bit_cast(float, u & 0xffff0000u); }
__device__ __forceinline__ float wave_sum(float v) {
#pragma unroll
    for (int o = 1; o < 64; o <<= 1) v += __shfl_xor(v, o);
    return v;
}

#define XB_TMO      128
#define XB_XCNT(j)  (256  + 64 * (j))
#define XB_XSUB(j)  (1280 + 64 * (j))
#define XB_XGEN(j)  (2304 + 64 * (j))
#define XB_TOP      3328
#define XB_TOPGEN   3392
#define XCD_BAR_WORDS 3456
#define XB_SPIN_CAP (1u << 20)
__device__ __forceinline__ unsigned xb_ld(unsigned* p)              { return __hip_atomic_load(p, __ATOMIC_RELAXED, __HIP_MEMORY_SCOPE_AGENT); }
__device__ __forceinline__ unsigned xb_add(unsigned* p, unsigned v) { return __hip_atomic_fetch_add(p, v, __ATOMIC_RELAXED, __HIP_MEMORY_SCOPE_AGENT); }
__device__ __forceinline__ unsigned xb_xcc_id() { return (unsigned)__builtin_amdgcn_s_getreg((3 << 11) | 20) & 0xFu; }
#define XB_SPIN(cond, bar) do { unsigned _sp = 0; while (cond) { __builtin_amdgcn_s_sleep(1); \
    if ((++_sp & 255u) == 0u) { if (xb_ld(&(bar)[XB_TMO])) break; if (_sp > XB_SPIN_CAP) { atomicAdd(&(bar)[XB_TMO], 1u); break; } } } } while (0)
struct XcdBarrier { unsigned* bar; unsigned x; volatile LAS unsigned* st; };
__device__ __forceinline__ XcdBarrier xcd_barrier_post(unsigned* bar, volatile LAS unsigned* st) {
    XcdBarrier b; b.bar = bar; b.x = xb_xcc_id(); b.st = st;
    if (threadIdx.x == 0) (void)xb_add(&bar[XB_XCNT(b.x)], 1u);
    return b;
}
__device__ __forceinline__ void xcd_barrier_complete(unsigned* bar, unsigned x, unsigned& nloc, unsigned& nx) {
    const unsigned G = gridDim.x * gridDim.y * gridDim.z;
    unsigned sum, cnt, mine, sp = 0u;
    for (;;) {
        sum = 0u; cnt = 0u; mine = 0u;
#pragma unroll
        for (unsigned j = 0; j < 16; ++j) { const unsigned c = xb_ld(&bar[XB_XCNT(j)]); sum += c; cnt += (c > 0u) ? 1u : 0u; mine = (j == x) ? c : mine; }
        if (sum == G) break;
        __builtin_amdgcn_s_sleep(1);
        if ((++sp & 255u) == 0u) { if (xb_ld(&bar[XB_TMO])) break; if (sp > XB_SPIN_CAP) { atomicAdd(&bar[XB_TMO], 1u); break; } }
    }
    nloc = mine > 0u ? mine : 1u; nx = cnt > 0u ? cnt : 1u;
}
__device__ __forceinline__ void xcd_barrier(const XcdBarrier& b) {
    asm volatile("s_waitcnt vmcnt(0)" ::: "memory");
    __syncthreads();
    if (threadIdx.x == 0) {
        unsigned* bar = b.bar;
        __builtin_amdgcn_s_waitcnt(0);
        unsigned nloc = b.st[0], nx = b.st[1];
        if (nloc == 0u) { xcd_barrier_complete(bar, b.x, nloc, nx); b.st[0] = nloc; b.st[1] = nx; }
        const unsigned old = xb_add(&bar[XB_XSUB(b.x)], 1u);
        const unsigned gen = old / nloc;
        if (old + 1u == (gen + 1u) * nloc) {
            __builtin_amdgcn_fence(__ATOMIC_RELEASE, "agent");
            asm volatile("s_waitcnt vmcnt(0)" ::: "memory");
            const unsigned og = xb_add(&bar[XB_TOP], 1u);
            const unsigned tg = og / nx;
            if (og + 1u == (tg + 1u) * nx) xb_add(&bar[XB_TOPGEN], 1u);
            else XB_SPIN(xb_ld(&bar[XB_TOPGEN]) == tg, bar);
            __builtin_amdgcn_fence(__ATOMIC_ACQUIRE, "agent");
            xb_add(&bar[XB_XGEN(b.x)], 1u);
            asm volatile("s_waitcnt vmcnt(0)" ::: "memory");
        } else {
            XB_SPIN(xb_ld(&bar[XB_XGEN(b.x)]) == gen, bar);
            __builtin_amdgcn_fence(__ATOMIC_ACQUIRE, "agent");
            asm volatile("s_waitcnt vmcnt(0)" ::: "memory");
        }
    }
    __syncthreads();
}

struct Frame {
    LAS unsigned char* lds;
    int tid, lane, wave, vcu, G;
    unsigned char* ws;
    __device__ __forceinline__ const float* in(int i) const {
        const volatile LAS unsigned* t = (const volatile LAS unsigned*)(lds + PTAB_OFF);
        const unsigned lo = __builtin_amdgcn_readfirstlane(t[2 * i]), hi = __builtin_amdgcn_readfirstlane(t[2 * i + 1]);
        return (const float*)(const __attribute__((address_space(1))) float*)(((unsigned long long)hi << 32) | lo);
    }
    __device__ __forceinline__ float* out() const { return (float*)in(14); }
};

template <bool FIRST> struct EpiRes {
    static constexpr bool PERM = false, AFTER_DRAIN = false;
    const void* hin; bf16* h; float* rss;
    __device__ __forceinline__ void operator()(const pg8::f32x4 (&acc)[2][2][4][2], const pg8::Unit& u, int wr, int wc, int fr, int fq) const {
        const int col0 = u.pn * 256 + wc * 32 + 4 * fq;
#pragma unroll
        for (int ai = 0; ai < 2; ++ai)
#pragma unroll
            for (int m = 0; m < 4; ++m) { const int row = u.pm * 256 + ai * 128 + wr * 64 + m * 16 + fr; bf16* rowp = h + (size_t)row * D + col0;
                float ss = 0.f;
#pragma unroll
                for (int bj = 0; bj < 2; ++bj)
#pragma unroll
                    for (int n = 0; n < 2; ++n) { f32x4 v;
                        if (FIRST) v = *(const f32x4*)((const float*)hin + (size_t)row * D + col0 + bj * 128 + n * 16);
                        else { const v2u hw = *(const v2u*)((const bf16*)hin + (size_t)row * D + col0 + bj * 128 + n * 16); v = (f32x4){bflo(hw.x), bfhi(hw.x), bflo(hw.y), bfhi(hw.y)}; }
                        v += acc[ai][bj][m][n];
                        ss += (v.x * v.x + v.y * v.y) + (v.z * v.z + v.w * v.w);
                        v2u w; w.x = pk2(v.x, v.y); w.y = pk2(v.z, v.w); *(v2u*)(rowp + bj * 128 + n * 16) = w; }
                ss += __shfl_xor(ss, 16); ss += __shfl_xor(ss, 32);
                if (fq == 0) rss[(size_t)row * 16 + u.pn * 4 + wc] = ss; }
    }
};
struct EpiConvIn {
    static constexpr bool PERM = true, AFTER_DRAIN = false;
    bf16* U; bf16* GB;
    __device__ __forceinline__ void operator()(const pg8::f32x4 (&acc)[2][2][4][2], const pg8::Unit& u, int wr, int wc, int fr, int fq) const {
        const int row0 = u.pm * 256 + wr * 64 + fr;
        if (u.pn < 8) {
            const int ch0 = u.pn * 128 + wc * 32 + 8 * fq;
#pragma unroll
            for (int ai = 0; ai < 2; ++ai)
#pragma unroll
                for (int m = 0; m < 4; ++m) { const f32x4 p0 = acc[ai][0][m][0] * acc[ai][1][m][0], p1 = acc[ai][0][m][1] * acc[ai][1][m][1];
                    v4u w; w.x = pk2(p0[0], p0[1]); w.y = pk2(p0[2], p0[3]); w.z = pk2(p1[0], p1[1]); w.w = pk2(p1[2], p1[3]);
                    *(v4u*)(U + (size_t)(row0 + ai * 128 + m * 16) * D + ch0) = w; }
        } else {
            const int col0 = (u.pn - 8) * 256 + wc * 32 + 8 * fq;
#pragma unroll
            for (int ai = 0; ai < 2; ++ai)
#pragma unroll
                for (int m = 0; m < 4; ++m)
#pragma unroll
                    for (int bj = 0; bj < 2; ++bj) { const f32x4 v0 = acc[ai][bj][m][0], v1 = acc[ai][bj][m][1];
                        v4u w; w.x = pk2(v0[0], v0[1]); w.y = pk2(v0[2], v0[3]); w.z = pk2(v1[0], v1[1]); w.w = pk2(v1[2], v1[3]);
                        *(v4u*)(GB + (size_t)(row0 + ai * 128 + m * 16) * D + col0 + bj * 128) = w; }
        }
    }
};
struct EpiF32 {
    static constexpr bool PERM = false, AFTER_DRAIN = false;
    float* O; int ldc;
    __device__ __forceinline__ void operator()(const pg8::f32x4 (&acc)[2][2][4][2], const pg8::Unit& u, int wr, int wc, int fr, int fq) const {
        const int col0 = u.pn * 256 + wc * 32 + 4 * fq;
#pragma unroll
        for (int ai = 0; ai < 2; ++ai)
#pragma unroll
            for (int m = 0; m < 4; ++m) { float* rowp = O + (size_t)(u.pm * 256 + ai * 128 + wr * 64 + m * 16 + fr) * ldc + col0;
#pragma unroll
                for (int bj = 0; bj < 2; ++bj)
#pragma unroll
                    for (int n = 0; n < 2; ++n) *(f32x4*)(rowp + bj * 128 + n * 16) = acc[ai][bj][m][n]; }
    }
};
struct EpiTopK {
    static constexpr bool PERM = false, AFTER_DRAIN = true;
    int* seli; float* selg; const float* rss;
    __device__ __forceinline__ void operator()(const pg8::f32x4 (&)[2][2][4][2], const pg8::Unit&, int, int, int, int) const {}
    __device__ __forceinline__ void fused(pg8::f32x4 (&acc)[2][2][4][2], const pg8::Unit& u, int wr, int wc, int fr, int fq, LAS unsigned char* lds, int wid, int lane) const {
        LAS float* S = (LAS float*)lds;
        LAS int* L = (LAS int*)lds;
        const int tid = wid * 64 + lane;
#pragma unroll 1
        for (int ai = 0; ai < 2; ++ai) {
#pragma unroll
            for (int m = 0; m < 4; ++m)
#pragma unroll
                for (int bj = 0; bj < 2; ++bj)
#pragma unroll
                    for (int n = 0; n < 2; ++n) {
                        const int row = wr * 64 + m * 16 + fr, col = bj * 128 + wc * 32 + n * 16 + 4 * fq;
                        *(LAS f32x4*)(S + row * 260 + col) = ai == 0 ? acc[0][bj][m][n] : acc[1][bj][m][n];
                    }
            BLOCK_BAR();
            const int row = tid & 127, q = tid >> 7;
            int best[16];
            {
                const LAS f32x4* sp = (const LAS f32x4*)(S + row * 260 + q * 64);
#pragma unroll
                for (int c = 0; c < 4; ++c) {
                    int x[16];
#pragma unroll
                    for (int e4 = 0; e4 < 4; ++e4) { const f32x4 v = sp[c * 4 + e4];
#pragma unroll
                        for (int e = 0; e < 4; ++e) x[e4 * 4 + e] = (tk_map(v[e]) & ~127) | (127 - ((q & 1) * 64 + c * 16 + e4 * 4 + e)); }
                    tk_sort_desc(x);
                    if (c == 0) {
#pragma unroll
                        for (int e = 0; e < 16; ++e) best[e] = x[e];
                    } else tk_merge_top(best, x);
                }
            }
            BLOCK_BAR();
#pragma unroll
            for (int e4 = 0; e4 < 4; ++e4) *(LAS v4u*)(L + row * 68 + q * 16 + e4 * 4) = (v4u){(unsigned)best[e4 * 4], (unsigned)best[e4 * 4 + 1], (unsigned)best[e4 * 4 + 2], (unsigned)best[e4 * 4 + 3]};
            BLOCK_BAR();
            if (tid < 128) {
                int a[16], b[16], t[16];
                LAS int* Lr = L + tid * 68;
#pragma unroll
                for (int e4 = 0; e4 < 4; ++e4) { const v4u va = *(LAS v4u*)(Lr + e4 * 4), vt = *(LAS v4u*)(Lr + 16 + e4 * 4);
#pragma unroll
                    for (int e = 0; e < 4; ++e) { a[e4 * 4 + e] = (int)va[e]; t[e4 * 4 + e] = (int)vt[e]; } }
                tk_merge_top(a, t);
#pragma unroll
                for (int e4 = 0; e4 < 4; ++e4) { const v4u vb = *(LAS v4u*)(Lr + 32 + e4 * 4), vt = *(LAS v4u*)(Lr + 48 + e4 * 4);
#pragma unroll
                    for (int e = 0; e < 4; ++e) { b[e4 * 4 + e] = (int)vb[e]; t[e4 * 4 + e] = (int)vt[e]; } }
                tk_merge_top(b, t);
                const int trow = u.pm * 256 + ai * 128 + tid;
                const f32x4 q0 = *(const f32x4*)(rss + (size_t)trow * 16), q1 = *(const f32x4*)(rss + (size_t)trow * 16 + 4), q2 = *(const f32x4*)(rss + (size_t)trow * 16 + 8), q3 = *(const f32x4*)(rss + (size_t)trow * 16 + 12);
                const float ssq = (((q0.x + q0.y) + (q0.z + q0.w)) + ((q1.x + q1.y) + (q1.z + q1.w))) + (((q2.x + q2.y) + (q2.z + q2.w)) + ((q3.x + q3.y) + (q3.z + q3.w)));
                const float rstd = 1.0f / sqrtf(ssq * (1.f / D) + RMS_EPS);
                const size_t o = ((size_t)trow * 8 + u.pn) * 16;
                tk_stage2(a, b, Lr, (__attribute__((address_space(1))) int*)(seli + o), (__attribute__((address_space(1))) float*)(selg + o), rstd);
            }
            BLOCK_BAR();
        }
    }
};
struct OneUnit {
    pg8::Unit u;
    __device__ __forceinline__ bool next(int i, pg8::Unit& o) const { if (i != 0) return false; o = u; return true; }
    __device__ __forceinline__ void a_ready(const pg8::Unit&) const {}
    __device__ __forceinline__ void done(const pg8::Unit&) const {}
};

__device__ __forceinline__ void p0_transpose_item(const float* W, int ldw, int ncols, bf16* WT, float scale, LAS float* scr, int item, int lane) {
    const int nblk = ncols / 64, kb = item / nblk, nb = item % nblk, k0 = 64 * kb, n0 = 64 * nb;
    f32x4 v[16];
#pragma unroll
    for (int i = 0; i < 16; ++i) v[i] = *(const f32x4*)(W + (size_t)(k0 + 4 * i + (lane >> 4)) * ldw + n0 + 4 * (lane & 15));
#pragma unroll
    for (int i = 0; i < 16; ++i) { LAS float* p = scr + (4 * i + (lane >> 4)) * 65 + 4 * (lane & 15); p[0] = v[i].x * scale; p[1] = v[i].y * scale; p[2] = v[i].z * scale; p[3] = v[i].w * scale; }
    LDS_WAIT(); asm volatile("" ::: "memory");
    const int c = lane & 7;
#pragma unroll
    for (int j = 0; j < 8; ++j) { const int n = (lane >> 3) + 8 * j; const LAS float* s = scr + (8 * c) * 65 + n;
        v4u o; o.x = pk2(s[0 * 65], s[1 * 65]); o.y = pk2(s[2 * 65], s[3 * 65]); o.z = pk2(s[4 * 65], s[5 * 65]); o.w = pk2(s[6 * 65], s[7 * 65]);
        *(v4u*)(WT + (size_t)(n0 + n) * 1024 + k0 + 8 * c) = o; }
    LDS_WAIT(); asm volatile("" ::: "memory");
}
__device__ __forceinline__ void rms_row_to_bf16(const float* xrow, const float* gain, bf16* orow, float* hcopy, int lane) {
    const f32x4* xr = (const f32x4*)xrow + lane; const f32x4* gr = (const f32x4*)gain + lane;
    f32x4 v[4]; float s = 0.f;
#pragma unroll
    for (int j = 0; j < 4; ++j) { v[j] = xr[64 * j]; s += (v[j].x * v[j].x + v[j].y * v[j].y) + (v[j].z * v[j].z + v[j].w * v[j].w); }
    if (hcopy) {
#pragma unroll
        for (int j = 0; j < 4; ++j) ((f32x4*)hcopy + lane)[64 * j] = v[j];
    }
    const float rstd = 1.0f / sqrtf(wave_sum(s) * (1.f / D) + RMS_EPS);
    unsigned long long* o8 = (unsigned long long*)orow + lane;
#pragma unroll
    for (int j = 0; j < 4; ++j) { const f32x4 g = gr[64 * j]; const f32x4 y = v[j] * rstd * g;
        o8[64 * j] = (unsigned long long)pk2(y.x, y.y) | ((unsigned long long)pk2(y.z, y.w) << 32); }
}
__device__ __forceinline__ void p0_prologue(Frame& F, bool dry) {
    if (!(dry && PROBE_PMODE == 1)) {
        LAS float* KL = (LAS float*)F.lds;
        LAS float* WL = (LAS float*)(F.lds + 128 * 132 * 4);
        const float* in10 = F.in(10); const float* in11 = F.in(11); const float* in2 = F.in(2);
        f32x4 kreg[8], wreg[4];
#define FOLD_LOAD(it_) do { const int l_ = (it_) >> 8, hp_ = ((it_) >> 4) & 15, k0_ = ((it_) & 15) * 64; \
            const float* kg_ = in11 + (size_t)(l_ * 16 + hp_) * 128 * 128; const float* wg_ = in10 + (size_t)l_ * 1024 * 2048 + (size_t)k0_ * 2048 + hp_ * 128; \
            _Pragma("unroll") for (int i = 0; i < 8; ++i) kreg[i] = *(const f32x4*)(kg_ + 4 * (F.tid + 512 * i)); \
            _Pragma("unroll") for (int i = 0; i < 4; ++i) { const int e = 4 * (F.tid + 512 * i); wreg[i] = *(const f32x4*)(wg_ + (size_t)(e >> 7) * 2048 + (e & 127)); } } while (0)
        if (F.vcu < DEPTH * 16 * 16) FOLD_LOAD(F.vcu);
        for (int it = F.vcu; it < DEPTH * 16 * 16; it += F.G) {
            const int l = it >> 8, hp = (it >> 4) & 15, k0 = (it & 15) * 64;
#pragma unroll
            for (int i = 0; i < 8; ++i) { const int e = 4 * (F.tid + 512 * i), n = e >> 7, d = e & 127; *(LAS f32x4*)(KL + n * 132 + d) = kreg[i]; }
#pragma unroll
            for (int i = 0; i < 4; ++i) { const int e = 4 * (F.tid + 512 * i), kk = e >> 7, d = e & 127; *(LAS f32x4*)(WL + kk * 132 + d) = wreg[i]; }
            if (it + F.G < DEPTH * 16 * 16) FOLD_LOAD(it + F.G);
            BLOCK_BAR();
            {
                const int i16 = F.lane & 15, g4 = F.lane >> 4, nt = F.wave;
                f32x4 facc[4];
#pragma unroll
                for (int mt = 0; mt < 4; ++mt) facc[mt] = (f32x4){0.f, 0.f, 0.f, 0.f};
#pragma unroll 2
                for (int s8 = 0; s8 < 8; ++s8) {
                    const f32x4 bq = *(const LAS f32x4*)(KL + (nt * 16 + i16) * 132 + 16 * s8 + 4 * g4);
                    f32x4 aq[4];
#pragma unroll
                    for (int mt = 0; mt < 4; ++mt) aq[mt] = *(const LAS f32x4*)(WL + (mt * 16 + i16) * 132 + 16 * s8 + 4 * g4);
#pragma unroll
                    for (int t = 0; t < 4; ++t)
#pragma unroll
                        for (int mt = 0; mt < 4; ++mt) facc[mt] = __builtin_amdgcn_mfma_f32_16x16x4f32(aq[mt][t], bq[t], facc[mt], 0, 0, 0);
                }
                bf16* o = (bf16*)(F.ws + WS_WP) + (size_t)l * 2048 * 1024 + (size_t)(hp * 128 + nt * 16 + i16) * 1024 + k0 + 4 * g4;
#pragma unroll
                for (int mt = 0; mt < 4; ++mt) { const f32x4 gf = *(const f32x4*)(in2 + (size_t)l * D + k0 + mt * 16 + 4 * g4); v2u w; w.x = pk2(facc[mt][0] * gf.x, facc[mt][1] * gf.y); w.y = pk2(facc[mt][2] * gf.z, facc[mt][3] * gf.w); *(v2u*)(o + mt * 16) = w; }
            }
            BLOCK_BAR();
        }
#undef FOLD_LOAD
    }
    LAS float* scr = (LAS float*)(F.lds + F.wave * 16640);
    const int gw = F.vcu * NWAVES + F.wave, NGW = F.G * NWAVES;
    constexpr int I_SQ = 16 * 16, I_IN = 16 * 48, PER_J = 3 * I_SQ + I_SQ + I_IN + I_SQ;
    if (!(dry && PROBE_PMODE == 2)) for (int it = gw; it < 2 * PER_J; it += NGW) {
        const int j = it / PER_J; int r = it % PER_J;
        const float* wqkv = F.in(4) + (size_t)j * 1024 * 3072;
        if (r < I_SQ) { p0_transpose_item(wqkv, 3072, 1024, (bf16*)(F.ws + WS_WQK) + (size_t)j * 2048 * 1024, 0.125f, scr, r, F.lane); continue; } r -= I_SQ;
        if (r < I_SQ) { p0_transpose_item(wqkv + 1024, 3072, 1024, (bf16*)(F.ws + WS_WQK) + (size_t)j * 2048 * 1024 + (size_t)1024 * 1024, 1.f, scr, r, F.lane); continue; } r -= I_SQ;
        if (r < I_SQ) { p0_transpose_item(wqkv + 2048, 3072, 1024, (bf16*)(F.ws + WS_WV) + (size_t)j * 1024 * 1024, 1.f, scr, r, F.lane); continue; } r -= I_SQ;
        if (r < I_SQ) { p0_transpose_item(F.in(5) + (size_t)j * 1024 * 1024, 1024, 1024, (bf16*)(F.ws + WS_WO) + (size_t)j * 1024 * 1024, 1.f, scr, r, F.lane); continue; } r -= I_SQ;
        if (r < I_IN) {
            const float* win = F.in(7) + (size_t)j * 1024 * 3072; bf16* wt = (bf16*)(F.ws + WS_WIN) + (size_t)j * 3072 * 1024;
            if (r < 512) { const int blk = r >> 5, pn = blk >> 1, which = blk & 1; p0_transpose_item(win + (which ? 2048 : 1024) + 128 * pn, 3072, 128, wt + (size_t)(256 * pn + 128 * which) * 1024, 1.f, scr, r & 31, F.lane); }
            else p0_transpose_item(win, 3072, 1024, wt + (size_t)2048 * 1024, 1.f, scr, r - 512, F.lane);
            continue; } r -= I_IN;
        p0_transpose_item(F.in(9) + (size_t)j * 1024 * 1024, 1024, 1024, (bf16*)(F.ws + WS_WOUT) + (size_t)j * 1024 * 1024, 1.f, scr, r, F.lane);
    }
    if (!(dry && PROBE_PMODE == 3)) {
        constexpr int NROW = DEPTH * 16384;
        const float* in12 = F.in(12); const float* in13 = F.in(13);
#define XC_LOAD(v, r0_) do { const int tb_ = (r0_) >= NROW ? 1 : 0, rr_ = (r0_) - tb_ * NROW; const float* src_ = (tb_ ? in13 : in12) + (size_t)rr_ * 1024 + 4 * F.lane; \
            _Pragma("unroll") for (int u = 0; u < 4; ++u) _Pragma("unroll") for (int i = 0; i < 4; ++i) v[u][i] = *(const f32x4*)(src_ + (size_t)u * 1024 + 256 * i); } while (0)
#if EXPERT_FP4
#define XC_PACK(v, u, q, dstp) do { v2u w_; _Pragma("unroll") for (int jj = 0; jj < 2; ++jj) { unsigned t_ = 0u; \
                    t_ = __builtin_amdgcn_cvt_scalef32_pk_fp4_f32(t_, v[u][2 * jj].x * q, v[u][2 * jj].y * q, 1.0f, 0); t_ = __builtin_amdgcn_cvt_scalef32_pk_fp4_f32(t_, v[u][2 * jj].z * q, v[u][2 * jj].w * q, 1.0f, 1); \
                    t_ = __builtin_amdgcn_cvt_scalef32_pk_fp4_f32(t_, v[u][2 * jj + 1].x * q, v[u][2 * jj + 1].y * q, 1.0f, 2); t_ = __builtin_amdgcn_cvt_scalef32_pk_fp4_f32(t_, v[u][2 * jj + 1].z * q, v[u][2 * jj + 1].w * q, 1.0f, 3); w_[jj] = t_; } \
                *(v2u*)(dstp) = w_; } while (0)
        constexpr float QMAX = 6.0f;
#else
#define XC_PACK(v, u, q, dstp) do { v4u w_; _Pragma("unroll") for (int i = 0; i < 4; ++i) { unsigned t_ = 0u; t_ = __builtin_amdgcn_cvt_pk_fp8_f32(v[u][i].x * q, v[u][i].y * q, t_, false); t_ = __builtin_amdgcn_cvt_pk_fp8_f32(v[u][i].z * q, v[u][i].w * q, t_, true); w_[i] = t_; } \
                *(v4u*)(dstp) = w_; } while (0)
        constexpr float QMAX = 256.0f;
#endif
#define XC_I4(x_) ((unsigned)__float2int_rn(x_) & 15u)
#define XC_PACK_I4(v, u, q, dstp) do { v2u w_; _Pragma("unroll") for (int jj = 0; jj < 2; ++jj) { const f32x4 a_ = v[u][2 * jj] * q, b_ = v[u][2 * jj + 1] * q; \
                    w_[jj] = XC_I4(a_.x) | (XC_I4(a_.y) << 4) | (XC_I4(a_.z) << 8) | (XC_I4(a_.w) << 12) | (XC_I4(b_.x) << 16) | (XC_I4(b_.y) << 20) | (XC_I4(b_.z) << 24) | (XC_I4(b_.w) << 28); } \
                *(v2u*)(dstp) = w_; } while (0)
#define XC_CONV(v, r0_) do { const int tb_ = (r0_) >= NROW ? 1 : 0, rr_ = (r0_) - tb_ * NROW; \
            unsigned char* dst_ = F.ws + (tb_ ? WS_DN : WS_UP) + (size_t)rr_ * ROWB + (ROWB / 64) * F.lane; float* sc_ = (float*)(F.ws + WS_SUP) + 2 * (size_t)rr_ + tb_; \
            _Pragma("unroll") for (int u = 0; u < 4; ++u) { float mx = 0.f; \
                _Pragma("unroll") for (int i = 0; i < 4; ++i) mx = fmaxf(fmaxf(mx, fmaxf(fabsf(v[u][i].x), fabsf(v[u][i].y))), fmaxf(fabsf(v[u][i].z), fabsf(v[u][i].w))); \
                _Pragma("unroll") for (int o = 1; o < 64; o <<= 1) mx = fmaxf(mx, __shfl_xor(mx, o)); \
                if (tb_) { const float q = mx > 0.f ? 7.0f / mx : 1.0f; XC_PACK_I4(v, u, q, dst_ + (size_t)u * ROWB); if (F.lane == 0) sc_[2 * u] = mx > 0.f ? mx * (1.0f / 7.0f) : 1.0f; } \
                else { const float q = mx > 0.f ? QMAX / mx : 1.0f; XC_PACK(v, u, q, dst_ + (size_t)u * ROWB); if (F.lane == 0) sc_[2 * u] = mx > 0.f ? mx * (1.0f / QMAX) : 1.0f; } } } while (0)
        const int stepr = NGW * 4;
        f32x4 va[4][4], vb[4][4];
        int r0 = gw * 4;
        if (r0 < 2 * NROW) XC_LOAD(va, r0);
#pragma unroll 1
        for (; r0 < 2 * NROW; r0 += 2 * stepr) {
            if (r0 + stepr < 2 * NROW) XC_LOAD(vb, r0 + stepr);
            XC_CONV(va, r0);
            if (r0 + 2 * stepr < 2 * NROW) XC_LOAD(va, r0 + 2 * stepr);
            if (r0 + stepr < 2 * NROW) XC_CONV(vb, r0 + stepr);
        }
#undef XC_LOAD
#undef XC_PACK
#undef XC_PACK_I4
#undef XC_I4
#undef XC_CONV
    }
    if (!(dry && PROBE_PMODE == 4)) {
        const float* x0 = F.in(0); const f32x4* gr = (const f32x4*)F.in(1) + F.lane;
        f32x4 gq[4];
#pragma unroll
        for (int j = 0; j < 4; ++j) gq[j] = gr[64 * j];
#pragma unroll 1
        for (int m0 = gw; m0 < M; m0 += 4 * NGW) {
            f32x4 v[4][4];
#pragma unroll
            for (int u = 0; u < 4; ++u) { const int m = m0 + u * NGW; if (m < M) {
#pragma unroll
                for (int j = 0; j < 4; ++j) v[u][j] = ((const f32x4*)(x0 + (size_t)m * D) + F.lane)[64 * j]; } }
#pragma unroll
            for (int u = 0; u < 4; ++u) { const int m = m0 + u * NGW; if (m < M) {
                float sq = 0.f;
#pragma unroll
                for (int j = 0; j < 4; ++j) { sq += (v[u][j].x * v[u][j].x + v[u][j].y * v[u][j].y) + (v[u][j].z * v[u][j].z + v[u][j].w * v[u][j].w); }
                const float rstd = 1.0f / sqrtf(wave_sum(sq) * (1.f / D) + RMS_EPS);
                unsigned long long* o8 = (unsigned long long*)((bf16*)(F.ws + WS_HN) + (size_t)m * D) + F.lane;
#pragma unroll
                for (int j = 0; j < 4; ++j) { const f32x4 y = v[u][j] * rstd * gq[j]; o8[64 * j] = (unsigned long long)pk2(y.x, y.y) | ((unsigned long long)pk2(y.z, y.w) << 32); } } }
        }
    }
}

__device__ __forceinline__ void conv_phase(Frame& F, int j) {
    const bf16* U = (const bf16*)(F.ws + WS_BIG); const bf16* GB = (const bf16*)(F.ws + WS_BIG + 32 * MiB); bf16* mix = (bf16*)(F.ws + WS_MIX);
    const float* wc = F.in(8) + (size_t)j * 3 * 1024;
    for (int idx = F.vcu * NTHR + F.tid; idx < M * 128; idx += F.G * NTHR) {
        const int t = idx >> 7, c8 = (idx & 127) * 8, s = t & (SEQ - 1);
        const v4u gb = *(const v4u*)(GB + (size_t)t * D + c8);
        float conv[8];
#pragma unroll
        for (int e = 0; e < 8; ++e) conv[e] = 0.f;
#pragma unroll
        for (int dj = -1; dj <= 1; ++dj) {
            if (s + dj >= 0 && s + dj < SEQ) {
                const v4u uu = *(const v4u*)(U + (size_t)(t + dj) * D + c8);
                const f32x4 w0 = *(const f32x4*)(wc + (dj + 1) * 1024 + c8), w1 = *(const f32x4*)(wc + (dj + 1) * 1024 + c8 + 4);
#pragma unroll
                for (int e2 = 0; e2 < 4; ++e2) {
                    const float wl = e2 < 2 ? w0[2 * e2] : w1[2 * e2 - 4], wh = e2 < 2 ? w0[2 * e2 + 1] : w1[2 * e2 - 3];
                    conv[2 * e2] += wl * bflo(uu[e2]); conv[2 * e2 + 1] += wh * bfhi(uu[e2]);
                }
            }
        }
        v4u o;
#pragma unroll
        for (int e2 = 0; e2 < 4; ++e2) o[e2] = pk2(bflo(gb[e2]) * conv[2 * e2], bfhi(gb[e2]) * conv[2 * e2 + 1]);
        *(v4u*)(mix + (size_t)t * 1024 + c8) = o;
    }
}

constexpr int AT_KSTR = 144, AT_VSTR = 1168, AT_KOFF = 0, AT_VOFF = 576 * AT_KSTR, AT_BOFF = AT_VOFF + 64 * AT_VSTR;
static_assert(AT_BOFF + 1860 <= PTAB_OFF, "attention LDS map");
__device__ __forceinline__ void attn_phase(Frame& F, int j) {
    const bf16* QK = (const bf16*)(F.ws + WS_BIG); const bf16* VT = (const bf16*)(F.ws + WS_VT); bf16* mix = (bf16*)(F.ws + WS_MIX);
    const float* biasl = F.in(6) + (size_t)j * NH * 15 * 31;
    const int lane = F.lane, q = lane & 15, g = lane >> 4, tid = F.tid;
    LAS unsigned char* KL = F.lds + AT_KOFF; LAS unsigned char* VL = F.lds + AT_VOFF; LAS float* btab = (LAS float*)(F.lds + AT_BOFF);
    v4u kreg[9], vreg[9];
    int cur_hh = -1;
#define AT_DECODE(it, b_, hh_, r0_, R0_) const int hh_ = (it) & 15, rp_##it = ((it) >> 4) & 63, b_ = (it) >> 10, r0_ = 2 * rp_##it; int R0_ = r0_ - 4; R0_ = R0_ < 0 ? 0 : (R0_ > NROWS - 8 ? NROWS - 8 : R0_);
#define AT_PREFETCH(it) do { AT_DECODE(it, pb, phh, pr0, pR0) \
        _Pragma("unroll") for (int i = 0; i < 9; ++i) { const int c = tid + 512 * i; \
            { const int key = c >> 3, ch = c & 7; int row = pR0 + (key >> 6); row = row > NROWS - 1 ? NROWS - 1 : row; \
              kreg[i] = *(const v4u*)(QK + ((size_t)pb * SEQ + row * 64 + (key & 63)) * 2048 + 1024 + phh * 64 + ch * 8); } \
            { const int d = c / 72, kch = c - d * 72; vreg[i] = *(const v4u*)(VT + (size_t)(phh * 64 + d) * M + (size_t)pb * SEQ + pR0 * 64 + kch * 8); } } } while (0)
    int it = F.vcu;
    if (it < 2048) AT_PREFETCH(it);
    for (; it < 2048; it += F.G) {
        AT_DECODE(it, b, hh, r0, R0)
        BLOCK_BAR();
#pragma unroll
        for (int i = 0; i < 9; ++i) { const int c = tid + 512 * i;
            *(LAS v4u*)(KL + (c >> 3) * AT_KSTR + (c & 7) * 16) = kreg[i];
            const int d = c / 72, kch = c - d * 72; *(LAS v4u*)(VL + d * AT_VSTR + kch * 16) = vreg[i]; }
        if (hh != cur_hh) { if (tid < 465) btab[tid] = biasl[(size_t)hh * 465 + tid]; cur_hh = hh; }
        BLOCK_BAR();
        const int r = r0 + (F.wave >> 2), jb = F.wave & 3;
        int rs = r - 4; rs = rs < 0 ? 0 : (rs > NROWS - 8 ? NROWS - 8 : rs);
        const int lr0 = rs - R0;
        int bs = 16 * jb - 8; bs = bs < 0 ? 0 : (bs > 32 ? 32 : bs);
        const int qc = 16 * jb + q; int wst = qc - 8; wst = wst < 0 ? 0 : (wst > 48 ? 48 : wst);
        const size_t tokq = (size_t)b * SEQ + r * 64 + qc;
        bf16x8 qf[2];
#pragma unroll
        for (int ks = 0; ks < 2; ++ks) qf[ks] = *(const bf16x8*)(QK + tokq * 2048 + hh * 64 + ks * 32 + 8 * g);
        f32x4 S[8][2];
        const int kcl_a = 8 * (q >> 2) + (q & 3);
#pragma unroll
        for (int wr = 0; wr < 8; ++wr)
#pragma unroll
            for (int T = 0; T < 2; ++T) {
                const LAS unsigned char* kp = KL + ((lr0 + wr) * 64 + bs + kcl_a + 4 * T) * AT_KSTR + 16 * g;
                const bf16x8 k0 = *(const LAS bf16x8*)kp, k1 = *(const LAS bf16x8*)(kp + 64);
                f32x4 c = (f32x4){0.f, 0.f, 0.f, 0.f};
                c = __builtin_amdgcn_mfma_f32_16x16x32_bf16(k0, qf[0], c, 0, 0, 0);
                c = __builtin_amdgcn_mfma_f32_16x16x32_bf16(k1, qf[1], c, 0, 0, 0);
                S[wr][T] = c;
            }
        float mx = -3.0e38f;
#pragma unroll
        for (int wr = 0; wr < 8; ++wr) {
            const LAS float* brow = btab + (rs + wr - r + 7) * 31;
#pragma unroll
            for (int T = 0; T < 2; ++T)
#pragma unroll
                for (int i = 0; i < 4; ++i) {
                    const int kc = bs + 8 * g + 4 * T + i;
                    int co = kc - qc + 15; co = co < 0 ? 0 : (co > 30 ? 30 : co);
                    const bool valid = (kc >= wst) && (kc < wst + 16);
                    const float v = valid ? S[wr][T][i] + brow[co] : -1e30f;
                    S[wr][T][i] = v; mx = fmaxf(mx, v);
                }
        }
        mx = fmaxf(mx, __shfl_xor(mx, 16)); mx = fmaxf(mx, __shfl_xor(mx, 32));
        float sum = 0.f;
        bf16x8 pf[8];
#pragma unroll
        for (int wr = 0; wr < 8; ++wr) {
            float p[8];
#pragma unroll
            for (int T = 0; T < 2; ++T)
#pragma unroll
                for (int i = 0; i < 4; ++i) { p[4 * T + i] = __expf(S[wr][T][i] - mx); sum += p[4 * T + i]; }
            v4u w; w.x = pk2(p[0], p[1]); w.y = pk2(p[2], p[3]); w.z = pk2(p[4], p[5]); w.w = pk2(p[6], p[7]);
            pf[wr] = __builtin_bit_cast(bf16x8, w);
        }
        sum += __shfl_xor(sum, 16); sum += __shfl_xor(sum, 32);
        if (it + F.G < 2048) { const int nit = it + F.G; AT_PREFETCH(nit); }
        f32x4 O[4];
#pragma unroll
        for (int dt = 0; dt < 4; ++dt) O[dt] = (f32x4){0.f, 0.f, 0.f, 0.f};
#pragma unroll
        for (int wr = 0; wr < 8; ++wr)
#pragma unroll
            for (int dt = 0; dt < 4; ++dt) {
                const bf16x8 vf = *(const LAS bf16x8*)(VL + (dt * 16 + q) * AT_VSTR + ((lr0 + wr) * 64 + bs + 8 * g) * 2);
                O[dt] = __builtin_amdgcn_mfma_f32_16x16x32_bf16(vf, pf[wr], O[dt], 0, 0, 0);
            }
        const float inv = 1.0f / sum;
#pragma unroll
        for (int dt = 0; dt < 4; ++dt) { v2u w; w.x = pk2(O[dt][0] * inv, O[dt][1] * inv); w.y = pk2(O[dt][2] * inv, O[dt][3] * inv);
            *(v2u*)(mix + tokq * 1024 + hh * 64 + dt * 16 + 4 * g) = w; }
    }
#undef AT_DECODE
#undef AT_PREFETCH
    BLOCK_BAR();
}
#if NAIVE_ATTN
__device__ __forceinline__ void attn_naive_phase(Frame& F, int j) {
    const bf16* QK = (const bf16*)(F.ws + WS_BIG); const bf16* VT = (const bf16*)(F.ws + WS_VT); bf16* mix = (bf16*)(F.ws + WS_MIX);
    const float* biasl = F.in(6) + (size_t)j * NH * 15 * 31;
    for (int idx = F.vcu * NTHR + F.tid; idx < M * NH; idx += F.G * NTHR) {
        const int hh = idx & 15, t = idx >> 4, b = t >> 13, s = t & (SEQ - 1), r = s >> 6, qc = s & 63;
        int rs = r - 4; rs = rs < 0 ? 0 : (rs > NROWS - 8 ? NROWS - 8 : rs);
        int wst = qc - 8; wst = wst < 0 ? 0 : (wst > 48 ? 48 : wst);
        float qv[64];
#pragma unroll
        for (int c = 0; c < 8; ++c) { const v4u w = *(const v4u*)(QK + (size_t)t * 2048 + hh * 64 + c * 8);
#pragma unroll
            for (int e = 0; e < 4; ++e) { qv[c * 8 + 2 * e] = bflo(w[e]); qv[c * 8 + 2 * e + 1] = bfhi(w[e]); } }
        float mrun = -3.0e38f, lrun = 0.f, o[64];
#pragma unroll
        for (int d = 0; d < 64; ++d) o[d] = 0.f;
        for (int wr = 0; wr < 8; ++wr)
            for (int kk = 0; kk < 16; ++kk) {
                const int kc = wst + kk; const size_t tk = (size_t)b * SEQ + (rs + wr) * 64 + kc;
                float sd = 0.f;
#pragma unroll
                for (int c = 0; c < 8; ++c) { const v4u w = *(const v4u*)(QK + tk * 2048 + 1024 + hh * 64 + c * 8);
#pragma unroll
                    for (int e = 0; e < 4; ++e) sd += qv[c * 8 + 2 * e] * bflo(w[e]) + qv[c * 8 + 2 * e + 1] * bfhi(w[e]); }
                int co = kc - qc + 15; co = co < 0 ? 0 : (co > 30 ? 30 : co);
                sd += biasl[(size_t)hh * 465 + (rs + wr - r + 7) * 31 + co];
                const float mn = fmaxf(mrun, sd), al = __expf(mrun - mn), p = __expf(sd - mn);
                lrun = lrun * al + p; mrun = mn;
#pragma unroll
                for (int d = 0; d < 64; ++d) o[d] = o[d] * al + p * bflo((unsigned)VT[(size_t)(hh * 64 + d) * M + tk]);
            }
        const float inv = 1.0f / lrun;
#pragma unroll
        for (int c = 0; c < 8; ++c) { v4u w;
#pragma unroll
            for (int e = 0; e < 4; ++e) w[e] = pk2(o[c * 8 + 2 * e] * inv, o[c * 8 + 2 * e + 1] * inv);
            *(v4u*)(mix + (size_t)t * 1024 + hh * 64 + c * 8) = w; }
    }
}
#endif
#if NAIVE_TOPK
__device__ __forceinline__ void select_naive_phase(Frame& F) {
    const float* SC = (const float*)(F.ws + WS_SC); int* seli = (int*)(F.ws + WS_SELI); float* selg = (float*)(F.ws + WS_SELG);
    LAS int* AB = (LAS int*)F.lds + F.tid * 33;
    for (int idx = F.vcu * NTHR + F.tid; idx < M * 8; idx += F.G * NTHR) {
        const float* s = SC + (size_t)idx * 256;
        int a[16], b[16], t[16];
        tk_stage1<4>(s, 0, a); tk_stage1<4>(s + 64, 64, t); tk_merge_top(a, t);
        tk_stage1<4>(s + 128, 0, b); tk_stage1<4>(s + 192, 64, t); tk_merge_top(b, t);
        tk_stage2(a, b, AB, seli + (size_t)idx * 16, selg + (size_t)idx * 16);
    }
}
#endif

__device__ __forceinline__ float gelu_erf(float a) { return 0.5f * a * (1.0f + erff(a * 0.70710678118654752f)); }
typedef float f32x2g __attribute__((ext_vector_type(2)));
#if EXPERT_FP4
typedef v2u rowv;
__device__ __forceinline__ rowv row_load(const unsigned char* T, int e, int lane) { return *(const v2u*)(T + (size_t)e * ROWB + 8 * lane); }
#define ROW_PAIR(r, m) __builtin_amdgcn_cvt_scalef32_pk_f32_fp4((r)[(m) >> 2], 1.0f, (m) & 3)
#else
typedef v4u rowv;
__device__ __forceinline__ rowv row_load(const unsigned char* T, int e, int lane) { return *(const v4u*)(T + (size_t)e * ROWB + 16 * lane); }
#define ROW_PAIR(r, m) __builtin_amdgcn_cvt_pk_f32_fp8((r)[(m) >> 1], ((m) & 1) != 0)
#endif
__device__ __forceinline__ void row_axpy(f32x2g (&out)[8], const rowv d, float ak) {
    const f32x2g a2 = (f32x2g){ak, ak};
    out[0] = __builtin_elementwise_fma(a2, ROW_PAIR(d, 0), out[0]); out[1] = __builtin_elementwise_fma(a2, ROW_PAIR(d, 1), out[1]); out[2] = __builtin_elementwise_fma(a2, ROW_PAIR(d, 2), out[2]); out[3] = __builtin_elementwise_fma(a2, ROW_PAIR(d, 3), out[3]);
    out[4] = __builtin_elementwise_fma(a2, ROW_PAIR(d, 4), out[4]); out[5] = __builtin_elementwise_fma(a2, ROW_PAIR(d, 5), out[5]); out[6] = __builtin_elementwise_fma(a2, ROW_PAIR(d, 6), out[6]); out[7] = __builtin_elementwise_fma(a2, ROW_PAIR(d, 7), out[7]);
}
typedef int v8i_g __attribute__((ext_vector_type(8)));
typedef unsigned char u8x4g __attribute__((ext_vector_type(4)));
#define TR_SHUF(a, b, i0, i1, i2, i3) __builtin_amdgcn_perm((unsigned)(b), (unsigned)(a), (unsigned)((i0) | ((i1) << 8) | ((i2) << 16) | ((i3) << 24)))
__device__ __forceinline__ void tr8_nib(const unsigned (&w)[8], unsigned (&t)[8]) {
    unsigned x[8], y[8];
#pragma unroll
    for (int r = 0; r < 4; ++r) { x[r] = TR_SHUF(w[r], w[r + 4], 0, 1, 4, 5); x[r + 4] = TR_SHUF(w[r], w[r + 4], 2, 3, 6, 7); }
#pragma unroll
    for (int g = 0; g < 2; ++g)
#pragma unroll
        for (int r = 0; r < 2; ++r) { y[4 * g + r] = TR_SHUF(x[4 * g + r], x[4 * g + r + 2], 0, 4, 2, 6); y[4 * g + r + 2] = TR_SHUF(x[4 * g + r], x[4 * g + r + 2], 1, 5, 3, 7); }
#pragma unroll
    for (int p = 0; p < 4; ++p) { const unsigned e = y[2 * p], o = y[2 * p + 1];
        t[2 * p] = (e & 0x0F0F0F0Fu) | ((o << 4) & 0xF0F0F0F0u);
        t[2 * p + 1] = ((e >> 4) & 0x0F0F0F0Fu) | (o & 0xF0F0F0F0u); }
}
__device__ __forceinline__ void gather_phase(Frame& F, int layer, bool dry) {
    const unsigned char* UP = F.ws + WS_UP + (size_t)layer * 16384 * ROWB; const unsigned char* DN = F.ws + WS_DN + (size_t)layer * 16384 * ROWB;
    const f32x2g* SC2 = (const f32x2g*)(F.ws + WS_SUP) + (size_t)layer * 16384;
    const float* gain = F.in(2) + (size_t)layer * D; const float* gnext = layer < DEPTH - 1 ? F.in(1) + (size_t)(layer + 1) * D : F.in(3);
    float* outp = F.out();
    const int* seli = (const int*)(F.ws + WS_SELI); const float* selg = (const float*)(F.ws + WS_SELG);
    const bf16* H = (const bf16*)(F.ws + WS_H); bf16* HN = (bf16*)(F.ws + (dry ? WS_SC + 64 * MiB : WS_HN)); bf16* HW = (bf16*)(F.ws + (dry ? WS_SC : WS_H)); if (dry) outp = (float*)(F.ws + WS_SC);
    const int lane = F.lane, gw = F.vcu * NWAVES + F.wave, NGW = F.G * NWAVES;
    const bool b5 = lane & 32, b4 = lane & 16, b3 = lane & 8, b2 = lane & 4;
    constexpr int G_RS = 528, G_RB = 32 * G_RS, G_NSLOT = 4;
    LAS unsigned char* RB = F.lds + F.wave * G_RB;
    LAS float* ACT = (LAS float*)(F.lds + 8 * G_RB + F.wave * (G_NSLOT * 512));
    static_assert(8 * G_RB + 8 * G_NSLOT * 512 + 8 * 1024 <= PTAB_OFF, "gather LDS map");
#pragma unroll 1
    for (int base = gw; base < M; base += G_NSLOT * NGW) {
    LAS unsigned char* X8 = F.lds + 8 * G_RB + 8 * G_NSLOT * 512 + F.wave * 1024;
    const int n16 = lane & 15, g4 = lane >> 4;
    v2u nhb[4]; int nidx_lo = 0, nidx_hi = 0; float ng_lo = 0.f, ng_hi = 0.f;
#define TOK_LOAD(t_) do { const bf16* hr_ = H + (size_t)(t_) * D + 4 * lane; _Pragma("unroll") for (int i = 0; i < 4; ++i) nhb[i] = *(const v2u*)(hr_ + 256 * i); \
        nidx_lo = seli[(size_t)(t_) * 128 + lane]; nidx_hi = seli[(size_t)(t_) * 128 + 64 + lane]; ng_lo = selg[(size_t)(t_) * 128 + lane]; ng_hi = selg[(size_t)(t_) * 128 + 64 + lane]; } while (0)
    if (base < M) TOK_LOAD(base);
#pragma unroll 1
    for (int slot = 0; slot < G_NSLOT; ++slot) {
        const int t = base + slot * NGW; if (t >= M) break;
        f32x4 hv[4];
#pragma unroll
        for (int i = 0; i < 4; ++i) { const unsigned w0_ = nhb[i].x, w1_ = nhb[i].y; hv[i] = (f32x4){bflo(w0_), bfhi(w0_), bflo(w1_), bfhi(w1_)}; }
        const int idx_lo = nidx_lo, idx_hi = nidx_hi; const float g_lo = ng_lo, g_hi = ng_hi;
        if (slot + 1 < G_NSLOT && t + NGW < M) TOK_LOAD(t + NGW);
        float ss = 0.f;
#pragma unroll
        for (int i = 0; i < 4; ++i) ss += (hv[i].x * hv[i].x + hv[i].y * hv[i].y) + (hv[i].z * hv[i].z + hv[i].w * hv[i].w);
        const float rstd = 1.0f / sqrtf(wave_sum(ss) * (1.f / D) + RMS_EPS);
        float xmax = 0.f;
        f32x4 xv[4];
#pragma unroll
        for (int i = 0; i < 4; ++i) { const f32x4 g = *(const f32x4*)(gain + 256 * i + 4 * lane); xv[i] = hv[i] * rstd * g;
            xmax = fmaxf(fmaxf(xmax, fmaxf(fabsf(xv[i].x), fabsf(xv[i].y))), fmaxf(fabsf(xv[i].z), fabsf(xv[i].w))); }
#pragma unroll
        for (int o = 1; o < 64; o <<= 1) xmax = fmaxf(xmax, __shfl_xor(xmax, o));
        const float qx = xmax > 0.f ? 256.0f / xmax : 1.0f, xinv = xmax > 0.f ? xmax * (1.0f / 256.0f) : 1.0f;
        {
            v4u w;
#pragma unroll
            for (int i = 0; i < 4; ++i) { unsigned tt = 0u; tt = __builtin_amdgcn_cvt_pk_fp8_f32(xv[i].x * qx, xv[i].y * qx, tt, false); tt = __builtin_amdgcn_cvt_pk_fp8_f32(xv[i].z * qx, xv[i].w * qx, tt, true); w[i] = tt; }
            *(LAS v4u*)(X8 + 16 * lane) = w;
        }
        LDS_WAIT(); asm volatile("" ::: "memory");
        v8i_g bx[8];
#pragma unroll
        for (int s8 = 0; s8 < 8; ++s8) { const v4u b0 = *(const LAS v4u*)(X8 + 128 * s8 + 16 * g4), b1 = *(const LAS v4u*)(X8 + 128 * s8 + 64 + 16 * g4);
            bx[s8] = (v8i_g){(int)b0.x, (int)b0.y, (int)b0.z, (int)b0.w, (int)b1.x, (int)b1.y, (int)b1.z, (int)b1.w}; }
        LDS_WAIT(); asm volatile("" ::: "memory");
#define UP_LOAD(buf, hq) do { const int sel_ = (hq) < 2 ? idx_lo : idx_hi; _Pragma("unroll") for (int k = 0; k < 32; ++k) buf[k] = row_load(UP, __builtin_amdgcn_readlane(sel_, ((hq) & 1) * 32 + k), lane); } while (0)
#define DN_LOAD(buf, hb) do { const int sel_ = (hb) < 4 ? idx_lo : idx_hi; _Pragma("unroll") for (int k = 0; k < 16; ++k) buf[k] = row_load(DN, __builtin_amdgcn_readlane(sel_, ((hb) & 3) * 16 + k), lane); } while (0)
        rowv da[16];
        {
            rowv ur[32];
            UP_LOAD(ur, 0);
#define UP_NEXT UP_LOAD(ur, hq + 1)
#pragma unroll 1
            for (int hq = 0; hq < 3; ++hq) {
                const int sel = hq < 2 ? idx_lo : idx_hi; const float gsel = hq < 2 ? g_lo : g_hi; const int lb0 = (hq & 1) * 32;
#pragma unroll
                for (int k = 0; k < 32; ++k) *(LAS v2u*)(RB + k * G_RS + 8 * lane) = ur[k];
                float sc[4];
#pragma unroll
                for (int hh_ = 0; hh_ < 2; ++hh_) { const int ek_ = __shfl(sel, lb0 + hh_ * 16 + 4 * g4 + (n16 & 3)); const f32x2g s2_ = SC2[ek_]; sc[2 * hh_] = s2_.x; sc[2 * hh_ + 1] = s2_.y; }
                LDS_WAIT(); asm volatile("" ::: "memory");
                UP_NEXT;
#pragma unroll
                for (int hh_ = 0; hh_ < 2; ++hh_) { const int lb = lb0 + hh_ * 16;
                    f32x4 c = (f32x4){0.f, 0.f, 0.f, 0.f};
#pragma unroll
                    for (int s8 = 0; s8 < 8; ++s8) { const v4u a4 = *(const LAS v4u*)(RB + (hh_ * 16 + n16) * G_RS + 64 * s8 + 16 * g4); const v8i_g a8 = (v8i_g){(int)a4.x, (int)a4.y, (int)a4.z, (int)a4.w, 0, 0, 0, 0};
                        c = __builtin_amdgcn_mfma_scale_f32_16x16x128_f8f6f4(a8, bx[s8], c, 4, 0, 0, 0x7f7f7f7f, 0, 0x7f7f7f7f); }
                    const int r_ = n16 & 3, k_ = 4 * g4 + r_;
                    const float my = r_ == 0 ? c[0] : (r_ == 1 ? c[1] : (r_ == 2 ? c[2] : c[3]));
                    const float gate = __shfl(gsel, lb + k_);
                    const float act = gelu_erf(my * sc[2 * hh_] * xinv) * gate * sc[2 * hh_ + 1];
                    if (n16 < 4) ACT[slot * 128 + hq * 32 + hh_ * 16 + k_] = act; }
                LDS_WAIT(); asm volatile("" ::: "memory");
            }
#undef UP_NEXT
#define UP_NEXT DN_LOAD(da, 0)
            { const int hq = 3;
                const int sel = hq < 2 ? idx_lo : idx_hi; const float gsel = hq < 2 ? g_lo : g_hi; const int lb0 = (hq & 1) * 32;
#pragma unroll
                for (int k = 0; k < 32; ++k) *(LAS v2u*)(RB + k * G_RS + 8 * lane) = ur[k];
                float sc[4];
#pragma unroll
                for (int hh_ = 0; hh_ < 2; ++hh_) { const int ek_ = __shfl(sel, lb0 + hh_ * 16 + 4 * g4 + (n16 & 3)); const f32x2g s2_ = SC2[ek_]; sc[2 * hh_] = s2_.x; sc[2 * hh_ + 1] = s2_.y; }
                LDS_WAIT(); asm volatile("" ::: "memory");
                UP_NEXT;
#pragma unroll
                for (int hh_ = 0; hh_ < 2; ++hh_) { const int lb = lb0 + hh_ * 16;
                    f32x4 c = (f32x4){0.f, 0.f, 0.f, 0.f};
#pragma unroll
                    for (int s8 = 0; s8 < 8; ++s8) { const v4u a4 = *(const LAS v4u*)(RB + (hh_ * 16 + n16) * G_RS + 64 * s8 + 16 * g4); const v8i_g a8 = (v8i_g){(int)a4.x, (int)a4.y, (int)a4.z, (int)a4.w, 0, 0, 0, 0};
                        c = __builtin_amdgcn_mfma_scale_f32_16x16x128_f8f6f4(a8, bx[s8], c, 4, 0, 0, 0x7f7f7f7f, 0, 0x7f7f7f7f); }
                    const int r_ = n16 & 3, k_ = 4 * g4 + r_;
                    const float my = r_ == 0 ? c[0] : (r_ == 1 ? c[1] : (r_ == 2 ? c[2] : c[3]));
                    const float gate = __shfl(gsel, lb + k_);
                    const float act = gelu_erf(my * sc[2 * hh_] * xinv) * gate * sc[2 * hh_ + 1];
                    if (n16 < 4) ACT[slot * 128 + hq * 32 + hh_ * 16 + k_] = act; }
                LDS_WAIT(); asm volatile("" ::: "memory");
            }
#undef UP_NEXT
        }
#undef UP_LOAD
        LDS_WAIT(); asm volatile("" ::: "memory");
        const float a_lo = ACT[slot * 128 + lane], a_hi = ACT[slot * 128 + 64 + lane];
        float amax = fmaxf(fabsf(a_lo), fabsf(a_hi));
#pragma unroll
        for (int o = 1; o < 64; o <<= 1) amax = fmaxf(amax, __shfl_xor(amax, o));
        const float ainv = amax > 0.f ? 119.0f / amax : 0.f, tscale = amax * (1.0f / 119.0f);
        unsigned pd[4];
        {
            const int A0 = __float2int_rn(a_lo * ainv), A1 = __float2int_rn(a_hi * ainv);
            const int h0 = (A0 + 8) >> 4, l0 = A0 - 16 * h0, h1 = (A1 + 8) >> 4, l1 = A1 - 16 * h1;
            const int sh = 4 * (lane & 7);
            pd[0] = ((unsigned)l0 & 15u) << sh; pd[1] = ((unsigned)h0 & 15u) << sh; pd[2] = ((unsigned)l1 & 15u) << sh; pd[3] = ((unsigned)h1 & 15u) << sh;
#pragma unroll
            for (int q = 0; q < 4; ++q) { pd[q] |= (unsigned)__shfl_xor((int)pd[q], 1); pd[q] |= (unsigned)__shfl_xor((int)pd[q], 2); pd[q] |= (unsigned)__shfl_xor((int)pd[q], 4); }
        }
        int acc0[16], acc1[16];
#pragma unroll
        for (int e = 0; e < 16; ++e) { acc0[e] = 0; acc1[e] = 0; }
#define DN_STEP(buf, hb) do { const unsigned plo_ = (hb) < 4 ? pd[0] : pd[2], phi_ = (hb) < 4 ? pd[1] : pd[3]; \
            _Pragma("unroll") for (int gg = 0; gg < 2; ++gg) { \
                const int alo_ = __builtin_amdgcn_readlane((int)plo_, ((hb) & 3) * 16 + 8 * gg), ahi_ = __builtin_amdgcn_readlane((int)phi_, ((hb) & 3) * 16 + 8 * gg); \
                _Pragma("unroll") for (int jj = 0; jj < 2; ++jj) { unsigned w_[8], t_[8]; \
                    _Pragma("unroll") for (int r = 0; r < 8; ++r) w_[r] = buf[8 * gg + r][jj]; \
                    tr8_nib(w_, t_); \
                    _Pragma("unroll") for (int c = 0; c < 8; ++c) { acc0[8 * jj + c] = __builtin_amdgcn_sdot8((int)t_[c], alo_, acc0[8 * jj + c], false); acc1[8 * jj + c] = __builtin_amdgcn_sdot8((int)t_[c], ahi_, acc1[8 * jj + c], false); } } } } while (0)
        {
            rowv db[16];
            DN_LOAD(db, 1); DN_STEP(da, 0);
            DN_LOAD(da, 2); DN_STEP(db, 1);
            DN_LOAD(db, 3); DN_STEP(da, 2);
            DN_LOAD(da, 4); DN_STEP(db, 3);
            DN_LOAD(db, 5); DN_STEP(da, 4);
            DN_LOAD(da, 6); DN_STEP(db, 5);
            DN_LOAD(db, 7); DN_STEP(da, 6);
            DN_STEP(db, 7);
        }
#undef DN_LOAD
#undef DN_STEP
        f32x2g out[8];
#pragma unroll
        for (int e = 0; e < 8; ++e) out[e] = (f32x2g){((float)acc0[2 * e] + 16.0f * (float)acc1[2 * e]) * tscale, ((float)acc0[2 * e + 1] + 16.0f * (float)acc1[2 * e + 1]) * tscale};
        float ss2 = 0.f;
#pragma unroll
        for (int i = 0; i < 4; ++i) { hv[i].x += out[2 * i].x; hv[i].y += out[2 * i].y; hv[i].z += out[2 * i + 1].x; hv[i].w += out[2 * i + 1].y;
            ss2 += (hv[i].x * hv[i].x + hv[i].y * hv[i].y) + (hv[i].z * hv[i].z + hv[i].w * hv[i].w); }
        const float rstd2 = 1.0f / sqrtf(wave_sum(ss2) * (1.f / D) + RMS_EPS);
        f32x4 y[4];
#pragma unroll
        for (int i = 0; i < 4; ++i) y[i] = hv[i] * rstd2 * *(const f32x4*)(gnext + 256 * i + 4 * lane);
        if (layer < DEPTH - 1) {
            bf16* hw_ = HW + (size_t)t * D + 4 * lane; bf16* hn = HN + (size_t)t * D + 4 * lane;
#pragma unroll
            for (int i = 0; i < 4; ++i) { v2u a_, b_; a_.x = pk2(hv[i].x, hv[i].y); a_.y = pk2(hv[i].z, hv[i].w); b_.x = pk2(y[i].x, y[i].y); b_.y = pk2(y[i].z, y[i].w);
                *(v2u*)(hw_ + 256 * i) = a_; *(v2u*)(hn + 256 * i) = b_; }
        } else {
            float* orow = outp + (size_t)t * D + 4 * lane;
#pragma unroll
            for (int i = 0; i < 4; ++i) *(f32x4*)(orow + 256 * i) = y[i];
        }
    }
    LDS_WAIT(); asm volatile("" ::: "memory");
    }
#undef TOK_LOAD
}

struct Args { const float* in[14]; float* out; unsigned char* ws; int ph_lo, ph_hi; };
__global__ void __launch_bounds__(NTHR, 2) mega_fwd(Args args) {
    extern __shared__ __attribute__((aligned(16))) unsigned char lds[];
    Frame F;
    F.lds = (LAS unsigned char*)lds;
    F.tid = threadIdx.x; F.lane = F.tid & 63; F.wave = __builtin_amdgcn_readfirstlane(F.tid >> 6);
    F.G = gridDim.x; { const int bx = blockIdx.x; F.vcu = (F.G % 8 == 0) ? (bx % 8) * (F.G / 8) + bx / 8 : bx; }
    F.ws = args.ws;
    volatile LAS unsigned* MISC = (volatile LAS unsigned*)(F.lds + MISC_OFF);
    if (F.tid < 64) MISC[F.tid] = 0u;
    if (F.tid < 15) { const unsigned long long p = F.tid < 14 ? (unsigned long long)args.in[F.tid] : (unsigned long long)args.out;
        volatile LAS unsigned* t = (volatile LAS unsigned*)(F.lds + PTAB_OFF); t[2 * F.tid] = (unsigned)p; t[2 * F.tid + 1] = (unsigned)(p >> 32); }
    __syncthreads();
    XcdBarrier bar; bar.bar = (unsigned*)(F.ws + WS_CTL) + CW_BAR; bar.x = 0; bar.st = nullptr;
    if (MK_N_LAUNCHES == 1) bar = xcd_barrier_post((unsigned*)(F.ws + WS_CTL) + CW_BAR, MISC + 8);

#pragma unroll 1
    for (int ph = args.ph_lo; ph < args.ph_hi; ++ph) {
        bool did = true;
        const int kind_ = ph == 0 ? 7 : (ph - 1) % PH_PER_LAYER; const int nrep = (PROBE_REP >= 0 && kind_ == PROBE_REP && (ph == 0 || ((PROBE_LMASK >> ((ph - 1) / PH_PER_LAYER)) & 1))) ? 2 : 1;
#pragma unroll 1
        for (int rep = 0; rep < nrep; ++rep) {
        const bool dry = (nrep == 2 && rep == 0);
        { int t_ = threadIdx.x; asm volatile("" : "+v"(t_)); F.tid = t_; F.lane = t_ & 63; F.wave = __builtin_amdgcn_readfirstlane(t_ >> 6);
          unsigned long long ws_ = (unsigned long long)args.ws; asm volatile("" : "+s"(ws_)); F.ws = (unsigned char*)(__attribute__((address_space(1))) unsigned char*)ws_; }
#ifndef DIS_PRO
        if (ph == 0) p0_prologue(F, dry);
#else
        if (ph == 0) {}
#endif
        else {
            const int layer = (ph - 1) / PH_PER_LAYER, k = (ph - 1) % PH_PER_LAYER, j = layer >> 1; const bool is_attn = (layer & 1) == 0;
            if (k == 0) {
                if (!is_attn) {
                    pg8::Gemm g{(const pg8::bf16_t*)(F.ws + WS_HN), (const pg8::bf16_t*)(F.ws + WS_WIN) + (size_t)j * 3072 * 1024, M, 3072, D};
                    pg8::StaticOrder S; S.init(g.M, g.N, F.G, (int)blockIdx.x);
                    EpiConvIn E{(bf16*)(F.ws + WS_BIG), (bf16*)(F.ws + WS_BIG + 32 * MiB)};
                    pg8::gemm_phase<EpiConvIn, pg8::StaticOrder, true, true>(F.lds, g, S, E);
                }
                const int ng = is_attn ? 2 : 0;
#pragma unroll 1
                for (int gi = 0; gi < ng; ++gi) {
                    pg8::Gemm g; pg8::EpiBf16<0> E; E.bias = nullptr; E.split_cols = 0; E.split_stride = 0; E.scale0 = 1.f;
                    if (is_attn && gi == 0) { g = pg8::Gemm{(const pg8::bf16_t*)(F.ws + WS_HN), (const pg8::bf16_t*)(F.ws + WS_WQK) + (size_t)j * 2048 * 1024, M, 2048, D}; E.O = (pg8::bf16_t*)(F.ws + WS_BIG); E.ldc = 2048; }
                    else if (is_attn) { g = pg8::Gemm{(const pg8::bf16_t*)(F.ws + WS_WV) + (size_t)j * 1024 * 1024, (const pg8::bf16_t*)(F.ws + WS_HN), D, M, D}; E.O = (pg8::bf16_t*)(F.ws + WS_VT); E.ldc = M; }
                    else { g = pg8::Gemm{(const pg8::bf16_t*)(F.ws + WS_HN), (const pg8::bf16_t*)(F.ws + WS_WIN) + (size_t)j * 3072 * 1024, M, 3072, D}; E.O = (pg8::bf16_t*)(F.ws + WS_BIG); E.ldc = 3072; }
                    pg8::StaticOrder S; S.init(g.M, g.N, F.G, (int)blockIdx.x);
                    pg8::gemm_phase<pg8::EpiBf16<0>, pg8::StaticOrder, true, true>(F.lds, g, S, E);
                }
            } else if (k == 1) {
                if (is_attn) {
#if NAIVE_ATTN
                    attn_naive_phase(F, j);
#elif !defined(DIS_ATTN)
                    attn_phase(F, j);
#endif
                } else {
#ifndef DIS_CONV
                    conv_phase(F, j);
#endif
                }
            } else if (k == 2) {
                pg8::Gemm g{(const pg8::bf16_t*)(F.ws + WS_MIX), (const pg8::bf16_t*)(F.ws + (is_attn ? WS_WO : WS_WOUT)) + (size_t)j * 1024 * 1024, M, D, D};
                pg8::StaticOrder S; S.init(M, D, F.G, (int)blockIdx.x);
                float* rssp = (float*)(F.ws + (dry ? WS_SC + 96 * MiB : WS_RSS)); bf16* hout = (bf16*)(F.ws + (dry ? WS_SC : WS_H));
                if (layer == 0) { EpiRes<true> E{(const void*)F.in(0), hout, rssp}; pg8::gemm_phase<EpiRes<true>, pg8::StaticOrder, false, true>(F.lds, g, S, E); }
                else { EpiRes<false> E{(const void*)(F.ws + WS_H), hout, rssp}; pg8::gemm_phase<EpiRes<false>, pg8::StaticOrder, false, true>(F.lds, g, S, E); }
            } else if (k == 3) {
                did = false;
            } else if (k == 4) {
                pg8::Gemm g{(const pg8::bf16_t*)(F.ws + WS_H), (const pg8::bf16_t*)(F.ws + WS_WP) + (size_t)layer * 2048 * 1024, M, 2048, D};
                pg8::StaticOrder S; S.init(M, 2048, F.G, (int)blockIdx.x);
#if NAIVE_TOPK
                EpiF32 E{(float*)(F.ws + WS_SC), 2048};
                pg8::gemm_phase<EpiF32, pg8::StaticOrder, true, true>(F.lds, g, S, E);
#else
#ifndef DIS_TOPK
                EpiTopK E{(int*)(F.ws + WS_SELI), (float*)(F.ws + WS_SELG), (const float*)(F.ws + WS_RSS)};
#pragma unroll 1
                for (int i = 0;; ++i) { OneUnit O1; if (!S.next(i, O1.u)) break; pg8::gemm_phase<EpiTopK, OneUnit, false, true>(F.lds, g, O1, E); }
#endif
#endif
            } else if (k == 5) {
#if NAIVE_TOPK
                select_naive_phase(F);
#else
                did = false;
#endif
            } else {
#ifndef DIS_GATHER
                gather_phase(F, layer, dry);
#endif
            }
        }
        if (MK_N_LAUNCHES == 1 && dry) xcd_barrier(bar);
        }
        if (MK_N_LAUNCHES == 1 && did && ph + 1 < args.ph_hi) { xcd_barrier(bar);
#ifdef PROBE_BAR2
            xcd_barrier(bar);
#endif
        }
    }
}

extern "C" void kernel_launch(void* const* d_in, const int* in_sizes, int n_in, void* d_out, int out_size, void* d_ws, size_t ws_size, hipStream_t stream) {
    static int grid = 0;
    if (grid == 0) {
        if (n_in != 14 || out_size != M * D || ws_size < WS_END) { fprintf(stderr, "kernel_launch: unexpected shapes (n_in %d, out %d, ws %zu); nothing launched\n", n_in, out_size, ws_size); grid = -1; return; }
        int dev = 0, cus = 0, per_cu = 0;
        if (hipGetDevice(&dev) != hipSuccess || hipDeviceGetAttribute(&cus, hipDeviceAttributeMultiprocessorCount, dev) != hipSuccess) { grid = -1; return; }
        if (hipFuncSetAttribute((const void*)mega_fwd, hipFuncAttributeMaxDynamicSharedMemorySize, LDS_BYTES) != hipSuccess) { fprintf(stderr, "kernel_launch: hipFuncSetAttribute failed\n"); grid = -1; return; }
        if (hipOccupancyMaxActiveBlocksPerMultiprocessor(&per_cu, (const void*)mega_fwd, NTHR, LDS_BYTES) != hipSuccess || per_cu < 1) fprintf(stderr, "kernel_launch: note: occupancy query reports %d\n", per_cu);
        (void)hipGetLastError();
        grid = cus;
    }
    if (grid < 0) return;
    if (hipMemsetAsync((char*)d_ws + WS_CTL, 0, CTL_ZERO_BYTES, stream) != hipSuccess) return;
    Args a{};
    for (int i = 0; i < 14; ++i) a.in[i] = (const float*)d_in[i];
    a.out = (float*)d_out; a.ws = (unsigned char*)d_ws;
    if (MK_N_LAUNCHES == 1) { a.ph_lo = 0; a.ph_hi = N_PHASES; hipLaunchKernelGGL(mega_fwd, dim3(grid), dim3(NTHR), LDS_BYTES, stream, a); }
    else for (int ph = 0; ph < N_PHASES; ++ph) {
        if (ph > 0 && ((ph - 1) % PH_PER_LAYER == 3 || (!NAIVE_TOPK && (ph - 1) % PH_PER_LAYER == 5))) continue;
        a.ph_lo = ph; a.ph_hi = ph + 1; hipLaunchKernelGGL(mega_fwd, dim3(grid), dim3(NTHR), LDS_BYTES, stream, a);
    }
}
```

```cpp
#include <hip/hip_runtime.h>
#include <cstdio>
#include <cstdint>
namespace pg8 {
#define PG8_LAS __attribute__((address_space(3)))
typedef unsigned short bf16_t;
typedef short bf16x8 __attribute__((ext_vector_type(8)));
typedef float f32x4 __attribute__((ext_vector_type(4)));
typedef unsigned u32x4 __attribute__((ext_vector_type(4)));
constexpr int BM = 256, BK = 64, HALF = 128, HTB = HALF * BK * 2  , STAGE_BYTES = 8 * HTB, NXCD = 8, WGM = 8;

__host__ __device__ __forceinline__ int lds_byte(int r, int c) { const int st = (r >> 4) * 2 + (c >> 5), rr = r & 15, cc = c & 31, ob = rr * 64 + cc * 2; return st * 1024 + (ob ^ (((ob >> 9) & 1) << 5)); }
__host__ __device__ __forceinline__ void stage_rc(int b, int& R, int& C) { const int st = b / 1024, sb = b % 1024, swz = sb ^ (((sb >> 9) & 1) << 5); R = (st >> 1) * 16 + swz / 64; C = (st & 1) * 32 + (swz % 64) / 2; }
__host__ __device__ __forceinline__ int perm32(int rho) { const int n = rho >> 4, i = rho & 15; return 8 * (i >> 2) + 4 * n + (i & 3); }

struct Unit { int pm, pn; };
struct Gemm { const bf16_t* A; const bf16_t* Bt; int M, N, K; };

struct StaticOrder {
    int nM, nN, nwg, G, c;
    __host__ __device__ void init(int M, int N, int G_, int c_) { nM = M / BM; nN = N / BM; nwg = nM * nN; G = G_; c = c_; }
    __host__ __device__ bool next(int i, Unit& u) const {
        const long L = (long)i * G + c; if (L >= nwg) return false;
        int wgid = (int)L; { const int q = nwg / NXCD, r = nwg % NXCD, xcd = wgid % NXCD, off = wgid / NXCD; wgid = (xcd < r ? xcd * (q + 1) : r * (q + 1) + (xcd - r) * q) + off; }
        const int nig = WGM * nN, gid = wgid / nig, fm = gid * WGM, gsz = (nM - fm) < WGM ? (nM - fm) : WGM;
        u.pm = fm + ((wgid % nig) % gsz); u.pn = (wgid % nig) / gsz; return true;
    }
    __device__ __forceinline__ void a_ready(const Unit&) const {}
    __device__ __forceinline__ void done(const Unit&) const {}
};

__device__ __forceinline__ unsigned cvt_pk_bf16(float lo, float hi) { unsigned r; asm volatile("v_cvt_pk_bf16_f32 %0, %1, %2" : "=v"(r) : "v"(lo), "v"(hi)); return r; }
typedef float f32x2 __attribute__((ext_vector_type(2)));
__device__ __forceinline__ f32x2 gelu_pk(f32x2 v) {
    const f32x2 av = __builtin_elementwise_abs(v), d = av * 0.2316418882f + 1.0f;
    f32x2 t; t.x = __builtin_amdgcn_rcpf(d.x); t.y = __builtin_amdgcn_rcpf(d.y);
    f32x2 q = t * 0.5307027145f + (-0.7265760135f); q = q * t + 0.7107068705f; q = q * t + (-0.142248368f); q = q * t + 0.127414796f; q = q * t;
    const f32x2 s = (v * v) * (-0.72134752044f);
    f32x2 e; e.x = __builtin_amdgcn_exp2f(s.x); e.y = __builtin_amdgcn_exp2f(s.y);
    const f32x2 m = v * (q * e), r = v - m;
    f32x2 o; o.x = v.x < 0.f ? m.x : r.x; o.y = v.y < 0.f ? m.y : r.y; return o;
}

template <int ACT  > struct EpiBf16 {
    static constexpr bool PERM = true, AFTER_DRAIN = false; static_assert(ACT == 0 || ACT == 1, "EpiBf16: ACT is 0 (none) or 1 (gelu_pk)");
    bf16_t* O; int ldc; const float* bias; int split_cols; size_t split_stride; float scale0;
    __device__ __forceinline__ void operator()(const f32x4 (&acc)[2][2][4][2], const Unit& u, int wr, int wc, int fr, int fq) const {
        const int row0 = u.pm * BM + wr * 64 + fr; int colt = u.pn * BM; bf16_t* base = O;
        float sc = 1.f; if (split_cols) { const int t = colt / split_cols; base += (size_t)t * split_stride; colt -= t * split_cols; if (t == 0) sc = scale0; }
        const int col0 = colt + wc * 32 + 8 * fq, bcol0 = u.pn * BM + wc * 32 + 8 * fq;
        f32x4 bv[2][2];
#pragma unroll
        for (int bj = 0; bj < 2; ++bj)
#pragma unroll
            for (int n = 0; n < 2; ++n) bv[bj][n] = bias ? *(const f32x4*)(bias + bcol0 + bj * HALF + 4 * n) : (f32x4){0.f, 0.f, 0.f, 0.f};
#pragma unroll
        for (int ai = 0; ai < 2; ++ai)
#pragma unroll
            for (int m = 0; m < 4; ++m) { bf16_t* rowp = base + (size_t)(row0 + ai * HALF + m * 16) * ldc + col0;
#pragma unroll
                for (int bj = 0; bj < 2; ++bj) { f32x4 v0 = acc[ai][bj][m][0] + bv[bj][0], v1 = acc[ai][bj][m][1] + bv[bj][1];
                    if (ACT == 1) { f32x2 a = gelu_pk((f32x2){v0[0], v0[1]}), b = gelu_pk((f32x2){v0[2], v0[3]}), c = gelu_pk((f32x2){v1[0], v1[1]}), d = gelu_pk((f32x2){v1[2], v1[3]});
                        v0 = (f32x4){a.x, a.y, b.x, b.y}; v1 = (f32x4){c.x, c.y, d.x, d.y}; }
                    v0 = v0 * sc; v1 = v1 * sc; u32x4 w; w.x = cvt_pk_bf16(v0[0], v0[1]); w.y = cvt_pk_bf16(v0[2], v0[3]); w.z = cvt_pk_bf16(v1[0], v1[1]); w.w = cvt_pk_bf16(v1[2], v1[3]);
                    *(u32x4*)(rowp + bj * HALF) = w; } }
    }
};

template <class Epi, class Sched, bool ALIGN_EPI = false, bool SP2 = false>
__device__ __forceinline__ void gemm_phase(PG8_LAS unsigned char* lds, const Gemm g, const Sched& S, const Epi& E) {
    int tid_l = threadIdx.x; asm volatile("" : "+v"(tid_l));
    const int tid = tid_l, wid = __builtin_amdgcn_readfirstlane(tid >> 6), lane = tid & 63, wr = wid >> 2, wc = wid & 3, fr = lane & 15, fq = lane >> 4;
    const int K = g.K, nt = K / BK;
    unsigned voffA[2], voffB[2];
#pragma unroll
    for (int i = 0; i < 2; ++i) { int R, C; stage_rc(tid * 16 + i * 8192, R, C); const int Rb = Epi::PERM ? ((R & ~31) + perm32(R & 31)) : R;
        voffA[i] = (unsigned)(R * K + C) * 2u; voffB[i] = (unsigned)(Rb * K + C) * 2u; }
    const size_t kstep = (size_t)(BK * 2);
    const size_t hstep = (size_t)HALF * K * 2;
    const size_t tstep = 2 * hstep;
    const unsigned ldsw = (unsigned)wid * 1024u;
    const int aoff = lds_byte(wr * 64 + fr, fq * 8), boff = lds_byte(wc * 32 + fr, fq * 8);
#define PG8_SA(b, h) (((b) * 2 + (h)) * HTB)
#define PG8_SB(b, h) ((4 + (b) * 2 + (h)) * HTB)
#define PG8_STAGE(bufoff, gbase, voff) do { _Pragma("unroll") for (int _i = 0; _i < 2; ++_i) \
        __builtin_amdgcn_global_load_lds((const unsigned*)((const char*)(gbase) + (voff)[_i]), (PG8_LAS unsigned*)(lds + (bufoff) + ldsw + _i * 8192), 16, 0, 0); } while (0)
#define PG8_LDA(dst, b, h) do { _Pragma("unroll") for (int m = 0; m < 4; ++m) _Pragma("unroll") for (int k = 0; k < 2; ++k) dst[m][k] = *(const PG8_LAS bf16x8*)(lds + PG8_SA(b, h) + aoff + m * 2048 + k * 1024); } while (0)
#define PG8_LDB(dst, b, h) do { _Pragma("unroll") for (int n = 0; n < 2; ++n) _Pragma("unroll") for (int k = 0; k < 2; ++k) dst[n][k] = *(const PG8_LAS bf16x8*)(lds + PG8_SB(b, h) + boff + n * 2048 + k * 1024); } while (0)
#define PG8_MMA(ai, bj, At, Bt) do { __builtin_amdgcn_s_setprio(1); _Pragma("unroll") for (int m = 0; m < 4; ++m) _Pragma("unroll") for (int n = 0; n < 2; ++n) _Pragma("unroll") for (int k = 0; k < 2; ++k) \
        acc[ai][bj][m][n] = __builtin_amdgcn_mfma_f32_16x16x32_bf16(Bt[n][k], At[m][k], acc[ai][bj][m][n], 0, 0, 0); __builtin_amdgcn_s_setprio(0); } while (0)
#define PG8_WAIT_V(n) asm volatile("s_waitcnt vmcnt(" #n ")" ::: "memory")
#define PG8_WAIT_L(n) asm volatile("s_waitcnt lgkmcnt(" #n ")" ::: "memory")
#define PG8_BAR __builtin_amdgcn_s_barrier()
#define PG8_SCHED __builtin_amdgcn_sched_barrier(0)
    Unit cur, nxt; int ui = 0;
    if (!S.next(0, cur)) return;
    f32x4 acc[2][2][4][2];
#pragma unroll
    for (int a = 0; a < 2; ++a)
#pragma unroll
        for (int b = 0; b < 2; ++b)
#pragma unroll
            for (int m = 0; m < 4; ++m)
#pragma unroll
                for (int n = 0; n < 2; ++n) acc[a][b][m][n] = (f32x4){0.f, 0.f, 0.f, 0.f};
    bf16x8 At[4][2], B0[2][2], B1[2][2];
    const char* cA = (const char*)g.A + (size_t)cur.pm * tstep; const char* cB = (const char*)g.Bt + (size_t)cur.pn * tstep;
    S.a_ready(cur);
    if constexpr (SP2) {
        PG8_STAGE(PG8_SB(0, 0), cB, voffB); PG8_STAGE(PG8_SB(0, 1), cB + hstep, voffB); PG8_STAGE(PG8_SA(0, 0), cA, voffA); PG8_STAGE(PG8_SA(0, 1), cA + hstep, voffA);
        if (wr == 1) PG8_BAR;
        PG8_WAIT_V(2); PG8_BAR;
        PG8_STAGE(PG8_SB(1, 0), cB + kstep, voffB); PG8_STAGE(PG8_SA(1, 0), cA + kstep, voffA); PG8_STAGE(PG8_SB(1, 1), cB + hstep + kstep, voffB);
        PG8_WAIT_V(6); PG8_BAR;
    } else {
        PG8_STAGE(PG8_SB(0, 0), cB, voffB); PG8_STAGE(PG8_SA(0, 0), cA, voffA); PG8_STAGE(PG8_SB(0, 1), cB + hstep, voffB); PG8_STAGE(PG8_SA(0, 1), cA + hstep, voffA);
        if (wr == 1) PG8_BAR;
        PG8_WAIT_V(4); PG8_BAR;
        PG8_STAGE(PG8_SB(1, 0), cB + kstep, voffB); PG8_STAGE(PG8_SA(1, 0), cA + kstep, voffA); PG8_STAGE(PG8_SB(1, 1), cB + hstep + kstep, voffB);
        PG8_WAIT_V(6); PG8_BAR;
    }
    for (;;) {
        const bool has_next = S.next(ui + 1, nxt);
        const char* nA = has_next ? (const char*)g.A + (size_t)nxt.pm * tstep : cA; const char* nB = has_next ? (const char*)g.Bt + (size_t)nxt.pn * tstep : cB;
        for (int t = 0; t < nt; t += 2) {
            const bool last = (t == nt - 2);
            const char* a1 = cA + (size_t)(t + 1) * kstep;
            const char* a2 = last ? nA : cA + (size_t)(t + 2) * kstep; const char* b2 = last ? nB : cB + (size_t)(t + 2) * kstep;
            const char* a3 = a2 + kstep; const char* b3 = b2 + kstep;
            if (last && has_next) S.a_ready(nxt);
            if constexpr (SP2) {
            PG8_LDB(B0, 0, 0); PG8_LDB(B1, 0, 1); PG8_SCHED; PG8_LDA(At, 0, 0); PG8_STAGE(PG8_SA(1, 1), a1 + hstep, voffA);
            PG8_WAIT_V(8); PG8_WAIT_L(0); PG8_BAR; PG8_MMA(0, 0, At, B0); PG8_MMA(0, 1, At, B1); PG8_BAR; PG8_SCHED;
            PG8_LDA(At, 0, 1); PG8_STAGE(PG8_SB(0, 0), b2, voffB); PG8_STAGE(PG8_SB(0, 1), b2 + hstep, voffB); PG8_STAGE(PG8_SA(0, 0), a2, voffA);
            PG8_WAIT_V(8); PG8_WAIT_L(0); PG8_BAR; PG8_MMA(1, 0, At, B0); PG8_MMA(1, 1, At, B1); PG8_BAR; PG8_SCHED;
            PG8_LDB(B0, 1, 0); PG8_LDB(B1, 1, 1); PG8_SCHED; PG8_LDA(At, 1, 0); PG8_STAGE(PG8_SA(0, 1), a2 + hstep, voffA);
            PG8_WAIT_V(8); PG8_WAIT_L(0); PG8_BAR; PG8_MMA(0, 0, At, B0); PG8_MMA(0, 1, At, B1); PG8_BAR; PG8_SCHED;
            PG8_LDA(At, 1, 1); PG8_STAGE(PG8_SB(1, 0), b3, voffB); PG8_STAGE(PG8_SB(1, 1), b3 + hstep, voffB); PG8_STAGE(PG8_SA(1, 0), a3, voffA);
            PG8_WAIT_V(8); PG8_WAIT_L(0); PG8_BAR; PG8_MMA(1, 0, At, B0); PG8_MMA(1, 1, At, B1); PG8_BAR; PG8_SCHED;
            } else {
            PG8_LDB(B0, 0, 0); PG8_SCHED; PG8_LDA(At, 0, 0); PG8_STAGE(PG8_SA(1, 1), a1 + hstep, voffA);
            PG8_WAIT_L(8); PG8_BAR; PG8_WAIT_L(0); PG8_MMA(0, 0, At, B0); PG8_BAR; PG8_SCHED;
            PG8_LDB(B1, 0, 1); PG8_STAGE(PG8_SB(0, 0), b2, voffB);
            PG8_BAR; PG8_WAIT_L(0); PG8_MMA(0, 1, At, B1); PG8_BAR;
            PG8_LDA(At, 0, 1); PG8_STAGE(PG8_SA(0, 0), a2, voffA);
            PG8_BAR; PG8_WAIT_L(0); PG8_MMA(1, 0, At, B0); PG8_BAR; PG8_SCHED;
            PG8_STAGE(PG8_SB(0, 1), b2 + hstep, voffB);
            PG8_WAIT_V(6); PG8_BAR; PG8_MMA(1, 1, At, B1); PG8_BAR;
            PG8_LDB(B0, 1, 0); PG8_SCHED; PG8_LDA(At, 1, 0); PG8_STAGE(PG8_SA(0, 1), a2 + hstep, voffA);
            PG8_WAIT_L(8); PG8_BAR; PG8_WAIT_L(0); PG8_MMA(0, 0, At, B0); PG8_BAR; PG8_SCHED;
            PG8_LDB(B1, 1, 1); PG8_STAGE(PG8_SB(1, 0), b3, voffB);
            PG8_BAR; PG8_WAIT_L(0); PG8_MMA(0, 1, At, B1); PG8_BAR;
            PG8_LDA(At, 1, 1); PG8_STAGE(PG8_SA(1, 0), a3, voffA);
            PG8_BAR; PG8_WAIT_L(0); PG8_MMA(1, 0, At, B0); PG8_BAR; PG8_SCHED;
            PG8_STAGE(PG8_SB(1, 1), b3 + hstep, voffB);
            PG8_WAIT_V(6); PG8_BAR; PG8_MMA(1, 1, At, B1); PG8_BAR;
            }
        }
        if constexpr (ALIGN_EPI) { if (wr == 0) PG8_BAR; }
        if constexpr (!Epi::AFTER_DRAIN) { E(acc, cur, wr, wc, fr, fq); S.done(cur); }
        if (!has_next) break;
#pragma unroll
        for (int a = 0; a < 2; ++a)
#pragma unroll
            for (int b = 0; b < 2; ++b)
#pragma unroll
                for (int m = 0; m < 4; ++m)
#pragma unroll
                    for (int n = 0; n < 2; ++n) acc[a][b][m][n] = (f32x4){0.f, 0.f, 0.f, 0.f};
        cur = nxt; cA = nA; cB = nB; ++ui;
        if constexpr (ALIGN_EPI) { if (wr == 1) PG8_BAR; }
    }
    PG8_WAIT_V(0);
    if constexpr (!ALIGN_EPI) { if (wr == 0) PG8_BAR; }
    PG8_BAR;
    if constexpr (Epi::AFTER_DRAIN) { E.fused(acc, cur, wr, wc, fr, fq, lds, wid, lane); S.done(cur); }
#undef PG8_SA
#undef PG8_SB
#undef PG8_STAGE
#undef PG8_LDA
#undef PG8_LDB
#undef PG8_MMA
#undef PG8_WAIT_V
#undef PG8_WAIT_L
#undef PG8_BAR
#undef PG8_SCHED
}
}
#ifndef HD
#define HD __host__ __device__ __forceinline__
#endif
HD int tk_map(float f) { int b = __builtin_bit_cast(int, f); return b ^ ((b >> 31) & 0x7fffffff); }
HD float tk_unmap(int k) { int b = k ^ ((k >> 31) & 0x7fffffff); return __builtin_bit_cast(float, b); }
HD void tk_cx(int& a, int& b) { const int hi = a > b ? a : b, lo = a > b ? b : a; a = hi; b = lo; }
template <int N> HD void tk_sort_desc(int (&v)[N]) {
#pragma unroll
    for (int k = 2; k <= N; k <<= 1)
#pragma unroll
        for (int j = k >> 1; j > 0; j >>= 1)
#pragma unroll
            for (int i = 0; i < N; ++i) { const int l = i ^ j; if (l > i) { if ((i & k) == 0) tk_cx(v[i], v[l]); else tk_cx(v[l], v[i]); } }
}
template <int N> HD void tk_merge_top(int (&a)[N], const int (&b)[N]) {
#pragma unroll
    for (int i = 0; i < N; ++i) a[i] = a[i] > b[N - 1 - i] ? a[i] : b[N - 1 - i];
#pragma unroll
    for (int j = N >> 1; j > 0; j >>= 1)
#pragma unroll
        for (int i = 0; i < N; ++i) { const int l = i ^ j; if (l > i) tk_cx(a[i], a[l]); }
}
template <int NCH, class FP> HD void tk_stage1(FP s, int n_base, int (&best)[16]) {
#pragma unroll
    for (int c = 0; c < NCH; ++c) {
        int x[16];
#pragma unroll
        for (int e = 0; e < 16; ++e) x[e] = (tk_map(s[c * 16 + e]) & ~127) | (127 - (n_base + c * 16 + e));
        tk_sort_desc(x);
        if (c == 0) {
#pragma unroll
            for (int e = 0; e < 16; ++e) best[e] = x[e];
        } else tk_merge_top(best, x);
    }
}
template <class IP, class OI, class OG> HD void tk_stage2(int (&a)[16], int (&b)[16], IP AB, OI out_idx, OG out_g, float vscale = 1.0f) {
    float va[16], vb[16];
#pragma unroll
    for (int i = 0; i < 16; ++i) { AB[i] = a[i]; AB[16 + i] = b[i]; va[i] = tk_unmap(a[i] & ~127); vb[i] = tk_unmap(b[i] & ~127); }
    int best[16];
#pragma unroll
    for (int c = 0; c < 4; ++c) {
        int x[16];
#pragma unroll
        for (int e = 0; e < 16; ++e) x[e] = (int)0x80000000;
        int n = 0;
#pragma unroll
        for (int i = 0; i < 16; ++i)
#pragma unroll
            for (int j = 0; j < 16; ++j)
                if ((i + 1) * (j + 1) <= 16) { if (n >= 16 * c && n < 16 * c + 16) x[n - 16 * c] = (tk_map(va[i] + vb[j]) & ~255) | (255 - (i * 16 + j)); ++n; }
        tk_sort_desc(x);
        if (c == 0) {
#pragma unroll
            for (int e = 0; e < 16; ++e) best[e] = x[e];
        } else tk_merge_top(best, x);
    }
    int ka[16], kb[16];
#pragma unroll
    for (int k = 0; k < 16; ++k) { const int flat = 255 - (best[k] & 255); ka[k] = AB[flat >> 4]; kb[k] = AB[16 + (flat & 15)]; }
    float sv[16]; int ei[16]; float sum = 0.f;
#pragma unroll
    for (int k = 0; k < 16; ++k) { ei[k] = (127 - (ka[k] & 127)) * 128 + (127 - (kb[k] & 127)); sv[k] = (tk_unmap(ka[k] & ~127) + tk_unmap(kb[k] & ~127)) * vscale; }
    const float m = sv[0];
#pragma unroll
    for (int k = 0; k < 16; ++k) { sv[k] = __expf(sv[k] - m); sum += sv[k]; }
    const float inv = 1.0f / sum;
#pragma unroll
    for (int k = 0; k < 16; ++k) { out_idx[k] = ei[k]; out_g[k] = sv[k] * inv; }
}
constexpr int NWAVES = 8, NTHR = 512;
constexpr int BATCH = 2, SEQ = 8192, D = 1024, M = BATCH * SEQ, DEPTH = 4;
constexpr int NH = 16, HDIM = 64, GRIDW = 64, NROWS = 128;
constexpr float RMS_EPS = 1e-6f;
#ifndef MK_N_LAUNCHES
#define MK_N_LAUNCHES 1
#endif
#ifndef NAIVE_ATTN
#define NAIVE_ATTN 0
#endif
#ifndef NAIVE_TOPK
#define NAIVE_TOPK 0
#endif
#ifndef EXPERT_FP4
#define EXPERT_FP4 1
#endif
constexpr int ROWB = EXPERT_FP4 ? 512 : 1024;
#ifndef PROBE_GMODE
#define PROBE_GMODE 0
#endif
#ifndef PROBE_PMODE
#define PROBE_PMODE 0
#endif
#ifndef PROBE_LMASK
#define PROBE_LMASK 15
#endif
#ifndef PROBE_REP
#define PROBE_REP -1
#endif
constexpr int PH_PER_LAYER = 7, N_PHASES = 1 + DEPTH * PH_PER_LAYER;

constexpr size_t MiB = 1u << 20;
constexpr size_t WS_CTL = 0, CTL_ZERO_BYTES = 32 * 1024;
constexpr size_t WS_WQK = 2 * MiB;
constexpr size_t WS_WV = 10 * MiB;
constexpr size_t WS_WO = 14 * MiB;
constexpr size_t WS_WIN = 18 * MiB;
constexpr size_t WS_WOUT = 30 * MiB;
constexpr size_t WS_WP = 34 * MiB;
constexpr size_t WS_H = 64 * MiB;
constexpr size_t WS_HN = 128 * MiB;
constexpr size_t WS_BIG = 160 * MiB;
constexpr size_t WS_VT = 224 * MiB;
constexpr size_t WS_MIX = 256 * MiB;
constexpr size_t WS_SELI = 288 * MiB;
constexpr size_t WS_SELG = 296 * MiB;
constexpr size_t WS_UP = 320 * MiB;
constexpr size_t WS_DN = 384 * MiB;
constexpr size_t WS_SUP = 448 * MiB;
constexpr size_t WS_RSS = 450 * MiB;
constexpr size_t WS_SC = 576 * MiB;
constexpr size_t WS_END = 704 * MiB;
constexpr int CW_BAR = 4096;
static_assert((CW_BAR + 3456) * 4 <= (int)CTL_ZERO_BYTES, "barrier words inside the per-call memset");

constexpr int LDS_BYTES = 163840, MISC_OFF = LDS_BYTES - 256, PTAB_OFF = LDS_BYTES - 512;

#define LAS __attribute__((address_space(3)))
typedef unsigned short bf16;
typedef unsigned v4u __attribute__((ext_vector_type(4)));
typedef unsigned v2u __attribute__((ext_vector_type(2)));
typedef float f32x4 __attribute__((ext_vector_type(4)));
typedef short bf16x8 __attribute__((ext_vector_type(8)));
#define LDS_WAIT() asm volatile("s_waitcnt lgkmcnt(0)" ::: "memory")
#define BLOCK_BAR() do { asm volatile("s_waitcnt vmcnt(0) lgkmcnt(0)" ::: "memory"); __builtin_amdgcn_s_barrier(); asm volatile("" ::: "memory"); } while (0)
__device__ __forceinline__ unsigned f2bf(float f) { unsigned u = __builtin_bit_cast(unsigned, f); return (u + 0x7fffu + ((u >> 16) & 1u)) >> 16; }
typedef float f32x2p __attribute__((ext_vector_type(2))); typedef __bf16 bf16x2p __attribute__((ext_vector_type(2)));
__device__ __forceinline__ unsigned pk2(float lo, float hi) { const f32x2p v = {lo, hi}; return __builtin_bit_cast(unsigned, __builtin_convertvector(v, bf16x2p)); }
__device__ __forceinline__ float bflo(unsigned u) { return __builtin_bit_cast(float, u << 16); }
__device__ __forceinline__ float bfhi(unsigned u) { return __builtin_bit_cast(float, u & 0xffff0000u); }
__device__ __forceinline__ float wave_sum(float v) {
#pragma unroll
    for (int o = 1; o < 64; o <<= 1) v += __shfl_xor(v, o);
    return v;
}

#define XB_TMO      128
#define XB_XCNT(j)  (256  + 64 * (j))
#define XB_XSUB(j)  (1280 + 64 * (j))
#define XB_XGEN(j)  (2304 + 64 * (j))
#define XB_TOP      3328
#define XB_TOPGEN   3392
#define XCD_BAR_WORDS 3456
#define XB_SPIN_CAP (1u << 20)
__device__ __forceinline__ unsigned xb_ld(unsigned* p)              { return __hip_atomic_load(p, __ATOMIC_RELAXED, __HIP_MEMORY_SCOPE_AGENT); }
__device__ __forceinline__ unsigned xb_add(unsigned* p, unsigned v) { return __hip_atomic_fetch_add(p, v, __ATOMIC_RELAXED, __HIP_MEMORY_SCOPE_AGENT); }
__device__ __forceinline__ unsigned xb_xcc_id() { return (unsigned)__builtin_amdgcn_s_getreg((3 << 11) | 20) & 0xFu; }
#define XB_SPIN(cond, bar) do { unsigned _sp = 0; while (cond) { __builtin_amdgcn_s_sleep(1); \
    if ((++_sp & 255u) == 0u) { if (xb_ld(&(bar)[XB_TMO])) break; if (_sp > XB_SPIN_CAP) { atomicAdd(&(bar)[XB_TMO], 1u); break; } } } } while (0)
struct XcdBarrier { unsigned* bar; unsigned x; volatile LAS unsigned* st; };
__device__ __forceinline__ XcdBarrier xcd_barrier_post(unsigned* bar, volatile LAS unsigned* st) {
    XcdBarrier b; b.bar = bar; b.x = xb_xcc_id(); b.st = st;
    if (threadIdx.x == 0) (void)xb_add(&bar[XB_XCNT(b.x)], 1u);
    return b;
}
__device__ __forceinline__ void xcd_barrier_complete(unsigned* bar, unsigned x, unsigned& nloc, unsigned& nx) {
    const unsigned G = gridDim.x * gridDim.y * gridDim.z;
    unsigned sum, cnt, mine, sp = 0u;
    for (;;) {
        sum = 0u; cnt = 0u; mine = 0u;
#pragma unroll
        for (unsigned j = 0; j < 16; ++j) { const unsigned c = xb_ld(&bar[XB_XCNT(j)]); sum += c; cnt += (c > 0u) ? 1u : 0u; mine = (j == x) ? c : mine; }
        if (sum == G) break;
        __builtin_amdgcn_s_sleep(1);
        if ((++sp & 255u) == 0u) { if (xb_ld(&bar[XB_TMO])) break; if (sp > XB_SPIN_CAP) { atomicAdd(&bar[XB_TMO], 1u); break; } }
    }
    nloc = mine > 0u ? mine : 1u; nx = cnt > 0u ? cnt : 1u;
}
__device__ __forceinline__ void xcd_barrier(const XcdBarrier& b) {
    asm volatile("s_waitcnt vmcnt(0)" ::: "memory");
    __syncthreads();
    if (threadIdx.x == 0) {
        unsigned* bar = b.bar;
        __builtin_amdgcn_s_waitcnt(0);
        unsigned nloc = b.st[0], nx = b.st[1];
        if (nloc == 0u) { xcd_barrier_complete(bar, b.x, nloc, nx); b.st[0] = nloc; b.st[1] = nx; }
        const unsigned old = xb_add(&bar[XB_XSUB(b.x)], 1u);
        const unsigned gen = old / nloc;
        if (old + 1u == (gen + 1u) * nloc) {
            __builtin_amdgcn_fence(__ATOMIC_RELEASE, "agent");
            asm volatile("s_waitcnt vmcnt(0)" ::: "memory");
            const unsigned og = xb_add(&bar[XB_TOP], 1u);
            const unsigned tg = og / nx;
            if (og + 1u == (tg + 1u) * nx) xb_add(&bar[XB_TOPGEN], 1u);
            else XB_SPIN(xb_ld(&bar[XB_TOPGEN]) == tg, bar);
            __builtin_amdgcn_fence(__ATOMIC_ACQUIRE, "agent");
            xb_add(&bar[XB_XGEN(b.x)], 1u);
            asm volatile("s_waitcnt vmcnt(0)" ::: "memory");
        } else {
            XB_SPIN(xb_ld(&bar[XB_XGEN(b.x)]) == gen, bar);
            __builtin_amdgcn_fence(__ATOMIC_ACQUIRE, "agent");
            asm volatile("s_waitcnt vmcnt(0)" ::: "memory");
        }
    }
    __syncthreads();
}

struct Frame {
    LAS unsigned char* lds;
    int tid, lane, wave, vcu, G;
    unsigned char* ws;
    __device__ __forceinline__ const float* in(int i) const {
        const volatile LAS unsigned* t = (const volatile LAS unsigned*)(lds + PTAB_OFF);
        const unsigned lo = __builtin_amdgcn_readfirstlane(t[2 * i]), hi = __builtin_amdgcn_readfirstlane(t[2 * i + 1]);
        return (const float*)(const __attribute__((address_space(1))) float*)(((unsigned long long)hi << 32) | lo);
    }
    __device__ __forceinline__ float* out() const { return (float*)in(14); }
};

template <bool FIRST> struct EpiRes {
    static constexpr bool PERM = false, AFTER_DRAIN = false;
    const void* hin; bf16* h; float* rss;
    __device__ __forceinline__ void operator()(const pg8::f32x4 (&acc)[2][2][4][2], const pg8::Unit& u, int wr, int wc, int fr, int fq) const {
        const int col0 = u.pn * 256 + wc * 32 + 4 * fq;
#pragma unroll
        for (int ai = 0; ai < 2; ++ai)
#pragma unroll
            for (int m = 0; m < 4; ++m) { const int row = u.pm * 256 + ai * 128 + wr * 64 + m * 16 + fr; bf16* rowp = h + (size_t)row * D + col0;
                float ss = 0.f;
#pragma unroll
                for (int bj = 0; bj < 2; ++bj)
#pragma unroll
                    for (int n = 0; n < 2; ++n) { f32x4 v;
                        if (FIRST) v = *(const f32x4*)((const float*)hin + (size_t)row * D + col0 + bj * 128 + n * 16);
                        else { const v2u hw = *(const v2u*)((const bf16*)hin + (size_t)row * D + col0 + bj * 128 + n * 16); v = (f32x4){bflo(hw.x), bfhi(hw.x), bflo(hw.y), bfhi(hw.y)}; }
                        v += acc[ai][bj][m][n];
                        ss += (v.x * v.x + v.y * v.y) + (v.z * v.z + v.w * v.w);
                        v2u w; w.x = pk2(v.x, v.y); w.y = pk2(v.z, v.w); *(v2u*)(rowp + bj * 128 + n * 16) = w; }
                ss += __shfl_xor(ss, 16); ss += __shfl_xor(ss, 32);
                if (fq == 0) rss[(size_t)row * 16 + u.pn * 4 + wc] = ss; }
    }
};
struct EpiConvIn {
    static constexpr bool PERM = true, AFTER_DRAIN = false;
    bf16* U; bf16* GB;
    __device__ __forceinline__ void operator()(const pg8::f32x4 (&acc)[2][2][4][2], const pg8::Unit& u, int wr, int wc, int fr, int fq) const {
        const int row0 = u.pm * 256 + wr * 64 + fr;
        if (u.pn < 8) {
            const int ch0 = u.pn * 128 + wc * 32 + 8 * fq;
#pragma unroll
            for (int ai = 0; ai < 2; ++ai)
#pragma unroll
                for (int m = 0; m < 4; ++m) { const f32x4 p0 = acc[ai][0][m][0] * acc[ai][1][m][0], p1 = acc[ai][0][m][1] * acc[ai][1][m][1];
                    v4u w; w.x = pk2(p0[0], p0[1]); w.y = pk2(p0[2], p0[3]); w.z = pk2(p1[0], p1[1]); w.w = pk2(p1[2], p1[3]);
                    *(v4u*)(U + (size_t)(row0 + ai * 128 + m * 16) * D + ch0) = w; }
        } else {
            const int col0 = (u.pn - 8) * 256 + wc * 32 + 8 * fq;
#pragma unroll
            for (int ai = 0; ai < 2; ++ai)
#pragma unroll
                for (int m = 0; m < 4; ++m)
#pragma unroll
                    for (int bj = 0; bj < 2; ++bj) { const f32x4 v0 = acc[ai][bj][m][0], v1 = acc[ai][bj][m][1];
                        v4u w; w.x = pk2(v0[0], v0[1]); w.y = pk2(v0[2], v0[3]); w.z = pk2(v1[0], v1[1]); w.w = pk2(v1[2], v1[3]);
                        *(v4u*)(GB + (size_t)(row0 + ai * 128 + m * 16) * D + col0 + bj * 128) = w; }
        }
    }
};
struct EpiF32 {
    static constexpr bool PERM = false, AFTER_DRAIN = false;
    float* O; int ldc;
    __device__ __forceinline__ void operator()(const pg8::f32x4 (&acc)[2][2][4][2], const pg8::Unit& u, int wr, int wc, int fr, int fq) const {
        const int col0 = u.pn * 256 + wc * 32 + 4 * fq;
#pragma unroll
        for (int ai = 0; ai < 2; ++ai)
#pragma unroll
            for (int m = 0; m < 4; ++m) { float* rowp = O + (size_t)(u.pm * 256 + ai * 128 + wr * 64 + m * 16 + fr) * ldc + col0;
#pragma unroll
                for (int bj = 0; bj < 2; ++bj)
#pragma unroll
                    for (int n = 0; n < 2; ++n) *(f32x4*)(rowp + bj * 128 + n * 16) = acc[ai][bj][m][n]; }
    }
};
struct EpiTopK {
    static constexpr bool PERM = false, AFTER_DRAIN = true;
    int* seli; float* selg; const float* rss;
    __device__ __forceinline__ void operator()(const pg8::f32x4 (&)[2][2][4][2], const pg8::Unit&, int, int, int, int) const {}
    __device__ __forceinline__ void fused(pg8::f32x4 (&acc)[2][2][4][2], const pg8::Unit& u, int wr, int wc, int fr, int fq, LAS unsigned char* lds, int wid, int lane) const {
        LAS float* S = (LAS float*)lds;
        LAS int* L = (LAS int*)lds;
        const int tid = wid * 64 + lane;
#pragma unroll 1
        for (int ai = 0; ai < 2; ++ai) {
#pragma unroll
            for (int m = 0; m < 4; ++m)
#pragma unroll
                for (int bj = 0; bj < 2; ++bj)
#pragma unroll
                    for (int n = 0; n < 2; ++n) {
                        const int row = wr * 64 + m * 16 + fr, col = bj * 128 + wc * 32 + n * 16 + 4 * fq;
                        *(LAS f32x4*)(S + row * 260 + col) = ai == 0 ? acc[0][bj][m][n] : acc[1][bj][m][n];
                    }
            BLOCK_BAR();
            const int row = tid & 127, q = tid >> 7;
            int best[16];
            {
                const LAS f32x4* sp = (const LAS f32x4*)(S + row * 260 + q * 64);
#pragma unroll
                for (int c = 0; c < 4; ++c) {
                    int x[16];
#pragma unroll
                    for (int e4 = 0; e4 < 4; ++e4) { const f32x4 v = sp[c * 4 + e4];
#pragma unroll
                        for (int e = 0; e < 4; ++e) x[e4 * 4 + e] = (tk_map(v[e]) & ~127) | (127 - ((q & 1) * 64 + c * 16 + e4 * 4 + e)); }
                    tk_sort_desc(x);
                    if (c == 0) {
#pragma unroll
                        for (int e = 0; e < 16; ++e) best[e] = x[e];
                    } else tk_merge_top(best, x);
                }
            }
            BLOCK_BAR();
#pragma unroll
            for (int e4 = 0; e4 < 4; ++e4) *(LAS v4u*)(L + row * 68 + q * 16 + e4 * 4) = (v4u){(unsigned)best[e4 * 4], (unsigned)best[e4 * 4 + 1], (unsigned)best[e4 * 4 + 2], (unsigned)best[e4 * 4 + 3]};
            BLOCK_BAR();
            if (tid < 128) {
                int a[16], b[16], t[16];
                LAS int* Lr = L + tid * 68;
#pragma unroll
                for (int e4 = 0; e4 < 4; ++e4) { const v4u va = *(LAS v4u*)(Lr + e4 * 4), vt = *(LAS v4u*)(Lr + 16 + e4 * 4);
#pragma unroll
                    for (int e = 0; e < 4; ++e) { a[e4 * 4 + e] = (int)va[e]; t[e4 * 4 + e] = (int)vt[e]; } }
                tk_merge_top(a, t);
#pragma unroll
                for (int e4 = 0; e4 < 4; ++e4) { const v4u vb = *(LAS v4u*)(Lr + 32 + e4 * 4), vt = *(LAS v4u*)(Lr + 48 + e4 * 4);
#pragma unroll
                    for (int e = 0; e < 4; ++e) { b[e4 * 4 + e] = (int)vb[e]; t[e4 * 4 + e] = (int)vt[e]; } }
                tk_merge_top(b, t);
                const int trow = u.pm * 256 + ai * 128 + tid;
                const f32x4 q0 = *(const f32x4*)(rss + (size_t)trow * 16), q1 = *(const f32x4*)(rss + (size_t)trow * 16 + 4), q2 = *(const f32x4*)(rss + (size_t)trow * 16 + 8), q3 = *(const f32x4*)(rss + (size_t)trow * 16 + 12);
                const float ssq = (((q0.x + q0.y) + (q0.z + q0.w)) + ((q1.x + q1.y) + (q1.z + q1.w))) + (((q2.x + q2.y) + (q2.z + q2.w)) + ((q3.x + q3.y) + (q3.z + q3.w)));
                const float rstd = 1.0f / sqrtf(ssq * (1.f / D) + RMS_EPS);
                const size_t o = ((size_t)trow * 8 + u.pn) * 16;
                tk_stage2(a, b, Lr, (__attribute__((address_space(1))) int*)(seli + o), (__attribute__((address_space(1))) float*)(selg + o), rstd);
            }
            BLOCK_BAR();
        }
    }
};
struct OneUnit {
    pg8::Unit u;
    __device__ __forceinline__ bool next(int i, pg8::Unit& o) const { if (i != 0) return false; o = u; return true; }
    __device__ __forceinline__ void a_ready(const pg8::Unit&) const {}
    __device__ __forceinline__ void done(const pg8::Unit&) const {}
};

__device__ __forceinline__ void p0_transpose_item(const float* W, int ldw, int ncols, bf16* WT, float scale, LAS float* scr, int item, int lane) {
    const int nblk = ncols / 64, kb = item / nblk, nb = item % nblk, k0 = 64 * kb, n0 = 64 * nb;
    f32x4 v[16];
#pragma unroll
    for (int i = 0; i < 16; ++i) v[i] = *(const f32x4*)(W + (size_t)(k0 + 4 * i + (lane >> 4)) * ldw + n0 + 4 * (lane & 15));
#pragma unroll
    for (int i = 0; i < 16; ++i) { LAS float* p = scr + (4 * i + (lane >> 4)) * 65 + 4 * (lane & 15); p[0] = v[i].x * scale; p[1] = v[i].y * scale; p[2] = v[i].z * scale; p[3] = v[i].w * scale; }
    LDS_WAIT(); asm volatile("" ::: "memory");
    const int c = lane & 7;
#pragma unroll
    for (int j = 0; j < 8; ++j) { const int n = (lane >> 3) + 8 * j; const LAS float* s = scr + (8 * c) * 65 + n;
        v4u o; o.x = pk2(s[0 * 65], s[1 * 65]); o.y = pk2(s[2 * 65], s[3 * 65]); o.z = pk2(s[4 * 65], s[5 * 65]); o.w = pk2(s[6 * 65], s[7 * 65]);
        *(v4u*)(WT + (size_t)(n0 + n) * 1024 + k0 + 8 * c) = o; }
    LDS_WAIT(); asm volatile("" ::: "memory");
}
__device__ __forceinline__ void rms_row_to_bf16(const float* xrow, const float* gain, bf16* orow, float* hcopy, int lane) {
    const f32x4* xr = (const f32x4*)xrow + lane; const f32x4* gr = (const f32x4*)gain + lane;
    f32x4 v[4]; float s = 0.f;
#pragma unroll
    for (int j = 0; j < 4; ++j) { v[j] = xr[64 * j]; s += (v[j].x * v[j].x + v[j].y * v[j].y) + (v[j].z * v[j].z + v[j].w * v[j].w); }
    if (hcopy) {
#pragma unroll
        for (int j = 0; j < 4; ++j) ((f32x4*)hcopy + lane)[64 * j] = v[j];
    }
    const float rstd = 1.0f / sqrtf(wave_sum(s) * (1.f / D) + RMS_EPS);
    unsigned long long* o8 = (unsigned long long*)orow + lane;
#pragma unroll
    for (int j = 0; j < 4; ++j) { const f32x4 g = gr[64 * j]; const f32x4 y = v[j] * rstd * g;
        o8[64 * j] = (unsigned long long)pk2(y.x, y.y) | ((unsigned long long)pk2(y.z, y.w) << 32); }
}
__device__ __forceinline__ void p0_prologue(Frame& F, bool dry) {
    if (!(dry && PROBE_PMODE == 1)) {
        LAS float* KL = (LAS float*)F.lds;
        LAS float* WL = (LAS float*)(F.lds + 128 * 132 * 4);
        const float* in10 = F.in(10); const float* in11 = F.in(11); const float* in2 = F.in(2);
        f32x4 kreg[8], wreg[4];
#define FOLD_LOAD(it_) do { const int l_ = (it_) >> 8, hp_ = ((it_) >> 4) & 15, k0_ = ((it_) & 15) * 64; \
            const float* kg_ = in11 + (size_t)(l_ * 16 + hp_) * 128 * 128; const float* wg_ = in10 + (size_t)l_ * 1024 * 2048 + (size_t)k0_ * 2048 + hp_ * 128; \
            _Pragma("unroll") for (int i = 0; i < 8; ++i) kreg[i] = *(const f32x4*)(kg_ + 4 * (F.tid + 512 * i)); \
            _Pragma("unroll") for (int i = 0; i < 4; ++i) { const int e = 4 * (F.tid + 512 * i); wreg[i] = *(const f32x4*)(wg_ + (size_t)(e >> 7) * 2048 + (e & 127)); } } while (0)
        if (F.vcu < DEPTH * 16 * 16) FOLD_LOAD(F.vcu);
        for (int it = F.vcu; it < DEPTH * 16 * 16; it += F.G) {
            const int l = it >> 8, hp = (it >> 4) & 15, k0 = (it & 15) * 64;
#pragma unroll
            for (int i = 0; i < 8; ++i) { const int e = 4 * (F.tid + 512 * i), n = e >> 7, d = e & 127; *(LAS f32x4*)(KL + n * 132 + d) = kreg[i]; }
#pragma unroll
            for (int i = 0; i < 4; ++i) { const int e = 4 * (F.tid + 512 * i), kk = e >> 7, d = e & 127; *(LAS f32x4*)(WL + kk * 132 + d) = wreg[i]; }
            if (it + F.G < DEPTH * 16 * 16) FOLD_LOAD(it + F.G);
            BLOCK_BAR();
            {
                const int i16 = F.lane & 15, g4 = F.lane >> 4, nt = F.wave;
                f32x4 facc[4];
#pragma unroll
                for (int mt = 0; mt < 4; ++mt) facc[mt] = (f32x4){0.f, 0.f, 0.f, 0.f};
#pragma unroll 2
                for (int s8 = 0; s8 < 8; ++s8) {
                    const f32x4 bq = *(const LAS f32x4*)(KL + (nt * 16 + i16) * 132 + 16 * s8 + 4 * g4);
                    f32x4 aq[4];
#pragma unroll
                    for (int mt = 0; mt < 4; ++mt) aq[mt] = *(const LAS f32x4*)(WL + (mt * 16 + i16) * 132 + 16 * s8 + 4 * g4);
#pragma unroll
                    for (int t = 0; t < 4; ++t)
#pragma unroll
                        for (int mt = 0; mt < 4; ++mt) facc[mt] = __builtin_amdgcn_mfma_f32_16x16x4f32(aq[mt][t], bq[t], facc[mt], 0, 0, 0);
                }
                bf16* o = (bf16*)(F.ws + WS_WP) + (size_t)l * 2048 * 1024 + (size_t)(hp * 128 + nt * 16 + i16) * 1024 + k0 + 4 * g4;
#pragma unroll
                for (int mt = 0; mt < 4; ++mt) { const f32x4 gf = *(const f32x4*)(in2 + (size_t)l * D + k0 + mt * 16 + 4 * g4); v2u w; w.x = pk2(facc[mt][0] * gf.x, facc[mt][1] * gf.y); w.y = pk2(facc[mt][2] * gf.z, facc[mt][3] * gf.w); *(v2u*)(o + mt * 16) = w; }
            }
            BLOCK_BAR();
        }
#undef FOLD_LOAD
    }
    LAS float* scr = (LAS float*)(F.lds + F.wave * 16640);
    const int gw = F.vcu * NWAVES + F.wave, NGW = F.G * NWAVES;
    constexpr int I_SQ = 16 * 16, I_IN = 16 * 48, PER_J = 3 * I_SQ + I_SQ + I_IN + I_SQ;
    if (!(dry && PROBE_PMODE == 2)) for (int it = gw; it < 2 * PER_J; it += NGW) {
        const int j = it / PER_J; int r = it % PER_J;
        const float* wqkv = F.in(4) + (size_t)j * 1024 * 3072;
        if (r < I_SQ) { p0_transpose_item(wqkv, 3072, 1024, (bf16*)(F.ws + WS_WQK) + (size_t)j * 2048 * 1024, 0.125f, scr, r, F.lane); continue; } r -= I_SQ;
        if (r < I_SQ) { p0_transpose_item(wqkv + 1024, 3072, 1024, (bf16*)(F.ws + WS_WQK) + (size_t)j * 2048 * 1024 + (size_t)1024 * 1024, 1.f, scr, r, F.lane); continue; } r -= I_SQ;
        if (r < I_SQ) { p0_transpose_item(wqkv + 2048, 3072, 1024, (bf16*)(F.ws + WS_WV) + (size_t)j * 1024 * 1024, 1.f, scr, r, F.lane); continue; } r -= I_SQ;
        if (r < I_SQ) { p0_transpose_item(F.in(5) + (size_t)j * 1024 * 1024, 1024, 1024, (bf16*)(F.ws + WS_WO) + (size_t)j * 1024 * 1024, 1.f, scr, r, F.lane); continue; } r -= I_SQ;
        if (r < I_IN) {
            const float* win = F.in(7) + (size_t)j * 1024 * 3072; bf16* wt = (bf16*)(F.ws + WS_WIN) + (size_t)j * 3072 * 1024;
            if (r < 512) { const int blk = r >> 5, pn = blk >> 1, which = blk & 1; p0_transpose_item(win + (which ? 2048 : 1024) + 128 * pn, 3072, 128, wt + (size_t)(256 * pn + 128 * which) * 1024, 1.f, scr, r & 31, F.lane); }
            else p0_transpose_item(win, 3072, 1024, wt + (size_t)2048 * 1024, 1.f, scr, r - 512, F.lane);
            continue; } r -= I_IN;
        p0_transpose_item(F.in(9) + (size_t)j * 1024 * 1024, 1024, 1024, (bf16*)(F.ws + WS_WOUT) + (size_t)j * 1024 * 1024, 1.f, scr, r, F.lane);
    }
    if (!(dry && PROBE_PMODE == 3)) {
        constexpr int NROW = DEPTH * 16384;
        const float* in12 = F.in(12); const float* in13 = F.in(13);
#define XC_LOAD(v, r0_) do { const int tb_ = (r0_) >= NROW ? 1 : 0, rr_ = (r0_) - tb_ * NROW; const float* src_ = (tb_ ? in13 : in12) + (size_t)rr_ * 1024 + 4 * F.lane; \
            _Pragma("unroll") for (int u = 0; u < 4; ++u) _Pragma("unroll") for (int i = 0; i < 4; ++i) v[u][i] = *(const f32x4*)(src_ + (size_t)u * 1024 + 256 * i); } while (0)
#if EXPERT_FP4
#define XC_PACK(v, u, q, dstp) do { v2u w_; _Pragma("unroll") for (int jj = 0; jj < 2; ++jj) { unsigned t_ = 0u; \
                    t_ = __builtin_amdgcn_cvt_scalef32_pk_fp4_f32(t_, v[u][2 * jj].x * q, v[u][2 * jj].y * q, 1.0f, 0); t_ = __builtin_amdgcn_cvt_scalef32_pk_fp4_f32(t_, v[u][2 * jj].z * q, v[u][2 * jj].w * q, 1.0f, 1); \
                    t_ = __builtin_amdgcn_cvt_scalef32_pk_fp4_f32(t_, v[u][2 * jj + 1].x * q, v[u][2 * jj + 1].y * q, 1.0f, 2); t_ = __builtin_amdgcn_cvt_scalef32_pk_fp4_f32(t_, v[u][2 * jj + 1].z * q, v[u][2 * jj + 1].w * q, 1.0f, 3); w_[jj] = t_; } \
                *(v2u*)(dstp) = w_; } while (0)
        constexpr float QMAX = 6.0f;
#else
#define XC_PACK(v, u, q, dstp) do { v4u w_; _Pragma("unroll") for (int i = 0; i < 4; ++i) { unsigned t_ = 0u; t_ = __builtin_amdgcn_cvt_pk_fp8_f32(v[u][i].x * q, v[u][i].y * q, t_, false); t_ = __builtin_amdgcn_cvt_pk_fp8_f32(v[u][i].z * q, v[u][i].w * q, t_, true); w_[i] = t_; } \
                *(v4u*)(dstp) = w_; } while (0)
        constexpr float QMAX = 256.0f;
#endif
#define XC_I4(x_) ((unsigned)__float2int_rn(x_) & 15u)
#define XC_PACK_I4(v, u, q, dstp) do { v2u w_; _Pragma("unroll") for (int jj = 0; jj < 2; ++jj) { const f32x4 a_ = v[u][2 * jj] * q, b_ = v[u][2 * jj + 1] * q; \
                    w_[jj] = XC_I4(a_.x) | (XC_I4(a_.y) << 4) | (XC_I4(a_.z) << 8) | (XC_I4(a_.w) << 12) | (XC_I4(b_.x) << 16) | (XC_I4(b_.y) << 20) | (XC_I4(b_.z) << 24) | (XC_I4(b_.w) << 28); } \
                *(v2u*)(dstp) = w_; } while (0)
#define XC_CONV(v, r0_) do { const int tb_ = (r0_) >= NROW ? 1 : 0, rr_ = (r0_) - tb_ * NROW; \
            unsigned char* dst_ = F.ws + (tb_ ? WS_DN : WS_UP) + (size_t)rr_ * ROWB + (ROWB / 64) * F.lane; float* sc_ = (float*)(F.ws + WS_SUP) + 2 * (size_t)rr_ + tb_; \
            _Pragma("unroll") for (int u = 0; u < 4; ++u) { float mx = 0.f; \
                _Pragma("unroll") for (int i = 0; i < 4; ++i) mx = fmaxf(fmaxf(mx, fmaxf(fabsf(v[u][i].x), fabsf(v[u][i].y))), fmaxf(fabsf(v[u][i].z), fabsf(v[u][i].w))); \
                _Pragma("unroll") for (int o = 1; o < 64; o <<= 1) mx = fmaxf(mx, __shfl_xor(mx, o)); \
                if (tb_) { const float q = mx > 0.f ? 7.0f / mx : 1.0f; XC_PACK_I4(v, u, q, dst_ + (size_t)u * ROWB); if (F.lane == 0) sc_[2 * u] = mx > 0.f ? mx * (1.0f / 7.0f) : 1.0f; } \
                else { const float q = mx > 0.f ? QMAX / mx : 1.0f; XC_PACK(v, u, q, dst_ + (size_t)u * ROWB); if (F.lane == 0) sc_[2 * u] = mx > 0.f ? mx * (1.0f / QMAX) : 1.0f; } } } while (0)
        const int stepr = NGW * 4;
        f32x4 va[4][4], vb[4][4];
        int r0 = gw * 4;
        if (r0 < 2 * NROW) XC_LOAD(va, r0);
#pragma unroll 1
        for (; r0 < 2 * NROW; r0 += 2 * stepr) {
            if (r0 + stepr < 2 * NROW) XC_LOAD(vb, r0 + stepr);
            XC_CONV(va, r0);
            if (r0 + 2 * stepr < 2 * NROW) XC_LOAD(va, r0 + 2 * stepr);
            if (r0 + stepr < 2 * NROW) XC_CONV(vb, r0 + stepr);
        }
#undef XC_LOAD
#undef XC_PACK
#undef XC_PACK_I4
#undef XC_I4
#undef XC_CONV
    }
    if (!(dry && PROBE_PMODE == 4)) {
        const float* x0 = F.in(0); const f32x4* gr = (const f32x4*)F.in(1) + F.lane;
        f32x4 gq[4];
#pragma unroll
        for (int j = 0; j < 4; ++j) gq[j] = gr[64 * j];
#pragma unroll 1
        for (int m0 = gw; m0 < M; m0 += 4 * NGW) {
            f32x4 v[4][4];
#pragma unroll
            for (int u = 0; u < 4; ++u) { const int m = m0 + u * NGW; if (m < M) {
#pragma unroll
                for (int j = 0; j < 4; ++j) v[u][j] = ((const f32x4*)(x0 + (size_t)m * D) + F.lane)[64 * j]; } }
#pragma unroll
            for (int u = 0; u < 4; ++u) { const int m = m0 + u * NGW; if (m < M) {
                float sq = 0.f;
#pragma unroll
                for (int j = 0; j < 4; ++j) { sq += (v[u][j].x * v[u][j].x + v[u][j].y * v[u][j].y) + (v[u][j].z * v[u][j].z + v[u][j].w * v[u][j].w); }
                const float rstd = 1.0f / sqrtf(wave_sum(sq) * (1.f / D) + RMS_EPS);
                unsigned long long* o8 = (unsigned long long*)((bf16*)(F.ws + WS_HN) + (size_t)m * D) + F.lane;
#pragma unroll
                for (int j = 0; j < 4; ++j) { const f32x4 y = v[u][j] * rstd * gq[j]; o8[64 * j] = (unsigned long long)pk2(y.x, y.y) | ((unsigned long long)pk2(y.z, y.w) << 32); } } }
        }
    }
}

__device__ __forceinline__ void conv_phase(Frame& F, int j) {
    const bf16* U = (const bf16*)(F.ws + WS_BIG); const bf16* GB = (const bf16*)(F.ws + WS_BIG + 32 * MiB); bf16* mix = (bf16*)(F.ws + WS_MIX);
    const float* wc = F.in(8) + (size_t)j * 3 * 1024;
    for (int idx = F.vcu * NTHR + F.tid; idx < M * 128; idx += F.G * NTHR) {
        const int t = idx >> 7, c8 = (idx & 127) * 8, s = t & (SEQ - 1);
        const v4u gb = *(const v4u*)(GB + (size_t)t * D + c8);
        float conv[8];
#pragma unroll
        for (int e = 0; e < 8; ++e) conv[e] = 0.f;
#pragma unroll
        for (int dj = -1; dj <= 1; ++dj) {
            if (s + dj >= 0 && s + dj < SEQ) {
                const v4u uu = *(const v4u*)(U + (size_t)(t + dj) * D + c8);
                const f32x4 w0 = *(const f32x4*)(wc + (dj + 1) * 1024 + c8), w1 = *(const f32x4*)(wc + (dj + 1) * 1024 + c8 + 4);
#pragma unroll
                for (int e2 = 0; e2 < 4; ++e2) {
                    const float wl = e2 < 2 ? w0[2 * e2] : w1[2 * e2 - 4], wh = e2 < 2 ? w0[2 * e2 + 1] : w1[2 * e2 - 3];
                    conv[2 * e2] += wl * bflo(uu[e2]); conv[2 * e2 + 1] += wh * bfhi(uu[e2]);
                }
            }
        }
        v4u o;
#pragma unroll
        for (int e2 = 0; e2 < 4; ++e2) o[e2] = pk2(bflo(gb[e2]) * conv[2 * e2], bfhi(gb[e2]) * conv[2 * e2 + 1]);
        *(v4u*)(mix + (size_t)t * 1024 + c8) = o;
    }
}

constexpr int AT_KSTR = 144, AT_VSTR = 1168, AT_KOFF = 0, AT_VOFF = 576 * AT_KSTR, AT_BOFF = AT_VOFF + 64 * AT_VSTR;
static_assert(AT_BOFF + 1860 <= PTAB_OFF, "attention LDS map");
__device__ __forceinline__ void attn_phase(Frame& F, int j) {
    const bf16* QK = (const bf16*)(F.ws + WS_BIG); const bf16* VT = (const bf16*)(F.ws + WS_VT); bf16* mix = (bf16*)(F.ws + WS_MIX);
    const float* biasl = F.in(6) + (size_t)j * NH * 15 * 31;
    const int lane = F.lane, q = lane & 15, g = lane >> 4, tid = F.tid;
    LAS unsigned char* KL = F.lds + AT_KOFF; LAS unsigned char* VL = F.lds + AT_VOFF; LAS float* btab = (LAS float*)(F.lds + AT_BOFF);
    v4u kreg[9], vreg[9];
    int cur_hh = -1;
#define AT_DECODE(it, b_, hh_, r0_, R0_) const int hh_ = (it) & 15, rp_##it = ((it) >> 4) & 63, b_ = (it) >> 10, r0_ = 2 * rp_##it; int R0_ = r0_ - 4; R0_ = R0_ < 0 ? 0 : (R0_ > NROWS - 8 ? NROWS - 8 : R0_);
#define AT_PREFETCH(it) do { AT_DECODE(it, pb, phh, pr0, pR0) \
        _Pragma("unroll") for (int i = 0; i < 9; ++i) { const int c = tid + 512 * i; \
            { const int key = c >> 3, ch = c & 7; int row = pR0 + (key >> 6); row = row > NROWS - 1 ? NROWS - 1 : row; \
              kreg[i] = *(const v4u*)(QK + ((size_t)pb * SEQ + row * 64 + (key & 63)) * 2048 + 1024 + phh * 64 + ch * 8); } \
            { const int d = c / 72, kch = c - d * 72; vreg[i] = *(const v4u*)(VT + (size_t)(phh * 64 + d) * M + (size_t)pb * SEQ + pR0 * 64 + kch * 8); } } } while (0)
    int it = F.vcu;
    if (it < 2048) AT_PREFETCH(it);
    for (; it < 2048; it += F.G) {
        AT_DECODE(it, b, hh, r0, R0)
        BLOCK_BAR();
#pragma unroll
        for (int i = 0; i < 9; ++i) { const int c = tid + 512 * i;
            *(LAS v4u*)(KL + (c >> 3) * AT_KSTR + (c & 7) * 16) = kreg[i];
            const int d = c / 72, kch = c - d * 72; *(LAS v4u*)(VL + d * AT_VSTR + kch * 16) = vreg[i]; }
        if (hh != cur_hh) { if (tid < 465) btab[tid] = biasl[(size_t)hh * 465 + tid]; cur_hh = hh; }
        BLOCK_BAR();
        const int r = r0 + (F.wave >> 2), jb = F.wave & 3;
        int rs = r - 4; rs = rs < 0 ? 0 : (rs > NROWS - 8 ? NROWS - 8 : rs);
        const int lr0 = rs - R0;
        int bs = 16 * jb - 8; bs = bs < 0 ? 0 : (bs > 32 ? 32 : bs);
        const int qc = 16 * jb + q; int wst = qc - 8; wst = wst < 0 ? 0 : (wst > 48 ? 48 : wst);
        const size_t tokq = (size_t)b * SEQ + r * 64 + qc;
        bf16x8 qf[2];
#pragma unroll
        for (int ks = 0; ks < 2; ++ks) qf[ks] = *(const bf16x8*)(QK + tokq * 2048 + hh * 64 + ks * 32 + 8 * g);
        f32x4 S[8][2];
        const int kcl_a = 8 * (q >> 2) + (q & 3);
#pragma unroll
        for (int wr = 0; wr < 8; ++wr)
#pragma unroll
            for (int T = 0; T < 2; ++T) {
                const LAS unsigned char* kp = KL + ((lr0 + wr) * 64 + bs + kcl_a + 4 * T) * AT_KSTR + 16 * g;
                const bf16x8 k0 = *(const LAS bf16x8*)kp, k1 = *(const LAS bf16x8*)(kp + 64);
                f32x4 c = (f32x4){0.f, 0.f, 0.f, 0.f};
                c = __builtin_amdgcn_mfma_f32_16x16x32_bf16(k0, qf[0], c, 0, 0, 0);
                c = __builtin_amdgcn_mfma_f32_16x16x32_bf16(k1, qf[1], c, 0, 0, 0);
                S[wr][T] = c;
            }
        float mx = -3.0e38f;
#pragma unroll
        for (int wr = 0; wr < 8; ++wr) {
            const LAS float* brow = btab + (rs + wr - r + 7) * 31;
#pragma unroll
            for (int T = 0; T < 2; ++T)
#pragma unroll
                for (int i = 0; i < 4; ++i) {
                    const int kc = bs + 8 * g + 4 * T + i;
                    int co = kc - qc + 15; co = co < 0 ? 0 : (co > 30 ? 30 : co);
                    const bool valid = (kc >= wst) && (kc < wst + 16);
                    const float v = valid ? S[wr][T][i] + brow[co] : -1e30f;
                    S[wr][T][i] = v; mx = fmaxf(mx, v);
                }
        }
        mx = fmaxf(mx, __shfl_xor(mx, 16)); mx = fmaxf(mx, __shfl_xor(mx, 32));
        float sum = 0.f;
        bf16x8 pf[8];
#pragma unroll
        for (int wr = 0; wr < 8; ++wr) {
            float p[8];
#pragma unroll
            for (int T = 0; T < 2; ++T)
#pragma unroll
                for (int i = 0; i < 4; ++i) { p[4 * T + i] = __expf(S[wr][T][i] - mx); sum += p[4 * T + i]; }
            v4u w; w.x = pk2(p[0], p[1]); w.y = pk2(p[2], p[3]); w.z = pk2(p[4], p[5]); w.w = pk2(p[6], p[7]);
            pf[wr] = __builtin_bit_cast(bf16x8, w);
        }
        sum += __shfl_xor(sum, 16); sum += __shfl_xor(sum, 32);
        if (it + F.G < 2048) { const int nit = it + F.G; AT_PREFETCH(nit); }
        f32x4 O[4];
#pragma unroll
        for (int dt = 0; dt < 4; ++dt) O[dt] = (f32x4){0.f, 0.f, 0.f, 0.f};
#pragma unroll
        for (int wr = 0; wr < 8; ++wr)
#pragma unroll
            for (int dt = 0; dt < 4; ++dt) {
                const bf16x8 vf = *(const LAS bf16x8*)(VL + (dt * 16 + q) * AT_VSTR + ((lr0 + wr) * 64 + bs + 8 * g) * 2);
                O[dt] = __builtin_amdgcn_mfma_f32_16x16x32_bf16(vf, pf[wr], O[dt], 0, 0, 0);
            }
        const float inv = 1.0f / sum;
#pragma unroll
        for (int dt = 0; dt < 4; ++dt) { v2u w; w.x = pk2(O[dt][0] * inv, O[dt][1] * inv); w.y = pk2(O[dt][2] * inv, O[dt][3] * inv);
            *(v2u*)(mix + tokq * 1024 + hh * 64 + dt * 16 + 4 * g) = w; }
    }
#undef AT_DECODE
#undef AT_PREFETCH
    BLOCK_BAR();
}
#if NAIVE_ATTN
__device__ __forceinline__ void attn_naive_phase(Frame& F, int j) {
    const bf16* QK = (const bf16*)(F.ws + WS_BIG); const bf16* VT = (const bf16*)(F.ws + WS_VT); bf16* mix = (bf16*)(F.ws + WS_MIX);
    const float* biasl = F.in(6) + (size_t)j * NH * 15 * 31;
    for (int idx = F.vcu * NTHR + F.tid; idx < M * NH; idx += F.G * NTHR) {
        const int hh = idx & 15, t = idx >> 4, b = t >> 13, s = t & (SEQ - 1), r = s >> 6, qc = s & 63;
        int rs = r - 4; rs = rs < 0 ? 0 : (rs > NROWS - 8 ? NROWS - 8 : rs);
        int wst = qc - 8; wst = wst < 0 ? 0 : (wst > 48 ? 48 : wst);
        float qv[64];
#pragma unroll
        for (int c = 0; c < 8; ++c) { const v4u w = *(const v4u*)(QK + (size_t)t * 2048 + hh * 64 + c * 8);
#pragma unroll
            for (int e = 0; e < 4; ++e) { qv[c * 8 + 2 * e] = bflo(w[e]); qv[c * 8 + 2 * e + 1] = bfhi(w[e]); } }
        float mrun = -3.0e38f, lrun = 0.f, o[64];
#pragma unroll
        for (int d = 0; d < 64; ++d) o[d] = 0.f;
        for (int wr = 0; wr < 8; ++wr)
            for (int kk = 0; kk < 16; ++kk) {
                const int kc = wst + kk; const size_t tk = (size_t)b * SEQ + (rs + wr) * 64 + kc;
                float sd = 0.f;
#pragma unroll
                for (int c = 0; c < 8; ++c) { const v4u w = *(const v4u*)(QK + tk * 2048 + 1024 + hh * 64 + c * 8);
#pragma unroll
                    for (int e = 0; e < 4; ++e) sd += qv[c * 8 + 2 * e] * bflo(w[e]) + qv[c * 8 + 2 * e + 1] * bfhi(w[e]); }
                int co = kc - qc + 15; co = co < 0 ? 0 : (co > 30 ? 30 : co);
                sd += biasl[(size_t)hh * 465 + (rs + wr - r + 7) * 31 + co];
                const float mn = fmaxf(mrun, sd), al = __expf(mrun - mn), p = __expf(sd - mn);
                lrun = lrun * al + p; mrun = mn;
#pragma unroll
                for (int d = 0; d < 64; ++d) o[d] = o[d] * al + p * bflo((unsigned)VT[(size_t)(hh * 64 + d) * M + tk]);
            }
        const float inv = 1.0f / lrun;
#pragma unroll
        for (int c = 0; c < 8; ++c) { v4u w;
#pragma unroll
            for (int e = 0; e < 4; ++e) w[e] = pk2(o[c * 8 + 2 * e] * inv, o[c * 8 + 2 * e + 1] * inv);
            *(v4u*)(mix + (size_t)t * 1024 + hh * 64 + c * 8) = w; }
    }
}
#endif
#if NAIVE_TOPK
__device__ __forceinline__ void select_naive_phase(Frame& F) {
    const float* SC = (const float*)(F.ws + WS_SC); int* seli = (int*)(F.ws + WS_SELI); float* selg = (float*)(F.ws + WS_SELG);
    LAS int* AB = (LAS int*)F.lds + F.tid * 33;
    for (int idx = F.vcu * NTHR + F.tid; idx < M * 8; idx += F.G * NTHR) {
        const float* s = SC + (size_t)idx * 256;
        int a[16], b[16], t[16];
        tk_stage1<4>(s, 0, a); tk_stage1<4>(s + 64, 64, t); tk_merge_top(a, t);
        tk_stage1<4>(s + 128, 0, b); tk_stage1<4>(s + 192, 64, t); tk_merge_top(b, t);
        tk_stage2(a, b, AB, seli + (size_t)idx * 16, selg + (size_t)idx * 16);
    }
}
#endif

__device__ __forceinline__ float gelu_erf(float a) { return 0.5f * a * (1.0f + erff(a * 0.70710678118654752f)); }
typedef float f32x2g __attribute__((ext_vector_type(2)));
#if EXPERT_FP4
typedef v2u rowv;
__device__ __forceinline__ rowv row_load(const unsigned char* T, int e, int lane) { return *(const v2u*)(T + (size_t)e * ROWB + 8 * lane); }
#define ROW_PAIR(r, m) __builtin_amdgcn_cvt_scalef32_pk_f32_fp4((r)[(m) >> 2], 1.0f, (m) & 3)
#else
typedef v4u rowv;
__device__ __forceinline__ rowv row_load(const unsigned char* T, int e, int lane) { return *(const v4u*)(T + (size_t)e * ROWB + 16 * lane); }
#define ROW_PAIR(r, m) __builtin_amdgcn_cvt_pk_f32_fp8((r)[(m) >> 1], ((m) & 1) != 0)
#endif
__device__ __forceinline__ void row_axpy(f32x2g (&out)[8], const rowv d, float ak) {
    const f32x2g a2 = (f32x2g){ak, ak};
    out[0] = __builtin_elementwise_fma(a2, ROW_PAIR(d, 0), out[0]); out[1] = __builtin_elementwise_fma(a2, ROW_PAIR(d, 1), out[1]); out[2] = __builtin_elementwise_fma(a2, ROW_PAIR(d, 2), out[2]); out[3] = __builtin_elementwise_fma(a2, ROW_PAIR(d, 3), out[3]);
    out[4] = __builtin_elementwise_fma(a2, ROW_PAIR(d, 4), out[4]); out[5] = __builtin_elementwise_fma(a2, ROW_PAIR(d, 5), out[5]); out[6] = __builtin_elementwise_fma(a2, ROW_PAIR(d, 6), out[6]); out[7] = __builtin_elementwise_fma(a2, ROW_PAIR(d, 7), out[7]);
}
typedef int v8i_g __attribute__((ext_vector_type(8)));
typedef unsigned char u8x4g __attribute__((ext_vector_type(4)));
#define TR_SHUF(a, b, i0, i1, i2, i3) __builtin_amdgcn_perm((unsigned)(b), (unsigned)(a), (unsigned)((i0) | ((i1) << 8) | ((i2) << 16) | ((i3) << 24)))
__device__ __forceinline__ void tr8_nib(const unsigned (&w)[8], unsigned (&t)[8]) {
    unsigned x[8], y[8];
#pragma unroll
    for (int r = 0; r < 4; ++r) { x[r] = TR_SHUF(w[r], w[r + 4], 0, 1, 4, 5); x[r + 4] = TR_SHUF(w[r], w[r + 4], 2, 3, 6, 7); }
#pragma unroll
    for (int g = 0; g < 2; ++g)
#pragma unroll
        for (int r = 0; r < 2; ++r) { y[4 * g + r] = TR_SHUF(x[4 * g + r], x[4 * g + r + 2], 0, 4, 2, 6); y[4 * g + r + 2] = TR_SHUF(x[4 * g + r], x[4 * g + r + 2], 1, 5, 3, 7); }
#pragma unroll
    for (int p = 0; p < 4; ++p) { const unsigned e = y[2 * p], o = y[2 * p + 1];
        t[2 * p] = (e & 0x0F0F0F0Fu) | ((o << 4) & 0xF0F0F0F0u);
        t[2 * p + 1] = ((e >> 4) & 0x0F0F0F0Fu) | (o & 0xF0F0F0F0u); }
}
__device__ __forceinline__ int sel2(bool hf, int e0, int e1) { return hf ? e1 : e0; }
__device__ __forceinline__ void gather_phase(Frame& F, int layer, bool dry) {
    const unsigned char* UP = F.ws + WS_UP + (size_t)layer * 16384 * ROWB; const unsigned char* DN = F.ws + WS_DN + (size_t)layer * 16384 * ROWB;
    const f32x2g* SC2 = (const f32x2g*)(F.ws + WS_SUP) + (size_t)layer * 16384;
    const float* gain = F.in(2) + (size_t)layer * D; const float* gnext = layer < DEPTH - 1 ? F.in(1) + (size_t)(layer + 1) * D : F.in(3);
    float* outp = F.out();
    const int* seli = (const int*)(F.ws + WS_SELI); const float* selg = (const float*)(F.ws + WS_SELG);
    const bf16* H = (const bf16*)(F.ws + WS_H); bf16* HN = (bf16*)(F.ws + (dry ? WS_SC + 64 * MiB : WS_HN)); bf16* HW = (bf16*)(F.ws + (dry ? WS_SC : WS_H)); if (dry) outp = (float*)(F.ws + WS_SC);
    const int lane = F.lane, gw = F.vcu * NWAVES + F.wave, NGW = F.G * NWAVES;
    const bool b5 = lane & 32, b4 = lane & 16, b3 = lane & 8, b2 = lane & 4;
    constexpr int G_RS = 528, G_RB = 32 * G_RS, G_NSLOT = 4;
    LAS unsigned char* RB = F.lds + F.wave * G_RB;
    LAS float* ACT = (LAS float*)(F.lds + 8 * G_RB + F.wave * (G_NSLOT * 512));
    static_assert(8 * G_RB + 8 * G_NSLOT * 512 + 8 * 1024 <= PTAB_OFF, "gather LDS map");
#pragma unroll 1
    for (int base = gw; base < M; base += G_NSLOT * NGW) {
    LAS unsigned char* X8 = F.lds + 8 * G_RB + 8 * G_NSLOT * 512 + F.wave * 1024;
    const int n16 = lane & 15, g4 = lane >> 4;
    const bool hf = lane >> 5; const int c32 = lane & 31, sg = 2 * c32 + (hf ? 1 : 0);
    v2u nhb[4]; int nidx_lo = 0, nidx_hi = 0; float ng_lo = 0.f, ng_hi = 0.f;
#define TOK_LOAD(t_) do { const bf16* hr_ = H + (size_t)(t_) * D + 4 * sg; _Pragma("unroll") for (int i = 0; i < 4; ++i) nhb[i] = *(const v2u*)(hr_ + 256 * i); \
        nidx_lo = seli[(size_t)(t_) * 128 + lane]; nidx_hi = seli[(size_t)(t_) * 128 + 64 + lane]; ng_lo = selg[(size_t)(t_) * 128 + lane]; ng_hi = selg[(size_t)(t_) * 128 + 64 + lane]; } while (0)
    if (base < M) TOK_LOAD(base);
#pragma unroll 1
    for (int slot = 0; slot < G_NSLOT; ++slot) {
        const int t = base + slot * NGW; if (t >= M) break;
        f32x4 hv[4];
#pragma unroll
        for (int i = 0; i < 4; ++i) { const unsigned w0_ = nhb[i].x, w1_ = nhb[i].y; hv[i] = (f32x4){bflo(w0_), bfhi(w0_), bflo(w1_), bfhi(w1_)}; }
        const int idx_lo = nidx_lo, idx_hi = nidx_hi; const float g_lo = ng_lo, g_hi = ng_hi;
        if (slot + 1 < G_NSLOT && t + NGW < M) TOK_LOAD(t + NGW);
        float ss = 0.f;
#pragma unroll
        for (int i = 0; i < 4; ++i) ss += (hv[i].x * hv[i].x + hv[i].y * hv[i].y) + (hv[i].z * hv[i].z + hv[i].w * hv[i].w);
        const float rstd = 1.0f / sqrtf(wave_sum(ss) * (1.f / D) + RMS_EPS);
        float xmax = 0.f;
        f32x4 xv[4];
#pragma unroll
        for (int i = 0; i < 4; ++i) { const f32x4 g = *(const f32x4*)(gain + 256 * i + 4 * sg); xv[i] = hv[i] * rstd * g;
            xmax = fmaxf(fmaxf(xmax, fmaxf(fabsf(xv[i].x), fabsf(xv[i].y))), fmaxf(fabsf(xv[i].z), fabsf(xv[i].w))); }
#pragma unroll
        for (int o = 1; o < 64; o <<= 1) xmax = fmaxf(xmax, __shfl_xor(xmax, o));
        const float qx = xmax > 0.f ? 256.0f / xmax : 1.0f, xinv = xmax > 0.f ? xmax * (1.0f / 256.0f) : 1.0f;
        {
            v4u w;
#pragma unroll
            for (int i = 0; i < 4; ++i) { unsigned tt = 0u; tt = __builtin_amdgcn_cvt_pk_fp8_f32(xv[i].x * qx, xv[i].y * qx, tt, false); tt = __builtin_amdgcn_cvt_pk_fp8_f32(xv[i].z * qx, xv[i].w * qx, tt, true); w[i] = tt; }
            *(LAS v4u*)(X8 + 16 * sg) = w;
        }
        LDS_WAIT(); asm volatile("" ::: "memory");
#define ROW2(T, sel_, l0_) (*(const v4u*)((T) + (unsigned)(sel2(hf, __builtin_amdgcn_readlane(sel_, (l0_)), __builtin_amdgcn_readlane(sel_, (l0_) + 1)) * ROWB + 16 * c32)))
#define UP_LOAD(buf, hq) do { const int sel_ = (hq) < 2 ? idx_lo : idx_hi; _Pragma("unroll") for (int k = 0; k < 16; ++k) buf[k] = ROW2(UP, sel_, ((hq) & 1) * 32 + 2 * k); } while (0)
#define DN_LOAD(buf, hb) do { const int sel_ = (hb) < 4 ? idx_lo : idx_hi; _Pragma("unroll") for (int k = 0; k < 8; ++k) buf[k] = ROW2(DN, sel_, ((hb) & 3) * 16 + 2 * k); } while (0)
        v4u da[8];
        {
            v4u ur[16];
            UP_LOAD(ur, 0);
#define UP_NEXT UP_LOAD(ur, hq + 1)
#pragma unroll 1
            for (int hq = 0; hq < 3; ++hq) {
                const int sel = hq < 2 ? idx_lo : idx_hi; const float gsel = hq < 2 ? g_lo : g_hi; const int lb0 = (hq & 1) * 32;
#pragma unroll
                for (int k = 0; k < 16; ++k) *(LAS v4u*)(RB + (2 * k + (hf ? 1 : 0)) * G_RS + 16 * c32) = ur[k];
                float sc[4];
#pragma unroll
                for (int hh_ = 0; hh_ < 2; ++hh_) { const int ek_ = __shfl(sel, lb0 + hh_ * 16 + 4 * g4 + (n16 & 3)); const f32x2g s2_ = SC2[ek_]; sc[2 * hh_] = s2_.x; sc[2 * hh_ + 1] = s2_.y; }
                LDS_WAIT(); asm volatile("" ::: "memory");
                UP_NEXT;
                f32x4 cc[2]; cc[0] = (f32x4){0.f, 0.f, 0.f, 0.f}; cc[1] = cc[0];
#pragma unroll
                for (int s8 = 0; s8 < 8; ++s8) { const v4u b0 = *(const LAS v4u*)(X8 + 128 * s8 + 16 * g4), b1 = *(const LAS v4u*)(X8 + 128 * s8 + 64 + 16 * g4);
                    const v8i_g bq = (v8i_g){(int)b0.x, (int)b0.y, (int)b0.z, (int)b0.w, (int)b1.x, (int)b1.y, (int)b1.z, (int)b1.w};
#pragma unroll
                    for (int hh_ = 0; hh_ < 2; ++hh_) { const v4u a4 = *(const LAS v4u*)(RB + (hh_ * 16 + n16) * G_RS + 64 * s8 + 16 * g4); const v8i_g a8 = (v8i_g){(int)a4.x, (int)a4.y, (int)a4.z, (int)a4.w, 0, 0, 0, 0};
                        cc[hh_] = __builtin_amdgcn_mfma_scale_f32_16x16x128_f8f6f4(a8, bq, cc[hh_], 4, 0, 0, 0x7f7f7f7f, 0, 0x7f7f7f7f); } }
#pragma unroll
                for (int hh_ = 0; hh_ < 2; ++hh_) { const int lb = lb0 + hh_ * 16; const f32x4 c = cc[hh_];
                    const int r_ = n16 & 3, k_ = 4 * g4 + r_;
                    const float my = r_ == 0 ? c[0] : (r_ == 1 ? c[1] : (r_ == 2 ? c[2] : c[3]));
                    const float gate = __shfl(gsel, lb + k_);
                    const float act = gelu_erf(my * sc[2 * hh_] * xinv) * gate * sc[2 * hh_ + 1];
                    if (n16 < 4) ACT[slot * 128 + hq * 32 + hh_ * 16 + k_] = act; }
                LDS_WAIT(); asm volatile("" ::: "memory");
            }
#undef UP_NEXT
#define UP_NEXT DN_LOAD(da, 0)
            { const int hq = 3;
                const int sel = hq < 2 ? idx_lo : idx_hi; const float gsel = hq < 2 ? g_lo : g_hi; const int lb0 = (hq & 1) * 32;
#pragma unroll
                for (int k = 0; k < 16; ++k) *(LAS v4u*)(RB + (2 * k + (hf ? 1 : 0)) * G_RS + 16 * c32) = ur[k];
                float sc[4];
#pragma unroll
                for (int hh_ = 0; hh_ < 2; ++hh_) { const int ek_ = __shfl(sel, lb0 + hh_ * 16 + 4 * g4 + (n16 & 3)); const f32x2g s2_ = SC2[ek_]; sc[2 * hh_] = s2_.x; sc[2 * hh_ + 1] = s2_.y; }
                LDS_WAIT(); asm volatile("" ::: "memory");
                UP_NEXT;
                f32x4 cc[2]; cc[0] = (f32x4){0.f, 0.f, 0.f, 0.f}; cc[1] = cc[0];
#pragma unroll
                for (int s8 = 0; s8 < 8; ++s8) { const v4u b0 = *(const LAS v4u*)(X8 + 128 * s8 + 16 * g4), b1 = *(const LAS v4u*)(X8 + 128 * s8 + 64 + 16 * g4);
                    const v8i_g bq = (v8i_g){(int)b0.x, (int)b0.y, (int)b0.z, (int)b0.w, (int)b1.x, (int)b1.y, (int)b1.z, (int)b1.w};
#pragma unroll
                    for (int hh_ = 0; hh_ < 2; ++hh_) { const v4u a4 = *(const LAS v4u*)(RB + (hh_ * 16 + n16) * G_RS + 64 * s8 + 16 * g4); const v8i_g a8 = (v8i_g){(int)a4.x, (int)a4.y, (int)a4.z, (int)a4.w, 0, 0, 0, 0};
                        cc[hh_] = __builtin_amdgcn_mfma_scale_f32_16x16x128_f8f6f4(a8, bq, cc[hh_], 4, 0, 0, 0x7f7f7f7f, 0, 0x7f7f7f7f); } }
#pragma unroll
                for (int hh_ = 0; hh_ < 2; ++hh_) { const int lb = lb0 + hh_ * 16; const f32x4 c = cc[hh_];
                    const int r_ = n16 & 3, k_ = 4 * g4 + r_;
                    const float my = r_ == 0 ? c[0] : (r_ == 1 ? c[1] : (r_ == 2 ? c[2] : c[3]));
                    const float gate = __shfl(gsel, lb + k_);
                    const float act = gelu_erf(my * sc[2 * hh_] * xinv) * gate * sc[2 * hh_ + 1];
                    if (n16 < 4) ACT[slot * 128 + hq * 32 + hh_ * 16 + k_] = act; }
                LDS_WAIT(); asm volatile("" ::: "memory");
            }
#undef UP_NEXT
        }
#undef UP_LOAD
        LDS_WAIT(); asm volatile("" ::: "memory");
        const float a_lo = ACT[slot * 128 + lane], a_hi = ACT[slot * 128 + 64 + lane];
        float amax = fmaxf(fabsf(a_lo), fabsf(a_hi));
#pragma unroll
        for (int o = 1; o < 64; o <<= 1) amax = fmaxf(amax, __shfl_xor(amax, o));
        const float ainv = amax > 0.f ? 119.0f / amax : 0.f, tscale = amax * (1.0f / 119.0f);
        unsigned pd[4];
        {
            const int A0 = __float2int_rn(a_lo * ainv), A1 = __float2int_rn(a_hi * ainv);
            const int h0 = (A0 + 8) >> 4, l0 = A0 - 16 * h0, h1 = (A1 + 8) >> 4, l1 = A1 - 16 * h1;
            const int sh = 4 * ((lane >> 1) & 7);
            pd[0] = ((unsigned)l0 & 15u) << sh; pd[1] = ((unsigned)h0 & 15u) << sh; pd[2] = ((unsigned)l1 & 15u) << sh; pd[3] = ((unsigned)h1 & 15u) << sh;
#pragma unroll
            for (int q = 0; q < 4; ++q) { pd[q] |= (unsigned)__shfl_xor((int)pd[q], 2); pd[q] |= (unsigned)__shfl_xor((int)pd[q], 4); pd[q] |= (unsigned)__shfl_xor((int)pd[q], 8); }
        }
        int acc0[32];
#pragma unroll
        for (int e = 0; e < 32; ++e) acc0[e] = 0;
#define DN_STEP(buf, hb) do { const unsigned plo_ = (hb) < 4 ? pd[0] : pd[2], phi_ = (hb) < 4 ? pd[1] : pd[3]; \
            const int alo_ = sel2(hf, __builtin_amdgcn_readlane((int)plo_, ((hb) & 3) * 16), __builtin_amdgcn_readlane((int)plo_, ((hb) & 3) * 16 + 1)), ahi_ = sel2(hf, __builtin_amdgcn_readlane((int)phi_, ((hb) & 3) * 16), __builtin_amdgcn_readlane((int)phi_, ((hb) & 3) * 16 + 1)); \
            _Pragma("unroll") for (int w = 0; w < 4; ++w) { unsigned w_[8], t_[8]; \
                _Pragma("unroll") for (int r = 0; r < 8; ++r) w_[r] = buf[r][w]; \
                tr8_nib(w_, t_); \
                _Pragma("unroll") for (int c = 0; c < 8; ++c) { const int hi_ = __builtin_amdgcn_sdot8((int)t_[c], ahi_, 0, false); acc0[8 * w + c] = __builtin_amdgcn_sdot8((int)t_[c], alo_, acc0[8 * w + c], false) + (hi_ << 4); } } } while (0)
        {
            v4u db[8];
            DN_LOAD(db, 1); DN_STEP(da, 0);
            DN_LOAD(da, 2); DN_STEP(db, 1);
            DN_LOAD(db, 3); DN_STEP(da, 2);
            DN_LOAD(da, 4); DN_STEP(db, 3);
            DN_LOAD(db, 5); DN_STEP(da, 4);
            DN_LOAD(da, 6); DN_STEP(db, 5);
            DN_LOAD(db, 7); DN_STEP(da, 6);
            DN_STEP(db, 7);
        }
#undef DN_LOAD
#undef DN_STEP
#undef ROW2
        int os[16];
#pragma unroll
        for (int k = 0; k < 16; ++k) { const int lo_ = acc0[k], hi_ = acc0[16 + k]; os[k] = (hf ? hi_ : lo_) + __shfl_xor(hf ? lo_ : hi_, 32); }
        f32x2g out[8];
#pragma unroll
        for (int e = 0; e < 8; ++e) out[e] = (f32x2g){(float)os[2 * e] * tscale, (float)os[2 * e + 1] * tscale};
        float ss2 = 0.f;
#pragma unroll
        for (int i = 0; i < 4; ++i) { hv[i].x += out[2 * i].x; hv[i].y += out[2 * i].y; hv[i].z += out[2 * i + 1].x; hv[i].w += out[2 * i + 1].y;
            ss2 += (hv[i].x * hv[i].x + hv[i].y * hv[i].y) + (hv[i].z * hv[i].z + hv[i].w * hv[i].w); }
        const float rstd2 = 1.0f / sqrtf(wave_sum(ss2) * (1.f / D) + RMS_EPS);
        f32x4 y[4];
#pragma unroll
        for (int i = 0; i < 4; ++i) y[i] = hv[i] * rstd2 * *(const f32x4*)(gnext + 256 * i + 4 * sg);
        if (layer < DEPTH - 1) {
            bf16* hw_ = HW + (size_t)t * D + 4 * sg; bf16* hn = HN + (size_t)t * D + 4 * sg;
#pragma unroll
            for (int i = 0; i < 4; ++i) { v2u a_, b_; a_.x = pk2(hv[i].x, hv[i].y); a_.y = pk2(hv[i].z, hv[i].w); b_.x = pk2(y[i].x, y[i].y); b_.y = pk2(y[i].z, y[i].w);
                *(v2u*)(hw_ + 256 * i) = a_; *(v2u*)(hn + 256 * i) = b_; }
        } else {
            float* orow = outp + (size_t)t * D + 4 * sg;
#pragma unroll
            for (int i = 0; i < 4; ++i) *(f32x4*)(orow + 256 * i) = y[i];
        }
    }
    LDS_WAIT(); asm volatile("" ::: "memory");
    }
#undef TOK_LOAD
}

struct Args { const float* in[14]; float* out; unsigned char* ws; int ph_lo, ph_hi; };
__global__ void __launch_bounds__(NTHR, 2) mega_fwd(Args args) {
    extern __shared__ __attribute__((aligned(16))) unsigned char lds[];
    Frame F;
    F.lds = (LAS unsigned char*)lds;
    F.tid = threadIdx.x; F.lane = F.tid & 63; F.wave = __builtin_amdgcn_readfirstlane(F.tid >> 6);
    F.G = gridDim.x; { const int bx = blockIdx.x; F.vcu = (F.G % 8 == 0) ? (bx % 8) * (F.G / 8) + bx / 8 : bx; }
    F.ws = args.ws;
    volatile LAS unsigned* MISC = (volatile LAS unsigned*)(F.lds + MISC_OFF);
    if (F.tid < 64) MISC[F.tid] = 0u;
    if (F.tid < 15) { const unsigned long long p = F.tid < 14 ? (unsigned long long)args.in[F.tid] : (unsigned long long)args.out;
        volatile LAS unsigned* t = (volatile LAS unsigned*)(F.lds + PTAB_OFF); t[2 * F.tid] = (unsigned)p; t[2 * F.tid + 1] = (unsigned)(p >> 32); }
    __syncthreads();
    XcdBarrier bar; bar.bar = (unsigned*)(F.ws + WS_CTL) + CW_BAR; bar.x = 0; bar.st = nullptr;
    if (MK_N_LAUNCHES == 1) bar = xcd_barrier_post((unsigned*)(F.ws + WS_CTL) + CW_BAR, MISC + 8);

#pragma unroll 1
    for (int ph = args.ph_lo; ph < args.ph_hi; ++ph) {
        bool did = true;
        const int kind_ = ph == 0 ? 7 : (ph - 1) % PH_PER_LAYER; const int nrep = (PROBE_REP >= 0 && kind_ == PROBE_REP && (ph == 0 || ((PROBE_LMASK >> ((ph - 1) / PH_PER_LAYER)) & 1))) ? 2 : 1;
#pragma unroll 1
        for (int rep = 0; rep < nrep; ++rep) {
        const bool dry = (nrep == 2 && rep == 0);
        { int t_ = threadIdx.x; asm volatile("" : "+v"(t_)); F.tid = t_; F.lane = t_ & 63; F.wave = __builtin_amdgcn_readfirstlane(t_ >> 6);
          unsigned long long ws_ = (unsigned long long)args.ws; asm volatile("" : "+s"(ws_)); F.ws = (unsigned char*)(__attribute__((address_space(1))) unsigned char*)ws_; }
#ifndef DIS_PRO
        if (ph == 0) p0_prologue(F, dry);
#else
        if (ph == 0) {}
#endif
        else {
            const int layer = (ph - 1) / PH_PER_LAYER, k = (ph - 1) % PH_PER_LAYER, j = layer >> 1; const bool is_attn = (layer & 1) == 0;
            if (k == 0) {
                if (!is_attn) {
                    pg8::Gemm g{(const pg8::bf16_t*)(F.ws + WS_HN), (const pg8::bf16_t*)(F.ws + WS_WIN) + (size_t)j * 3072 * 1024, M, 3072, D};
                    pg8::StaticOrder S; S.init(g.M, g.N, F.G, (int)blockIdx.x);
                    EpiConvIn E{(bf16*)(F.ws + WS_BIG), (bf16*)(F.ws + WS_BIG + 32 * MiB)};
                    pg8::gemm_phase<EpiConvIn, pg8::StaticOrder, true, true>(F.lds, g, S, E);
                }
                const int ng = is_attn ? 2 : 0;
#pragma unroll 1
                for (int gi = 0; gi < ng; ++gi) {
                    pg8::Gemm g; pg8::EpiBf16<0> E; E.bias = nullptr; E.split_cols = 0; E.split_stride = 0; E.scale0 = 1.f;
                    if (is_attn && gi == 0) { g = pg8::Gemm{(const pg8::bf16_t*)(F.ws + WS_HN), (const pg8::bf16_t*)(F.ws + WS_WQK) + (size_t)j * 2048 * 1024, M, 2048, D}; E.O = (pg8::bf16_t*)(F.ws + WS_BIG); E.ldc = 2048; }
                    else if (is_attn) { g = pg8::Gemm{(const pg8::bf16_t*)(F.ws + WS_WV) + (size_t)j * 1024 * 1024, (const pg8::bf16_t*)(F.ws + WS_HN), D, M, D}; E.O = (pg8::bf16_t*)(F.ws + WS_VT); E.ldc = M; }
                    else { g = pg8::Gemm{(const pg8::bf16_t*)(F.ws + WS_HN), (const pg8::bf16_t*)(F.ws + WS_WIN) + (size_t)j * 3072 * 1024, M, 3072, D}; E.O = (pg8::bf16_t*)(F.ws + WS_BIG); E.ldc = 3072; }
                    pg8::StaticOrder S; S.init(g.M, g.N, F.G, (int)blockIdx.x);
                    pg8::gemm_phase<pg8::EpiBf16<0>, pg8::StaticOrder, true, true>(F.lds, g, S, E);
                }
            } else if (k == 1) {
                if (is_attn) {
#if NAIVE_ATTN
                    attn_naive_phase(F, j);
#elif !defined(DIS_ATTN)
                    attn_phase(F, j);
#endif
                } else {
#ifndef DIS_CONV
                    conv_phase(F, j);
#endif
                }
            } else if (k == 2) {
                pg8::Gemm g{(const pg8::bf16_t*)(F.ws + WS_MIX), (const pg8::bf16_t*)(F.ws + (is_attn ? WS_WO : WS_WOUT)) + (size_t)j * 1024 * 1024, M, D, D};
                pg8::StaticOrder S; S.init(M, D, F.G, (int)blockIdx.x);
                float* rssp = (float*)(F.ws + (dry ? WS_SC + 96 * MiB : WS_RSS)); bf16* hout = (bf16*)(F.ws + (dry ? WS_SC : WS_H));
                if (layer == 0) { EpiRes<true> E{(const void*)F.in(0), hout, rssp}; pg8::gemm_phase<EpiRes<true>, pg8::StaticOrder, false, true>(F.lds, g, S, E); }
                else { EpiRes<false> E{(const void*)(F.ws + WS_H), hout, rssp}; pg8::gemm_phase<EpiRes<false>, pg8::StaticOrder, false, true>(F.lds, g, S, E); }
            } else if (k == 3) {
                did = false;
            } else if (k == 4) {
                pg8::Gemm g{(const pg8::bf16_t*)(F.ws + WS_H), (const pg8::bf16_t*)(F.ws + WS_WP) + (size_t)layer * 2048 * 1024, M, 2048, D};
                pg8::StaticOrder S; S.init(M, 2048, F.G, (int)blockIdx.x);
#if NAIVE_TOPK
                EpiF32 E{(float*)(F.ws + WS_SC), 2048};
                pg8::gemm_phase<EpiF32, pg8::StaticOrder, true, true>(F.lds, g, S, E);
#else
#ifndef DIS_TOPK
                EpiTopK E{(int*)(F.ws + WS_SELI), (float*)(F.ws + WS_SELG), (const float*)(F.ws + WS_RSS)};
#pragma unroll 1
                for (int i = 0;; ++i) { OneUnit O1; if (!S.next(i, O1.u)) break; pg8::gemm_phase<EpiTopK, OneUnit, false, true>(F.lds, g, O1, E); }
#endif
#endif
            } else if (k == 5) {
#if NAIVE_TOPK
                select_naive_phase(F);
#else
                did = false;
#endif
            } else {
#ifndef DIS_GATHER
                gather_phase(F, layer, dry);
#endif
            }
        }
        if (MK_N_LAUNCHES == 1 && dry) xcd_barrier(bar);
        }
        if (MK_N_LAUNCHES == 1 && did && ph + 1 < args.ph_hi) { xcd_barrier(bar);
#ifdef PROBE_BAR2
            xcd_barrier(bar);
#endif
        }
    }
}

extern "C" void kernel_launch(void* const* d_in, const int* in_sizes, int n_in, void* d_out, int out_size, void* d_ws, size_t ws_size, hipStream_t stream) {
    static int grid = 0;
    if (grid == 0) {
        if (n_in != 14 || out_size != M * D || ws_size < WS_END) { fprintf(stderr, "kernel_launch: unexpected shapes (n_in %d, out %d, ws %zu); nothing launched\n", n_in, out_size, ws_size); grid = -1; return; }
        int dev = 0, cus = 0, per_cu = 0;
        if (hipGetDevice(&dev) != hipSuccess || hipDeviceGetAttribute(&cus, hipDeviceAttributeMultiprocessorCount, dev) != hipSuccess) { grid = -1; return; }
        if (hipFuncSetAttribute((const void*)mega_fwd, hipFuncAttributeMaxDynamicSharedMemorySize, LDS_BYTES) != hipSuccess) { fprintf(stderr, "kernel_launch: hipFuncSetAttribute failed\n"); grid = -1; return; }
        if (hipOccupancyMaxActiveBlocksPerMultiprocessor(&per_cu, (const void*)mega_fwd, NTHR, LDS_BYTES) != hipSuccess || per_cu < 1) fprintf(stderr, "kernel_launch: note: occupancy query reports %d\n", per_cu);
        (void)hipGetLastError();
        grid = cus;
    }
    if (grid < 0) return;
    if (hipMemsetAsync((char*)d_ws + WS_CTL, 0, CTL_ZERO_BYTES, stream) != hipSuccess) return;
    Args a{};
    for (int i = 0; i < 14; ++i) a.in[i] = (const float*)d_in[i];
    a.out = (float*)d_out; a.ws = (unsigned char*)d_ws;
    if (MK_N_LAUNCHES == 1) { a.ph_lo = 0; a.ph_hi = N_PHASES; hipLaunchKernelGGL(mega_fwd, dim3(grid), dim3(NTHR), LDS_BYTES, stream, a); }
    else for (int ph = 0; ph < N_PHASES; ++ph) {
        if (ph > 0 && ((ph - 1) % PH_PER_LAYER == 3 || (!NAIVE_TOPK && (ph - 1) % PH_PER_LAYER == 5))) continue;
        a.ph_lo = ph; a.ph_hi = ph + 1; hipLaunchKernelGGL(mega_fwd, dim3(grid), dim3(NTHR), LDS_BYTES, stream, a);
    }
}
```

```cpp
#include <hip/hip_runtime.h>
#include <cstdio>
#include <cstdint>
namespace pg8 {
#define PG8_LAS __attribute__((address_space(3)))
typedef unsigned short bf16_t;
typedef short bf16x8 __attribute__((ext_vector_type(8)));
typedef float f32x4 __attribute__((ext_vector_type(4)));
typedef unsigned u32x4 __attribute__((ext_vector_type(4)));
constexpr int BM = 256, BK = 64, HALF = 128, HTB = HALF * BK * 2  , STAGE_BYTES = 8 * HTB, NXCD = 8, WGM = 8;

__host__ __device__ __forceinline__ int lds_byte(int r, int c) { const int st = (r >> 4) * 2 + (c >> 5), rr = r & 15, cc = c & 31, ob = rr * 64 + cc * 2; return st * 1024 + (ob ^ (((ob >> 9) & 1) << 5)); }
__host__ __device__ __forceinline__ void stage_rc(int b, int& R, int& C) { const int st = b / 1024, sb = b % 1024, swz = sb ^ (((sb >> 9) & 1) << 5); R = (st >> 1) * 16 + swz / 64; C = (st & 1) * 32 + (swz % 64) / 2; }
__host__ __device__ __forceinline__ int perm32(int rho) { const int n = rho >> 4, i = rho & 15; return 8 * (i >> 2) + 4 * n + (i & 3); }

struct Unit { int pm, pn; };
struct Gemm { const bf16_t* A; const bf16_t* Bt; int M, N, K; };

struct StaticOrder {
    int nM, nN, nwg, G, c;
    __host__ __device__ void init(int M, int N, int G_, int c_) { nM = M / BM; nN = N / BM; nwg = nM * nN; G = G_; c = c_; }
    __host__ __device__ bool next(int i, Unit& u) const {
        const long L = (long)i * G + c; if (L >= nwg) return false;
        int wgid = (int)L; { const int q = nwg / NXCD, r = nwg % NXCD, xcd = wgid % NXCD, off = wgid / NXCD; wgid = (xcd < r ? xcd * (q + 1) : r * (q + 1) + (xcd - r) * q) + off; }
        const int nig = WGM * nN, gid = wgid / nig, fm = gid * WGM, gsz = (nM - fm) < WGM ? (nM - fm) : WGM;
        u.pm = fm + ((wgid % nig) % gsz); u.pn = (wgid % nig) / gsz; return true;
    }
    __device__ __forceinline__ void a_ready(const Unit&) const {}
    __device__ __forceinline__ void done(const Unit&) const {}
};

__device__ __forceinline__ unsigned cvt_pk_bf16(float lo, float hi) { unsigned r; asm volatile("v_cvt_pk_bf16_f32 %0, %1, %2" : "=v"(r) : "v"(lo), "v"(hi)); return r; }
typedef float f32x2 __attribute__((ext_vector_type(2)));
__device__ __forceinline__ f32x2 gelu_pk(f32x2 v) {
    const f32x2 av = __builtin_elementwise_abs(v), d = av * 0.2316418882f + 1.0f;
    f32x2 t; t.x = __builtin_amdgcn_rcpf(d.x); t.y = __builtin_amdgcn_rcpf(d.y);
    f32x2 q = t * 0.5307027145f + (-0.7265760135f); q = q * t + 0.7107068705f; q = q * t + (-0.142248368f); q = q * t + 0.127414796f; q = q * t;
    const f32x2 s = (v * v) * (-0.72134752044f);
    f32x2 e; e.x = __builtin_amdgcn_exp2f(s.x); e.y = __builtin_amdgcn_exp2f(s.y);
    const f32x2 m = v * (q * e), r = v - m;
    f32x2 o; o.x = v.x < 0.f ? m.x : r.x; o.y = v.y < 0.f ? m.y : r.y; return o;
}

template <int ACT  > struct EpiBf16 {
    static constexpr bool PERM = true, AFTER_DRAIN = false; static_assert(ACT == 0 || ACT == 1, "EpiBf16: ACT is 0 (none) or 1 (gelu_pk)");
    bf16_t* O; int ldc; const float* bias; int split_cols; size_t split_stride; float scale0;
    __device__ __forceinline__ void operator()(const f32x4 (&acc)[2][2][4][2], const Unit& u, int wr, int wc, int fr, int fq) const {
        const int row0 = u.pm * BM + wr * 64 + fr; int colt = u.pn * BM; bf16_t* base = O;
        float sc = 1.f; if (split_cols) { const int t = colt / split_cols; base += (size_t)t * split_stride; colt -= t * split_cols; if (t == 0) sc = scale0; }
        const int col0 = colt + wc * 32 + 8 * fq, bcol0 = u.pn * BM + wc * 32 + 8 * fq;
        f32x4 bv[2][2];
#pragma unroll
        for (int bj = 0; bj < 2; ++bj)
#pragma unroll
            for (int n = 0; n < 2; ++n) bv[bj][n] = bias ? *(const f32x4*)(bias + bcol0 + bj * HALF + 4 * n) : (f32x4){0.f, 0.f, 0.f, 0.f};
#pragma unroll
        for (int ai = 0; ai < 2; ++ai)
#pragma unroll
            for (int m = 0; m < 4; ++m) { bf16_t* rowp = base + (size_t)(row0 + ai * HALF + m * 16) * ldc + col0;
#pragma unroll
                for (int bj = 0; bj < 2; ++bj) { f32x4 v0 = acc[ai][bj][m][0] + bv[bj][0], v1 = acc[ai][bj][m][1] + bv[bj][1];
                    if (ACT == 1) { f32x2 a = gelu_pk((f32x2){v0[0], v0[1]}), b = gelu_pk((f32x2){v0[2], v0[3]}), c = gelu_pk((f32x2){v1[0], v1[1]}), d = gelu_pk((f32x2){v1[2], v1[3]});
                        v0 = (f32x4){a.x, a.y, b.x, b.y}; v1 = (f32x4){c.x, c.y, d.x, d.y}; }
                    v0 = v0 * sc; v1 = v1 * sc; u32x4 w; w.x = cvt_pk_bf16(v0[0], v0[1]); w.y = cvt_pk_bf16(v0[2], v0[3]); w.z = cvt_pk_bf16(v1[0], v1[1]); w.w = cvt_pk_bf16(v1[2], v1[3]);
                    *(u32x4*)(rowp + bj * HALF) = w; } }
    }
};

template <class Epi, class Sched, bool ALIGN_EPI = false, bool SP2 = false>
__device__ __forceinline__ void gemm_phase(PG8_LAS unsigned char* lds, const Gemm g, const Sched& S, const Epi& E) {
    int tid_l = threadIdx.x; asm volatile("" : "+v"(tid_l));
    const int tid = tid_l, wid = __builtin_amdgcn_readfirstlane(tid >> 6), lane = tid & 63, wr = wid >> 2, wc = wid & 3, fr = lane & 15, fq = lane >> 4;
    const int K = g.K, nt = K / BK;
    unsigned voffA[2], voffB[2];
#pragma unroll
    for (int i = 0; i < 2; ++i) { int R, C; stage_rc(tid * 16 + i * 8192, R, C); const int Rb = Epi::PERM ? ((R & ~31) + perm32(R & 31)) : R;
        voffA[i] = (unsigned)(R * K + C) * 2u; voffB[i] = (unsigned)(Rb * K + C) * 2u; }
    const size_t kstep = (size_t)(BK * 2);
    const size_t hstep = (size_t)HALF * K * 2;
    const size_t tstep = 2 * hstep;
    const unsigned ldsw = (unsigned)wid * 1024u;
    const int aoff = lds_byte(wr * 64 + fr, fq * 8), boff = lds_byte(wc * 32 + fr, fq * 8);
#define PG8_SA(b, h) (((b) * 2 + (h)) * HTB)
#define PG8_SB(b, h) ((4 + (b) * 2 + (h)) * HTB)
#define PG8_STAGE(bufoff, gbase, voff) do { _Pragma("unroll") for (int _i = 0; _i < 2; ++_i) \
        __builtin_amdgcn_global_load_lds((const unsigned*)((const char*)(gbase) + (voff)[_i]), (PG8_LAS unsigned*)(lds + (bufoff) + ldsw + _i * 8192), 16, 0, 0); } while (0)
#define PG8_LDA(dst, b, h) do { _Pragma("unroll") for (int m = 0; m < 4; ++m) _Pragma("unroll") for (int k = 0; k < 2; ++k) dst[m][k] = *(const PG8_LAS bf16x8*)(lds + PG8_SA(b, h) + aoff + m * 2048 + k * 1024); } while (0)
#define PG8_LDB(dst, b, h) do { _Pragma("unroll") for (int n = 0; n < 2; ++n) _Pragma("unroll") for (int k = 0; k < 2; ++k) dst[n][k] = *(const PG8_LAS bf16x8*)(lds + PG8_SB(b, h) + boff + n * 2048 + k * 1024); } while (0)
#define PG8_MMA(ai, bj, At, Bt) do { __builtin_amdgcn_s_setprio(1); _Pragma("unroll") for (int m = 0; m < 4; ++m) _Pragma("unroll") for (int n = 0; n < 2; ++n) _Pragma("unroll") for (int k = 0; k < 2; ++k) \
        acc[ai][bj][m][n] = __builtin_amdgcn_mfma_f32_16x16x32_bf16(Bt[n][k], At[m][k], acc[ai][bj][m][n], 0, 0, 0); __builtin_amdgcn_s_setprio(0); } while (0)
#define PG8_WAIT_V(n) asm volatile("s_waitcnt vmcnt(" #n ")" ::: "memory")
#define PG8_WAIT_L(n) asm volatile("s_waitcnt lgkmcnt(" #n ")" ::: "memory")
#define PG8_BAR __builtin_amdgcn_s_barrier()
#define PG8_SCHED __builtin_amdgcn_sched_barrier(0)
    Unit cur, nxt; int ui = 0;
    if (!S.next(0, cur)) return;
    f32x4 acc[2][2][4][2];
#pragma unroll
    for (int a = 0; a < 2; ++a)
#pragma unroll
        for (int b = 0; b < 2; ++b)
#pragma unroll
            for (int m = 0; m < 4; ++m)
#pragma unroll
                for (int n = 0; n < 2; ++n) acc[a][b][m][n] = (f32x4){0.f, 0.f, 0.f, 0.f};
    bf16x8 At[4][2], B0[2][2], B1[2][2];
    const char* cA = (const char*)g.A + (size_t)cur.pm * tstep; const char* cB = (const char*)g.Bt + (size_t)cur.pn * tstep;
    S.a_ready(cur);
    if constexpr (SP2) {
        PG8_STAGE(PG8_SB(0, 0), cB, voffB); PG8_STAGE(PG8_SB(0, 1), cB + hstep, voffB); PG8_STAGE(PG8_SA(0, 0), cA, voffA); PG8_STAGE(PG8_SA(0, 1), cA + hstep, voffA);
        if (wr == 1) PG8_BAR;
        PG8_WAIT_V(2); PG8_BAR;
        PG8_STAGE(PG8_SB(1, 0), cB + kstep, voffB); PG8_STAGE(PG8_SA(1, 0), cA + kstep, voffA); PG8_STAGE(PG8_SB(1, 1), cB + hstep + kstep, voffB);
        PG8_WAIT_V(6); PG8_BAR;
    } else {
        PG8_STAGE(PG8_SB(0, 0), cB, voffB); PG8_STAGE(PG8_SA(0, 0), cA, voffA); PG8_STAGE(PG8_SB(0, 1), cB + hstep, voffB); PG8_STAGE(PG8_SA(0, 1), cA + hstep, voffA);
        if (wr == 1) PG8_BAR;
        PG8_WAIT_V(4); PG8_BAR;
        PG8_STAGE(PG8_SB(1, 0), cB + kstep, voffB); PG8_STAGE(PG8_SA(1, 0), cA + kstep, voffA); PG8_STAGE(PG8_SB(1, 1), cB + hstep + kstep, voffB);
        PG8_WAIT_V(6); PG8_BAR;
    }
    for (;;) {
        const bool has_next = S.next(ui + 1, nxt);
        const char* nA = has_next ? (const char*)g.A + (size_t)nxt.pm * tstep : cA; const char* nB = has_next ? (const char*)g.Bt + (size_t)nxt.pn * tstep : cB;
        for (int t = 0; t < nt; t += 2) {
            const bool last = (t == nt - 2);
            const char* a1 = cA + (size_t)(t + 1) * kstep;
            const char* a2 = last ? nA : cA + (size_t)(t + 2) * kstep; const char* b2 = last ? nB : cB + (size_t)(t + 2) * kstep;
            const char* a3 = a2 + kstep; const char* b3 = b2 + kstep;
            if (last && has_next) S.a_ready(nxt);
            if constexpr (SP2) {
            PG8_LDB(B0, 0, 0); PG8_LDB(B1, 0, 1); PG8_SCHED; PG8_LDA(At, 0, 0); PG8_STAGE(PG8_SA(1, 1), a1 + hstep, voffA);
            PG8_WAIT_V(8); PG8_WAIT_L(0); PG8_BAR; PG8_MMA(0, 0, At, B0); PG8_MMA(0, 1, At, B1); PG8_BAR; PG8_SCHED;
            PG8_LDA(At, 0, 1); PG8_STAGE(PG8_SB(0, 0), b2, voffB); PG8_STAGE(PG8_SB(0, 1), b2 + hstep, voffB); PG8_STAGE(PG8_SA(0, 0), a2, voffA);
            PG8_WAIT_V(8); PG8_WAIT_L(0); PG8_BAR; PG8_MMA(1, 0, At, B0); PG8_MMA(1, 1, At, B1); PG8_BAR; PG8_SCHED;
            PG8_LDB(B0, 1, 0); PG8_LDB(B1, 1, 1); PG8_SCHED; PG8_LDA(At, 1, 0); PG8_STAGE(PG8_SA(0, 1), a2 + hstep, voffA);
            PG8_WAIT_V(8); PG8_WAIT_L(0); PG8_BAR; PG8_MMA(0, 0, At, B0); PG8_MMA(0, 1, At, B1); PG8_BAR; PG8_SCHED;
            PG8_LDA(At, 1, 1); PG8_STAGE(PG8_SB(1, 0), b3, voffB); PG8_STAGE(PG8_SB(1, 1), b3 + hstep, voffB); PG8_STAGE(PG8_SA(1, 0), a3, voffA);
            PG8_WAIT_V(8); PG8_WAIT_L(0); PG8_BAR; PG8_MMA(1, 0, At, B0); PG8_MMA(1, 1, At, B1); PG8_BAR; PG8_SCHED;
            } else {
            PG8_LDB(B0, 0, 0); PG8_SCHED; PG8_LDA(At, 0, 0); PG8_STAGE(PG8_SA(1, 1), a1 + hstep, voffA);
            PG8_WAIT_L(8); PG8_BAR; PG8_WAIT_L(0); PG8_MMA(0, 0, At, B0); PG8_BAR; PG8_SCHED;
            PG8_LDB(B1, 0, 1); PG8_STAGE(PG8_SB(0, 0), b2, voffB);
            PG8_BAR; PG8_WAIT_L(0); PG8_MMA(0, 1, At, B1); PG8_BAR;
            PG8_LDA(At, 0, 1); PG8_STAGE(PG8_SA(0, 0), a2, voffA);
            PG8_BAR; PG8_WAIT_L(0); PG8_MMA(1, 0, At, B0); PG8_BAR; PG8_SCHED;
            PG8_STAGE(PG8_SB(0, 1), b2 + hstep, voffB);
            PG8_WAIT_V(6); PG8_BAR; PG8_MMA(1, 1, At, B1); PG8_BAR;
            PG8_LDB(B0, 1, 0); PG8_SCHED; PG8_LDA(At, 1, 0); PG8_STAGE(PG8_SA(0, 1), a2 + hstep, voffA);
            PG8_WAIT_L(8); PG8_BAR; PG8_WAIT_L(0); PG8_MMA(0, 0, At, B0); PG8_BAR; PG8_SCHED;
            PG8_LDB(B1, 1, 1); PG8_STAGE(PG8_SB(1, 0), b3, voffB);
            PG8_BAR; PG8_WAIT_L(0); PG8_MMA(0, 1, At, B1); PG8_BAR;
            PG8_LDA(At, 1, 1); PG8_STAGE(PG8_SA(1, 0), a3, voffA);
            PG8_BAR; PG8_WAIT_L(0); PG8_MMA(1, 0, At, B0); PG8_BAR; PG8_SCHED;
            PG8_STAGE(PG8_SB(1, 1), b3 + hstep, voffB);
            PG8_WAIT_V(6); PG8_BAR; PG8_MMA(1, 1, At, B1); PG8_BAR;
            }
        }
        if constexpr (ALIGN_EPI) { if (wr == 0) PG8_BAR; }
        if constexpr (!Epi::AFTER_DRAIN) { E(acc, cur, wr, wc, fr, fq); S.done(cur); }
        if (!has_next) break;
#pragma unroll
        for (int a = 0; a < 2; ++a)
#pragma unroll
            for (int b = 0; b < 2; ++b)
#pragma unroll
                for (int m = 0; m < 4; ++m)
#pragma unroll
                    for (int n = 0; n < 2; ++n) acc[a][b][m][n] = (f32x4){0.f, 0.f, 0.f, 0.f};
        cur = nxt; cA = nA; cB = nB; ++ui;
        if constexpr (ALIGN_EPI) { if (wr == 1) PG8_BAR; }
    }
    PG8_WAIT_V(0);
    if constexpr (!ALIGN_EPI) { if (wr == 0) PG8_BAR; }
    PG8_BAR;
    if constexpr (Epi::AFTER_DRAIN) { E.fused(acc, cur, wr, wc, fr, fq, lds, wid, lane); S.done(cur); }
#undef PG8_SA
#undef PG8_SB
#undef PG8_STAGE
#undef PG8_LDA
#undef PG8_LDB
#undef PG8_MMA
#undef PG8_WAIT_V
#undef PG8_WAIT_L
#undef PG8_BAR
#undef PG8_SCHED
}
}
#ifndef HD
#define HD __host__ __device__ __forceinline__
#endif
HD int tk_map(float f) { int b = __builtin_bit_cast(int, f); return b ^ ((b >> 31) & 0x7fffffff); }
HD float tk_unmap(int k) { int b = k ^ ((k >> 31) & 0x7fffffff); return __builtin_bit_cast(float, b); }
HD void tk_cx(int& a, int& b) { const int hi = a > b ? a : b, lo = a > b ? b : a; a = hi; b = lo; }
template <int N> HD void tk_sort_desc(int (&v)[N]) {
#pragma unroll
    for (int k = 2; k <= N; k <<= 1)
#pragma unroll
        for (int j = k >> 1; j > 0; j >>= 1)
#pragma unroll
            for (int i = 0; i < N; ++i) { const int l = i ^ j; if (l > i) { if ((i & k) == 0) tk_cx(v[i], v[l]); else tk_cx(v[l], v[i]); } }
}
template <int N> HD void tk_merge_top(int (&a)[N], const int (&b)[N]) {
#pragma unroll
    for (int i = 0; i < N; ++i) a[i] = a[i] > b[N - 1 - i] ? a[i] : b[N - 1 - i];
#pragma unroll
    for (int j = N >> 1; j > 0; j >>= 1)
#pragma unroll
        for (int i = 0; i < N; ++i) { const int l = i ^ j; if (l > i) tk_cx(a[i], a[l]); }
}
template <int NCH, class FP> HD void tk_stage1(FP s, int n_base, int (&best)[16]) {
#pragma unroll
    for (int c = 0; c < NCH; ++c) {
        int x[16];
#pragma unroll
        for (int e = 0; e < 16; ++e) x[e] = (tk_map(s[c * 16 + e]) & ~127) | (127 - (n_base + c * 16 + e));
        tk_sort_desc(x);
        if (c == 0) {
#pragma unroll
            for (int e = 0; e < 16; ++e) best[e] = x[e];
        } else tk_merge_top(best, x);
    }
}
template <class IP, class OI, class OG> HD void tk_stage2(int (&a)[16], int (&b)[16], IP AB, OI out_idx, OG out_g, float vscale = 1.0f) {
    float va[16], vb[16];
#pragma unroll
    for (int i = 0; i < 16; ++i) { AB[i] = a[i]; AB[16 + i] = b[i]; va[i] = tk_unmap(a[i] & ~127); vb[i] = tk_unmap(b[i] & ~127); }
    int best[16];
#pragma unroll
    for (int c = 0; c < 4; ++c) {
        int x[16];
#pragma unroll
        for (int e = 0; e < 16; ++e) x[e] = (int)0x80000000;
        int n = 0;
#pragma unroll
        for (int i = 0; i < 16; ++i)
#pragma unroll
            for (int j = 0; j < 16; ++j)
                if ((i + 1) * (j + 1) <= 16) { if (n >= 16 * c && n < 16 * c + 16) x[n - 16 * c] = (tk_map(va[i] + vb[j]) & ~255) | (255 - (i * 16 + j)); ++n; }
        tk_sort_desc(x);
        if (c == 0) {
#pragma unroll
            for (int e = 0; e < 16; ++e) best[e] = x[e];
        } else tk_merge_top(best, x);
    }
    int ka[16], kb[16];
#pragma unroll
    for (int k = 0; k < 16; ++k) { const int flat = 255 - (best[k] & 255); ka[k] = AB[flat >> 4]; kb[k] = AB[16 + (flat & 15)]; }
    float sv[16]; int ei[16]; float sum = 0.f;
#pragma unroll
    for (int k = 0; k < 16; ++k) { ei[k] = (127 - (ka[k] & 127)) * 128 + (127 - (kb[k] & 127)); sv[k] = (tk_unmap(ka[k] & ~127) + tk_unmap(kb[k] & ~127)) * vscale; }
    const float m = sv[0];
#pragma unroll
    for (int k = 0; k < 16; ++k) { sv[k] = __expf(sv[k] - m); sum += sv[k]; }
    const float inv = 1.0f / sum;
#pragma unroll
    for (int k = 0; k < 16; ++k) { out_idx[k] = ei[k]; out_g[k] = sv[k] * inv; }
}
constexpr int NWAVES = 8, NTHR = 512;
constexpr int BATCH = 2, SEQ = 8192, D = 1024, M = BATCH * SEQ, DEPTH = 4;
constexpr int NH = 16, HDIM = 64, GRIDW = 64, NROWS = 128;
constexpr float RMS_EPS = 1e-6f;
#ifndef MK_N_LAUNCHES
#define MK_N_LAUNCHES 1
#endif
#ifndef NAIVE_ATTN
#define NAIVE_ATTN 0
#endif
#ifndef NAIVE_TOPK
#define NAIVE_TOPK 0
#endif
#ifndef EXPERT_FP4
#define EXPERT_FP4 1
#endif
constexpr int ROWB = EXPERT_FP4 ? 512 : 1024;
#ifndef PROBE_GMODE
#define PROBE_GMODE 0
#endif
#ifndef PROBE_PMODE
#define PROBE_PMODE 0
#endif
#ifndef PROBE_LMASK
#define PROBE_LMASK 15
#endif
#ifndef PROBE_REP
#define PROBE_REP -1
#endif
constexpr int PH_PER_LAYER = 7, N_PHASES = 1 + DEPTH * PH_PER_LAYER;

constexpr size_t MiB = 1u << 20;
constexpr size_t WS_CTL = 0, CTL_ZERO_BYTES = 32 * 1024;
constexpr size_t WS_WQK = 2 * MiB;
constexpr size_t WS_WV = 10 * MiB;
constexpr size_t WS_WO = 14 * MiB;
constexpr size_t WS_WIN = 18 * MiB;
constexpr size_t WS_WOUT = 30 * MiB;
constexpr size_t WS_WP = 34 * MiB;
constexpr size_t WS_H = 64 * MiB;
constexpr size_t WS_HN = 128 * MiB;
constexpr size_t WS_BIG = 160 * MiB;
constexpr size_t WS_VT = 224 * MiB;
constexpr size_t WS_MIX = 256 * MiB;
constexpr size_t WS_SELI = 288 * MiB;
constexpr size_t WS_SELG = 296 * MiB;
constexpr size_t WS_UP = 320 * MiB;
constexpr size_t WS_DN = 384 * MiB;
constexpr size_t WS_SUP = 448 * MiB;
constexpr size_t WS_RSS = 450 * MiB;
constexpr size_t WS_SC = 576 * MiB;
constexpr size_t WS_END = 704 * MiB;
constexpr int CW_BAR = 4096;
static_assert((CW_BAR + 3456) * 4 <= (int)CTL_ZERO_BYTES, "barrier words inside the per-call memset");

constexpr int LDS_BYTES = 163840, MISC_OFF = LDS_BYTES - 256, PTAB_OFF = LDS_BYTES - 512;

#define LAS __attribute__((address_space(3)))
typedef unsigned short bf16;
typedef unsigned v4u __attribute__((ext_vector_type(4)));
typedef unsigned v2u __attribute__((ext_vector_type(2)));
typedef float f32x4 __attribute__((ext_vector_type(4)));
typedef short bf16x8 __attribute__((ext_vector_type(8)));
#define LDS_WAIT() asm volatile("s_waitcnt lgkmcnt(0)" ::: "memory")
#define BLOCK_BAR() do { asm volatile("s_waitcnt vmcnt(0) lgkmcnt(0)" ::: "memory"); __builtin_amdgcn_s_barrier(); asm volatile("" ::: "memory"); } while (0)
__device__ __forceinline__ unsigned f2bf(float f) { unsigned u = __builtin_bit_cast(unsigned, f); return (u + 0x7fffu + ((u >> 16) & 1u)) >> 16; }
typedef float f32x2p __attribute__((ext_vector_type(2))); typedef __bf16 bf16x2p __attribute__((ext_vector_type(2)));
__device__ __forceinline__ unsigned pk2(float lo, float hi) { const f32x2p v = {lo, hi}; return __builtin_bit_cast(unsigned, __builtin_convertvector(v, bf16x2p)); }
__device__ __forceinline__ float bflo(unsigned u) { return __builtin_bit_cast(float, u << 16); }
__device__ __forceinline__ float bfhi(unsigned u) { return __builtin_bit_cast(float, u & 0xffff0000u); }
__device__ __forceinline__ float wave_sum(float v) {
#pragma unroll
    for (int o = 1; o < 64; o <<= 1) v += __shfl_xor(v, o);
    return v;
}

#define XB_TMO      128
#define XB_XCNT(j)  (256  + 64 * (j))
#define XB_XSUB(j)  (1280 + 64 * (j))
#define XB_XGEN(j)  (2304 + 64 * (j))
#define XB_TOP      3328
#define XB_TOPGEN   3392
#define XCD_BAR_WORDS 3456
#define XB_SPIN_CAP (1u << 20)
__device__ __forceinline__ unsigned xb_ld(unsigned* p)              { return __hip_atomic_load(p, __ATOMIC_RELAXED, __HIP_MEMORY_SCOPE_AGENT); }
__device__ __forceinline__ unsigned xb_add(unsigned* p, unsigned v) { return __hip_atomic_fetch_add(p, v, __ATOMIC_RELAXED, __HIP_MEMORY_SCOPE_AGENT); }
__device__ __forceinline__ unsigned xb_xcc_id() { return (unsigned)__builtin_amdgcn_s_getreg((3 << 11) | 20) & 0xFu; }
#define XB_SPIN(cond, bar) do { unsigned _sp = 0; while (cond) { __builtin_amdgcn_s_sleep(1); \
    if ((++_sp & 255u) == 0u) { if (xb_ld(&(bar)[XB_TMO])) break; if (_sp > XB_SPIN_CAP) { atomicAdd(&(bar)[XB_TMO], 1u); break; } } } } while (0)
struct XcdBarrier { unsigned* bar; unsigned x; volatile LAS unsigned* st; };
__device__ __forceinline__ XcdBarrier xcd_barrier_post(unsigned* bar, volatile LAS unsigned* st) {
    XcdBarrier b; b.bar = bar; b.x = xb_xcc_id(); b.st = st;
    if (threadIdx.x == 0) (void)xb_add(&bar[XB_XCNT(b.x)], 1u);
    return b;
}
__device__ __forceinline__ void xcd_barrier_complete(unsigned* bar, unsigned x, unsigned& nloc, unsigned& nx) {
    const unsigned G = gridDim.x * gridDim.y * gridDim.z;
    unsigned sum, cnt, mine, sp = 0u;
    for (;;) {
        sum = 0u; cnt = 0u; mine = 0u;
#pragma unroll
        for (unsigned j = 0; j < 16; ++j) { const unsigned c = xb_ld(&bar[XB_XCNT(j)]); sum += c; cnt += (c > 0u) ? 1u : 0u; mine = (j == x) ? c : mine; }
        if (sum == G) break;
        __builtin_amdgcn_s_sleep(1);
        if ((++sp & 255u) == 0u) { if (xb_ld(&bar[XB_TMO])) break; if (sp > XB_SPIN_CAP) { atomicAdd(&bar[XB_TMO], 1u); break; } }
    }
    nloc = mine > 0u ? mine : 1u; nx = cnt > 0u ? cnt : 1u;
}
__device__ __forceinline__ void xcd_barrier(const XcdBarrier& b) {
    asm volatile("s_waitcnt vmcnt(0)" ::: "memory");
    __syncthreads();
    if (threadIdx.x == 0) {
        unsigned* bar = b.bar;
        __builtin_amdgcn_s_waitcnt(0);
        unsigned nloc = b.st[0], nx = b.st[1];
        if (nloc == 0u) { xcd_barrier_complete(bar, b.x, nloc, nx); b.st[0] = nloc; b.st[1] = nx; }
        const unsigned old = xb_add(&bar[XB_XSUB(b.x)], 1u);
        const unsigned gen = old / nloc;
        if (old + 1u == (gen + 1u) * nloc) {
            __builtin_amdgcn_fence(__ATOMIC_RELEASE, "agent");
            asm volatile("s_waitcnt vmcnt(0)" ::: "memory");
            const unsigned og = xb_add(&bar[XB_TOP], 1u);
            const unsigned tg = og / nx;
            if (og + 1u == (tg + 1u) * nx) xb_add(&bar[XB_TOPGEN], 1u);
            else XB_SPIN(xb_ld(&bar[XB_TOPGEN]) == tg, bar);
            __builtin_amdgcn_fence(__ATOMIC_ACQUIRE, "agent");
            xb_add(&bar[XB_XGEN(b.x)], 1u);
            asm volatile("s_waitcnt vmcnt(0)" ::: "memory");
        } else {
            XB_SPIN(xb_ld(&bar[XB_XGEN(b.x)]) == gen, bar);
            __builtin_amdgcn_fence(__ATOMIC_ACQUIRE, "agent");
            asm volatile("s_waitcnt vmcnt(0)" ::: "memory");
        }
    }
    __syncthreads();
}

struct Frame {
    LAS unsigned char* lds;
    int tid, lane, wave, vcu, G;
    unsigned char* ws;
    __device__ __forceinline__ const float* in(int i) const {
        const volatile LAS unsigned* t = (const volatile LAS unsigned*)(lds + PTAB_OFF);
        const unsigned lo = __builtin_amdgcn_readfirstlane(t[2 * i]), hi = __builtin_amdgcn_readfirstlane(t[2 * i + 1]);
        return (const float*)(const __attribute__((address_space(1))) float*)(((unsigned long long)hi << 32) | lo);
    }
    __device__ __forceinline__ float* out() const { return (float*)in(14); }
};

template <bool FIRST> struct EpiRes {
    static constexpr bool PERM = false, AFTER_DRAIN = false;
    const void* hin; bf16* h; float* rss;
    __device__ __forceinline__ void operator()(const pg8::f32x4 (&acc)[2][2][4][2], const pg8::Unit& u, int wr, int wc, int fr, int fq) const {
        const int col0 = u.pn * 256 + wc * 32 + 4 * fq;
#pragma unroll
        for (int ai = 0; ai < 2; ++ai)
#pragma unroll
            for (int m = 0; m < 4; ++m) { const int row = u.pm * 256 + ai * 128 + wr * 64 + m * 16 + fr; bf16* rowp = h + (size_t)row * D + col0;
                float ss = 0.f;
#pragma unroll
                for (int bj = 0; bj < 2; ++bj)
#pragma unroll
                    for (int n = 0; n < 2; ++n) { f32x4 v;
                        if (FIRST) v = *(const f32x4*)((const float*)hin + (size_t)row * D + col0 + bj * 128 + n * 16);
                        else { const v2u hw = *(const v2u*)((const bf16*)hin + (size_t)row * D + col0 + bj * 128 + n * 16); v = (f32x4){bflo(hw.x), bfhi(hw.x), bflo(hw.y), bfhi(hw.y)}; }
                        v += acc[ai][bj][m][n];
                        ss += (v.x * v.x + v.y * v.y) + (v.z * v.z + v.w * v.w);
                        v2u w; w.x = pk2(v.x, v.y); w.y = pk2(v.z, v.w); *(v2u*)(rowp + bj * 128 + n * 16) = w; }
                ss += __shfl_xor(ss, 16); ss += __shfl_xor(ss, 32);
                if (fq == 0) rss[(size_t)row * 16 + u.pn * 4 + wc] = ss; }
    }
};
struct EpiConvIn {
    static constexpr bool PERM = true, AFTER_DRAIN = false;
    bf16* U; bf16* GB;
    __device__ __forceinline__ void operator()(const pg8::f32x4 (&acc)[2][2][4][2], const pg8::Unit& u, int wr, int wc, int fr, int fq) const {
        const int row0 = u.pm * 256 + wr * 64 + fr;
        if (u.pn < 8) {
            const int ch0 = u.pn * 128 + wc * 32 + 8 * fq;
#pragma unroll
            for (int ai = 0; ai < 2; ++ai)
#pragma unroll
                for (int m = 0; m < 4; ++m) { const f32x4 p0 = acc[ai][0][m][0] * acc[ai][1][m][0], p1 = acc[ai][0][m][1] * acc[ai][1][m][1];
                    v4u w; w.x = pk2(p0[0], p0[1]); w.y = pk2(p0[2], p0[3]); w.z = pk2(p1[0], p1[1]); w.w = pk2(p1[2], p1[3]);
                    *(v4u*)(U + (size_t)(row0 + ai * 128 + m * 16) * D + ch0) = w; }
        } else {
            const int col0 = (u.pn - 8) * 256 + wc * 32 + 8 * fq;
#pragma unroll
            for (int ai = 0; ai < 2; ++ai)
#pragma unroll
                for (int m = 0; m < 4; ++m)
#pragma unroll
                    for (int bj = 0; bj < 2; ++bj) { const f32x4 v0 = acc[ai][bj][m][0], v1 = acc[ai][bj][m][1];
                        v4u w; w.x = pk2(v0[0], v0[1]); w.y = pk2(v0[2], v0[3]); w.z = pk2(v1[0], v1[1]); w.w = pk2(v1[2], v1[3]);
                        *(v4u*)(GB + (size_t)(row0 + ai * 128 + m * 16) * D + col0 + bj * 128) = w; }
        }
    }
};
struct EpiF32 {
    static constexpr bool PERM = false, AFTER_DRAIN = false;
    float* O; int ldc;
    __device__ __forceinline__ void operator()(const pg8::f32x4 (&acc)[2][2][4][2], const pg8::Unit& u, int wr, int wc, int fr, int fq) const {
        const int col0 = u.pn * 256 + wc * 32 + 4 * fq;
#pragma unroll
        for (int ai = 0; ai < 2; ++ai)
#pragma unroll
            for (int m = 0; m < 4; ++m) { float* rowp = O + (size_t)(u.pm * 256 + ai * 128 + wr * 64 + m * 16 + fr) * ldc + col0;
#pragma unroll
                for (int bj = 0; bj < 2; ++bj)
#pragma unroll
                    for (int n = 0; n < 2; ++n) *(f32x4*)(rowp + bj * 128 + n * 16) = acc[ai][bj][m][n]; }
    }
};
struct EpiTopK {
    static constexpr bool PERM = false, AFTER_DRAIN = true;
    int* seli; float* selg; const float* rss;
    __device__ __forceinline__ void operator()(const pg8::f32x4 (&)[2][2][4][2], const pg8::Unit&, int, int, int, int) const {}
    __device__ __forceinline__ void fused(pg8::f32x4 (&acc)[2][2][4][2], const pg8::Unit& u, int wr, int wc, int fr, int fq, LAS unsigned char* lds, int wid, int lane) const {
        LAS float* S = (LAS float*)lds;
        LAS int* L = (LAS int*)lds;
        const int tid = wid * 64 + lane;
#pragma unroll 1
        for (int ai = 0; ai < 2; ++ai) {
#pragma unroll
            for (int m = 0; m < 4; ++m)
#pragma unroll
                for (int bj = 0; bj < 2; ++bj)
#pragma unroll
                    for (int n = 0; n < 2; ++n) {
                        const int row = wr * 64 + m * 16 + fr, col = bj * 128 + wc * 32 + n * 16 + 4 * fq;
                        *(LAS f32x4*)(S + row * 260 + col) = ai == 0 ? acc[0][bj][m][n] : acc[1][bj][m][n];
                    }
            BLOCK_BAR();
            const int row = tid & 127, q = tid >> 7;
            int best[16];
            {
                const LAS f32x4* sp = (const LAS f32x4*)(S + row * 260 + q * 64);
#pragma unroll
                for (int c = 0; c < 4; ++c) {
                    int x[16];
#pragma unroll
                    for (int e4 = 0; e4 < 4; ++e4) { const f32x4 v = sp[c * 4 + e4];
#pragma unroll
                        for (int e = 0; e < 4; ++e) x[e4 * 4 + e] = (tk_map(v[e]) & ~127) | (127 - ((q & 1) * 64 + c * 16 + e4 * 4 + e)); }
                    tk_sort_desc(x);
                    if (c == 0) {
#pragma unroll
                        for (int e = 0; e < 16; ++e) best[e] = x[e];
                    } else tk_merge_top(best, x);
                }
            }
            BLOCK_BAR();
#pragma unroll
            for (int e4 = 0; e4 < 4; ++e4) *(LAS v4u*)(L + row * 68 + q * 16 + e4 * 4) = (v4u){(unsigned)best[e4 * 4], (unsigned)best[e4 * 4 + 1], (unsigned)best[e4 * 4 + 2], (unsigned)best[e4 * 4 + 3]};
            BLOCK_BAR();
            if (tid < 128) {
                int a[16], b[16], t[16];
                LAS int* Lr = L + tid * 68;
#pragma unroll
                for (int e4 = 0; e4 < 4; ++e4) { const v4u va = *(LAS v4u*)(Lr + e4 * 4), vt = *(LAS v4u*)(Lr + 16 + e4 * 4);
#pragma unroll
                    for (int e = 0; e < 4; ++e) { a[e4 * 4 + e] = (int)va[e]; t[e4 * 4 + e] = (int)vt[e]; } }
                tk_merge_top(a, t);
#pragma unroll
                for (int e4 = 0; e4 < 4; ++e4) { const v4u vb = *(LAS v4u*)(Lr + 32 + e4 * 4), vt = *(LAS v4u*)(Lr + 48 + e4 * 4);
#pragma unroll
                    for (int e = 0; e < 4; ++e) { b[e4 * 4 + e] = (int)vb[e]; t[e4 * 4 + e] = (int)vt[e]; } }
                tk_merge_top(b, t);
                const int trow = u.pm * 256 + ai * 128 + tid;
                const f32x4 q0 = *(const f32x4*)(rss + (size_t)trow * 16), q1 = *(const f32x4*)(rss + (size_t)trow * 16 + 4), q2 = *(const f32x4*)(rss + (size_t)trow * 16 + 8), q3 = *(const f32x4*)(rss + (size_t)trow * 16 + 12);
                const float ssq = (((q0.x + q0.y) + (q0.z + q0.w)) + ((q1.x + q1.y) + (q1.z + q1.w))) + (((q2.x + q2.y) + (q2.z + q2.w)) + ((q3.x + q3.y) + (q3.z + q3.w)));
                const float rstd = 1.0f / sqrtf(ssq * (1.f / D) + RMS_EPS);
                const size_t o = ((size_t)trow * 8 + u.pn) * 16;
                tk_stage2(a, b, Lr, (__attribute__((address_space(1))) int*)(seli + o), (__attribute__((address_space(1))) float*)(selg + o), rstd);
            }
            BLOCK_BAR();
        }
    }
};
struct OneUnit {
    pg8::Unit u;
    __device__ __forceinline__ bool next(int i, pg8::Unit& o) const { if (i != 0) return false; o = u; return true; }
    __device__ __forceinline__ void a_ready(const pg8::Unit&) const {}
    __device__ __forceinline__ void done(const pg8::Unit&) const {}
};

__device__ __forceinline__ void p0_transpose_item(const float* W, int ldw, int ncols, bf16* WT, float scale, LAS float* scr, int item, int lane) {
    const int nblk = ncols / 64, kb = item / nblk, nb = item % nblk, k0 = 64 * kb, n0 = 64 * nb;
    f32x4 v[16];
#pragma unroll
    for (int i = 0; i < 16; ++i) v[i] = __builtin_nontemporal_load((const f32x4*)(W + (size_t)(k0 + 4 * i + (lane >> 4)) * ldw + n0 + 4 * (lane & 15)));
#pragma unroll
    for (int i = 0; i < 16; ++i) { LAS float* p = scr + (4 * i + (lane >> 4)) * 65 + 4 * (lane & 15); p[0] = v[i].x * scale; p[1] = v[i].y * scale; p[2] = v[i].z * scale; p[3] = v[i].w * scale; }
    LDS_WAIT(); asm volatile("" ::: "memory");
    const int c = lane & 7;
#pragma unroll
    for (int j = 0; j < 8; ++j) { const int n = (lane >> 3) + 8 * j; const LAS float* s = scr + (8 * c) * 65 + n;
        v4u o; o.x = pk2(s[0 * 65], s[1 * 65]); o.y = pk2(s[2 * 65], s[3 * 65]); o.z = pk2(s[4 * 65], s[5 * 65]); o.w = pk2(s[6 * 65], s[7 * 65]);
        *(v4u*)(WT + (size_t)(n0 + n) * 1024 + k0 + 8 * c) = o; }
    LDS_WAIT(); asm volatile("" ::: "memory");
}
__device__ __forceinline__ void rms_row_to_bf16(const float* xrow, const float* gain, bf16* orow, float* hcopy, int lane) {
    const f32x4* xr = (const f32x4*)xrow + lane; const f32x4* gr = (const f32x4*)gain + lane;
    f32x4 v[4]; float s = 0.f;
#pragma unroll
    for (int j = 0; j < 4; ++j) { v[j] = xr[64 * j]; s += (v[j].x * v[j].x + v[j].y * v[j].y) + (v[j].z * v[j].z + v[j].w * v[j].w); }
    if (hcopy) {
#pragma unroll
        for (int j = 0; j < 4; ++j) ((f32x4*)hcopy + lane)[64 * j] = v[j];
    }
    const float rstd = 1.0f / sqrtf(wave_sum(s) * (1.f / D) + RMS_EPS);
    unsigned long long* o8 = (unsigned long long*)orow + lane;
#pragma unroll
    for (int j = 0; j < 4; ++j) { const f32x4 g = gr[64 * j]; const f32x4 y = v[j] * rstd * g;
        o8[64 * j] = (unsigned long long)pk2(y.x, y.y) | ((unsigned long long)pk2(y.z, y.w) << 32); }
}
__device__ __forceinline__ void p0_prologue(Frame& F, bool dry) {
    if (!(dry && PROBE_PMODE == 1)) {
        LAS float* KL = (LAS float*)F.lds;
        LAS float* WL = (LAS float*)(F.lds + 128 * 132 * 4);
        const float* in10 = F.in(10); const float* in11 = F.in(11); const float* in2 = F.in(2);
        f32x4 kreg[8], wreg[4];
#define FOLD_LOAD(it_) do { const int l_ = (it_) >> 8, hp_ = ((it_) >> 4) & 15, k0_ = ((it_) & 15) * 64; \
            const float* kg_ = in11 + (size_t)(l_ * 16 + hp_) * 128 * 128; const float* wg_ = in10 + (size_t)l_ * 1024 * 2048 + (size_t)k0_ * 2048 + hp_ * 128; \
            _Pragma("unroll") for (int i = 0; i < 8; ++i) kreg[i] = *(const f32x4*)(kg_ + 4 * (F.tid + 512 * i)); \
            _Pragma("unroll") for (int i = 0; i < 4; ++i) { const int e = 4 * (F.tid + 512 * i); wreg[i] = __builtin_nontemporal_load((const f32x4*)(wg_ + (size_t)(e >> 7) * 2048 + (e & 127))); } } while (0)
        if (F.vcu < DEPTH * 16 * 16) FOLD_LOAD(F.vcu);
        for (int it = F.vcu; it < DEPTH * 16 * 16; it += F.G) {
            const int l = it >> 8, hp = (it >> 4) & 15, k0 = (it & 15) * 64;
#pragma unroll
            for (int i = 0; i < 8; ++i) { const int e = 4 * (F.tid + 512 * i), n = e >> 7, d = e & 127; *(LAS f32x4*)(KL + n * 132 + d) = kreg[i]; }
#pragma unroll
            for (int i = 0; i < 4; ++i) { const int e = 4 * (F.tid + 512 * i), kk = e >> 7, d = e & 127; *(LAS f32x4*)(WL + kk * 132 + d) = wreg[i]; }
            if (it + F.G < DEPTH * 16 * 16) FOLD_LOAD(it + F.G);
            BLOCK_BAR();
            {
                const int i16 = F.lane & 15, g4 = F.lane >> 4, nt = F.wave;
                f32x4 facc[4];
#pragma unroll
                for (int mt = 0; mt < 4; ++mt) facc[mt] = (f32x4){0.f, 0.f, 0.f, 0.f};
#pragma unroll 2
                for (int s8 = 0; s8 < 8; ++s8) {
                    const f32x4 bq = *(const LAS f32x4*)(KL + (nt * 16 + i16) * 132 + 16 * s8 + 4 * g4);
                    f32x4 aq[4];
#pragma unroll
                    for (int mt = 0; mt < 4; ++mt) aq[mt] = *(const LAS f32x4*)(WL + (mt * 16 + i16) * 132 + 16 * s8 + 4 * g4);
#pragma unroll
                    for (int t = 0; t < 4; ++t)
#pragma unroll
                        for (int mt = 0; mt < 4; ++mt) facc[mt] = __builtin_amdgcn_mfma_f32_16x16x4f32(aq[mt][t], bq[t], facc[mt], 0, 0, 0);
                }
                bf16* o = (bf16*)(F.ws + WS_WP) + (size_t)l * 2048 * 1024 + (size_t)(hp * 128 + nt * 16 + i16) * 1024 + k0 + 4 * g4;
#pragma unroll
                for (int mt = 0; mt < 4; ++mt) { const f32x4 gf = *(const f32x4*)(in2 + (size_t)l * D + k0 + mt * 16 + 4 * g4); v2u w; w.x = pk2(facc[mt][0] * gf.x, facc[mt][1] * gf.y); w.y = pk2(facc[mt][2] * gf.z, facc[mt][3] * gf.w); *(v2u*)(o + mt * 16) = w; }
            }
            BLOCK_BAR();
        }
#undef FOLD_LOAD
    }
    LAS float* scr = (LAS float*)(F.lds + F.wave * 16640);
    const int gw = F.vcu * NWAVES + F.wave, NGW = F.G * NWAVES;
    constexpr int I_SQ = 16 * 16, I_IN = 16 * 48, PER_J = 3 * I_SQ + I_SQ + I_IN + I_SQ;
    if (!(dry && PROBE_PMODE == 2)) for (int it = gw; it < 2 * PER_J; it += NGW) {
        const int j = it / PER_J; int r = it % PER_J;
        const float* wqkv = F.in(4) + (size_t)j * 1024 * 3072;
        if (r < I_SQ) { p0_transpose_item(wqkv, 3072, 1024, (bf16*)(F.ws + WS_WQK) + (size_t)j * 2048 * 1024, 0.125f, scr, r, F.lane); continue; } r -= I_SQ;
        if (r < I_SQ) { p0_transpose_item(wqkv + 1024, 3072, 1024, (bf16*)(F.ws + WS_WQK) + (size_t)j * 2048 * 1024 + (size_t)1024 * 1024, 1.f, scr, r, F.lane); continue; } r -= I_SQ;
        if (r < I_SQ) { p0_transpose_item(wqkv + 2048, 3072, 1024, (bf16*)(F.ws + WS_WV) + (size_t)j * 1024 * 1024, 1.f, scr, r, F.lane); continue; } r -= I_SQ;
        if (r < I_SQ) { p0_transpose_item(F.in(5) + (size_t)j * 1024 * 1024, 1024, 1024, (bf16*)(F.ws + WS_WO) + (size_t)j * 1024 * 1024, 1.f, scr, r, F.lane); continue; } r -= I_SQ;
        if (r < I_IN) {
            const float* win = F.in(7) + (size_t)j * 1024 * 3072; bf16* wt = (bf16*)(F.ws + WS_WIN) + (size_t)j * 3072 * 1024;
            if (r < 512) { const int blk = r >> 5, pn = blk >> 1, which = blk & 1; p0_transpose_item(win + (which ? 2048 : 1024) + 128 * pn, 3072, 128, wt + (size_t)(256 * pn + 128 * which) * 1024, 1.f, scr, r & 31, F.lane); }
            else p0_transpose_item(win, 3072, 1024, wt + (size_t)2048 * 1024, 1.f, scr, r - 512, F.lane);
            continue; } r -= I_IN;
        p0_transpose_item(F.in(9) + (size_t)j * 1024 * 1024, 1024, 1024, (bf16*)(F.ws + WS_WOUT) + (size_t)j * 1024 * 1024, 1.f, scr, r, F.lane);
    }
    if (!(dry && PROBE_PMODE == 3)) {
        constexpr int NROW = DEPTH * 16384;
        const float* in12 = F.in(12); const float* in13 = F.in(13);
#define XC_LOAD(v, r0_) do { const int tb_ = (r0_) >= NROW ? 1 : 0, rr_ = (r0_) - tb_ * NROW; const float* src_ = (tb_ ? in13 : in12) + (size_t)rr_ * 1024 + 4 * F.lane; \
            _Pragma("unroll") for (int u = 0; u < 4; ++u) _Pragma("unroll") for (int i = 0; i < 4; ++i) v[u][i] = __builtin_nontemporal_load((const f32x4*)(src_ + (size_t)u * 1024 + 256 * i)); } while (0)
#if EXPERT_FP4
#define XC_PACK(v, u, q, dstp) do { v2u w_; _Pragma("unroll") for (int jj = 0; jj < 2; ++jj) { unsigned t_ = 0u; \
                    t_ = __builtin_amdgcn_cvt_scalef32_pk_fp4_f32(t_, v[u][2 * jj].x * q, v[u][2 * jj].y * q, 1.0f, 0); t_ = __builtin_amdgcn_cvt_scalef32_pk_fp4_f32(t_, v[u][2 * jj].z * q, v[u][2 * jj].w * q, 1.0f, 1); \
                    t_ = __builtin_amdgcn_cvt_scalef32_pk_fp4_f32(t_, v[u][2 * jj + 1].x * q, v[u][2 * jj + 1].y * q, 1.0f, 2); t_ = __builtin_amdgcn_cvt_scalef32_pk_fp4_f32(t_, v[u][2 * jj + 1].z * q, v[u][2 * jj + 1].w * q, 1.0f, 3); w_[jj] = t_; } \
                *(v2u*)(dstp) = w_; } while (0)
        constexpr float QMAX = 6.0f;
#else
#define XC_PACK(v, u, q, dstp) do { v4u w_; _Pragma("unroll") for (int i = 0; i < 4; ++i) { unsigned t_ = 0u; t_ = __builtin_amdgcn_cvt_pk_fp8_f32(v[u][i].x * q, v[u][i].y * q, t_, false); t_ = __builtin_amdgcn_cvt_pk_fp8_f32(v[u][i].z * q, v[u][i].w * q, t_, true); w_[i] = t_; } \
                *(v4u*)(dstp) = w_; } while (0)
        constexpr float QMAX = 256.0f;
#endif
#define XC_I4(x_) ((unsigned)__float2int_rn(x_) & 15u)
#define XC_PACK_I4(v, u, q, dstp) do { v2u w_; _Pragma("unroll") for (int jj = 0; jj < 2; ++jj) { const f32x4 a_ = v[u][2 * jj] * q, b_ = v[u][2 * jj + 1] * q; \
                    w_[jj] = XC_I4(a_.x) | (XC_I4(a_.y) << 4) | (XC_I4(a_.z) << 8) | (XC_I4(a_.w) << 12) | (XC_I4(b_.x) << 16) | (XC_I4(b_.y) << 20) | (XC_I4(b_.z) << 24) | (XC_I4(b_.w) << 28); } \
                *(v2u*)(dstp) = w_; } while (0)
#define XC_CONV(v, r0_) do { const int tb_ = (r0_) >= NROW ? 1 : 0, rr_ = (r0_) - tb_ * NROW; \
            unsigned char* dst_ = F.ws + (tb_ ? WS_DN : WS_UP) + (size_t)rr_ * ROWB + (ROWB / 64) * F.lane; float* sc_ = (float*)(F.ws + WS_SUP) + 2 * (size_t)rr_ + tb_; \
            _Pragma("unroll") for (int u = 0; u < 4; ++u) { float mx = 0.f; \
                _Pragma("unroll") for (int i = 0; i < 4; ++i) mx = fmaxf(fmaxf(mx, fmaxf(fabsf(v[u][i].x), fabsf(v[u][i].y))), fmaxf(fabsf(v[u][i].z), fabsf(v[u][i].w))); \
                _Pragma("unroll") for (int o = 1; o < 64; o <<= 1) mx = fmaxf(mx, __shfl_xor(mx, o)); \
                if (tb_) { const float q = mx > 0.f ? 7.0f / mx : 1.0f; XC_PACK_I4(v, u, q, dst_ + (size_t)u * ROWB); if (F.lane == 0) sc_[2 * u] = mx > 0.f ? mx * (1.0f / 7.0f) : 1.0f; } \
                else { const float q = mx > 0.f ? QMAX / mx : 1.0f; XC_PACK(v, u, q, dst_ + (size_t)u * ROWB); if (F.lane == 0) sc_[2 * u] = mx > 0.f ? mx * (1.0f / QMAX) : 1.0f; } } } while (0)
        const int stepr = NGW * 4;
        f32x4 va[4][4], vb[4][4];
        int r0 = gw * 4;
        if (r0 < 2 * NROW) XC_LOAD(va, r0);
#pragma unroll 1
        for (; r0 < 2 * NROW; r0 += 2 * stepr) {
            if (r0 + stepr < 2 * NROW) XC_LOAD(vb, r0 + stepr);
            XC_CONV(va, r0);
            if (r0 + 2 * stepr < 2 * NROW) XC_LOAD(va, r0 + 2 * stepr);
            if (r0 + stepr < 2 * NROW) XC_CONV(vb, r0 + stepr);
        }
#undef XC_LOAD
#undef XC_PACK
#undef XC_PACK_I4
#undef XC_I4
#undef XC_CONV
    }
    if (!(dry && PROBE_PMODE == 4)) {
        const float* x0 = F.in(0); const f32x4* gr = (const f32x4*)F.in(1) + F.lane;
        f32x4 gq[4];
#pragma unroll
        for (int j = 0; j < 4; ++j) gq[j] = gr[64 * j];
#pragma unroll 1
        for (int m0 = gw; m0 < M; m0 += 4 * NGW) {
            f32x4 v[4][4];
#pragma unroll
            for (int u = 0; u < 4; ++u) { const int m = m0 + u * NGW; if (m < M) {
#pragma unroll
                for (int j = 0; j < 4; ++j) v[u][j] = ((const f32x4*)(x0 + (size_t)m * D) + F.lane)[64 * j]; } }
#pragma unroll
            for (int u = 0; u < 4; ++u) { const int m = m0 + u * NGW; if (m < M) {
                float sq = 0.f;
#pragma unroll
                for (int j = 0; j < 4; ++j) { sq += (v[u][j].x * v[u][j].x + v[u][j].y * v[u][j].y) + (v[u][j].z * v[u][j].z + v[u][j].w * v[u][j].w); }
                const float rstd = 1.0f / sqrtf(wave_sum(sq) * (1.f / D) + RMS_EPS);
                unsigned long long* o8 = (unsigned long long*)((bf16*)(F.ws + WS_HN) + (size_t)m * D) + F.lane;
#pragma unroll
                for (int j = 0; j < 4; ++j) { const f32x4 y = v[u][j] * rstd * gq[j]; o8[64 * j] = (unsigned long long)pk2(y.x, y.y) | ((unsigned long long)pk2(y.z, y.w) << 32); } } }
        }
    }
}

__device__ __forceinline__ void conv_phase(Frame& F, int j) {
    const bf16* U = (const bf16*)(F.ws + WS_BIG); const bf16* GB = (const bf16*)(F.ws + WS_BIG + 32 * MiB); bf16* mix = (bf16*)(F.ws + WS_MIX);
    const float* wc = F.in(8) + (size_t)j * 3 * 1024;
    for (int idx = F.vcu * NTHR + F.tid; idx < M * 128; idx += F.G * NTHR) {
        const int t = idx >> 7, c8 = (idx & 127) * 8, s = t & (SEQ - 1);
        const v4u gb = *(const v4u*)(GB + (size_t)t * D + c8);
        float conv[8];
#pragma unroll
        for (int e = 0; e < 8; ++e) conv[e] = 0.f;
#pragma unroll
        for (int dj = -1; dj <= 1; ++dj) {
            if (s + dj >= 0 && s + dj < SEQ) {
                const v4u uu = *(const v4u*)(U + (size_t)(t + dj) * D + c8);
                const f32x4 w0 = *(const f32x4*)(wc + (dj + 1) * 1024 + c8), w1 = *(const f32x4*)(wc + (dj + 1) * 1024 + c8 + 4);
#pragma unroll
                for (int e2 = 0; e2 < 4; ++e2) {
                    const float wl = e2 < 2 ? w0[2 * e2] : w1[2 * e2 - 4], wh = e2 < 2 ? w0[2 * e2 + 1] : w1[2 * e2 - 3];
                    conv[2 * e2] += wl * bflo(uu[e2]); conv[2 * e2 + 1] += wh * bfhi(uu[e2]);
                }
            }
        }
        v4u o;
#pragma unroll
        for (int e2 = 0; e2 < 4; ++e2) o[e2] = pk2(bflo(gb[e2]) * conv[2 * e2], bfhi(gb[e2]) * conv[2 * e2 + 1]);
        *(v4u*)(mix + (size_t)t * 1024 + c8) = o;
    }
}

constexpr int AT_KSTR = 144, AT_VSTR = 1168, AT_KOFF = 0, AT_VOFF = 576 * AT_KSTR, AT_BOFF = AT_VOFF + 64 * AT_VSTR;
static_assert(AT_BOFF + 1860 <= PTAB_OFF, "attention LDS map");
__device__ __forceinline__ void attn_phase(Frame& F, int j) {
    const bf16* QK = (const bf16*)(F.ws + WS_BIG); const bf16* VT = (const bf16*)(F.ws + WS_VT); bf16* mix = (bf16*)(F.ws + WS_MIX);
    const float* biasl = F.in(6) + (size_t)j * NH * 15 * 31;
    const int lane = F.lane, q = lane & 15, g = lane >> 4, tid = F.tid;
    LAS unsigned char* KL = F.lds + AT_KOFF; LAS unsigned char* VL = F.lds + AT_VOFF; LAS float* btab = (LAS float*)(F.lds + AT_BOFF);
    v4u kreg[9], vreg[9];
    int cur_hh = -1;
#define AT_DECODE(it, b_, hh_, r0_, R0_) const int hh_ = (it) & 15, rp_##it = ((it) >> 4) & 63, b_ = (it) >> 10, r0_ = 2 * rp_##it; int R0_ = r0_ - 4; R0_ = R0_ < 0 ? 0 : (R0_ > NROWS - 8 ? NROWS - 8 : R0_);
#define AT_PREFETCH(it) do { AT_DECODE(it, pb, phh, pr0, pR0) \
        _Pragma("unroll") for (int i = 0; i < 9; ++i) { const int c = tid + 512 * i; \
            { const int key = c >> 3, ch = c & 7; int row = pR0 + (key >> 6); row = row > NROWS - 1 ? NROWS - 1 : row; \
              kreg[i] = *(const v4u*)(QK + ((size_t)pb * SEQ + row * 64 + (key & 63)) * 2048 + 1024 + phh * 64 + ch * 8); } \
            { const int d = c / 72, kch = c - d * 72; vreg[i] = *(const v4u*)(VT + (size_t)(phh * 64 + d) * M + (size_t)pb * SEQ + pR0 * 64 + kch * 8); } } } while (0)
    int it = F.vcu;
    if (it < 2048) AT_PREFETCH(it);
    for (; it < 2048; it += F.G) {
        AT_DECODE(it, b, hh, r0, R0)
        BLOCK_BAR();
#pragma unroll
        for (int i = 0; i < 9; ++i) { const int c = tid + 512 * i;
            *(LAS v4u*)(KL + (c >> 3) * AT_KSTR + (c & 7) * 16) = kreg[i];
            const int d = c / 72, kch = c - d * 72; *(LAS v4u*)(VL + d * AT_VSTR + kch * 16) = vreg[i]; }
        if (hh != cur_hh) { if (tid < 465) btab[tid] = biasl[(size_t)hh * 465 + tid]; cur_hh = hh; }
        BLOCK_BAR();
        const int r = r0 + (F.wave >> 2), jb = F.wave & 3;
        int rs = r - 4; rs = rs < 0 ? 0 : (rs > NROWS - 8 ? NROWS - 8 : rs);
        const int lr0 = rs - R0;
        int bs = 16 * jb - 8; bs = bs < 0 ? 0 : (bs > 32 ? 32 : bs);
        const int qc = 16 * jb + q; int wst = qc - 8; wst = wst < 0 ? 0 : (wst > 48 ? 48 : wst);
        const size_t tokq = (size_t)b * SEQ + r * 64 + qc;
        bf16x8 qf[2];
#pragma unroll
        for (int ks = 0; ks < 2; ++ks) qf[ks] = *(const bf16x8*)(QK + tokq * 2048 + hh * 64 + ks * 32 + 8 * g);
        f32x4 S[8][2];
        const int kcl_a = 8 * (q >> 2) + (q & 3);
#pragma unroll
        for (int wr = 0; wr < 8; ++wr)
#pragma unroll
            for (int T = 0; T < 2; ++T) {
                const LAS unsigned char* kp = KL + ((lr0 + wr) * 64 + bs + kcl_a + 4 * T) * AT_KSTR + 16 * g;
                const bf16x8 k0 = *(const LAS bf16x8*)kp, k1 = *(const LAS bf16x8*)(kp + 64);
                f32x4 c = (f32x4){0.f, 0.f, 0.f, 0.f};
                c = __builtin_amdgcn_mfma_f32_16x16x32_bf16(k0, qf[0], c, 0, 0, 0);
                c = __builtin_amdgcn_mfma_f32_16x16x32_bf16(k1, qf[1], c, 0, 0, 0);
                S[wr][T] = c;
            }
        float mx = -3.0e38f;
#pragma unroll
        for (int wr = 0; wr < 8; ++wr) {
            const LAS float* brow = btab + (rs + wr - r + 7) * 31;
#pragma unroll
            for (int T = 0; T < 2; ++T)
#pragma unroll
                for (int i = 0; i < 4; ++i) {
                    const int kc = bs + 8 * g + 4 * T + i;
                    int co = kc - qc + 15; co = co < 0 ? 0 : (co > 30 ? 30 : co);
                    const bool valid = (kc >= wst) && (kc < wst + 16);
                    const float v = valid ? S[wr][T][i] + brow[co] : -1e30f;
                    S[wr][T][i] = v; mx = fmaxf(mx, v);
                }
        }
        mx = fmaxf(mx, __shfl_xor(mx, 16)); mx = fmaxf(mx, __shfl_xor(mx, 32));
        float sum = 0.f;
        bf16x8 pf[8];
#pragma unroll
        for (int wr = 0; wr < 8; ++wr) {
            float p[8];
#pragma unroll
            for (int T = 0; T < 2; ++T)
#pragma unroll
                for (int i = 0; i < 4; ++i) { p[4 * T + i] = __expf(S[wr][T][i] - mx); sum += p[4 * T + i]; }
            v4u w; w.x = pk2(p[0], p[1]); w.y = pk2(p[2], p[3]); w.z = pk2(p[4], p[5]); w.w = pk2(p[6], p[7]);
            pf[wr] = __builtin_bit_cast(bf16x8, w);
        }
        sum += __shfl_xor(sum, 16); sum += __shfl_xor(sum, 32);
        if (it + F.G < 2048) { const int nit = it + F.G; AT_PREFETCH(nit); }
        f32x4 O[4];
#pragma unroll
        for (int dt = 0; dt < 4; ++dt) O[dt] = (f32x4){0.f, 0.f, 0.f, 0.f};
#pragma unroll
        for (int wr = 0; wr < 8; ++wr)
#pragma unroll
            for (int dt = 0; dt < 4; ++dt) {
                const bf16x8 vf = *(const LAS bf16x8*)(VL + (dt * 16 + q) * AT_VSTR + ((lr0 + wr) * 64 + bs + 8 * g) * 2);
                O[dt] = __builtin_amdgcn_mfma_f32_16x16x32_bf16(vf, pf[wr], O[dt], 0, 0, 0);
            }
        const float inv = 1.0f / sum;
#pragma unroll
        for (int dt = 0; dt < 4; ++dt) { v2u w; w.x = pk2(O[dt][0] * inv, O[dt][1] * inv); w.y = pk2(O[dt][2] * inv, O[dt][3] * inv);
            *(v2u*)(mix + tokq * 1024 + hh * 64 + dt * 16 + 4 * g) = w; }
    }
#undef AT_DECODE
#undef AT_PREFETCH
    BLOCK_BAR();
}
#if NAIVE_ATTN
__device__ __forceinline__ void attn_naive_phase(Frame& F, int j) {
    const bf16* QK = (const bf16*)(F.ws + WS_BIG); const bf16* VT = (const bf16*)(F.ws + WS_VT); bf16* mix = (bf16*)(F.ws + WS_MIX);
    const float* biasl = F.in(6) + (size_t)j * NH * 15 * 31;
    for (int idx = F.vcu * NTHR + F.tid; idx < M * NH; idx += F.G * NTHR) {
        const int hh = idx & 15, t = idx >> 4, b = t >> 13, s = t & (SEQ - 1), r = s >> 6, qc = s & 63;
        int rs = r - 4; rs = rs < 0 ? 0 : (rs > NROWS - 8 ? NROWS - 8 : rs);
        int wst = qc - 8; wst = wst < 0 ? 0 : (wst > 48 ? 48 : wst);
        float qv[64];
#pragma unroll
        for (int c = 0; c < 8; ++c) { const v4u w = *(const v4u*)(QK + (size_t)t * 2048 + hh * 64 + c * 8);
#pragma unroll
            for (int e = 0; e < 4; ++e) { qv[c * 8 + 2 * e] = bflo(w[e]); qv[c * 8 + 2 * e + 1] = bfhi(w[e]); } }
        float mrun = -3.0e38f, lrun = 0.f, o[64];
#pragma unroll
        for (int d = 0; d < 64; ++d) o[d] = 0.f;
        for (int wr = 0; wr < 8; ++wr)
            for (int kk = 0; kk < 16; ++kk) {
                const int kc = wst + kk; const size_t tk = (size_t)b * SEQ + (rs + wr) * 64 + kc;
                float sd = 0.f;
#pragma unroll
                for (int c = 0; c < 8; ++c) { const v4u w = *(const v4u*)(QK + tk * 2048 + 1024 + hh * 64 + c * 8);
#pragma unroll
                    for (int e = 0; e < 4; ++e) sd += qv[c * 8 + 2 * e] * bflo(w[e]) + qv[c * 8 + 2 * e + 1] * bfhi(w[e]); }
                int co = kc - qc + 15; co = co < 0 ? 0 : (co > 30 ? 30 : co);
                sd += biasl[(size_t)hh * 465 + (rs + wr - r + 7) * 31 + co];
                const float mn = fmaxf(mrun, sd), al = __expf(mrun - mn), p = __expf(sd - mn);
                lrun = lrun * al + p; mrun = mn;
#pragma unroll
                for (int d = 0; d < 64; ++d) o[d] = o[d] * al + p * bflo((unsigned)VT[(size_t)(hh * 64 + d) * M + tk]);
            }
        const float inv = 1.0f / lrun;
#pragma unroll
        for (int c = 0; c < 8; ++c) { v4u w;
#pragma unroll
            for (int e = 0; e < 4; ++e) w[e] = pk2(o[c * 8 + 2 * e] * inv, o[c * 8 + 2 * e + 1] * inv);
            *(v4u*)(mix + (size_t)t * 1024 + hh * 64 + c * 8) = w; }
    }
}
#endif
#if NAIVE_TOPK
__device__ __forceinline__ void select_naive_phase(Frame& F) {
    const float* SC = (const float*)(F.ws + WS_SC); int* seli = (int*)(F.ws + WS_SELI); float* selg = (float*)(F.ws + WS_SELG);
    LAS int* AB = (LAS int*)F.lds + F.tid * 33;
    for (int idx = F.vcu * NTHR + F.tid; idx < M * 8; idx += F.G * NTHR) {
        const float* s = SC + (size_t)idx * 256;
        int a[16], b[16], t[16];
        tk_stage1<4>(s, 0, a); tk_stage1<4>(s + 64, 64, t); tk_merge_top(a, t);
        tk_stage1<4>(s + 128, 0, b); tk_stage1<4>(s + 192, 64, t); tk_merge_top(b, t);
        tk_stage2(a, b, AB, seli + (size_t)idx * 16, selg + (size_t)idx * 16);
    }
}
#endif

__device__ __forceinline__ float gelu_erf(float a) { return 0.5f * a * (1.0f + erff(a * 0.70710678118654752f)); }
typedef float f32x2g __attribute__((ext_vector_type(2)));
#if EXPERT_FP4
typedef v2u rowv;
__device__ __forceinline__ rowv row_load(const unsigned char* T, int e, int lane) { return *(const v2u*)(T + (size_t)e * ROWB + 8 * lane); }
#define ROW_PAIR(r, m) __builtin_amdgcn_cvt_scalef32_pk_f32_fp4((r)[(m) >> 2], 1.0f, (m) & 3)
#else
typedef v4u rowv;
__device__ __forceinline__ rowv row_load(const unsigned char* T, int e, int lane) { return *(const v4u*)(T + (size_t)e * ROWB + 16 * lane); }
#define ROW_PAIR(r, m) __builtin_amdgcn_cvt_pk_f32_fp8((r)[(m) >> 1], ((m) & 1) != 0)
#endif
__device__ __forceinline__ void row_axpy(f32x2g (&out)[8], const rowv d, float ak) {
    const f32x2g a2 = (f32x2g){ak, ak};
    out[0] = __builtin_elementwise_fma(a2, ROW_PAIR(d, 0), out[0]); out[1] = __builtin_elementwise_fma(a2, ROW_PAIR(d, 1), out[1]); out[2] = __builtin_elementwise_fma(a2, ROW_PAIR(d, 2), out[2]); out[3] = __builtin_elementwise_fma(a2, ROW_PAIR(d, 3), out[3]);
    out[4] = __builtin_elementwise_fma(a2, ROW_PAIR(d, 4), out[4]); out[5] = __builtin_elementwise_fma(a2, ROW_PAIR(d, 5), out[5]); out[6] = __builtin_elementwise_fma(a2, ROW_PAIR(d, 6), out[6]); out[7] = __builtin_elementwise_fma(a2, ROW_PAIR(d, 7), out[7]);
}
typedef int v8i_g __attribute__((ext_vector_type(8)));
typedef unsigned char u8x4g __attribute__((ext_vector_type(4)));
#define TR_SHUF(a, b, i0, i1, i2, i3) __builtin_amdgcn_perm((unsigned)(b), (unsigned)(a), (unsigned)((i0) | ((i1) << 8) | ((i2) << 16) | ((i3) << 24)))
__device__ __forceinline__ void tr8_nib(const unsigned (&w)[8], unsigned (&t)[8]) {
    unsigned x[8], y[8];
#pragma unroll
    for (int r = 0; r < 4; ++r) { x[r] = TR_SHUF(w[r], w[r + 4], 0, 1, 4, 5); x[r + 4] = TR_SHUF(w[r], w[r + 4], 2, 3, 6, 7); }
#pragma unroll
    for (int g = 0; g < 2; ++g)
#pragma unroll
        for (int r = 0; r < 2; ++r) { y[4 * g + r] = TR_SHUF(x[4 * g + r], x[4 * g + r + 2], 0, 4, 2, 6); y[4 * g + r + 2] = TR_SHUF(x[4 * g + r], x[4 * g + r + 2], 1, 5, 3, 7); }
#pragma unroll
    for (int p = 0; p < 4; ++p) { const unsigned e = y[2 * p], o = y[2 * p + 1];
        t[2 * p] = (e & 0x0F0F0F0Fu) | ((o << 4) & 0xF0F0F0F0u);
        t[2 * p + 1] = ((e >> 4) & 0x0F0F0F0Fu) | (o & 0xF0F0F0F0u); }
}
__device__ __forceinline__ int sel2(bool hf, int e0, int e1) { return hf ? e1 : e0; }
__device__ __forceinline__ void gather_phase(Frame& F, int layer, bool dry) {
    const unsigned char* UP = F.ws + WS_UP + (size_t)layer * 16384 * ROWB; const unsigned char* DN = F.ws + WS_DN + (size_t)layer * 16384 * ROWB;
    const f32x2g* SC2 = (const f32x2g*)(F.ws + WS_SUP) + (size_t)layer * 16384;
    const float* gain = F.in(2) + (size_t)layer * D; const float* gnext = layer < DEPTH - 1 ? F.in(1) + (size_t)(layer + 1) * D : F.in(3);
    float* outp = F.out();
    const int* seli = (const int*)(F.ws + WS_SELI); const float* selg = (const float*)(F.ws + WS_SELG);
    const bf16* H = (const bf16*)(F.ws + WS_H); bf16* HN = (bf16*)(F.ws + (dry ? WS_SC + 64 * MiB : WS_HN)); bf16* HW = (bf16*)(F.ws + (dry ? WS_SC : WS_H)); if (dry) outp = (float*)(F.ws + WS_SC);
    const int lane = F.lane, gw = F.vcu * NWAVES + F.wave, NGW = F.G * NWAVES;
    const bool b5 = lane & 32, b4 = lane & 16, b3 = lane & 8, b2 = lane & 4;
    constexpr int G_RS = 528, G_RB = 32 * G_RS, G_NSLOT = 4;
    LAS unsigned char* RB = F.lds + F.wave * G_RB;
    LAS float* ACT = (LAS float*)(F.lds + 8 * G_RB + F.wave * (G_NSLOT * 512));
    static_assert(8 * G_RB + 8 * G_NSLOT * 512 + 8 * 1024 <= PTAB_OFF, "gather LDS map");
#pragma unroll 1
    for (int base = gw; base < M; base += G_NSLOT * NGW) {
    LAS unsigned char* X8 = F.lds + 8 * G_RB + 8 * G_NSLOT * 512 + F.wave * 1024;
    const int n16 = lane & 15, g4 = lane >> 4;
    const bool hf = lane >> 5; const int c32 = lane & 31, sg = 2 * c32 + (hf ? 1 : 0);
    v2u nhb[4]; int nidx_lo = 0, nidx_hi = 0; float ng_lo = 0.f, ng_hi = 0.f;
#define TOK_LOAD(t_) do { const bf16* hr_ = H + (size_t)(t_) * D + 4 * sg; _Pragma("unroll") for (int i = 0; i < 4; ++i) nhb[i] = *(const v2u*)(hr_ + 256 * i); \
        nidx_lo = seli[(size_t)(t_) * 128 + lane]; nidx_hi = seli[(size_t)(t_) * 128 + 64 + lane]; ng_lo = selg[(size_t)(t_) * 128 + lane]; ng_hi = selg[(size_t)(t_) * 128 + 64 + lane]; } while (0)
    if (base < M) TOK_LOAD(base);
#pragma unroll 1
    for (int slot = 0; slot < G_NSLOT; ++slot) {
        const int t = base + slot * NGW; if (t >= M) break;
        f32x4 hv[4];
#pragma unroll
        for (int i = 0; i < 4; ++i) { const unsigned w0_ = nhb[i].x, w1_ = nhb[i].y; hv[i] = (f32x4){bflo(w0_), bfhi(w0_), bflo(w1_), bfhi(w1_)}; }
        const int idx_lo = nidx_lo, idx_hi = nidx_hi; const float g_lo = ng_lo, g_hi = ng_hi;
        if (slot + 1 < G_NSLOT && t + NGW < M) TOK_LOAD(t + NGW);
        float ss = 0.f;
#pragma unroll
        for (int i = 0; i < 4; ++i) ss += (hv[i].x * hv[i].x + hv[i].y * hv[i].y) + (hv[i].z * hv[i].z + hv[i].w * hv[i].w);
        const float rstd = 1.0f / sqrtf(wave_sum(ss) * (1.f / D) + RMS_EPS);
        float xmax = 0.f;
        f32x4 xv[4];
#pragma unroll
        for (int i = 0; i < 4; ++i) { const f32x4 g = *(const f32x4*)(gain + 256 * i + 4 * sg); xv[i] = hv[i] * rstd * g;
            xmax = fmaxf(fmaxf(xmax, fmaxf(fabsf(xv[i].x), fabsf(xv[i].y))), fmaxf(fabsf(xv[i].z), fabsf(xv[i].w))); }
#pragma unroll
        for (int o = 1; o < 64; o <<= 1) xmax = fmaxf(xmax, __shfl_xor(xmax, o));
        const float qx = xmax > 0.f ? 256.0f / xmax : 1.0f, xinv = xmax > 0.f ? xmax * (1.0f / 256.0f) : 1.0f;
        {
            v4u w;
#pragma unroll
            for (int i = 0; i < 4; ++i) { unsigned tt = 0u; tt = __builtin_amdgcn_cvt_pk_fp8_f32(xv[i].x * qx, xv[i].y * qx, tt, false); tt = __builtin_amdgcn_cvt_pk_fp8_f32(xv[i].z * qx, xv[i].w * qx, tt, true); w[i] = tt; }
            *(LAS v4u*)(X8 + 16 * sg) = w;
        }
        LDS_WAIT(); asm volatile("" ::: "memory");
#define ROW2(T, sel_, l0_) (*(const v4u*)((T) + (unsigned)(sel2(hf, __builtin_amdgcn_readlane(sel_, (l0_)), __builtin_amdgcn_readlane(sel_, (l0_) + 1)) * ROWB + 16 * c32)))
#define UP_LOAD(buf, hq) do { const int sel_ = (hq) < 2 ? idx_lo : idx_hi; _Pragma("unroll") for (int k = 0; k < 16; ++k) buf[k] = ROW2(UP, sel_, ((hq) & 1) * 32 + 2 * k); } while (0)
#define DN_LOAD(buf, hb) do { const int sel_ = (hb) < 4 ? idx_lo : idx_hi; _Pragma("unroll") for (int k = 0; k < 8; ++k) buf[k] = ROW2(DN, sel_, ((hb) & 3) * 16 + 2 * k); } while (0)
        v4u da[8];
        {
            v4u ur[16];
            UP_LOAD(ur, 0);
#define UP_NEXT UP_LOAD(ur, hq + 1)
#pragma unroll 1
            for (int hq = 0; hq < 3; ++hq) {
                const int sel = hq < 2 ? idx_lo : idx_hi; const float gsel = hq < 2 ? g_lo : g_hi; const int lb0 = (hq & 1) * 32;
#pragma unroll
                for (int k = 0; k < 16; ++k) *(LAS v4u*)(RB + (2 * k + (hf ? 1 : 0)) * G_RS + 16 * c32) = ur[k];
                float sc[4];
#pragma unroll
                for (int hh_ = 0; hh_ < 2; ++hh_) { const int ek_ = __shfl(sel, lb0 + hh_ * 16 + 4 * g4 + (n16 & 3)); const f32x2g s2_ = SC2[ek_]; sc[2 * hh_] = s2_.x; sc[2 * hh_ + 1] = s2_.y; }
                LDS_WAIT(); asm volatile("" ::: "memory");
                UP_NEXT;
                f32x4 cc[2]; cc[0] = (f32x4){0.f, 0.f, 0.f, 0.f}; cc[1] = cc[0];
#pragma unroll
                for (int s8 = 0; s8 < 8; ++s8) { const v4u b0 = *(const LAS v4u*)(X8 + 128 * s8 + 16 * g4), b1 = *(const LAS v4u*)(X8 + 128 * s8 + 64 + 16 * g4);
                    const v8i_g bq = (v8i_g){(int)b0.x, (int)b0.y, (int)b0.z, (int)b0.w, (int)b1.x, (int)b1.y, (int)b1.z, (int)b1.w};
#pragma unroll
                    for (int hh_ = 0; hh_ < 2; ++hh_) { const v4u a4 = *(const LAS v4u*)(RB + (hh_ * 16 + n16) * G_RS + 64 * s8 + 16 * g4); const v8i_g a8 = (v8i_g){(int)a4.x, (int)a4.y, (int)a4.z, (int)a4.w, 0, 0, 0, 0};
                        cc[hh_] = __builtin_amdgcn_mfma_scale_f32_16x16x128_f8f6f4(a8, bq, cc[hh_], 4, 0, 0, 0x7f7f7f7f, 0, 0x7f7f7f7f); } }
#pragma unroll
                for (int hh_ = 0; hh_ < 2; ++hh_) { const int lb = lb0 + hh_ * 16; const f32x4 c = cc[hh_];
                    const int r_ = n16 & 3, k_ = 4 * g4 + r_;
                    const float my = r_ == 0 ? c[0] : (r_ == 1 ? c[1] : (r_ == 2 ? c[2] : c[3]));
                    const float gate = __shfl(gsel, lb + k_);
                    const float act = gelu_erf(my * sc[2 * hh_] * xinv) * gate * sc[2 * hh_ + 1];
                    if (n16 < 4) ACT[slot * 128 + hq * 32 + hh_ * 16 + k_] = act; }
                LDS_WAIT(); asm volatile("" ::: "memory");
            }
#undef UP_NEXT
#define UP_NEXT DN_LOAD(da, 0)
            { const int hq = 3;
                const int sel = hq < 2 ? idx_lo : idx_hi; const float gsel = hq < 2 ? g_lo : g_hi; const int lb0 = (hq & 1) * 32;
#pragma unroll
                for (int k = 0; k < 16; ++k) *(LAS v4u*)(RB + (2 * k + (hf ? 1 : 0)) * G_RS + 16 * c32) = ur[k];
                float sc[4];
#pragma unroll
                for (int hh_ = 0; hh_ < 2; ++hh_) { const int ek_ = __shfl(sel, lb0 + hh_ * 16 + 4 * g4 + (n16 & 3)); const f32x2g s2_ = SC2[ek_]; sc[2 * hh_] = s2_.x; sc[2 * hh_ + 1] = s2_.y; }
                LDS_WAIT(); asm volatile("" ::: "memory");
                UP_NEXT;
                f32x4 cc[2]; cc[0] = (f32x4){0.f, 0.f, 0.f, 0.f}; cc[1] = cc[0];
#pragma unroll
                for (int s8 = 0; s8 < 8; ++s8) { const v4u b0 = *(const LAS v4u*)(X8 + 128 * s8 + 16 * g4), b1 = *(const LAS v4u*)(X8 + 128 * s8 + 64 + 16 * g4);
                    const v8i_g bq = (v8i_g){(int)b0.x, (int)b0.y, (int)b0.z, (int)b0.w, (int)b1.x, (int)b1.y, (int)b1.z, (int)b1.w};
#pragma unroll
                    for (int hh_ = 0; hh_ < 2; ++hh_) { const v4u a4 = *(const LAS v4u*)(RB + (hh_ * 16 + n16) * G_RS + 64 * s8 + 16 * g4); const v8i_g a8 = (v8i_g){(int)a4.x, (int)a4.y, (int)a4.z, (int)a4.w, 0, 0, 0, 0};
                        cc[hh_] = __builtin_amdgcn_mfma_scale_f32_16x16x128_f8f6f4(a8, bq, cc[hh_], 4, 0, 0, 0x7f7f7f7f, 0, 0x7f7f7f7f); } }
#pragma unroll
                for (int hh_ = 0; hh_ < 2; ++hh_) { const int lb = lb0 + hh_ * 16; const f32x4 c = cc[hh_];
                    const int r_ = n16 & 3, k_ = 4 * g4 + r_;
                    const float my = r_ == 0 ? c[0] : (r_ == 1 ? c[1] : (r_ == 2 ? c[2] : c[3]));
                    const float gate = __shfl(gsel, lb + k_);
                    const float act = gelu_erf(my * sc[2 * hh_] * xinv) * gate * sc[2 * hh_ + 1];
                    if (n16 < 4) ACT[slot * 128 + hq * 32 + hh_ * 16 + k_] = act; }
                LDS_WAIT(); asm volatile("" ::: "memory");
            }
#undef UP_NEXT
        }
#undef UP_LOAD
        LDS_WAIT(); asm volatile("" ::: "memory");
        const float a_lo = ACT[slot * 128 + lane], a_hi = ACT[slot * 128 + 64 + lane];
        float amax = fmaxf(fabsf(a_lo), fabsf(a_hi));
#pragma unroll
        for (int o = 1; o < 64; o <<= 1) amax = fmaxf(amax, __shfl_xor(amax, o));
        const float ainv = amax > 0.f ? 119.0f / amax : 0.f, tscale = amax * (1.0f / 119.0f);
        unsigned pd[4];
        {
            const int A0 = __float2int_rn(a_lo * ainv), A1 = __float2int_rn(a_hi * ainv);
            const int h0 = (A0 + 8) >> 4, l0 = A0 - 16 * h0, h1 = (A1 + 8) >> 4, l1 = A1 - 16 * h1;
            const int sh = 4 * ((lane >> 1) & 7);
            pd[0] = ((unsigned)l0 & 15u) << sh; pd[1] = ((unsigned)h0 & 15u) << sh; pd[2] = ((unsigned)l1 & 15u) << sh; pd[3] = ((unsigned)h1 & 15u) << sh;
#pragma unroll
            for (int q = 0; q < 4; ++q) { pd[q] |= (unsigned)__shfl_xor((int)pd[q], 2); pd[q] |= (unsigned)__shfl_xor((int)pd[q], 4); pd[q] |= (unsigned)__shfl_xor((int)pd[q], 8); }
        }
        int acc0[32];
#pragma unroll
        for (int e = 0; e < 32; ++e) acc0[e] = 0;
#define DN_STEP(buf, hb) do { const unsigned plo_ = (hb) < 4 ? pd[0] : pd[2], phi_ = (hb) < 4 ? pd[1] : pd[3]; \
            const int alo_ = sel2(hf, __builtin_amdgcn_readlane((int)plo_, ((hb) & 3) * 16), __builtin_amdgcn_readlane((int)plo_, ((hb) & 3) * 16 + 1)), ahi_ = sel2(hf, __builtin_amdgcn_readlane((int)phi_, ((hb) & 3) * 16), __builtin_amdgcn_readlane((int)phi_, ((hb) & 3) * 16 + 1)); \
            _Pragma("unroll") for (int w = 0; w < 4; ++w) { unsigned w_[8], t_[8]; \
                _Pragma("unroll") for (int r = 0; r < 8; ++r) w_[r] = buf[r][w]; \
                tr8_nib(w_, t_); \
                _Pragma("unroll") for (int c = 0; c < 8; ++c) { const int hi_ = __builtin_amdgcn_sdot8((int)t_[c], ahi_, 0, false); acc0[8 * w + c] = __builtin_amdgcn_sdot8((int)t_[c], alo_, acc0[8 * w + c], false) + (hi_ << 4); } } } while (0)
        {
            v4u db[8];
            DN_LOAD(db, 1); DN_STEP(da, 0);
            DN_LOAD(da, 2); DN_STEP(db, 1);
            DN_LOAD(db, 3); DN_STEP(da, 2);
            DN_LOAD(da, 4); DN_STEP(db, 3);
            DN_LOAD(db, 5); DN_STEP(da, 4);
            DN_LOAD(da, 6); DN_STEP(db, 5);
            DN_LOAD(db, 7); DN_STEP(da, 6);
            DN_STEP(db, 7);
        }
#undef DN_LOAD
#undef DN_STEP
#undef ROW2
        int os[16];
#pragma unroll
        for (int k = 0; k < 16; ++k) { const int lo_ = acc0[k], hi_ = acc0[16 + k]; os[k] = (hf ? hi_ : lo_) + __shfl_xor(hf ? lo_ : hi_, 32); }
        f32x2g out[8];
#pragma unroll
        for (int e = 0; e < 8; ++e) out[e] = (f32x2g){(float)os[2 * e] * tscale, (float)os[2 * e + 1] * tscale};
        float ss2 = 0.f;
#pragma unroll
        for (int i = 0; i < 4; ++i) { hv[i].x += out[2 * i].x; hv[i].y += out[2 * i].y; hv[i].z += out[2 * i + 1].x; hv[i].w += out[2 * i + 1].y;
            ss2 += (hv[i].x * hv[i].x + hv[i].y * hv[i].y) + (hv[i].z * hv[i].z + hv[i].w * hv[i].w); }
        const float rstd2 = 1.0f / sqrtf(wave_sum(ss2) * (1.f / D) + RMS_EPS);
        f32x4 y[4];
#pragma unroll
        for (int i = 0; i < 4; ++i) y[i] = hv[i] * rstd2 * *(const f32x4*)(gnext + 256 * i + 4 * sg);
        if (layer < DEPTH - 1) {
            bf16* hw_ = HW + (size_t)t * D + 4 * sg; bf16* hn = HN + (size_t)t * D + 4 * sg;
#pragma unroll
            for (int i = 0; i < 4; ++i) { v2u a_, b_; a_.x = pk2(hv[i].x, hv[i].y); a_.y = pk2(hv[i].z, hv[i].w); b_.x = pk2(y[i].x, y[i].y); b_.y = pk2(y[i].z, y[i].w);
                *(v2u*)(hw_ + 256 * i) = a_; *(v2u*)(hn + 256 * i) = b_; }
        } else {
            float* orow = outp + (size_t)t * D + 4 * sg;
#pragma unroll
            for (int i = 0; i < 4; ++i) *(f32x4*)(orow + 256 * i) = y[i];
        }
    }
    LDS_WAIT(); asm volatile("" ::: "memory");
    }
#undef TOK_LOAD
}

struct Args { const float* in[14]; float* out; unsigned char* ws; int ph_lo, ph_hi; };
__global__ void __launch_bounds__(NTHR, 2) mega_fwd(Args args) {
    extern __shared__ __attribute__((aligned(16))) unsigned char lds[];
    Frame F;
    F.lds = (LAS unsigned char*)lds;
    F.tid = threadIdx.x; F.lane = F.tid & 63; F.wave = __builtin_amdgcn_readfirstlane(F.tid >> 6);
    F.G = gridDim.x; { const int bx = blockIdx.x; F.vcu = (F.G % 8 == 0) ? (bx % 8) * (F.G / 8) + bx / 8 : bx; }
    F.ws = args.ws;
    volatile LAS unsigned* MISC = (volatile LAS unsigned*)(F.lds + MISC_OFF);
    if (F.tid < 64) MISC[F.tid] = 0u;
    if (F.tid < 15) { const unsigned long long p = F.tid < 14 ? (unsigned long long)args.in[F.tid] : (unsigned long long)args.out;
        volatile LAS unsigned* t = (volatile LAS unsigned*)(F.lds + PTAB_OFF); t[2 * F.tid] = (unsigned)p; t[2 * F.tid + 1] = (unsigned)(p >> 32); }
    __syncthreads();
    XcdBarrier bar; bar.bar = (unsigned*)(F.ws + WS_CTL) + CW_BAR; bar.x = 0; bar.st = nullptr;
    if (MK_N_LAUNCHES == 1) bar = xcd_barrier_post((unsigned*)(F.ws + WS_CTL) + CW_BAR, MISC + 8);

#pragma unroll 1
    for (int ph = args.ph_lo; ph < args.ph_hi; ++ph) {
        bool did = true;
        const int kind_ = ph == 0 ? 7 : (ph - 1) % PH_PER_LAYER; const int nrep = (PROBE_REP >= 0 && kind_ == PROBE_REP && (ph == 0 || ((PROBE_LMASK >> ((ph - 1) / PH_PER_LAYER)) & 1))) ? 2 : 1;
#pragma unroll 1
        for (int rep = 0; rep < nrep; ++rep) {
        const bool dry = (nrep == 2 && rep == 0);
        { int t_ = threadIdx.x; asm volatile("" : "+v"(t_)); F.tid = t_; F.lane = t_ & 63; F.wave = __builtin_amdgcn_readfirstlane(t_ >> 6);
          unsigned long long ws_ = (unsigned long long)args.ws; asm volatile("" : "+s"(ws_)); F.ws = (unsigned char*)(__attribute__((address_space(1))) unsigned char*)ws_; }
#ifndef DIS_PRO
        if (ph == 0) p0_prologue(F, dry);
#else
        if (ph == 0) {}
#endif
        else {
            const int layer = (ph - 1) / PH_PER_LAYER, k = (ph - 1) % PH_PER_LAYER, j = layer >> 1; const bool is_attn = (layer & 1) == 0;
            if (k == 0) {
                if (!is_attn) {
                    pg8::Gemm g{(const pg8::bf16_t*)(F.ws + WS_HN), (const pg8::bf16_t*)(F.ws + WS_WIN) + (size_t)j * 3072 * 1024, M, 3072, D};
                    pg8::StaticOrder S; S.init(g.M, g.N, F.G, (int)blockIdx.x);
                    EpiConvIn E{(bf16*)(F.ws + WS_BIG), (bf16*)(F.ws + WS_BIG + 32 * MiB)};
                    pg8::gemm_phase<EpiConvIn, pg8::StaticOrder, true, true>(F.lds, g, S, E);
                }
                const int ng = is_attn ? 2 : 0;
#pragma unroll 1
                for (int gi = 0; gi < ng; ++gi) {
                    pg8::Gemm g; pg8::EpiBf16<0> E; E.bias = nullptr; E.split_cols = 0; E.split_stride = 0; E.scale0 = 1.f;
                    if (is_attn && gi == 0) { g = pg8::Gemm{(const pg8::bf16_t*)(F.ws + WS_HN), (const pg8::bf16_t*)(F.ws + WS_WQK) + (size_t)j * 2048 * 1024, M, 2048, D}; E.O = (pg8::bf16_t*)(F.ws + WS_BIG); E.ldc = 2048; }
                    else if (is_attn) { g = pg8::Gemm{(const pg8::bf16_t*)(F.ws + WS_WV) + (size_t)j * 1024 * 1024, (const pg8::bf16_t*)(F.ws + WS_HN), D, M, D}; E.O = (pg8::bf16_t*)(F.ws + WS_VT); E.ldc = M; }
                    else { g = pg8::Gemm{(const pg8::bf16_t*)(F.ws + WS_HN), (const pg8::bf16_t*)(F.ws + WS_WIN) + (size_t)j * 3072 * 1024, M, 3072, D}; E.O = (pg8::bf16_t*)(F.ws + WS_BIG); E.ldc = 3072; }
                    pg8::StaticOrder S; S.init(g.M, g.N, F.G, (int)blockIdx.x);
                    pg8::gemm_phase<pg8::EpiBf16<0>, pg8::StaticOrder, true, true>(F.lds, g, S, E);
                }
            } else if (k == 1) {
                if (is_attn) {
#if NAIVE_ATTN
                    attn_naive_phase(F, j);
#elif !defined(DIS_ATTN)
                    attn_phase(F, j);
#endif
                } else {
#ifndef DIS_CONV
                    conv_phase(F, j);
#endif
                }
            } else if (k == 2) {
                pg8::Gemm g{(const pg8::bf16_t*)(F.ws + WS_MIX), (const pg8::bf16_t*)(F.ws + (is_attn ? WS_WO : WS_WOUT)) + (size_t)j * 1024 * 1024, M, D, D};
                pg8::StaticOrder S; S.init(M, D, F.G, (int)blockIdx.x);
                float* rssp = (float*)(F.ws + (dry ? WS_SC + 96 * MiB : WS_RSS)); bf16* hout = (bf16*)(F.ws + (dry ? WS_SC : WS_H));
                if (layer == 0) { EpiRes<true> E{(const void*)F.in(0), hout, rssp}; pg8::gemm_phase<EpiRes<true>, pg8::StaticOrder, false, true>(F.lds, g, S, E); }
                else { EpiRes<false> E{(const void*)(F.ws + WS_H), hout, rssp}; pg8::gemm_phase<EpiRes<false>, pg8::StaticOrder, false, true>(F.lds, g, S, E); }
            } else if (k == 3) {
                did = false;
            } else if (k == 4) {
                pg8::Gemm g{(const pg8::bf16_t*)(F.ws + WS_H), (const pg8::bf16_t*)(F.ws + WS_WP) + (size_t)layer * 2048 * 1024, M, 2048, D};
                pg8::StaticOrder S; S.init(M, 2048, F.G, (int)blockIdx.x);
#if NAIVE_TOPK
                EpiF32 E{(float*)(F.ws + WS_SC), 2048};
                pg8::gemm_phase<EpiF32, pg8::StaticOrder, true, true>(F.lds, g, S, E);
#else
#ifndef DIS_TOPK
                EpiTopK E{(int*)(F.ws + WS_SELI), (float*)(F.ws + WS_SELG), (const float*)(F.ws + WS_RSS)};
#pragma unroll 1
                for (int i = 0;; ++i) { OneUnit O1; if (!S.next(i, O1.u)) break; pg8::gemm_phase<EpiTopK, OneUnit, false, true>(F.lds, g, O1, E); }
#endif
#endif
            } else if (k == 5) {
#if NAIVE_TOPK
                select_naive_phase(F);
#else
                did = false;
#endif
            } else {
#ifndef DIS_GATHER
                gather_phase(F, layer, dry);
#endif
            }
        }
        if (MK_N_LAUNCHES == 1 && dry) xcd_barrier(bar);
        }
        if (MK_N_LAUNCHES == 1 && did && ph + 1 < args.ph_hi) { xcd_barrier(bar);
#ifdef PROBE_BAR2
            xcd_barrier(bar);
#endif
        }
    }
}

extern "C" void kernel_launch(void* const* d_in, const int* in_sizes, int n_in, void* d_out, int out_size, void* d_ws, size_t ws_size, hipStream_t stream) {
    static int grid = 0;
    if (grid == 0) {
        if (n_in != 14 || out_size != M * D || ws_size < WS_END) { fprintf(stderr, "kernel_launch: unexpected shapes (n_in %d, out %d, ws %zu); nothing launched\n", n_in, out_size, ws_size); grid = -1; return; }
        int dev = 0, cus = 0, per_cu = 0;
        if (hipGetDevice(&dev) != hipSuccess || hipDeviceGetAttribute(&cus, hipDeviceAttributeMultiprocessorCount, dev) != hipSuccess) { grid = -1; return; }
        if (hipFuncSetAttribute((const void*)mega_fwd, hipFuncAttributeMaxDynamicSharedMemorySize, LDS_BYTES) != hipSuccess) { fprintf(stderr, "kernel_launch: hipFuncSetAttribute failed\n"); grid = -1; return; }
        if (hipOccupancyMaxActiveBlocksPerMultiprocessor(&per_cu, (const void*)mega_fwd, NTHR, LDS_BYTES) != hipSuccess || per_cu < 1) fprintf(stderr, "kernel_launch: note: occupancy query reports %d\n", per_cu);
        (void)hipGetLastError();
        grid = cus;
    }
    if (grid < 0) return;
    if (hipMemsetAsync((char*)d_ws + WS_CTL, 0, CTL_ZERO_BYTES, stream) != hipSuccess) return;
    Args a{};
    for (int i = 0; i < 14; ++i) a.in[i] = (const float*)d_in[i];
    a.out = (float*)d_out; a.ws = (unsigned char*)d_ws;
    if (MK_N_LAUNCHES == 1) { a.ph_lo = 0; a.ph_hi = N_PHASES; hipLaunchKernelGGL(mega_fwd, dim3(grid), dim3(NTHR), LDS_BYTES, stream, a); }
    else for (int ph = 0; ph < N_PHASES; ++ph) {
        if (ph > 0 && ((ph - 1) % PH_PER_LAYER == 3 || (!NAIVE_TOPK && (ph - 1) % PH_PER_LAYER == 5))) continue;
        a.ph_lo = ph; a.ph_hi = ph + 1; hipLaunchKernelGGL(mega_fwd, dim3(grid), dim3(NTHR), LDS_BYTES, stream, a);
    }
}
```

```cpp
#include <hip/hip_runtime.h>
#include <cstdio>
#include <cstdint>
namespace pg8 {
#define PG8_LAS __attribute__((address_space(3)))
typedef unsigned short bf16_t;
typedef short bf16x8 __attribute__((ext_vector_type(8)));
typedef float f32x4 __attribute__((ext_vector_type(4)));
typedef unsigned u32x4 __attribute__((ext_vector_type(4)));
constexpr int BM = 256, BK = 64, HALF = 128, HTB = HALF * BK * 2  , STAGE_BYTES = 8 * HTB, NXCD = 8, WGM = 8;

__host__ __device__ __forceinline__ int lds_byte(int r, int c) { const int st = (r >> 4) * 2 + (c >> 5), rr = r & 15, cc = c & 31, ob = rr * 64 + cc * 2; return st * 1024 + (ob ^ (((ob >> 9) & 1) << 5)); }
__host__ __device__ __forceinline__ void stage_rc(int b, int& R, int& C) { const int st = b / 1024, sb = b % 1024, swz = sb ^ (((sb >> 9) & 1) << 5); R = (st >> 1) * 16 + swz / 64; C = (st & 1) * 32 + (swz % 64) / 2; }
__host__ __device__ __forceinline__ int perm32(int rho) { const int n = rho >> 4, i = rho & 15; return 8 * (i >> 2) + 4 * n + (i & 3); }

struct Unit { int pm, pn; };
struct Gemm { const bf16_t* A; const bf16_t* Bt; int M, N, K; };

struct StaticOrder {
    int nM, nN, nwg, G, c;
    __host__ __device__ void init(int M, int N, int G_, int c_) { nM = M / BM; nN = N / BM; nwg = nM * nN; G = G_; c = c_; }
    __host__ __device__ bool next(int i, Unit& u) const {
        const long L = (long)i * G + c; if (L >= nwg) return false;
        int wgid = (int)L; { const int q = nwg / NXCD, r = nwg % NXCD, xcd = wgid % NXCD, off = wgid / NXCD; wgid = (xcd < r ? xcd * (q + 1) : r * (q + 1) + (xcd - r) * q) + off; }
        const int nig = WGM * nN, gid = wgid / nig, fm = gid * WGM, gsz = (nM - fm) < WGM ? (nM - fm) : WGM;
        u.pm = fm + ((wgid % nig) % gsz); u.pn = (wgid % nig) / gsz; return true;
    }
    __device__ __forceinline__ void a_ready(const Unit&) const {}
    __device__ __forceinline__ void done(const Unit&) const {}
};

__device__ __forceinline__ unsigned cvt_pk_bf16(float lo, float hi) { unsigned r; asm volatile("v_cvt_pk_bf16_f32 %0, %1, %2" : "=v"(r) : "v"(lo), "v"(hi)); return r; }
typedef float f32x2 __attribute__((ext_vector_type(2)));
__device__ __forceinline__ f32x2 gelu_pk(f32x2 v) {
    const f32x2 av = __builtin_elementwise_abs(v), d = av * 0.2316418882f + 1.0f;
    f32x2 t; t.x = __builtin_amdgcn_rcpf(d.x); t.y = __builtin_amdgcn_rcpf(d.y);
    f32x2 q = t * 0.5307027145f + (-0.7265760135f); q = q * t + 0.7107068705f; q = q * t + (-0.142248368f); q = q * t + 0.127414796f; q = q * t;
    const f32x2 s = (v * v) * (-0.72134752044f);
    f32x2 e; e.x = __builtin_amdgcn_exp2f(s.x); e.y = __builtin_amdgcn_exp2f(s.y);
    const f32x2 m = v * (q * e), r = v - m;
    f32x2 o; o.x = v.x < 0.f ? m.x : r.x; o.y = v.y < 0.f ? m.y : r.y; return o;
}

template <int ACT  > struct EpiBf16 {
    static constexpr bool PERM = true, AFTER_DRAIN = false; static_assert(ACT == 0 || ACT == 1, "EpiBf16: ACT is 0 (none) or 1 (gelu_pk)");
    bf16_t* O; int ldc; const float* bias; int split_cols; size_t split_stride; float scale0;
    __device__ __forceinline__ void operator()(const f32x4 (&acc)[2][2][4][2], const Unit& u, int wr, int wc, int fr, int fq) const {
        const int row0 = u.pm * BM + wr * 64 + fr; int colt = u.pn * BM; bf16_t* base = O;
        float sc = 1.f; if (split_cols) { const int t = colt / split_cols; base += (size_t)t * split_stride; colt -= t * split_cols; if (t == 0) sc = scale0; }
        const int col0 = colt + wc * 32 + 8 * fq, bcol0 = u.pn * BM + wc * 32 + 8 * fq;
        f32x4 bv[2][2];
#pragma unroll
        for (int bj = 0; bj < 2; ++bj)
#pragma unroll
            for (int n = 0; n < 2; ++n) bv[bj][n] = bias ? *(const f32x4*)(bias + bcol0 + bj * HALF + 4 * n) : (f32x4){0.f, 0.f, 0.f, 0.f};
#pragma unroll
        for (int ai = 0; ai < 2; ++ai)
#pragma unroll
            for (int m = 0; m < 4; ++m) { bf16_t* rowp = base + (size_t)(row0 + ai * HALF + m * 16) * ldc + col0;
#pragma unroll
                for (int bj = 0; bj < 2; ++bj) { f32x4 v0 = acc[ai][bj][m][0] + bv[bj][0], v1 = acc[ai][bj][m][1] + bv[bj][1];
                    if (ACT == 1) { f32x2 a = gelu_pk((f32x2){v0[0], v0[1]}), b = gelu_pk((f32x2){v0[2], v0[3]}), c = gelu_pk((f32x2){v1[0], v1[1]}), d = gelu_pk((f32x2){v1[2], v1[3]});
                        v0 = (f32x4){a.x, a.y, b.x, b.y}; v1 = (f32x4){c.x, c.y, d.x, d.y}; }
                    v0 = v0 * sc; v1 = v1 * sc; u32x4 w; w.x = cvt_pk_bf16(v0[0], v0[1]); w.y = cvt_pk_bf16(v0[2], v0[3]); w.z = cvt_pk_bf16(v1[0], v1[1]); w.w = cvt_pk_bf16(v1[2], v1[3]);
                    *(u32x4*)(rowp + bj * HALF) = w; } }
    }
};

template <class Epi, class Sched, bool ALIGN_EPI = false, bool SP2 = false>
__device__ __forceinline__ void gemm_phase(PG8_LAS unsigned char* lds, const Gemm g, const Sched& S, const Epi& E) {
    int tid_l = threadIdx.x; asm volatile("" : "+v"(tid_l));
    const int tid = tid_l, wid = __builtin_amdgcn_readfirstlane(tid >> 6), lane = tid & 63, wr = wid >> 2, wc = wid & 3, fr = lane & 15, fq = lane >> 4;
    const int K = g.K, nt = K / BK;
    unsigned voffA[2], voffB[2];
#pragma unroll
    for (int i = 0; i < 2; ++i) { int R, C; stage_rc(tid * 16 + i * 8192, R, C); const int Rb = Epi::PERM ? ((R & ~31) + perm32(R & 31)) : R;
        voffA[i] = (unsigned)(R * K + C) * 2u; voffB[i] = (unsigned)(Rb * K + C) * 2u; }
    const size_t kstep = (size_t)(BK * 2);
    const size_t hstep = (size_t)HALF * K * 2;
    const size_t tstep = 2 * hstep;
    const unsigned ldsw = (unsigned)wid * 1024u;
    const int aoff = lds_byte(wr * 64 + fr, fq * 8), boff = lds_byte(wc * 32 + fr, fq * 8);
#define PG8_SA(b, h) (((b) * 2 + (h)) * HTB)
#define PG8_SB(b, h) ((4 + (b) * 2 + (h)) * HTB)
#define PG8_STAGE(bufoff, gbase, voff) do { _Pragma("unroll") for (int _i = 0; _i < 2; ++_i) \
        __builtin_amdgcn_global_load_lds((const unsigned*)((const char*)(gbase) + (voff)[_i]), (PG8_LAS unsigned*)(lds + (bufoff) + ldsw + _i * 8192), 16, 0, 0); } while (0)
#define PG8_LDA(dst, b, h) do { _Pragma("unroll") for (int m = 0; m < 4; ++m) _Pragma("unroll") for (int k = 0; k < 2; ++k) dst[m][k] = *(const PG8_LAS bf16x8*)(lds + PG8_SA(b, h) + aoff + m * 2048 + k * 1024); } while (0)
#define PG8_LDB(dst, b, h) do { _Pragma("unroll") for (int n = 0; n < 2; ++n) _Pragma("unroll") for (int k = 0; k < 2; ++k) dst[n][k] = *(const PG8_LAS bf16x8*)(lds + PG8_SB(b, h) + boff + n * 2048 + k * 1024); } while (0)
#define PG8_MMA(ai, bj, At, Bt) do { __builtin_amdgcn_s_setprio(1); _Pragma("unroll") for (int m = 0; m < 4; ++m) _Pragma("unroll") for (int n = 0; n < 2; ++n) _Pragma("unroll") for (int k = 0; k < 2; ++k) \
        acc[ai][bj][m][n] = __builtin_amdgcn_mfma_f32_16x16x32_bf16(Bt[n][k], At[m][k], acc[ai][bj][m][n], 0, 0, 0); __builtin_amdgcn_s_setprio(0); } while (0)
#define PG8_WAIT_V(n) asm volatile("s_waitcnt vmcnt(" #n ")" ::: "memory")
#define PG8_WAIT_L(n) asm volatile("s_waitcnt lgkmcnt(" #n ")" ::: "memory")
#define PG8_BAR __builtin_amdgcn_s_barrier()
#define PG8_SCHED __builtin_amdgcn_sched_barrier(0)
    Unit cur, nxt; int ui = 0;
    if (!S.next(0, cur)) return;
    f32x4 acc[2][2][4][2];
#pragma unroll
    for (int a = 0; a < 2; ++a)
#pragma unroll
        for (int b = 0; b < 2; ++b)
#pragma unroll
            for (int m = 0; m < 4; ++m)
#pragma unroll
                for (int n = 0; n < 2; ++n) acc[a][b][m][n] = (f32x4){0.f, 0.f, 0.f, 0.f};
    bf16x8 At[4][2], B0[2][2], B1[2][2];
    const char* cA = (const char*)g.A + (size_t)cur.pm * tstep; const char* cB = (const char*)g.Bt + (size_t)cur.pn * tstep;
    S.a_ready(cur);
    if constexpr (SP2) {
        PG8_STAGE(PG8_SB(0, 0), cB, voffB); PG8_STAGE(PG8_SB(0, 1), cB + hstep, voffB); PG8_STAGE(PG8_SA(0, 0), cA, voffA); PG8_STAGE(PG8_SA(0, 1), cA + hstep, voffA);
        if (wr == 1) PG8_BAR;
        PG8_WAIT_V(2); PG8_BAR;
        PG8_STAGE(PG8_SB(1, 0), cB + kstep, voffB); PG8_STAGE(PG8_SA(1, 0), cA + kstep, voffA); PG8_STAGE(PG8_SB(1, 1), cB + hstep + kstep, voffB);
        PG8_WAIT_V(6); PG8_BAR;
    } else {
        PG8_STAGE(PG8_SB(0, 0), cB, voffB); PG8_STAGE(PG8_SA(0, 0), cA, voffA); PG8_STAGE(PG8_SB(0, 1), cB + hstep, voffB); PG8_STAGE(PG8_SA(0, 1), cA + hstep, voffA);
        if (wr == 1) PG8_BAR;
        PG8_WAIT_V(4); PG8_BAR;
        PG8_STAGE(PG8_SB(1, 0), cB + kstep, voffB); PG8_STAGE(PG8_SA(1, 0), cA + kstep, voffA); PG8_STAGE(PG8_SB(1, 1), cB + hstep + kstep, voffB);
        PG8_WAIT_V(6); PG8_BAR;
    }
    for (;;) {
        const bool has_next = S.next(ui + 1, nxt);
        const char* nA = has_next ? (const char*)g.A + (size_t)nxt.pm * tstep : cA; const char* nB = has_next ? (const char*)g.Bt + (size_t)nxt.pn * tstep : cB;
        for (int t = 0; t < nt; t += 2) {
            const bool last = (t == nt - 2);
            const char* a1 = cA + (size_t)(t + 1) * kstep;
            const char* a2 = last ? nA : cA + (size_t)(t + 2) * kstep; const char* b2 = last ? nB : cB + (size_t)(t + 2) * kstep;
            const char* a3 = a2 + kstep; const char* b3 = b2 + kstep;
            if (last && has_next) S.a_ready(nxt);
            if constexpr (SP2) {
            PG8_LDB(B0, 0, 0); PG8_LDB(B1, 0, 1); PG8_SCHED; PG8_LDA(At, 0, 0); PG8_STAGE(PG8_SA(1, 1), a1 + hstep, voffA);
            PG8_WAIT_V(8); PG8_WAIT_L(0); PG8_BAR; PG8_MMA(0, 0, At, B0); PG8_MMA(0, 1, At, B1); PG8_BAR; PG8_SCHED;
            PG8_LDA(At, 0, 1); PG8_STAGE(PG8_SB(0, 0), b2, voffB); PG8_STAGE(PG8_SB(0, 1), b2 + hstep, voffB); PG8_STAGE(PG8_SA(0, 0), a2, voffA);
            PG8_WAIT_V(8); PG8_WAIT_L(0); PG8_BAR; PG8_MMA(1, 0, At, B0); PG8_MMA(1, 1, At, B1); PG8_BAR; PG8_SCHED;
            PG8_LDB(B0, 1, 0); PG8_LDB(B1, 1, 1); PG8_SCHED; PG8_LDA(At, 1, 0); PG8_STAGE(PG8_SA(0, 1), a2 + hstep, voffA);
            PG8_WAIT_V(8); PG8_WAIT_L(0); PG8_BAR; PG8_MMA(0, 0, At, B0); PG8_MMA(0, 1, At, B1); PG8_BAR; PG8_SCHED;
            PG8_LDA(At, 1, 1); PG8_STAGE(PG8_SB(1, 0), b3, voffB); PG8_STAGE(PG8_SB(1, 1), b3 + hstep, voffB); PG8_STAGE(PG8_SA(1, 0), a3, voffA);
            PG8_WAIT_V(8); PG8_WAIT_L(0); PG8_BAR; PG8_MMA(1, 0, At, B0); PG8_MMA(1, 1, At, B1); PG8_BAR; PG8_SCHED;
            } else {
            PG8_LDB(B0, 0, 0); PG8_SCHED; PG8_LDA(At, 0, 0); PG8_STAGE(PG8_SA(1, 1), a1 + hstep, voffA);
            PG8_WAIT_L(8); PG8_BAR; PG8_WAIT_L(0); PG8_MMA(0, 0, At, B0); PG8_BAR; PG8_SCHED;
            PG8_LDB(B1, 0, 1); PG8_STAGE(PG8_SB(0, 0), b2, voffB);
            PG8_BAR; PG8_WAIT_L(0); PG8_MMA(0, 1, At, B1); PG8_BAR;
            PG8_LDA(At, 0, 1); PG8_STAGE(PG8_SA(0, 0), a2, voffA);
            PG8_BAR; PG8_WAIT_L(0); PG8_MMA(1, 0, At, B0); PG8_BAR; PG8_SCHED;
            PG8_STAGE(PG8_SB(0, 1), b2 + hstep, voffB);
            PG8_WAIT_V(6); PG8_BAR; PG8_MMA(1, 1, At, B1); PG8_BAR;
            PG8_LDB(B0, 1, 0); PG8_SCHED; PG8_LDA(At, 1, 0); PG8_STAGE(PG8_SA(0, 1), a2 + hstep, voffA);
            PG8_WAIT_L(8); PG8_BAR; PG8_WAIT_L(0); PG8_MMA(0, 0, At, B0); PG8_BAR; PG8_SCHED;
            PG8_LDB(B1, 1, 1); PG8_STAGE(PG8_SB(1, 0), b3, voffB);
            PG8_BAR; PG8_WAIT_L(0); PG8_MMA(0, 1, At, B1); PG8_BAR;
            PG8_LDA(At, 1, 1); PG8_STAGE(PG8_SA(1, 0), a3, voffA);
            PG8_BAR; PG8_WAIT_L(0); PG8_MMA(1, 0, At, B0); PG8_BAR; PG8_SCHED;
            PG8_STAGE(PG8_SB(1, 1), b3 + hstep, voffB);
            PG8_WAIT_V(6); PG8_BAR; PG8_MMA(1, 1, At, B1); PG8_BAR;
            }
        }
        if constexpr (ALIGN_EPI) { if (wr == 0) PG8_BAR; }
        if constexpr (!Epi::AFTER_DRAIN) { E(acc, cur, wr, wc, fr, fq); S.done(cur); }
        if (!has_next) break;
#pragma unroll
        for (int a = 0; a < 2; ++a)
#pragma unroll
            for (int b = 0; b < 2; ++b)
#pragma unroll
                for (int m = 0; m < 4; ++m)
#pragma unroll
                    for (int n = 0; n < 2; ++n) acc[a][b][m][n] = (f32x4){0.f, 0.f, 0.f, 0.f};
        cur = nxt; cA = nA; cB = nB; ++ui;
        if constexpr (ALIGN_EPI) { if (wr == 1) PG8_BAR; }
    }
    PG8_WAIT_V(0);
    if constexpr (!ALIGN_EPI) { if (wr == 0) PG8_BAR; }
    PG8_BAR;
    if constexpr (Epi::AFTER_DRAIN) { E.fused(acc, cur, wr, wc, fr, fq, lds, wid, lane); S.done(cur); }
#undef PG8_SA
#undef PG8_SB
#undef PG8_STAGE
#undef PG8_LDA
#undef PG8_LDB
#undef PG8_MMA
#undef PG8_WAIT_V
#undef PG8_WAIT_L
#undef PG8_BAR
#undef PG8_SCHED
}
}
#ifndef HD
#define HD __host__ __device__ __forceinline__
#endif
HD int tk_map(float f) { int b = __builtin_bit_cast(int, f); return b ^ ((b >> 31) & 0x7fffffff); }
HD float tk_unmap(int k) { int b = k ^ ((k >> 31) & 0x7fffffff); return __builtin_bit_cast(float, b); }
HD void tk_cx(int& a, int& b) { const int hi = a > b ? a : b, lo = a > b ? b : a; a = hi; b = lo; }
template <int N> HD void tk_sort_desc(int (&v)[N]) {
#pragma unroll
    for (int k = 2; k <= N; k <<= 1)
#pragma unroll
        for (int j = k >> 1; j > 0; j >>= 1)
#pragma unroll
            for (int i = 0; i < N; ++i) { const int l = i ^ j; if (l > i) { if ((i & k) == 0) tk_cx(v[i], v[l]); else tk_cx(v[l], v[i]); } }
}
template <int N> HD void tk_merge_top(int (&a)[N], const int (&b)[N]) {
#pragma unroll
    for (int i = 0; i < N; ++i) a[i] = a[i] > b[N - 1 - i] ? a[i] : b[N - 1 - i];
#pragma unroll
    for (int j = N >> 1; j > 0; j >>= 1)
#pragma unroll
        for (int i = 0; i < N; ++i) { const int l = i ^ j; if (l > i) tk_cx(a[i], a[l]); }
}
template <int NCH, class FP> HD void tk_stage1(FP s, int n_base, int (&best)[16]) {
#pragma unroll
    for (int c = 0; c < NCH; ++c) {
        int x[16];
#pragma unroll
        for (int e = 0; e < 16; ++e) x[e] = (tk_map(s[c * 16 + e]) & ~127) | (127 - (n_base + c * 16 + e));
        tk_sort_desc(x);
        if (c == 0) {
#pragma unroll
            for (int e = 0; e < 16; ++e) best[e] = x[e];
        } else tk_merge_top(best, x);
    }
}
template <class IP, class OI, class OG> HD void tk_stage2(int (&a)[16], int (&b)[16], IP AB, OI out_idx, OG out_g, float vscale = 1.0f) {
    float va[16], vb[16];
#pragma unroll
    for (int i = 0; i < 16; ++i) { AB[i] = a[i]; AB[16 + i] = b[i]; va[i] = tk_unmap(a[i] & ~127); vb[i] = tk_unmap(b[i] & ~127); }
    int best[16];
#pragma unroll
    for (int c = 0; c < 4; ++c) {
        int x[16];
#pragma unroll
        for (int e = 0; e < 16; ++e) x[e] = (int)0x80000000;
        int n = 0;
#pragma unroll
        for (int i = 0; i < 16; ++i)
#pragma unroll
            for (int j = 0; j < 16; ++j)
                if ((i + 1) * (j + 1) <= 16) { if (n >= 16 * c && n < 16 * c + 16) x[n - 16 * c] = (tk_map(va[i] + vb[j]) & ~255) | (255 - (i * 16 + j)); ++n; }
        tk_sort_desc(x);
        if (c == 0) {
#pragma unroll
            for (int e = 0; e < 16; ++e) best[e] = x[e];
        } else tk_merge_top(best, x);
    }
    int ka[16], kb[16];
#pragma unroll
    for (int k = 0; k < 16; ++k) { const int flat = 255 - (best[k] & 255); ka[k] = AB[flat >> 4]; kb[k] = AB[16 + (flat & 15)]; }
    float sv[16]; int ei[16]; float sum = 0.f;
#pragma unroll
    for (int k = 0; k < 16; ++k) { ei[k] = (127 - (ka[k] & 127)) * 128 + (127 - (kb[k] & 127)); sv[k] = (tk_unmap(ka[k] & ~127) + tk_unmap(kb[k] & ~127)) * vscale; }
    const float m = sv[0];
#pragma unroll
    for (int k = 0; k < 16; ++k) { sv[k] = __expf(sv[k] - m); sum += sv[k]; }
    const float inv = 1.0f / sum;
#pragma unroll
    for (int k = 0; k < 16; ++k) { out_idx[k] = ei[k]; out_g[k] = sv[k] * inv; }
}
constexpr int NWAVES = 8, NTHR = 512;
constexpr int BATCH = 2, SEQ = 8192, D = 1024, M = BATCH * SEQ, DEPTH = 4;
constexpr int NH = 16, HDIM = 64, GRIDW = 64, NROWS = 128;
constexpr float RMS_EPS = 1e-6f;
#ifndef MK_N_LAUNCHES
#define MK_N_LAUNCHES 1
#endif
#ifndef NAIVE_ATTN
#define NAIVE_ATTN 0
#endif
#ifndef NAIVE_TOPK
#define NAIVE_TOPK 0
#endif
#ifndef EXPERT_FP4
#define EXPERT_FP4 1
#endif
constexpr int ROWB = EXPERT_FP4 ? 512 : 1024;
#ifndef PROBE_GMODE
#define PROBE_GMODE 0
#endif
#ifndef PROBE_PMODE
#define PROBE_PMODE 0
#endif
#ifndef PROBE_LMASK
#define PROBE_LMASK 15
#endif
#ifndef PROBE_REP
#define PROBE_REP -1
#endif
constexpr int PH_PER_LAYER = 7, N_PHASES = 1 + DEPTH * PH_PER_LAYER;

constexpr size_t MiB = 1u << 20;
constexpr size_t WS_CTL = 0, CTL_ZERO_BYTES = 32 * 1024;
constexpr size_t WS_WQK = 2 * MiB;
constexpr size_t WS_WV = 10 * MiB;
constexpr size_t WS_WO = 14 * MiB;
constexpr size_t WS_WIN = 18 * MiB;
constexpr size_t WS_WOUT = 30 * MiB;
constexpr size_t WS_WP = 34 * MiB;
constexpr size_t WS_H = 64 * MiB;
constexpr size_t WS_HN = 128 * MiB;
constexpr size_t WS_BIG = 160 * MiB;
constexpr size_t WS_VT = 224 * MiB;
constexpr size_t WS_MIX = 256 * MiB;
constexpr size_t WS_SELI = 288 * MiB;
constexpr size_t WS_SELG = 296 * MiB;
constexpr size_t WS_UP = 320 * MiB;
constexpr size_t WS_DN = 384 * MiB;
constexpr size_t WS_SUP = 448 * MiB;
constexpr size_t WS_RSS = 450 * MiB;
constexpr size_t WS_SC = 576 * MiB;
constexpr size_t WS_END = 704 * MiB;
constexpr int CW_BAR = 4096;
static_assert((CW_BAR + 3456) * 4 <= (int)CTL_ZERO_BYTES, "barrier words inside the per-call memset");

constexpr int LDS_BYTES = 163840, MISC_OFF = LDS_BYTES - 256, PTAB_OFF = LDS_BYTES - 512;

#define LAS __attribute__((address_space(3)))
typedef unsigned short bf16;
typedef unsigned v4u __attribute__((ext_vector_type(4)));
typedef unsigned v2u __attribute__((ext_vector_type(2)));
typedef float f32x4 __attribute__((ext_vector_type(4)));
typedef short bf16x8 __attribute__((ext_vector_type(8)));
#define LDS_WAIT() asm volatile("s_waitcnt lgkmcnt(0)" ::: "memory")
#define BLOCK_BAR() do { asm volatile("s_waitcnt vmcnt(0) lgkmcnt(0)" ::: "memory"); __builtin_amdgcn_s_barrier(); asm volatile("" ::: "memory"); } while (0)
__device__ __forceinline__ unsigned f2bf(float f) { unsigned u = __builtin_bit_cast(unsigned, f); return (u + 0x7fffu + ((u >> 16) & 1u)) >> 16; }
typedef float f32x2p __attribute__((ext_vector_type(2))); typedef __bf16 bf16x2p __attribute__((ext_vector_type(2)));
__device__ __forceinline__ unsigned pk2(float lo, float hi) { const f32x2p v = {lo, hi}; return __builtin_bit_cast(unsigned, __builtin_convertvector(v, bf16x2p)); }
__device__ __forceinline__ float bflo(unsigned u) { return __builtin_bit_cast(float, u << 16); }
__device__ __forceinline__ float bfhi(unsigned u) { return __builtin_bit_cast(float, u & 0xffff0000u); }
__device__ __forceinline__ float wave_sum(float v) {
#pragma unroll
    for (int o = 1; o < 64; o <<= 1) v += __shfl_xor(v, o);
    return v;
}

#define XB_TMO      128
#define XB_XCNT(j)  (256  + 64 * (j))
#define XB_XSUB(j)  (1280 + 64 * (j))
#define XB_XGEN(j)  (2304 + 64 * (j))
#define XB_TOP      3328
#define XB_TOPGEN   3392
#define XCD_BAR_WORDS 3456
#define XB_SPIN_CAP (1u << 20)
__device__ __forceinline__ unsigned xb_ld(unsigned* p)              { return __hip_atomic_load(p, __ATOMIC_RELAXED, __HIP_MEMORY_SCOPE_AGENT); }
__device__ __forceinline__ unsigned xb_add(unsigned* p, unsigned v) { return __hip_atomic_fetch_add(p, v, __ATOMIC_RELAXED, __HIP_MEMORY_SCOPE_AGENT); }
__device__ __forceinline__ unsigned xb_xcc_id() { return (unsigned)__builtin_amdgcn_s_getreg((3 << 11) | 20) & 0xFu; }
#define XB_SPIN(cond, bar) do { unsigned _sp = 0; while (cond) { __builtin_amdgcn_s_sleep(1); \
    if ((++_sp & 255u) == 0u) { if (xb_ld(&(bar)[XB_TMO])) break; if (_sp > XB_SPIN_CAP) { atomicAdd(&(bar)[XB_TMO], 1u); break; } } } } while (0)
struct XcdBarrier { unsigned* bar; unsigned x; volatile LAS unsigned* st; };
__device__ __forceinline__ XcdBarrier xcd_barrier_post(unsigned* bar, volatile LAS unsigned* st) {
    XcdBarrier b; b.bar = bar; b.x = xb_xcc_id(); b.st = st;
    if (threadIdx.x == 0) (void)xb_add(&bar[XB_XCNT(b.x)], 1u);
    return b;
}
__device__ __forceinline__ void xcd_barrier_complete(unsigned* bar, unsigned x, unsigned& nloc, unsigned& nx) {
    const unsigned G = gridDim.x * gridDim.y * gridDim.z;
    unsigned sum, cnt, mine, sp = 0u;
    for (;;) {
        sum = 0u; cnt = 0u; mine = 0u;
#pragma unroll
        for (unsigned j = 0; j < 16; ++j) { const unsigned c = xb_ld(&bar[XB_XCNT(j)]); sum += c; cnt += (c > 0u) ? 1u : 0u; mine = (j == x) ? c : mine; }
        if (sum == G) break;
        __builtin_amdgcn_s_sleep(1);
        if ((++sp & 255u) == 0u) { if (xb_ld(&bar[XB_TMO])) break; if (sp > XB_SPIN_CAP) { atomicAdd(&bar[XB_TMO], 1u); break; } }
    }
    nloc = mine > 0u ? mine : 1u; nx = cnt > 0u ? cnt : 1u;
}
__device__ __forceinline__ void xcd_barrier(const XcdBarrier& b) {
    asm volatile("s_waitcnt vmcnt(0)" ::: "memory");
    __syncthreads();
    if (threadIdx.x == 0) {
        unsigned* bar = b.bar;
        __builtin_amdgcn_s_waitcnt(0);
        unsigned nloc = b.st[0], nx = b.st[1];
        if (nloc == 0u) { xcd_barrier_complete(bar, b.x, nloc, nx); b.st[0] = nloc; b.st[1] = nx; }
        const unsigned old = xb_add(&bar[XB_XSUB(b.x)], 1u);
        const unsigned gen = old / nloc;
        if (old + 1u == (gen + 1u) * nloc) {
            __builtin_amdgcn_fence(__ATOMIC_RELEASE, "agent");
            asm volatile("s_waitcnt vmcnt(0)" ::: "memory");
            const unsigned og = xb_add(&bar[XB_TOP], 1u);
            const unsigned tg = og / nx;
            if (og + 1u == (tg + 1u) * nx) xb_add(&bar[XB_TOPGEN], 1u);
            else XB_SPIN(xb_ld(&bar[XB_TOPGEN]) == tg, bar);
            __builtin_amdgcn_fence(__ATOMIC_ACQUIRE, "agent");
            xb_add(&bar[XB_XGEN(b.x)], 1u);
            asm volatile("s_waitcnt vmcnt(0)" ::: "memory");
        } else {
            XB_SPIN(xb_ld(&bar[XB_XGEN(b.x)]) == gen, bar);
            __builtin_amdgcn_fence(__ATOMIC_ACQUIRE, "agent");
            asm volatile("s_waitcnt vmcnt(0)" ::: "memory");
        }
    }
    __syncthreads();
}

struct Frame {
    LAS unsigned char* lds;
    int tid, lane, wave, vcu, G;
    unsigned char* ws;
    __device__ __forceinline__ const float* in(int i) const {
        const volatile LAS unsigned* t = (const volatile LAS unsigned*)(lds + PTAB_OFF);
        const unsigned lo = __builtin_amdgcn_readfirstlane(t[2 * i]), hi = __builtin_amdgcn_readfirstlane(t[2 * i + 1]);
        return (const float*)(const __attribute__((address_space(1))) float*)(((unsigned long long)hi << 32) | lo);
    }
    __device__ __forceinline__ float* out() const { return (float*)in(14); }
};

template <bool FIRST> struct EpiRes {
    static constexpr bool PERM = false, AFTER_DRAIN = false;
    const void* hin; bf16* h; float* rss;
    __device__ __forceinline__ void operator()(const pg8::f32x4 (&acc)[2][2][4][2], const pg8::Unit& u, int wr, int wc, int fr, int fq) const {
        const int col0 = u.pn * 256 + wc * 32 + 4 * fq;
#pragma unroll
        for (int ai = 0; ai < 2; ++ai)
#pragma unroll
            for (int m = 0; m < 4; ++m) { const int row = u.pm * 256 + ai * 128 + wr * 64 + m * 16 + fr; bf16* rowp = h + (size_t)row * D + col0;
                float ss = 0.f;
#pragma unroll
                for (int bj = 0; bj < 2; ++bj)
#pragma unroll
                    for (int n = 0; n < 2; ++n) { f32x4 v;
                        if (FIRST) v = *(const f32x4*)((const float*)hin + (size_t)row * D + col0 + bj * 128 + n * 16);
                        else { const v2u hw = *(const v2u*)((const bf16*)hin + (size_t)row * D + col0 + bj * 128 + n * 16); v = (f32x4){bflo(hw.x), bfhi(hw.x), bflo(hw.y), bfhi(hw.y)}; }
                        v += acc[ai][bj][m][n];
                        ss += (v.x * v.x + v.y * v.y) + (v.z * v.z + v.w * v.w);
                        v2u w; w.x = pk2(v.x, v.y); w.y = pk2(v.z, v.w); *(v2u*)(rowp + bj * 128 + n * 16) = w; }
                ss += __shfl_xor(ss, 16); ss += __shfl_xor(ss, 32);
                if (fq == 0) rss[(size_t)row * 16 + u.pn * 4 + wc] = ss; }
    }
};
struct EpiConvIn {
    static constexpr bool PERM = true, AFTER_DRAIN = false;
    bf16* U; bf16* GB;
    __device__ __forceinline__ void operator()(const pg8::f32x4 (&acc)[2][2][4][2], const pg8::Unit& u, int wr, int wc, int fr, int fq) const {
        const int row0 = u.pm * 256 + wr * 64 + fr;
        if (u.pn < 8) {
            const int ch0 = u.pn * 128 + wc * 32 + 8 * fq;
#pragma unroll
            for (int ai = 0; ai < 2; ++ai)
#pragma unroll
                for (int m = 0; m < 4; ++m) { const f32x4 p0 = acc[ai][0][m][0] * acc[ai][1][m][0], p1 = acc[ai][0][m][1] * acc[ai][1][m][1];
                    v4u w; w.x = pk2(p0[0], p0[1]); w.y = pk2(p0[2], p0[3]); w.z = pk2(p1[0], p1[1]); w.w = pk2(p1[2], p1[3]);
                    *(v4u*)(U + (size_t)(row0 + ai * 128 + m * 16) * D + ch0) = w; }
        } else {
            const int col0 = (u.pn - 8) * 256 + wc * 32 + 8 * fq;
#pragma unroll
            for (int ai = 0; ai < 2; ++ai)
#pragma unroll
                for (int m = 0; m < 4; ++m)
#pragma unroll
                    for (int bj = 0; bj < 2; ++bj) { const f32x4 v0 = acc[ai][bj][m][0], v1 = acc[ai][bj][m][1];
                        v4u w; w.x = pk2(v0[0], v0[1]); w.y = pk2(v0[2], v0[3]); w.z = pk2(v1[0], v1[1]); w.w = pk2(v1[2], v1[3]);
                        *(v4u*)(GB + (size_t)(row0 + ai * 128 + m * 16) * D + col0 + bj * 128) = w; }
        }
    }
};
struct EpiF32 {
    static constexpr bool PERM = false, AFTER_DRAIN = false;
    float* O; int ldc;
    __device__ __forceinline__ void operator()(const pg8::f32x4 (&acc)[2][2][4][2], const pg8::Unit& u, int wr, int wc, int fr, int fq) const {
        const int col0 = u.pn * 256 + wc * 32 + 4 * fq;
#pragma unroll
        for (int ai = 0; ai < 2; ++ai)
#pragma unroll
            for (int m = 0; m < 4; ++m) { float* rowp = O + (size_t)(u.pm * 256 + ai * 128 + wr * 64 + m * 16 + fr) * ldc + col0;
#pragma unroll
                for (int bj = 0; bj < 2; ++bj)
#pragma unroll
                    for (int n = 0; n < 2; ++n) *(f32x4*)(rowp + bj * 128 + n * 16) = acc[ai][bj][m][n]; }
    }
};
struct EpiTopK {
    static constexpr bool PERM = false, AFTER_DRAIN = true;
    int* seli; float* selg; const float* rss;
    __device__ __forceinline__ void operator()(const pg8::f32x4 (&)[2][2][4][2], const pg8::Unit&, int, int, int, int) const {}
    __device__ __forceinline__ void fused(pg8::f32x4 (&acc)[2][2][4][2], const pg8::Unit& u, int wr, int wc, int fr, int fq, LAS unsigned char* lds, int wid, int lane) const {
        LAS float* S = (LAS float*)lds;
        LAS int* L = (LAS int*)lds;
        const int tid = wid * 64 + lane;
#pragma unroll 1
        for (int ai = 0; ai < 2; ++ai) {
#pragma unroll
            for (int m = 0; m < 4; ++m)
#pragma unroll
                for (int bj = 0; bj < 2; ++bj)
#pragma unroll
                    for (int n = 0; n < 2; ++n) {
                        const int row = wr * 64 + m * 16 + fr, col = bj * 128 + wc * 32 + n * 16 + 4 * fq;
                        *(LAS f32x4*)(S + row * 260 + col) = ai == 0 ? acc[0][bj][m][n] : acc[1][bj][m][n];
                    }
            BLOCK_BAR();
            const int row = tid & 127, q = tid >> 7;
            int best[16];
            {
                const LAS f32x4* sp = (const LAS f32x4*)(S + row * 260 + q * 64);
#pragma unroll
                for (int c = 0; c < 4; ++c) {
                    int x[16];
#pragma unroll
                    for (int e4 = 0; e4 < 4; ++e4) { const f32x4 v = sp[c * 4 + e4];
#pragma unroll
                        for (int e = 0; e < 4; ++e) x[e4 * 4 + e] = (tk_map(v[e]) & ~127) | (127 - ((q & 1) * 64 + c * 16 + e4 * 4 + e)); }
                    tk_sort_desc(x);
                    if (c == 0) {
#pragma unroll
                        for (int e = 0; e < 16; ++e) best[e] = x[e];
                    } else tk_merge_top(best, x);
                }
            }
            BLOCK_BAR();
#pragma unroll
            for (int e4 = 0; e4 < 4; ++e4) *(LAS v4u*)(L + row * 68 + q * 16 + e4 * 4) = (v4u){(unsigned)best[e4 * 4], (unsigned)best[e4 * 4 + 1], (unsigned)best[e4 * 4 + 2], (unsigned)best[e4 * 4 + 3]};
            BLOCK_BAR();
            if (tid < 128) {
                int a[16], b[16], t[16];
                LAS int* Lr = L + tid * 68;
#pragma unroll
                for (int e4 = 0; e4 < 4; ++e4) { const v4u va = *(LAS v4u*)(Lr + e4 * 4), vt = *(LAS v4u*)(Lr + 16 + e4 * 4);
#pragma unroll
                    for (int e = 0; e < 4; ++e) { a[e4 * 4 + e] = (int)va[e]; t[e4 * 4 + e] = (int)vt[e]; } }
                tk_merge_top(a, t);
#pragma unroll
                for (int e4 = 0; e4 < 4; ++e4) { const v4u vb = *(LAS v4u*)(Lr + 32 + e4 * 4), vt = *(LAS v4u*)(Lr + 48 + e4 * 4);
#pragma unroll
                    for (int e = 0; e < 4; ++e) { b[e4 * 4 + e] = (int)vb[e]; t[e4 * 4 + e] = (int)vt[e]; } }
                tk_merge_top(b, t);
                const int trow = u.pm * 256 + ai * 128 + tid;
                const f32x4 q0 = *(const f32x4*)(rss + (size_t)trow * 16), q1 = *(const f32x4*)(rss + (size_t)trow * 16 + 4), q2 = *(const f32x4*)(rss + (size_t)trow * 16 + 8), q3 = *(const f32x4*)(rss + (size_t)trow * 16 + 12);
                const float ssq = (((q0.x + q0.y) + (q0.z + q0.w)) + ((q1.x + q1.y) + (q1.z + q1.w))) + (((q2.x + q2.y) + (q2.z + q2.w)) + ((q3.x + q3.y) + (q3.z + q3.w)));
                const float rstd = 1.0f / sqrtf(ssq * (1.f / D) + RMS_EPS);
                const size_t o = ((size_t)trow * 8 + u.pn) * 16;
                tk_stage2(a, b, Lr, (__attribute__((address_space(1))) int*)(seli + o), (__attribute__((address_space(1))) float*)(selg + o), rstd);
            }
            BLOCK_BAR();
        }
    }
};
struct OneUnit {
    pg8::Unit u;
    __device__ __forceinline__ bool next(int i, pg8::Unit& o) const { if (i != 0) return false; o = u; return true; }
    __device__ __forceinline__ void a_ready(const pg8::Unit&) const {}
    __device__ __forceinline__ void done(const pg8::Unit&) const {}
};

__device__ __forceinline__ void p0_transpose_item(const float* W, int ldw, int ncols, bf16* WT, float scale, LAS float* scr, int item, int lane) {
    const int nblk = ncols / 64, kb = item / nblk, nb = item % nblk, k0 = 64 * kb, n0 = 64 * nb;
    f32x4 v[16];
#pragma unroll
    for (int i = 0; i < 16; ++i) v[i] = __builtin_nontemporal_load((const f32x4*)(W + (size_t)(k0 + 4 * i + (lane >> 4)) * ldw + n0 + 4 * (lane & 15)));
#pragma unroll
    for (int i = 0; i < 16; ++i) { LAS float* p = scr + (4 * i + (lane >> 4)) * 65 + 4 * (lane & 15); p[0] = v[i].x * scale; p[1] = v[i].y * scale; p[2] = v[i].z * scale; p[3] = v[i].w * scale; }
    LDS_WAIT(); asm volatile("" ::: "memory");
    const int c = lane & 7;
#pragma unroll
    for (int j = 0; j < 8; ++j) { const int n = (lane >> 3) + 8 * j; const LAS float* s = scr + (8 * c) * 65 + n;
        v4u o; o.x = pk2(s[0 * 65], s[1 * 65]); o.y = pk2(s[2 * 65], s[3 * 65]); o.z = pk2(s[4 * 65], s[5 * 65]); o.w = pk2(s[6 * 65], s[7 * 65]);
        *(v4u*)(WT + (size_t)(n0 + n) * 1024 + k0 + 8 * c) = o; }
    LDS_WAIT(); asm volatile("" ::: "memory");
}
__device__ __forceinline__ void rms_row_to_bf16(const float* xrow, const float* gain, bf16* orow, float* hcopy, int lane) {
    const f32x4* xr = (const f32x4*)xrow + lane; const f32x4* gr = (const f32x4*)gain + lane;
    f32x4 v[4]; float s = 0.f;
#pragma unroll
    for (int j = 0; j < 4; ++j) { v[j] = xr[64 * j]; s += (v[j].x * v[j].x + v[j].y * v[j].y) + (v[j].z * v[j].z + v[j].w * v[j].w); }
    if (hcopy) {
#pragma unroll
        for (int j = 0; j < 4; ++j) ((f32x4*)hcopy + lane)[64 * j] = v[j];
    }
    const float rstd = 1.0f / sqrtf(wave_sum(s) * (1.f / D) + RMS_EPS);
    unsigned long long* o8 = (unsigned long long*)orow + lane;
#pragma unroll
    for (int j = 0; j < 4; ++j) { const f32x4 g = gr[64 * j]; const f32x4 y = v[j] * rstd * g;
        o8[64 * j] = (unsigned long long)pk2(y.x, y.y) | ((unsigned long long)pk2(y.z, y.w) << 32); }
}
__device__ __forceinline__ void p0_prologue(Frame& F, bool dry) {
    if (!(dry && PROBE_PMODE == 1)) {
        LAS float* KL = (LAS float*)F.lds;
        LAS float* WL = (LAS float*)(F.lds + 128 * 132 * 4);
        const float* in10 = F.in(10); const float* in11 = F.in(11); const float* in2 = F.in(2);
        f32x4 kreg[8], wreg[4];
#define FOLD_LOAD(it_) do { const int l_ = (it_) >> 8, hp_ = ((it_) >> 4) & 15, k0_ = ((it_) & 15) * 64; \
            const float* kg_ = in11 + (size_t)(l_ * 16 + hp_) * 128 * 128; const float* wg_ = in10 + (size_t)l_ * 1024 * 2048 + (size_t)k0_ * 2048 + hp_ * 128; \
            _Pragma("unroll") for (int i = 0; i < 8; ++i) kreg[i] = *(const f32x4*)(kg_ + 4 * (F.tid + 512 * i)); \
            _Pragma("unroll") for (int i = 0; i < 4; ++i) { const int e = 4 * (F.tid + 512 * i); wreg[i] = __builtin_nontemporal_load((const f32x4*)(wg_ + (size_t)(e >> 7) * 2048 + (e & 127))); } } while (0)
        if (F.vcu < DEPTH * 16 * 16) FOLD_LOAD(F.vcu);
        for (int it = F.vcu; it < DEPTH * 16 * 16; it += F.G) {
            const int l = it >> 8, hp = (it >> 4) & 15, k0 = (it & 15) * 64;
#pragma unroll
            for (int i = 0; i < 8; ++i) { const int e = 4 * (F.tid + 512 * i), n = e >> 7, d = e & 127; *(LAS f32x4*)(KL + n * 132 + d) = kreg[i]; }
#pragma unroll
            for (int i = 0; i < 4; ++i) { const int e = 4 * (F.tid + 512 * i), kk = e >> 7, d = e & 127; *(LAS f32x4*)(WL + kk * 132 + d) = wreg[i]; }
            if (it + F.G < DEPTH * 16 * 16) FOLD_LOAD(it + F.G);
            BLOCK_BAR();
            {
                const int i16 = F.lane & 15, g4 = F.lane >> 4, nt = F.wave;
                f32x4 facc[4];
#pragma unroll
                for (int mt = 0; mt < 4; ++mt) facc[mt] = (f32x4){0.f, 0.f, 0.f, 0.f};
#pragma unroll 2
                for (int s8 = 0; s8 < 8; ++s8) {
                    const f32x4 bq = *(const LAS f32x4*)(KL + (nt * 16 + i16) * 132 + 16 * s8 + 4 * g4);
                    f32x4 aq[4];
#pragma unroll
                    for (int mt = 0; mt < 4; ++mt) aq[mt] = *(const LAS f32x4*)(WL + (mt * 16 + i16) * 132 + 16 * s8 + 4 * g4);
#pragma unroll
                    for (int t = 0; t < 4; ++t)
#pragma unroll
                        for (int mt = 0; mt < 4; ++mt) facc[mt] = __builtin_amdgcn_mfma_f32_16x16x4f32(aq[mt][t], bq[t], facc[mt], 0, 0, 0);
                }
                bf16* o = (bf16*)(F.ws + WS_WP) + (size_t)l * 2048 * 1024 + (size_t)(hp * 128 + nt * 16 + i16) * 1024 + k0 + 4 * g4;
#pragma unroll
                for (int mt = 0; mt < 4; ++mt) { const f32x4 gf = *(const f32x4*)(in2 + (size_t)l * D + k0 + mt * 16 + 4 * g4); v2u w; w.x = pk2(facc[mt][0] * gf.x, facc[mt][1] * gf.y); w.y = pk2(facc[mt][2] * gf.z, facc[mt][3] * gf.w); *(v2u*)(o + mt * 16) = w; }
            }
            BLOCK_BAR();
        }
#undef FOLD_LOAD
    }
    LAS float* scr = (LAS float*)(F.lds + F.wave * 16640);
    const int gw = F.vcu * NWAVES + F.wave, NGW = F.G * NWAVES;
    constexpr int I_SQ = 16 * 16, I_IN = 16 * 48, PER_J = 3 * I_SQ + I_SQ + I_IN + I_SQ;
    if (!(dry && PROBE_PMODE == 2)) for (int it = gw; it < 2 * PER_J; it += NGW) {
        const int j = it / PER_J; int r = it % PER_J;
        const float* wqkv = F.in(4) + (size_t)j * 1024 * 3072;
        if (r < I_SQ) { p0_transpose_item(wqkv, 3072, 1024, (bf16*)(F.ws + WS_WQK) + (size_t)j * 2048 * 1024, 0.125f, scr, r, F.lane); continue; } r -= I_SQ;
        if (r < I_SQ) { p0_transpose_item(wqkv + 1024, 3072, 1024, (bf16*)(F.ws + WS_WQK) + (size_t)j * 2048 * 1024 + (size_t)1024 * 1024, 1.f, scr, r, F.lane); continue; } r -= I_SQ;
        if (r < I_SQ) { p0_transpose_item(wqkv + 2048, 3072, 1024, (bf16*)(F.ws + WS_WV) + (size_t)j * 1024 * 1024, 1.f, scr, r, F.lane); continue; } r -= I_SQ;
        if (r < I_SQ) { p0_transpose_item(F.in(5) + (size_t)j * 1024 * 1024, 1024, 1024, (bf16*)(F.ws + WS_WO) + (size_t)j * 1024 * 1024, 1.f, scr, r, F.lane); continue; } r -= I_SQ;
        if (r < I_IN) {
            const float* win = F.in(7) + (size_t)j * 1024 * 3072; bf16* wt = (bf16*)(F.ws + WS_WIN) + (size_t)j * 3072 * 1024;
            if (r < 512) { const int blk = r >> 5, pn = blk >> 1, which = blk & 1; p0_transpose_item(win + (which ? 2048 : 1024) + 128 * pn, 3072, 128, wt + (size_t)(256 * pn + 128 * which) * 1024, 1.f, scr, r & 31, F.lane); }
            else p0_transpose_item(win, 3072, 1024, wt + (size_t)2048 * 1024, 1.f, scr, r - 512, F.lane);
            continue; } r -= I_IN;
        p0_transpose_item(F.in(9) + (size_t)j * 1024 * 1024, 1024, 1024, (bf16*)(F.ws + WS_WOUT) + (size_t)j * 1024 * 1024, 1.f, scr, r, F.lane);
    }
    if (!(dry && PROBE_PMODE == 3)) {
        constexpr int NROW = DEPTH * 16384;
        const float* in12 = F.in(12); const float* in13 = F.in(13);
#define XC_LOAD(v, r0_) do { const int tb_ = (r0_) >= NROW ? 1 : 0, rr_ = (r0_) - tb_ * NROW; const float* src_ = (tb_ ? in13 : in12) + (size_t)rr_ * 1024 + 4 * F.lane; \
            _Pragma("unroll") for (int u = 0; u < 4; ++u) _Pragma("unroll") for (int i = 0; i < 4; ++i) v[u][i] = __builtin_nontemporal_load((const f32x4*)(src_ + (size_t)u * 1024 + 256 * i)); } while (0)
#if EXPERT_FP4
#define XC_PACK(v, u, q, dstp) do { v2u w_; _Pragma("unroll") for (int jj = 0; jj < 2; ++jj) { unsigned t_ = 0u; \
                    t_ = __builtin_amdgcn_cvt_scalef32_pk_fp4_f32(t_, v[u][2 * jj].x * q, v[u][2 * jj].y * q, 1.0f, 0); t_ = __builtin_amdgcn_cvt_scalef32_pk_fp4_f32(t_, v[u][2 * jj].z * q, v[u][2 * jj].w * q, 1.0f, 1); \
                    t_ = __builtin_amdgcn_cvt_scalef32_pk_fp4_f32(t_, v[u][2 * jj + 1].x * q, v[u][2 * jj + 1].y * q, 1.0f, 2); t_ = __builtin_amdgcn_cvt_scalef32_pk_fp4_f32(t_, v[u][2 * jj + 1].z * q, v[u][2 * jj + 1].w * q, 1.0f, 3); w_[jj] = t_; } \
                *(v2u*)(dstp) = w_; } while (0)
        constexpr float QMAX = 6.0f;
#else
#define XC_PACK(v, u, q, dstp) do { v4u w_; _Pragma("unroll") for (int i = 0; i < 4; ++i) { unsigned t_ = 0u; t_ = __builtin_amdgcn_cvt_pk_fp8_f32(v[u][i].x * q, v[u][i].y * q, t_, false); t_ = __builtin_amdgcn_cvt_pk_fp8_f32(v[u][i].z * q, v[u][i].w * q, t_, true); w_[i] = t_; } \
                *(v4u*)(dstp) = w_; } while (0)
        constexpr float QMAX = 256.0f;
#endif
#define XC_I4(x_) ((unsigned)__float2int_rn(x_) & 15u)
#define XC_PACK_I4(v, u, q, dstp) do { v2u w_; _Pragma("unroll") for (int jj = 0; jj < 2; ++jj) { const f32x4 a_ = v[u][2 * jj] * q, b_ = v[u][2 * jj + 1] * q; \
                    w_[jj] = XC_I4(a_.x) | (XC_I4(a_.y) << 4) | (XC_I4(a_.z) << 8) | (XC_I4(a_.w) << 12) | (XC_I4(b_.x) << 16) | (XC_I4(b_.y) << 20) | (XC_I4(b_.z) << 24) | (XC_I4(b_.w) << 28); } \
                *(v2u*)(dstp) = w_; } while (0)
#define XC_CONV(v, r0_) do { const int tb_ = (r0_) >= NROW ? 1 : 0, rr_ = (r0_) - tb_ * NROW; \
            unsigned char* dst_ = F.ws + (tb_ ? WS_DN : WS_UP) + (size_t)rr_ * ROWB + (ROWB / 64) * F.lane; float* sc_ = (float*)(F.ws + WS_SUP) + 2 * (size_t)rr_ + tb_; \
            _Pragma("unroll") for (int u = 0; u < 4; ++u) { float mx = 0.f; \
                _Pragma("unroll") for (int i = 0; i < 4; ++i) mx = fmaxf(fmaxf(mx, fmaxf(fabsf(v[u][i].x), fabsf(v[u][i].y))), fmaxf(fabsf(v[u][i].z), fabsf(v[u][i].w))); \
                _Pragma("unroll") for (int o = 1; o < 64; o <<= 1) mx = fmaxf(mx, __shfl_xor(mx, o)); \
                if (tb_) { const float q = mx > 0.f ? 7.0f / mx : 1.0f; XC_PACK_I4(v, u, q, dst_ + (size_t)u * ROWB); if (F.lane == 0) sc_[2 * u] = mx > 0.f ? mx * (1.0f / 7.0f) : 1.0f; } \
                else { const float q = mx > 0.f ? QMAX / mx : 1.0f; XC_PACK(v, u, q, dst_ + (size_t)u * ROWB); if (F.lane == 0) sc_[2 * u] = mx > 0.f ? mx * (1.0f / QMAX) : 1.0f; } } } while (0)
        const int stepr = NGW * 4;
        f32x4 va[4][4], vb[4][4];
        int r0 = gw * 4;
        if (r0 < 2 * NROW) XC_LOAD(va, r0);
#pragma unroll 1
        for (; r0 < 2 * NROW; r0 += 2 * stepr) {
            if (r0 + stepr < 2 * NROW) XC_LOAD(vb, r0 + stepr);
            XC_CONV(va, r0);
            if (r0 + 2 * stepr < 2 * NROW) XC_LOAD(va, r0 + 2 * stepr);
            if (r0 + stepr < 2 * NROW) XC_CONV(vb, r0 + stepr);
        }
#undef XC_LOAD
#undef XC_PACK
#undef XC_PACK_I4
#undef XC_I4
#undef XC_CONV
    }
    if (!(dry && PROBE_PMODE == 4)) {
        const float* x0 = F.in(0); const f32x4* gr = (const f32x4*)F.in(1) + F.lane;
        f32x4 gq[4];
#pragma unroll
        for (int j = 0; j < 4; ++j) gq[j] = gr[64 * j];
#pragma unroll 1
        for (int m0 = gw; m0 < M; m0 += 4 * NGW) {
            f32x4 v[4][4];
#pragma unroll
            for (int u = 0; u < 4; ++u) { const int m = m0 + u * NGW; if (m < M) {
#pragma unroll
                for (int j = 0; j < 4; ++j) v[u][j] = __builtin_nontemporal_load((const f32x4*)(x0 + (size_t)m * D) + F.lane + 64 * j); } }
#pragma unroll
            for (int u = 0; u < 4; ++u) { const int m = m0 + u * NGW; if (m < M) {
                float sq = 0.f;
#pragma unroll
                for (int j = 0; j < 4; ++j) { sq += (v[u][j].x * v[u][j].x + v[u][j].y * v[u][j].y) + (v[u][j].z * v[u][j].z + v[u][j].w * v[u][j].w); }
                const float rstd = 1.0f / sqrtf(wave_sum(sq) * (1.f / D) + RMS_EPS);
                unsigned long long* o8 = (unsigned long long*)((bf16*)(F.ws + WS_HN) + (size_t)m * D) + F.lane;
#pragma unroll
                for (int j = 0; j < 4; ++j) { const f32x4 y = v[u][j] * rstd * gq[j]; o8[64 * j] = (unsigned long long)pk2(y.x, y.y) | ((unsigned long long)pk2(y.z, y.w) << 32); } } }
        }
    }
}

__device__ __forceinline__ void conv_phase(Frame& F, int j) {
    const bf16* U = (const bf16*)(F.ws + WS_BIG); const bf16* GB = (const bf16*)(F.ws + WS_BIG + 32 * MiB); bf16* mix = (bf16*)(F.ws + WS_MIX);
    const float* wc = F.in(8) + (size_t)j * 3 * 1024;
    for (int idx = F.vcu * NTHR + F.tid; idx < M * 128; idx += F.G * NTHR) {
        const int t = idx >> 7, c8 = (idx & 127) * 8, s = t & (SEQ - 1);
        const v4u gb = *(const v4u*)(GB + (size_t)t * D + c8);
        float conv[8];
#pragma unroll
        for (int e = 0; e < 8; ++e) conv[e] = 0.f;
#pragma unroll
        for (int dj = -1; dj <= 1; ++dj) {
            if (s + dj >= 0 && s + dj < SEQ) {
                const v4u uu = *(const v4u*)(U + (size_t)(t + dj) * D + c8);
                const f32x4 w0 = *(const f32x4*)(wc + (dj + 1) * 1024 + c8), w1 = *(const f32x4*)(wc + (dj + 1) * 1024 + c8 + 4);
#pragma unroll
                for (int e2 = 0; e2 < 4; ++e2) {
                    const float wl = e2 < 2 ? w0[2 * e2] : w1[2 * e2 - 4], wh = e2 < 2 ? w0[2 * e2 + 1] : w1[2 * e2 - 3];
                    conv[2 * e2] += wl * bflo(uu[e2]); conv[2 * e2 + 1] += wh * bfhi(uu[e2]);
                }
            }
        }
        v4u o;
#pragma unroll
        for (int e2 = 0; e2 < 4; ++e2) o[e2] = pk2(bflo(gb[e2]) * conv[2 * e2], bfhi(gb[e2]) * conv[2 * e2 + 1]);
        *(v4u*)(mix + (size_t)t * 1024 + c8) = o;
    }
}

constexpr int AT_KSTR = 144, AT_VSTR = 1168, AT_KOFF = 0, AT_VOFF = 576 * AT_KSTR, AT_BOFF = AT_VOFF + 64 * AT_VSTR;
static_assert(AT_BOFF + 1860 <= PTAB_OFF, "attention LDS map");
__device__ __forceinline__ void attn_phase(Frame& F, int j) {
    const bf16* QK = (const bf16*)(F.ws + WS_BIG); const bf16* VT = (const bf16*)(F.ws + WS_VT); bf16* mix = (bf16*)(F.ws + WS_MIX);
    const float* biasl = F.in(6) + (size_t)j * NH * 15 * 31;
    const int lane = F.lane, q = lane & 15, g = lane >> 4, tid = F.tid;
    LAS unsigned char* KL = F.lds + AT_KOFF; LAS unsigned char* VL = F.lds + AT_VOFF; LAS float* btab = (LAS float*)(F.lds + AT_BOFF);
    v4u kreg[9], vreg[9];
    int cur_hh = -1;
#define AT_DECODE(it, b_, hh_, r0_, R0_) const int hh_ = (it) & 15, rp_##it = ((it) >> 4) & 63, b_ = (it) >> 10, r0_ = 2 * rp_##it; int R0_ = r0_ - 4; R0_ = R0_ < 0 ? 0 : (R0_ > NROWS - 8 ? NROWS - 8 : R0_);
#define AT_PREFETCH(it) do { AT_DECODE(it, pb, phh, pr0, pR0) \
        _Pragma("unroll") for (int i = 0; i < 9; ++i) { const int c = tid + 512 * i; \
            { const int key = c >> 3, ch = c & 7; int row = pR0 + (key >> 6); row = row > NROWS - 1 ? NROWS - 1 : row; \
              kreg[i] = *(const v4u*)(QK + ((size_t)pb * SEQ + row * 64 + (key & 63)) * 2048 + 1024 + phh * 64 + ch * 8); } \
            { const int d = c / 72, kch = c - d * 72; vreg[i] = *(const v4u*)(VT + (size_t)(phh * 64 + d) * M + (size_t)pb * SEQ + pR0 * 64 + kch * 8); } } } while (0)
    int it = F.vcu;
    if (it < 2048) AT_PREFETCH(it);
    for (; it < 2048; it += F.G) {
        AT_DECODE(it, b, hh, r0, R0)
        BLOCK_BAR();
#pragma unroll
        for (int i = 0; i < 9; ++i) { const int c = tid + 512 * i;
            *(LAS v4u*)(KL + (c >> 3) * AT_KSTR + (c & 7) * 16) = kreg[i];
            const int d = c / 72, kch = c - d * 72; *(LAS v4u*)(VL + d * AT_VSTR + kch * 16) = vreg[i]; }
        if (hh != cur_hh) { if (tid < 465) btab[tid] = biasl[(size_t)hh * 465 + tid]; cur_hh = hh; }
        BLOCK_BAR();
        const int r = r0 + (F.wave >> 2), jb = F.wave & 3;
        int rs = r - 4; rs = rs < 0 ? 0 : (rs > NROWS - 8 ? NROWS - 8 : rs);
        const int lr0 = rs - R0;
        int bs = 16 * jb - 8; bs = bs < 0 ? 0 : (bs > 32 ? 32 : bs);
        const int qc = 16 * jb + q; int wst = qc - 8; wst = wst < 0 ? 0 : (wst > 48 ? 48 : wst);
        const size_t tokq = (size_t)b * SEQ + r * 64 + qc;
        bf16x8 qf[2];
#pragma unroll
        for (int ks = 0; ks < 2; ++ks) qf[ks] = *(const bf16x8*)(QK + tokq * 2048 + hh * 64 + ks * 32 + 8 * g);
        f32x4 S[8][2];
        const int kcl_a = 8 * (q >> 2) + (q & 3);
#pragma unroll
        for (int wr = 0; wr < 8; ++wr)
#pragma unroll
            for (int T = 0; T < 2; ++T) {
                const LAS unsigned char* kp = KL + ((lr0 + wr) * 64 + bs + kcl_a + 4 * T) * AT_KSTR + 16 * g;
                const bf16x8 k0 = *(const LAS bf16x8*)kp, k1 = *(const LAS bf16x8*)(kp + 64);
                f32x4 c = (f32x4){0.f, 0.f, 0.f, 0.f};
                c = __builtin_amdgcn_mfma_f32_16x16x32_bf16(k0, qf[0], c, 0, 0, 0);
                c = __builtin_amdgcn_mfma_f32_16x16x32_bf16(k1, qf[1], c, 0, 0, 0);
                S[wr][T] = c;
            }
        float mx = -3.0e38f;
#pragma unroll
        for (int wr = 0; wr < 8; ++wr) {
            const LAS float* brow = btab + (rs + wr - r + 7) * 31;
#pragma unroll
            for (int T = 0; T < 2; ++T)
#pragma unroll
                for (int i = 0; i < 4; ++i) {
                    const int kc = bs + 8 * g + 4 * T + i;
                    int co = kc - qc + 15; co = co < 0 ? 0 : (co > 30 ? 30 : co);
                    const bool valid = (kc >= wst) && (kc < wst + 16);
                    const float v = valid ? S[wr][T][i] + brow[co] : -1e30f;
                    S[wr][T][i] = v; mx = fmaxf(mx, v);
                }
        }
        mx = fmaxf(mx, __shfl_xor(mx, 16)); mx = fmaxf(mx, __shfl_xor(mx, 32));
        float sum = 0.f;
        bf16x8 pf[8];
#pragma unroll
        for (int wr = 0; wr < 8; ++wr) {
            float p[8];
#pragma unroll
            for (int T = 0; T < 2; ++T)
#pragma unroll
                for (int i = 0; i < 4; ++i) { p[4 * T + i] = __expf(S[wr][T][i] - mx); sum += p[4 * T + i]; }
            v4u w; w.x = pk2(p[0], p[1]); w.y = pk2(p[2], p[3]); w.z = pk2(p[4], p[5]); w.w = pk2(p[6], p[7]);
            pf[wr] = __builtin_bit_cast(bf16x8, w);
        }
        sum += __shfl_xor(sum, 16); sum += __shfl_xor(sum, 32);
        if (it + F.G < 2048) { const int nit = it + F.G; AT_PREFETCH(nit); }
        f32x4 O[4];
#pragma unroll
        for (int dt = 0; dt < 4; ++dt) O[dt] = (f32x4){0.f, 0.f, 0.f, 0.f};
#pragma unroll
        for (int wr = 0; wr < 8; ++wr)
#pragma unroll
            for (int dt = 0; dt < 4; ++dt) {
                const bf16x8 vf = *(const LAS bf16x8*)(VL + (dt * 16 + q) * AT_VSTR + ((lr0 + wr) * 64 + bs + 8 * g) * 2);
                O[dt] = __builtin_amdgcn_mfma_f32_16x16x32_bf16(vf, pf[wr], O[dt], 0, 0, 0);
            }
        const float inv = 1.0f / sum;
#pragma unroll
        for (int dt = 0; dt < 4; ++dt) { v2u w; w.x = pk2(O[dt][0] * inv, O[dt][1] * inv); w.y = pk2(O[dt][2] * inv, O[dt][3] * inv);
            *(v2u*)(mix + tokq * 1024 + hh * 64 + dt * 16 + 4 * g) = w; }
    }
#undef AT_DECODE
#undef AT_PREFETCH
    BLOCK_BAR();
}
#if NAIVE_ATTN
__device__ __forceinline__ void attn_naive_phase(Frame& F, int j) {
    const bf16* QK = (const bf16*)(F.ws + WS_BIG); const bf16* VT = (const bf16*)(F.ws + WS_VT); bf16* mix = (bf16*)(F.ws + WS_MIX);
    const float* biasl = F.in(6) + (size_t)j * NH * 15 * 31;
    for (int idx = F.vcu * NTHR + F.tid; idx < M * NH; idx += F.G * NTHR) {
        const int hh = idx & 15, t = idx >> 4, b = t >> 13, s = t & (SEQ - 1), r = s >> 6, qc = s & 63;
        int rs = r - 4; rs = rs < 0 ? 0 : (rs > NROWS - 8 ? NROWS - 8 : rs);
        int wst = qc - 8; wst = wst < 0 ? 0 : (wst > 48 ? 48 : wst);
        float qv[64];
#pragma unroll
        for (int c = 0; c < 8; ++c) { const v4u w = *(const v4u*)(QK + (size_t)t * 2048 + hh * 64 + c * 8);
#pragma unroll
            for (int e = 0; e < 4; ++e) { qv[c * 8 + 2 * e] = bflo(w[e]); qv[c * 8 + 2 * e + 1] = bfhi(w[e]); } }
        float mrun = -3.0e38f, lrun = 0.f, o[64];
#pragma unroll
        for (int d = 0; d < 64; ++d) o[d] = 0.f;
        for (int wr = 0; wr < 8; ++wr)
            for (int kk = 0; kk < 16; ++kk) {
                const int kc = wst + kk; const size_t tk = (size_t)b * SEQ + (rs + wr) * 64 + kc;
                float sd = 0.f;
#pragma unroll
                for (int c = 0; c < 8; ++c) { const v4u w = *(const v4u*)(QK + tk * 2048 + 1024 + hh * 64 + c * 8);
#pragma unroll
                    for (int e = 0; e < 4; ++e) sd += qv[c * 8 + 2 * e] * bflo(w[e]) + qv[c * 8 + 2 * e + 1] * bfhi(w[e]); }
                int co = kc - qc + 15; co = co < 0 ? 0 : (co > 30 ? 30 : co);
                sd += biasl[(size_t)hh * 465 + (rs + wr - r + 7) * 31 + co];
                const float mn = fmaxf(mrun, sd), al = __expf(mrun - mn), p = __expf(sd - mn);
                lrun = lrun * al + p; mrun = mn;
#pragma unroll
                for (int d = 0; d < 64; ++d) o[d] = o[d] * al + p * bflo((unsigned)VT[(size_t)(hh * 64 + d) * M + tk]);
            }
        const float inv = 1.0f / lrun;
#pragma unroll
        for (int c = 0; c < 8; ++c) { v4u w;
#pragma unroll
            for (int e = 0; e < 4; ++e) w[e] = pk2(o[c * 8 + 2 * e] * inv, o[c * 8 + 2 * e + 1] * inv);
            *(v4u*)(mix + (size_t)t * 1024 + hh * 64 + c * 8) = w; }
    }
}
#endif
#if NAIVE_TOPK
__device__ __forceinline__ void select_naive_phase(Frame& F) {
    const float* SC = (const float*)(F.ws + WS_SC); int* seli = (int*)(F.ws + WS_SELI); float* selg = (float*)(F.ws + WS_SELG);
    LAS int* AB = (LAS int*)F.lds + F.tid * 33;
    for (int idx = F.vcu * NTHR + F.tid; idx < M * 8; idx += F.G * NTHR) {
        const float* s = SC + (size_t)idx * 256;
        int a[16], b[16], t[16];
        tk_stage1<4>(s, 0, a); tk_stage1<4>(s + 64, 64, t); tk_merge_top(a, t);
        tk_stage1<4>(s + 128, 0, b); tk_stage1<4>(s + 192, 64, t); tk_merge_top(b, t);
        tk_stage2(a, b, AB, seli + (size_t)idx * 16, selg + (size_t)idx * 16);
    }
}
#endif

__device__ __forceinline__ float gelu_erf(float a) { return 0.5f * a * (1.0f + erff(a * 0.70710678118654752f)); }
typedef float f32x2g __attribute__((ext_vector_type(2)));
#if EXPERT_FP4
typedef v2u rowv;
__device__ __forceinline__ rowv row_load(const unsigned char* T, int e, int lane) { return *(const v2u*)(T + (size_t)e * ROWB + 8 * lane); }
#define ROW_PAIR(r, m) __builtin_amdgcn_cvt_scalef32_pk_f32_fp4((r)[(m) >> 2], 1.0f, (m) & 3)
#else
typedef v4u rowv;
__device__ __forceinline__ rowv row_load(const unsigned char* T, int e, int lane) { return *(const v4u*)(T + (size_t)e * ROWB + 16 * lane); }
#define ROW_PAIR(r, m) __builtin_amdgcn_cvt_pk_f32_fp8((r)[(m) >> 1], ((m) & 1) != 0)
#endif
__device__ __forceinline__ void row_axpy(f32x2g (&out)[8], const rowv d, float ak) {
    const f32x2g a2 = (f32x2g){ak, ak};
    out[0] = __builtin_elementwise_fma(a2, ROW_PAIR(d, 0), out[0]); out[1] = __builtin_elementwise_fma(a2, ROW_PAIR(d, 1), out[1]); out[2] = __builtin_elementwise_fma(a2, ROW_PAIR(d, 2), out[2]); out[3] = __builtin_elementwise_fma(a2, ROW_PAIR(d, 3), out[3]);
    out[4] = __builtin_elementwise_fma(a2, ROW_PAIR(d, 4), out[4]); out[5] = __builtin_elementwise_fma(a2, ROW_PAIR(d, 5), out[5]); out[6] = __builtin_elementwise_fma(a2, ROW_PAIR(d, 6), out[6]); out[7] = __builtin_elementwise_fma(a2, ROW_PAIR(d, 7), out[7]);
}
typedef int v8i_g __attribute__((ext_vector_type(8)));
typedef unsigned char u8x4g __attribute__((ext_vector_type(4)));
#define TR_SHUF(a, b, i0, i1, i2, i3) __builtin_amdgcn_perm((unsigned)(b), (unsigned)(a), (unsigned)((i0) | ((i1) << 8) | ((i2) << 16) | ((i3) << 24)))
__device__ __forceinline__ void tr8_nib(const unsigned (&w)[8], unsigned (&t)[8]) {
    unsigned x[8], y[8];
#pragma unroll
    for (int r = 0; r < 4; ++r) { x[r] = TR_SHUF(w[r], w[r + 4], 0, 1, 4, 5); x[r + 4] = TR_SHUF(w[r], w[r + 4], 2, 3, 6, 7); }
#pragma unroll
    for (int g = 0; g < 2; ++g)
#pragma unroll
        for (int r = 0; r < 2; ++r) { y[4 * g + r] = TR_SHUF(x[4 * g + r], x[4 * g + r + 2], 0, 4, 2, 6); y[4 * g + r + 2] = TR_SHUF(x[4 * g + r], x[4 * g + r + 2], 1, 5, 3, 7); }
#pragma unroll
    for (int p = 0; p < 4; ++p) { const unsigned e = y[2 * p], o = y[2 * p + 1];
        t[2 * p] = (e & 0x0F0F0F0Fu) | ((o << 4) & 0xF0F0F0F0u);
        t[2 * p + 1] = ((e >> 4) & 0x0F0F0F0Fu) | (o & 0xF0F0F0F0u); }
}
__device__ __forceinline__ int sel2(bool hf, int e0, int e1) { return hf ? e1 : e0; }
__device__ __forceinline__ void gather_phase(Frame& F, int layer, bool dry) {
    const unsigned char* UP = F.ws + WS_UP + (size_t)layer * 16384 * ROWB; const unsigned char* DN = F.ws + WS_DN + (size_t)layer * 16384 * ROWB;
    const f32x2g* SC2 = (const f32x2g*)(F.ws + WS_SUP) + (size_t)layer * 16384;
    const float* gain = F.in(2) + (size_t)layer * D; const float* gnext = layer < DEPTH - 1 ? F.in(1) + (size_t)(layer + 1) * D : F.in(3);
    float* outp = F.out();
    const int* seli = (const int*)(F.ws + WS_SELI); const float* selg = (const float*)(F.ws + WS_SELG);
    const bf16* H = (const bf16*)(F.ws + WS_H); bf16* HN = (bf16*)(F.ws + (dry ? WS_SC + 64 * MiB : WS_HN)); bf16* HW = (bf16*)(F.ws + (dry ? WS_SC : WS_H)); if (dry) outp = (float*)(F.ws + WS_SC);
    const int lane = F.lane, gw = F.vcu * NWAVES + F.wave, NGW = F.G * NWAVES;
    const bool b5 = lane & 32, b4 = lane & 16, b3 = lane & 8, b2 = lane & 4;
    constexpr int G_RS = 528, G_RB = 32 * G_RS, G_NSLOT = 4;
    LAS unsigned char* RB = F.lds + F.wave * G_RB;
    LAS float* ACT = (LAS float*)(F.lds + 8 * G_RB + F.wave * (G_NSLOT * 512));
    static_assert(8 * G_RB + 8 * G_NSLOT * 512 + 8 * 1024 <= PTAB_OFF, "gather LDS map");
#pragma unroll 1
    for (int base = gw; base < M; base += G_NSLOT * NGW) {
    LAS unsigned char* X8 = F.lds + 8 * G_RB + 8 * G_NSLOT * 512 + F.wave * 1024;
    const int n16 = lane & 15, g4 = lane >> 4;
    const bool hf = lane >> 5; const int c32 = lane & 31, sg = 2 * c32 + (hf ? 1 : 0);
    v2u nhb[4]; int nidx_lo = 0, nidx_hi = 0; float ng_lo = 0.f, ng_hi = 0.f;
#define TOK_LOAD(t_) do { const bf16* hr_ = H + (size_t)(t_) * D + 4 * sg; _Pragma("unroll") for (int i = 0; i < 4; ++i) nhb[i] = __builtin_nontemporal_load((const v2u*)(hr_ + 256 * i)); \
        nidx_lo = __builtin_nontemporal_load(seli + (size_t)(t_) * 128 + lane); nidx_hi = __builtin_nontemporal_load(seli + (size_t)(t_) * 128 + 64 + lane); ng_lo = __builtin_nontemporal_load(selg + (size_t)(t_) * 128 + lane); ng_hi = __builtin_nontemporal_load(selg + (size_t)(t_) * 128 + 64 + lane); } while (0)
    if (base < M) TOK_LOAD(base);
#pragma unroll 1
    for (int slot = 0; slot < G_NSLOT; ++slot) {
        const int t = base + slot * NGW; if (t >= M) break;
        f32x4 hv[4];
#pragma unroll
        for (int i = 0; i < 4; ++i) { const unsigned w0_ = nhb[i].x, w1_ = nhb[i].y; hv[i] = (f32x4){bflo(w0_), bfhi(w0_), bflo(w1_), bfhi(w1_)}; }
        const int idx_lo = nidx_lo, idx_hi = nidx_hi; const float g_lo = ng_lo, g_hi = ng_hi;
        if (slot + 1 < G_NSLOT && t + NGW < M) TOK_LOAD(t + NGW);
        float ss = 0.f;
#pragma unroll
        for (int i = 0; i < 4; ++i) ss += (hv[i].x * hv[i].x + hv[i].y * hv[i].y) + (hv[i].z * hv[i].z + hv[i].w * hv[i].w);
        const float rstd = 1.0f / sqrtf(wave_sum(ss) * (1.f / D) + RMS_EPS);
        float xmax = 0.f;
        f32x4 xv[4];
#pragma unroll
        for (int i = 0; i < 4; ++i) { const f32x4 g = *(const f32x4*)(gain + 256 * i + 4 * sg); xv[i] = hv[i] * rstd * g;
            xmax = fmaxf(fmaxf(xmax, fmaxf(fabsf(xv[i].x), fabsf(xv[i].y))), fmaxf(fabsf(xv[i].z), fabsf(xv[i].w))); }
#pragma unroll
        for (int o = 1; o < 64; o <<= 1) xmax = fmaxf(xmax, __shfl_xor(xmax, o));
        const float qx = xmax > 0.f ? 256.0f / xmax : 1.0f, xinv = xmax > 0.f ? xmax * (1.0f / 256.0f) : 1.0f;
        {
            v4u w;
#pragma unroll
            for (int i = 0; i < 4; ++i) { unsigned tt = 0u; tt = __builtin_amdgcn_cvt_pk_fp8_f32(xv[i].x * qx, xv[i].y * qx, tt, false); tt = __builtin_amdgcn_cvt_pk_fp8_f32(xv[i].z * qx, xv[i].w * qx, tt, true); w[i] = tt; }
            *(LAS v4u*)(X8 + 16 * sg) = w;
        }
        LDS_WAIT(); asm volatile("" ::: "memory");
#define ROW2(T, sel_, l0_) (*(const v4u*)((T) + (unsigned)(sel2(hf, __builtin_amdgcn_readlane(sel_, (l0_)), __builtin_amdgcn_readlane(sel_, (l0_) + 1)) * ROWB + 16 * c32)))
#define UP_LOAD(buf, hq) do { const int sel_ = (hq) < 2 ? idx_lo : idx_hi; _Pragma("unroll") for (int k = 0; k < 16; ++k) buf[k] = ROW2(UP, sel_, ((hq) & 1) * 32 + 2 * k); } while (0)
#define DN_LOAD(buf, hb) do { const int sel_ = (hb) < 4 ? idx_lo : idx_hi; _Pragma("unroll") for (int k = 0; k < 8; ++k) buf[k] = ROW2(DN, sel_, ((hb) & 3) * 16 + 2 * k); } while (0)
        v4u da[8];
        {
            v4u ur[16];
            UP_LOAD(ur, 0);
#define UP_NEXT UP_LOAD(ur, hq + 1)
#pragma unroll 1
            for (int hq = 0; hq < 3; ++hq) {
                const int sel = hq < 2 ? idx_lo : idx_hi; const float gsel = hq < 2 ? g_lo : g_hi; const int lb0 = (hq & 1) * 32;
#pragma unroll
                for (int k = 0; k < 16; ++k) *(LAS v4u*)(RB + (2 * k + (hf ? 1 : 0)) * G_RS + 16 * c32) = ur[k];
                float sc[4];
#pragma unroll
                for (int hh_ = 0; hh_ < 2; ++hh_) { const int ek_ = __shfl(sel, lb0 + hh_ * 16 + 4 * g4 + (n16 & 3)); const f32x2g s2_ = SC2[ek_]; sc[2 * hh_] = s2_.x; sc[2 * hh_ + 1] = s2_.y; }
                LDS_WAIT(); asm volatile("" ::: "memory");
                UP_NEXT;
                f32x4 cc[2]; cc[0] = (f32x4){0.f, 0.f, 0.f, 0.f}; cc[1] = cc[0];
#pragma unroll
                for (int s8 = 0; s8 < 8; ++s8) { const v4u b0 = *(const LAS v4u*)(X8 + 128 * s8 + 16 * g4), b1 = *(const LAS v4u*)(X8 + 128 * s8 + 64 + 16 * g4);
                    const v8i_g bq = (v8i_g){(int)b0.x, (int)b0.y, (int)b0.z, (int)b0.w, (int)b1.x, (int)b1.y, (int)b1.z, (int)b1.w};
#pragma unroll
                    for (int hh_ = 0; hh_ < 2; ++hh_) { const v4u a4 = *(const LAS v4u*)(RB + (hh_ * 16 + n16) * G_RS + 64 * s8 + 16 * g4); const v8i_g a8 = (v8i_g){(int)a4.x, (int)a4.y, (int)a4.z, (int)a4.w, 0, 0, 0, 0};
                        cc[hh_] = __builtin_amdgcn_mfma_scale_f32_16x16x128_f8f6f4(a8, bq, cc[hh_], 4, 0, 0, 0x7f7f7f7f, 0, 0x7f7f7f7f); } }
#pragma unroll
                for (int hh_ = 0; hh_ < 2; ++hh_) { const int lb = lb0 + hh_ * 16; const f32x4 c = cc[hh_];
                    const int r_ = n16 & 3, k_ = 4 * g4 + r_;
                    const float my = r_ == 0 ? c[0] : (r_ == 1 ? c[1] : (r_ == 2 ? c[2] : c[3]));
                    const float gate = __shfl(gsel, lb + k_);
                    const float act = gelu_erf(my * sc[2 * hh_] * xinv) * gate * sc[2 * hh_ + 1];
                    if (n16 < 4) ACT[slot * 128 + hq * 32 + hh_ * 16 + k_] = act; }
                LDS_WAIT(); asm volatile("" ::: "memory");
            }
#undef UP_NEXT
#define UP_NEXT DN_LOAD(da, 0)
            { const int hq = 3;
                const int sel = hq < 2 ? idx_lo : idx_hi; const float gsel = hq < 2 ? g_lo : g_hi; const int lb0 = (hq & 1) * 32;
#pragma unroll
                for (int k = 0; k < 16; ++k) *(LAS v4u*)(RB + (2 * k + (hf ? 1 : 0)) * G_RS + 16 * c32) = ur[k];
                float sc[4];
#pragma unroll
                for (int hh_ = 0; hh_ < 2; ++hh_) { const int ek_ = __shfl(sel, lb0 + hh_ * 16 + 4 * g4 + (n16 & 3)); const f32x2g s2_ = SC2[ek_]; sc[2 * hh_] = s2_.x; sc[2 * hh_ + 1] = s2_.y; }
                LDS_WAIT(); asm volatile("" ::: "memory");
                UP_NEXT;
                f32x4 cc[2]; cc[0] = (f32x4){0.f, 0.f, 0.f, 0.f}; cc[1] = cc[0];
#pragma unroll
                for (int s8 = 0; s8 < 8; ++s8) { const v4u b0 = *(const LAS v4u*)(X8 + 128 * s8 + 16 * g4), b1 = *(const LAS v4u*)(X8 + 128 * s8 + 64 + 16 * g4);
                    const v8i_g bq = (v8i_g){(int)b0.x, (int)b0.y, (int)b0.z, (int)b0.w, (int)b1.x, (int)b1.y, (int)b1.z, (int)b1.w};
#pragma unroll
                    for (int hh_ = 0; hh_ < 2; ++hh_) { const v4u a4 = *(const LAS v4u*)(RB + (hh_ * 16 + n16) * G_RS + 64 * s8 + 16 * g4); const v8i_g a8 = (v8i_g){(int)a4.x, (int)a4.y, (int)a4.z, (int)a4.w, 0, 0, 0, 0};
                        cc[hh_] = __builtin_amdgcn_mfma_scale_f32_16x16x128_f8f6f4(a8, bq, cc[hh_], 4, 0, 0, 0x7f7f7f7f, 0, 0x7f7f7f7f); } }
#pragma unroll
                for (int hh_ = 0; hh_ < 2; ++hh_) { const int lb = lb0 + hh_ * 16; const f32x4 c = cc[hh_];
                    const int r_ = n16 & 3, k_ = 4 * g4 + r_;
                    const float my = r_ == 0 ? c[0] : (r_ == 1 ? c[1] : (r_ == 2 ? c[2] : c[3]));
                    const float gate = __shfl(gsel, lb + k_);
                    const float act = gelu_erf(my * sc[2 * hh_] * xinv) * gate * sc[2 * hh_ + 1];
                    if (n16 < 4) ACT[slot * 128 + hq * 32 + hh_ * 16 + k_] = act; }
                LDS_WAIT(); asm volatile("" ::: "memory");
            }
#undef UP_NEXT
        }
#undef UP_LOAD
        LDS_WAIT(); asm volatile("" ::: "memory");
        const float a_lo = ACT[slot * 128 + lane], a_hi = ACT[slot * 128 + 64 + lane];
        float amax = fmaxf(fabsf(a_lo), fabsf(a_hi));
#pragma unroll
        for (int o = 1; o < 64; o <<= 1) amax = fmaxf(amax, __shfl_xor(amax, o));
        const float ainv = amax > 0.f ? 119.0f / amax : 0.f, tscale = amax * (1.0f / 119.0f);
        unsigned pd[4];
        {
            const int A0 = __float2int_rn(a_lo * ainv), A1 = __float2int_rn(a_hi * ainv);
            const int h0 = (A0 + 8) >> 4, l0 = A0 - 16 * h0, h1 = (A1 + 8) >> 4, l1 = A1 - 16 * h1;
            const int sh = 4 * ((lane >> 1) & 7);
            pd[0] = ((unsigned)l0 & 15u) << sh; pd[1] = ((unsigned)h0 & 15u) << sh; pd[2] = ((unsigned)l1 & 15u) << sh; pd[3] = ((unsigned)h1 & 15u) << sh;
#pragma unroll
            for (int q = 0; q < 4; ++q) { pd[q] |= (unsigned)__shfl_xor((int)pd[q], 2); pd[q] |= (unsigned)__shfl_xor((int)pd[q], 4); pd[q] |= (unsigned)__shfl_xor((int)pd[q], 8); }
        }
        int acc0[32];
#pragma unroll
        for (int e = 0; e < 32; ++e) acc0[e] = 0;
#define DN_STEP(buf, hb) do { const unsigned plo_ = (hb) < 4 ? pd[0] : pd[2], phi_ = (hb) < 4 ? pd[1] : pd[3]; \
            const int alo_ = sel2(hf, __builtin_amdgcn_readlane((int)plo_, ((hb) & 3) * 16), __builtin_amdgcn_readlane((int)plo_, ((hb) & 3) * 16 + 1)), ahi_ = sel2(hf, __builtin_amdgcn_readlane((int)phi_, ((hb) & 3) * 16), __builtin_amdgcn_readlane((int)phi_, ((hb) & 3) * 16 + 1)); \
            _Pragma("unroll") for (int w = 0; w < 4; ++w) { unsigned w_[8], t_[8]; \
                _Pragma("unroll") for (int r = 0; r < 8; ++r) w_[r] = buf[r][w]; \
                tr8_nib(w_, t_); \
                _Pragma("unroll") for (int c = 0; c < 8; ++c) { const int hi_ = __builtin_amdgcn_sdot8((int)t_[c], ahi_, 0, false); acc0[8 * w + c] = __builtin_amdgcn_sdot8((int)t_[c], alo_, acc0[8 * w + c], false) + (hi_ << 4); } } } while (0)
        {
            v4u db[8];
            DN_LOAD(db, 1); DN_STEP(da, 0);
            DN_LOAD(da, 2); DN_STEP(db, 1);
            DN_LOAD(db, 3); DN_STEP(da, 2);
            DN_LOAD(da, 4); DN_STEP(db, 3);
            DN_LOAD(db, 5); DN_STEP(da, 4);
            DN_LOAD(da, 6); DN_STEP(db, 5);
            DN_LOAD(db, 7); DN_STEP(da, 6);
            DN_STEP(db, 7);
        }
#undef DN_LOAD
#undef DN_STEP
#undef ROW2
        int os[16];
#pragma unroll
        for (int k = 0; k < 16; ++k) { const int lo_ = acc0[k], hi_ = acc0[16 + k]; os[k] = (hf ? hi_ : lo_) + __shfl_xor(hf ? lo_ : hi_, 32); }
        f32x2g out[8];
#pragma unroll
        for (int e = 0; e < 8; ++e) out[e] = (f32x2g){(float)os[2 * e] * tscale, (float)os[2 * e + 1] * tscale};
        float ss2 = 0.f;
#pragma unroll
        for (int i = 0; i < 4; ++i) { hv[i].x += out[2 * i].x; hv[i].y += out[2 * i].y; hv[i].z += out[2 * i + 1].x; hv[i].w += out[2 * i + 1].y;
            ss2 += (hv[i].x * hv[i].x + hv[i].y * hv[i].y) + (hv[i].z * hv[i].z + hv[i].w * hv[i].w); }
        const float rstd2 = 1.0f / sqrtf(wave_sum(ss2) * (1.f / D) + RMS_EPS);
        f32x4 y[4];
#pragma unroll
        for (int i = 0; i < 4; ++i) y[i] = hv[i] * rstd2 * *(const f32x4*)(gnext + 256 * i + 4 * sg);
        if (layer < DEPTH - 1) {
            bf16* hw_ = HW + (size_t)t * D + 4 * sg; bf16* hn = HN + (size_t)t * D + 4 * sg;
#pragma unroll
            for (int i = 0; i < 4; ++i) { v2u a_, b_; a_.x = pk2(hv[i].x, hv[i].y); a_.y = pk2(hv[i].z, hv[i].w); b_.x = pk2(y[i].x, y[i].y); b_.y = pk2(y[i].z, y[i].w);
                *(v2u*)(hw_ + 256 * i) = a_; *(v2u*)(hn + 256 * i) = b_; }
        } else {
            float* orow = outp + (size_t)t * D + 4 * sg;
#pragma unroll
            for (int i = 0; i < 4; ++i) *(f32x4*)(orow + 256 * i) = y[i];
        }
    }
    LDS_WAIT(); asm volatile("" ::: "memory");
    }
#undef TOK_LOAD
}

struct Args { const float* in[14]; float* out; unsigned char* ws; int ph_lo, ph_hi; };
__global__ void __launch_bounds__(NTHR, 2) mega_fwd(Args args) {
    extern __shared__ __attribute__((aligned(16))) unsigned char lds[];
    Frame F;
    F.lds = (LAS unsigned char*)lds;
    F.tid = threadIdx.x; F.lane = F.tid & 63; F.wave = __builtin_amdgcn_readfirstlane(F.tid >> 6);
    F.G = gridDim.x; { const int bx = blockIdx.x; F.vcu = (F.G % 8 == 0) ? (bx % 8) * (F.G / 8) + bx / 8 : bx; }
    F.ws = args.ws;
    volatile LAS unsigned* MISC = (volatile LAS unsigned*)(F.lds + MISC_OFF);
    if (F.tid < 64) MISC[F.tid] = 0u;
    if (F.tid < 15) { const unsigned long long p = F.tid < 14 ? (unsigned long long)args.in[F.tid] : (unsigned long long)args.out;
        volatile LAS unsigned* t = (volatile LAS unsigned*)(F.lds + PTAB_OFF); t[2 * F.tid] = (unsigned)p; t[2 * F.tid + 1] = (unsigned)(p >> 32); }
    __syncthreads();
    XcdBarrier bar; bar.bar = (unsigned*)(F.ws + WS_CTL) + CW_BAR; bar.x = 0; bar.st = nullptr;
    if (MK_N_LAUNCHES == 1) bar = xcd_barrier_post((unsigned*)(F.ws + WS_CTL) + CW_BAR, MISC + 8);

#pragma unroll 1
    for (int ph = args.ph_lo; ph < args.ph_hi; ++ph) {
        bool did = true;
        const int kind_ = ph == 0 ? 7 : (ph - 1) % PH_PER_LAYER; const int nrep = (PROBE_REP >= 0 && kind_ == PROBE_REP && (ph == 0 || ((PROBE_LMASK >> ((ph - 1) / PH_PER_LAYER)) & 1))) ? 2 : 1;
#pragma unroll 1
        for (int rep = 0; rep < nrep; ++rep) {
        const bool dry = (nrep == 2 && rep == 0);
        { int t_ = threadIdx.x; asm volatile("" : "+v"(t_)); F.tid = t_; F.lane = t_ & 63; F.wave = __builtin_amdgcn_readfirstlane(t_ >> 6);
          unsigned long long ws_ = (unsigned long long)args.ws; asm volatile("" : "+s"(ws_)); F.ws = (unsigned char*)(__attribute__((address_space(1))) unsigned char*)ws_; }
#ifndef DIS_PRO
        if (ph == 0) p0_prologue(F, dry);
#else
        if (ph == 0) {}
#endif
        else {
            const int layer = (ph - 1) / PH_PER_LAYER, k = (ph - 1) % PH_PER_LAYER, j = layer >> 1; const bool is_attn = (layer & 1) == 0;
            if (k == 0) {
                if (!is_attn) {
                    pg8::Gemm g{(const pg8::bf16_t*)(F.ws + WS_HN), (const pg8::bf16_t*)(F.ws + WS_WIN) + (size_t)j * 3072 * 1024, M, 3072, D};
                    pg8::StaticOrder S; S.init(g.M, g.N, F.G, (int)blockIdx.x);
                    EpiConvIn E{(bf16*)(F.ws + WS_BIG), (bf16*)(F.ws + WS_BIG + 32 * MiB)};
                    pg8::gemm_phase<EpiConvIn, pg8::StaticOrder, true, true>(F.lds, g, S, E);
                }
                const int ng = is_attn ? 2 : 0;
#pragma unroll 1
                for (int gi = 0; gi < ng; ++gi) {
                    pg8::Gemm g; pg8::EpiBf16<0> E; E.bias = nullptr; E.split_cols = 0; E.split_stride = 0; E.scale0 = 1.f;
                    if (is_attn && gi == 0) { g = pg8::Gemm{(const pg8::bf16_t*)(F.ws + WS_HN), (const pg8::bf16_t*)(F.ws + WS_WQK) + (size_t)j * 2048 * 1024, M, 2048, D}; E.O = (pg8::bf16_t*)(F.ws + WS_BIG); E.ldc = 2048; }
                    else if (is_attn) { g = pg8::Gemm{(const pg8::bf16_t*)(F.ws + WS_WV) + (size_t)j * 1024 * 1024, (const pg8::bf16_t*)(F.ws + WS_HN), D, M, D}; E.O = (pg8::bf16_t*)(F.ws + WS_VT); E.ldc = M; }
                    else { g = pg8::Gemm{(const pg8::bf16_t*)(F.ws + WS_HN), (const pg8::bf16_t*)(F.ws + WS_WIN) + (size_t)j * 3072 * 1024, M, 3072, D}; E.O = (pg8::bf16_t*)(F.ws + WS_BIG); E.ldc = 3072; }
                    pg8::StaticOrder S; S.init(g.M, g.N, F.G, (int)blockIdx.x);
                    pg8::gemm_phase<pg8::EpiBf16<0>, pg8::StaticOrder, true, true>(F.lds, g, S, E);
                }
            } else if (k == 1) {
                if (is_attn) {
#if NAIVE_ATTN
                    attn_naive_phase(F, j);
#elif !defined(DIS_ATTN)
                    attn_phase(F, j);
#endif
                } else {
#ifndef DIS_CONV
                    conv_phase(F, j);
#endif
                }
            } else if (k == 2) {
                pg8::Gemm g{(const pg8::bf16_t*)(F.ws + WS_MIX), (const pg8::bf16_t*)(F.ws + (is_attn ? WS_WO : WS_WOUT)) + (size_t)j * 1024 * 1024, M, D, D};
                pg8::StaticOrder S; S.init(M, D, F.G, (int)blockIdx.x);
                float* rssp = (float*)(F.ws + (dry ? WS_SC + 96 * MiB : WS_RSS)); bf16* hout = (bf16*)(F.ws + (dry ? WS_SC : WS_H));
                if (layer == 0) { EpiRes<true> E{(const void*)F.in(0), hout, rssp}; pg8::gemm_phase<EpiRes<true>, pg8::StaticOrder, false, true>(F.lds, g, S, E); }
                else { EpiRes<false> E{(const void*)(F.ws + WS_H), hout, rssp}; pg8::gemm_phase<EpiRes<false>, pg8::StaticOrder, false, true>(F.lds, g, S, E); }
            } else if (k == 3) {
                did = false;
            } else if (k == 4) {
                pg8::Gemm g{(const pg8::bf16_t*)(F.ws + WS_H), (const pg8::bf16_t*)(F.ws + WS_WP) + (size_t)layer * 2048 * 1024, M, 2048, D};
                pg8::StaticOrder S; S.init(M, 2048, F.G, (int)blockIdx.x);
#if NAIVE_TOPK
                EpiF32 E{(float*)(F.ws + WS_SC), 2048};
                pg8::gemm_phase<EpiF32, pg8::StaticOrder, true, true>(F.lds, g, S, E);
#else
#ifndef DIS_TOPK
                EpiTopK E{(int*)(F.ws + WS_SELI), (float*)(F.ws + WS_SELG), (const float*)(F.ws + WS_RSS)};
#pragma unroll 1
                for (int i = 0;; ++i) { OneUnit O1; if (!S.next(i, O1.u)) break; pg8::gemm_phase<EpiTopK, OneUnit, false, true>(F.lds, g, O1, E); }
#endif
#endif
            } else if (k == 5) {
#if NAIVE_TOPK
                select_naive_phase(F);
#else
                did = false;
#endif
            } else {
#ifndef DIS_GATHER
                gather_phase(F, layer, dry);
#endif
            }
        }
        if (MK_N_LAUNCHES == 1 && dry) xcd_barrier(bar);
        }
        if (MK_N_LAUNCHES == 1 && did && ph + 1 < args.ph_hi) { xcd_barrier(bar);
#ifdef PROBE_BAR2
            xcd_barrier(bar);
#endif
        }
    }
}

extern "C" void kernel_launch(void* const* d_in, const int* in_sizes, int n_in, void* d_out, int out_size, void* d_ws, size_t ws_size, hipStream_t stream) {
    static int grid = 0;
    if (grid == 0) {
        if (n_in != 14 || out_size != M * D || ws_size < WS_END) { fprintf(stderr, "kernel_launch: unexpected shapes (n_in %d, out %d, ws %zu); nothing launched\n", n_in, out_size, ws_size); grid = -1; return; }
        int dev = 0, cus = 0, per_cu = 0;
        if (hipGetDevice(&dev) != hipSuccess || hipDeviceGetAttribute(&cus, hipDeviceAttributeMultiprocessorCount, dev) != hipSuccess) { grid = -1; return; }
        if (hipFuncSetAttribute((const void*)mega_fwd, hipFuncAttributeMaxDynamicSharedMemorySize, LDS_BYTES) != hipSuccess) { fprintf(stderr, "kernel_launch: hipFuncSetAttribute failed\n"); grid = -1; return; }
        if (hipOccupancyMaxActiveBlocksPerMultiprocessor(&per_cu, (const void*)mega_fwd, NTHR, LDS_BYTES) != hipSuccess || per_cu < 1) fprintf(stderr, "kernel_launch: note: occupancy query reports %d\n", per_cu);
        (void)hipGetLastError();
        grid = cus;
    }
    if (grid < 0) return;
    if (hipMemsetAsync((char*)d_ws + WS_CTL, 0, CTL_ZERO_BYTES, stream) != hipSuccess) return;
    Args a{};
    for (int i = 0; i < 14; ++i) a.in[i] = (const float*)d_in[i];
    a.out = (float*)d_out; a.ws = (unsigned char*)d_ws;
    if (MK_N_LAUNCHES == 1) { a.ph_lo = 0; a.ph_hi = N_PHASES; hipLaunchKernelGGL(mega_fwd, dim3(grid), dim3(NTHR), LDS_BYTES, stream, a); }
    else for (int ph = 0; ph < N_PHASES; ++ph) {
        if (ph > 0 && ((ph - 1) % PH_PER_LAYER == 3 || (!NAIVE_TOPK && (ph - 1) % PH_PER_LAYER == 5))) continue;
        a.ph_lo = ph; a.ph_hi = ph + 1; hipLaunchKernelGGL(mega_fwd, dim3(grid), dim3(NTHR), LDS_BYTES, stream, a);
    }
}
```

```cpp
#include <hip/hip_runtime.h>
#include <cstdio>
#include <cstdint>
namespace pg8 {
#define PG8_LAS __attribute__((address_space(3)))
typedef unsigned short bf16_t;
typedef short bf16x8 __attribute__((ext_vector_type(8)));
typedef float f32x4 __attribute__((ext_vector_type(4)));
typedef unsigned u32x4 __attribute__((ext_vector_type(4)));
constexpr int BM = 256, BK = 64, HALF = 128, HTB = HALF * BK * 2  , STAGE_BYTES = 8 * HTB, NXCD = 8, WGM = 8;

__host__ __device__ __forceinline__ int lds_byte(int r, int c) { const int st = (r >> 4) * 2 + (c >> 5), rr = r & 15, cc = c & 31, ob = rr * 64 + cc * 2; return st * 1024 + (ob ^ (((ob >> 9) & 1) << 5)); }
__host__ __device__ __forceinline__ void stage_rc(int b, int& R, int& C) { const int st = b / 1024, sb = b % 1024, swz = sb ^ (((sb >> 9) & 1) << 5); R = (st >> 1) * 16 + swz / 64; C = (st & 1) * 32 + (swz % 64) / 2; }
__host__ __device__ __forceinline__ int perm32(int rho) { const int n = rho >> 4, i = rho & 15; return 8 * (i >> 2) + 4 * n + (i & 3); }

struct Unit { int pm, pn; };
struct Gemm { const bf16_t* A; const bf16_t* Bt; int M, N, K; };

struct StaticOrder {
    int nM, nN, nwg, G, c;
    __host__ __device__ void init(int M, int N, int G_, int c_) { nM = M / BM; nN = N / BM; nwg = nM * nN; G = G_; c = c_; }
    __host__ __device__ bool next(int i, Unit& u) const {
        const long L = (long)i * G + c; if (L >= nwg) return false;
        int wgid = (int)L; { const int q = nwg / NXCD, r = nwg % NXCD, xcd = wgid % NXCD, off = wgid / NXCD; wgid = (xcd < r ? xcd * (q + 1) : r * (q + 1) + (xcd - r) * q) + off; }
        const int nig = WGM * nN, gid = wgid / nig, fm = gid * WGM, gsz = (nM - fm) < WGM ? (nM - fm) : WGM;
        u.pm = fm + ((wgid % nig) % gsz); u.pn = (wgid % nig) / gsz; return true;
    }
    __device__ __forceinline__ void a_ready(const Unit&) const {}
    __device__ __forceinline__ void done(const Unit&) const {}
};

__device__ __forceinline__ unsigned cvt_pk_bf16(float lo, float hi) { unsigned r; asm volatile("v_cvt_pk_bf16_f32 %0, %1, %2" : "=v"(r) : "v"(lo), "v"(hi)); return r; }
typedef float f32x2 __attribute__((ext_vector_type(2)));
__device__ __forceinline__ f32x2 gelu_pk(f32x2 v) {
    const f32x2 av = __builtin_elementwise_abs(v), d = av * 0.2316418882f + 1.0f;
    f32x2 t; t.x = __builtin_amdgcn_rcpf(d.x); t.y = __builtin_amdgcn_rcpf(d.y);
    f32x2 q = t * 0.5307027145f + (-0.7265760135f); q = q * t + 0.7107068705f; q = q * t + (-0.142248368f); q = q * t + 0.127414796f; q = q * t;
    const f32x2 s = (v * v) * (-0.72134752044f);
    f32x2 e; e.x = __builtin_amdgcn_exp2f(s.x); e.y = __builtin_amdgcn_exp2f(s.y);
    const f32x2 m = v * (q * e), r = v - m;
    f32x2 o; o.x = v.x < 0.f ? m.x : r.x; o.y = v.y < 0.f ? m.y : r.y; return o;
}

template <int ACT  > struct EpiBf16 {
    static constexpr bool PERM = true, AFTER_DRAIN = false; static_assert(ACT == 0 || ACT == 1, "EpiBf16: ACT is 0 (none) or 1 (gelu_pk)");
    bf16_t* O; int ldc; const float* bias; int split_cols; size_t split_stride; float scale0;
    __device__ __forceinline__ void operator()(const f32x4 (&acc)[2][2][4][2], const Unit& u, int wr, int wc, int fr, int fq) const {
        const int row0 = u.pm * BM + wr * 64 + fr; int colt = u.pn * BM; bf16_t* base = O;
        float sc = 1.f; if (split_cols) { const int t = colt / split_cols; base += (size_t)t * split_stride; colt -= t * split_cols; if (t == 0) sc = scale0; }
        const int col0 = colt + wc * 32 + 8 * fq, bcol0 = u.pn * BM + wc * 32 + 8 * fq;
        f32x4 bv[2][2];
#pragma unroll
        for (int bj = 0; bj < 2; ++bj)
#pragma unroll
            for (int n = 0; n < 2; ++n) bv[bj][n] = bias ? *(const f32x4*)(bias + bcol0 + bj * HALF + 4 * n) : (f32x4){0.f, 0.f, 0.f, 0.f};
#pragma unroll
        for (int ai = 0; ai < 2; ++ai)
#pragma unroll
            for (int m = 0; m < 4; ++m) { bf16_t* rowp = base + (size_t)(row0 + ai * HALF + m * 16) * ldc + col0;
#pragma unroll
                for (int bj = 0; bj < 2; ++bj) { f32x4 v0 = acc[ai][bj][m][0] + bv[bj][0], v1 = acc[ai][bj][m][1] + bv[bj][1];
                    if (ACT == 1) { f32x2 a = gelu_pk((f32x2){v0[0], v0[1]}), b = gelu_pk((f32x2){v0[2], v0[3]}), c = gelu_pk((f32x2){v1[0], v1[1]}), d = gelu_pk((f32x2){v1[2], v1[3]});
                        v0 = (f32x4){a.x, a.y, b.x, b.y}; v1 = (f32x4){c.x, c.y, d.x, d.y}; }
                    v0 = v0 * sc; v1 = v1 * sc; u32x4 w; w.x = cvt_pk_bf16(v0[0], v0[1]); w.y = cvt_pk_bf16(v0[2], v0[3]); w.z = cvt_pk_bf16(v1[0], v1[1]); w.w = cvt_pk_bf16(v1[2], v1[3]);
                    *(u32x4*)(rowp + bj * HALF) = w; } }
    }
};

template <class Epi, class Sched, bool ALIGN_EPI = false, bool SP2 = false>
__device__ __forceinline__ void gemm_phase(PG8_LAS unsigned char* lds, const Gemm g, const Sched& S, const Epi& E) {
    int tid_l = threadIdx.x; asm volatile("" : "+v"(tid_l));
    const int tid = tid_l, wid = __builtin_amdgcn_readfirstlane(tid >> 6), lane = tid & 63, wr = wid >> 2, wc = wid & 3, fr = lane & 15, fq = lane >> 4;
    const int K = g.K, nt = K / BK;
    unsigned voffA[2], voffB[2];
#pragma unroll
    for (int i = 0; i < 2; ++i) { int R, C; stage_rc(tid * 16 + i * 8192, R, C); const int Rb = Epi::PERM ? ((R & ~31) + perm32(R & 31)) : R;
        voffA[i] = (unsigned)(R * K + C) * 2u; voffB[i] = (unsigned)(Rb * K + C) * 2u; }
    const size_t kstep = (size_t)(BK * 2);
    const size_t hstep = (size_t)HALF * K * 2;
    const size_t tstep = 2 * hstep;
    const unsigned ldsw = (unsigned)wid * 1024u;
    const int aoff = lds_byte(wr * 64 + fr, fq * 8), boff = lds_byte(wc * 32 + fr, fq * 8);
#define PG8_SA(b, h) (((b) * 2 + (h)) * HTB)
#define PG8_SB(b, h) ((4 + (b) * 2 + (h)) * HTB)
#define PG8_STAGE(bufoff, gbase, voff) do { _Pragma("unroll") for (int _i = 0; _i < 2; ++_i) \
        __builtin_amdgcn_global_load_lds((const unsigned*)((const char*)(gbase) + (voff)[_i]), (PG8_LAS unsigned*)(lds + (bufoff) + ldsw + _i * 8192), 16, 0, 0); } while (0)
#define PG8_LDA(dst, b, h) do { _Pragma("unroll") for (int m = 0; m < 4; ++m) _Pragma("unroll") for (int k = 0; k < 2; ++k) dst[m][k] = *(const PG8_LAS bf16x8*)(lds + PG8_SA(b, h) + aoff + m * 2048 + k * 1024); } while (0)
#define PG8_LDB(dst, b, h) do { _Pragma("unroll") for (int n = 0; n < 2; ++n) _Pragma("unroll") for (int k = 0; k < 2; ++k) dst[n][k] = *(const PG8_LAS bf16x8*)(lds + PG8_SB(b, h) + boff + n * 2048 + k * 1024); } while (0)
#define PG8_MMA(ai, bj, At, Bt) do { __builtin_amdgcn_s_setprio(1); _Pragma("unroll") for (int m = 0; m < 4; ++m) _Pragma("unroll") for (int n = 0; n < 2; ++n) _Pragma("unroll") for (int k = 0; k < 2; ++k) \
        acc[ai][bj][m][n] = __builtin_amdgcn_mfma_f32_16x16x32_bf16(Bt[n][k], At[m][k], acc[ai][bj][m][n], 0, 0, 0); __builtin_amdgcn_s_setprio(0); } while (0)
#define PG8_WAIT_V(n) asm volatile("s_waitcnt vmcnt(" #n ")" ::: "memory")
#define PG8_WAIT_L(n) asm volatile("s_waitcnt lgkmcnt(" #n ")" ::: "memory")
#define PG8_BAR __builtin_amdgcn_s_barrier()
#define PG8_SCHED __builtin_amdgcn_sched_barrier(0)
    Unit cur, nxt; int ui = 0;
    if (!S.next(0, cur)) return;
    f32x4 acc[2][2][4][2];
#pragma unroll
    for (int a = 0; a < 2; ++a)
#pragma unroll
        for (int b = 0; b < 2; ++b)
#pragma unroll
            for (int m = 0; m < 4; ++m)
#pragma unroll
                for (int n = 0; n < 2; ++n) acc[a][b][m][n] = (f32x4){0.f, 0.f, 0.f, 0.f};
    bf16x8 At[4][2], B0[2][2], B1[2][2];
    const char* cA = (const char*)g.A + (size_t)cur.pm * tstep; const char* cB = (const char*)g.Bt + (size_t)cur.pn * tstep;
    S.a_ready(cur);
    if constexpr (SP2) {
        PG8_STAGE(PG8_SB(0, 0), cB, voffB); PG8_STAGE(PG8_SB(0, 1), cB + hstep, voffB); PG8_STAGE(PG8_SA(0, 0), cA, voffA); PG8_STAGE(PG8_SA(0, 1), cA + hstep, voffA);
        if (wr == 1) PG8_BAR;
        PG8_WAIT_V(2); PG8_BAR;
        PG8_STAGE(PG8_SB(1, 0), cB + kstep, voffB); PG8_STAGE(PG8_SA(1, 0), cA + kstep, voffA); PG8_STAGE(PG8_SB(1, 1), cB + hstep + kstep, voffB);
        PG8_WAIT_V(6); PG8_BAR;
    } else {
        PG8_STAGE(PG8_SB(0, 0), cB, voffB); PG8_STAGE(PG8_SA(0, 0), cA, voffA); PG8_STAGE(PG8_SB(0, 1), cB + hstep, voffB); PG8_STAGE(PG8_SA(0, 1), cA + hstep, voffA);
        if (wr == 1) PG8_BAR;
        PG8_WAIT_V(4); PG8_BAR;
        PG8_STAGE(PG8_SB(1, 0), cB + kstep, voffB); PG8_STAGE(PG8_SA(1, 0), cA + kstep, voffA); PG8_STAGE(PG8_SB(1, 1), cB + hstep + kstep, voffB);
        PG8_WAIT_V(6); PG8_BAR;
    }
    for (;;) {
        const bool has_next = S.next(ui + 1, nxt);
        const char* nA = has_next ? (const char*)g.A + (size_t)nxt.pm * tstep : cA; const char* nB = has_next ? (const char*)g.Bt + (size_t)nxt.pn * tstep : cB;
        for (int t = 0; t < nt; t += 2) {
            const bool last = (t == nt - 2);
            const char* a1 = cA + (size_t)(t + 1) * kstep;
            const char* a2 = last ? nA : cA + (size_t)(t + 2) * kstep; const char* b2 = last ? nB : cB + (size_t)(t + 2) * kstep;
            const char* a3 = a2 + kstep; const char* b3 = b2 + kstep;
            if (last && has_next) S.a_ready(nxt);
            if constexpr (SP2) {
            PG8_LDB(B0, 0, 0); PG8_LDB(B1, 0, 1); PG8_SCHED; PG8_LDA(At, 0, 0); PG8_STAGE(PG8_SA(1, 1), a1 + hstep, voffA);
            PG8_WAIT_V(8); PG8_WAIT_L(0); PG8_BAR; PG8_MMA(0, 0, At, B0); PG8_MMA(0, 1, At, B1); PG8_BAR; PG8_SCHED;
            PG8_LDA(At, 0, 1); PG8_STAGE(PG8_SB(0, 0), b2, voffB); PG8_STAGE(PG8_SB(0, 1), b2 + hstep, voffB); PG8_STAGE(PG8_SA(0, 0), a2, voffA);
            PG8_WAIT_V(8); PG8_WAIT_L(0); PG8_BAR; PG8_MMA(1, 0, At, B0); PG8_MMA(1, 1, At, B1); PG8_BAR; PG8_SCHED;
            PG8_LDB(B0, 1, 0); PG8_LDB(B1, 1, 1); PG8_SCHED; PG8_LDA(At, 1, 0); PG8_STAGE(PG8_SA(0, 1), a2 + hstep, voffA);
            PG8_WAIT_V(8); PG8_WAIT_L(0); PG8_BAR; PG8_MMA(0, 0, At, B0); PG8_MMA(0, 1, At, B1); PG8_BAR; PG8_SCHED;
            PG8_LDA(At, 1, 1); PG8_STAGE(PG8_SB(1, 0), b3, voffB); PG8_STAGE(PG8_SB(1, 1), b3 + hstep, voffB); PG8_STAGE(PG8_SA(1, 0), a3, voffA);
            PG8_WAIT_V(8); PG8_WAIT_L(0); PG8_BAR; PG8_MMA(1, 0, At, B0); PG8_MMA(1, 1, At, B1); PG8_BAR; PG8_SCHED;
            } else {
            PG8_LDB(B0, 0, 0); PG8_SCHED; PG8_LDA(At, 0, 0); PG8_STAGE(PG8_SA(1, 1), a1 + hstep, voffA);
            PG8_WAIT_L(8); PG8_BAR; PG8_WAIT_L(0); PG8_MMA(0, 0, At, B0); PG8_BAR; PG8_SCHED;
            PG8_LDB(B1, 0, 1); PG8_STAGE(PG8_SB(0, 0), b2, voffB);
            PG8_BAR; PG8_WAIT_L(0); PG8_MMA(0, 1, At, B1); PG8_BAR;
            PG8_LDA(At, 0, 1); PG8_STAGE(PG8_SA(0, 0), a2, voffA);
            PG8_BAR; PG8_WAIT_L(0); PG8_MMA(1, 0, At, B0); PG8_BAR; PG8_SCHED;
            PG8_STAGE(PG8_SB(0, 1), b2 + hstep, voffB);
            PG8_WAIT_V(6); PG8_BAR; PG8_MMA(1, 1, At, B1); PG8_BAR;
            PG8_LDB(B0, 1, 0); PG8_SCHED; PG8_LDA(At, 1, 0); PG8_STAGE(PG8_SA(0, 1), a2 + hstep, voffA);
            PG8_WAIT_L(8); PG8_BAR; PG8_WAIT_L(0); PG8_MMA(0, 0, At, B0); PG8_BAR; PG8_SCHED;
            PG8_LDB(B1, 1, 1); PG8_STAGE(PG8_SB(1, 0), b3, voffB);
            PG8_BAR; PG8_WAIT_L(0); PG8_MMA(0, 1, At, B1); PG8_BAR;
            PG8_LDA(At, 1, 1); PG8_STAGE(PG8_SA(1, 0), a3, voffA);
            PG8_BAR; PG8_WAIT_L(0); PG8_MMA(1, 0, At, B0); PG8_BAR; PG8_SCHED;
            PG8_STAGE(PG8_SB(1, 1), b3 + hstep, voffB);
            PG8_WAIT_V(6); PG8_BAR; PG8_MMA(1, 1, At, B1); PG8_BAR;
            }
        }
        if constexpr (ALIGN_EPI) { if (wr == 0) PG8_BAR; }
        if constexpr (!Epi::AFTER_DRAIN) { E(acc, cur, wr, wc, fr, fq); S.done(cur); }
        if (!has_next) break;
#pragma unroll
        for (int a = 0; a < 2; ++a)
#pragma unroll
            for (int b = 0; b < 2; ++b)
#pragma unroll
                for (int m = 0; m < 4; ++m)
#pragma unroll
                    for (int n = 0; n < 2; ++n) acc[a][b][m][n] = (f32x4){0.f, 0.f, 0.f, 0.f};
        cur = nxt; cA = nA; cB = nB; ++ui;
        if constexpr (ALIGN_EPI) { if (wr == 1) PG8_BAR; }
    }
    PG8_WAIT_V(0);
    if constexpr (!ALIGN_EPI) { if (wr == 0) PG8_BAR; }
    PG8_BAR;
    if constexpr (Epi::AFTER_DRAIN) { E.fused(acc, cur, wr, wc, fr, fq, lds, wid, lane); S.done(cur); }
#undef PG8_SA
#undef PG8_SB
#undef PG8_STAGE
#undef PG8_LDA
#undef PG8_LDB
#undef PG8_MMA
#undef PG8_WAIT_V
#undef PG8_WAIT_L
#undef PG8_BAR
#undef PG8_SCHED
}
}
#ifndef HD
#define HD __host__ __device__ __forceinline__
#endif
HD int tk_map(float f) { int b = __builtin_bit_cast(int, f); return b ^ ((b >> 31) & 0x7fffffff); }
HD float tk_unmap(int k) { int b = k ^ ((k >> 31) & 0x7fffffff); return __builtin_bit_cast(float, b); }
HD void tk_cx(int& a, int& b) { const int hi = a > b ? a : b, lo = a > b ? b : a; a = hi; b = lo; }
template <int N> HD void tk_sort_desc(int (&v)[N]) {
#pragma unroll
    for (int k = 2; k <= N; k <<= 1)
#pragma unroll
        for (int j = k >> 1; j > 0; j >>= 1)
#pragma unroll
            for (int i = 0; i < N; ++i) { const int l = i ^ j; if (l > i) { if ((i & k) == 0) tk_cx(v[i], v[l]); else tk_cx(v[l], v[i]); } }
}
template <int N> HD void tk_merge_top(int (&a)[N], const int (&b)[N]) {
#pragma unroll
    for (int i = 0; i < N; ++i) a[i] = a[i] > b[N - 1 - i] ? a[i] : b[N - 1 - i];
#pragma unroll
    for (int j = N >> 1; j > 0; j >>= 1)
#pragma unroll
        for (int i = 0; i < N; ++i) { const int l = i ^ j; if (l > i) tk_cx(a[i], a[l]); }
}
template <int NCH, class FP> HD void tk_stage1(FP s, int n_base, int (&best)[16]) {
#pragma unroll
    for (int c = 0; c < NCH; ++c) {
        int x[16];
#pragma unroll
        for (int e = 0; e < 16; ++e) x[e] = (tk_map(s[c * 16 + e]) & ~127) | (127 - (n_base + c * 16 + e));
        tk_sort_desc(x);
        if (c == 0) {
#pragma unroll
            for (int e = 0; e < 16; ++e) best[e] = x[e];
        } else tk_merge_top(best, x);
    }
}
template <class IP, class OI, class OG> HD void tk_stage2(int (&a)[16], int (&b)[16], IP AB, OI out_idx, OG out_g, float vscale = 1.0f) {
    float va[16], vb[16];
#pragma unroll
    for (int i = 0; i < 16; ++i) { AB[i] = a[i]; AB[16 + i] = b[i]; va[i] = tk_unmap(a[i] & ~127); vb[i] = tk_unmap(b[i] & ~127); }
    int best[16];
#pragma unroll
    for (int c = 0; c < 4; ++c) {
        int x[16];
#pragma unroll
        for (int e = 0; e < 16; ++e) x[e] = (int)0x80000000;
        int n = 0;
#pragma unroll
        for (int i = 0; i < 16; ++i)
#pragma unroll
            for (int j = 0; j < 16; ++j)
                if ((i + 1) * (j + 1) <= 16) { if (n >= 16 * c && n < 16 * c + 16) x[n - 16 * c] = (tk_map(va[i] + vb[j]) & ~255) | (255 - (i * 16 + j)); ++n; }
        tk_sort_desc(x);
        if (c == 0) {
#pragma unroll
            for (int e = 0; e < 16; ++e) best[e] = x[e];
        } else tk_merge_top(best, x);
    }
    int ka[16], kb[16];
#pragma unroll
    for (int k = 0; k < 16; ++k) { const int flat = 255 - (best[k] & 255); ka[k] = AB[flat >> 4]; kb[k] = AB[16 + (flat & 15)]; }
    float sv[16]; int ei[16]; float sum = 0.f;
#pragma unroll
    for (int k = 0; k < 16; ++k) { ei[k] = (127 - (ka[k] & 127)) * 128 + (127 - (kb[k] & 127)); sv[k] = (tk_unmap(ka[k] & ~127) + tk_unmap(kb[k] & ~127)) * vscale; }
    const float m = sv[0];
#pragma unroll
    for (int k = 0; k < 16; ++k) { sv[k] = __expf(sv[k] - m); sum += sv[k]; }
    const float inv = 1.0f / sum;
#pragma unroll
    for (int k = 0; k < 16; ++k) { out_idx[k] = ei[k]; out_g[k] = sv[k] * inv; }
}
constexpr int NWAVES = 8, NTHR = 512;
constexpr int BATCH = 2, SEQ = 8192, D = 1024, M = BATCH * SEQ, DEPTH = 4;
constexpr int NH = 16, HDIM = 64, GRIDW = 64, NROWS = 128;
constexpr float RMS_EPS = 1e-6f;
#ifndef MK_N_LAUNCHES
#define MK_N_LAUNCHES 1
#endif
#ifndef NAIVE_ATTN
#define NAIVE_ATTN 0
#endif
#ifndef NAIVE_TOPK
#define NAIVE_TOPK 0
#endif
#ifndef EXPERT_FP4
#define EXPERT_FP4 1
#endif
constexpr int ROWB = EXPERT_FP4 ? 512 : 1024;
#ifndef PROBE_GMODE
#define PROBE_GMODE 0
#endif
#ifndef PROBE_PMODE
#define PROBE_PMODE 0
#endif
#ifndef PROBE_LMASK
#define PROBE_LMASK 15
#endif
#ifndef PROBE_REP
#define PROBE_REP -1
#endif
constexpr int PH_PER_LAYER = 7, N_PHASES = 1 + DEPTH * PH_PER_LAYER;

constexpr size_t MiB = 1u << 20;
constexpr size_t WS_CTL = 0, CTL_ZERO_BYTES = 32 * 1024;
constexpr size_t WS_WQK = 2 * MiB;
constexpr size_t WS_WV = 10 * MiB;
constexpr size_t WS_WO = 14 * MiB;
constexpr size_t WS_WIN = 18 * MiB;
constexpr size_t WS_WOUT = 30 * MiB;
constexpr size_t WS_WP = 34 * MiB;
constexpr size_t WS_H = 64 * MiB;
constexpr size_t WS_HN = 128 * MiB;
constexpr size_t WS_BIG = 160 * MiB;
constexpr size_t WS_VT = 224 * MiB;
constexpr size_t WS_MIX = 256 * MiB;
constexpr size_t WS_SELI = 288 * MiB;
constexpr size_t WS_SELG = 296 * MiB;
constexpr size_t WS_UP = 320 * MiB;
constexpr size_t WS_DN = 384 * MiB;
constexpr size_t WS_SUP = 448 * MiB;
constexpr size_t WS_RSS = 450 * MiB;
constexpr size_t WS_SC = 576 * MiB;
constexpr size_t WS_END = 704 * MiB;
constexpr int CW_BAR = 4096;
static_assert((CW_BAR + 3456) * 4 <= (int)CTL_ZERO_BYTES, "barrier words inside the per-call memset");

constexpr int LDS_BYTES = 163840, MISC_OFF = LDS_BYTES - 256, PTAB_OFF = LDS_BYTES - 512;

#define LAS __attribute__((address_space(3)))
typedef unsigned short bf16;
typedef unsigned v4u __attribute__((ext_vector_type(4)));
typedef unsigned v2u __attribute__((ext_vector_type(2)));
typedef float f32x4 __attribute__((ext_vector_type(4)));
typedef short bf16x8 __attribute__((ext_vector_type(8)));
#define LDS_WAIT() asm volatile("s_waitcnt lgkmcnt(0)" ::: "memory")
#define BLOCK_BAR() do { asm volatile("s_waitcnt vmcnt(0) lgkmcnt(0)" ::: "memory"); __builtin_amdgcn_s_barrier(); asm volatile("" ::: "memory"); } while (0)
__device__ __forceinline__ unsigned f2bf(float f) { unsigned u = __builtin_bit_cast(unsigned, f); return (u + 0x7fffu + ((u >> 16) & 1u)) >> 16; }
typedef float f32x2p __attribute__((ext_vector_type(2))); typedef __bf16 bf16x2p __attribute__((ext_vector_type(2)));
__device__ __forceinline__ unsigned pk2(float lo, float hi) { const f32x2p v = {lo, hi}; return __builtin_bit_cast(unsigned, __builtin_convertvector(v, bf16x2p)); }
__device__ __forceinline__ float bflo(unsigned u) { return __builtin_bit_cast(float, u << 16); }
__device__ __forceinline__ float bfhi(unsigned u) { return __builtin_bit_cast(float, u & 0xffff0000u); }
__device__ __forceinline__ float wave_sum(float v) {
#pragma unroll
    for (int o = 1; o < 64; o <<= 1) v += __shfl_xor(v, o);
    return v;
}

#define XB_TMO      128
#define XB_XCNT(j)  (256  + 64 * (j))
#define XB_XSUB(j)  (1280 + 64 * (j))
#define XB_XGEN(j)  (2304 + 64 * (j))
#define XB_TOP      3328
#define XB_TOPGEN   3392
#define XCD_BAR_WORDS 3456
#define XB_SPIN_CAP (1u << 20)
__device__ __forceinline__ unsigned xb_ld(unsigned* p)              { return __hip_atomic_load(p, __ATOMIC_RELAXED, __HIP_MEMORY_SCOPE_AGENT); }
__device__ __forceinline__ unsigned xb_add(unsigned* p, unsigned v) { return __hip_atomic_fetch_add(p, v, __ATOMIC_RELAXED, __HIP_MEMORY_SCOPE_AGENT); }
__device__ __forceinline__ unsigned xb_xcc_id() { return (unsigned)__builtin_amdgcn_s_getreg((3 << 11) | 20) & 0xFu; }
#define XB_SPIN(cond, bar) do { unsigned _sp = 0; while (cond) { __builtin_amdgcn_s_sleep(1); \
    if ((++_sp & 255u) == 0u) { if (xb_ld(&(bar)[XB_TMO])) break; if (_sp > XB_SPIN_CAP) { atomicAdd(&(bar)[XB_TMO], 1u); break; } } } } while (0)
struct XcdBarrier { unsigned* bar; unsigned x; volatile LAS unsigned* st; };
__device__ __forceinline__ XcdBarrier xcd_barrier_post(unsigned* bar, volatile LAS unsigned* st) {
    XcdBarrier b; b.bar = bar; b.x = xb_xcc_id(); b.st = st;
    if (threadIdx.x == 0) (void)xb_add(&bar[XB_XCNT(b.x)], 1u);
    return b;
}
__device__ __forceinline__ void xcd_barrier_complete(unsigned* bar, unsigned x, unsigned& nloc, unsigned& nx) {
    const unsigned G = gridDim.x * gridDim.y * gridDim.z;
    unsigned sum, cnt, mine, sp = 0u;
    for (;;) {
        sum = 0u; cnt = 0u; mine = 0u;
#pragma unroll
        for (unsigned j = 0; j < 16; ++j) { const unsigned c = xb_ld(&bar[XB_XCNT(j)]); sum += c; cnt += (c > 0u) ? 1u : 0u; mine = (j == x) ? c : mine; }
        if (sum == G) break;
        __builtin_amdgcn_s_sleep(1);
        if ((++sp & 255u) == 0u) { if (xb_ld(&bar[XB_TMO])) break; if (sp > XB_SPIN_CAP) { atomicAdd(&bar[XB_TMO], 1u); break; } }
    }
    nloc = mine > 0u ? mine : 1u; nx = cnt > 0u ? cnt : 1u;
}
__device__ __forceinline__ void xcd_barrier(const XcdBarrier& b) {
    asm volatile("s_waitcnt vmcnt(0)" ::: "memory");
    __syncthreads();
    if (threadIdx.x == 0) {
        unsigned* bar = b.bar;
        __builtin_amdgcn_s_waitcnt(0);
        unsigned nloc = b.st[0], nx = b.st[1];
        if (nloc == 0u) { xcd_barrier_complete(bar, b.x, nloc, nx); b.st[0] = nloc; b.st[1] = nx; }
        const unsigned old = xb_add(&bar[XB_XSUB(b.x)], 1u);
        const unsigned gen = old / nloc;
        if (old + 1u == (gen + 1u) * nloc) {
            __builtin_amdgcn_fence(__ATOMIC_RELEASE, "agent");
            asm volatile("s_waitcnt vmcnt(0)" ::: "memory");
            const unsigned og = xb_add(&bar[XB_TOP], 1u);
            const unsigned tg = og / nx;
            if (og + 1u == (tg + 1u) * nx) xb_add(&bar[XB_TOPGEN], 1u);
            else XB_SPIN(xb_ld(&bar[XB_TOPGEN]) == tg, bar);
            __builtin_amdgcn_fence(__ATOMIC_ACQUIRE, "agent");
            xb_add(&bar[XB_XGEN(b.x)], 1u);
            asm volatile("s_waitcnt vmcnt(0)" ::: "memory");
        } else {
            XB_SPIN(xb_ld(&bar[XB_XGEN(b.x)]) == gen, bar);
            __builtin_amdgcn_fence(__ATOMIC_ACQUIRE, "agent");
            asm volatile("s_waitcnt vmcnt(0)" ::: "memory");
        }
    }
    __syncthreads();
}

struct Frame {
    LAS unsigned char* lds;
    int tid, lane, wave, vcu, G;
    unsigned char* ws;
    __device__ __forceinline__ const float* in(int i) const {
        const volatile LAS unsigned* t = (const volatile LAS unsigned*)(lds + PTAB_OFF);
        const unsigned lo = __builtin_amdgcn_readfirstlane(t[2 * i]), hi = __builtin_amdgcn_readfirstlane(t[2 * i + 1]);
        return (const float*)(const __attribute__((address_space(1))) float*)(((unsigned long long)hi << 32) | lo);
    }
    __device__ __forceinline__ float* out() const { return (float*)in(14); }
};

template <bool FIRST> struct EpiRes {
    static constexpr bool PERM = false, AFTER_DRAIN = false;
    const void* hin; bf16* h; float* rss;
    __device__ __forceinline__ void operator()(const pg8::f32x4 (&acc)[2][2][4][2], const pg8::Unit& u, int wr, int wc, int fr, int fq) const {
        const int col0 = u.pn * 256 + wc * 32 + 4 * fq;
#pragma unroll
        for (int ai = 0; ai < 2; ++ai)
#pragma unroll
            for (int m = 0; m < 4; ++m) { const int row = u.pm * 256 + ai * 128 + wr * 64 + m * 16 + fr; bf16* rowp = h + (size_t)row * D + col0;
                float ss = 0.f;
#pragma unroll
                for (int bj = 0; bj < 2; ++bj)
#pragma unroll
                    for (int n = 0; n < 2; ++n) { f32x4 v;
                        if (FIRST) v = *(const f32x4*)((const float*)hin + (size_t)row * D + col0 + bj * 128 + n * 16);
                        else { const v2u hw = *(const v2u*)((const bf16*)hin + (size_t)row * D + col0 + bj * 128 + n * 16); v = (f32x4){bflo(hw.x), bfhi(hw.x), bflo(hw.y), bfhi(hw.y)}; }
                        v += acc[ai][bj][m][n];
                        ss += (v.x * v.x + v.y * v.y) + (v.z * v.z + v.w * v.w);
                        v2u w; w.x = pk2(v.x, v.y); w.y = pk2(v.z, v.w); *(v2u*)(rowp + bj * 128 + n * 16) = w; }
                ss += __shfl_xor(ss, 16); ss += __shfl_xor(ss, 32);
                if (fq == 0) rss[(size_t)row * 16 + u.pn * 4 + wc] = ss; }
    }
};
struct EpiConvIn {
    static constexpr bool PERM = true, AFTER_DRAIN = false;
    bf16* U; bf16* GB;
    __device__ __forceinline__ void operator()(const pg8::f32x4 (&acc)[2][2][4][2], const pg8::Unit& u, int wr, int wc, int fr, int fq) const {
        const int row0 = u.pm * 256 + wr * 64 + fr;
        if (u.pn < 8) {
            const int ch0 = u.pn * 128 + wc * 32 + 8 * fq;
#pragma unroll
            for (int ai = 0; ai < 2; ++ai)
#pragma unroll
                for (int m = 0; m < 4; ++m) { const f32x4 p0 = acc[ai][0][m][0] * acc[ai][1][m][0], p1 = acc[ai][0][m][1] * acc[ai][1][m][1];
                    v4u w; w.x = pk2(p0[0], p0[1]); w.y = pk2(p0[2], p0[3]); w.z = pk2(p1[0], p1[1]); w.w = pk2(p1[2], p1[3]);
                    *(v4u*)(U + (size_t)(row0 + ai * 128 + m * 16) * D + ch0) = w; }
        } else {
            const int col0 = (u.pn - 8) * 256 + wc * 32 + 8 * fq;
#pragma unroll
            for (int ai = 0; ai < 2; ++ai)
#pragma unroll
                for (int m = 0; m < 4; ++m)
#pragma unroll
                    for (int bj = 0; bj < 2; ++bj) { const f32x4 v0 = acc[ai][bj][m][0], v1 = acc[ai][bj][m][1];
                        v4u w; w.x = pk2(v0[0], v0[1]); w.y = pk2(v0[2], v0[3]); w.z = pk2(v1[0], v1[1]); w.w = pk2(v1[2], v1[3]);
                        *(v4u*)(GB + (size_t)(row0 + ai * 128 + m * 16) * D + col0 + bj * 128) = w; }
        }
    }
};
struct EpiF32 {
    static constexpr bool PERM = false, AFTER_DRAIN = false;
    float* O; int ldc;
    __device__ __forceinline__ void operator()(const pg8::f32x4 (&acc)[2][2][4][2], const pg8::Unit& u, int wr, int wc, int fr, int fq) const {
        const int col0 = u.pn * 256 + wc * 32 + 4 * fq;
#pragma unroll
        for (int ai = 0; ai < 2; ++ai)
#pragma unroll
            for (int m = 0; m < 4; ++m) { float* rowp = O + (size_t)(u.pm * 256 + ai * 128 + wr * 64 + m * 16 + fr) * ldc + col0;
#pragma unroll
                for (int bj = 0; bj < 2; ++bj)
#pragma unroll
                    for (int n = 0; n < 2; ++n) *(f32x4*)(rowp + bj * 128 + n * 16) = acc[ai][bj][m][n]; }
    }
};
struct EpiTopK {
    static constexpr bool PERM = false, AFTER_DRAIN = true;
    int* seli; float* selg; const float* rss;
    __device__ __forceinline__ void operator()(const pg8::f32x4 (&)[2][2][4][2], const pg8::Unit&, int, int, int, int) const {}
    __device__ __forceinline__ void fused(pg8::f32x4 (&acc)[2][2][4][2], const pg8::Unit& u, int wr, int wc, int fr, int fq, LAS unsigned char* lds, int wid, int lane) const {
        LAS float* S = (LAS float*)lds;
        LAS int* L = (LAS int*)lds;
        const int tid = wid * 64 + lane;
#pragma unroll 1
        for (int ai = 0; ai < 2; ++ai) {
#pragma unroll
            for (int m = 0; m < 4; ++m)
#pragma unroll
                for (int bj = 0; bj < 2; ++bj)
#pragma unroll
                    for (int n = 0; n < 2; ++n) {
                        const int row = wr * 64 + m * 16 + fr, col = bj * 128 + wc * 32 + n * 16 + 4 * fq;
                        *(LAS f32x4*)(S + row * 260 + col) = ai == 0 ? acc[0][bj][m][n] : acc[1][bj][m][n];
                    }
            BLOCK_BAR();
            const int row = tid & 127, q = tid >> 7;
            int best[16];
            {
                const LAS f32x4* sp = (const LAS f32x4*)(S + row * 260 + q * 64);
#pragma unroll
                for (int c = 0; c < 4; ++c) {
                    int x[16];
#pragma unroll
                    for (int e4 = 0; e4 < 4; ++e4) { const f32x4 v = sp[c * 4 + e4];
#pragma unroll
                        for (int e = 0; e < 4; ++e) x[e4 * 4 + e] = (tk_map(v[e]) & ~127) | (127 - ((q & 1) * 64 + c * 16 + e4 * 4 + e)); }
                    tk_sort_desc(x);
                    if (c == 0) {
#pragma unroll
                        for (int e = 0; e < 16; ++e) best[e] = x[e];
                    } else tk_merge_top(best, x);
                }
            }
            BLOCK_BAR();
#pragma unroll
            for (int e4 = 0; e4 < 4; ++e4) *(LAS v4u*)(L + row * 68 + q * 16 + e4 * 4) = (v4u){(unsigned)best[e4 * 4], (unsigned)best[e4 * 4 + 1], (unsigned)best[e4 * 4 + 2], (unsigned)best[e4 * 4 + 3]};
            BLOCK_BAR();
            if (tid < 128) {
                int a[16], b[16], t[16];
                LAS int* Lr = L + tid * 68;
#pragma unroll
                for (int e4 = 0; e4 < 4; ++e4) { const v4u va = *(LAS v4u*)(Lr + e4 * 4), vt = *(LAS v4u*)(Lr + 16 + e4 * 4);
#pragma unroll
                    for (int e = 0; e < 4; ++e) { a[e4 * 4 + e] = (int)va[e]; t[e4 * 4 + e] = (int)vt[e]; } }
                tk_merge_top(a, t);
#pragma unroll
                for (int e4 = 0; e4 < 4; ++e4) { const v4u vb = *(LAS v4u*)(Lr + 32 + e4 * 4), vt = *(LAS v4u*)(Lr + 48 + e4 * 4);
#pragma unroll
                    for (int e = 0; e < 4; ++e) { b[e4 * 4 + e] = (int)vb[e]; t[e4 * 4 + e] = (int)vt[e]; } }
                tk_merge_top(b, t);
                const int trow = u.pm * 256 + ai * 128 + tid;
                const f32x4 q0 = *(const f32x4*)(rss + (size_t)trow * 16), q1 = *(const f32x4*)(rss + (size_t)trow * 16 + 4), q2 = *(const f32x4*)(rss + (size_t)trow * 16 + 8), q3 = *(const f32x4*)(rss + (size_t)trow * 16 + 12);
                const float ssq = (((q0.x + q0.y) + (q0.z + q0.w)) + ((q1.x + q1.y) + (q1.z + q1.w))) + (((q2.x + q2.y) + (q2.z + q2.w)) + ((q3.x + q3.y) + (q3.z + q3.w)));
                const float rstd = 1.0f / sqrtf(ssq * (1.f / D) + RMS_EPS);
                const size_t o = ((size_t)trow * 8 + u.pn) * 16;
                tk_stage2(a, b, Lr, (__attribute__((address_space(1))) int*)(seli + o), (__attribute__((address_space(1))) float*)(selg + o), rstd);
            }
            BLOCK_BAR();
        }
    }
};
struct OneUnit {
    pg8::Unit u;
    __device__ __forceinline__ bool next(int i, pg8::Unit& o) const { if (i != 0) return false; o = u; return true; }
    __device__ __forceinline__ void a_ready(const pg8::Unit&) const {}
    __device__ __forceinline__ void done(const pg8::Unit&) const {}
};

__device__ __forceinline__ void p0_transpose_item(const float* W, int ldw, int ncols, bf16* WT, float scale, LAS float* scr, int item, int lane) {
    const int nblk = ncols / 64, kb = item / nblk, nb = item % nblk, k0 = 64 * kb, n0 = 64 * nb;
    f32x4 v[16];
#pragma unroll
    for (int i = 0; i < 16; ++i) v[i] = __builtin_nontemporal_load((const f32x4*)(W + (size_t)(k0 + 4 * i + (lane >> 4)) * ldw + n0 + 4 * (lane & 15)));
#pragma unroll
    for (int i = 0; i < 16; ++i) { LAS float* p = scr + (4 * i + (lane >> 4)) * 65 + 4 * (lane & 15); p[0] = v[i].x * scale; p[1] = v[i].y * scale; p[2] = v[i].z * scale; p[3] = v[i].w * scale; }
    LDS_WAIT(); asm volatile("" ::: "memory");
    const int c = lane & 7;
#pragma unroll
    for (int j = 0; j < 8; ++j) { const int n = (lane >> 3) + 8 * j; const LAS float* s = scr + (8 * c) * 65 + n;
        v4u o; o.x = pk2(s[0 * 65], s[1 * 65]); o.y = pk2(s[2 * 65], s[3 * 65]); o.z = pk2(s[4 * 65], s[5 * 65]); o.w = pk2(s[6 * 65], s[7 * 65]);
        *(v4u*)(WT + (size_t)(n0 + n) * 1024 + k0 + 8 * c) = o; }
    LDS_WAIT(); asm volatile("" ::: "memory");
}
__device__ __forceinline__ void rms_row_to_bf16(const float* xrow, const float* gain, bf16* orow, float* hcopy, int lane) {
    const f32x4* xr = (const f32x4*)xrow + lane; const f32x4* gr = (const f32x4*)gain + lane;
    f32x4 v[4]; float s = 0.f;
#pragma unroll
    for (int j = 0; j < 4; ++j) { v[j] = xr[64 * j]; s += (v[j].x * v[j].x + v[j].y * v[j].y) + (v[j].z * v[j].z + v[j].w * v[j].w); }
    if (hcopy) {
#pragma unroll
        for (int j = 0; j < 4; ++j) ((f32x4*)hcopy + lane)[64 * j] = v[j];
    }
    const float rstd = 1.0f / sqrtf(wave_sum(s) * (1.f / D) + RMS_EPS);
    unsigned long long* o8 = (unsigned long long*)orow + lane;
#pragma unroll
    for (int j = 0; j < 4; ++j) { const f32x4 g = gr[64 * j]; const f32x4 y = v[j] * rstd * g;
        o8[64 * j] = (unsigned long long)pk2(y.x, y.y) | ((unsigned long long)pk2(y.z, y.w) << 32); }
}
__device__ __forceinline__ void p0_prologue(Frame& F, bool dry) {
    if (!(dry && PROBE_PMODE == 1)) {
        LAS float* KL = (LAS float*)F.lds;
        LAS float* WL = (LAS float*)(F.lds + 128 * 132 * 4);
        const float* in10 = F.in(10); const float* in11 = F.in(11); const float* in2 = F.in(2);
        f32x4 kreg[8], wreg[4];
#define FOLD_LOAD(it_) do { const int l_ = (it_) >> 8, hp_ = ((it_) >> 4) & 15, k0_ = ((it_) & 15) * 64; \
            const float* kg_ = in11 + (size_t)(l_ * 16 + hp_) * 128 * 128; const float* wg_ = in10 + (size_t)l_ * 1024 * 2048 + (size_t)k0_ * 2048 + hp_ * 128; \
            _Pragma("unroll") for (int i = 0; i < 8; ++i) kreg[i] = *(const f32x4*)(kg_ + 4 * (F.tid + 512 * i)); \
            _Pragma("unroll") for (int i = 0; i < 4; ++i) { const int e = 4 * (F.tid + 512 * i); wreg[i] = __builtin_nontemporal_load((const f32x4*)(wg_ + (size_t)(e >> 7) * 2048 + (e & 127))); } } while (0)
        if (F.vcu < DEPTH * 16 * 16) FOLD_LOAD(F.vcu);
        for (int it = F.vcu; it < DEPTH * 16 * 16; it += F.G) {
            const int l = it >> 8, hp = (it >> 4) & 15, k0 = (it & 15) * 64;
#pragma unroll
            for (int i = 0; i < 8; ++i) { const int e = 4 * (F.tid + 512 * i), n = e >> 7, d = e & 127; *(LAS f32x4*)(KL + n * 132 + d) = kreg[i]; }
#pragma unroll
            for (int i = 0; i < 4; ++i) { const int e = 4 * (F.tid + 512 * i), kk = e >> 7, d = e & 127; *(LAS f32x4*)(WL + kk * 132 + d) = wreg[i]; }
            if (it + F.G < DEPTH * 16 * 16) FOLD_LOAD(it + F.G);
            BLOCK_BAR();
            {
                const int i16 = F.lane & 15, g4 = F.lane >> 4, nt = F.wave;
                f32x4 facc[4];
#pragma unroll
                for (int mt = 0; mt < 4; ++mt) facc[mt] = (f32x4){0.f, 0.f, 0.f, 0.f};
#pragma unroll 2
                for (int s8 = 0; s8 < 8; ++s8) {
                    const f32x4 bq = *(const LAS f32x4*)(KL + (nt * 16 + i16) * 132 + 16 * s8 + 4 * g4);
                    f32x4 aq[4];
#pragma unroll
                    for (int mt = 0; mt < 4; ++mt) aq[mt] = *(const LAS f32x4*)(WL + (mt * 16 + i16) * 132 + 16 * s8 + 4 * g4);
#pragma unroll
                    for (int t = 0; t < 4; ++t)
#pragma unroll
                        for (int mt = 0; mt < 4; ++mt) facc[mt] = __builtin_amdgcn_mfma_f32_16x16x4f32(aq[mt][t], bq[t], facc[mt], 0, 0, 0);
                }
                bf16* o = (bf16*)(F.ws + WS_WP) + (size_t)l * 2048 * 1024 + (size_t)(hp * 128 + nt * 16 + i16) * 1024 + k0 + 4 * g4;
#pragma unroll
                for (int mt = 0; mt < 4; ++mt) { const f32x4 gf = *(const f32x4*)(in2 + (size_t)l * D + k0 + mt * 16 + 4 * g4); v2u w; w.x = pk2(facc[mt][0] * gf.x, facc[mt][1] * gf.y); w.y = pk2(facc[mt][2] * gf.z, facc[mt][3] * gf.w); *(v2u*)(o + mt * 16) = w; }
            }
            BLOCK_BAR();
        }
#undef FOLD_LOAD
    }
    LAS float* scr = (LAS float*)(F.lds + F.wave * 16640);
    const int gw = F.vcu * NWAVES + F.wave, NGW = F.G * NWAVES;
    constexpr int I_SQ = 16 * 16, I_IN = 16 * 48, PER_J = 3 * I_SQ + I_SQ + I_IN + I_SQ;
    if (!(dry && PROBE_PMODE == 2)) for (int it = gw; it < 2 * PER_J; it += NGW) {
        const int j = it / PER_J; int r = it % PER_J;
        const float* wqkv = F.in(4) + (size_t)j * 1024 * 3072;
        if (r < I_SQ) { p0_transpose_item(wqkv, 3072, 1024, (bf16*)(F.ws + WS_WQK) + (size_t)j * 2048 * 1024, 0.125f, scr, r, F.lane); continue; } r -= I_SQ;
        if (r < I_SQ) { p0_transpose_item(wqkv + 1024, 3072, 1024, (bf16*)(F.ws + WS_WQK) + (size_t)j * 2048 * 1024 + (size_t)1024 * 1024, 1.f, scr, r, F.lane); continue; } r -= I_SQ;
        if (r < I_SQ) { p0_transpose_item(wqkv + 2048, 3072, 1024, (bf16*)(F.ws + WS_WV) + (size_t)j * 1024 * 1024, 1.f, scr, r, F.lane); continue; } r -= I_SQ;
        if (r < I_SQ) { p0_transpose_item(F.in(5) + (size_t)j * 1024 * 1024, 1024, 1024, (bf16*)(F.ws + WS_WO) + (size_t)j * 1024 * 1024, 1.f, scr, r, F.lane); continue; } r -= I_SQ;
        if (r < I_IN) {
            const float* win = F.in(7) + (size_t)j * 1024 * 3072; bf16* wt = (bf16*)(F.ws + WS_WIN) + (size_t)j * 3072 * 1024;
            if (r < 512) { const int blk = r >> 5, pn = blk >> 1, which = blk & 1; p0_transpose_item(win + (which ? 2048 : 1024) + 128 * pn, 3072, 128, wt + (size_t)(256 * pn + 128 * which) * 1024, 1.f, scr, r & 31, F.lane); }
            else p0_transpose_item(win, 3072, 1024, wt + (size_t)2048 * 1024, 1.f, scr, r - 512, F.lane);
            continue; } r -= I_IN;
        p0_transpose_item(F.in(9) + (size_t)j * 1024 * 1024, 1024, 1024, (bf16*)(F.ws + WS_WOUT) + (size_t)j * 1024 * 1024, 1.f, scr, r, F.lane);
    }
    if (!(dry && PROBE_PMODE == 3)) {
        constexpr int NROW = DEPTH * 16384;
        const float* in12 = F.in(12); const float* in13 = F.in(13);
#define XC_LOAD(v, r0_) do { const int tb_ = (r0_) >= NROW ? 1 : 0, rr_ = (r0_) - tb_ * NROW; const float* src_ = (tb_ ? in13 : in12) + (size_t)rr_ * 1024 + 4 * F.lane; \
            _Pragma("unroll") for (int u = 0; u < 4; ++u) _Pragma("unroll") for (int i = 0; i < 4; ++i) v[u][i] = __builtin_nontemporal_load((const f32x4*)(src_ + (size_t)u * 1024 + 256 * i)); } while (0)
#if EXPERT_FP4
#define XC_PACK(v, u, q, dstp) do { v2u w_; _Pragma("unroll") for (int jj = 0; jj < 2; ++jj) { unsigned t_ = 0u; \
                    t_ = __builtin_amdgcn_cvt_scalef32_pk_fp4_f32(t_, v[u][2 * jj].x * q, v[u][2 * jj].y * q, 1.0f, 0); t_ = __builtin_amdgcn_cvt_scalef32_pk_fp4_f32(t_, v[u][2 * jj].z * q, v[u][2 * jj].w * q, 1.0f, 1); \
                    t_ = __builtin_amdgcn_cvt_scalef32_pk_fp4_f32(t_, v[u][2 * jj + 1].x * q, v[u][2 * jj + 1].y * q, 1.0f, 2); t_ = __builtin_amdgcn_cvt_scalef32_pk_fp4_f32(t_, v[u][2 * jj + 1].z * q, v[u][2 * jj + 1].w * q, 1.0f, 3); w_[jj] = t_; } \
                *(v2u*)(dstp) = w_; } while (0)
        constexpr float QMAX = 6.0f;
#else
#define XC_PACK(v, u, q, dstp) do { v4u w_; _Pragma("unroll") for (int i = 0; i < 4; ++i) { unsigned t_ = 0u; t_ = __builtin_amdgcn_cvt_pk_fp8_f32(v[u][i].x * q, v[u][i].y * q, t_, false); t_ = __builtin_amdgcn_cvt_pk_fp8_f32(v[u][i].z * q, v[u][i].w * q, t_, true); w_[i] = t_; } \
                *(v4u*)(dstp) = w_; } while (0)
        constexpr float QMAX = 256.0f;
#endif
#define XC_I4(x_) ((unsigned)__float2int_rn(x_) & 15u)
#define XC_PACK_I4(v, u, q, dstp) do { v2u w_; _Pragma("unroll") for (int jj = 0; jj < 2; ++jj) { const f32x4 a_ = v[u][2 * jj] * q, b_ = v[u][2 * jj + 1] * q; \
                    w_[jj] = XC_I4(a_.x) | (XC_I4(a_.y) << 4) | (XC_I4(a_.z) << 8) | (XC_I4(a_.w) << 12) | (XC_I4(b_.x) << 16) | (XC_I4(b_.y) << 20) | (XC_I4(b_.z) << 24) | (XC_I4(b_.w) << 28); } \
                *(v2u*)(dstp) = w_; } while (0)
#define XC_CONV(v, r0_) do { const int tb_ = (r0_) >= NROW ? 1 : 0, rr_ = (r0_) - tb_ * NROW; \
            unsigned char* dst_ = F.ws + (tb_ ? WS_DN : WS_UP) + (size_t)rr_ * ROWB + (ROWB / 64) * F.lane; float* sc_ = (float*)(F.ws + WS_SUP) + 2 * (size_t)rr_ + tb_; \
            _Pragma("unroll") for (int u = 0; u < 4; ++u) { float mx = 0.f; \
                _Pragma("unroll") for (int i = 0; i < 4; ++i) mx = fmaxf(fmaxf(mx, fmaxf(fabsf(v[u][i].x), fabsf(v[u][i].y))), fmaxf(fabsf(v[u][i].z), fabsf(v[u][i].w))); \
                _Pragma("unroll") for (int o = 1; o < 64; o <<= 1) mx = fmaxf(mx, __shfl_xor(mx, o)); \
                if (tb_) { const float q = mx > 0.f ? 7.0f / mx : 1.0f; XC_PACK_I4(v, u, q, dst_ + (size_t)u * ROWB); if (F.lane == 0) sc_[2 * u] = mx > 0.f ? mx * (1.0f / 7.0f) : 1.0f; } \
                else { const float q = mx > 0.f ? QMAX / mx : 1.0f; XC_PACK(v, u, q, dst_ + (size_t)u * ROWB); if (F.lane == 0) sc_[2 * u] = mx > 0.f ? mx * (1.0f / QMAX) : 1.0f; } } } while (0)
        const int stepr = NGW * 4;
        f32x4 va[4][4], vb[4][4];
        int r0 = gw * 4;
        if (r0 < 2 * NROW) XC_LOAD(va, r0);
#pragma unroll 1
        for (; r0 < 2 * NROW; r0 += 2 * stepr) {
            if (r0 + stepr < 2 * NROW) XC_LOAD(vb, r0 + stepr);
            XC_CONV(va, r0);
            if (r0 + 2 * stepr < 2 * NROW) XC_LOAD(va, r0 + 2 * stepr);
            if (r0 + stepr < 2 * NROW) XC_CONV(vb, r0 + stepr);
        }
#undef XC_LOAD
#undef XC_PACK
#undef XC_PACK_I4
#undef XC_I4
#undef XC_CONV
    }
    if (!(dry && PROBE_PMODE == 4)) {
        const float* x0 = F.in(0); const f32x4* gr = (const f32x4*)F.in(1) + F.lane;
        f32x4 gq[4];
#pragma unroll
        for (int j = 0; j < 4; ++j) gq[j] = gr[64 * j];
#pragma unroll 1
        for (int m0 = gw; m0 < M; m0 += 4 * NGW) {
            f32x4 v[4][4];
#pragma unroll
            for (int u = 0; u < 4; ++u) { const int m = m0 + u * NGW; if (m < M) {
#pragma unroll
                for (int j = 0; j < 4; ++j) v[u][j] = __builtin_nontemporal_load((const f32x4*)(x0 + (size_t)m * D) + F.lane + 64 * j); } }
#pragma unroll
            for (int u = 0; u < 4; ++u) { const int m = m0 + u * NGW; if (m < M) {
                float sq = 0.f;
#pragma unroll
                for (int j = 0; j < 4; ++j) { sq += (v[u][j].x * v[u][j].x + v[u][j].y * v[u][j].y) + (v[u][j].z * v[u][j].z + v[u][j].w * v[u][j].w); }
                const float rstd = 1.0f / sqrtf(wave_sum(sq) * (1.f / D) + RMS_EPS);
                unsigned long long* o8 = (unsigned long long*)((bf16*)(F.ws + WS_HN) + (size_t)m * D) + F.lane;
#pragma unroll
                for (int j = 0; j < 4; ++j) { const f32x4 y = v[u][j] * rstd * gq[j]; o8[64 * j] = (unsigned long long)pk2(y.x, y.y) | ((unsigned long long)pk2(y.z, y.w) << 32); } } }
        }
    }
}

__device__ __forceinline__ void conv_phase(Frame& F, int j) {
    const bf16* U = (const bf16*)(F.ws + WS_BIG); const bf16* GB = (const bf16*)(F.ws + WS_BIG + 32 * MiB); bf16* mix = (bf16*)(F.ws + WS_MIX);
    const float* wc = F.in(8) + (size_t)j * 3 * 1024;
    for (int idx = F.vcu * NTHR + F.tid; idx < M * 128; idx += F.G * NTHR) {
        const int t = idx >> 7, c8 = (idx & 127) * 8, s = t & (SEQ - 1);
        const v4u gb = *(const v4u*)(GB + (size_t)t * D + c8);
        float conv[8];
#pragma unroll
        for (int e = 0; e < 8; ++e) conv[e] = 0.f;
#pragma unroll
        for (int dj = -1; dj <= 1; ++dj) {
            if (s + dj >= 0 && s + dj < SEQ) {
                const v4u uu = *(const v4u*)(U + (size_t)(t + dj) * D + c8);
                const f32x4 w0 = *(const f32x4*)(wc + (dj + 1) * 1024 + c8), w1 = *(const f32x4*)(wc + (dj + 1) * 1024 + c8 + 4);
#pragma unroll
                for (int e2 = 0; e2 < 4; ++e2) {
                    const float wl = e2 < 2 ? w0[2 * e2] : w1[2 * e2 - 4], wh = e2 < 2 ? w0[2 * e2 + 1] : w1[2 * e2 - 3];
                    conv[2 * e2] += wl * bflo(uu[e2]); conv[2 * e2 + 1] += wh * bfhi(uu[e2]);
                }
            }
        }
        v4u o;
#pragma unroll
        for (int e2 = 0; e2 < 4; ++e2) o[e2] = pk2(bflo(gb[e2]) * conv[2 * e2], bfhi(gb[e2]) * conv[2 * e2 + 1]);
        *(v4u*)(mix + (size_t)t * 1024 + c8) = o;
    }
}

constexpr int AT_KSTR = 144, AT_VSTR = 1168, AT_KOFF = 0, AT_VOFF = 576 * AT_KSTR, AT_BOFF = AT_VOFF + 64 * AT_VSTR;
static_assert(AT_BOFF + 1860 <= PTAB_OFF, "attention LDS map");
__device__ __forceinline__ void attn_phase(Frame& F, int j) {
    const bf16* QK = (const bf16*)(F.ws + WS_BIG); const bf16* VT = (const bf16*)(F.ws + WS_VT); bf16* mix = (bf16*)(F.ws + WS_MIX);
    const float* biasl = F.in(6) + (size_t)j * NH * 15 * 31;
    const int lane = F.lane, q = lane & 15, g = lane >> 4, tid = F.tid;
    LAS unsigned char* KL = F.lds + AT_KOFF; LAS unsigned char* VL = F.lds + AT_VOFF; LAS float* btab = (LAS float*)(F.lds + AT_BOFF);
    v4u kreg[9], vreg[9];
    int cur_hh = -1;
#define AT_DECODE(it, b_, hh_, r0_, R0_) const int hh_ = (it) & 15, rp_##it = ((it) >> 4) & 63, b_ = (it) >> 10, r0_ = 2 * rp_##it; int R0_ = r0_ - 4; R0_ = R0_ < 0 ? 0 : (R0_ > NROWS - 8 ? NROWS - 8 : R0_);
#define AT_PREFETCH(it) do { AT_DECODE(it, pb, phh, pr0, pR0) \
        _Pragma("unroll") for (int i = 0; i < 9; ++i) { const int c = tid + 512 * i; \
            { const int key = c >> 3, ch = c & 7; int row = pR0 + (key >> 6); row = row > NROWS - 1 ? NROWS - 1 : row; \
              kreg[i] = *(const v4u*)(QK + ((size_t)pb * SEQ + row * 64 + (key & 63)) * 2048 + 1024 + phh * 64 + ch * 8); } \
            { const int d = c / 72, kch = c - d * 72; vreg[i] = *(const v4u*)(VT + (size_t)(phh * 64 + d) * M + (size_t)pb * SEQ + pR0 * 64 + kch * 8); } } } while (0)
    int it = F.vcu;
    if (it < 2048) AT_PREFETCH(it);
    for (; it < 2048; it += F.G) {
        AT_DECODE(it, b, hh, r0, R0)
        BLOCK_BAR();
#pragma unroll
        for (int i = 0; i < 9; ++i) { const int c = tid + 512 * i;
            *(LAS v4u*)(KL + (c >> 3) * AT_KSTR + (c & 7) * 16) = kreg[i];
            const int d = c / 72, kch = c - d * 72; *(LAS v4u*)(VL + d * AT_VSTR + kch * 16) = vreg[i]; }
        if (hh != cur_hh) { if (tid < 465) btab[tid] = biasl[(size_t)hh * 465 + tid]; cur_hh = hh; }
        BLOCK_BAR();
        const int r = r0 + (F.wave >> 2), jb = F.wave & 3;
        int rs = r - 4; rs = rs < 0 ? 0 : (rs > NROWS - 8 ? NROWS - 8 : rs);
        const int lr0 = rs - R0;
        int bs = 16 * jb - 8; bs = bs < 0 ? 0 : (bs > 32 ? 32 : bs);
        const int qc = 16 * jb + q; int wst = qc - 8; wst = wst < 0 ? 0 : (wst > 48 ? 48 : wst);
        const size_t tokq = (size_t)b * SEQ + r * 64 + qc;
        bf16x8 qf[2];
#pragma unroll
        for (int ks = 0; ks < 2; ++ks) qf[ks] = *(const bf16x8*)(QK + tokq * 2048 + hh * 64 + ks * 32 + 8 * g);
        f32x4 S[8][2];
        const int kcl_a = 8 * (q >> 2) + (q & 3);
#pragma unroll
        for (int wr = 0; wr < 8; ++wr)
#pragma unroll
            for (int T = 0; T < 2; ++T) {
                const LAS unsigned char* kp = KL + ((lr0 + wr) * 64 + bs + kcl_a + 4 * T) * AT_KSTR + 16 * g;
                const bf16x8 k0 = *(const LAS bf16x8*)kp, k1 = *(const LAS bf16x8*)(kp + 64);
                f32x4 c = (f32x4){0.f, 0.f, 0.f, 0.f};
                c = __builtin_amdgcn_mfma_f32_16x16x32_bf16(k0, qf[0], c, 0, 0, 0);
                c = __builtin_amdgcn_mfma_f32_16x16x32_bf16(k1, qf[1], c, 0, 0, 0);
                S[wr][T] = c;
            }
        float mx = -3.0e38f;
#pragma unroll
        for (int wr = 0; wr < 8; ++wr) {
            const LAS float* brow = btab + (rs + wr - r + 7) * 31;
#pragma unroll
            for (int T = 0; T < 2; ++T)
#pragma unroll
                for (int i = 0; i < 4; ++i) {
                    const int kc = bs + 8 * g + 4 * T + i;
                    int co = kc - qc + 15; co = co < 0 ? 0 : (co > 30 ? 30 : co);
                    const bool valid = (kc >= wst) && (kc < wst + 16);
                    const float v = valid ? S[wr][T][i] + brow[co] : -1e30f;
                    S[wr][T][i] = v; mx = fmaxf(mx, v);
                }
        }
        mx = fmaxf(mx, __shfl_xor(mx, 16)); mx = fmaxf(mx, __shfl_xor(mx, 32));
        float sum = 0.f;
        bf16x8 pf[8];
#pragma unroll
        for (int wr = 0; wr < 8; ++wr) {
            float p[8];
#pragma unroll
            for (int T = 0; T < 2; ++T)
#pragma unroll
                for (int i = 0; i < 4; ++i) { p[4 * T + i] = __expf(S[wr][T][i] - mx); sum += p[4 * T + i]; }
            v4u w; w.x = pk2(p[0], p[1]); w.y = pk2(p[2], p[3]); w.z = pk2(p[4], p[5]); w.w = pk2(p[6], p[7]);
            pf[wr] = __builtin_bit_cast(bf16x8, w);
        }
        sum += __shfl_xor(sum, 16); sum += __shfl_xor(sum, 32);
        if (it + F.G < 2048) { const int nit = it + F.G; AT_PREFETCH(nit); }
        f32x4 O[4];
#pragma unroll
        for (int dt = 0; dt < 4; ++dt) O[dt] = (f32x4){0.f, 0.f, 0.f, 0.f};
#pragma unroll
        for (int wr = 0; wr < 8; ++wr)
#pragma unroll
            for (int dt = 0; dt < 4; ++dt) {
                const bf16x8 vf = *(const LAS bf16x8*)(VL + (dt * 16 + q) * AT_VSTR + ((lr0 + wr) * 64 + bs + 8 * g) * 2);
                O[dt] = __builtin_amdgcn_mfma_f32_16x16x32_bf16(vf, pf[wr], O[dt], 0, 0, 0);
            }
        const float inv = 1.0f / sum;
#pragma unroll
        for (int dt = 0; dt < 4; ++dt) { v2u w; w.x = pk2(O[dt][0] * inv, O[dt][1] * inv); w.y = pk2(O[dt][2] * inv, O[dt][3] * inv);
            *(v2u*)(mix + tokq * 1024 + hh * 64 + dt * 16 + 4 * g) = w; }
    }
#undef AT_DECODE
#undef AT_PREFETCH
    BLOCK_BAR();
}
#if NAIVE_ATTN
__device__ __forceinline__ void attn_naive_phase(Frame& F, int j) {
    const bf16* QK = (const bf16*)(F.ws + WS_BIG); const bf16* VT = (const bf16*)(F.ws + WS_VT); bf16* mix = (bf16*)(F.ws + WS_MIX);
    const float* biasl = F.in(6) + (size_t)j * NH * 15 * 31;
    for (int idx = F.vcu * NTHR + F.tid; idx < M * NH; idx += F.G * NTHR) {
        const int hh = idx & 15, t = idx >> 4, b = t >> 13, s = t & (SEQ - 1), r = s >> 6, qc = s & 63;
        int rs = r - 4; rs = rs < 0 ? 0 : (rs > NROWS - 8 ? NROWS - 8 : rs);
        int wst = qc - 8; wst = wst < 0 ? 0 : (wst > 48 ? 48 : wst);
        float qv[64];
#pragma unroll
        for (int c = 0; c < 8; ++c) { const v4u w = *(const v4u*)(QK + (size_t)t * 2048 + hh * 64 + c * 8);
#pragma unroll
            for (int e = 0; e < 4; ++e) { qv[c * 8 + 2 * e] = bflo(w[e]); qv[c * 8 + 2 * e + 1] = bfhi(w[e]); } }
        float mrun = -3.0e38f, lrun = 0.f, o[64];
#pragma unroll
        for (int d = 0; d < 64; ++d) o[d] = 0.f;
        for (int wr = 0; wr < 8; ++wr)
            for (int kk = 0; kk < 16; ++kk) {
                const int kc = wst + kk; const size_t tk = (size_t)b * SEQ + (rs + wr) * 64 + kc;
                float sd = 0.f;
#pragma unroll
                for (int c = 0; c < 8; ++c) { const v4u w = *(const v4u*)(QK + tk * 2048 + 1024 + hh * 64 + c * 8);
#pragma unroll
                    for (int e = 0; e < 4; ++e) sd += qv[c * 8 + 2 * e] * bflo(w[e]) + qv[c * 8 + 2 * e + 1] * bfhi(w[e]); }
                int co = kc - qc + 15; co = co < 0 ? 0 : (co > 30 ? 30 : co);
                sd += biasl[(size_t)hh * 465 + (rs + wr - r + 7) * 31 + co];
                const float mn = fmaxf(mrun, sd), al = __expf(mrun - mn), p = __expf(sd - mn);
                lrun = lrun * al + p; mrun = mn;
#pragma unroll
                for (int d = 0; d < 64; ++d) o[d] = o[d] * al + p * bflo((unsigned)VT[(size_t)(hh * 64 + d) * M + tk]);
            }
        const float inv = 1.0f / lrun;
#pragma unroll
        for (int c = 0; c < 8; ++c) { v4u w;
#pragma unroll
            for (int e = 0; e < 4; ++e) w[e] = pk2(o[c * 8 + 2 * e] * inv, o[c * 8 + 2 * e + 1] * inv);
            *(v4u*)(mix + (size_t)t * 1024 + hh * 64 + c * 8) = w; }
    }
}
#endif
#if NAIVE_TOPK
__device__ __forceinline__ void select_naive_phase(Frame& F) {
    const float* SC = (const float*)(F.ws + WS_SC); int* seli = (int*)(F.ws + WS_SELI); float* selg = (float*)(F.ws + WS_SELG);
    LAS int* AB = (LAS int*)F.lds + F.tid * 33;
    for (int idx = F.vcu * NTHR + F.tid; idx < M * 8; idx += F.G * NTHR) {
        const float* s = SC + (size_t)idx * 256;
        int a[16], b[16], t[16];
        tk_stage1<4>(s, 0, a); tk_stage1<4>(s + 64, 64, t); tk_merge_top(a, t);
        tk_stage1<4>(s + 128, 0, b); tk_stage1<4>(s + 192, 64, t); tk_merge_top(b, t);
        tk_stage2(a, b, AB, seli + (size_t)idx * 16, selg + (size_t)idx * 16);
    }
}
#endif

__device__ __forceinline__ float gelu_erf(float a) { return 0.5f * a * (1.0f + erff(a * 0.70710678118654752f)); }
typedef float f32x2g __attribute__((ext_vector_type(2)));
#if EXPERT_FP4
typedef v2u rowv;
__device__ __forceinline__ rowv row_load(const unsigned char* T, int e, int lane) { return *(const v2u*)(T + (size_t)e * ROWB + 8 * lane); }
#define ROW_PAIR(r, m) __builtin_amdgcn_cvt_scalef32_pk_f32_fp4((r)[(m) >> 2], 1.0f, (m) & 3)
#else
typedef v4u rowv;
__device__ __forceinline__ rowv row_load(const unsigned char* T, int e, int lane) { return *(const v4u*)(T + (size_t)e * ROWB + 16 * lane); }
#define ROW_PAIR(r, m) __builtin_amdgcn_cvt_pk_f32_fp8((r)[(m) >> 1], ((m) & 1) != 0)
#endif
__device__ __forceinline__ void row_axpy(f32x2g (&out)[8], const rowv d, float ak) {
    const f32x2g a2 = (f32x2g){ak, ak};
    out[0] = __builtin_elementwise_fma(a2, ROW_PAIR(d, 0), out[0]); out[1] = __builtin_elementwise_fma(a2, ROW_PAIR(d, 1), out[1]); out[2] = __builtin_elementwise_fma(a2, ROW_PAIR(d, 2), out[2]); out[3] = __builtin_elementwise_fma(a2, ROW_PAIR(d, 3), out[3]);
    out[4] = __builtin_elementwise_fma(a2, ROW_PAIR(d, 4), out[4]); out[5] = __builtin_elementwise_fma(a2, ROW_PAIR(d, 5), out[5]); out[6] = __builtin_elementwise_fma(a2, ROW_PAIR(d, 6), out[6]); out[7] = __builtin_elementwise_fma(a2, ROW_PAIR(d, 7), out[7]);
}
typedef int v8i_g __attribute__((ext_vector_type(8)));
typedef unsigned char u8x4g __attribute__((ext_vector_type(4)));
#define TR_SHUF(a, b, i0, i1, i2, i3) __builtin_amdgcn_perm((unsigned)(b), (unsigned)(a), (unsigned)((i0) | ((i1) << 8) | ((i2) << 16) | ((i3) << 24)))
__device__ __forceinline__ void tr8_nib(const unsigned (&w)[8], unsigned (&t)[8]) {
    unsigned x[8], y[8];
#pragma unroll
    for (int r = 0; r < 4; ++r) { x[r] = TR_SHUF(w[r], w[r + 4], 0, 1, 4, 5); x[r + 4] = TR_SHUF(w[r], w[r + 4], 2, 3, 6, 7); }
#pragma unroll
    for (int g = 0; g < 2; ++g)
#pragma unroll
        for (int r = 0; r < 2; ++r) { y[4 * g + r] = TR_SHUF(x[4 * g + r], x[4 * g + r + 2], 0, 4, 2, 6); y[4 * g + r + 2] = TR_SHUF(x[4 * g + r], x[4 * g + r + 2], 1, 5, 3, 7); }
#pragma unroll
    for (int p = 0; p < 4; ++p) { const unsigned e = y[2 * p], o = y[2 * p + 1];
        t[2 * p] = (e & 0x0F0F0F0Fu) | ((o << 4) & 0xF0F0F0F0u);
        t[2 * p + 1] = ((e >> 4) & 0x0F0F0F0Fu) | (o & 0xF0F0F0F0u); }
}
__device__ __forceinline__ int sel2(bool hf, int e0, int e1) { return hf ? e1 : e0; }
__device__ __forceinline__ void gather_phase(Frame& F, int layer, bool dry) {
    const unsigned char* UP = F.ws + WS_UP + (size_t)layer * 16384 * ROWB; const unsigned char* DN = F.ws + WS_DN + (size_t)layer * 16384 * ROWB;
    const f32x2g* SC2 = (const f32x2g*)(F.ws + WS_SUP) + (size_t)layer * 16384;
    const float* gain = F.in(2) + (size_t)layer * D; const float* gnext = layer < DEPTH - 1 ? F.in(1) + (size_t)(layer + 1) * D : F.in(3);
    float* outp = F.out();
    const int* seli = (const int*)(F.ws + WS_SELI); const float* selg = (const float*)(F.ws + WS_SELG);
    const bf16* H = (const bf16*)(F.ws + WS_H); bf16* HN = (bf16*)(F.ws + (dry ? WS_SC + 64 * MiB : WS_HN)); bf16* HW = (bf16*)(F.ws + (dry ? WS_SC : WS_H)); if (dry) outp = (float*)(F.ws + WS_SC);
    const int lane = F.lane, gw = F.vcu * NWAVES + F.wave, NGW = F.G * NWAVES;
    const bool b5 = lane & 32, b4 = lane & 16, b3 = lane & 8, b2 = lane & 4;
    constexpr int G_RS = 528, G_RB = 32 * G_RS, G_NSLOT = 4;
    LAS unsigned char* RB = F.lds + F.wave * G_RB;
    LAS float* ACT = (LAS float*)(F.lds + 8 * G_RB + F.wave * 512);
    LAS int* SELB = (LAS int*)(F.lds + 8 * G_RB + 8 * 512 + 8 * 1024 + F.wave * 512);
    static_assert(8 * G_RB + 8 * 512 + 8 * 1024 + 8 * 512 <= PTAB_OFF, "gather LDS map");
#pragma unroll 1
    for (int base = gw; base < M; base += G_NSLOT * NGW) {
    LAS unsigned char* X8 = F.lds + 8 * G_RB + 8 * 512 + F.wave * 1024;
    const int n16 = lane & 15, g4 = lane >> 4;
    const bool hf = lane >> 5; const int c32 = lane & 31, sg = 2 * c32 + (hf ? 1 : 0);
    v2u nhb[4]; int nidx_lo = 0, nidx_hi = 0; float ng_lo = 0.f, ng_hi = 0.f;
#define TOK_LOAD(t_) do { const bf16* hr_ = H + (size_t)(t_) * D + 4 * sg; _Pragma("unroll") for (int i = 0; i < 4; ++i) nhb[i] = __builtin_nontemporal_load((const v2u*)(hr_ + 256 * i)); \
        nidx_lo = __builtin_nontemporal_load(seli + (size_t)(t_) * 128 + lane); nidx_hi = __builtin_nontemporal_load(seli + (size_t)(t_) * 128 + 64 + lane); ng_lo = __builtin_nontemporal_load(selg + (size_t)(t_) * 128 + lane); ng_hi = __builtin_nontemporal_load(selg + (size_t)(t_) * 128 + 64 + lane); } while (0)
    if (base < M) TOK_LOAD(base);
#pragma unroll 1
    for (int slot = 0; slot < G_NSLOT; ++slot) {
        const int t = base + slot * NGW; if (t >= M) break;
        f32x4 hv[4];
#pragma unroll
        for (int i = 0; i < 4; ++i) { const unsigned w0_ = nhb[i].x, w1_ = nhb[i].y; hv[i] = (f32x4){bflo(w0_), bfhi(w0_), bflo(w1_), bfhi(w1_)}; }
        const int idx_lo = nidx_lo, idx_hi = nidx_hi; const float g_lo = ng_lo, g_hi = ng_hi;
        if (slot + 1 < G_NSLOT && t + NGW < M) TOK_LOAD(t + NGW);
        float ss = 0.f;
#pragma unroll
        for (int i = 0; i < 4; ++i) ss += (hv[i].x * hv[i].x + hv[i].y * hv[i].y) + (hv[i].z * hv[i].z + hv[i].w * hv[i].w);
        const float rstd = 1.0f / sqrtf(wave_sum(ss) * (1.f / D) + RMS_EPS);
        float xmax = 0.f;
        f32x4 xv[4];
#pragma unroll
        for (int i = 0; i < 4; ++i) { const f32x4 g = *(const f32x4*)(gain + 256 * i + 4 * sg); xv[i] = hv[i] * rstd * g;
            xmax = fmaxf(fmaxf(xmax, fmaxf(fabsf(xv[i].x), fabsf(xv[i].y))), fmaxf(fabsf(xv[i].z), fabsf(xv[i].w))); }
#pragma unroll
        for (int o = 1; o < 64; o <<= 1) xmax = fmaxf(xmax, __shfl_xor(xmax, o));
        const float qx = xmax > 0.f ? 256.0f / xmax : 1.0f, xinv = xmax > 0.f ? xmax * (1.0f / 256.0f) : 1.0f;
        {
            v4u w;
#pragma unroll
            for (int i = 0; i < 4; ++i) { unsigned tt = 0u; tt = __builtin_amdgcn_cvt_pk_fp8_f32(xv[i].x * qx, xv[i].y * qx, tt, false); tt = __builtin_amdgcn_cvt_pk_fp8_f32(xv[i].z * qx, xv[i].w * qx, tt, true); w[i] = tt; }
            *(LAS v4u*)(X8 + 16 * sg) = w;
            SELB[(lane & 1) * 64 + (lane >> 1)] = idx_lo; SELB[(lane & 1) * 64 + 32 + (lane >> 1)] = idx_hi;
        }
        LDS_WAIT(); asm volatile("" ::: "memory");
#define UP_LOAD(buf, hq) do { const LAS v4u* ip_ = (const LAS v4u*)(SELB + (hf ? 64 : 0) + 16 * (hq)); v4u i4_[4]; _Pragma("unroll") for (int k = 0; k < 4; ++k) i4_[k] = ip_[k]; \
        _Pragma("unroll") for (int k = 0; k < 16; ++k) buf[k] = *(const v4u*)(UP + (unsigned)(i4_[k >> 2][k & 3] * ROWB + 16 * c32)); } while (0)
#define DN_LOAD(buf, hb) do { const LAS v4u* ip_ = (const LAS v4u*)(SELB + (hf ? 64 : 0) + 8 * (hb)); v4u i4_[2]; i4_[0] = ip_[0]; i4_[1] = ip_[1]; \
        _Pragma("unroll") for (int k = 0; k < 8; ++k) buf[k] = *(const v4u*)(DN + (unsigned)(i4_[k >> 2][k & 3] * ROWB + 16 * c32)); } while (0)
        v4u da[8];
        {
            v4u ur[16];
            UP_LOAD(ur, 0);
#define UP_NEXT UP_LOAD(ur, hq + 1)
#pragma unroll 1
            for (int hq = 0; hq < 3; ++hq) {
                const int sel = hq < 2 ? idx_lo : idx_hi; const float gsel = hq < 2 ? g_lo : g_hi; const int lb0 = (hq & 1) * 32;
#pragma unroll
                for (int k = 0; k < 16; ++k) *(LAS v4u*)(RB + (2 * k + (hf ? 1 : 0)) * G_RS + 16 * c32) = ur[k];
                float sc[4];
#pragma unroll
                for (int hh_ = 0; hh_ < 2; ++hh_) { const int ek_ = __shfl(sel, lb0 + hh_ * 16 + 4 * g4 + (n16 & 3)); const f32x2g s2_ = SC2[ek_]; sc[2 * hh_] = s2_.x; sc[2 * hh_ + 1] = s2_.y; }
                LDS_WAIT(); asm volatile("" ::: "memory");
                UP_NEXT;
                f32x4 cc[2]; cc[0] = (f32x4){0.f, 0.f, 0.f, 0.f}; cc[1] = cc[0];
#pragma unroll
                for (int s8 = 0; s8 < 8; ++s8) { const v4u b0 = *(const LAS v4u*)(X8 + 128 * s8 + 16 * g4), b1 = *(const LAS v4u*)(X8 + 128 * s8 + 64 + 16 * g4);
                    const v8i_g bq = (v8i_g){(int)b0.x, (int)b0.y, (int)b0.z, (int)b0.w, (int)b1.x, (int)b1.y, (int)b1.z, (int)b1.w};
#pragma unroll
                    for (int hh_ = 0; hh_ < 2; ++hh_) { const v4u a4 = *(const LAS v4u*)(RB + (hh_ * 16 + n16) * G_RS + 64 * s8 + 16 * g4); const v8i_g a8 = (v8i_g){(int)a4.x, (int)a4.y, (int)a4.z, (int)a4.w, 0, 0, 0, 0};
                        cc[hh_] = __builtin_amdgcn_mfma_scale_f32_16x16x128_f8f6f4(a8, bq, cc[hh_], 4, 0, 0, 0x7f7f7f7f, 0, 0x7f7f7f7f); } }
#pragma unroll
                for (int hh_ = 0; hh_ < 2; ++hh_) { const int lb = lb0 + hh_ * 16; const f32x4 c = cc[hh_];
                    const int r_ = n16 & 3, k_ = 4 * g4 + r_;
                    const float my = r_ == 0 ? c[0] : (r_ == 1 ? c[1] : (r_ == 2 ? c[2] : c[3]));
                    const float gate = __shfl(gsel, lb + k_);
                    const float act = gelu_erf(my * sc[2 * hh_] * xinv) * gate * sc[2 * hh_ + 1];
                    if (n16 < 4) ACT[hq * 32 + hh_ * 16 + k_] = act; }
                LDS_WAIT(); asm volatile("" ::: "memory");
            }
#undef UP_NEXT
#define UP_NEXT DN_LOAD(da, 0)
            { const int hq = 3;
                const int sel = hq < 2 ? idx_lo : idx_hi; const float gsel = hq < 2 ? g_lo : g_hi; const int lb0 = (hq & 1) * 32;
#pragma unroll
                for (int k = 0; k < 16; ++k) *(LAS v4u*)(RB + (2 * k + (hf ? 1 : 0)) * G_RS + 16 * c32) = ur[k];
                float sc[4];
#pragma unroll
                for (int hh_ = 0; hh_ < 2; ++hh_) { const int ek_ = __shfl(sel, lb0 + hh_ * 16 + 4 * g4 + (n16 & 3)); const f32x2g s2_ = SC2[ek_]; sc[2 * hh_] = s2_.x; sc[2 * hh_ + 1] = s2_.y; }
                LDS_WAIT(); asm volatile("" ::: "memory");
                UP_NEXT;
                f32x4 cc[2]; cc[0] = (f32x4){0.f, 0.f, 0.f, 0.f}; cc[1] = cc[0];
#pragma unroll
                for (int s8 = 0; s8 < 8; ++s8) { const v4u b0 = *(const LAS v4u*)(X8 + 128 * s8 + 16 * g4), b1 = *(const LAS v4u*)(X8 + 128 * s8 + 64 + 16 * g4);
                    const v8i_g bq = (v8i_g){(int)b0.x, (int)b0.y, (int)b0.z, (int)b0.w, (int)b1.x, (int)b1.y, (int)b1.z, (int)b1.w};
#pragma unroll
                    for (int hh_ = 0; hh_ < 2; ++hh_) { const v4u a4 = *(const LAS v4u*)(RB + (hh_ * 16 + n16) * G_RS + 64 * s8 + 16 * g4); const v8i_g a8 = (v8i_g){(int)a4.x, (int)a4.y, (int)a4.z, (int)a4.w, 0, 0, 0, 0};
                        cc[hh_] = __builtin_amdgcn_mfma_scale_f32_16x16x128_f8f6f4(a8, bq, cc[hh_], 4, 0, 0, 0x7f7f7f7f, 0, 0x7f7f7f7f); } }
#pragma unroll
                for (int hh_ = 0; hh_ < 2; ++hh_) { const int lb = lb0 + hh_ * 16; const f32x4 c = cc[hh_];
                    const int r_ = n16 & 3, k_ = 4 * g4 + r_;
                    const float my = r_ == 0 ? c[0] : (r_ == 1 ? c[1] : (r_ == 2 ? c[2] : c[3]));
                    const float gate = __shfl(gsel, lb + k_);
                    const float act = gelu_erf(my * sc[2 * hh_] * xinv) * gate * sc[2 * hh_ + 1];
                    if (n16 < 4) ACT[hq * 32 + hh_ * 16 + k_] = act; }
                LDS_WAIT(); asm volatile("" ::: "memory");
            }
#undef UP_NEXT
        }
#undef UP_LOAD
        LDS_WAIT(); asm volatile("" ::: "memory");
        const float a_lo = ACT[lane], a_hi = ACT[64 + lane];
        float amax = fmaxf(fabsf(a_lo), fabsf(a_hi));
#pragma unroll
        for (int o = 1; o < 64; o <<= 1) amax = fmaxf(amax, __shfl_xor(amax, o));
        const float ainv = amax > 0.f ? 119.0f / amax : 0.f, tscale = amax * (1.0f / 119.0f);
        unsigned pd[4];
        {
            const int A0 = __float2int_rn(a_lo * ainv), A1 = __float2int_rn(a_hi * ainv);
            const int h0 = (A0 + 8) >> 4, l0 = A0 - 16 * h0, h1 = (A1 + 8) >> 4, l1 = A1 - 16 * h1;
            const int sh = 4 * ((lane >> 1) & 7);
            pd[0] = ((unsigned)l0 & 15u) << sh; pd[1] = ((unsigned)h0 & 15u) << sh; pd[2] = ((unsigned)l1 & 15u) << sh; pd[3] = ((unsigned)h1 & 15u) << sh;
#pragma unroll
            for (int q = 0; q < 4; ++q) { pd[q] |= (unsigned)__shfl_xor((int)pd[q], 2); pd[q] |= (unsigned)__shfl_xor((int)pd[q], 4); pd[q] |= (unsigned)__shfl_xor((int)pd[q], 8); }
        }
        int acc0[32], acc1[32];
#pragma unroll
        for (int e = 0; e < 32; ++e) { acc0[e] = 0; acc1[e] = 0; }
#define DN_STEP(buf, hb) do { const unsigned plo_ = (hb) < 4 ? pd[0] : pd[2], phi_ = (hb) < 4 ? pd[1] : pd[3]; \
            const int alo_ = sel2(hf, __builtin_amdgcn_readlane((int)plo_, ((hb) & 3) * 16), __builtin_amdgcn_readlane((int)plo_, ((hb) & 3) * 16 + 1)), ahi_ = sel2(hf, __builtin_amdgcn_readlane((int)phi_, ((hb) & 3) * 16), __builtin_amdgcn_readlane((int)phi_, ((hb) & 3) * 16 + 1)); \
            _Pragma("unroll") for (int w = 0; w < 4; ++w) { unsigned w_[8], t_[8]; \
                _Pragma("unroll") for (int r = 0; r < 8; ++r) w_[r] = buf[r][w]; \
                tr8_nib(w_, t_); \
                _Pragma("unroll") for (int c = 0; c < 8; ++c) { acc0[8 * w + c] = __builtin_amdgcn_sdot8((int)t_[c], alo_, acc0[8 * w + c], false); acc1[8 * w + c] = __builtin_amdgcn_sdot8((int)t_[c], ahi_, acc1[8 * w + c], false); } } } while (0)
        {
            v4u db[8];
            DN_LOAD(db, 1); DN_STEP(da, 0);
            DN_LOAD(da, 2); DN_STEP(db, 1);
            DN_LOAD(db, 3); DN_STEP(da, 2);
            DN_LOAD(da, 4); DN_STEP(db, 3);
            DN_LOAD(db, 5); DN_STEP(da, 4);
            DN_LOAD(da, 6); DN_STEP(db, 5);
            DN_LOAD(db, 7); DN_STEP(da, 6);
            DN_STEP(db, 7);
        }
#undef DN_LOAD
#undef DN_STEP
        int os[16];
#pragma unroll
        for (int k = 0; k < 16; ++k) { const int lo_ = acc0[k] + (acc1[k] << 4), hi_ = acc0[16 + k] + (acc1[16 + k] << 4); os[k] = (hf ? hi_ : lo_) + __shfl_xor(hf ? lo_ : hi_, 32); }
        f32x2g out[8];
#pragma unroll
        for (int e = 0; e < 8; ++e) out[e] = (f32x2g){(float)os[2 * e] * tscale, (float)os[2 * e + 1] * tscale};
        float ss2 = 0.f;
#pragma unroll
        for (int i = 0; i < 4; ++i) { hv[i].x += out[2 * i].x; hv[i].y += out[2 * i].y; hv[i].z += out[2 * i + 1].x; hv[i].w += out[2 * i + 1].y;
            ss2 += (hv[i].x * hv[i].x + hv[i].y * hv[i].y) + (hv[i].z * hv[i].z + hv[i].w * hv[i].w); }
        const float rstd2 = 1.0f / sqrtf(wave_sum(ss2) * (1.f / D) + RMS_EPS);
        f32x4 y[4];
#pragma unroll
        for (int i = 0; i < 4; ++i) y[i] = hv[i] * rstd2 * *(const f32x4*)(gnext + 256 * i + 4 * sg);
        if (layer < DEPTH - 1) {
            bf16* hw_ = HW + (size_t)t * D + 4 * sg; bf16* hn = HN + (size_t)t * D + 4 * sg;
#pragma unroll
            for (int i = 0; i < 4; ++i) { v2u a_, b_; a_.x = pk2(hv[i].x, hv[i].y); a_.y = pk2(hv[i].z, hv[i].w); b_.x = pk2(y[i].x, y[i].y); b_.y = pk2(y[i].z, y[i].w);
                *(v2u*)(hw_ + 256 * i) = a_; *(v2u*)(hn + 256 * i) = b_; }
        } else {
            float* orow = outp + (size_t)t * D + 4 * sg;
#pragma unroll
            for (int i = 0; i < 4; ++i) *(f32x4*)(orow + 256 * i) = y[i];
        }
    }
    LDS_WAIT(); asm volatile("" ::: "memory");
    }
#undef TOK_LOAD
}

struct Args { const float* in[14]; float* out; unsigned char* ws; int ph_lo, ph_hi; };
__global__ void __launch_bounds__(NTHR, 2) mega_fwd(Args args) {
    extern __shared__ __attribute__((aligned(16))) unsigned char lds[];
    Frame F;
    F.lds = (LAS unsigned char*)lds;
    F.tid = threadIdx.x; F.lane = F.tid & 63; F.wave = __builtin_amdgcn_readfirstlane(F.tid >> 6);
    F.G = gridDim.x; { const int bx = blockIdx.x; F.vcu = (F.G % 8 == 0) ? (bx % 8) * (F.G / 8) + bx / 8 : bx; }
    F.ws = args.ws;
    volatile LAS unsigned* MISC = (volatile LAS unsigned*)(F.lds + MISC_OFF);
    if (F.tid < 64) MISC[F.tid] = 0u;
    if (F.tid < 15) { const unsigned long long p = F.tid < 14 ? (unsigned long long)args.in[F.tid] : (unsigned long long)args.out;
        volatile LAS unsigned* t = (volatile LAS unsigned*)(F.lds + PTAB_OFF); t[2 * F.tid] = (unsigned)p; t[2 * F.tid + 1] = (unsigned)(p >> 32); }
    __syncthreads();
    XcdBarrier bar; bar.bar = (unsigned*)(F.ws + WS_CTL) + CW_BAR; bar.x = 0; bar.st = nullptr;
    if (MK_N_LAUNCHES == 1) bar = xcd_barrier_post((unsigned*)(F.ws + WS_CTL) + CW_BAR, MISC + 8);

#pragma unroll 1
    for (int ph = args.ph_lo; ph < args.ph_hi; ++ph) {
        bool did = true;
        const int kind_ = ph == 0 ? 7 : (ph - 1) % PH_PER_LAYER; const int nrep = (PROBE_REP >= 0 && kind_ == PROBE_REP && (ph == 0 || ((PROBE_LMASK >> ((ph - 1) / PH_PER_LAYER)) & 1))) ? 2 : 1;
#pragma unroll 1
        for (int rep = 0; rep < nrep; ++rep) {
        const bool dry = (nrep == 2 && rep == 0);
        { int t_ = threadIdx.x; asm volatile("" : "+v"(t_)); F.tid = t_; F.lane = t_ & 63; F.wave = __builtin_amdgcn_readfirstlane(t_ >> 6);
          unsigned long long ws_ = (unsigned long long)args.ws; asm volatile("" : "+s"(ws_)); F.ws = (unsigned char*)(__attribute__((address_space(1))) unsigned char*)ws_; }
#ifndef DIS_PRO
        if (ph == 0) p0_prologue(F, dry);
#else
        if (ph == 0) {}
#endif
        else {
            const int layer = (ph - 1) / PH_PER_LAYER, k = (ph - 1) % PH_PER_LAYER, j = layer >> 1; const bool is_attn = (layer & 1) == 0;
            if (k == 0) {
                if (!is_attn) {
                    pg8::Gemm g{(const pg8::bf16_t*)(F.ws + WS_HN), (const pg8::bf16_t*)(F.ws + WS_WIN) + (size_t)j * 3072 * 1024, M, 3072, D};
                    pg8::StaticOrder S; S.init(g.M, g.N, F.G, (int)blockIdx.x);
                    EpiConvIn E{(bf16*)(F.ws + WS_BIG), (bf16*)(F.ws + WS_BIG + 32 * MiB)};
                    pg8::gemm_phase<EpiConvIn, pg8::StaticOrder, true, true>(F.lds, g, S, E);
                }
                const int ng = is_attn ? 2 : 0;
#pragma unroll 1
                for (int gi = 0; gi < ng; ++gi) {
                    pg8::Gemm g; pg8::EpiBf16<0> E; E.bias = nullptr; E.split_cols = 0; E.split_stride = 0; E.scale0 = 1.f;
                    if (is_attn && gi == 0) { g = pg8::Gemm{(const pg8::bf16_t*)(F.ws + WS_HN), (const pg8::bf16_t*)(F.ws + WS_WQK) + (size_t)j * 2048 * 1024, M, 2048, D}; E.O = (pg8::bf16_t*)(F.ws + WS_BIG); E.ldc = 2048; }
                    else if (is_attn) { g = pg8::Gemm{(const pg8::bf16_t*)(F.ws + WS_WV) + (size_t)j * 1024 * 1024, (const pg8::bf16_t*)(F.ws + WS_HN), D, M, D}; E.O = (pg8::bf16_t*)(F.ws + WS_VT); E.ldc = M; }
                    else { g = pg8::Gemm{(const pg8::bf16_t*)(F.ws + WS_HN), (const pg8::bf16_t*)(F.ws + WS_WIN) + (size_t)j * 3072 * 1024, M, 3072, D}; E.O = (pg8::bf16_t*)(F.ws + WS_BIG); E.ldc = 3072; }
                    pg8::StaticOrder S; S.init(g.M, g.N, F.G, (int)blockIdx.x);
                    pg8::gemm_phase<pg8::EpiBf16<0>, pg8::StaticOrder, true, true>(F.lds, g, S, E);
                }
            } else if (k == 1) {
                if (is_attn) {
#if NAIVE_ATTN
                    attn_naive_phase(F, j);
#elif !defined(DIS_ATTN)
                    attn_phase(F, j);
#endif
                } else {
#ifndef DIS_CONV
                    conv_phase(F, j);
#endif
                }
            } else if (k == 2) {
                pg8::Gemm g{(const pg8::bf16_t*)(F.ws + WS_MIX), (const pg8::bf16_t*)(F.ws + (is_attn ? WS_WO : WS_WOUT)) + (size_t)j * 1024 * 1024, M, D, D};
                pg8::StaticOrder S; S.init(M, D, F.G, (int)blockIdx.x);
                float* rssp = (float*)(F.ws + (dry ? WS_SC + 96 * MiB : WS_RSS)); bf16* hout = (bf16*)(F.ws + (dry ? WS_SC : WS_H));
                if (layer == 0) { EpiRes<true> E{(const void*)F.in(0), hout, rssp}; pg8::gemm_phase<EpiRes<true>, pg8::StaticOrder, false, true>(F.lds, g, S, E); }
                else { EpiRes<false> E{(const void*)(F.ws + WS_H), hout, rssp}; pg8::gemm_phase<EpiRes<false>, pg8::StaticOrder, false, true>(F.lds, g, S, E); }
            } else if (k == 3) {
                did = false;
            } else if (k == 4) {
                pg8::Gemm g{(const pg8::bf16_t*)(F.ws + WS_H), (const pg8::bf16_t*)(F.ws + WS_WP) + (size_t)layer * 2048 * 1024, M, 2048, D};
                pg8::StaticOrder S; S.init(M, 2048, F.G, (int)blockIdx.x);
#if NAIVE_TOPK
                EpiF32 E{(float*)(F.ws + WS_SC), 2048};
                pg8::gemm_phase<EpiF32, pg8::StaticOrder, true, true>(F.lds, g, S, E);
#else
#ifndef DIS_TOPK
                EpiTopK E{(int*)(F.ws + WS_SELI), (float*)(F.ws + WS_SELG), (const float*)(F.ws + WS_RSS)};
#pragma unroll 1
                for (int i = 0;; ++i) { OneUnit O1; if (!S.next(i, O1.u)) break; pg8::gemm_phase<EpiTopK, OneUnit, false, true>(F.lds, g, O1, E); }
#endif
#endif
            } else if (k == 5) {
#if NAIVE_TOPK
                select_naive_phase(F);
#else
                did = false;
#endif
            } else {
#ifndef DIS_GATHER
                gather_phase(F, layer, dry);
#endif
            }
        }
        if (MK_N_LAUNCHES == 1 && dry) xcd_barrier(bar);
        }
        if (MK_N_LAUNCHES == 1 && did && ph + 1 < args.ph_hi) { xcd_barrier(bar);
#ifdef PROBE_BAR2
            xcd_barrier(bar);
#endif
        }
    }
}

extern "C" void kernel_launch(void* const* d_in, const int* in_sizes, int n_in, void* d_out, int out_size, void* d_ws, size_t ws_size, hipStream_t stream) {
    static int grid = 0;
    if (grid == 0) {
        if (n_in != 14 || out_size != M * D || ws_size < WS_END) { fprintf(stderr, "kernel_launch: unexpected shapes (n_in %d, out %d, ws %zu); nothing launched\n", n_in, out_size, ws_size); grid = -1; return; }
        int dev = 0, cus = 0, per_cu = 0;
        if (hipGetDevice(&dev) != hipSuccess || hipDeviceGetAttribute(&cus, hipDeviceAttributeMultiprocessorCount, dev) != hipSuccess) { grid = -1; return; }
        if (hipFuncSetAttribute((const void*)mega_fwd, hipFuncAttributeMaxDynamicSharedMemorySize, LDS_BYTES) != hipSuccess) { fprintf(stderr, "kernel_launch: hipFuncSetAttribute failed\n"); grid = -1; return; }
        if (hipOccupancyMaxActiveBlocksPerMultiprocessor(&per_cu, (const void*)mega_fwd, NTHR, LDS_BYTES) != hipSuccess || per_cu < 1) fprintf(stderr, "kernel_launch: note: occupancy query reports %d\n", per_cu);
        (void)hipGetLastError();
        grid = cus;
    }
    if (grid < 0) return;
    if (hipMemsetAsync((char*)d_ws + WS_CTL, 0, CTL_ZERO_BYTES, stream) != hipSuccess) return;
    Args a{};
    for (int i = 0; i < 14; ++i) a.in[i] = (const float*)d_in[i];
    a.out = (float*)d_out; a.ws = (unsigned char*)d_ws;
    if (MK_N_LAUNCHES == 1) { a.ph_lo = 0; a.ph_hi = N_PHASES; hipLaunchKernelGGL(mega_fwd, dim3(grid), dim3(NTHR), LDS_BYTES, stream, a); }
    else for (int ph = 0; ph < N_PHASES; ++ph) {
        if (ph > 0 && ((ph - 1) % PH_PER_LAYER == 3 || (!NAIVE_TOPK && (ph - 1) % PH_PER_LAYER == 5))) continue;
        a.ph_lo = ph; a.ph_hi = ph + 1; hipLaunchKernelGGL(mega_fwd, dim3(grid), dim3(NTHR), LDS_BYTES, stream, a);
    }
}
```

```cpp
#include <hip/hip_runtime.h>
#include <cstdio>
#include <cstdint>
namespace pg8 {
#define PG8_LAS __attribute__((address_space(3)))
typedef unsigned short bf16_t;
typedef short bf16x8 __attribute__((ext_vector_type(8)));
typedef float f32x4 __attribute__((ext_vector_type(4)));
typedef unsigned u32x4 __attribute__((ext_vector_type(4)));
constexpr int BM = 256, BK = 64, HALF = 128, HTB = HALF * BK * 2  , STAGE_BYTES = 8 * HTB, NXCD = 8, WGM = 8;

__host__ __device__ __forceinline__ int lds_byte(int r, int c) { const int st = (r >> 4) * 2 + (c >> 5), rr = r & 15, cc = c & 31, ob = rr * 64 + cc * 2; return st * 1024 + (ob ^ (((ob >> 9) & 1) << 5)); }
__host__ __device__ __forceinline__ void stage_rc(int b, int& R, int& C) { const int st = b / 1024, sb = b % 1024, swz = sb ^ (((sb >> 9) & 1) << 5); R = (st >> 1) * 16 + swz / 64; C = (st & 1) * 32 + (swz % 64) / 2; }
__host__ __device__ __forceinline__ int perm32(int rho) { const int n = rho >> 4, i = rho & 15; return 8 * (i >> 2) + 4 * n + (i & 3); }

struct Unit { int pm, pn; };
struct Gemm { const bf16_t* A; const bf16_t* Bt; int M, N, K; };

struct StaticOrder {
    int nM, nN, nwg, G, c;
    __host__ __device__ void init(int M, int N, int G_, int c_) { nM = M / BM; nN = N / BM; nwg = nM * nN; G = G_; c = c_; }
    __host__ __device__ bool next(int i, Unit& u) const {
        const long L = (long)i * G + c; if (L >= nwg) return false;
        int wgid = (int)L; { const int q = nwg / NXCD, r = nwg % NXCD, xcd = wgid % NXCD, off = wgid / NXCD; wgid = (xcd < r ? xcd * (q + 1) : r * (q + 1) + (xcd - r) * q) + off; }
        const int nig = WGM * nN, gid = wgid / nig, fm = gid * WGM, gsz = (nM - fm) < WGM ? (nM - fm) : WGM;
        u.pm = fm + ((wgid % nig) % gsz); u.pn = (wgid % nig) / gsz; return true;
    }
    __device__ __forceinline__ void a_ready(const Unit&) const {}
    __device__ __forceinline__ void done(const Unit&) const {}
};

__device__ __forceinline__ unsigned cvt_pk_bf16(float lo, float hi) { unsigned r; asm volatile("v_cvt_pk_bf16_f32 %0, %1, %2" : "=v"(r) : "v"(lo), "v"(hi)); return r; }
typedef float f32x2 __attribute__((ext_vector_type(2)));
__device__ __forceinline__ f32x2 gelu_pk(f32x2 v) {
    const f32x2 av = __builtin_elementwise_abs(v), d = av * 0.2316418882f + 1.0f;
    f32x2 t; t.x = __builtin_amdgcn_rcpf(d.x); t.y = __builtin_amdgcn_rcpf(d.y);
    f32x2 q = t * 0.5307027145f + (-0.7265760135f); q = q * t + 0.7107068705f; q = q * t + (-0.142248368f); q = q * t + 0.127414796f; q = q * t;
    const f32x2 s = (v * v) * (-0.72134752044f);
    f32x2 e; e.x = __builtin_amdgcn_exp2f(s.x); e.y = __builtin_amdgcn_exp2f(s.y);
    const f32x2 m = v * (q * e), r = v - m;
    f32x2 o; o.x = v.x < 0.f ? m.x : r.x; o.y = v.y < 0.f ? m.y : r.y; return o;
}

template <int ACT  > struct EpiBf16 {
    static constexpr bool PERM = true, AFTER_DRAIN = false; static_assert(ACT == 0 || ACT == 1, "EpiBf16: ACT is 0 (none) or 1 (gelu_pk)");
    bf16_t* O; int ldc; const float* bias; int split_cols; size_t split_stride; float scale0;
    __device__ __forceinline__ void operator()(const f32x4 (&acc)[2][2][4][2], const Unit& u, int wr, int wc, int fr, int fq) const {
        const int row0 = u.pm * BM + wr * 64 + fr; int colt = u.pn * BM; bf16_t* base = O;
        float sc = 1.f; if (split_cols) { const int t = colt / split_cols; base += (size_t)t * split_stride; colt -= t * split_cols; if (t == 0) sc = scale0; }
        const int col0 = colt + wc * 32 + 8 * fq, bcol0 = u.pn * BM + wc * 32 + 8 * fq;
        f32x4 bv[2][2];
#pragma unroll
        for (int bj = 0; bj < 2; ++bj)
#pragma unroll
            for (int n = 0; n < 2; ++n) bv[bj][n] = bias ? *(const f32x4*)(bias + bcol0 + bj * HALF + 4 * n) : (f32x4){0.f, 0.f, 0.f, 0.f};
#pragma unroll
        for (int ai = 0; ai < 2; ++ai)
#pragma unroll
            for (int m = 0; m < 4; ++m) { bf16_t* rowp = base + (size_t)(row0 + ai * HALF + m * 16) * ldc + col0;
#pragma unroll
                for (int bj = 0; bj < 2; ++bj) { f32x4 v0 = acc[ai][bj][m][0] + bv[bj][0], v1 = acc[ai][bj][m][1] + bv[bj][1];
                    if (ACT == 1) { f32x2 a = gelu_pk((f32x2){v0[0], v0[1]}), b = gelu_pk((f32x2){v0[2], v0[3]}), c = gelu_pk((f32x2){v1[0], v1[1]}), d = gelu_pk((f32x2){v1[2], v1[3]});
                        v0 = (f32x4){a.x, a.y, b.x, b.y}; v1 = (f32x4){c.x, c.y, d.x, d.y}; }
                    v0 = v0 * sc; v1 = v1 * sc; u32x4 w; w.x = cvt_pk_bf16(v0[0], v0[1]); w.y = cvt_pk_bf16(v0[2], v0[3]); w.z = cvt_pk_bf16(v1[0], v1[1]); w.w = cvt_pk_bf16(v1[2], v1[3]);
                    *(u32x4*)(rowp + bj * HALF) = w; } }
    }
};

template <class Epi, class Sched, bool ALIGN_EPI = false, bool SP2 = false>
__device__ __forceinline__ void gemm_phase(PG8_LAS unsigned char* lds, const Gemm g, const Sched& S, const Epi& E) {
    int tid_l = threadIdx.x; asm volatile("" : "+v"(tid_l));
    const int tid = tid_l, wid = __builtin_amdgcn_readfirstlane(tid >> 6), lane = tid & 63, wr = wid >> 2, wc = wid & 3, fr = lane & 15, fq = lane >> 4;
    const int K = g.K, nt = K / BK;
    unsigned voffA[2], voffB[2];
#pragma unroll
    for (int i = 0; i < 2; ++i) { int R, C; stage_rc(tid * 16 + i * 8192, R, C); const int Rb = Epi::PERM ? ((R & ~31) + perm32(R & 31)) : R;
        voffA[i] = (unsigned)(R * K + C) * 2u; voffB[i] = (unsigned)(Rb * K + C) * 2u; }
    const size_t kstep = (size_t)(BK * 2);
    const size_t hstep = (size_t)HALF * K * 2;
    const size_t tstep = 2 * hstep;
    const unsigned ldsw = (unsigned)wid * 1024u;
    const int aoff = lds_byte(wr * 64 + fr, fq * 8), boff = lds_byte(wc * 32 + fr, fq * 8);
#define PG8_SA(b, h) (((b) * 2 + (h)) * HTB)
#define PG8_SB(b, h) ((4 + (b) * 2 + (h)) * HTB)
#define PG8_STAGE(bufoff, gbase, voff) do { _Pragma("unroll") for (int _i = 0; _i < 2; ++_i) \
        __builtin_amdgcn_global_load_lds((const unsigned*)((const char*)(gbase) + (voff)[_i]), (PG8_LAS unsigned*)(lds + (bufoff) + ldsw + _i * 8192), 16, 0, 0); } while (0)
#define PG8_LDA(dst, b, h) do { _Pragma("unroll") for (int m = 0; m < 4; ++m) _Pragma("unroll") for (int k = 0; k < 2; ++k) dst[m][k] = *(const PG8_LAS bf16x8*)(lds + PG8_SA(b, h) + aoff + m * 2048 + k * 1024); } while (0)
#define PG8_LDB(dst, b, h) do { _Pragma("unroll") for (int n = 0; n < 2; ++n) _Pragma("unroll") for (int k = 0; k < 2; ++k) dst[n][k] = *(const PG8_LAS bf16x8*)(lds + PG8_SB(b, h) + boff + n * 2048 + k * 1024); } while (0)
#define PG8_MMA(ai, bj, At, Bt) do { __builtin_amdgcn_s_setprio(1); _Pragma("unroll") for (int m = 0; m < 4; ++m) _Pragma("unroll") for (int n = 0; n < 2; ++n) _Pragma("unroll") for (int k = 0; k < 2; ++k) \
        acc[ai][bj][m][n] = __builtin_amdgcn_mfma_f32_16x16x32_bf16(Bt[n][k], At[m][k], acc[ai][bj][m][n], 0, 0, 0); __builtin_amdgcn_s_setprio(0); } while (0)
#define PG8_WAIT_V(n) asm volatile("s_waitcnt vmcnt(" #n ")" ::: "memory")
#define PG8_WAIT_L(n) asm volatile("s_waitcnt lgkmcnt(" #n ")" ::: "memory")
#define PG8_BAR __builtin_amdgcn_s_barrier()
#define PG8_SCHED __builtin_amdgcn_sched_barrier(0)
    Unit cur, nxt; int ui = 0;
    if (!S.next(0, cur)) return;
    f32x4 acc[2][2][4][2];
#pragma unroll
    for (int a = 0; a < 2; ++a)
#pragma unroll
        for (int b = 0; b < 2; ++b)
#pragma unroll
            for (int m = 0; m < 4; ++m)
#pragma unroll
                for (int n = 0; n < 2; ++n) acc[a][b][m][n] = (f32x4){0.f, 0.f, 0.f, 0.f};
    bf16x8 At[4][2], B0[2][2], B1[2][2];
    const char* cA = (const char*)g.A + (size_t)cur.pm * tstep; const char* cB = (const char*)g.Bt + (size_t)cur.pn * tstep;
    S.a_ready(cur);
    if constexpr (SP2) {
        PG8_STAGE(PG8_SB(0, 0), cB, voffB); PG8_STAGE(PG8_SB(0, 1), cB + hstep, voffB); PG8_STAGE(PG8_SA(0, 0), cA, voffA); PG8_STAGE(PG8_SA(0, 1), cA + hstep, voffA);
        if (wr == 1) PG8_BAR;
        PG8_WAIT_V(2); PG8_BAR;
        PG8_STAGE(PG8_SB(1, 0), cB + kstep, voffB); PG8_STAGE(PG8_SA(1, 0), cA + kstep, voffA); PG8_STAGE(PG8_SB(1, 1), cB + hstep + kstep, voffB);
        PG8_WAIT_V(6); PG8_BAR;
    } else {
        PG8_STAGE(PG8_SB(0, 0), cB, voffB); PG8_STAGE(PG8_SA(0, 0), cA, voffA); PG8_STAGE(PG8_SB(0, 1), cB + hstep, voffB); PG8_STAGE(PG8_SA(0, 1), cA + hstep, voffA);
        if (wr == 1) PG8_BAR;
        PG8_WAIT_V(4); PG8_BAR;
        PG8_STAGE(PG8_SB(1, 0), cB + kstep, voffB); PG8_STAGE(PG8_SA(1, 0), cA + kstep, voffA); PG8_STAGE(PG8_SB(1, 1), cB + hstep + kstep, voffB);
        PG8_WAIT_V(6); PG8_BAR;
    }
    for (;;) {
        const bool has_next = S.next(ui + 1, nxt);
        const char* nA = has_next ? (const char*)g.A + (size_t)nxt.pm * tstep : cA; const char* nB = has_next ? (const char*)g.Bt + (size_t)nxt.pn * tstep : cB;
        for (int t = 0; t < nt; t += 2) {
            const bool last = (t == nt - 2);
            const char* a1 = cA + (size_t)(t + 1) * kstep;
            const char* a2 = last ? nA : cA + (size_t)(t + 2) * kstep; const char* b2 = last ? nB : cB + (size_t)(t + 2) * kstep;
            const char* a3 = a2 + kstep; const char* b3 = b2 + kstep;
            if (last && has_next) S.a_ready(nxt);
            if constexpr (SP2) {
            PG8_LDB(B0, 0, 0); PG8_LDB(B1, 0, 1); PG8_SCHED; PG8_LDA(At, 0, 0); PG8_STAGE(PG8_SA(1, 1), a1 + hstep, voffA);
            PG8_WAIT_V(8); PG8_WAIT_L(0); PG8_BAR; PG8_MMA(0, 0, At, B0); PG8_MMA(0, 1, At, B1); PG8_BAR; PG8_SCHED;
            PG8_LDA(At, 0, 1); PG8_STAGE(PG8_SB(0, 0), b2, voffB); PG8_STAGE(PG8_SB(0, 1), b2 + hstep, voffB); PG8_STAGE(PG8_SA(0, 0), a2, voffA);
            PG8_WAIT_V(8); PG8_WAIT_L(0); PG8_BAR; PG8_MMA(1, 0, At, B0); PG8_MMA(1, 1, At, B1); PG8_BAR; PG8_SCHED;
            PG8_LDB(B0, 1, 0); PG8_LDB(B1, 1, 1); PG8_SCHED; PG8_LDA(At, 1, 0); PG8_STAGE(PG8_SA(0, 1), a2 + hstep, voffA);
            PG8_WAIT_V(8); PG8_WAIT_L(0); PG8_BAR; PG8_MMA(0, 0, At, B0); PG8_MMA(0, 1, At, B1); PG8_BAR; PG8_SCHED;
            PG8_LDA(At, 1, 1); PG8_STAGE(PG8_SB(1, 0), b3, voffB); PG8_STAGE(PG8_SB(1, 1), b3 + hstep, voffB); PG8_STAGE(PG8_SA(1, 0), a3, voffA);
            PG8_WAIT_V(8); PG8_WAIT_L(0); PG8_BAR; PG8_MMA(1, 0, At, B0); PG8_MMA(1, 1, At, B1); PG8_BAR; PG8_SCHED;
            } else {
            PG8_LDB(B0, 0, 0); PG8_SCHED; PG8_LDA(At, 0, 0); PG8_STAGE(PG8_SA(1, 1), a1 + hstep, voffA);
            PG8_WAIT_L(8); PG8_BAR; PG8_WAIT_L(0); PG8_MMA(0, 0, At, B0); PG8_BAR; PG8_SCHED;
            PG8_LDB(B1, 0, 1); PG8_STAGE(PG8_SB(0, 0), b2, voffB);
            PG8_BAR; PG8_WAIT_L(0); PG8_MMA(0, 1, At, B1); PG8_BAR;
            PG8_LDA(At, 0, 1); PG8_STAGE(PG8_SA(0, 0), a2, voffA);
            PG8_BAR; PG8_WAIT_L(0); PG8_MMA(1, 0, At, B0); PG8_BAR; PG8_SCHED;
            PG8_STAGE(PG8_SB(0, 1), b2 + hstep, voffB);
            PG8_WAIT_V(6); PG8_BAR; PG8_MMA(1, 1, At, B1); PG8_BAR;
            PG8_LDB(B0, 1, 0); PG8_SCHED; PG8_LDA(At, 1, 0); PG8_STAGE(PG8_SA(0, 1), a2 + hstep, voffA);
            PG8_WAIT_L(8); PG8_BAR; PG8_WAIT_L(0); PG8_MMA(0, 0, At, B0); PG8_BAR; PG8_SCHED;
            PG8_LDB(B1, 1, 1); PG8_STAGE(PG8_SB(1, 0), b3, voffB);
            PG8_BAR; PG8_WAIT_L(0); PG8_MMA(0, 1, At, B1); PG8_BAR;
            PG8_LDA(At, 1, 1); PG8_STAGE(PG8_SA(1, 0), a3, voffA);
            PG8_BAR; PG8_WAIT_L(0); PG8_MMA(1, 0, At, B0); PG8_BAR; PG8_SCHED;
            PG8_STAGE(PG8_SB(1, 1), b3 + hstep, voffB);
            PG8_WAIT_V(6); PG8_BAR; PG8_MMA(1, 1, At, B1); PG8_BAR;
            }
        }
        if constexpr (ALIGN_EPI) { if (wr == 0) PG8_BAR; }
        if constexpr (!Epi::AFTER_DRAIN) { E(acc, cur, wr, wc, fr, fq); S.done(cur); }
        if (!has_next) break;
#pragma unroll
        for (int a = 0; a < 2; ++a)
#pragma unroll
            for (int b = 0; b < 2; ++b)
#pragma unroll
                for (int m = 0; m < 4; ++m)
#pragma unroll
                    for (int n = 0; n < 2; ++n) acc[a][b][m][n] = (f32x4){0.f, 0.f, 0.f, 0.f};
        cur = nxt; cA = nA; cB = nB; ++ui;
        if constexpr (ALIGN_EPI) { if (wr == 1) PG8_BAR; }
    }
    PG8_WAIT_V(0);
    if constexpr (!ALIGN_EPI) { if (wr == 0) PG8_BAR; }
    PG8_BAR;
    if constexpr (Epi::AFTER_DRAIN) { E.fused(acc, cur, wr, wc, fr, fq, lds, wid, lane); S.done(cur); }
#undef PG8_SA
#undef PG8_SB
#undef PG8_STAGE
#undef PG8_LDA
#undef PG8_LDB
#undef PG8_MMA
#undef PG8_WAIT_V
#undef PG8_WAIT_L
#undef PG8_BAR
#undef PG8_SCHED
}
}
#ifndef HD
#define HD __host__ __device__ __forceinline__
#endif
HD int tk_map(float f) { int b = __builtin_bit_cast(int, f); return b ^ ((b >> 31) & 0x7fffffff); }
HD float tk_unmap(int k) { int b = k ^ ((k >> 31) & 0x7fffffff); return __builtin_bit_cast(float, b); }
HD void tk_cx(int& a, int& b) { const int hi = a > b ? a : b, lo = a > b ? b : a; a = hi; b = lo; }
template <int N> HD void tk_sort_desc(int (&v)[N]) {
#pragma unroll
    for (int k = 2; k <= N; k <<= 1)
#pragma unroll
        for (int j = k >> 1; j > 0; j >>= 1)
#pragma unroll
            for (int i = 0; i < N; ++i) { const int l = i ^ j; if (l > i) { if ((i & k) == 0) tk_cx(v[i], v[l]); else tk_cx(v[l], v[i]); } }
}
template <int N> HD void tk_merge_top(int (&a)[N], const int (&b)[N]) {
#pragma unroll
    for (int i = 0; i < N; ++i) a[i] = a[i] > b[N - 1 - i] ? a[i] : b[N - 1 - i];
#pragma unroll
    for (int j = N >> 1; j > 0; j >>= 1)
#pragma unroll
        for (int i = 0; i < N; ++i) { const int l = i ^ j; if (l > i) tk_cx(a[i], a[l]); }
}
template <int NCH, class FP> HD void tk_stage1(FP s, int n_base, int (&best)[16]) {
#pragma unroll
    for (int c = 0; c < NCH; ++c) {
        int x[16];
#pragma unroll
        for (int e = 0; e < 16; ++e) x[e] = (tk_map(s[c * 16 + e]) & ~127) | (127 - (n_base + c * 16 + e));
        tk_sort_desc(x);
        if (c == 0) {
#pragma unroll
            for (int e = 0; e < 16; ++e) best[e] = x[e];
        } else tk_merge_top(best, x);
    }
}
template <class IP, class OI, class OG> HD void tk_stage2(int (&a)[16], int (&b)[16], IP AB, OI out_idx, OG out_g, float vscale = 1.0f) {
    float va[16], vb[16];
#pragma unroll
    for (int i = 0; i < 16; ++i) { AB[i] = a[i]; AB[16 + i] = b[i]; va[i] = tk_unmap(a[i] & ~127); vb[i] = tk_unmap(b[i] & ~127); }
    int best[16];
#pragma unroll
    for (int c = 0; c < 4; ++c) {
        int x[16];
#pragma unroll
        for (int e = 0; e < 16; ++e) x[e] = (int)0x80000000;
        int n = 0;
#pragma unroll
        for (int i = 0; i < 16; ++i)
#pragma unroll
            for (int j = 0; j < 16; ++j)
                if ((i + 1) * (j + 1) <= 16) { if (n >= 16 * c && n < 16 * c + 16) x[n - 16 * c] = (tk_map(va[i] + vb[j]) & ~255) | (255 - (i * 16 + j)); ++n; }
        tk_sort_desc(x);
        if (c == 0) {
#pragma unroll
            for (int e = 0; e < 16; ++e) best[e] = x[e];
        } else tk_merge_top(best, x);
    }
    int ka[16], kb[16];
#pragma unroll
    for (int k = 0; k < 16; ++k) { const int flat = 255 - (best[k] & 255); ka[k] = AB[flat >> 4]; kb[k] = AB[16 + (flat & 15)]; }
    float sv[16]; int ei[16]; float sum = 0.f;
#pragma unroll
    for (int k = 0; k < 16; ++k) { ei[k] = (127 - (ka[k] & 127)) * 128 + (127 - (kb[k] & 127)); sv[k] = (tk_unmap(ka[k] & ~127) + tk_unmap(kb[k] & ~127)) * vscale; }
    const float m = sv[0];
#pragma unroll
    for (int k = 0; k < 16; ++k) { sv[k] = __expf(sv[k] - m); sum += sv[k]; }
    const float inv = 1.0f / sum;
#pragma unroll
    for (int k = 0; k < 16; ++k) { out_idx[k] = ei[k]; out_g[k] = sv[k] * inv; }
}
constexpr int NWAVES = 8, NTHR = 512;
constexpr int BATCH = 2, SEQ = 8192, D = 1024, M = BATCH * SEQ, DEPTH = 4;
constexpr int NH = 16, HDIM = 64, GRIDW = 64, NROWS = 128;
constexpr float RMS_EPS = 1e-6f;
#ifndef MK_N_LAUNCHES
#define MK_N_LAUNCHES 1
#endif
#ifndef NAIVE_ATTN
#define NAIVE_ATTN 0
#endif
#ifndef NAIVE_TOPK
#define NAIVE_TOPK 0
#endif
#ifndef EXPERT_FP4
#define EXPERT_FP4 1
#endif
constexpr int ROWB = EXPERT_FP4 ? 512 : 1024;
#ifndef PROBE_GMODE
#define PROBE_GMODE 0
#endif
#ifndef PROBE_PMODE
#define PROBE_PMODE 0
#endif
#ifndef PROBE_LMASK
#define PROBE_LMASK 15
#endif
#ifndef PROBE_REP
#define PROBE_REP -1
#endif
constexpr int PH_PER_LAYER = 7, N_PHASES = 1 + DEPTH * PH_PER_LAYER;

constexpr size_t MiB = 1u << 20;
constexpr size_t WS_CTL = 0, CTL_ZERO_BYTES = 32 * 1024;
constexpr size_t WS_WQK = 2 * MiB;
constexpr size_t WS_WV = 10 * MiB;
constexpr size_t WS_WO = 14 * MiB;
constexpr size_t WS_WIN = 18 * MiB;
constexpr size_t WS_WOUT = 30 * MiB;
constexpr size_t WS_WP = 34 * MiB;
constexpr size_t WS_H = 64 * MiB;
constexpr size_t WS_HN = 128 * MiB;
constexpr size_t WS_BIG = 160 * MiB;
constexpr size_t WS_VT = 224 * MiB;
constexpr size_t WS_MIX = 256 * MiB;
constexpr size_t WS_SELI = 288 * MiB;
constexpr size_t WS_SELG = 296 * MiB;
constexpr size_t WS_UP = 320 * MiB;
constexpr size_t WS_DN = 384 * MiB;
constexpr size_t WS_SUP = 448 * MiB;
constexpr size_t WS_RSS = 450 * MiB;
constexpr size_t WS_SC = 576 * MiB;
constexpr size_t WS_END = 704 * MiB;
constexpr int CW_BAR = 4096;
static_assert((CW_BAR + 3456) * 4 <= (int)CTL_ZERO_BYTES, "barrier words inside the per-call memset");

constexpr int LDS_BYTES = 163840, MISC_OFF = LDS_BYTES - 256, PTAB_OFF = LDS_BYTES - 512;

#define LAS __attribute__((address_space(3)))
typedef unsigned short bf16;
typedef unsigned v4u __attribute__((ext_vector_type(4)));
typedef unsigned v2u __attribute__((ext_vector_type(2)));
typedef float f32x4 __attribute__((ext_vector_type(4)));
typedef short bf16x8 __attribute__((ext_vector_type(8)));
#define LDS_WAIT() asm volatile("s_waitcnt lgkmcnt(0)" ::: "memory")
#define BLOCK_BAR() do { asm volatile("s_waitcnt vmcnt(0) lgkmcnt(0)" ::: "memory"); __builtin_amdgcn_s_barrier(); asm volatile("" ::: "memory"); } while (0)
__device__ __forceinline__ unsigned f2bf(float f) { unsigned u = __builtin_bit_cast(unsigned, f); return (u + 0x7fffu + ((u >> 16) & 1u)) >> 16; }
typedef float f32x2p __attribute__((ext_vector_type(2))); typedef __bf16 bf16x2p __attribute__((ext_vector_type(2)));
__device__ __forceinline__ unsigned pk2(float lo, float hi) { const f32x2p v = {lo, hi}; return __builtin_bit_cast(unsigned, __builtin_convertvector(v, bf16x2p)); }
__device__ __forceinline__ float bflo(unsigned u) { return __builtin_bit_cast(float, u << 16); }
__device__ __forceinline__ float bfhi(unsigned u) { return __builtin_bit_cast(float, u & 0xffff0000u); }
__device__ __forceinline__ float wave_sum(float v) {
#pragma unroll
    for (int o = 1; o < 64; o <<= 1) v += __shfl_xor(v, o);
    return v;
}

#define XB_TMO      128
#define XB_XCNT(j)  (256  + 64 * (j))
#define XB_XSUB(j)  (1280 + 64 * (j))
#define XB_XGEN(j)  (2304 + 64 * (j))
#define XB_TOP      3328
#define XB_TOPGEN   3392
#define XCD_BAR_WORDS 3456
#define XB_SPIN_CAP (1u << 20)
__device__ __forceinline__ unsigned xb_ld(unsigned* p)              { return __hip_atomic_load(p, __ATOMIC_RELAXED, __HIP_MEMORY_SCOPE_AGENT); }
__device__ __forceinline__ unsigned xb_add(unsigned* p, unsigned v) { return __hip_atomic_fetch_add(p, v, __ATOMIC_RELAXED, __HIP_MEMORY_SCOPE_AGENT); }
__device__ __forceinline__ unsigned xb_xcc_id() { return (unsigned)__builtin_amdgcn_s_getreg((3 << 11) | 20) & 0xFu; }
#define XB_SPIN(cond, bar) do { unsigned _sp = 0; while (cond) { __builtin_amdgcn_s_sleep(1); \
    if ((++_sp & 255u) == 0u) { if (xb_ld(&(bar)[XB_TMO])) break; if (_sp > XB_SPIN_CAP) { atomicAdd(&(bar)[XB_TMO], 1u); break; } } } } while (0)
struct XcdBarrier { unsigned* bar; unsigned x; volatile LAS unsigned* st; };
__device__ __forceinline__ XcdBarrier xcd_barrier_post(unsigned* bar, volatile LAS unsigned* st) {
    XcdBarrier b; b.bar = bar; b.x = xb_xcc_id(); b.st = st;
    if (threadIdx.x == 0) (void)xb_add(&bar[XB_XCNT(b.x)], 1u);
    return b;
}
__device__ __forceinline__ void xcd_barrier_complete(unsigned* bar, unsigned x, unsigned& nloc, unsigned& nx) {
    const unsigned G = gridDim.x * gridDim.y * gridDim.z;
    unsigned sum, cnt, mine, sp = 0u;
    for (;;) {
        sum = 0u; cnt = 0u; mine = 0u;
#pragma unroll
        for (unsigned j = 0; j < 16; ++j) { const unsigned c = xb_ld(&bar[XB_XCNT(j)]); sum += c; cnt += (c > 0u) ? 1u : 0u; mine = (j == x) ? c : mine; }
        if (sum == G) break;
        __builtin_amdgcn_s_sleep(1);
        if ((++sp & 255u) == 0u) { if (xb_ld(&bar[XB_TMO])) break; if (sp > XB_SPIN_CAP) { atomicAdd(&bar[XB_TMO], 1u); break; } }
    }
    nloc = mine > 0u ? mine : 1u; nx = cnt > 0u ? cnt : 1u;
}
__device__ __forceinline__ void xcd_barrier(const XcdBarrier& b) {
    asm volatile("s_waitcnt vmcnt(0)" ::: "memory");
    __syncthreads();
    if (threadIdx.x == 0) {
        unsigned* bar = b.bar;
        __builtin_amdgcn_s_waitcnt(0);
        unsigned nloc = b.st[0], nx = b.st[1];
        if (nloc == 0u) { xcd_barrier_complete(bar, b.x, nloc, nx); b.st[0] = nloc; b.st[1] = nx; }
        const unsigned old = xb_add(&bar[XB_XSUB(b.x)], 1u);
        const unsigned gen = old / nloc;
        if (old + 1u == (gen + 1u) * nloc) {
            __builtin_amdgcn_fence(__ATOMIC_RELEASE, "agent");
            asm volatile("s_waitcnt vmcnt(0)" ::: "memory");
            const unsigned og = xb_add(&bar[XB_TOP], 1u);
            const unsigned tg = og / nx;
            if (og + 1u == (tg + 1u) * nx) xb_add(&bar[XB_TOPGEN], 1u);
            else XB_SPIN(xb_ld(&bar[XB_TOPGEN]) == tg, bar);
            __builtin_amdgcn_fence(__ATOMIC_ACQUIRE, "agent");
            xb_add(&bar[XB_XGEN(b.x)], 1u);
            asm volatile("s_waitcnt vmcnt(0)" ::: "memory");
        } else {
            XB_SPIN(xb_ld(&bar[XB_XGEN(b.x)]) == gen, bar);
            __builtin_amdgcn_fence(__ATOMIC_ACQUIRE, "agent");
            asm volatile("s_waitcnt vmcnt(0)" ::: "memory");
        }
    }
    __syncthreads();
}

struct Frame {
    LAS unsigned char* lds;
    int tid, lane, wave, vcu, G;
    unsigned char* ws;
    __device__ __forceinline__ const float* in(int i) const {
        const volatile LAS unsigned* t = (const volatile LAS unsigned*)(lds + PTAB_OFF);
        const unsigned lo = __builtin_amdgcn_readfirstlane(t[2 * i]), hi = __builtin_amdgcn_readfirstlane(t[2 * i + 1]);
        return (const float*)(const __attribute__((address_space(1))) float*)(((unsigned long long)hi << 32) | lo);
    }
    __device__ __forceinline__ float* out() const { return (float*)in(14); }
};

template <bool FIRST> struct EpiRes {
    static constexpr bool PERM = false, AFTER_DRAIN = false;
    const void* hin; bf16* h; float* rss;
    __device__ __forceinline__ void operator()(const pg8::f32x4 (&acc)[2][2][4][2], const pg8::Unit& u, int wr, int wc, int fr, int fq) const {
        const int col0 = u.pn * 256 + wc * 32 + 4 * fq;
#pragma unroll
        for (int ai = 0; ai < 2; ++ai)
#pragma unroll
            for (int m = 0; m < 4; ++m) { const int row = u.pm * 256 + ai * 128 + wr * 64 + m * 16 + fr; bf16* rowp = h + (size_t)row * D + col0;
                float ss = 0.f;
#pragma unroll
                for (int bj = 0; bj < 2; ++bj)
#pragma unroll
                    for (int n = 0; n < 2; ++n) { f32x4 v;
                        if (FIRST) v = *(const f32x4*)((const float*)hin + (size_t)row * D + col0 + bj * 128 + n * 16);
                        else { const v2u hw = *(const v2u*)((const bf16*)hin + (size_t)row * D + col0 + bj * 128 + n * 16); v = (f32x4){bflo(hw.x), bfhi(hw.x), bflo(hw.y), bfhi(hw.y)}; }
                        v += acc[ai][bj][m][n];
                        ss += (v.x * v.x + v.y * v.y) + (v.z * v.z + v.w * v.w);
                        v2u w; w.x = pk2(v.x, v.y); w.y = pk2(v.z, v.w); *(v2u*)(rowp + bj * 128 + n * 16) = w; }
                ss += __shfl_xor(ss, 16); ss += __shfl_xor(ss, 32);
                if (fq == 0) rss[(size_t)row * 16 + u.pn * 4 + wc] = ss; }
    }
};
struct EpiConvIn {
    static constexpr bool PERM = true, AFTER_DRAIN = false;
    bf16* U; bf16* GB;
    __device__ __forceinline__ void operator()(const pg8::f32x4 (&acc)[2][2][4][2], const pg8::Unit& u, int wr, int wc, int fr, int fq) const {
        const int row0 = u.pm * 256 + wr * 64 + fr;
        if (u.pn < 8) {
            const int ch0 = u.pn * 128 + wc * 32 + 8 * fq;
#pragma unroll
            for (int ai = 0; ai < 2; ++ai)
#pragma unroll
                for (int m = 0; m < 4; ++m) { const f32x4 p0 = acc[ai][0][m][0] * acc[ai][1][m][0], p1 = acc[ai][0][m][1] * acc[ai][1][m][1];
                    v4u w; w.x = pk2(p0[0], p0[1]); w.y = pk2(p0[2], p0[3]); w.z = pk2(p1[0], p1[1]); w.w = pk2(p1[2], p1[3]);
                    *(v4u*)(U + (size_t)(row0 + ai * 128 + m * 16) * D + ch0) = w; }
        } else {
            const int col0 = (u.pn - 8) * 256 + wc * 32 + 8 * fq;
#pragma unroll
            for (int ai = 0; ai < 2; ++ai)
#pragma unroll
                for (int m = 0; m < 4; ++m)
#pragma unroll
                    for (int bj = 0; bj < 2; ++bj) { const f32x4 v0 = acc[ai][bj][m][0], v1 = acc[ai][bj][m][1];
                        v4u w; w.x = pk2(v0[0], v0[1]); w.y = pk2(v0[2], v0[3]); w.z = pk2(v1[0], v1[1]); w.w = pk2(v1[2], v1[3]);
                        *(v4u*)(GB + (size_t)(row0 + ai * 128 + m * 16) * D + col0 + bj * 128) = w; }
        }
    }
};
struct EpiF32 {
    static constexpr bool PERM = false, AFTER_DRAIN = false;
    float* O; int ldc;
    __device__ __forceinline__ void operator()(const pg8::f32x4 (&acc)[2][2][4][2], const pg8::Unit& u, int wr, int wc, int fr, int fq) const {
        const int col0 = u.pn * 256 + wc * 32 + 4 * fq;
#pragma unroll
        for (int ai = 0; ai < 2; ++ai)
#pragma unroll
            for (int m = 0; m < 4; ++m) { float* rowp = O + (size_t)(u.pm * 256 + ai * 128 + wr * 64 + m * 16 + fr) * ldc + col0;
#pragma unroll
                for (int bj = 0; bj < 2; ++bj)
#pragma unroll
                    for (int n = 0; n < 2; ++n) *(f32x4*)(rowp + bj * 128 + n * 16) = acc[ai][bj][m][n]; }
    }
};
struct EpiTopK {
    static constexpr bool PERM = false, AFTER_DRAIN = true;
    int* seli; float* selg; const float* rss;
    __device__ __forceinline__ void operator()(const pg8::f32x4 (&)[2][2][4][2], const pg8::Unit&, int, int, int, int) const {}
    __device__ __forceinline__ void fused(pg8::f32x4 (&acc)[2][2][4][2], const pg8::Unit& u, int wr, int wc, int fr, int fq, LAS unsigned char* lds, int wid, int lane) const {
        LAS float* S = (LAS float*)lds;
        LAS int* L = (LAS int*)lds;
        const int tid = wid * 64 + lane;
#pragma unroll 1
        for (int ai = 0; ai < 2; ++ai) {
#pragma unroll
            for (int m = 0; m < 4; ++m)
#pragma unroll
                for (int bj = 0; bj < 2; ++bj)
#pragma unroll
                    for (int n = 0; n < 2; ++n) {
                        const int row = wr * 64 + m * 16 + fr, col = bj * 128 + wc * 32 + n * 16 + 4 * fq;
                        *(LAS f32x4*)(S + row * 260 + col) = ai == 0 ? acc[0][bj][m][n] : acc[1][bj][m][n];
                    }
            BLOCK_BAR();
            const int row = tid & 127, q = tid >> 7;
            int best[16];
            {
                const LAS f32x4* sp = (const LAS f32x4*)(S + row * 260 + q * 64);
#pragma unroll
                for (int c = 0; c < 4; ++c) {
                    int x[16];
#pragma unroll
                    for (int e4 = 0; e4 < 4; ++e4) { const f32x4 v = sp[c * 4 + e4];
#pragma unroll
                        for (int e = 0; e < 4; ++e) x[e4 * 4 + e] = (tk_map(v[e]) & ~127) | (127 - ((q & 1) * 64 + c * 16 + e4 * 4 + e)); }
                    tk_sort_desc(x);
                    if (c == 0) {
#pragma unroll
                        for (int e = 0; e < 16; ++e) best[e] = x[e];
                    } else tk_merge_top(best, x);
                }
            }
            BLOCK_BAR();
#pragma unroll
            for (int e4 = 0; e4 < 4; ++e4) *(LAS v4u*)(L + row * 68 + q * 16 + e4 * 4) = (v4u){(unsigned)best[e4 * 4], (unsigned)best[e4 * 4 + 1], (unsigned)best[e4 * 4 + 2], (unsigned)best[e4 * 4 + 3]};
            BLOCK_BAR();
            if (tid < 128) {
                int a[16], b[16], t[16];
                LAS int* Lr = L + tid * 68;
#pragma unroll
                for (int e4 = 0; e4 < 4; ++e4) { const v4u va = *(LAS v4u*)(Lr + e4 * 4), vt = *(LAS v4u*)(Lr + 16 + e4 * 4);
#pragma unroll
                    for (int e = 0; e < 4; ++e) { a[e4 * 4 + e] = (int)va[e]; t[e4 * 4 + e] = (int)vt[e]; } }
                tk_merge_top(a, t);
#pragma unroll
                for (int e4 = 0; e4 < 4; ++e4) { const v4u vb = *(LAS v4u*)(Lr + 32 + e4 * 4), vt = *(LAS v4u*)(Lr + 48 + e4 * 4);
#pragma unroll
                    for (int e = 0; e < 4; ++e) { b[e4 * 4 + e] = (int)vb[e]; t[e4 * 4 + e] = (int)vt[e]; } }
                tk_merge_top(b, t);
                const int trow = u.pm * 256 + ai * 128 + tid;
                const f32x4 q0 = *(const f32x4*)(rss + (size_t)trow * 16), q1 = *(const f32x4*)(rss + (size_t)trow * 16 + 4), q2 = *(const f32x4*)(rss + (size_t)trow * 16 + 8), q3 = *(const f32x4*)(rss + (size_t)trow * 16 + 12);
                const float ssq = (((q0.x + q0.y) + (q0.z + q0.w)) + ((q1.x + q1.y) + (q1.z + q1.w))) + (((q2.x + q2.y) + (q2.z + q2.w)) + ((q3.x + q3.y) + (q3.z + q3.w)));
                const float rstd = 1.0f / sqrtf(ssq * (1.f / D) + RMS_EPS);
                const size_t o = ((size_t)trow * 8 + u.pn) * 16;
                tk_stage2(a, b, Lr, (__attribute__((address_space(1))) int*)(seli + o), (__attribute__((address_space(1))) float*)(selg + o), rstd);
            }
            BLOCK_BAR();
        }
    }
};
struct OneUnit {
    pg8::Unit u;
    __device__ __forceinline__ bool next(int i, pg8::Unit& o) const { if (i != 0) return false; o = u; return true; }
    __device__ __forceinline__ void a_ready(const pg8::Unit&) const {}
    __device__ __forceinline__ void done(const pg8::Unit&) const {}
};

__device__ __forceinline__ void p0_transpose_item(const float* W, int ldw, int ncols, bf16* WT, float scale, LAS float* scr, int item, int lane) {
    const int nblk = ncols / 64, kb = item / nblk, nb = item % nblk, k0 = 64 * kb, n0 = 64 * nb;
    f32x4 v[16];
#pragma unroll
    for (int i = 0; i < 16; ++i) v[i] = __builtin_nontemporal_load((const f32x4*)(W + (size_t)(k0 + 4 * i + (lane >> 4)) * ldw + n0 + 4 * (lane & 15)));
#pragma unroll
    for (int i = 0; i < 16; ++i) { LAS float* p = scr + (4 * i + (lane >> 4)) * 65 + 4 * (lane & 15); p[0] = v[i].x * scale; p[1] = v[i].y * scale; p[2] = v[i].z * scale; p[3] = v[i].w * scale; }
    LDS_WAIT(); asm volatile("" ::: "memory");
    const int c = lane & 7;
#pragma unroll
    for (int j = 0; j < 8; ++j) { const int n = (lane >> 3) + 8 * j; const LAS float* s = scr + (8 * c) * 65 + n;
        v4u o; o.x = pk2(s[0 * 65], s[1 * 65]); o.y = pk2(s[2 * 65], s[3 * 65]); o.z = pk2(s[4 * 65], s[5 * 65]); o.w = pk2(s[6 * 65], s[7 * 65]);
        *(v4u*)(WT + (size_t)(n0 + n) * 1024 + k0 + 8 * c) = o; }
    LDS_WAIT(); asm volatile("" ::: "memory");
}
__device__ __forceinline__ void rms_row_to_bf16(const float* xrow, const float* gain, bf16* orow, float* hcopy, int lane) {
    const f32x4* xr = (const f32x4*)xrow + lane; const f32x4* gr = (const f32x4*)gain + lane;
    f32x4 v[4]; float s = 0.f;
#pragma unroll
    for (int j = 0; j < 4; ++j) { v[j] = xr[64 * j]; s += (v[j].x * v[j].x + v[j].y * v[j].y) + (v[j].z * v[j].z + v[j].w * v[j].w); }
    if (hcopy) {
#pragma unroll
        for (int j = 0; j < 4; ++j) ((f32x4*)hcopy + lane)[64 * j] = v[j];
    }
    const float rstd = 1.0f / sqrtf(wave_sum(s) * (1.f / D) + RMS_EPS);
    unsigned long long* o8 = (unsigned long long*)orow + lane;
#pragma unroll
    for (int j = 0; j < 4; ++j) { const f32x4 g = gr[64 * j]; const f32x4 y = v[j] * rstd * g;
        o8[64 * j] = (unsigned long long)pk2(y.x, y.y) | ((unsigned long long)pk2(y.z, y.w) << 32); }
}
__device__ __forceinline__ void p0_dense(Frame& F, bool dry) {
    if (!(dry && PROBE_PMODE == 1)) {
        LAS float* KL = (LAS float*)F.lds;
        LAS float* WL = (LAS float*)(F.lds + 128 * 132 * 4);
        const float* in10 = F.in(10); const float* in11 = F.in(11); const float* in2 = F.in(2);
        f32x4 kreg[8], wreg[4];
#define FOLD_LOAD(it_) do { const int l_ = (it_) >> 8, hp_ = ((it_) >> 4) & 15, k0_ = ((it_) & 15) * 64; \
            const float* kg_ = in11 + (size_t)(l_ * 16 + hp_) * 128 * 128; const float* wg_ = in10 + (size_t)l_ * 1024 * 2048 + (size_t)k0_ * 2048 + hp_ * 128; \
            _Pragma("unroll") for (int i = 0; i < 8; ++i) kreg[i] = *(const f32x4*)(kg_ + 4 * (F.tid + 512 * i)); \
            _Pragma("unroll") for (int i = 0; i < 4; ++i) { const int e = 4 * (F.tid + 512 * i); wreg[i] = __builtin_nontemporal_load((const f32x4*)(wg_ + (size_t)(e >> 7) * 2048 + (e & 127))); } } while (0)
        if (F.vcu < DEPTH * 16 * 16) FOLD_LOAD(F.vcu);
        for (int it = F.vcu; it < DEPTH * 16 * 16; it += F.G) {
            const int l = it >> 8, hp = (it >> 4) & 15, k0 = (it & 15) * 64;
#pragma unroll
            for (int i = 0; i < 8; ++i) { const int e = 4 * (F.tid + 512 * i), n = e >> 7, d = e & 127; *(LAS f32x4*)(KL + n * 132 + d) = kreg[i]; }
#pragma unroll
            for (int i = 0; i < 4; ++i) { const int e = 4 * (F.tid + 512 * i), kk = e >> 7, d = e & 127; *(LAS f32x4*)(WL + kk * 132 + d) = wreg[i]; }
            if (it + F.G < DEPTH * 16 * 16) FOLD_LOAD(it + F.G);
            BLOCK_BAR();
            {
                const int i16 = F.lane & 15, g4 = F.lane >> 4, nt = F.wave;
                f32x4 facc[4];
#pragma unroll
                for (int mt = 0; mt < 4; ++mt) facc[mt] = (f32x4){0.f, 0.f, 0.f, 0.f};
#pragma unroll 2
                for (int s8 = 0; s8 < 8; ++s8) {
                    const f32x4 bq = *(const LAS f32x4*)(KL + (nt * 16 + i16) * 132 + 16 * s8 + 4 * g4);
                    f32x4 aq[4];
#pragma unroll
                    for (int mt = 0; mt < 4; ++mt) aq[mt] = *(const LAS f32x4*)(WL + (mt * 16 + i16) * 132 + 16 * s8 + 4 * g4);
#pragma unroll
                    for (int t = 0; t < 4; ++t)
#pragma unroll
                        for (int mt = 0; mt < 4; ++mt) facc[mt] = __builtin_amdgcn_mfma_f32_16x16x4f32(aq[mt][t], bq[t], facc[mt], 0, 0, 0);
                }
                bf16* o = (bf16*)(F.ws + WS_WP) + (size_t)l * 2048 * 1024 + (size_t)(hp * 128 + nt * 16 + i16) * 1024 + k0 + 4 * g4;
#pragma unroll
                for (int mt = 0; mt < 4; ++mt) { const f32x4 gf = *(const f32x4*)(in2 + (size_t)l * D + k0 + mt * 16 + 4 * g4); v2u w; w.x = pk2(facc[mt][0] * gf.x, facc[mt][1] * gf.y); w.y = pk2(facc[mt][2] * gf.z, facc[mt][3] * gf.w); *(v2u*)(o + mt * 16) = w; }
            }
            BLOCK_BAR();
        }
#undef FOLD_LOAD
    }
    LAS float* scr = (LAS float*)(F.lds + F.wave * 16640);
    const int gw = F.vcu * NWAVES + F.wave, NGW = F.G * NWAVES;
    constexpr int I_SQ = 16 * 16, I_IN = 16 * 48, PER_J = 3 * I_SQ + I_SQ + I_IN + I_SQ;
    if (!(dry && PROBE_PMODE == 2)) for (int it = gw; it < 2 * PER_J; it += NGW) {
        const int j = it / PER_J; int r = it % PER_J;
        const float* wqkv = F.in(4) + (size_t)j * 1024 * 3072;
        if (r < I_SQ) { p0_transpose_item(wqkv, 3072, 1024, (bf16*)(F.ws + WS_WQK) + (size_t)j * 2048 * 1024, 0.125f, scr, r, F.lane); continue; } r -= I_SQ;
        if (r < I_SQ) { p0_transpose_item(wqkv + 1024, 3072, 1024, (bf16*)(F.ws + WS_WQK) + (size_t)j * 2048 * 1024 + (size_t)1024 * 1024, 1.f, scr, r, F.lane); continue; } r -= I_SQ;
        if (r < I_SQ) { p0_transpose_item(wqkv + 2048, 3072, 1024, (bf16*)(F.ws + WS_WV) + (size_t)j * 1024 * 1024, 1.f, scr, r, F.lane); continue; } r -= I_SQ;
        if (r < I_SQ) { p0_transpose_item(F.in(5) + (size_t)j * 1024 * 1024, 1024, 1024, (bf16*)(F.ws + WS_WO) + (size_t)j * 1024 * 1024, 1.f, scr, r, F.lane); continue; } r -= I_SQ;
        if (r < I_IN) {
            const float* win = F.in(7) + (size_t)j * 1024 * 3072; bf16* wt = (bf16*)(F.ws + WS_WIN) + (size_t)j * 3072 * 1024;
            if (r < 512) { const int blk = r >> 5, pn = blk >> 1, which = blk & 1; p0_transpose_item(win + (which ? 2048 : 1024) + 128 * pn, 3072, 128, wt + (size_t)(256 * pn + 128 * which) * 1024, 1.f, scr, r & 31, F.lane); }
            else p0_transpose_item(win, 3072, 1024, wt + (size_t)2048 * 1024, 1.f, scr, r - 512, F.lane);
            continue; } r -= I_IN;
        p0_transpose_item(F.in(9) + (size_t)j * 1024 * 1024, 1024, 1024, (bf16*)(F.ws + WS_WOUT) + (size_t)j * 1024 * 1024, 1.f, scr, r, F.lane);
    }
}
__device__ __forceinline__ void p0_tables(Frame& F, bool dry) {
    const int gw = F.vcu * NWAVES + F.wave, NGW = F.G * NWAVES;
    if (!(dry && PROBE_PMODE == 3)) {
        constexpr int NROW = DEPTH * 16384;
        const float* in12 = F.in(12); const float* in13 = F.in(13);
#define XC_LOAD(v, r0_) do { const int tb_ = (r0_) >= NROW ? 1 : 0, rr_ = (r0_) - tb_ * NROW; const float* src_ = (tb_ ? in13 : in12) + (size_t)rr_ * 1024 + 4 * F.lane; \
            _Pragma("unroll") for (int u = 0; u < 4; ++u) _Pragma("unroll") for (int i = 0; i < 4; ++i) v[u][i] = __builtin_nontemporal_load((const f32x4*)(src_ + (size_t)u * 1024 + 256 * i)); } while (0)
#if EXPERT_FP4
#define XC_PACK(v, u, q, dstp) do { v2u w_; _Pragma("unroll") for (int jj = 0; jj < 2; ++jj) { unsigned t_ = 0u; \
                    t_ = __builtin_amdgcn_cvt_scalef32_pk_fp4_f32(t_, v[u][2 * jj].x * q, v[u][2 * jj].y * q, 1.0f, 0); t_ = __builtin_amdgcn_cvt_scalef32_pk_fp4_f32(t_, v[u][2 * jj].z * q, v[u][2 * jj].w * q, 1.0f, 1); \
                    t_ = __builtin_amdgcn_cvt_scalef32_pk_fp4_f32(t_, v[u][2 * jj + 1].x * q, v[u][2 * jj + 1].y * q, 1.0f, 2); t_ = __builtin_amdgcn_cvt_scalef32_pk_fp4_f32(t_, v[u][2 * jj + 1].z * q, v[u][2 * jj + 1].w * q, 1.0f, 3); w_[jj] = t_; } \
                *(v2u*)(dstp) = w_; } while (0)
        constexpr float QMAX = 6.0f;
#else
#define XC_PACK(v, u, q, dstp) do { v4u w_; _Pragma("unroll") for (int i = 0; i < 4; ++i) { unsigned t_ = 0u; t_ = __builtin_amdgcn_cvt_pk_fp8_f32(v[u][i].x * q, v[u][i].y * q, t_, false); t_ = __builtin_amdgcn_cvt_pk_fp8_f32(v[u][i].z * q, v[u][i].w * q, t_, true); w_[i] = t_; } \
                *(v4u*)(dstp) = w_; } while (0)
        constexpr float QMAX = 256.0f;
#endif
#define XC_I4(x_) ((unsigned)__float2int_rn(x_) & 15u)
#define XC_PACK_I4(v, u, q, dstp) do { v2u w_; _Pragma("unroll") for (int jj = 0; jj < 2; ++jj) { const f32x4 a_ = v[u][2 * jj] * q, b_ = v[u][2 * jj + 1] * q; \
                    w_[jj] = XC_I4(a_.x) | (XC_I4(a_.y) << 4) | (XC_I4(a_.z) << 8) | (XC_I4(a_.w) << 12) | (XC_I4(b_.x) << 16) | (XC_I4(b_.y) << 20) | (XC_I4(b_.z) << 24) | (XC_I4(b_.w) << 28); } \
                *(v2u*)(dstp) = w_; } while (0)
#define XC_CONV(v, r0_) do { const int tb_ = (r0_) >= NROW ? 1 : 0, rr_ = (r0_) - tb_ * NROW; \
            unsigned char* dst_ = F.ws + (tb_ ? WS_DN : WS_UP) + (size_t)rr_ * ROWB + (ROWB / 64) * F.lane; float* sc_ = (float*)(F.ws + WS_SUP) + 2 * (size_t)rr_ + tb_; \
            _Pragma("unroll") for (int u = 0; u < 4; ++u) { float mx = 0.f; \
                _Pragma("unroll") for (int i = 0; i < 4; ++i) mx = fmaxf(fmaxf(mx, fmaxf(fabsf(v[u][i].x), fabsf(v[u][i].y))), fmaxf(fabsf(v[u][i].z), fabsf(v[u][i].w))); \
                _Pragma("unroll") for (int o = 1; o < 64; o <<= 1) mx = fmaxf(mx, __shfl_xor(mx, o)); \
                if (tb_) { const float q = mx > 0.f ? 7.0f / mx : 1.0f; XC_PACK_I4(v, u, q, dst_ + (size_t)u * ROWB); if (F.lane == 0) sc_[2 * u] = mx > 0.f ? mx * (1.0f / 7.0f) : 1.0f; } \
                else { const float q = mx > 0.f ? QMAX / mx : 1.0f; XC_PACK(v, u, q, dst_ + (size_t)u * ROWB); if (F.lane == 0) sc_[2 * u] = mx > 0.f ? mx * (1.0f / QMAX) : 1.0f; } } } while (0)
        const int stepr = NGW * 4;
        f32x4 va[4][4], vb[4][4];
        int r0 = gw * 4;
        if (r0 < 2 * NROW) XC_LOAD(va, r0);
#pragma unroll 1
        for (; r0 < 2 * NROW; r0 += 2 * stepr) {
            if (r0 + stepr < 2 * NROW) XC_LOAD(vb, r0 + stepr);
            XC_CONV(va, r0);
            if (r0 + 2 * stepr < 2 * NROW) XC_LOAD(va, r0 + 2 * stepr);
            if (r0 + stepr < 2 * NROW) XC_CONV(vb, r0 + stepr);
        }
#undef XC_LOAD
#undef XC_PACK
#undef XC_PACK_I4
#undef XC_I4
#undef XC_CONV
    }
}
__device__ __forceinline__ void p0_prologue(Frame& F, bool dry) {
    if (((int)blockIdx.x >> 3) & 1) { p0_tables(F, dry); p0_dense(F, dry); } else { p0_dense(F, dry); p0_tables(F, dry); }
    const int gw = F.vcu * NWAVES + F.wave, NGW = F.G * NWAVES;
    if (!(dry && PROBE_PMODE == 4)) {
        const float* x0 = F.in(0); const f32x4* gr = (const f32x4*)F.in(1) + F.lane;
        f32x4 gq[4];
#pragma unroll
        for (int j = 0; j < 4; ++j) gq[j] = gr[64 * j];
#pragma unroll 1
        for (int m0 = gw; m0 < M; m0 += 4 * NGW) {
            f32x4 v[4][4];
#pragma unroll
            for (int u = 0; u < 4; ++u) { const int m = m0 + u * NGW; if (m < M) {
#pragma unroll
                for (int j = 0; j < 4; ++j) v[u][j] = __builtin_nontemporal_load((const f32x4*)(x0 + (size_t)m * D) + F.lane + 64 * j); } }
#pragma unroll
            for (int u = 0; u < 4; ++u) { const int m = m0 + u * NGW; if (m < M) {
                float sq = 0.f;
#pragma unroll
                for (int j = 0; j < 4; ++j) { sq += (v[u][j].x * v[u][j].x + v[u][j].y * v[u][j].y) + (v[u][j].z * v[u][j].z + v[u][j].w * v[u][j].w); }
                const float rstd = 1.0f / sqrtf(wave_sum(sq) * (1.f / D) + RMS_EPS);
                unsigned long long* o8 = (unsigned long long*)((bf16*)(F.ws + WS_HN) + (size_t)m * D) + F.lane;
#pragma unroll
                for (int j = 0; j < 4; ++j) { const f32x4 y = v[u][j] * rstd * gq[j]; o8[64 * j] = (unsigned long long)pk2(y.x, y.y) | ((unsigned long long)pk2(y.z, y.w) << 32); } } }
        }
    }
}

__device__ __forceinline__ void conv_phase(Frame& F, int j) {
    const bf16* U = (const bf16*)(F.ws + WS_BIG); const bf16* GB = (const bf16*)(F.ws + WS_BIG + 32 * MiB); bf16* mix = (bf16*)(F.ws + WS_MIX);
    const float* wc = F.in(8) + (size_t)j * 3 * 1024;
    for (int idx = F.vcu * NTHR + F.tid; idx < M * 128; idx += F.G * NTHR) {
        const int t = idx >> 7, c8 = (idx & 127) * 8, s = t & (SEQ - 1);
        const v4u gb = *(const v4u*)(GB + (size_t)t * D + c8);
        float conv[8];
#pragma unroll
        for (int e = 0; e < 8; ++e) conv[e] = 0.f;
#pragma unroll
        for (int dj = -1; dj <= 1; ++dj) {
            if (s + dj >= 0 && s + dj < SEQ) {
                const v4u uu = *(const v4u*)(U + (size_t)(t + dj) * D + c8);
                const f32x4 w0 = *(const f32x4*)(wc + (dj + 1) * 1024 + c8), w1 = *(const f32x4*)(wc + (dj + 1) * 1024 + c8 + 4);
#pragma unroll
                for (int e2 = 0; e2 < 4; ++e2) {
                    const float wl = e2 < 2 ? w0[2 * e2] : w1[2 * e2 - 4], wh = e2 < 2 ? w0[2 * e2 + 1] : w1[2 * e2 - 3];
                    conv[2 * e2] += wl * bflo(uu[e2]); conv[2 * e2 + 1] += wh * bfhi(uu[e2]);
                }
            }
        }
        v4u o;
#pragma unroll
        for (int e2 = 0; e2 < 4; ++e2) o[e2] = pk2(bflo(gb[e2]) * conv[2 * e2], bfhi(gb[e2]) * conv[2 * e2 + 1]);
        *(v4u*)(mix + (size_t)t * 1024 + c8) = o;
    }
}

constexpr int AT_KSTR = 144, AT_VSTR = 1168, AT_KOFF = 0, AT_VOFF = 576 * AT_KSTR, AT_BOFF = AT_VOFF + 64 * AT_VSTR;
static_assert(AT_BOFF + 1860 <= PTAB_OFF, "attention LDS map");
__device__ __forceinline__ void attn_phase(Frame& F, int j) {
    const bf16* QK = (const bf16*)(F.ws + WS_BIG); const bf16* VT = (const bf16*)(F.ws + WS_VT); bf16* mix = (bf16*)(F.ws + WS_MIX);
    const float* biasl = F.in(6) + (size_t)j * NH * 15 * 31;
    const int lane = F.lane, q = lane & 15, g = lane >> 4, tid = F.tid;
    LAS unsigned char* KL = F.lds + AT_KOFF; LAS unsigned char* VL = F.lds + AT_VOFF; LAS float* btab = (LAS float*)(F.lds + AT_BOFF);
    v4u kreg[9], vreg[9];
    int cur_hh = -1;
#define AT_DECODE(it, b_, hh_, r0_, R0_) const int hh_ = (it) & 15, rp_##it = ((it) >> 4) & 63, b_ = (it) >> 10, r0_ = 2 * rp_##it; int R0_ = r0_ - 4; R0_ = R0_ < 0 ? 0 : (R0_ > NROWS - 8 ? NROWS - 8 : R0_);
#define AT_PREFETCH(it) do { AT_DECODE(it, pb, phh, pr0, pR0) \
        _Pragma("unroll") for (int i = 0; i < 9; ++i) { const int c = tid + 512 * i; \
            { const int key = c >> 3, ch = c & 7; int row = pR0 + (key >> 6); row = row > NROWS - 1 ? NROWS - 1 : row; \
              kreg[i] = *(const v4u*)(QK + ((size_t)pb * SEQ + row * 64 + (key & 63)) * 2048 + 1024 + phh * 64 + ch * 8); } \
            { const int d = c / 72, kch = c - d * 72; vreg[i] = *(const v4u*)(VT + (size_t)(phh * 64 + d) * M + (size_t)pb * SEQ + pR0 * 64 + kch * 8); } } } while (0)
    int it = F.vcu;
    if (it < 2048) AT_PREFETCH(it);
    for (; it < 2048; it += F.G) {
        AT_DECODE(it, b, hh, r0, R0)
        BLOCK_BAR();
#pragma unroll
        for (int i = 0; i < 9; ++i) { const int c = tid + 512 * i;
            *(LAS v4u*)(KL + (c >> 3) * AT_KSTR + (c & 7) * 16) = kreg[i];
            const int d = c / 72, kch = c - d * 72; *(LAS v4u*)(VL + d * AT_VSTR + kch * 16) = vreg[i]; }
        if (hh != cur_hh) { if (tid < 465) btab[tid] = biasl[(size_t)hh * 465 + tid]; cur_hh = hh; }
        BLOCK_BAR();
        const int r = r0 + (F.wave >> 2), jb = F.wave & 3;
        int rs = r - 4; rs = rs < 0 ? 0 : (rs > NROWS - 8 ? NROWS - 8 : rs);
        const int lr0 = rs - R0;
        int bs = 16 * jb - 8; bs = bs < 0 ? 0 : (bs > 32 ? 32 : bs);
        const int qc = 16 * jb + q; int wst = qc - 8; wst = wst < 0 ? 0 : (wst > 48 ? 48 : wst);
        const size_t tokq = (size_t)b * SEQ + r * 64 + qc;
        bf16x8 qf[2];
#pragma unroll
        for (int ks = 0; ks < 2; ++ks) qf[ks] = *(const bf16x8*)(QK + tokq * 2048 + hh * 64 + ks * 32 + 8 * g);
        f32x4 S[8][2];
        const int kcl_a = 8 * (q >> 2) + (q & 3);
#pragma unroll
        for (int wr = 0; wr < 8; ++wr)
#pragma unroll
            for (int T = 0; T < 2; ++T) {
                const LAS unsigned char* kp = KL + ((lr0 + wr) * 64 + bs + kcl_a + 4 * T) * AT_KSTR + 16 * g;
                const bf16x8 k0 = *(const LAS bf16x8*)kp, k1 = *(const LAS bf16x8*)(kp + 64);
                f32x4 c = (f32x4){0.f, 0.f, 0.f, 0.f};
                c = __builtin_amdgcn_mfma_f32_16x16x32_bf16(k0, qf[0], c, 0, 0, 0);
                c = __builtin_amdgcn_mfma_f32_16x16x32_bf16(k1, qf[1], c, 0, 0, 0);
                S[wr][T] = c;
            }
        float mx = -3.0e38f;
#pragma unroll
        for (int wr = 0; wr < 8; ++wr) {
            const LAS float* brow = btab + (rs + wr - r + 7) * 31;
#pragma unroll
            for (int T = 0; T < 2; ++T)
#pragma unroll
                for (int i = 0; i < 4; ++i) {
                    const int kc = bs + 8 * g + 4 * T + i;
                    int co = kc - qc + 15; co = co < 0 ? 0 : (co > 30 ? 30 : co);
                    const bool valid = (kc >= wst) && (kc < wst + 16);
                    const float v = valid ? S[wr][T][i] + brow[co] : -1e30f;
                    S[wr][T][i] = v; mx = fmaxf(mx, v);
                }
        }
        mx = fmaxf(mx, __shfl_xor(mx, 16)); mx = fmaxf(mx, __shfl_xor(mx, 32));
        float sum = 0.f;
        bf16x8 pf[8];
#pragma unroll
        for (int wr = 0; wr < 8; ++wr) {
            float p[8];
#pragma unroll
            for (int T = 0; T < 2; ++T)
#pragma unroll
                for (int i = 0; i < 4; ++i) { p[4 * T + i] = __expf(S[wr][T][i] - mx); sum += p[4 * T + i]; }
            v4u w; w.x = pk2(p[0], p[1]); w.y = pk2(p[2], p[3]); w.z = pk2(p[4], p[5]); w.w = pk2(p[6], p[7]);
            pf[wr] = __builtin_bit_cast(bf16x8, w);
        }
        sum += __shfl_xor(sum, 16); sum += __shfl_xor(sum, 32);
        if (it + F.G < 2048) { const int nit = it + F.G; AT_PREFETCH(nit); }
        f32x4 O[4];
#pragma unroll
        for (int dt = 0; dt < 4; ++dt) O[dt] = (f32x4){0.f, 0.f, 0.f, 0.f};
#pragma unroll
        for (int wr = 0; wr < 8; ++wr)
#pragma unroll
            for (int dt = 0; dt < 4; ++dt) {
                const bf16x8 vf = *(const LAS bf16x8*)(VL + (dt * 16 + q) * AT_VSTR + ((lr0 + wr) * 64 + bs + 8 * g) * 2);
                O[dt] = __builtin_amdgcn_mfma_f32_16x16x32_bf16(vf, pf[wr], O[dt], 0, 0, 0);
            }
        const float inv = 1.0f / sum;
#pragma unroll
        for (int dt = 0; dt < 4; ++dt) { v2u w; w.x = pk2(O[dt][0] * inv, O[dt][1] * inv); w.y = pk2(O[dt][2] * inv, O[dt][3] * inv);
            *(v2u*)(mix + tokq * 1024 + hh * 64 + dt * 16 + 4 * g) = w; }
    }
#undef AT_DECODE
#undef AT_PREFETCH
    BLOCK_BAR();
}
#if NAIVE_ATTN
__device__ __forceinline__ void attn_naive_phase(Frame& F, int j) {
    const bf16* QK = (const bf16*)(F.ws + WS_BIG); const bf16* VT = (const bf16*)(F.ws + WS_VT); bf16* mix = (bf16*)(F.ws + WS_MIX);
    const float* biasl = F.in(6) + (size_t)j * NH * 15 * 31;
    for (int idx = F.vcu * NTHR + F.tid; idx < M * NH; idx += F.G * NTHR) {
        const int hh = idx & 15, t = idx >> 4, b = t >> 13, s = t & (SEQ - 1), r = s >> 6, qc = s & 63;
        int rs = r - 4; rs = rs < 0 ? 0 : (rs > NROWS - 8 ? NROWS - 8 : rs);
        int wst = qc - 8; wst = wst < 0 ? 0 : (wst > 48 ? 48 : wst);
        float qv[64];
#pragma unroll
        for (int c = 0; c < 8; ++c) { const v4u w = *(const v4u*)(QK + (size_t)t * 2048 + hh * 64 + c * 8);
#pragma unroll
            for (int e = 0; e < 4; ++e) { qv[c * 8 + 2 * e] = bflo(w[e]); qv[c * 8 + 2 * e + 1] = bfhi(w[e]); } }
        float mrun = -3.0e38f, lrun = 0.f, o[64];
#pragma unroll
        for (int d = 0; d < 64; ++d) o[d] = 0.f;
        for (int wr = 0; wr < 8; ++wr)
            for (int kk = 0; kk < 16; ++kk) {
                const int kc = wst + kk; const size_t tk = (size_t)b * SEQ + (rs + wr) * 64 + kc;
                float sd = 0.f;
#pragma unroll
                for (int c = 0; c < 8; ++c) { const v4u w = *(const v4u*)(QK + tk * 2048 + 1024 + hh * 64 + c * 8);
#pragma unroll
                    for (int e = 0; e < 4; ++e) sd += qv[c * 8 + 2 * e] * bflo(w[e]) + qv[c * 8 + 2 * e + 1] * bfhi(w[e]); }
                int co = kc - qc + 15; co = co < 0 ? 0 : (co > 30 ? 30 : co);
                sd += biasl[(size_t)hh * 465 + (rs + wr - r + 7) * 31 + co];
                const float mn = fmaxf(mrun, sd), al = __expf(mrun - mn), p = __expf(sd - mn);
                lrun = lrun * al + p; mrun = mn;
#pragma unroll
                for (int d = 0; d < 64; ++d) o[d] = o[d] * al + p * bflo((unsigned)VT[(size_t)(hh * 64 + d) * M + tk]);
            }
        const float inv = 1.0f / lrun;
#pragma unroll
        for (int c = 0; c < 8; ++c) { v4u w;
#pragma unroll
            for (int e = 0; e < 4; ++e) w[e] = pk2(o[c * 8 + 2 * e] * inv, o[c * 8 + 2 * e + 1] * inv);
            *(v4u*)(mix + (size_t)t * 1024 + hh * 64 + c * 8) = w; }
    }
}
#endif
#if NAIVE_TOPK
__device__ __forceinline__ void select_naive_phase(Frame& F) {
    const float* SC = (const float*)(F.ws + WS_SC); int* seli = (int*)(F.ws + WS_SELI); float* selg = (float*)(F.ws + WS_SELG);
    LAS int* AB = (LAS int*)F.lds + F.tid * 33;
    for (int idx = F.vcu * NTHR + F.tid; idx < M * 8; idx += F.G * NTHR) {
        const float* s = SC + (size_t)idx * 256;
        int a[16], b[16], t[16];
        tk_stage1<4>(s, 0, a); tk_stage1<4>(s + 64, 64, t); tk_merge_top(a, t);
        tk_stage1<4>(s + 128, 0, b); tk_stage1<4>(s + 192, 64, t); tk_merge_top(b, t);
        tk_stage2(a, b, AB, seli + (size_t)idx * 16, selg + (size_t)idx * 16);
    }
}
#endif

__device__ __forceinline__ float gelu_erf(float a) { return 0.5f * a * (1.0f + erff(a * 0.70710678118654752f)); }
typedef float f32x2g __attribute__((ext_vector_type(2)));
#if EXPERT_FP4
typedef v2u rowv;
__device__ __forceinline__ rowv row_load(const unsigned char* T, int e, int lane) { return *(const v2u*)(T + (size_t)e * ROWB + 8 * lane); }
#define ROW_PAIR(r, m) __builtin_amdgcn_cvt_scalef32_pk_f32_fp4((r)[(m) >> 2], 1.0f, (m) & 3)
#else
typedef v4u rowv;
__device__ __forceinline__ rowv row_load(const unsigned char* T, int e, int lane) { return *(const v4u*)(T + (size_t)e * ROWB + 16 * lane); }
#define ROW_PAIR(r, m) __builtin_amdgcn_cvt_pk_f32_fp8((r)[(m) >> 1], ((m) & 1) != 0)
#endif
__device__ __forceinline__ void row_axpy(f32x2g (&out)[8], const rowv d, float ak) {
    const f32x2g a2 = (f32x2g){ak, ak};
    out[0] = __builtin_elementwise_fma(a2, ROW_PAIR(d, 0), out[0]); out[1] = __builtin_elementwise_fma(a2, ROW_PAIR(d, 1), out[1]); out[2] = __builtin_elementwise_fma(a2, ROW_PAIR(d, 2), out[2]); out[3] = __builtin_elementwise_fma(a2, ROW_PAIR(d, 3), out[3]);
    out[4] = __builtin_elementwise_fma(a2, ROW_PAIR(d, 4), out[4]); out[5] = __builtin_elementwise_fma(a2, ROW_PAIR(d, 5), out[5]); out[6] = __builtin_elementwise_fma(a2, ROW_PAIR(d, 6), out[6]); out[7] = __builtin_elementwise_fma(a2, ROW_PAIR(d, 7), out[7]);
}
typedef int v8i_g __attribute__((ext_vector_type(8)));
typedef unsigned char u8x4g __attribute__((ext_vector_type(4)));
#define TR_SHUF(a, b, i0, i1, i2, i3) __builtin_amdgcn_perm((unsigned)(b), (unsigned)(a), (unsigned)((i0) | ((i1) << 8) | ((i2) << 16) | ((i3) << 24)))
__device__ __forceinline__ void tr8_nib(const unsigned (&w)[8], unsigned (&t)[8]) {
    unsigned x[8], y[8];
#pragma unroll
    for (int r = 0; r < 4; ++r) { x[r] = TR_SHUF(w[r], w[r + 4], 0, 1, 4, 5); x[r + 4] = TR_SHUF(w[r], w[r + 4], 2, 3, 6, 7); }
#pragma unroll
    for (int g = 0; g < 2; ++g)
#pragma unroll
        for (int r = 0; r < 2; ++r) { y[4 * g + r] = TR_SHUF(x[4 * g + r], x[4 * g + r + 2], 0, 4, 2, 6); y[4 * g + r + 2] = TR_SHUF(x[4 * g + r], x[4 * g + r + 2], 1, 5, 3, 7); }
#pragma unroll
    for (int p = 0; p < 4; ++p) { const unsigned e = y[2 * p], o = y[2 * p + 1];
        t[2 * p] = (e & 0x0F0F0F0Fu) | ((o << 4) & 0xF0F0F0F0u);
        t[2 * p + 1] = ((e >> 4) & 0x0F0F0F0Fu) | (o & 0xF0F0F0F0u); }
}
__device__ __forceinline__ int sel2(bool hf, int e0, int e1) { return hf ? e1 : e0; }
__device__ __forceinline__ void gather_phase(Frame& F, int layer, bool dry) {
    const unsigned char* UP = F.ws + WS_UP + (size_t)layer * 16384 * ROWB; const unsigned char* DN = F.ws + WS_DN + (size_t)layer * 16384 * ROWB;
    const f32x2g* SC2 = (const f32x2g*)(F.ws + WS_SUP) + (size_t)layer * 16384;
    const float* gain = F.in(2) + (size_t)layer * D; const float* gnext = layer < DEPTH - 1 ? F.in(1) + (size_t)(layer + 1) * D : F.in(3);
    float* outp = F.out();
    const int* seli = (const int*)(F.ws + WS_SELI); const float* selg = (const float*)(F.ws + WS_SELG);
    const bf16* H = (const bf16*)(F.ws + WS_H); bf16* HN = (bf16*)(F.ws + (dry ? WS_SC + 64 * MiB : WS_HN)); bf16* HW = (bf16*)(F.ws + (dry ? WS_SC : WS_H)); if (dry) outp = (float*)(F.ws + WS_SC);
    const int lane = F.lane, gw = F.vcu * NWAVES + F.wave, NGW = F.G * NWAVES;
    const bool b5 = lane & 32, b4 = lane & 16, b3 = lane & 8, b2 = lane & 4;
    constexpr int G_RS = 528, G_RB = 32 * G_RS, G_NSLOT = 4;
    LAS unsigned char* RB = F.lds + F.wave * G_RB;
    LAS float* ACT = (LAS float*)(F.lds + 8 * G_RB + F.wave * 512);
    LAS int* SELB = (LAS int*)(F.lds + 8 * G_RB + 8 * 512 + 8 * 1024 + F.wave * 512);
    static_assert(8 * G_RB + 8 * 512 + 8 * 1024 + 8 * 512 <= PTAB_OFF, "gather LDS map");
#pragma unroll 1
    for (int base = gw; base < M; base += G_NSLOT * NGW) {
    LAS unsigned char* X8 = F.lds + 8 * G_RB + 8 * 512 + F.wave * 1024;
    const int n16 = lane & 15, g4 = lane >> 4;
    const bool hf = lane >> 5; const int c32 = lane & 31, sg = 2 * c32 + (hf ? 1 : 0);
    v2u nhb[4]; int nidx_lo = 0, nidx_hi = 0; float ng_lo = 0.f, ng_hi = 0.f;
#define TOK_LOAD(t_) do { const bf16* hr_ = H + (size_t)(t_) * D + 4 * sg; _Pragma("unroll") for (int i = 0; i < 4; ++i) nhb[i] = __builtin_nontemporal_load((const v2u*)(hr_ + 256 * i)); \
        nidx_lo = __builtin_nontemporal_load(seli + (size_t)(t_) * 128 + lane); nidx_hi = __builtin_nontemporal_load(seli + (size_t)(t_) * 128 + 64 + lane); ng_lo = __builtin_nontemporal_load(selg + (size_t)(t_) * 128 + lane); ng_hi = __builtin_nontemporal_load(selg + (size_t)(t_) * 128 + 64 + lane); } while (0)
    if (base < M) TOK_LOAD(base);
#pragma unroll 1
    for (int slot = 0; slot < G_NSLOT; ++slot) {
        const int t = base + slot * NGW; if (t >= M) break;
        f32x4 hv[4];
#pragma unroll
        for (int i = 0; i < 4; ++i) { const unsigned w0_ = nhb[i].x, w1_ = nhb[i].y; hv[i] = (f32x4){bflo(w0_), bfhi(w0_), bflo(w1_), bfhi(w1_)}; }
        const int idx_lo = nidx_lo, idx_hi = nidx_hi; const float g_lo = ng_lo, g_hi = ng_hi;
        if (slot + 1 < G_NSLOT && t + NGW < M) TOK_LOAD(t + NGW);
        float ss = 0.f;
#pragma unroll
        for (int i = 0; i < 4; ++i) ss += (hv[i].x * hv[i].x + hv[i].y * hv[i].y) + (hv[i].z * hv[i].z + hv[i].w * hv[i].w);
        const float rstd = 1.0f / sqrtf(wave_sum(ss) * (1.f / D) + RMS_EPS);
        float xmax = 0.f;
        f32x4 xv[4];
#pragma unroll
        for (int i = 0; i < 4; ++i) { const f32x4 g = *(const f32x4*)(gain + 256 * i + 4 * sg); xv[i] = hv[i] * rstd * g;
            xmax = fmaxf(fmaxf(xmax, fmaxf(fabsf(xv[i].x), fabsf(xv[i].y))), fmaxf(fabsf(xv[i].z), fabsf(xv[i].w))); }
#pragma unroll
        for (int o = 1; o < 64; o <<= 1) xmax = fmaxf(xmax, __shfl_xor(xmax, o));
        const float qx = xmax > 0.f ? 256.0f / xmax : 1.0f, xinv = xmax > 0.f ? xmax * (1.0f / 256.0f) : 1.0f;
        {
            v4u w;
#pragma unroll
            for (int i = 0; i < 4; ++i) { unsigned tt = 0u; tt = __builtin_amdgcn_cvt_pk_fp8_f32(xv[i].x * qx, xv[i].y * qx, tt, false); tt = __builtin_amdgcn_cvt_pk_fp8_f32(xv[i].z * qx, xv[i].w * qx, tt, true); w[i] = tt; }
            *(LAS v4u*)(X8 + 16 * sg) = w;
            SELB[(lane & 1) * 64 + (lane >> 1)] = idx_lo; SELB[(lane & 1) * 64 + 32 + (lane >> 1)] = idx_hi;
        }
        LDS_WAIT(); asm volatile("" ::: "memory");
#define UP_LOAD(buf, hq) do { const LAS v4u* ip_ = (const LAS v4u*)(SELB + (hf ? 64 : 0) + 16 * (hq)); v4u i4_[4]; _Pragma("unroll") for (int k = 0; k < 4; ++k) i4_[k] = ip_[k]; \
        _Pragma("unroll") for (int k = 0; k < 16; ++k) buf[k] = *(const v4u*)(UP + (unsigned)(i4_[k >> 2][k & 3] * ROWB + 16 * c32)); } while (0)
#define DN_LOAD(buf, hb) do { const LAS v4u* ip_ = (const LAS v4u*)(SELB + (hf ? 64 : 0) + 8 * (hb)); v4u i4_[2]; i4_[0] = ip_[0]; i4_[1] = ip_[1]; \
        _Pragma("unroll") for (int k = 0; k < 8; ++k) buf[k] = *(const v4u*)(DN + (unsigned)(i4_[k >> 2][k & 3] * ROWB + 16 * c32)); } while (0)
        v4u da[8];
        {
            v4u ur[16];
            UP_LOAD(ur, 0);
#define UP_NEXT UP_LOAD(ur, hq + 1)
#pragma unroll 1
            for (int hq = 0; hq < 3; ++hq) {
                const int sel = hq < 2 ? idx_lo : idx_hi; const float gsel = hq < 2 ? g_lo : g_hi; const int lb0 = (hq & 1) * 32;
#pragma unroll
                for (int k = 0; k < 16; ++k) *(LAS v4u*)(RB + (2 * k + (hf ? 1 : 0)) * G_RS + 16 * c32) = ur[k];
                float sc[4];
#pragma unroll
                for (int hh_ = 0; hh_ < 2; ++hh_) { const int ek_ = __shfl(sel, lb0 + hh_ * 16 + 4 * g4 + (n16 & 3)); const f32x2g s2_ = SC2[ek_]; sc[2 * hh_] = s2_.x; sc[2 * hh_ + 1] = s2_.y; }
                LDS_WAIT(); asm volatile("" ::: "memory");
                UP_NEXT;
                f32x4 cc[2]; cc[0] = (f32x4){0.f, 0.f, 0.f, 0.f}; cc[1] = cc[0];
#pragma unroll
                for (int s8 = 0; s8 < 8; ++s8) { const v4u b0 = *(const LAS v4u*)(X8 + 128 * s8 + 16 * g4), b1 = *(const LAS v4u*)(X8 + 128 * s8 + 64 + 16 * g4);
                    const v8i_g bq = (v8i_g){(int)b0.x, (int)b0.y, (int)b0.z, (int)b0.w, (int)b1.x, (int)b1.y, (int)b1.z, (int)b1.w};
#pragma unroll
                    for (int hh_ = 0; hh_ < 2; ++hh_) { const v4u a4 = *(const LAS v4u*)(RB + (hh_ * 16 + n16) * G_RS + 64 * s8 + 16 * g4); const v8i_g a8 = (v8i_g){(int)a4.x, (int)a4.y, (int)a4.z, (int)a4.w, 0, 0, 0, 0};
                        cc[hh_] = __builtin_amdgcn_mfma_scale_f32_16x16x128_f8f6f4(a8, bq, cc[hh_], 4, 0, 0, 0x7f7f7f7f, 0, 0x7f7f7f7f); } }
#pragma unroll
                for (int hh_ = 0; hh_ < 2; ++hh_) { const int lb = lb0 + hh_ * 16; const f32x4 c = cc[hh_];
                    const int r_ = n16 & 3, k_ = 4 * g4 + r_;
                    const float my = r_ == 0 ? c[0] : (r_ == 1 ? c[1] : (r_ == 2 ? c[2] : c[3]));
                    const float gate = __shfl(gsel, lb + k_);
                    const float act = gelu_erf(my * sc[2 * hh_] * xinv) * gate * sc[2 * hh_ + 1];
                    if (n16 < 4) ACT[hq * 32 + hh_ * 16 + k_] = act; }
                LDS_WAIT(); asm volatile("" ::: "memory");
            }
#undef UP_NEXT
#define UP_NEXT DN_LOAD(da, 0)
            { const int hq = 3;
                const int sel = hq < 2 ? idx_lo : idx_hi; const float gsel = hq < 2 ? g_lo : g_hi; const int lb0 = (hq & 1) * 32;
#pragma unroll
                for (int k = 0; k < 16; ++k) *(LAS v4u*)(RB + (2 * k + (hf ? 1 : 0)) * G_RS + 16 * c32) = ur[k];
                float sc[4];
#pragma unroll
                for (int hh_ = 0; hh_ < 2; ++hh_) { const int ek_ = __shfl(sel, lb0 + hh_ * 16 + 4 * g4 + (n16 & 3)); const f32x2g s2_ = SC2[ek_]; sc[2 * hh_] = s2_.x; sc[2 * hh_ + 1] = s2_.y; }
                LDS_WAIT(); asm volatile("" ::: "memory");
                UP_NEXT;
                f32x4 cc[2]; cc[0] = (f32x4){0.f, 0.f, 0.f, 0.f}; cc[1] = cc[0];
#pragma unroll
                for (int s8 = 0; s8 < 8; ++s8) { const v4u b0 = *(const LAS v4u*)(X8 + 128 * s8 + 16 * g4), b1 = *(const LAS v4u*)(X8 + 128 * s8 + 64 + 16 * g4);
                    const v8i_g bq = (v8i_g){(int)b0.x, (int)b0.y, (int)b0.z, (int)b0.w, (int)b1.x, (int)b1.y, (int)b1.z, (int)b1.w};
#pragma unroll
                    for (int hh_ = 0; hh_ < 2; ++hh_) { const v4u a4 = *(const LAS v4u*)(RB + (hh_ * 16 + n16) * G_RS + 64 * s8 + 16 * g4); const v8i_g a8 = (v8i_g){(int)a4.x, (int)a4.y, (int)a4.z, (int)a4.w, 0, 0, 0, 0};
                        cc[hh_] = __builtin_amdgcn_mfma_scale_f32_16x16x128_f8f6f4(a8, bq, cc[hh_], 4, 0, 0, 0x7f7f7f7f, 0, 0x7f7f7f7f); } }
#pragma unroll
                for (int hh_ = 0; hh_ < 2; ++hh_) { const int lb = lb0 + hh_ * 16; const f32x4 c = cc[hh_];
                    const int r_ = n16 & 3, k_ = 4 * g4 + r_;
                    const float my = r_ == 0 ? c[0] : (r_ == 1 ? c[1] : (r_ == 2 ? c[2] : c[3]));
                    const float gate = __shfl(gsel, lb + k_);
                    const float act = gelu_erf(my * sc[2 * hh_] * xinv) * gate * sc[2 * hh_ + 1];
                    if (n16 < 4) ACT[hq * 32 + hh_ * 16 + k_] = act; }
                LDS_WAIT(); asm volatile("" ::: "memory");
            }
#undef UP_NEXT
        }
#undef UP_LOAD
        LDS_WAIT(); asm volatile("" ::: "memory");
        const float a_lo = ACT[lane], a_hi = ACT[64 + lane];
        float amax = fmaxf(fabsf(a_lo), fabsf(a_hi));
#pragma unroll
        for (int o = 1; o < 64; o <<= 1) amax = fmaxf(amax, __shfl_xor(amax, o));
        const float ainv = amax > 0.f ? 119.0f / amax : 0.f, tscale = amax * (1.0f / 119.0f);
        unsigned pd[4];
        {
            const int A0 = __float2int_rn(a_lo * ainv), A1 = __float2int_rn(a_hi * ainv);
            const int h0 = (A0 + 8) >> 4, l0 = A0 - 16 * h0, h1 = (A1 + 8) >> 4, l1 = A1 - 16 * h1;
            const int sh = 4 * ((lane >> 1) & 7);
            pd[0] = ((unsigned)l0 & 15u) << sh; pd[1] = ((unsigned)h0 & 15u) << sh; pd[2] = ((unsigned)l1 & 15u) << sh; pd[3] = ((unsigned)h1 & 15u) << sh;
#pragma unroll
            for (int q = 0; q < 4; ++q) { pd[q] |= (unsigned)__shfl_xor((int)pd[q], 2); pd[q] |= (unsigned)__shfl_xor((int)pd[q], 4); pd[q] |= (unsigned)__shfl_xor((int)pd[q], 8); }
        }
        int acc0[32], acc1[32];
#pragma unroll
        for (int e = 0; e < 32; ++e) { acc0[e] = 0; acc1[e] = 0; }
#define DN_STEP(buf, hb) do { const unsigned plo_ = (hb) < 4 ? pd[0] : pd[2], phi_ = (hb) < 4 ? pd[1] : pd[3]; \
            const int alo_ = sel2(hf, __builtin_amdgcn_readlane((int)plo_, ((hb) & 3) * 16), __builtin_amdgcn_readlane((int)plo_, ((hb) & 3) * 16 + 1)), ahi_ = sel2(hf, __builtin_amdgcn_readlane((int)phi_, ((hb) & 3) * 16), __builtin_amdgcn_readlane((int)phi_, ((hb) & 3) * 16 + 1)); \
            _Pragma("unroll") for (int w = 0; w < 4; ++w) { unsigned w_[8], t_[8]; \
                _Pragma("unroll") for (int r = 0; r < 8; ++r) w_[r] = buf[r][w]; \
                tr8_nib(w_, t_); \
                _Pragma("unroll") for (int c = 0; c < 8; ++c) { acc0[8 * w + c] = __builtin_amdgcn_sdot8((int)t_[c], alo_, acc0[8 * w + c], false); acc1[8 * w + c] = __builtin_amdgcn_sdot8((int)t_[c], ahi_, acc1[8 * w + c], false); } } } while (0)
        {
            v4u db[8];
            DN_LOAD(db, 1); DN_STEP(da, 0);
            DN_LOAD(da, 2); DN_STEP(db, 1);
            DN_LOAD(db, 3); DN_STEP(da, 2);
            DN_LOAD(da, 4); DN_STEP(db, 3);
            DN_LOAD(db, 5); DN_STEP(da, 4);
            DN_LOAD(da, 6); DN_STEP(db, 5);
            DN_LOAD(db, 7); DN_STEP(da, 6);
            DN_STEP(db, 7);
        }
#undef DN_LOAD
#undef DN_STEP
        int os[16];
#pragma unroll
        for (int k = 0; k < 16; ++k) { const int lo_ = acc0[k] + (acc1[k] << 4), hi_ = acc0[16 + k] + (acc1[16 + k] << 4); os[k] = (hf ? hi_ : lo_) + __shfl_xor(hf ? lo_ : hi_, 32); }
        f32x2g out[8];
#pragma unroll
        for (int e = 0; e < 8; ++e) out[e] = (f32x2g){(float)os[2 * e] * tscale, (float)os[2 * e + 1] * tscale};
        float ss2 = 0.f;
#pragma unroll
        for (int i = 0; i < 4; ++i) { hv[i].x += out[2 * i].x; hv[i].y += out[2 * i].y; hv[i].z += out[2 * i + 1].x; hv[i].w += out[2 * i + 1].y;
            ss2 += (hv[i].x * hv[i].x + hv[i].y * hv[i].y) + (hv[i].z * hv[i].z + hv[i].w * hv[i].w); }
        const float rstd2 = 1.0f / sqrtf(wave_sum(ss2) * (1.f / D) + RMS_EPS);
        f32x4 y[4];
#pragma unroll
        for (int i = 0; i < 4; ++i) y[i] = hv[i] * rstd2 * *(const f32x4*)(gnext + 256 * i + 4 * sg);
        if (layer < DEPTH - 1) {
            bf16* hw_ = HW + (size_t)t * D + 4 * sg; bf16* hn = HN + (size_t)t * D + 4 * sg;
#pragma unroll
            for (int i = 0; i < 4; ++i) { v2u a_, b_; a_.x = pk2(hv[i].x, hv[i].y); a_.y = pk2(hv[i].z, hv[i].w); b_.x = pk2(y[i].x, y[i].y); b_.y = pk2(y[i].z, y[i].w);
                *(v2u*)(hw_ + 256 * i) = a_; *(v2u*)(hn + 256 * i) = b_; }
        } else {
            float* orow = outp + (size_t)t * D + 4 * sg;
#pragma unroll
            for (int i = 0; i < 4; ++i) *(f32x4*)(orow + 256 * i) = y[i];
        }
    }
    LDS_WAIT(); asm volatile("" ::: "memory");
    }
#undef TOK_LOAD
}

struct Args { const float* in[14]; float* out; unsigned char* ws; int ph_lo, ph_hi; };
__global__ void __launch_bounds__(NTHR, 2) mega_fwd(Args args) {
    extern __shared__ __attribute__((aligned(16))) unsigned char lds[];
    Frame F;
    F.lds = (LAS unsigned char*)lds;
    F.tid = threadIdx.x; F.lane = F.tid & 63; F.wave = __builtin_amdgcn_readfirstlane(F.tid >> 6);
    F.G = gridDim.x; { const int bx = blockIdx.x; F.vcu = (F.G % 8 == 0) ? (bx % 8) * (F.G / 8) + bx / 8 : bx; }
    F.ws = args.ws;
    volatile LAS unsigned* MISC = (volatile LAS unsigned*)(F.lds + MISC_OFF);
    if (F.tid < 64) MISC[F.tid] = 0u;
    if (F.tid < 15) { const unsigned long long p = F.tid < 14 ? (unsigned long long)args.in[F.tid] : (unsigned long long)args.out;
        volatile LAS unsigned* t = (volatile LAS unsigned*)(F.lds + PTAB_OFF); t[2 * F.tid] = (unsigned)p; t[2 * F.tid + 1] = (unsigned)(p >> 32); }
    __syncthreads();
    XcdBarrier bar; bar.bar = (unsigned*)(F.ws + WS_CTL) + CW_BAR; bar.x = 0; bar.st = nullptr;
    if (MK_N_LAUNCHES == 1) bar = xcd_barrier_post((unsigned*)(F.ws + WS_CTL) + CW_BAR, MISC + 8);

#pragma unroll 1
    for (int ph = args.ph_lo; ph < args.ph_hi; ++ph) {
        bool did = true;
        const int kind_ = ph == 0 ? 7 : (ph - 1) % PH_PER_LAYER; const int nrep = (PROBE_REP >= 0 && kind_ == PROBE_REP && (ph == 0 || ((PROBE_LMASK >> ((ph - 1) / PH_PER_LAYER)) & 1))) ? 2 : 1;
#pragma unroll 1
        for (int rep = 0; rep < nrep; ++rep) {
        const bool dry = (nrep == 2 && rep == 0);
        { int t_ = threadIdx.x; asm volatile("" : "+v"(t_)); F.tid = t_; F.lane = t_ & 63; F.wave = __builtin_amdgcn_readfirstlane(t_ >> 6);
          unsigned long long ws_ = (unsigned long long)args.ws; asm volatile("" : "+s"(ws_)); F.ws = (unsigned char*)(__attribute__((address_space(1))) unsigned char*)ws_; }
#ifndef DIS_PRO
        if (ph == 0) p0_prologue(F, dry);
#else
        if (ph == 0) {}
#endif
        else {
            const int layer = (ph - 1) / PH_PER_LAYER, k = (ph - 1) % PH_PER_LAYER, j = layer >> 1; const bool is_attn = (layer & 1) == 0;
            if (k == 0) {
                if (!is_attn) {
                    pg8::Gemm g{(const pg8::bf16_t*)(F.ws + WS_HN), (const pg8::bf16_t*)(F.ws + WS_WIN) + (size_t)j * 3072 * 1024, M, 3072, D};
                    pg8::StaticOrder S; S.init(g.M, g.N, F.G, (int)blockIdx.x);
                    EpiConvIn E{(bf16*)(F.ws + WS_BIG), (bf16*)(F.ws + WS_BIG + 32 * MiB)};
                    pg8::gemm_phase<EpiConvIn, pg8::StaticOrder, true, true>(F.lds, g, S, E);
                }
                const int ng = is_attn ? 2 : 0;
#pragma unroll 1
                for (int gi = 0; gi < ng; ++gi) {
                    pg8::Gemm g; pg8::EpiBf16<0> E; E.bias = nullptr; E.split_cols = 0; E.split_stride = 0; E.scale0 = 1.f;
                    if (is_attn && gi == 0) { g = pg8::Gemm{(const pg8::bf16_t*)(F.ws + WS_HN), (const pg8::bf16_t*)(F.ws + WS_WQK) + (size_t)j * 2048 * 1024, M, 2048, D}; E.O = (pg8::bf16_t*)(F.ws + WS_BIG); E.ldc = 2048; }
                    else if (is_attn) { g = pg8::Gemm{(const pg8::bf16_t*)(F.ws + WS_WV) + (size_t)j * 1024 * 1024, (const pg8::bf16_t*)(F.ws + WS_HN), D, M, D}; E.O = (pg8::bf16_t*)(F.ws + WS_VT); E.ldc = M; }
                    else { g = pg8::Gemm{(const pg8::bf16_t*)(F.ws + WS_HN), (const pg8::bf16_t*)(F.ws + WS_WIN) + (size_t)j * 3072 * 1024, M, 3072, D}; E.O = (pg8::bf16_t*)(F.ws + WS_BIG); E.ldc = 3072; }
                    pg8::StaticOrder S; S.init(g.M, g.N, F.G, (int)blockIdx.x);
                    pg8::gemm_phase<pg8::EpiBf16<0>, pg8::StaticOrder, true, true>(F.lds, g, S, E);
                }
            } else if (k == 1) {
                if (is_attn) {
#if NAIVE_ATTN
                    attn_naive_phase(F, j);
#elif !defined(DIS_ATTN)
                    attn_phase(F, j);
#endif
                } else {
#ifndef DIS_CONV
                    conv_phase(F, j);
#endif
                }
            } else if (k == 2) {
                pg8::Gemm g{(const pg8::bf16_t*)(F.ws + WS_MIX), (const pg8::bf16_t*)(F.ws + (is_attn ? WS_WO : WS_WOUT)) + (size_t)j * 1024 * 1024, M, D, D};
                pg8::StaticOrder S; S.init(M, D, F.G, (int)blockIdx.x);
                float* rssp = (float*)(F.ws + (dry ? WS_SC + 96 * MiB : WS_RSS)); bf16* hout = (bf16*)(F.ws + (dry ? WS_SC : WS_H));
                if (layer == 0) { EpiRes<true> E{(const void*)F.in(0), hout, rssp}; pg8::gemm_phase<EpiRes<true>, pg8::StaticOrder, false, true>(F.lds, g, S, E); }
                else { EpiRes<false> E{(const void*)(F.ws + WS_H), hout, rssp}; pg8::gemm_phase<EpiRes<false>, pg8::StaticOrder, false, true>(F.lds, g, S, E); }
            } else if (k == 3) {
                did = false;
            } else if (k == 4) {
                pg8::Gemm g{(const pg8::bf16_t*)(F.ws + WS_H), (const pg8::bf16_t*)(F.ws + WS_WP) + (size_t)layer * 2048 * 1024, M, 2048, D};
                pg8::StaticOrder S; S.init(M, 2048, F.G, (int)blockIdx.x);
#if NAIVE_TOPK
                EpiF32 E{(float*)(F.ws + WS_SC), 2048};
                pg8::gemm_phase<EpiF32, pg8::StaticOrder, true, true>(F.lds, g, S, E);
#else
#ifndef DIS_TOPK
                EpiTopK E{(int*)(F.ws + WS_SELI), (float*)(F.ws + WS_SELG), (const float*)(F.ws + WS_RSS)};
#pragma unroll 1
                for (int i = 0;; ++i) { OneUnit O1; if (!S.next(i, O1.u)) break; pg8::gemm_phase<EpiTopK, OneUnit, false, true>(F.lds, g, O1, E); }
#endif
#endif
            } else if (k == 5) {
#if NAIVE_TOPK
                select_naive_phase(F);
#else
                did = false;
#endif
            } else {
#ifndef DIS_GATHER
                gather_phase(F, layer, dry);
#endif
            }
        }
        if (MK_N_LAUNCHES == 1 && dry) xcd_barrier(bar);
        }
        if (MK_N_LAUNCHES == 1 && did && ph + 1 < args.ph_hi) { xcd_barrier(bar);
#ifdef PROBE_BAR2
            xcd_barrier(bar);
#endif
        }
    }
}

extern "C" void kernel_launch(void* const* d_in, const int* in_sizes, int n_in, void* d_out, int out_size, void* d_ws, size_t ws_size, hipStream_t stream) {
    static int grid = 0;
    if (grid == 0) {
        if (n_in != 14 || out_size != M * D || ws_size < WS_END) { fprintf(stderr, "kernel_launch: unexpected shapes (n_in %d, out %d, ws %zu); nothing launched\n", n_in, out_size, ws_size); grid = -1; return; }
        int dev = 0, cus = 0, per_cu = 0;
        if (hipGetDevice(&dev) != hipSuccess || hipDeviceGetAttribute(&cus, hipDeviceAttributeMultiprocessorCount, dev) != hipSuccess) { grid = -1; return; }
        if (hipFuncSetAttribute((const void*)mega_fwd, hipFuncAttributeMaxDynamicSharedMemorySize, LDS_BYTES) != hipSuccess) { fprintf(stderr, "kernel_launch: hipFuncSetAttribute failed\n"); grid = -1; return; }
        if (hipOccupancyMaxActiveBlocksPerMultiprocessor(&per_cu, (const void*)mega_fwd, NTHR, LDS_BYTES) != hipSuccess || per_cu < 1) fprintf(stderr, "kernel_launch: note: occupancy query reports %d\n", per_cu);
        (void)hipGetLastError();
        grid = cus;
    }
    if (grid < 0) return;
    if (hipMemsetAsync((char*)d_ws + WS_CTL, 0, CTL_ZERO_BYTES, stream) != hipSuccess) return;
    Args a{};
    for (int i = 0; i < 14; ++i) a.in[i] = (const float*)d_in[i];
    a.out = (float*)d_out; a.ws = (unsigned char*)d_ws;
    if (MK_N_LAUNCHES == 1) { a.ph_lo = 0; a.ph_hi = N_PHASES; hipLaunchKernelGGL(mega_fwd, dim3(grid), dim3(NTHR), LDS_BYTES, stream, a); }
    else for (int ph = 0; ph < N_PHASES; ++ph) {
        if (ph > 0 && ((ph - 1) % PH_PER_LAYER == 3 || (!NAIVE_TOPK && (ph - 1) % PH_PER_LAYER == 5))) continue;
        a.ph_lo = ph; a.ph_hi = ph + 1; hipLaunchKernelGGL(mega_fwd, dim3(grid), dim3(NTHR), LDS_BYTES, stream, a);
    }
}
```

```cpp
#include <hip/hip_runtime.h>
#include <cstdio>
#include <cstdint>
namespace pg8 {
#define PG8_LAS __attribute__((address_space(3)))
typedef unsigned short bf16_t;
typedef short bf16x8 __attribute__((ext_vector_type(8)));
typedef float f32x4 __attribute__((ext_vector_type(4)));
typedef unsigned u32x4 __attribute__((ext_vector_type(4)));
constexpr int BM = 256, BK = 64, HALF = 128, HTB = HALF * BK * 2  , STAGE_BYTES = 8 * HTB, NXCD = 8, WGM = 8;

__host__ __device__ __forceinline__ int lds_byte(int r, int c) { const int st = (r >> 4) * 2 + (c >> 5), rr = r & 15, cc = c & 31, ob = rr * 64 + cc * 2; return st * 1024 + (ob ^ (((ob >> 9) & 1) << 5)); }
__host__ __device__ __forceinline__ void stage_rc(int b, int& R, int& C) { const int st = b / 1024, sb = b % 1024, swz = sb ^ (((sb >> 9) & 1) << 5); R = (st >> 1) * 16 + swz / 64; C = (st & 1) * 32 + (swz % 64) / 2; }
__host__ __device__ __forceinline__ int perm32(int rho) { const int n = rho >> 4, i = rho & 15; return 8 * (i >> 2) + 4 * n + (i & 3); }

struct Unit { int pm, pn; };
struct Gemm { const bf16_t* A; const bf16_t* Bt; int M, N, K; };

struct StaticOrder {
    int nM, nN, nwg, G, c;
    __host__ __device__ void init(int M, int N, int G_, int c_) { nM = M / BM; nN = N / BM; nwg = nM * nN; G = G_; c = c_; }
    __host__ __device__ bool next(int i, Unit& u) const {
        const long L = (long)i * G + c; if (L >= nwg) return false;
        int wgid = (int)L; { const int q = nwg / NXCD, r = nwg % NXCD, xcd = wgid % NXCD, off = wgid / NXCD; wgid = (xcd < r ? xcd * (q + 1) : r * (q + 1) + (xcd - r) * q) + off; }
        const int nig = WGM * nN, gid = wgid / nig, fm = gid * WGM, gsz = (nM - fm) < WGM ? (nM - fm) : WGM;
        u.pm = fm + ((wgid % nig) % gsz); u.pn = (wgid % nig) / gsz; return true;
    }
    __device__ __forceinline__ void a_ready(const Unit&) const {}
    __device__ __forceinline__ void done(const Unit&) const {}
};

__device__ __forceinline__ unsigned cvt_pk_bf16(float lo, float hi) { unsigned r; asm volatile("v_cvt_pk_bf16_f32 %0, %1, %2" : "=v"(r) : "v"(lo), "v"(hi)); return r; }
typedef float f32x2 __attribute__((ext_vector_type(2)));
__device__ __forceinline__ f32x2 gelu_pk(f32x2 v) {
    const f32x2 av = __builtin_elementwise_abs(v), d = av * 0.2316418882f + 1.0f;
    f32x2 t; t.x = __builtin_amdgcn_rcpf(d.x); t.y = __builtin_amdgcn_rcpf(d.y);
    f32x2 q = t * 0.5307027145f + (-0.7265760135f); q = q * t + 0.7107068705f; q = q * t + (-0.142248368f); q = q * t + 0.127414796f; q = q * t;
    const f32x2 s = (v * v) * (-0.72134752044f);
    f32x2 e; e.x = __builtin_amdgcn_exp2f(s.x); e.y = __builtin_amdgcn_exp2f(s.y);
    const f32x2 m = v * (q * e), r = v - m;
    f32x2 o; o.x = v.x < 0.f ? m.x : r.x; o.y = v.y < 0.f ? m.y : r.y; return o;
}

template <int ACT  > struct EpiBf16 {
    static constexpr bool PERM = true, AFTER_DRAIN = false; static_assert(ACT == 0 || ACT == 1, "EpiBf16: ACT is 0 (none) or 1 (gelu_pk)");
    bf16_t* O; int ldc; const float* bias; int split_cols; size_t split_stride; float scale0;
    __device__ __forceinline__ void operator()(const f32x4 (&acc)[2][2][4][2], const Unit& u, int wr, int wc, int fr, int fq) const {
        const int row0 = u.pm * BM + wr * 64 + fr; int colt = u.pn * BM; bf16_t* base = O;
        float sc = 1.f; if (split_cols) { const int t = colt / split_cols; base += (size_t)t * split_stride; colt -= t * split_cols; if (t == 0) sc = scale0; }
        const int col0 = colt + wc * 32 + 8 * fq, bcol0 = u.pn * BM + wc * 32 + 8 * fq;
        f32x4 bv[2][2];
#pragma unroll
        for (int bj = 0; bj < 2; ++bj)
#pragma unroll
            for (int n = 0; n < 2; ++n) bv[bj][n] = bias ? *(const f32x4*)(bias + bcol0 + bj * HALF + 4 * n) : (f32x4){0.f, 0.f, 0.f, 0.f};
#pragma unroll
        for (int ai = 0; ai < 2; ++ai)
#pragma unroll
            for (int m = 0; m < 4; ++m) { bf16_t* rowp = base + (size_t)(row0 + ai * HALF + m * 16) * ldc + col0;
#pragma unroll
                for (int bj = 0; bj < 2; ++bj) { f32x4 v0 = acc[ai][bj][m][0] + bv[bj][0], v1 = acc[ai][bj][m][1] + bv[bj][1];
                    if (ACT == 1) { f32x2 a = gelu_pk((f32x2){v0[0], v0[1]}), b = gelu_pk((f32x2){v0[2], v0[3]}), c = gelu_pk((f32x2){v1[0], v1[1]}), d = gelu_pk((f32x2){v1[2], v1[3]});
                        v0 = (f32x4){a.x, a.y, b.x, b.y}; v1 = (f32x4){c.x, c.y, d.x, d.y}; }
                    v0 = v0 * sc; v1 = v1 * sc; u32x4 w; w.x = cvt_pk_bf16(v0[0], v0[1]); w.y = cvt_pk_bf16(v0[2], v0[3]); w.z = cvt_pk_bf16(v1[0], v1[1]); w.w = cvt_pk_bf16(v1[2], v1[3]);
                    *(u32x4*)(rowp + bj * HALF) = w; } }
    }
};

template <class Epi, class Sched, bool ALIGN_EPI = false, bool SP2 = false>
__device__ __forceinline__ void gemm_phase(PG8_LAS unsigned char* lds, const Gemm g, const Sched& S, const Epi& E) {
    int tid_l = threadIdx.x; asm volatile("" : "+v"(tid_l));
    const int tid = tid_l, wid = __builtin_amdgcn_readfirstlane(tid >> 6), lane = tid & 63, wr = wid >> 2, wc = wid & 3, fr = lane & 15, fq = lane >> 4;
    const int K = g.K, nt = K / BK;
    unsigned voffA[2], voffB[2];
#pragma unroll
    for (int i = 0; i < 2; ++i) { int R, C; stage_rc(tid * 16 + i * 8192, R, C); const int Rb = Epi::PERM ? ((R & ~31) + perm32(R & 31)) : R;
        voffA[i] = (unsigned)(R * K + C) * 2u; voffB[i] = (unsigned)(Rb * K + C) * 2u; }
    const size_t kstep = (size_t)(BK * 2);
    const size_t hstep = (size_t)HALF * K * 2;
    const size_t tstep = 2 * hstep;
    const unsigned ldsw = (unsigned)wid * 1024u;
    const int aoff = lds_byte(wr * 64 + fr, fq * 8), boff = lds_byte(wc * 32 + fr, fq * 8);
#define PG8_SA(b, h) (((b) * 2 + (h)) * HTB)
#define PG8_SB(b, h) ((4 + (b) * 2 + (h)) * HTB)
#define PG8_STAGE(bufoff, gbase, voff) do { _Pragma("unroll") for (int _i = 0; _i < 2; ++_i) \
        __builtin_amdgcn_global_load_lds((const unsigned*)((const char*)(gbase) + (voff)[_i]), (PG8_LAS unsigned*)(lds + (bufoff) + ldsw + _i * 8192), 16, 0, 0); } while (0)
#define PG8_LDA(dst, b, h) do { _Pragma("unroll") for (int m = 0; m < 4; ++m) _Pragma("unroll") for (int k = 0; k < 2; ++k) dst[m][k] = *(const PG8_LAS bf16x8*)(lds + PG8_SA(b, h) + aoff + m * 2048 + k * 1024); } while (0)
#define PG8_LDB(dst, b, h) do { _Pragma("unroll") for (int n = 0; n < 2; ++n) _Pragma("unroll") for (int k = 0; k < 2; ++k) dst[n][k] = *(const PG8_LAS bf16x8*)(lds + PG8_SB(b, h) + boff + n * 2048 + k * 1024); } while (0)
#define PG8_MMA(ai, bj, At, Bt) do { __builtin_amdgcn_s_setprio(1); _Pragma("unroll") for (int m = 0; m < 4; ++m) _Pragma("unroll") for (int n = 0; n < 2; ++n) _Pragma("unroll") for (int k = 0; k < 2; ++k) \
        acc[ai][bj][m][n] = __builtin_amdgcn_mfma_f32_16x16x32_bf16(Bt[n][k], At[m][k], acc[ai][bj][m][n], 0, 0, 0); __builtin_amdgcn_s_setprio(0); } while (0)
#define PG8_WAIT_V(n) asm volatile("s_waitcnt vmcnt(" #n ")" ::: "memory")
#define PG8_WAIT_L(n) asm volatile("s_waitcnt lgkmcnt(" #n ")" ::: "memory")
#define PG8_BAR __builtin_amdgcn_s_barrier()
#define PG8_SCHED __builtin_amdgcn_sched_barrier(0)
    Unit cur, nxt; int ui = 0;
    if (!S.next(0, cur)) return;
    f32x4 acc[2][2][4][2];
#pragma unroll
    for (int a = 0; a < 2; ++a)
#pragma unroll
        for (int b = 0; b < 2; ++b)
#pragma unroll
            for (int m = 0; m < 4; ++m)
#pragma unroll
                for (int n = 0; n < 2; ++n) acc[a][b][m][n] = (f32x4){0.f, 0.f, 0.f, 0.f};
    bf16x8 At[4][2], B0[2][2], B1[2][2];
    const char* cA = (const char*)g.A + (size_t)cur.pm * tstep; const char* cB = (const char*)g.Bt + (size_t)cur.pn * tstep;
    S.a_ready(cur);
    if constexpr (SP2) {
        PG8_STAGE(PG8_SB(0, 0), cB, voffB); PG8_STAGE(PG8_SB(0, 1), cB + hstep, voffB); PG8_STAGE(PG8_SA(0, 0), cA, voffA); PG8_STAGE(PG8_SA(0, 1), cA + hstep, voffA);
        if (wr == 1) PG8_BAR;
        PG8_WAIT_V(2); PG8_BAR;
        PG8_STAGE(PG8_SB(1, 0), cB + kstep, voffB); PG8_STAGE(PG8_SA(1, 0), cA + kstep, voffA); PG8_STAGE(PG8_SB(1, 1), cB + hstep + kstep, voffB);
        PG8_WAIT_V(6); PG8_BAR;
    } else {
        PG8_STAGE(PG8_SB(0, 0), cB, voffB); PG8_STAGE(PG8_SA(0, 0), cA, voffA); PG8_STAGE(PG8_SB(0, 1), cB + hstep, voffB); PG8_STAGE(PG8_SA(0, 1), cA + hstep, voffA);
        if (wr == 1) PG8_BAR;
        PG8_WAIT_V(4); PG8_BAR;
        PG8_STAGE(PG8_SB(1, 0), cB + kstep, voffB); PG8_STAGE(PG8_SA(1, 0), cA + kstep, voffA); PG8_STAGE(PG8_SB(1, 1), cB + hstep + kstep, voffB);
        PG8_WAIT_V(6); PG8_BAR;
    }
    for (;;) {
        const bool has_next = S.next(ui + 1, nxt);
        const char* nA = has_next ? (const char*)g.A + (size_t)nxt.pm * tstep : cA; const char* nB = has_next ? (const char*)g.Bt + (size_t)nxt.pn * tstep : cB;
        for (int t = 0; t < nt; t += 2) {
            const bool last = (t == nt - 2);
            const char* a1 = cA + (size_t)(t + 1) * kstep;
            const char* a2 = last ? nA : cA + (size_t)(t + 2) * kstep; const char* b2 = last ? nB : cB + (size_t)(t + 2) * kstep;
            const char* a3 = a2 + kstep; const char* b3 = b2 + kstep;
            if (last && has_next) S.a_ready(nxt);
            if constexpr (SP2) {
            PG8_LDB(B0, 0, 0); PG8_LDB(B1, 0, 1); PG8_SCHED; PG8_LDA(At, 0, 0); PG8_STAGE(PG8_SA(1, 1), a1 + hstep, voffA);
            PG8_WAIT_V(8); PG8_WAIT_L(0); PG8_BAR; PG8_MMA(0, 0, At, B0); PG8_MMA(0, 1, At, B1); PG8_BAR; PG8_SCHED;
            PG8_LDA(At, 0, 1); PG8_STAGE(PG8_SB(0, 0), b2, voffB); PG8_STAGE(PG8_SB(0, 1), b2 + hstep, voffB); PG8_STAGE(PG8_SA(0, 0), a2, voffA);
            PG8_WAIT_V(8); PG8_WAIT_L(0); PG8_BAR; PG8_MMA(1, 0, At, B0); PG8_MMA(1, 1, At, B1); PG8_BAR; PG8_SCHED;
            PG8_LDB(B0, 1, 0); PG8_LDB(B1, 1, 1); PG8_SCHED; PG8_LDA(At, 1, 0); PG8_STAGE(PG8_SA(0, 1), a2 + hstep, voffA);
            PG8_WAIT_V(8); PG8_WAIT_L(0); PG8_BAR; PG8_MMA(0, 0, At, B0); PG8_MMA(0, 1, At, B1); PG8_BAR; PG8_SCHED;
            PG8_LDA(At, 1, 1); PG8_STAGE(PG8_SB(1, 0), b3, voffB); PG8_STAGE(PG8_SB(1, 1), b3 + hstep, voffB); PG8_STAGE(PG8_SA(1, 0), a3, voffA);
            PG8_WAIT_V(8); PG8_WAIT_L(0); PG8_BAR; PG8_MMA(1, 0, At, B0); PG8_MMA(1, 1, At, B1); PG8_BAR; PG8_SCHED;
            } else {
            PG8_LDB(B0, 0, 0); PG8_SCHED; PG8_LDA(At, 0, 0); PG8_STAGE(PG8_SA(1, 1), a1 + hstep, voffA);
            PG8_WAIT_L(8); PG8_BAR; PG8_WAIT_L(0); PG8_MMA(0, 0, At, B0); PG8_BAR; PG8_SCHED;
            PG8_LDB(B1, 0, 1); PG8_STAGE(PG8_SB(0, 0), b2, voffB);
            PG8_BAR; PG8_WAIT_L(0); PG8_MMA(0, 1, At, B1); PG8_BAR;
            PG8_LDA(At, 0, 1); PG8_STAGE(PG8_SA(0, 0), a2, voffA);
            PG8_BAR; PG8_WAIT_L(0); PG8_MMA(1, 0, At, B0); PG8_BAR; PG8_SCHED;
            PG8_STAGE(PG8_SB(0, 1), b2 + hstep, voffB);
            PG8_WAIT_V(6); PG8_BAR; PG8_MMA(1, 1, At, B1); PG8_BAR;
            PG8_LDB(B0, 1, 0); PG8_SCHED; PG8_LDA(At, 1, 0); PG8_STAGE(PG8_SA(0, 1), a2 + hstep, voffA);
            PG8_WAIT_L(8); PG8_BAR; PG8_WAIT_L(0); PG8_MMA(0, 0, At, B0); PG8_BAR; PG8_SCHED;
            PG8_LDB(B1, 1, 1); PG8_STAGE(PG8_SB(1, 0), b3, voffB);
            PG8_BAR; PG8_WAIT_L(0); PG8_MMA(0, 1, At, B1); PG8_BAR;
            PG8_LDA(At, 1, 1); PG8_STAGE(PG8_SA(1, 0), a3, voffA);
            PG8_BAR; PG8_WAIT_L(0); PG8_MMA(1, 0, At, B0); PG8_BAR; PG8_SCHED;
            PG8_STAGE(PG8_SB(1, 1), b3 + hstep, voffB);
            PG8_WAIT_V(6); PG8_BAR; PG8_MMA(1, 1, At, B1); PG8_BAR;
            }
        }
        if constexpr (ALIGN_EPI) { if (wr == 0) PG8_BAR; }
        if constexpr (!Epi::AFTER_DRAIN) { E(acc, cur, wr, wc, fr, fq); S.done(cur); }
        if (!has_next) break;
#pragma unroll
        for (int a = 0; a < 2; ++a)
#pragma unroll
            for (int b = 0; b < 2; ++b)
#pragma unroll
                for (int m = 0; m < 4; ++m)
#pragma unroll
                    for (int n = 0; n < 2; ++n) acc[a][b][m][n] = (f32x4){0.f, 0.f, 0.f, 0.f};
        cur = nxt; cA = nA; cB = nB; ++ui;
        if constexpr (ALIGN_EPI) { if (wr == 1) PG8_BAR; }
    }
    PG8_WAIT_V(0);
    if constexpr (!ALIGN_EPI) { if (wr == 0) PG8_BAR; }
    PG8_BAR;
    if constexpr (Epi::AFTER_DRAIN) { E.fused(acc, cur, wr, wc, fr, fq, lds, wid, lane); S.done(cur); }
#undef PG8_SA
#undef PG8_SB
#undef PG8_STAGE
#undef PG8_LDA
#undef PG8_LDB
#undef PG8_MMA
#undef PG8_WAIT_V
#undef PG8_WAIT_L
#undef PG8_BAR
#undef PG8_SCHED
}
}
#ifndef HD
#define HD __host__ __device__ __forceinline__
#endif
HD int tk_map(float f) { int b = __builtin_bit_cast(int, f); return b ^ ((b >> 31) & 0x7fffffff); }
HD float tk_unmap(int k) { int b = k ^ ((k >> 31) & 0x7fffffff); return __builtin_bit_cast(float, b); }
HD void tk_cx(int& a, int& b) { const int hi = a > b ? a : b, lo = a > b ? b : a; a = hi; b = lo; }
template <int N> HD void tk_sort_desc(int (&v)[N]) {
#pragma unroll
    for (int k = 2; k <= N; k <<= 1)
#pragma unroll
        for (int j = k >> 1; j > 0; j >>= 1)
#pragma unroll
            for (int i = 0; i < N; ++i) { const int l = i ^ j; if (l > i) { if ((i & k) == 0) tk_cx(v[i], v[l]); else tk_cx(v[l], v[i]); } }
}
template <int N> HD void tk_merge_top(int (&a)[N], const int (&b)[N]) {
#pragma unroll
    for (int i = 0; i < N; ++i) a[i] = a[i] > b[N - 1 - i] ? a[i] : b[N - 1 - i];
#pragma unroll
    for (int j = N >> 1; j > 0; j >>= 1)
#pragma unroll
        for (int i = 0; i < N; ++i) { const int l = i ^ j; if (l > i) tk_cx(a[i], a[l]); }
}
template <int NCH, class FP> HD void tk_stage1(FP s, int n_base, int (&best)[16]) {
#pragma unroll
    for (int c = 0; c < NCH; ++c) {
        int x[16];
#pragma unroll
        for (int e = 0; e < 16; ++e) x[e] = (tk_map(s[c * 16 + e]) & ~127) | (127 - (n_base + c * 16 + e));
        tk_sort_desc(x);
        if (c == 0) {
#pragma unroll
            for (int e = 0; e < 16; ++e) best[e] = x[e];
        } else tk_merge_top(best, x);
    }
}
template <class IP, class OI, class OG> HD void tk_stage2(int (&a)[16], int (&b)[16], IP AB, OI out_idx, OG out_g, float vscale = 1.0f) {
    float va[16], vb[16];
#pragma unroll
    for (int i = 0; i < 16; ++i) { AB[i] = a[i]; AB[16 + i] = b[i]; va[i] = tk_unmap(a[i] & ~127); vb[i] = tk_unmap(b[i] & ~127); }
    int best[16];
#pragma unroll
    for (int c = 0; c < 4; ++c) {
        int x[16];
#pragma unroll
        for (int e = 0; e < 16; ++e) x[e] = (int)0x80000000;
        int n = 0;
#pragma unroll
        for (int i = 0; i < 16; ++i)
#pragma unroll
            for (int j = 0; j < 16; ++j)
                if ((i + 1) * (j + 1) <= 16) { if (n >= 16 * c && n < 16 * c + 16) x[n - 16 * c] = (tk_map(va[i] + vb[j]) & ~255) | (255 - (i * 16 + j)); ++n; }
        tk_sort_desc(x);
        if (c == 0) {
#pragma unroll
            for (int e = 0; e < 16; ++e) best[e] = x[e];
        } else tk_merge_top(best, x);
    }
    int ka[16], kb[16];
#pragma unroll
    for (int k = 0; k < 16; ++k) { const int flat = 255 - (best[k] & 255); ka[k] = AB[flat >> 4]; kb[k] = AB[16 + (flat & 15)]; }
    float sv[16]; int ei[16]; float sum = 0.f;
#pragma unroll
    for (int k = 0; k < 16; ++k) { ei[k] = (127 - (ka[k] & 127)) * 128 + (127 - (kb[k] & 127)); sv[k] = (tk_unmap(ka[k] & ~127) + tk_unmap(kb[k] & ~127)) * vscale; }
    const float m = sv[0];
#pragma unroll
    for (int k = 0; k < 16; ++k) { sv[k] = __expf(sv[k] - m); sum += sv[k]; }
    const float inv = 1.0f / sum;
#pragma unroll
    for (int k = 0; k < 16; ++k) { out_idx[k] = ei[k]; out_g[k] = sv[k] * inv; }
}
constexpr int NWAVES = 8, NTHR = 512;
constexpr int BATCH = 2, SEQ = 8192, D = 1024, M = BATCH * SEQ, DEPTH = 4;
constexpr int NH = 16, HDIM = 64, GRIDW = 64, NROWS = 128;
constexpr float RMS_EPS = 1e-6f;
#ifndef MK_N_LAUNCHES
#define MK_N_LAUNCHES 1
#endif
#ifndef NAIVE_ATTN
#define NAIVE_ATTN 0
#endif
#ifndef NAIVE_TOPK
#define NAIVE_TOPK 0
#endif
#ifndef EXPERT_FP4
#define EXPERT_FP4 1
#endif
constexpr int ROWB = EXPERT_FP4 ? 512 : 1024;
#ifndef PROBE_GMODE
#define PROBE_GMODE 0
#endif
#ifndef PROBE_PMODE
#define PROBE_PMODE 0
#endif
#ifndef PROBE_LMASK
#define PROBE_LMASK 15
#endif
#ifndef PROBE_REP
#define PROBE_REP -1
#endif
constexpr int PH_PER_LAYER = 7, N_PHASES = 1 + DEPTH * PH_PER_LAYER;

constexpr size_t MiB = 1u << 20;
constexpr size_t WS_CTL = 0, CTL_ZERO_BYTES = 32 * 1024;
constexpr size_t WS_WQK = 2 * MiB;
constexpr size_t WS_WV = 10 * MiB;
constexpr size_t WS_WO = 14 * MiB;
constexpr size_t WS_WIN = 18 * MiB;
constexpr size_t WS_WOUT = 30 * MiB;
constexpr size_t WS_WP = 34 * MiB;
constexpr size_t WS_H = 64 * MiB;
constexpr size_t WS_HN = 128 * MiB;
constexpr size_t WS_BIG = 160 * MiB;
constexpr size_t WS_VT = 224 * MiB;
constexpr size_t WS_MIX = 256 * MiB;
constexpr size_t WS_SELI = 288 * MiB;
constexpr size_t WS_SELG = 296 * MiB;
constexpr size_t WS_UP = 320 * MiB;
constexpr size_t WS_DN = 384 * MiB;
constexpr size_t WS_SUP = 448 * MiB;
constexpr size_t WS_RSS = 450 * MiB;
constexpr size_t WS_SC = 576 * MiB;
constexpr size_t WS_END = 704 * MiB;
constexpr int CW_BAR = 4096;
static_assert((CW_BAR + 3456) * 4 <= (int)CTL_ZERO_BYTES, "barrier words inside the per-call memset");

constexpr int LDS_BYTES = 163840, MISC_OFF = LDS_BYTES - 256, PTAB_OFF = LDS_BYTES - 512;

#define LAS __attribute__((address_space(3)))
typedef unsigned short bf16;
typedef unsigned v4u __attribute__((ext_vector_type(4)));
typedef unsigned v2u __attribute__((ext_vector_type(2)));
typedef float f32x4 __attribute__((ext_vector_type(4)));
typedef short bf16x8 __attribute__((ext_vector_type(8)));
#define LDS_WAIT() asm volatile("s_waitcnt lgkmcnt(0)" ::: "memory")
#define BLOCK_BAR() do { asm volatile("s_waitcnt vmcnt(0) lgkmcnt(0)" ::: "memory"); __builtin_amdgcn_s_barrier(); asm volatile("" ::: "memory"); } while (0)
__device__ __forceinline__ unsigned f2bf(float f) { unsigned u = __builtin_bit_cast(unsigned, f); return (u + 0x7fffu + ((u >> 16) & 1u)) >> 16; }
typedef float f32x2p __attribute__((ext_vector_type(2))); typedef __bf16 bf16x2p __attribute__((ext_vector_type(2)));
__device__ __forceinline__ unsigned pk2(float lo, float hi) { const f32x2p v = {lo, hi}; return __builtin_bit_cast(unsigned, __builtin_convertvector(v, bf16x2p)); }
__device__ __forceinline__ float bflo(unsigned u) { return __builtin_bit_cast(float, u << 16); }
__device__ __forceinline__ float bfhi(unsigned u) { return __builtin_bit_cast(float, u & 0xffff0000u); }
__device__ __forceinline__ float wave_sum(float v) {
#pragma unroll
    for (int o = 1; o < 64; o <<= 1) v += __shfl_xor(v, o);
    return v;
}

#define XB_TMO      128
#define XB_XCNT(j)  (256  + 64 * (j))
#define XB_XSUB(j)  (1280 + 64 * (j))
#define XB_XGEN(j)  (2304 + 64 * (j))
#define XB_TOP      3328
#define XB_TOPGEN   3392
#define XCD_BAR_WORDS 3456
#define XB_SPIN_CAP (1u << 20)
__device__ __forceinline__ unsigned xb_ld(unsigned* p)              { return __hip_atomic_load(p, __ATOMIC_RELAXED, __HIP_MEMORY_SCOPE_AGENT); }
__device__ __forceinline__ unsigned xb_add(unsigned* p, unsigned v) { return __hip_atomic_fetch_add(p, v, __ATOMIC_RELAXED, __HIP_MEMORY_SCOPE_AGENT); }
__device__ __forceinline__ unsigned xb_xcc_id() { return (unsigned)__builtin_amdgcn_s_getreg((3 << 11) | 20) & 0xFu; }
#define XB_SPIN(cond, bar) do { unsigned _sp = 0; while (cond) { __builtin_amdgcn_s_sleep(1); \
    if ((++_sp & 255u) == 0u) { if (xb_ld(&(bar)[XB_TMO])) break; if (_sp > XB_SPIN_CAP) { atomicAdd(&(bar)[XB_TMO], 1u); break; } } } } while (0)
struct XcdBarrier { unsigned* bar; unsigned x; volatile LAS unsigned* st; };
__device__ __forceinline__ XcdBarrier xcd_barrier_post(unsigned* bar, volatile LAS unsigned* st) {
    XcdBarrier b; b.bar = bar; b.x = xb_xcc_id(); b.st = st;
    if (threadIdx.x == 0) (void)xb_add(&bar[XB_XCNT(b.x)], 1u);
    return b;
}
__device__ __forceinline__ void xcd_barrier_complete(unsigned* bar, unsigned x, unsigned& nloc, unsigned& nx) {
    const unsigned G = gridDim.x * gridDim.y * gridDim.z;
    unsigned sum, cnt, mine, sp = 0u;
    for (;;) {
        sum = 0u; cnt = 0u; mine = 0u;
#pragma unroll
        for (unsigned j = 0; j < 16; ++j) { const unsigned c = xb_ld(&bar[XB_XCNT(j)]); sum += c; cnt += (c > 0u) ? 1u : 0u; mine = (j == x) ? c : mine; }
        if (sum == G) break;
        __builtin_amdgcn_s_sleep(1);
        if ((++sp & 255u) == 0u) { if (xb_ld(&bar[XB_TMO])) break; if (sp > XB_SPIN_CAP) { atomicAdd(&bar[XB_TMO], 1u); break; } }
    }
    nloc = mine > 0u ? mine : 1u; nx = cnt > 0u ? cnt : 1u;
}
__device__ __forceinline__ void xcd_barrier(const XcdBarrier& b) {
    asm volatile("s_waitcnt vmcnt(0)" ::: "memory");
    __syncthreads();
    if (threadIdx.x == 0) {
        unsigned* bar = b.bar;
        __builtin_amdgcn_s_waitcnt(0);
        unsigned nloc = b.st[0], nx = b.st[1];
        if (nloc == 0u) { xcd_barrier_complete(bar, b.x, nloc, nx); b.st[0] = nloc; b.st[1] = nx; }
        const unsigned old = xb_add(&bar[XB_XSUB(b.x)], 1u);
        const unsigned gen = old / nloc;
        if (old + 1u == (gen + 1u) * nloc) {
            __builtin_amdgcn_fence(__ATOMIC_RELEASE, "agent");
            asm volatile("s_waitcnt vmcnt(0)" ::: "memory");
            const unsigned og = xb_add(&bar[XB_TOP], 1u);
            const unsigned tg = og / nx;
            if (og + 1u == (tg + 1u) * nx) xb_add(&bar[XB_TOPGEN], 1u);
            else XB_SPIN(xb_ld(&bar[XB_TOPGEN]) == tg, bar);
            __builtin_amdgcn_fence(__ATOMIC_ACQUIRE, "agent");
            xb_add(&bar[XB_XGEN(b.x)], 1u);
            asm volatile("s_waitcnt vmcnt(0)" ::: "memory");
        } else {
            XB_SPIN(xb_ld(&bar[XB_XGEN(b.x)]) == gen, bar);
            __builtin_amdgcn_fence(__ATOMIC_ACQUIRE, "agent");
            asm volatile("s_waitcnt vmcnt(0)" ::: "memory");
        }
    }
    __syncthreads();
}

struct Frame {
    LAS unsigned char* lds;
    int tid, lane, wave, vcu, G;
    unsigned char* ws;
    __device__ __forceinline__ const float* in(int i) const {
        const volatile LAS unsigned* t = (const volatile LAS unsigned*)(lds + PTAB_OFF);
        const unsigned lo = __builtin_amdgcn_readfirstlane(t[2 * i]), hi = __builtin_amdgcn_readfirstlane(t[2 * i + 1]);
        return (const float*)(const __attribute__((address_space(1))) float*)(((unsigned long long)hi << 32) | lo);
    }
    __device__ __forceinline__ float* out() const { return (float*)in(14); }
};

template <bool FIRST> struct EpiRes {
    static constexpr bool PERM = true, AFTER_DRAIN = false;
    const void* hin; bf16* h; float* rss;
    __device__ __forceinline__ void operator()(const pg8::f32x4 (&acc)[2][2][4][2], const pg8::Unit& u, int wr, int wc, int fr, int fq) const {
        const int col0 = u.pn * 256 + wc * 32 + 8 * fq;
#pragma unroll
        for (int ai = 0; ai < 2; ++ai)
#pragma unroll
            for (int m = 0; m < 4; ++m) { const int row = u.pm * 256 + ai * 128 + wr * 64 + m * 16 + fr; bf16* rowp = h + (size_t)row * D + col0;
                float ss = 0.f;
#pragma unroll
                for (int bj = 0; bj < 2; ++bj) { f32x4 v0, v1;
                    if (FIRST) { const float* xp = (const float*)hin + (size_t)row * D + col0 + bj * 128; v0 = *(const f32x4*)xp; v1 = *(const f32x4*)(xp + 4); }
                    else { const v4u hw = *(const v4u*)((const bf16*)hin + (size_t)row * D + col0 + bj * 128); v0 = (f32x4){bflo(hw.x), bfhi(hw.x), bflo(hw.y), bfhi(hw.y)}; v1 = (f32x4){bflo(hw.z), bfhi(hw.z), bflo(hw.w), bfhi(hw.w)}; }
                    v0 += acc[ai][bj][m][0]; v1 += acc[ai][bj][m][1];
                    ss += ((v0.x * v0.x + v0.y * v0.y) + (v0.z * v0.z + v0.w * v0.w)) + ((v1.x * v1.x + v1.y * v1.y) + (v1.z * v1.z + v1.w * v1.w));
                    v4u w; w.x = pk2(v0.x, v0.y); w.y = pk2(v0.z, v0.w); w.z = pk2(v1.x, v1.y); w.w = pk2(v1.z, v1.w); *(v4u*)(rowp + bj * 128) = w; }
                ss += __shfl_xor(ss, 16); ss += __shfl_xor(ss, 32);
                if (fq == 0) rss[(size_t)row * 16 + u.pn * 4 + wc] = ss; }
    }
};
struct EpiConvIn {
    static constexpr bool PERM = true, AFTER_DRAIN = false;
    bf16* U; bf16* GB;
    __device__ __forceinline__ void operator()(const pg8::f32x4 (&acc)[2][2][4][2], const pg8::Unit& u, int wr, int wc, int fr, int fq) const {
        const int row0 = u.pm * 256 + wr * 64 + fr;
        if (u.pn < 8) {
            const int ch0 = u.pn * 128 + wc * 32 + 8 * fq;
#pragma unroll
            for (int ai = 0; ai < 2; ++ai)
#pragma unroll
                for (int m = 0; m < 4; ++m) { const f32x4 p0 = acc[ai][0][m][0] * acc[ai][1][m][0], p1 = acc[ai][0][m][1] * acc[ai][1][m][1];
                    v4u w; w.x = pk2(p0[0], p0[1]); w.y = pk2(p0[2], p0[3]); w.z = pk2(p1[0], p1[1]); w.w = pk2(p1[2], p1[3]);
                    *(v4u*)(U + (size_t)(row0 + ai * 128 + m * 16) * D + ch0) = w; }
        } else {
            const int col0 = (u.pn - 8) * 256 + wc * 32 + 8 * fq;
#pragma unroll
            for (int ai = 0; ai < 2; ++ai)
#pragma unroll
                for (int m = 0; m < 4; ++m)
#pragma unroll
                    for (int bj = 0; bj < 2; ++bj) { const f32x4 v0 = acc[ai][bj][m][0], v1 = acc[ai][bj][m][1];
                        v4u w; w.x = pk2(v0[0], v0[1]); w.y = pk2(v0[2], v0[3]); w.z = pk2(v1[0], v1[1]); w.w = pk2(v1[2], v1[3]);
                        *(v4u*)(GB + (size_t)(row0 + ai * 128 + m * 16) * D + col0 + bj * 128) = w; }
        }
    }
};
struct EpiF32 {
    static constexpr bool PERM = false, AFTER_DRAIN = false;
    float* O; int ldc;
    __device__ __forceinline__ void operator()(const pg8::f32x4 (&acc)[2][2][4][2], const pg8::Unit& u, int wr, int wc, int fr, int fq) const {
        const int col0 = u.pn * 256 + wc * 32 + 4 * fq;
#pragma unroll
        for (int ai = 0; ai < 2; ++ai)
#pragma unroll
            for (int m = 0; m < 4; ++m) { float* rowp = O + (size_t)(u.pm * 256 + ai * 128 + wr * 64 + m * 16 + fr) * ldc + col0;
#pragma unroll
                for (int bj = 0; bj < 2; ++bj)
#pragma unroll
                    for (int n = 0; n < 2; ++n) *(f32x4*)(rowp + bj * 128 + n * 16) = acc[ai][bj][m][n]; }
    }
};
struct EpiTopK {
    static constexpr bool PERM = false, AFTER_DRAIN = true;
    int* seli; float* selg; const float* rss;
    __device__ __forceinline__ void operator()(const pg8::f32x4 (&)[2][2][4][2], const pg8::Unit&, int, int, int, int) const {}
    __device__ __forceinline__ void fused(pg8::f32x4 (&acc)[2][2][4][2], const pg8::Unit& u, int wr, int wc, int fr, int fq, LAS unsigned char* lds, int wid, int lane) const {
        LAS float* S = (LAS float*)lds;
        LAS int* L = (LAS int*)lds;
        const int tid = wid * 64 + lane;
#pragma unroll 1
        for (int ai = 0; ai < 2; ++ai) {
#pragma unroll
            for (int m = 0; m < 4; ++m)
#pragma unroll
                for (int bj = 0; bj < 2; ++bj)
#pragma unroll
                    for (int n = 0; n < 2; ++n) {
                        const int row = wr * 64 + m * 16 + fr, col = bj * 128 + wc * 32 + n * 16 + 4 * fq;
                        *(LAS f32x4*)(S + row * 260 + col) = ai == 0 ? acc[0][bj][m][n] : acc[1][bj][m][n];
                    }
            BLOCK_BAR();
            const int row = tid & 127, q = tid >> 7;
            int best[16];
            {
                const LAS f32x4* sp = (const LAS f32x4*)(S + row * 260 + q * 64);
#pragma unroll
                for (int c = 0; c < 4; ++c) {
                    int x[16];
#pragma unroll
                    for (int e4 = 0; e4 < 4; ++e4) { const f32x4 v = sp[c * 4 + e4];
#pragma unroll
                        for (int e = 0; e < 4; ++e) x[e4 * 4 + e] = (tk_map(v[e]) & ~127) | (127 - ((q & 1) * 64 + c * 16 + e4 * 4 + e)); }
                    tk_sort_desc(x);
                    if (c == 0) {
#pragma unroll
                        for (int e = 0; e < 16; ++e) best[e] = x[e];
                    } else tk_merge_top(best, x);
                }
            }
            BLOCK_BAR();
#pragma unroll
            for (int e4 = 0; e4 < 4; ++e4) *(LAS v4u*)(L + row * 68 + q * 16 + e4 * 4) = (v4u){(unsigned)best[e4 * 4], (unsigned)best[e4 * 4 + 1], (unsigned)best[e4 * 4 + 2], (unsigned)best[e4 * 4 + 3]};
            BLOCK_BAR();
            if (tid < 128) {
                int a[16], b[16], t[16];
                LAS int* Lr = L + tid * 68;
#pragma unroll
                for (int e4 = 0; e4 < 4; ++e4) { const v4u va = *(LAS v4u*)(Lr + e4 * 4), vt = *(LAS v4u*)(Lr + 16 + e4 * 4);
#pragma unroll
                    for (int e = 0; e < 4; ++e) { a[e4 * 4 + e] = (int)va[e]; t[e4 * 4 + e] = (int)vt[e]; } }
                tk_merge_top(a, t);
#pragma unroll
                for (int e4 = 0; e4 < 4; ++e4) { const v4u vb = *(LAS v4u*)(Lr + 32 + e4 * 4), vt = *(LAS v4u*)(Lr + 48 + e4 * 4);
#pragma unroll
                    for (int e = 0; e < 4; ++e) { b[e4 * 4 + e] = (int)vb[e]; t[e4 * 4 + e] = (int)vt[e]; } }
                tk_merge_top(b, t);
                const int trow = u.pm * 256 + ai * 128 + tid;
                const f32x4 q0 = *(const f32x4*)(rss + (size_t)trow * 16), q1 = *(const f32x4*)(rss + (size_t)trow * 16 + 4), q2 = *(const f32x4*)(rss + (size_t)trow * 16 + 8), q3 = *(const f32x4*)(rss + (size_t)trow * 16 + 12);
                const float ssq = (((q0.x + q0.y) + (q0.z + q0.w)) + ((q1.x + q1.y) + (q1.z + q1.w))) + (((q2.x + q2.y) + (q2.z + q2.w)) + ((q3.x + q3.y) + (q3.z + q3.w)));
                const float rstd = 1.0f / sqrtf(ssq * (1.f / D) + RMS_EPS);
                const size_t o = ((size_t)trow * 8 + u.pn) * 16;
                tk_stage2(a, b, Lr, (__attribute__((address_space(1))) int*)(seli + o), (__attribute__((address_space(1))) float*)(selg + o), rstd);
            }
            BLOCK_BAR();
        }
    }
};
struct OneUnit {
    pg8::Unit u;
    __device__ __forceinline__ bool next(int i, pg8::Unit& o) const { if (i != 0) return false; o = u; return true; }
    __device__ __forceinline__ void a_ready(const pg8::Unit&) const {}
    __device__ __forceinline__ void done(const pg8::Unit&) const {}
};

__device__ __forceinline__ void p0_transpose_item(const float* W, int ldw, int ncols, bf16* WT, float scale, LAS float* scr, int item, int lane) {
    const int nblk = ncols / 64, kb = item / nblk, nb = item % nblk, k0 = 64 * kb, n0 = 64 * nb;
    f32x4 v[16];
#pragma unroll
    for (int i = 0; i < 16; ++i) v[i] = __builtin_nontemporal_load((const f32x4*)(W + (size_t)(k0 + 4 * i + (lane >> 4)) * ldw + n0 + 4 * (lane & 15)));
#pragma unroll
    for (int i = 0; i < 16; ++i) { LAS float* p = scr + (4 * i + (lane >> 4)) * 65 + 4 * (lane & 15); p[0] = v[i].x * scale; p[1] = v[i].y * scale; p[2] = v[i].z * scale; p[3] = v[i].w * scale; }
    LDS_WAIT(); asm volatile("" ::: "memory");
    const int c = lane & 7;
#pragma unroll
    for (int j = 0; j < 8; ++j) { const int n = (lane >> 3) + 8 * j; const LAS float* s = scr + (8 * c) * 65 + n;
        v4u o; o.x = pk2(s[0 * 65], s[1 * 65]); o.y = pk2(s[2 * 65], s[3 * 65]); o.z = pk2(s[4 * 65], s[5 * 65]); o.w = pk2(s[6 * 65], s[7 * 65]);
        *(v4u*)(WT + (size_t)(n0 + n) * 1024 + k0 + 8 * c) = o; }
    LDS_WAIT(); asm volatile("" ::: "memory");
}
__device__ __forceinline__ void rms_row_to_bf16(const float* xrow, const float* gain, bf16* orow, float* hcopy, int lane) {
    const f32x4* xr = (const f32x4*)xrow + lane; const f32x4* gr = (const f32x4*)gain + lane;
    f32x4 v[4]; float s = 0.f;
#pragma unroll
    for (int j = 0; j < 4; ++j) { v[j] = xr[64 * j]; s += (v[j].x * v[j].x + v[j].y * v[j].y) + (v[j].z * v[j].z + v[j].w * v[j].w); }
    if (hcopy) {
#pragma unroll
        for (int j = 0; j < 4; ++j) ((f32x4*)hcopy + lane)[64 * j] = v[j];
    }
    const float rstd = 1.0f / sqrtf(wave_sum(s) * (1.f / D) + RMS_EPS);
    unsigned long long* o8 = (unsigned long long*)orow + lane;
#pragma unroll
    for (int j = 0; j < 4; ++j) { const f32x4 g = gr[64 * j]; const f32x4 y = v[j] * rstd * g;
        o8[64 * j] = (unsigned long long)pk2(y.x, y.y) | ((unsigned long long)pk2(y.z, y.w) << 32); }
}
__device__ __forceinline__ void p0_dense(Frame& F, bool dry) {
    if (!(dry && PROBE_PMODE == 1)) {
        LAS float* KL = (LAS float*)F.lds;
        LAS float* WL = (LAS float*)(F.lds + 128 * 132 * 4);
        const float* in10 = F.in(10); const float* in11 = F.in(11); const float* in2 = F.in(2);
        f32x4 kreg[8], wreg[4];
#define FOLD_LOAD(it_) do { const int l_ = (it_) >> 8, hp_ = ((it_) >> 4) & 15, k0_ = ((it_) & 15) * 64; \
            const float* kg_ = in11 + (size_t)(l_ * 16 + hp_) * 128 * 128; const float* wg_ = in10 + (size_t)l_ * 1024 * 2048 + (size_t)k0_ * 2048 + hp_ * 128; \
            _Pragma("unroll") for (int i = 0; i < 8; ++i) kreg[i] = *(const f32x4*)(kg_ + 4 * (F.tid + 512 * i)); \
            _Pragma("unroll") for (int i = 0; i < 4; ++i) { const int e = 4 * (F.tid + 512 * i); wreg[i] = __builtin_nontemporal_load((const f32x4*)(wg_ + (size_t)(e >> 7) * 2048 + (e & 127))); } } while (0)
        if (F.vcu < DEPTH * 16 * 16) FOLD_LOAD(F.vcu);
        for (int it = F.vcu; it < DEPTH * 16 * 16; it += F.G) {
            const int l = it >> 8, hp = (it >> 4) & 15, k0 = (it & 15) * 64;
#pragma unroll
            for (int i = 0; i < 8; ++i) { const int e = 4 * (F.tid + 512 * i), n = e >> 7, d = e & 127; *(LAS f32x4*)(KL + n * 132 + d) = kreg[i]; }
#pragma unroll
            for (int i = 0; i < 4; ++i) { const int e = 4 * (F.tid + 512 * i), kk = e >> 7, d = e & 127; *(LAS f32x4*)(WL + kk * 132 + d) = wreg[i]; }
            if (it + F.G < DEPTH * 16 * 16) FOLD_LOAD(it + F.G);
            BLOCK_BAR();
            {
                const int i16 = F.lane & 15, g4 = F.lane >> 4, nt = F.wave;
                f32x4 facc[4];
#pragma unroll
                for (int mt = 0; mt < 4; ++mt) facc[mt] = (f32x4){0.f, 0.f, 0.f, 0.f};
#pragma unroll 2
                for (int s8 = 0; s8 < 8; ++s8) {
                    const f32x4 bq = *(const LAS f32x4*)(KL + (nt * 16 + i16) * 132 + 16 * s8 + 4 * g4);
                    f32x4 aq[4];
#pragma unroll
                    for (int mt = 0; mt < 4; ++mt) aq[mt] = *(const LAS f32x4*)(WL + (mt * 16 + i16) * 132 + 16 * s8 + 4 * g4);
#pragma unroll
                    for (int t = 0; t < 4; ++t)
#pragma unroll
                        for (int mt = 0; mt < 4; ++mt) facc[mt] = __builtin_amdgcn_mfma_f32_16x16x4f32(aq[mt][t], bq[t], facc[mt], 0, 0, 0);
                }
                bf16* o = (bf16*)(F.ws + WS_WP) + (size_t)l * 2048 * 1024 + (size_t)(hp * 128 + nt * 16 + i16) * 1024 + k0 + 4 * g4;
#pragma unroll
                for (int mt = 0; mt < 4; ++mt) { const f32x4 gf = *(const f32x4*)(in2 + (size_t)l * D + k0 + mt * 16 + 4 * g4); v2u w; w.x = pk2(facc[mt][0] * gf.x, facc[mt][1] * gf.y); w.y = pk2(facc[mt][2] * gf.z, facc[mt][3] * gf.w); *(v2u*)(o + mt * 16) = w; }
            }
            BLOCK_BAR();
        }
#undef FOLD_LOAD
    }
    LAS float* scr = (LAS float*)(F.lds + F.wave * 16640);
    const int gw = F.vcu * NWAVES + F.wave, NGW = F.G * NWAVES;
    constexpr int I_SQ = 16 * 16, I_IN = 16 * 48, PER_J = 3 * I_SQ + I_SQ + I_IN + I_SQ;
    if (!(dry && PROBE_PMODE == 2)) for (int it = gw; it < 2 * PER_J; it += NGW) {
        const int j = it / PER_J; int r = it % PER_J;
        const float* wqkv = F.in(4) + (size_t)j * 1024 * 3072;
        if (r < I_SQ) { p0_transpose_item(wqkv, 3072, 1024, (bf16*)(F.ws + WS_WQK) + (size_t)j * 2048 * 1024, 0.125f, scr, r, F.lane); continue; } r -= I_SQ;
        if (r < I_SQ) { p0_transpose_item(wqkv + 1024, 3072, 1024, (bf16*)(F.ws + WS_WQK) + (size_t)j * 2048 * 1024 + (size_t)1024 * 1024, 1.f, scr, r, F.lane); continue; } r -= I_SQ;
        if (r < I_SQ) { p0_transpose_item(wqkv + 2048, 3072, 1024, (bf16*)(F.ws + WS_WV) + (size_t)j * 1024 * 1024, 1.f, scr, r, F.lane); continue; } r -= I_SQ;
        if (r < I_SQ) { p0_transpose_item(F.in(5) + (size_t)j * 1024 * 1024, 1024, 1024, (bf16*)(F.ws + WS_WO) + (size_t)j * 1024 * 1024, 1.f, scr, r, F.lane); continue; } r -= I_SQ;
        if (r < I_IN) {
            const float* win = F.in(7) + (size_t)j * 1024 * 3072; bf16* wt = (bf16*)(F.ws + WS_WIN) + (size_t)j * 3072 * 1024;
            if (r < 512) { const int blk = r >> 5, pn = blk >> 1, which = blk & 1; p0_transpose_item(win + (which ? 2048 : 1024) + 128 * pn, 3072, 128, wt + (size_t)(256 * pn + 128 * which) * 1024, 1.f, scr, r & 31, F.lane); }
            else p0_transpose_item(win, 3072, 1024, wt + (size_t)2048 * 1024, 1.f, scr, r - 512, F.lane);
            continue; } r -= I_IN;
        p0_transpose_item(F.in(9) + (size_t)j * 1024 * 1024, 1024, 1024, (bf16*)(F.ws + WS_WOUT) + (size_t)j * 1024 * 1024, 1.f, scr, r, F.lane);
    }
}
__device__ __forceinline__ void p0_tables(Frame& F, bool dry) {
    const int gw = F.vcu * NWAVES + F.wave, NGW = F.G * NWAVES;
    if (!(dry && PROBE_PMODE == 3)) {
        constexpr int NROW = DEPTH * 16384;
        const float* in12 = F.in(12); const float* in13 = F.in(13);
#define XC_LOAD(v, r0_) do { const int tb_ = (r0_) >= NROW ? 1 : 0, rr_ = (r0_) - tb_ * NROW; const float* src_ = (tb_ ? in13 : in12) + (size_t)rr_ * 1024 + 4 * F.lane; \
            _Pragma("unroll") for (int u = 0; u < 4; ++u) _Pragma("unroll") for (int i = 0; i < 4; ++i) v[u][i] = __builtin_nontemporal_load((const f32x4*)(src_ + (size_t)u * 1024 + 256 * i)); } while (0)
#if EXPERT_FP4
#define XC_PACK(v, u, q, dstp) do { v2u w_; _Pragma("unroll") for (int jj = 0; jj < 2; ++jj) { unsigned t_ = 0u; \
                    t_ = __builtin_amdgcn_cvt_scalef32_pk_fp4_f32(t_, v[u][2 * jj].x * q, v[u][2 * jj].y * q, 1.0f, 0); t_ = __builtin_amdgcn_cvt_scalef32_pk_fp4_f32(t_, v[u][2 * jj].z * q, v[u][2 * jj].w * q, 1.0f, 1); \
                    t_ = __builtin_amdgcn_cvt_scalef32_pk_fp4_f32(t_, v[u][2 * jj + 1].x * q, v[u][2 * jj + 1].y * q, 1.0f, 2); t_ = __builtin_amdgcn_cvt_scalef32_pk_fp4_f32(t_, v[u][2 * jj + 1].z * q, v[u][2 * jj + 1].w * q, 1.0f, 3); w_[jj] = t_; } \
                *(v2u*)(dstp) = w_; } while (0)
        constexpr float QMAX = 6.0f;
#else
#define XC_PACK(v, u, q, dstp) do { v4u w_; _Pragma("unroll") for (int i = 0; i < 4; ++i) { unsigned t_ = 0u; t_ = __builtin_amdgcn_cvt_pk_fp8_f32(v[u][i].x * q, v[u][i].y * q, t_, false); t_ = __builtin_amdgcn_cvt_pk_fp8_f32(v[u][i].z * q, v[u][i].w * q, t_, true); w_[i] = t_; } \
                *(v4u*)(dstp) = w_; } while (0)
        constexpr float QMAX = 256.0f;
#endif
#define XC_I4(x_) ((unsigned)__float2int_rn(x_) & 15u)
#define XC_PACK_I4(v, u, q, dstp) do { v2u w_; _Pragma("unroll") for (int jj = 0; jj < 2; ++jj) { const f32x4 a_ = v[u][2 * jj] * q, b_ = v[u][2 * jj + 1] * q; \
                    w_[jj] = XC_I4(a_.x) | (XC_I4(a_.y) << 4) | (XC_I4(a_.z) << 8) | (XC_I4(a_.w) << 12) | (XC_I4(b_.x) << 16) | (XC_I4(b_.y) << 20) | (XC_I4(b_.z) << 24) | (XC_I4(b_.w) << 28); } \
                *(v2u*)(dstp) = w_; } while (0)
#define XC_CONV(v, r0_) do { const int tb_ = (r0_) >= NROW ? 1 : 0, rr_ = (r0_) - tb_ * NROW; \
            unsigned char* dst_ = F.ws + (tb_ ? WS_DN : WS_UP) + (size_t)rr_ * ROWB + (ROWB / 64) * F.lane; float* sc_ = (float*)(F.ws + WS_SUP) + 2 * (size_t)rr_ + tb_; \
            _Pragma("unroll") for (int u = 0; u < 4; ++u) { float mx = 0.f; \
                _Pragma("unroll") for (int i = 0; i < 4; ++i) mx = fmaxf(fmaxf(mx, fmaxf(fabsf(v[u][i].x), fabsf(v[u][i].y))), fmaxf(fabsf(v[u][i].z), fabsf(v[u][i].w))); \
                _Pragma("unroll") for (int o = 1; o < 64; o <<= 1) mx = fmaxf(mx, __shfl_xor(mx, o)); \
                if (tb_) { const float q = mx > 0.f ? 7.0f / mx : 1.0f; XC_PACK_I4(v, u, q, dst_ + (size_t)u * ROWB); if (F.lane == 0) sc_[2 * u] = mx > 0.f ? mx * (1.0f / 7.0f) : 1.0f; } \
                else { const float q = mx > 0.f ? QMAX / mx : 1.0f; XC_PACK(v, u, q, dst_ + (size_t)u * ROWB); if (F.lane == 0) sc_[2 * u] = mx > 0.f ? mx * (1.0f / QMAX) : 1.0f; } } } while (0)
        const int stepr = NGW * 4;
        f32x4 va[4][4], vb[4][4];
        int r0 = gw * 4;
        if (r0 < 2 * NROW) XC_LOAD(va, r0);
#pragma unroll 1
        for (; r0 < 2 * NROW; r0 += 2 * stepr) {
            if (r0 + stepr < 2 * NROW) XC_LOAD(vb, r0 + stepr);
            XC_CONV(va, r0);
            if (r0 + 2 * stepr < 2 * NROW) XC_LOAD(va, r0 + 2 * stepr);
            if (r0 + stepr < 2 * NROW) XC_CONV(vb, r0 + stepr);
        }
#undef XC_LOAD
#undef XC_PACK
#undef XC_PACK_I4
#undef XC_I4
#undef XC_CONV
    }
}
__device__ __forceinline__ void p0_prologue(Frame& F, bool dry) {
    if (((int)blockIdx.x >> 3) & 1) { p0_tables(F, dry); p0_dense(F, dry); } else { p0_dense(F, dry); p0_tables(F, dry); }
    const int gw = F.vcu * NWAVES + F.wave, NGW = F.G * NWAVES;
    if (!(dry && PROBE_PMODE == 4)) {
        const float* x0 = F.in(0); const f32x4* gr = (const f32x4*)F.in(1) + F.lane;
        f32x4 gq[4];
#pragma unroll
        for (int j = 0; j < 4; ++j) gq[j] = gr[64 * j];
#pragma unroll 1
        for (int m0 = gw; m0 < M; m0 += 4 * NGW) {
            f32x4 v[4][4];
#pragma unroll
            for (int u = 0; u < 4; ++u) { const int m = m0 + u * NGW; if (m < M) {
#pragma unroll
                for (int j = 0; j < 4; ++j) v[u][j] = __builtin_nontemporal_load((const f32x4*)(x0 + (size_t)m * D) + F.lane + 64 * j); } }
#pragma unroll
            for (int u = 0; u < 4; ++u) { const int m = m0 + u * NGW; if (m < M) {
                float sq = 0.f;
#pragma unroll
                for (int j = 0; j < 4; ++j) { sq += (v[u][j].x * v[u][j].x + v[u][j].y * v[u][j].y) + (v[u][j].z * v[u][j].z + v[u][j].w * v[u][j].w); }
                const float rstd = 1.0f / sqrtf(wave_sum(sq) * (1.f / D) + RMS_EPS);
                unsigned long long* o8 = (unsigned long long*)((bf16*)(F.ws + WS_HN) + (size_t)m * D) + F.lane;
#pragma unroll
                for (int j = 0; j < 4; ++j) { const f32x4 y = v[u][j] * rstd * gq[j]; o8[64 * j] = (unsigned long long)pk2(y.x, y.y) | ((unsigned long long)pk2(y.z, y.w) << 32); } } }
        }
    }
}

__device__ __forceinline__ void conv_phase(Frame& F, int j) {
    const bf16* U = (const bf16*)(F.ws + WS_BIG); const bf16* GB = (const bf16*)(F.ws + WS_BIG + 32 * MiB); bf16* mix = (bf16*)(F.ws + WS_MIX);
    const float* wc = F.in(8) + (size_t)j * 3 * 1024;
    for (int idx = F.vcu * NTHR + F.tid; idx < M * 128; idx += F.G * NTHR) {
        const int t = idx >> 7, c8 = (idx & 127) * 8, s = t & (SEQ - 1);
        const v4u gb = *(const v4u*)(GB + (size_t)t * D + c8);
        float conv[8];
#pragma unroll
        for (int e = 0; e < 8; ++e) conv[e] = 0.f;
#pragma unroll
        for (int dj = -1; dj <= 1; ++dj) {
            if (s + dj >= 0 && s + dj < SEQ) {
                const v4u uu = *(const v4u*)(U + (size_t)(t + dj) * D + c8);
                const f32x4 w0 = *(const f32x4*)(wc + (dj + 1) * 1024 + c8), w1 = *(const f32x4*)(wc + (dj + 1) * 1024 + c8 + 4);
#pragma unroll
                for (int e2 = 0; e2 < 4; ++e2) {
                    const float wl = e2 < 2 ? w0[2 * e2] : w1[2 * e2 - 4], wh = e2 < 2 ? w0[2 * e2 + 1] : w1[2 * e2 - 3];
                    conv[2 * e2] += wl * bflo(uu[e2]); conv[2 * e2 + 1] += wh * bfhi(uu[e2]);
                }
            }
        }
        v4u o;
#pragma unroll
        for (int e2 = 0; e2 < 4; ++e2) o[e2] = pk2(bflo(gb[e2]) * conv[2 * e2], bfhi(gb[e2]) * conv[2 * e2 + 1]);
        *(v4u*)(mix + (size_t)t * 1024 + c8) = o;
    }
}

constexpr int AT_KSTR = 144, AT_VSTR = 1168, AT_KOFF = 0, AT_VOFF = 576 * AT_KSTR, AT_BOFF = AT_VOFF + 64 * AT_VSTR;
static_assert(AT_BOFF + 1860 <= PTAB_OFF, "attention LDS map");
__device__ __forceinline__ void attn_phase(Frame& F, int j) {
    const bf16* QK = (const bf16*)(F.ws + WS_BIG); const bf16* VT = (const bf16*)(F.ws + WS_VT); bf16* mix = (bf16*)(F.ws + WS_MIX);
    const float* biasl = F.in(6) + (size_t)j * NH * 15 * 31;
    const int lane = F.lane, q = lane & 15, g = lane >> 4, tid = F.tid;
    LAS unsigned char* KL = F.lds + AT_KOFF; LAS unsigned char* VL = F.lds + AT_VOFF; LAS float* btab = (LAS float*)(F.lds + AT_BOFF);
    v4u kreg[9], vreg[9];
    int cur_hh = -1;
#define AT_DECODE(it, b_, hh_, r0_, R0_) const int hh_ = (it) & 15, rp_##it = ((it) >> 4) & 63, b_ = (it) >> 10, r0_ = 2 * rp_##it; int R0_ = r0_ - 4; R0_ = R0_ < 0 ? 0 : (R0_ > NROWS - 8 ? NROWS - 8 : R0_);
#define AT_PREFETCH(it) do { AT_DECODE(it, pb, phh, pr0, pR0) \
        _Pragma("unroll") for (int i = 0; i < 9; ++i) { const int c = tid + 512 * i; \
            { const int key = c >> 3, ch = c & 7; int row = pR0 + (key >> 6); row = row > NROWS - 1 ? NROWS - 1 : row; \
              kreg[i] = *(const v4u*)(QK + ((size_t)pb * SEQ + row * 64 + (key & 63)) * 2048 + 1024 + phh * 64 + ch * 8); } \
            { const int d = c / 72, kch = c - d * 72; vreg[i] = *(const v4u*)(VT + (size_t)(phh * 64 + d) * M + (size_t)pb * SEQ + pR0 * 64 + kch * 8); } } } while (0)
    int it = F.vcu;
    if (it < 2048) AT_PREFETCH(it);
    for (; it < 2048; it += F.G) {
        AT_DECODE(it, b, hh, r0, R0)
        BLOCK_BAR();
#pragma unroll
        for (int i = 0; i < 9; ++i) { const int c = tid + 512 * i;
            *(LAS v4u*)(KL + (c >> 3) * AT_KSTR + (c & 7) * 16) = kreg[i];
            const int d = c / 72, kch = c - d * 72; *(LAS v4u*)(VL + d * AT_VSTR + kch * 16) = vreg[i]; }
        if (hh != cur_hh) { if (tid < 465) btab[tid] = biasl[(size_t)hh * 465 + tid]; cur_hh = hh; }
        BLOCK_BAR();
        const int r = r0 + (F.wave >> 2), jb = F.wave & 3;
        int rs = r - 4; rs = rs < 0 ? 0 : (rs > NROWS - 8 ? NROWS - 8 : rs);
        const int lr0 = rs - R0;
        int bs = 16 * jb - 8; bs = bs < 0 ? 0 : (bs > 32 ? 32 : bs);
        const int qc = 16 * jb + q; int wst = qc - 8; wst = wst < 0 ? 0 : (wst > 48 ? 48 : wst);
        const size_t tokq = (size_t)b * SEQ + r * 64 + qc;
        bf16x8 qf[2];
#pragma unroll
        for (int ks = 0; ks < 2; ++ks) qf[ks] = *(const bf16x8*)(QK + tokq * 2048 + hh * 64 + ks * 32 + 8 * g);
        f32x4 S[8][2];
        const int kcl_a = 8 * (q >> 2) + (q & 3);
#pragma unroll
        for (int wr = 0; wr < 8; ++wr)
#pragma unroll
            for (int T = 0; T < 2; ++T) {
                const LAS unsigned char* kp = KL + ((lr0 + wr) * 64 + bs + kcl_a + 4 * T) * AT_KSTR + 16 * g;
                const bf16x8 k0 = *(const LAS bf16x8*)kp, k1 = *(const LAS bf16x8*)(kp + 64);
                f32x4 c = (f32x4){0.f, 0.f, 0.f, 0.f};
                c = __builtin_amdgcn_mfma_f32_16x16x32_bf16(k0, qf[0], c, 0, 0, 0);
                c = __builtin_amdgcn_mfma_f32_16x16x32_bf16(k1, qf[1], c, 0, 0, 0);
                S[wr][T] = c;
            }
        float mx = -3.0e38f;
#pragma unroll
        for (int wr = 0; wr < 8; ++wr) {
            const LAS float* brow = btab + (rs + wr - r + 7) * 31;
#pragma unroll
            for (int T = 0; T < 2; ++T)
#pragma unroll
                for (int i = 0; i < 4; ++i) {
                    const int kc = bs + 8 * g + 4 * T + i;
                    int co = kc - qc + 15; co = co < 0 ? 0 : (co > 30 ? 30 : co);
                    const bool valid = (kc >= wst) && (kc < wst + 16);
                    const float v = valid ? S[wr][T][i] + brow[co] : -1e30f;
                    S[wr][T][i] = v; mx = fmaxf(mx, v);
                }
        }
        mx = fmaxf(mx, __shfl_xor(mx, 16)); mx = fmaxf(mx, __shfl_xor(mx, 32));
        float sum = 0.f;
        bf16x8 pf[8];
#pragma unroll
        for (int wr = 0; wr < 8; ++wr) {
            float p[8];
#pragma unroll
            for (int T = 0; T < 2; ++T)
#pragma unroll
                for (int i = 0; i < 4; ++i) { p[4 * T + i] = __expf(S[wr][T][i] - mx); sum += p[4 * T + i]; }
            v4u w; w.x = pk2(p[0], p[1]); w.y = pk2(p[2], p[3]); w.z = pk2(p[4], p[5]); w.w = pk2(p[6], p[7]);
            pf[wr] = __builtin_bit_cast(bf16x8, w);
        }
        sum += __shfl_xor(sum, 16); sum += __shfl_xor(sum, 32);
        if (it + F.G < 2048) { const int nit = it + F.G; AT_PREFETCH(nit); }
        f32x4 O[4];
#pragma unroll
        for (int dt = 0; dt < 4; ++dt) O[dt] = (f32x4){0.f, 0.f, 0.f, 0.f};
#pragma unroll
        for (int wr = 0; wr < 8; ++wr)
#pragma unroll
            for (int dt = 0; dt < 4; ++dt) {
                const bf16x8 vf = *(const LAS bf16x8*)(VL + (dt * 16 + q) * AT_VSTR + ((lr0 + wr) * 64 + bs + 8 * g) * 2);
                O[dt] = __builtin_amdgcn_mfma_f32_16x16x32_bf16(vf, pf[wr], O[dt], 0, 0, 0);
            }
        const float inv = 1.0f / sum;
#pragma unroll
        for (int dt = 0; dt < 4; ++dt) { v2u w; w.x = pk2(O[dt][0] * inv, O[dt][1] * inv); w.y = pk2(O[dt][2] * inv, O[dt][3] * inv);
            *(v2u*)(mix + tokq * 1024 + hh * 64 + dt * 16 + 4 * g) = w; }
    }
#undef AT_DECODE
#undef AT_PREFETCH
    BLOCK_BAR();
}
#if NAIVE_ATTN
__device__ __forceinline__ void attn_naive_phase(Frame& F, int j) {
    const bf16* QK = (const bf16*)(F.ws + WS_BIG); const bf16* VT = (const bf16*)(F.ws + WS_VT); bf16* mix = (bf16*)(F.ws + WS_MIX);
    const float* biasl = F.in(6) + (size_t)j * NH * 15 * 31;
    for (int idx = F.vcu * NTHR + F.tid; idx < M * NH; idx += F.G * NTHR) {
        const int hh = idx & 15, t = idx >> 4, b = t >> 13, s = t & (SEQ - 1), r = s >> 6, qc = s & 63;
        int rs = r - 4; rs = rs < 0 ? 0 : (rs > NROWS - 8 ? NROWS - 8 : rs);
        int wst = qc - 8; wst = wst < 0 ? 0 : (wst > 48 ? 48 : wst);
        float qv[64];
#pragma unroll
        for (int c = 0; c < 8; ++c) { const v4u w = *(const v4u*)(QK + (size_t)t * 2048 + hh * 64 + c * 8);
#pragma unroll
            for (int e = 0; e < 4; ++e) { qv[c * 8 + 2 * e] = bflo(w[e]); qv[c * 8 + 2 * e + 1] = bfhi(w[e]); } }
        float mrun = -3.0e38f, lrun = 0.f, o[64];
#pragma unroll
        for (int d = 0; d < 64; ++d) o[d] = 0.f;
        for (int wr = 0; wr < 8; ++wr)
            for (int kk = 0; kk < 16; ++kk) {
                const int kc = wst + kk; const size_t tk = (size_t)b * SEQ + (rs + wr) * 64 + kc;
                float sd = 0.f;
#pragma unroll
                for (int c = 0; c < 8; ++c) { const v4u w = *(const v4u*)(QK + tk * 2048 + 1024 + hh * 64 + c * 8);
#pragma unroll
                    for (int e = 0; e < 4; ++e) sd += qv[c * 8 + 2 * e] * bflo(w[e]) + qv[c * 8 + 2 * e + 1] * bfhi(w[e]); }
                int co = kc - qc + 15; co = co < 0 ? 0 : (co > 30 ? 30 : co);
                sd += biasl[(size_t)hh * 465 + (rs + wr - r + 7) * 31 + co];
                const float mn = fmaxf(mrun, sd), al = __expf(mrun - mn), p = __expf(sd - mn);
                lrun = lrun * al + p; mrun = mn;
#pragma unroll
                for (int d = 0; d < 64; ++d) o[d] = o[d] * al + p * bflo((unsigned)VT[(size_t)(hh * 64 + d) * M + tk]);
            }
        const float inv = 1.0f / lrun;
#pragma unroll
        for (int c = 0; c < 8; ++c) { v4u w;
#pragma unroll
            for (int e = 0; e < 4; ++e) w[e] = pk2(o[c * 8 + 2 * e] * inv, o[c * 8 + 2 * e + 1] * inv);
            *(v4u*)(mix + (size_t)t * 1024 + hh * 64 + c * 8) = w; }
    }
}
#endif
#if NAIVE_TOPK
__device__ __forceinline__ void select_naive_phase(Frame& F) {
    const float* SC = (const float*)(F.ws + WS_SC); int* seli = (int*)(F.ws + WS_SELI); float* selg = (float*)(F.ws + WS_SELG);
    LAS int* AB = (LAS int*)F.lds + F.tid * 33;
    for (int idx = F.vcu * NTHR + F.tid; idx < M * 8; idx += F.G * NTHR) {
        const float* s = SC + (size_t)idx * 256;
        int a[16], b[16], t[16];
        tk_stage1<4>(s, 0, a); tk_stage1<4>(s + 64, 64, t); tk_merge_top(a, t);
        tk_stage1<4>(s + 128, 0, b); tk_stage1<4>(s + 192, 64, t); tk_merge_top(b, t);
        tk_stage2(a, b, AB, seli + (size_t)idx * 16, selg + (size_t)idx * 16);
    }
}
#endif

__device__ __forceinline__ float gelu_erf(float a) { return 0.5f * a * (1.0f + erff(a * 0.70710678118654752f)); }
typedef float f32x2g __attribute__((ext_vector_type(2)));
#if EXPERT_FP4
typedef v2u rowv;
__device__ __forceinline__ rowv row_load(const unsigned char* T, int e, int lane) { return *(const v2u*)(T + (size_t)e * ROWB + 8 * lane); }
#define ROW_PAIR(r, m) __builtin_amdgcn_cvt_scalef32_pk_f32_fp4((r)[(m) >> 2], 1.0f, (m) & 3)
#else
typedef v4u rowv;
__device__ __forceinline__ rowv row_load(const unsigned char* T, int e, int lane) { return *(const v4u*)(T + (size_t)e * ROWB + 16 * lane); }
#define ROW_PAIR(r, m) __builtin_amdgcn_cvt_pk_f32_fp8((r)[(m) >> 1], ((m) & 1) != 0)
#endif
__device__ __forceinline__ void row_axpy(f32x2g (&out)[8], const rowv d, float ak) {
    const f32x2g a2 = (f32x2g){ak, ak};
    out[0] = __builtin_elementwise_fma(a2, ROW_PAIR(d, 0), out[0]); out[1] = __builtin_elementwise_fma(a2, ROW_PAIR(d, 1), out[1]); out[2] = __builtin_elementwise_fma(a2, ROW_PAIR(d, 2), out[2]); out[3] = __builtin_elementwise_fma(a2, ROW_PAIR(d, 3), out[3]);
    out[4] = __builtin_elementwise_fma(a2, ROW_PAIR(d, 4), out[4]); out[5] = __builtin_elementwise_fma(a2, ROW_PAIR(d, 5), out[5]); out[6] = __builtin_elementwise_fma(a2, ROW_PAIR(d, 6), out[6]); out[7] = __builtin_elementwise_fma(a2, ROW_PAIR(d, 7), out[7]);
}
typedef int v8i_g __attribute__((ext_vector_type(8)));
typedef unsigned char u8x4g __attribute__((ext_vector_type(4)));
#define TR_SHUF(a, b, i0, i1, i2, i3) __builtin_amdgcn_perm((unsigned)(b), (unsigned)(a), (unsigned)((i0) | ((i1) << 8) | ((i2) << 16) | ((i3) << 24)))
__device__ __forceinline__ void tr8_nib(const unsigned (&w)[8], unsigned (&t)[8]) {
    unsigned x[8], y[8];
#pragma unroll
    for (int r = 0; r < 4; ++r) { x[r] = TR_SHUF(w[r], w[r + 4], 0, 1, 4, 5); x[r + 4] = TR_SHUF(w[r], w[r + 4], 2, 3, 6, 7); }
#pragma unroll
    for (int g = 0; g < 2; ++g)
#pragma unroll
        for (int r = 0; r < 2; ++r) { y[4 * g + r] = TR_SHUF(x[4 * g + r], x[4 * g + r + 2], 0, 4, 2, 6); y[4 * g + r + 2] = TR_SHUF(x[4 * g + r], x[4 * g + r + 2], 1, 5, 3, 7); }
#pragma unroll
    for (int p = 0; p < 4; ++p) { const unsigned e = y[2 * p], o = y[2 * p + 1];
        t[2 * p] = (e & 0x0F0F0F0Fu) | ((o << 4) & 0xF0F0F0F0u);
        t[2 * p + 1] = ((e >> 4) & 0x0F0F0F0Fu) | (o & 0xF0F0F0F0u); }
}
__device__ __forceinline__ int sel2(bool hf, int e0, int e1) { return hf ? e1 : e0; }
__device__ __forceinline__ void gather_phase(Frame& F, int layer, bool dry) {
    const unsigned char* UP = F.ws + WS_UP + (size_t)layer * 16384 * ROWB; const unsigned char* DN = F.ws + WS_DN + (size_t)layer * 16384 * ROWB;
    const f32x2g* SC2 = (const f32x2g*)(F.ws + WS_SUP) + (size_t)layer * 16384;
    const float* gain = F.in(2) + (size_t)layer * D; const float* gnext = layer < DEPTH - 1 ? F.in(1) + (size_t)(layer + 1) * D : F.in(3);
    float* outp = F.out();
    const int* seli = (const int*)(F.ws + WS_SELI); const float* selg = (const float*)(F.ws + WS_SELG);
    const bf16* H = (const bf16*)(F.ws + WS_H); bf16* HN = (bf16*)(F.ws + (dry ? WS_SC + 64 * MiB : WS_HN)); bf16* HW = (bf16*)(F.ws + (dry ? WS_SC : WS_H)); if (dry) outp = (float*)(F.ws + WS_SC);
    const int lane = F.lane, gw = F.vcu * NWAVES + F.wave, NGW = F.G * NWAVES;
    const bool b5 = lane & 32, b4 = lane & 16, b3 = lane & 8, b2 = lane & 4;
    constexpr int G_RS = 528, G_RB = 32 * G_RS, G_NSLOT = 4;
    LAS unsigned char* RB = F.lds + F.wave * G_RB;
    LAS float* ACT = (LAS float*)(F.lds + 8 * G_RB + F.wave * 512);
    LAS int* SELB = (LAS int*)(F.lds + 8 * G_RB + 8 * 512 + 8 * 1024 + F.wave * 512);
    static_assert(8 * G_RB + 8 * 512 + 8 * 1024 + 8 * 512 <= PTAB_OFF, "gather LDS map");
#pragma unroll 1
    for (int base = gw; base < M; base += G_NSLOT * NGW) {
    LAS unsigned char* X8 = F.lds + 8 * G_RB + 8 * 512 + F.wave * 1024;
    const int n16 = lane & 15, g4 = lane >> 4;
    const bool hf = lane >> 5; const int c32 = lane & 31, sg = 2 * c32 + (hf ? 1 : 0);
    v2u nhb[4]; int nidx_lo = 0, nidx_hi = 0; float ng_lo = 0.f, ng_hi = 0.f;
#define TOK_LOAD(t_) do { const bf16* hr_ = H + (size_t)(t_) * D + 4 * sg; _Pragma("unroll") for (int i = 0; i < 4; ++i) nhb[i] = __builtin_nontemporal_load((const v2u*)(hr_ + 256 * i)); \
        nidx_lo = __builtin_nontemporal_load(seli + (size_t)(t_) * 128 + lane); nidx_hi = __builtin_nontemporal_load(seli + (size_t)(t_) * 128 + 64 + lane); ng_lo = __builtin_nontemporal_load(selg + (size_t)(t_) * 128 + lane); ng_hi = __builtin_nontemporal_load(selg + (size_t)(t_) * 128 + 64 + lane); } while (0)
    if (base < M) TOK_LOAD(base);
#pragma unroll 1
    for (int slot = 0; slot < G_NSLOT; ++slot) {
        const int t = base + slot * NGW; if (t >= M) break;
        f32x4 hv[4];
#pragma unroll
        for (int i = 0; i < 4; ++i) { const unsigned w0_ = nhb[i].x, w1_ = nhb[i].y; hv[i] = (f32x4){bflo(w0_), bfhi(w0_), bflo(w1_), bfhi(w1_)}; }
        const int idx_lo = nidx_lo, idx_hi = nidx_hi; const float g_lo = ng_lo, g_hi = ng_hi;
        if (slot + 1 < G_NSLOT && t + NGW < M) TOK_LOAD(t + NGW);
        float ss = 0.f;
#pragma unroll
        for (int i = 0; i < 4; ++i) ss += (hv[i].x * hv[i].x + hv[i].y * hv[i].y) + (hv[i].z * hv[i].z + hv[i].w * hv[i].w);
        const float rstd = 1.0f / sqrtf(wave_sum(ss) * (1.f / D) + RMS_EPS);
        float xmax = 0.f;
        f32x4 xv[4];
#pragma unroll
        for (int i = 0; i < 4; ++i) { const f32x4 g = *(const f32x4*)(gain + 256 * i + 4 * sg); xv[i] = hv[i] * rstd * g;
            xmax = fmaxf(fmaxf(xmax, fmaxf(fabsf(xv[i].x), fabsf(xv[i].y))), fmaxf(fabsf(xv[i].z), fabsf(xv[i].w))); }
#pragma unroll
        for (int o = 1; o < 64; o <<= 1) xmax = fmaxf(xmax, __shfl_xor(xmax, o));
        const float qx = xmax > 0.f ? 256.0f / xmax : 1.0f, xinv = xmax > 0.f ? xmax * (1.0f / 256.0f) : 1.0f;
        {
            v4u w;
#pragma unroll
            for (int i = 0; i < 4; ++i) { unsigned tt = 0u; tt = __builtin_amdgcn_cvt_pk_fp8_f32(xv[i].x * qx, xv[i].y * qx, tt, false); tt = __builtin_amdgcn_cvt_pk_fp8_f32(xv[i].z * qx, xv[i].w * qx, tt, true); w[i] = tt; }
            *(LAS v4u*)(X8 + 16 * sg) = w;
            SELB[(lane & 1) * 64 + (lane >> 1)] = idx_lo; SELB[(lane & 1) * 64 + 32 + (lane >> 1)] = idx_hi;
        }
        LDS_WAIT(); asm volatile("" ::: "memory");
#define UP_LOAD(buf, hq) do { const LAS v4u* ip_ = (const LAS v4u*)(SELB + (hf ? 64 : 0) + 16 * (hq)); v4u i4_[4]; _Pragma("unroll") for (int k = 0; k < 4; ++k) i4_[k] = ip_[k]; \
        _Pragma("unroll") for (int k = 0; k < 16; ++k) buf[k] = *(const v4u*)(UP + (unsigned)(i4_[k >> 2][k & 3] * ROWB + 16 * c32)); } while (0)
#define DN_LOAD(buf, hb) do { const LAS v4u* ip_ = (const LAS v4u*)(SELB + (hf ? 64 : 0) + 8 * (hb)); v4u i4_[2]; i4_[0] = ip_[0]; i4_[1] = ip_[1]; \
        _Pragma("unroll") for (int k = 0; k < 8; ++k) buf[k] = *(const v4u*)(DN + (unsigned)(i4_[k >> 2][k & 3] * ROWB + 16 * c32)); } while (0)
        v4u da[8];
        {
            v4u ur[16];
            UP_LOAD(ur, 0);
#define UP_NEXT UP_LOAD(ur, hq + 1)
#pragma unroll 1
            for (int hq = 0; hq < 3; ++hq) {
                const int sel = hq < 2 ? idx_lo : idx_hi; const float gsel = hq < 2 ? g_lo : g_hi; const int lb0 = (hq & 1) * 32;
#pragma unroll
                for (int k = 0; k < 16; ++k) *(LAS v4u*)(RB + (2 * k + (hf ? 1 : 0)) * G_RS + 16 * c32) = ur[k];
                float sc[4];
#pragma unroll
                for (int hh_ = 0; hh_ < 2; ++hh_) { const int ek_ = __shfl(sel, lb0 + hh_ * 16 + 4 * g4 + (n16 & 3)); const f32x2g s2_ = SC2[ek_]; sc[2 * hh_] = s2_.x; sc[2 * hh_ + 1] = s2_.y; }
                LDS_WAIT(); asm volatile("" ::: "memory");
                UP_NEXT;
                f32x4 cc[2]; cc[0] = (f32x4){0.f, 0.f, 0.f, 0.f}; cc[1] = cc[0];
#pragma unroll
                for (int s8 = 0; s8 < 8; ++s8) { const v4u b0 = *(const LAS v4u*)(X8 + 128 * s8 + 16 * g4), b1 = *(const LAS v4u*)(X8 + 128 * s8 + 64 + 16 * g4);
                    const v8i_g bq = (v8i_g){(int)b0.x, (int)b0.y, (int)b0.z, (int)b0.w, (int)b1.x, (int)b1.y, (int)b1.z, (int)b1.w};
#pragma unroll
                    for (int hh_ = 0; hh_ < 2; ++hh_) { const v4u a4 = *(const LAS v4u*)(RB + (hh_ * 16 + n16) * G_RS + 64 * s8 + 16 * g4); const v8i_g a8 = (v8i_g){(int)a4.x, (int)a4.y, (int)a4.z, (int)a4.w, 0, 0, 0, 0};
                        cc[hh_] = __builtin_amdgcn_mfma_scale_f32_16x16x128_f8f6f4(a8, bq, cc[hh_], 4, 0, 0, 0x7f7f7f7f, 0, 0x7f7f7f7f); } }
#pragma unroll
                for (int hh_ = 0; hh_ < 2; ++hh_) { const int lb = lb0 + hh_ * 16; const f32x4 c = cc[hh_];
                    const int r_ = n16 & 3, k_ = 4 * g4 + r_;
                    const float my = r_ == 0 ? c[0] : (r_ == 1 ? c[1] : (r_ == 2 ? c[2] : c[3]));
                    const float gate = __shfl(gsel, lb + k_);
                    const float act = gelu_erf(my * sc[2 * hh_] * xinv) * gate * sc[2 * hh_ + 1];
                    if (n16 < 4) ACT[hq * 32 + hh_ * 16 + k_] = act; }
                LDS_WAIT(); asm volatile("" ::: "memory");
            }
#undef UP_NEXT
#define UP_NEXT DN_LOAD(da, 0)
            { const int hq = 3;
                const int sel = hq < 2 ? idx_lo : idx_hi; const float gsel = hq < 2 ? g_lo : g_hi; const int lb0 = (hq & 1) * 32;
#pragma unroll
                for (int k = 0; k < 16; ++k) *(LAS v4u*)(RB + (2 * k + (hf ? 1 : 0)) * G_RS + 16 * c32) = ur[k];
                float sc[4];
#pragma unroll
                for (int hh_ = 0; hh_ < 2; ++hh_) { const int ek_ = __shfl(sel, lb0 + hh_ * 16 + 4 * g4 + (n16 & 3)); const f32x2g s2_ = SC2[ek_]; sc[2 * hh_] = s2_.x; sc[2 * hh_ + 1] = s2_.y; }
                LDS_WAIT(); asm volatile("" ::: "memory");
                UP_NEXT;
                f32x4 cc[2]; cc[0] = (f32x4){0.f, 0.f, 0.f, 0.f}; cc[1] = cc[0];
#pragma unroll
                for (int s8 = 0; s8 < 8; ++s8) { const v4u b0 = *(const LAS v4u*)(X8 + 128 * s8 + 16 * g4), b1 = *(const LAS v4u*)(X8 + 128 * s8 + 64 + 16 * g4);
                    const v8i_g bq = (v8i_g){(int)b0.x, (int)b0.y, (int)b0.z, (int)b0.w, (int)b1.x, (int)b1.y, (int)b1.z, (int)b1.w};
#pragma unroll
                    for (int hh_ = 0; hh_ < 2; ++hh_) { const v4u a4 = *(const LAS v4u*)(RB + (hh_ * 16 + n16) * G_RS + 64 * s8 + 16 * g4); const v8i_g a8 = (v8i_g){(int)a4.x, (int)a4.y, (int)a4.z, (int)a4.w, 0, 0, 0, 0};
                        cc[hh_] = __builtin_amdgcn_mfma_scale_f32_16x16x128_f8f6f4(a8, bq, cc[hh_], 4, 0, 0, 0x7f7f7f7f, 0, 0x7f7f7f7f); } }
#pragma unroll
                for (int hh_ = 0; hh_ < 2; ++hh_) { const int lb = lb0 + hh_ * 16; const f32x4 c = cc[hh_];
                    const int r_ = n16 & 3, k_ = 4 * g4 + r_;
                    const float my = r_ == 0 ? c[0] : (r_ == 1 ? c[1] : (r_ == 2 ? c[2] : c[3]));
                    const float gate = __shfl(gsel, lb + k_);
                    const float act = gelu_erf(my * sc[2 * hh_] * xinv) * gate * sc[2 * hh_ + 1];
                    if (n16 < 4) ACT[hq * 32 + hh_ * 16 + k_] = act; }
                LDS_WAIT(); asm volatile("" ::: "memory");
            }
#undef UP_NEXT
        }
#undef UP_LOAD
        LDS_WAIT(); asm volatile("" ::: "memory");
        const float a_lo = ACT[lane], a_hi = ACT[64 + lane];
        float amax = fmaxf(fabsf(a_lo), fabsf(a_hi));
#pragma unroll
        for (int o = 1; o < 64; o <<= 1) amax = fmaxf(amax, __shfl_xor(amax, o));
        const float ainv = amax > 0.f ? 119.0f / amax : 0.f, tscale = amax * (1.0f / 119.0f);
        unsigned pd[4];
        {
            const int A0 = __float2int_rn(a_lo * ainv), A1 = __float2int_rn(a_hi * ainv);
            const int h0 = (A0 + 8) >> 4, l0 = A0 - 16 * h0, h1 = (A1 + 8) >> 4, l1 = A1 - 16 * h1;
            const int sh = 4 * ((lane >> 1) & 7);
            pd[0] = ((unsigned)l0 & 15u) << sh; pd[1] = ((unsigned)h0 & 15u) << sh; pd[2] = ((unsigned)l1 & 15u) << sh; pd[3] = ((unsigned)h1 & 15u) << sh;
#pragma unroll
            for (int q = 0; q < 4; ++q) { pd[q] |= (unsigned)__shfl_xor((int)pd[q], 2); pd[q] |= (unsigned)__shfl_xor((int)pd[q], 4); pd[q] |= (unsigned)__shfl_xor((int)pd[q], 8); }
        }
        int acc0[32], acc1[32];
#pragma unroll
        for (int e = 0; e < 32; ++e) { acc0[e] = 0; acc1[e] = 0; }
#define DN_STEP(buf, hb) do { const unsigned plo_ = (hb) < 4 ? pd[0] : pd[2], phi_ = (hb) < 4 ? pd[1] : pd[3]; \
            const int alo_ = sel2(hf, __builtin_amdgcn_readlane((int)plo_, ((hb) & 3) * 16), __builtin_amdgcn_readlane((int)plo_, ((hb) & 3) * 16 + 1)), ahi_ = sel2(hf, __builtin_amdgcn_readlane((int)phi_, ((hb) & 3) * 16), __builtin_amdgcn_readlane((int)phi_, ((hb) & 3) * 16 + 1)); \
            _Pragma("unroll") for (int w = 0; w < 4; ++w) { unsigned w_[8], t_[8]; \
                _Pragma("unroll") for (int r = 0; r < 8; ++r) w_[r] = buf[r][w]; \
                tr8_nib(w_, t_); \
                _Pragma("unroll") for (int c = 0; c < 8; ++c) { acc0[8 * w + c] = __builtin_amdgcn_sdot8((int)t_[c], alo_, acc0[8 * w + c], false); acc1[8 * w + c] = __builtin_amdgcn_sdot8((int)t_[c], ahi_, acc1[8 * w + c], false); } } } while (0)
        {
            v4u db[8];
            DN_LOAD(db, 1); DN_STEP(da, 0);
            DN_LOAD(da, 2); DN_STEP(db, 1);
            DN_LOAD(db, 3); DN_STEP(da, 2);
            DN_LOAD(da, 4); DN_STEP(db, 3);
            DN_LOAD(db, 5); DN_STEP(da, 4);
            DN_LOAD(da, 6); DN_STEP(db, 5);
            DN_LOAD(db, 7); DN_STEP(da, 6);
            DN_STEP(db, 7);
        }
#undef DN_LOAD
#undef DN_STEP
        int os[16];
#pragma unroll
        for (int k = 0; k < 16; ++k) { const int lo_ = acc0[k] + (acc1[k] << 4), hi_ = acc0[16 + k] + (acc1[16 + k] << 4); os[k] = (hf ? hi_ : lo_) + __shfl_xor(hf ? lo_ : hi_, 32); }
        f32x2g out[8];
#pragma unroll
        for (int e = 0; e < 8; ++e) out[e] = (f32x2g){(float)os[2 * e] * tscale, (float)os[2 * e + 1] * tscale};
        float ss2 = 0.f;
#pragma unroll
        for (int i = 0; i < 4; ++i) { hv[i].x += out[2 * i].x; hv[i].y += out[2 * i].y; hv[i].z += out[2 * i + 1].x; hv[i].w += out[2 * i + 1].y;
            ss2 += (hv[i].x * hv[i].x + hv[i].y * hv[i].y) + (hv[i].z * hv[i].z + hv[i].w * hv[i].w); }
        const float rstd2 = 1.0f / sqrtf(wave_sum(ss2) * (1.f / D) + RMS_EPS);
        f32x4 y[4];
#pragma unroll
        for (int i = 0; i < 4; ++i) y[i] = hv[i] * rstd2 * *(const f32x4*)(gnext + 256 * i + 4 * sg);
        if (layer < DEPTH - 1) {
            bf16* hw_ = HW + (size_t)t * D + 4 * sg; bf16* hn = HN + (size_t)t * D + 4 * sg;
#pragma unroll
            for (int i = 0; i < 4; ++i) { v2u a_, b_; a_.x = pk2(hv[i].x, hv[i].y); a_.y = pk2(hv[i].z, hv[i].w); b_.x = pk2(y[i].x, y[i].y); b_.y = pk2(y[i].z, y[i].w);
                *(v2u*)(hw_ + 256 * i) = a_; *(v2u*)(hn + 256 * i) = b_; }
        } else {
            float* orow = outp + (size_t)t * D + 4 * sg;
#pragma unroll
            for (int i = 0; i < 4; ++i) *(f32x4*)(orow + 256 * i) = y[i];
        }
    }
    LDS_WAIT(); asm volatile("" ::: "memory");
    }
#undef TOK_LOAD
}

struct Args { const float* in[14]; float* out; unsigned char* ws; int ph_lo, ph_hi; };
__global__ void __launch_bounds__(NTHR, 2) mega_fwd(Args args) {
    extern __shared__ __attribute__((aligned(16))) unsigned char lds[];
    Frame F;
    F.lds = (LAS unsigned char*)lds;
    F.tid = threadIdx.x; F.lane = F.tid & 63; F.wave = __builtin_amdgcn_readfirstlane(F.tid >> 6);
    F.G = gridDim.x; { const int bx = blockIdx.x; F.vcu = (F.G % 8 == 0) ? (bx % 8) * (F.G / 8) + bx / 8 : bx; }
    F.ws = args.ws;
    volatile LAS unsigned* MISC = (volatile LAS unsigned*)(F.lds + MISC_OFF);
    if (F.tid < 64) MISC[F.tid] = 0u;
    if (F.tid < 15) { const unsigned long long p = F.tid < 14 ? (unsigned long long)args.in[F.tid] : (unsigned long long)args.out;
        volatile LAS unsigned* t = (volatile LAS unsigned*)(F.lds + PTAB_OFF); t[2 * F.tid] = (unsigned)p; t[2 * F.tid + 1] = (unsigned)(p >> 32); }
    __syncthreads();
    XcdBarrier bar; bar.bar = (unsigned*)(F.ws + WS_CTL) + CW_BAR; bar.x = 0; bar.st = nullptr;
    if (MK_N_LAUNCHES == 1) bar = xcd_barrier_post((unsigned*)(F.ws + WS_CTL) + CW_BAR, MISC + 8);

#pragma unroll 1
    for (int ph = args.ph_lo; ph < args.ph_hi; ++ph) {
        bool did = true;
        const int kind_ = ph == 0 ? 7 : (ph - 1) % PH_PER_LAYER; const int nrep = (PROBE_REP >= 0 && kind_ == PROBE_REP && (ph == 0 || ((PROBE_LMASK >> ((ph - 1) / PH_PER_LAYER)) & 1))) ? 2 : 1;
#pragma unroll 1
        for (int rep = 0; rep < nrep; ++rep) {
        const bool dry = (nrep == 2 && rep == 0);
        { int t_ = threadIdx.x; asm volatile("" : "+v"(t_)); F.tid = t_; F.lane = t_ & 63; F.wave = __builtin_amdgcn_readfirstlane(t_ >> 6);
          unsigned long long ws_ = (unsigned long long)args.ws; asm volatile("" : "+s"(ws_)); F.ws = (unsigned char*)(__attribute__((address_space(1))) unsigned char*)ws_; }
#ifndef DIS_PRO
        if (ph == 0) p0_prologue(F, dry);
#else
        if (ph == 0) {}
#endif
        else {
            const int layer = (ph - 1) / PH_PER_LAYER, k = (ph - 1) % PH_PER_LAYER, j = layer >> 1; const bool is_attn = (layer & 1) == 0;
            if (k == 0) {
                if (!is_attn) {
                    pg8::Gemm g{(const pg8::bf16_t*)(F.ws + WS_HN), (const pg8::bf16_t*)(F.ws + WS_WIN) + (size_t)j * 3072 * 1024, M, 3072, D};
                    pg8::StaticOrder S; S.init(g.M, g.N, F.G, (int)blockIdx.x);
                    EpiConvIn E{(bf16*)(F.ws + WS_BIG), (bf16*)(F.ws + WS_BIG + 32 * MiB)};
                    pg8::gemm_phase<EpiConvIn, pg8::StaticOrder, true, true>(F.lds, g, S, E);
                }
                const int ng = is_attn ? 2 : 0;
#pragma unroll 1
                for (int gi = 0; gi < ng; ++gi) {
                    pg8::Gemm g; pg8::EpiBf16<0> E; E.bias = nullptr; E.split_cols = 0; E.split_stride = 0; E.scale0 = 1.f;
                    if (is_attn && gi == 0) { g = pg8::Gemm{(const pg8::bf16_t*)(F.ws + WS_HN), (const pg8::bf16_t*)(F.ws + WS_WQK) + (size_t)j * 2048 * 1024, M, 2048, D}; E.O = (pg8::bf16_t*)(F.ws + WS_BIG); E.ldc = 2048; }
                    else if (is_attn) { g = pg8::Gemm{(const pg8::bf16_t*)(F.ws + WS_WV) + (size_t)j * 1024 * 1024, (const pg8::bf16_t*)(F.ws + WS_HN), D, M, D}; E.O = (pg8::bf16_t*)(F.ws + WS_VT); E.ldc = M; }
                    else { g = pg8::Gemm{(const pg8::bf16_t*)(F.ws + WS_HN), (const pg8::bf16_t*)(F.ws + WS_WIN) + (size_t)j * 3072 * 1024, M, 3072, D}; E.O = (pg8::bf16_t*)(F.ws + WS_BIG); E.ldc = 3072; }
                    pg8::StaticOrder S; S.init(g.M, g.N, F.G, (int)blockIdx.x);
                    pg8::gemm_phase<pg8::EpiBf16<0>, pg8::StaticOrder, true, true>(F.lds, g, S, E);
                }
            } else if (k == 1) {
                if (is_attn) {
#if NAIVE_ATTN
                    attn_naive_phase(F, j);
#elif !defined(DIS_ATTN)
                    attn_phase(F, j);
#endif
                } else {
#ifndef DIS_CONV
                    conv_phase(F, j);
#endif
                }
            } else if (k == 2) {
                pg8::Gemm g{(const pg8::bf16_t*)(F.ws + WS_MIX), (const pg8::bf16_t*)(F.ws + (is_attn ? WS_WO : WS_WOUT)) + (size_t)j * 1024 * 1024, M, D, D};
                pg8::StaticOrder S; S.init(M, D, F.G, (int)blockIdx.x);
                float* rssp = (float*)(F.ws + (dry ? WS_SC + 96 * MiB : WS_RSS)); bf16* hout = (bf16*)(F.ws + (dry ? WS_SC : WS_H));
                if (layer == 0) { EpiRes<true> E{(const void*)F.in(0), hout, rssp}; pg8::gemm_phase<EpiRes<true>, pg8::StaticOrder, false, true>(F.lds, g, S, E); }
                else { EpiRes<false> E{(const void*)(F.ws + WS_H), hout, rssp}; pg8::gemm_phase<EpiRes<false>, pg8::StaticOrder, false, true>(F.lds, g, S, E); }
            } else if (k == 3) {
                did = false;
            } else if (k == 4) {
                pg8::Gemm g{(const pg8::bf16_t*)(F.ws + WS_H), (const pg8::bf16_t*)(F.ws + WS_WP) + (size_t)layer * 2048 * 1024, M, 2048, D};
                pg8::StaticOrder S; S.init(M, 2048, F.G, (int)blockIdx.x);
#if NAIVE_TOPK
                EpiF32 E{(float*)(F.ws + WS_SC), 2048};
                pg8::gemm_phase<EpiF32, pg8::StaticOrder, true, true>(F.lds, g, S, E);
#else
#ifndef DIS_TOPK
                EpiTopK E{(int*)(F.ws + WS_SELI), (float*)(F.ws + WS_SELG), (const float*)(F.ws + WS_RSS)};
#pragma unroll 1
                for (int i = 0;; ++i) { OneUnit O1; if (!S.next(i, O1.u)) break; pg8::gemm_phase<EpiTopK, OneUnit, false, true>(F.lds, g, O1, E); }
#endif
#endif
            } else if (k == 5) {
#if NAIVE_TOPK
                select_naive_phase(F);
#else
                did = false;
#endif
            } else {
#ifndef DIS_GATHER
                gather_phase(F, layer, dry);
#endif
            }
        }
        if (MK_N_LAUNCHES == 1 && dry) xcd_barrier(bar);
        }
        if (MK_N_LAUNCHES == 1 && did && ph + 1 < args.ph_hi) { xcd_barrier(bar);
#ifdef PROBE_BAR2
            xcd_barrier(bar);
#endif
        }
    }
}

extern "C" void kernel_launch(void* const* d_in, const int* in_sizes, int n_in, void* d_out, int out_size, void* d_ws, size_t ws_size, hipStream_t stream) {
    static int grid = 0;
    if (grid == 0) {
        if (n_in != 14 || out_size != M * D || ws_size < WS_END) { fprintf(stderr, "kernel_launch: unexpected shapes (n_in %d, out %d, ws %zu); nothing launched\n", n_in, out_size, ws_size); grid = -1; return; }
        int dev = 0, cus = 0, per_cu = 0;
        if (hipGetDevice(&dev) != hipSuccess || hipDeviceGetAttribute(&cus, hipDeviceAttributeMultiprocessorCount, dev) != hipSuccess) { grid = -1; return; }
        if (hipFuncSetAttribute((const void*)mega_fwd, hipFuncAttributeMaxDynamicSharedMemorySize, LDS_BYTES) != hipSuccess) { fprintf(stderr, "kernel_launch: hipFuncSetAttribute failed\n"); grid = -1; return; }
        if (hipOccupancyMaxActiveBlocksPerMultiprocessor(&per_cu, (const void*)mega_fwd, NTHR, LDS_BYTES) != hipSuccess || per_cu < 1) fprintf(stderr, "kernel_launch: note: occupancy query reports %d\n", per_cu);
        (void)hipGetLastError();
        grid = cus;
    }
    if (grid < 0) return;
    if (hipMemsetAsync((char*)d_ws + WS_CTL, 0, CTL_ZERO_BYTES, stream) != hipSuccess) return;
    Args a{};
    for (int i = 0; i < 14; ++i) a.in[i] = (const float*)d_in[i];
    a.out = (float*)d_out; a.ws = (unsigned char*)d_ws;
    if (MK_N_LAUNCHES == 1) { a.ph_lo = 0; a.ph_hi = N_PHASES; hipLaunchKernelGGL(mega_fwd, dim3(grid), dim3(NTHR), LDS_BYTES, stream, a); }
    else for (int ph = 0; ph < N_PHASES; ++ph) {
        if (ph > 0 && ((ph - 1) % PH_PER_LAYER == 3 || (!NAIVE_TOPK && (ph - 1) % PH_PER_LAYER == 5))) continue;
        a.ph_lo = ph; a.ph_hi = ph + 1; hipLaunchKernelGGL(mega_fwd, dim3(grid), dim3(NTHR), LDS_BYTES, stream, a);
    }
}
```

```cpp
#include <hip/hip_runtime.h>
#include <cstdio>
#include <cstdint>
namespace pg8 {
#define PG8_LAS __attribute__((address_space(3)))
typedef unsigned short bf16_t;
typedef short bf16x8 __attribute__((ext_vector_type(8)));
typedef float f32x4 __attribute__((ext_vector_type(4)));
typedef unsigned u32x4 __attribute__((ext_vector_type(4)));
constexpr int BM = 256, BK = 64, HALF = 128, HTB = HALF * BK * 2  , STAGE_BYTES = 8 * HTB, NXCD = 8, WGM = 8;

__host__ __device__ __forceinline__ int lds_byte(int r, int c) { const int st = (r >> 4) * 2 + (c >> 5), rr = r & 15, cc = c & 31, ob = rr * 64 + cc * 2; return st * 1024 + (ob ^ (((ob >> 9) & 1) << 5)); }
__host__ __device__ __forceinline__ void stage_rc(int b, int& R, int& C) { const int st = b / 1024, sb = b % 1024, swz = sb ^ (((sb >> 9) & 1) << 5); R = (st >> 1) * 16 + swz / 64; C = (st & 1) * 32 + (swz % 64) / 2; }
__host__ __device__ __forceinline__ int perm32(int rho) { const int n = rho >> 4, i = rho & 15; return 8 * (i >> 2) + 4 * n + (i & 3); }

struct Unit { int pm, pn; };
struct Gemm { const bf16_t* A; const bf16_t* Bt; int M, N, K; };

struct StaticOrder {
    int nM, nN, nwg, G, c;
    __host__ __device__ void init(int M, int N, int G_, int c_) { nM = M / BM; nN = N / BM; nwg = nM * nN; G = G_; c = c_; }
    __host__ __device__ bool next(int i, Unit& u) const {
        const long L = (long)i * G + c; if (L >= nwg) return false;
        int wgid = (int)L; { const int q = nwg / NXCD, r = nwg % NXCD, xcd = wgid % NXCD, off = wgid / NXCD; wgid = (xcd < r ? xcd * (q + 1) : r * (q + 1) + (xcd - r) * q) + off; }
        const int nig = WGM * nN, gid = wgid / nig, fm = gid * WGM, gsz = (nM - fm) < WGM ? (nM - fm) : WGM;
        u.pm = fm + ((wgid % nig) % gsz); u.pn = (wgid % nig) / gsz; return true;
    }
    __device__ __forceinline__ void a_ready(const Unit&) const {}
    __device__ __forceinline__ void done(const Unit&) const {}
};

__device__ __forceinline__ unsigned cvt_pk_bf16(float lo, float hi) { unsigned r; asm volatile("v_cvt_pk_bf16_f32 %0, %1, %2" : "=v"(r) : "v"(lo), "v"(hi)); return r; }
typedef float f32x2 __attribute__((ext_vector_type(2)));
__device__ __forceinline__ f32x2 gelu_pk(f32x2 v) {
    const f32x2 av = __builtin_elementwise_abs(v), d = av * 0.2316418882f + 1.0f;
    f32x2 t; t.x = __builtin_amdgcn_rcpf(d.x); t.y = __builtin_amdgcn_rcpf(d.y);
    f32x2 q = t * 0.5307027145f + (-0.7265760135f); q = q * t + 0.7107068705f; q = q * t + (-0.142248368f); q = q * t + 0.127414796f; q = q * t;
    const f32x2 s = (v * v) * (-0.72134752044f);
    f32x2 e; e.x = __builtin_amdgcn_exp2f(s.x); e.y = __builtin_amdgcn_exp2f(s.y);
    const f32x2 m = v * (q * e), r = v - m;
    f32x2 o; o.x = v.x < 0.f ? m.x : r.x; o.y = v.y < 0.f ? m.y : r.y; return o;
}

template <int ACT  > struct EpiBf16 {
    static constexpr bool PERM = true, AFTER_DRAIN = false; static_assert(ACT == 0 || ACT == 1, "EpiBf16: ACT is 0 (none) or 1 (gelu_pk)");
    bf16_t* O; int ldc; const float* bias; int split_cols; size_t split_stride; float scale0;
    __device__ __forceinline__ void operator()(const f32x4 (&acc)[2][2][4][2], const Unit& u, int wr, int wc, int fr, int fq) const {
        const int row0 = u.pm * BM + wr * 64 + fr; int colt = u.pn * BM; bf16_t* base = O;
        float sc = 1.f; if (split_cols) { const int t = colt / split_cols; base += (size_t)t * split_stride; colt -= t * split_cols; if (t == 0) sc = scale0; }
        const int col0 = colt + wc * 32 + 8 * fq, bcol0 = u.pn * BM + wc * 32 + 8 * fq;
        f32x4 bv[2][2];
#pragma unroll
        for (int bj = 0; bj < 2; ++bj)
#pragma unroll
            for (int n = 0; n < 2; ++n) bv[bj][n] = bias ? *(const f32x4*)(bias + bcol0 + bj * HALF + 4 * n) : (f32x4){0.f, 0.f, 0.f, 0.f};
#pragma unroll
        for (int ai = 0; ai < 2; ++ai)
#pragma unroll
            for (int m = 0; m < 4; ++m) { bf16_t* rowp = base + (size_t)(row0 + ai * HALF + m * 16) * ldc + col0;
#pragma unroll
                for (int bj = 0; bj < 2; ++bj) { f32x4 v0 = acc[ai][bj][m][0] + bv[bj][0], v1 = acc[ai][bj][m][1] + bv[bj][1];
                    if (ACT == 1) { f32x2 a = gelu_pk((f32x2){v0[0], v0[1]}), b = gelu_pk((f32x2){v0[2], v0[3]}), c = gelu_pk((f32x2){v1[0], v1[1]}), d = gelu_pk((f32x2){v1[2], v1[3]});
                        v0 = (f32x4){a.x, a.y, b.x, b.y}; v1 = (f32x4){c.x, c.y, d.x, d.y}; }
                    v0 = v0 * sc; v1 = v1 * sc; u32x4 w; w.x = cvt_pk_bf16(v0[0], v0[1]); w.y = cvt_pk_bf16(v0[2], v0[3]); w.z = cvt_pk_bf16(v1[0], v1[1]); w.w = cvt_pk_bf16(v1[2], v1[3]);
                    *(u32x4*)(rowp + bj * HALF) = w; } }
    }
};

template <class Epi, class Sched, bool ALIGN_EPI = false, bool SP2 = false>
__device__ __forceinline__ void gemm_phase(PG8_LAS unsigned char* lds, const Gemm g, const Sched& S, const Epi& E) {
    int tid_l = threadIdx.x; asm volatile("" : "+v"(tid_l));
    const int tid = tid_l, wid = __builtin_amdgcn_readfirstlane(tid >> 6), lane = tid & 63, wr = wid >> 2, wc = wid & 3, fr = lane & 15, fq = lane >> 4;
    const int K = g.K, nt = K / BK;
    unsigned voffA[2], voffB[2];
#pragma unroll
    for (int i = 0; i < 2; ++i) { int R, C; stage_rc(tid * 16 + i * 8192, R, C); const int Rb = Epi::PERM ? ((R & ~31) + perm32(R & 31)) : R;
        voffA[i] = (unsigned)(R * K + C) * 2u; voffB[i] = (unsigned)(Rb * K + C) * 2u; }
    const size_t kstep = (size_t)(BK * 2);
    const size_t hstep = (size_t)HALF * K * 2;
    const size_t tstep = 2 * hstep;
    const unsigned ldsw = (unsigned)wid * 1024u;
    const int aoff = lds_byte(wr * 64 + fr, fq * 8), boff = lds_byte(wc * 32 + fr, fq * 8);
#define PG8_SA(b, h) (((b) * 2 + (h)) * HTB)
#define PG8_SB(b, h) ((4 + (b) * 2 + (h)) * HTB)
#define PG8_STAGE(bufoff, gbase, voff) do { _Pragma("unroll") for (int _i = 0; _i < 2; ++_i) \
        __builtin_amdgcn_global_load_lds((const unsigned*)((const char*)(gbase) + (voff)[_i]), (PG8_LAS unsigned*)(lds + (bufoff) + ldsw + _i * 8192), 16, 0, 0); } while (0)
#define PG8_LDA(dst, b, h) do { _Pragma("unroll") for (int m = 0; m < 4; ++m) _Pragma("unroll") for (int k = 0; k < 2; ++k) dst[m][k] = *(const PG8_LAS bf16x8*)(lds + PG8_SA(b, h) + aoff + m * 2048 + k * 1024); } while (0)
#define PG8_LDB(dst, b, h) do { _Pragma("unroll") for (int n = 0; n < 2; ++n) _Pragma("unroll") for (int k = 0; k < 2; ++k) dst[n][k] = *(const PG8_LAS bf16x8*)(lds + PG8_SB(b, h) + boff + n * 2048 + k * 1024); } while (0)
#define PG8_MMA(ai, bj, At, Bt) do { __builtin_amdgcn_s_setprio(1); _Pragma("unroll") for (int m = 0; m < 4; ++m) _Pragma("unroll") for (int n = 0; n < 2; ++n) _Pragma("unroll") for (int k = 0; k < 2; ++k) \
        acc[ai][bj][m][n] = __builtin_amdgcn_mfma_f32_16x16x32_bf16(Bt[n][k], At[m][k], acc[ai][bj][m][n], 0, 0, 0); __builtin_amdgcn_s_setprio(0); } while (0)
#define PG8_WAIT_V(n) asm volatile("s_waitcnt vmcnt(" #n ")" ::: "memory")
#define PG8_WAIT_L(n) asm volatile("s_waitcnt lgkmcnt(" #n ")" ::: "memory")
#define PG8_BAR __builtin_amdgcn_s_barrier()
#define PG8_SCHED __builtin_amdgcn_sched_barrier(0)
    Unit cur, nxt; int ui = 0;
    if (!S.next(0, cur)) return;
    f32x4 acc[2][2][4][2];
#pragma unroll
    for (int a = 0; a < 2; ++a)
#pragma unroll
        for (int b = 0; b < 2; ++b)
#pragma unroll
            for (int m = 0; m < 4; ++m)
#pragma unroll
                for (int n = 0; n < 2; ++n) acc[a][b][m][n] = (f32x4){0.f, 0.f, 0.f, 0.f};
    bf16x8 At[4][2], B0[2][2], B1[2][2];
    const char* cA = (const char*)g.A + (size_t)cur.pm * tstep; const char* cB = (const char*)g.Bt + (size_t)cur.pn * tstep;
    S.a_ready(cur);
    if constexpr (SP2) {
        PG8_STAGE(PG8_SB(0, 0), cB, voffB); PG8_STAGE(PG8_SB(0, 1), cB + hstep, voffB); PG8_STAGE(PG8_SA(0, 0), cA, voffA); PG8_STAGE(PG8_SA(0, 1), cA + hstep, voffA);
        if (wr == 1) PG8_BAR;
        PG8_WAIT_V(2); PG8_BAR;
        PG8_STAGE(PG8_SB(1, 0), cB + kstep, voffB); PG8_STAGE(PG8_SA(1, 0), cA + kstep, voffA); PG8_STAGE(PG8_SB(1, 1), cB + hstep + kstep, voffB);
        PG8_WAIT_V(6); PG8_BAR;
    } else {
        PG8_STAGE(PG8_SB(0, 0), cB, voffB); PG8_STAGE(PG8_SA(0, 0), cA, voffA); PG8_STAGE(PG8_SB(0, 1), cB + hstep, voffB); PG8_STAGE(PG8_SA(0, 1), cA + hstep, voffA);
        if (wr == 1) PG8_BAR;
        PG8_WAIT_V(4); PG8_BAR;
        PG8_STAGE(PG8_SB(1, 0), cB + kstep, voffB); PG8_STAGE(PG8_SA(1, 0), cA + kstep, voffA); PG8_STAGE(PG8_SB(1, 1), cB + hstep + kstep, voffB);
        PG8_WAIT_V(6); PG8_BAR;
    }
    for (;;) {
        const bool has_next = S.next(ui + 1, nxt);
        const char* nA = has_next ? (const char*)g.A + (size_t)nxt.pm * tstep : cA; const char* nB = has_next ? (const char*)g.Bt + (size_t)nxt.pn * tstep : cB;
        for (int t = 0; t < nt; t += 2) {
            const bool last = (t == nt - 2);
            const char* a1 = cA + (size_t)(t + 1) * kstep;
            const char* a2 = last ? nA : cA + (size_t)(t + 2) * kstep; const char* b2 = last ? nB : cB + (size_t)(t + 2) * kstep;
            const char* a3 = a2 + kstep; const char* b3 = b2 + kstep;
            if (last && has_next) S.a_ready(nxt);
            if constexpr (SP2) {
            PG8_LDB(B0, 0, 0); PG8_LDB(B1, 0, 1); PG8_SCHED; PG8_LDA(At, 0, 0); PG8_STAGE(PG8_SA(1, 1), a1 + hstep, voffA);
            PG8_WAIT_V(8); PG8_WAIT_L(0); PG8_BAR; PG8_MMA(0, 0, At, B0); PG8_MMA(0, 1, At, B1); PG8_BAR; PG8_SCHED;
            PG8_LDA(At, 0, 1); PG8_STAGE(PG8_SB(0, 0), b2, voffB); PG8_STAGE(PG8_SB(0, 1), b2 + hstep, voffB); PG8_STAGE(PG8_SA(0, 0), a2, voffA);
            PG8_WAIT_V(8); PG8_WAIT_L(0); PG8_BAR; PG8_MMA(1, 0, At, B0); PG8_MMA(1, 1, At, B1); PG8_BAR; PG8_SCHED;
            PG8_LDB(B0, 1, 0); PG8_LDB(B1, 1, 1); PG8_SCHED; PG8_LDA(At, 1, 0); PG8_STAGE(PG8_SA(0, 1), a2 + hstep, voffA);
            PG8_WAIT_V(8); PG8_WAIT_L(0); PG8_BAR; PG8_MMA(0, 0, At, B0); PG8_MMA(0, 1, At, B1); PG8_BAR; PG8_SCHED;
            PG8_LDA(At, 1, 1); PG8_STAGE(PG8_SB(1, 0), b3, voffB); PG8_STAGE(PG8_SB(1, 1), b3 + hstep, voffB); PG8_STAGE(PG8_SA(1, 0), a3, voffA);
            PG8_WAIT_V(8); PG8_WAIT_L(0); PG8_BAR; PG8_MMA(1, 0, At, B0); PG8_MMA(1, 1, At, B1); PG8_BAR; PG8_SCHED;
            } else {
            PG8_LDB(B0, 0, 0); PG8_SCHED; PG8_LDA(At, 0, 0); PG8_STAGE(PG8_SA(1, 1), a1 + hstep, voffA);
            PG8_WAIT_L(8); PG8_BAR; PG8_WAIT_L(0); PG8_MMA(0, 0, At, B0); PG8_BAR; PG8_SCHED;
            PG8_LDB(B1, 0, 1); PG8_STAGE(PG8_SB(0, 0), b2, voffB);
            PG8_BAR; PG8_WAIT_L(0); PG8_MMA(0, 1, At, B1); PG8_BAR;
            PG8_LDA(At, 0, 1); PG8_STAGE(PG8_SA(0, 0), a2, voffA);
            PG8_BAR; PG8_WAIT_L(0); PG8_MMA(1, 0, At, B0); PG8_BAR; PG8_SCHED;
            PG8_STAGE(PG8_SB(0, 1), b2 + hstep, voffB);
            PG8_WAIT_V(6); PG8_BAR; PG8_MMA(1, 1, At, B1); PG8_BAR;
            PG8_LDB(B0, 1, 0); PG8_SCHED; PG8_LDA(At, 1, 0); PG8_STAGE(PG8_SA(0, 1), a2 + hstep, voffA);
            PG8_WAIT_L(8); PG8_BAR; PG8_WAIT_L(0); PG8_MMA(0, 0, At, B0); PG8_BAR; PG8_SCHED;
            PG8_LDB(B1, 1, 1); PG8_STAGE(PG8_SB(1, 0), b3, voffB);
            PG8_BAR; PG8_WAIT_L(0); PG8_MMA(0, 1, At, B1); PG8_BAR;
            PG8_LDA(At, 1, 1); PG8_STAGE(PG8_SA(1, 0), a3, voffA);
            PG8_BAR; PG8_WAIT_L(0); PG8_MMA(1, 0, At, B0); PG8_BAR; PG8_SCHED;
            PG8_STAGE(PG8_SB(1, 1), b3 + hstep, voffB);
            PG8_WAIT_V(6); PG8_BAR; PG8_MMA(1, 1, At, B1); PG8_BAR;
            }
        }
        if constexpr (ALIGN_EPI) { if (wr == 0) PG8_BAR; }
        if constexpr (!Epi::AFTER_DRAIN) { E(acc, cur, wr, wc, fr, fq); S.done(cur); }
        if (!has_next) break;
#pragma unroll
        for (int a = 0; a < 2; ++a)
#pragma unroll
            for (int b = 0; b < 2; ++b)
#pragma unroll
                for (int m = 0; m < 4; ++m)
#pragma unroll
                    for (int n = 0; n < 2; ++n) acc[a][b][m][n] = (f32x4){0.f, 0.f, 0.f, 0.f};
        cur = nxt; cA = nA; cB = nB; ++ui;
        if constexpr (ALIGN_EPI) { if (wr == 1) PG8_BAR; }
    }
    PG8_WAIT_V(0);
    if constexpr (!ALIGN_EPI) { if (wr == 0) PG8_BAR; }
    PG8_BAR;
    if constexpr (Epi::AFTER_DRAIN) { E.fused(acc, cur, wr, wc, fr, fq, lds, wid, lane); S.done(cur); }
#undef PG8_SA
#undef PG8_SB
#undef PG8_STAGE
#undef PG8_LDA
#undef PG8_LDB
#undef PG8_MMA
#undef PG8_WAIT_V
#undef PG8_WAIT_L
#undef PG8_BAR
#undef PG8_SCHED
}
}
#ifndef HD
#define HD __host__ __device__ __forceinline__
#endif
HD int tk_map(float f) { int b = __builtin_bit_cast(int, f); return b ^ ((b >> 31) & 0x7fffffff); }
HD float tk_unmap(int k) { int b = k ^ ((k >> 31) & 0x7fffffff); return __builtin_bit_cast(float, b); }
HD void tk_cx(int& a, int& b) { const int hi = a > b ? a : b, lo = a > b ? b : a; a = hi; b = lo; }
template <int N> HD void tk_sort_desc(int (&v)[N]) {
#pragma unroll
    for (int k = 2; k <= N; k <<= 1)
#pragma unroll
        for (int j = k >> 1; j > 0; j >>= 1)
#pragma unroll
            for (int i = 0; i < N; ++i) { const int l = i ^ j; if (l > i) { if ((i & k) == 0) tk_cx(v[i], v[l]); else tk_cx(v[l], v[i]); } }
}
template <int N> HD void tk_merge_top(int (&a)[N], const int (&b)[N]) {
#pragma unroll
    for (int i = 0; i < N; ++i) a[i] = a[i] > b[N - 1 - i] ? a[i] : b[N - 1 - i];
#pragma unroll
    for (int j = N >> 1; j > 0; j >>= 1)
#pragma unroll
        for (int i = 0; i < N; ++i) { const int l = i ^ j; if (l > i) tk_cx(a[i], a[l]); }
}
template <int NCH, class FP> HD void tk_stage1(FP s, int n_base, int (&best)[16]) {
#pragma unroll
    for (int c = 0; c < NCH; ++c) {
        int x[16];
#pragma unroll
        for (int e = 0; e < 16; ++e) x[e] = (tk_map(s[c * 16 + e]) & ~127) | (127 - (n_base + c * 16 + e));
        tk_sort_desc(x);
        if (c == 0) {
#pragma unroll
            for (int e = 0; e < 16; ++e) best[e] = x[e];
        } else tk_merge_top(best, x);
    }
}
template <class IP, class OI, class OG> HD void tk_stage2(int (&a)[16], int (&b)[16], IP AB, OI out_idx, OG out_g, float vscale = 1.0f) {
    float va[16], vb[16];
#pragma unroll
    for (int i = 0; i < 16; ++i) { AB[i] = a[i]; AB[16 + i] = b[i]; va[i] = tk_unmap(a[i] & ~127); vb[i] = tk_unmap(b[i] & ~127); }
    int best[16];
#pragma unroll
    for (int c = 0; c < 4; ++c) {
        int x[16];
#pragma unroll
        for (int e = 0; e < 16; ++e) x[e] = (int)0x80000000;
        int n = 0;
#pragma unroll
        for (int i = 0; i < 16; ++i)
#pragma unroll
            for (int j = 0; j < 16; ++j)
                if ((i + 1) * (j + 1) <= 16) { if (n >= 16 * c && n < 16 * c + 16) x[n - 16 * c] = (tk_map(va[i] + vb[j]) & ~255) | (255 - (i * 16 + j)); ++n; }
        tk_sort_desc(x);
        if (c == 0) {
#pragma unroll
            for (int e = 0; e < 16; ++e) best[e] = x[e];
        } else tk_merge_top(best, x);
    }
    int ka[16], kb[16];
#pragma unroll
    for (int k = 0; k < 16; ++k) { const int flat = 255 - (best[k] & 255); ka[k] = AB[flat >> 4]; kb[k] = AB[16 + (flat & 15)]; }
    float sv[16]; int ei[16]; float sum = 0.f;
#pragma unroll
    for (int k = 0; k < 16; ++k) { ei[k] = (127 - (ka[k] & 127)) * 128 + (127 - (kb[k] & 127)); sv[k] = (tk_unmap(ka[k] & ~127) + tk_unmap(kb[k] & ~127)) * vscale; }
    const float m = sv[0];
#pragma unroll
    for (int k = 0; k < 16; ++k) { sv[k] = __expf(sv[k] - m); sum += sv[k]; }
    const float inv = 1.0f / sum;
#pragma unroll
    for (int k = 0; k < 16; ++k) { out_idx[k] = ei[k]; out_g[k] = sv[k] * inv; }
}
constexpr int NWAVES = 8, NTHR = 512;
constexpr int BATCH = 2, SEQ = 8192, D = 1024, M = BATCH * SEQ, DEPTH = 4;
constexpr int NH = 16, HDIM = 64, GRIDW = 64, NROWS = 128;
constexpr float RMS_EPS = 1e-6f;
#ifndef MK_N_LAUNCHES
#define MK_N_LAUNCHES 1
#endif
#ifndef NAIVE_ATTN
#define NAIVE_ATTN 0
#endif
#ifndef NAIVE_TOPK
#define NAIVE_TOPK 0
#endif
#ifndef EXPERT_FP4
#define EXPERT_FP4 1
#endif
constexpr int ROWB = EXPERT_FP4 ? 512 : 1024;
#ifndef PROBE_GMODE
#define PROBE_GMODE 0
#endif
#ifndef PROBE_PMODE
#define PROBE_PMODE 0
#endif
#ifndef PROBE_LMASK
#define PROBE_LMASK 15
#endif
#ifndef PROBE_REP
#define PROBE_REP -1
#endif
constexpr int PH_PER_LAYER = 7, N_PHASES = 1 + DEPTH * PH_PER_LAYER;

constexpr size_t MiB = 1u << 20;
constexpr size_t WS_CTL = 0, CTL_ZERO_BYTES = 32 * 1024;
constexpr size_t WS_WQK = 2 * MiB;
constexpr size_t WS_WV = 10 * MiB;
constexpr size_t WS_WO = 14 * MiB;
constexpr size_t WS_WIN = 18 * MiB;
constexpr size_t WS_WOUT = 30 * MiB;
constexpr size_t WS_WP = 34 * MiB;
constexpr size_t WS_H = 64 * MiB;
constexpr size_t WS_HN = 128 * MiB;
constexpr size_t WS_BIG = 160 * MiB;
constexpr size_t WS_VT = 224 * MiB;
constexpr size_t WS_MIX = 256 * MiB;
constexpr size_t WS_SELI = 288 * MiB;
constexpr size_t WS_SELG = 296 * MiB;
constexpr size_t WS_UP = 320 * MiB;
constexpr size_t WS_DN = 384 * MiB;
constexpr size_t WS_SUP = 448 * MiB;
constexpr size_t WS_ACTG = 452 * MiB;
constexpr size_t WS_RSS = 450 * MiB;
constexpr size_t WS_SC = 576 * MiB;
constexpr size_t WS_END = 704 * MiB;
constexpr int CW_BAR = 4096;
static_assert((CW_BAR + 3456) * 4 <= (int)CTL_ZERO_BYTES, "barrier words inside the per-call memset");

constexpr int LDS_BYTES = 163840, MISC_OFF = LDS_BYTES - 256, PTAB_OFF = LDS_BYTES - 512;

#define LAS __attribute__((address_space(3)))
typedef unsigned short bf16;
typedef unsigned v4u __attribute__((ext_vector_type(4)));
typedef unsigned v2u __attribute__((ext_vector_type(2)));
typedef float f32x4 __attribute__((ext_vector_type(4)));
typedef short bf16x8 __attribute__((ext_vector_type(8)));
#define LDS_WAIT() asm volatile("s_waitcnt lgkmcnt(0)" ::: "memory")
#define BLOCK_BAR() do { asm volatile("s_waitcnt vmcnt(0) lgkmcnt(0)" ::: "memory"); __builtin_amdgcn_s_barrier(); asm volatile("" ::: "memory"); } while (0)
__device__ __forceinline__ unsigned f2bf(float f) { unsigned u = __builtin_bit_cast(unsigned, f); return (u + 0x7fffu + ((u >> 16) & 1u)) >> 16; }
typedef float f32x2p __attribute__((ext_vector_type(2))); typedef __bf16 bf16x2p __attribute__((ext_vector_type(2)));
__device__ __forceinline__ unsigned pk2(float lo, float hi) { const f32x2p v = {lo, hi}; return __builtin_bit_cast(unsigned, __builtin_convertvector(v, bf16x2p)); }
__device__ __forceinline__ float bflo(unsigned u) { return __builtin_bit_cast(float, u << 16); }
__device__ __forceinline__ float bfhi(unsigned u) { return __builtin_bit_cast(float, u & 0xffff0000u); }
__device__ __forceinline__ float wave_sum(float v) {
#pragma unroll
    for (int o = 1; o < 64; o <<= 1) v += __shfl_xor(v, o);
    return v;
}

#define XB_TMO      128
#define XB_XCNT(j)  (256  + 64 * (j))
#define XB_XSUB(j)  (1280 + 64 * (j))
#define XB_XGEN(j)  (2304 + 64 * (j))
#define XB_TOP      3328
#define XB_TOPGEN   3392
#define XCD_BAR_WORDS 3456
#define XB_SPIN_CAP (1u << 20)
__device__ __forceinline__ unsigned xb_ld(unsigned* p)              { return __hip_atomic_load(p, __ATOMIC_RELAXED, __HIP_MEMORY_SCOPE_AGENT); }
__device__ __forceinline__ unsigned xb_add(unsigned* p, unsigned v) { return __hip_atomic_fetch_add(p, v, __ATOMIC_RELAXED, __HIP_MEMORY_SCOPE_AGENT); }
__device__ __forceinline__ unsigned xb_xcc_id() { return (unsigned)__builtin_amdgcn_s_getreg((3 << 11) | 20) & 0xFu; }
#define XB_SPIN(cond, bar) do { unsigned _sp = 0; while (cond) { __builtin_amdgcn_s_sleep(1); \
    if ((++_sp & 255u) == 0u) { if (xb_ld(&(bar)[XB_TMO])) break; if (_sp > XB_SPIN_CAP) { atomicAdd(&(bar)[XB_TMO], 1u); break; } } } } while (0)
struct XcdBarrier { unsigned* bar; unsigned x; volatile LAS unsigned* st; };
__device__ __forceinline__ XcdBarrier xcd_barrier_post(unsigned* bar, volatile LAS unsigned* st) {
    XcdBarrier b; b.bar = bar; b.x = xb_xcc_id(); b.st = st;
    if (threadIdx.x == 0) (void)xb_add(&bar[XB_XCNT(b.x)], 1u);
    return b;
}
__device__ __forceinline__ void xcd_barrier_complete(unsigned* bar, unsigned x, unsigned& nloc, unsigned& nx) {
    const unsigned G = gridDim.x * gridDim.y * gridDim.z;
    unsigned sum, cnt, mine, sp = 0u;
    for (;;) {
        sum = 0u; cnt = 0u; mine = 0u;
#pragma unroll
        for (unsigned j = 0; j < 16; ++j) { const unsigned c = xb_ld(&bar[XB_XCNT(j)]); sum += c; cnt += (c > 0u) ? 1u : 0u; mine = (j == x) ? c : mine; }
        if (sum == G) break;
        __builtin_amdgcn_s_sleep(1);
        if ((++sp & 255u) == 0u) { if (xb_ld(&bar[XB_TMO])) break; if (sp > XB_SPIN_CAP) { atomicAdd(&bar[XB_TMO], 1u); break; } }
    }
    nloc = mine > 0u ? mine : 1u; nx = cnt > 0u ? cnt : 1u;
}
__device__ __forceinline__ void xcd_barrier(const XcdBarrier& b) {
    asm volatile("s_waitcnt vmcnt(0)" ::: "memory");
    __syncthreads();
    if (threadIdx.x == 0) {
        unsigned* bar = b.bar;
        __builtin_amdgcn_s_waitcnt(0);
        unsigned nloc = b.st[0], nx = b.st[1];
        if (nloc == 0u) { xcd_barrier_complete(bar, b.x, nloc, nx); b.st[0] = nloc; b.st[1] = nx; }
        const unsigned old = xb_add(&bar[XB_XSUB(b.x)], 1u);
        const unsigned gen = old / nloc;
        if (old + 1u == (gen + 1u) * nloc) {
            __builtin_amdgcn_fence(__ATOMIC_RELEASE, "agent");
            asm volatile("s_waitcnt vmcnt(0)" ::: "memory");
            const unsigned og = xb_add(&bar[XB_TOP], 1u);
            const unsigned tg = og / nx;
            if (og + 1u == (tg + 1u) * nx) xb_add(&bar[XB_TOPGEN], 1u);
            else XB_SPIN(xb_ld(&bar[XB_TOPGEN]) == tg, bar);
            __builtin_amdgcn_fence(__ATOMIC_ACQUIRE, "agent");
            xb_add(&bar[XB_XGEN(b.x)], 1u);
            asm volatile("s_waitcnt vmcnt(0)" ::: "memory");
        } else {
            XB_SPIN(xb_ld(&bar[XB_XGEN(b.x)]) == gen, bar);
            __builtin_amdgcn_fence(__ATOMIC_ACQUIRE, "agent");
            asm volatile("s_waitcnt vmcnt(0)" ::: "memory");
        }
    }
    __syncthreads();
}

struct Frame {
    LAS unsigned char* lds;
    int tid, lane, wave, vcu, G;
    unsigned char* ws;
    __device__ __forceinline__ const float* in(int i) const {
        const volatile LAS unsigned* t = (const volatile LAS unsigned*)(lds + PTAB_OFF);
        const unsigned lo = __builtin_amdgcn_readfirstlane(t[2 * i]), hi = __builtin_amdgcn_readfirstlane(t[2 * i + 1]);
        return (const float*)(const __attribute__((address_space(1))) float*)(((unsigned long long)hi << 32) | lo);
    }
    __device__ __forceinline__ float* out() const { return (float*)in(14); }
};

template <bool FIRST> struct EpiRes {
    static constexpr bool PERM = true, AFTER_DRAIN = false;
    const void* hin; bf16* h; float* rss;
    __device__ __forceinline__ void operator()(const pg8::f32x4 (&acc)[2][2][4][2], const pg8::Unit& u, int wr, int wc, int fr, int fq) const {
        const int col0 = u.pn * 256 + wc * 32 + 8 * fq;
#pragma unroll
        for (int ai = 0; ai < 2; ++ai)
#pragma unroll
            for (int m = 0; m < 4; ++m) { const int row = u.pm * 256 + ai * 128 + wr * 64 + m * 16 + fr; bf16* rowp = h + (size_t)row * D + col0;
                float ss = 0.f;
#pragma unroll
                for (int bj = 0; bj < 2; ++bj) { f32x4 v0, v1;
                    if (FIRST) { const float* xp = (const float*)hin + (size_t)row * D + col0 + bj * 128; v0 = *(const f32x4*)xp; v1 = *(const f32x4*)(xp + 4); }
                    else { const v4u hw = *(const v4u*)((const bf16*)hin + (size_t)row * D + col0 + bj * 128); v0 = (f32x4){bflo(hw.x), bfhi(hw.x), bflo(hw.y), bfhi(hw.y)}; v1 = (f32x4){bflo(hw.z), bfhi(hw.z), bflo(hw.w), bfhi(hw.w)}; }
                    v0 += acc[ai][bj][m][0]; v1 += acc[ai][bj][m][1];
                    ss += ((v0.x * v0.x + v0.y * v0.y) + (v0.z * v0.z + v0.w * v0.w)) + ((v1.x * v1.x + v1.y * v1.y) + (v1.z * v1.z + v1.w * v1.w));
                    v4u w; w.x = pk2(v0.x, v0.y); w.y = pk2(v0.z, v0.w); w.z = pk2(v1.x, v1.y); w.w = pk2(v1.z, v1.w); *(v4u*)(rowp + bj * 128) = w; }
                ss += __shfl_xor(ss, 16); ss += __shfl_xor(ss, 32);
                if (fq == 0) rss[(size_t)row * 16 + u.pn * 4 + wc] = ss; }
    }
};
struct EpiConvIn {
    static constexpr bool PERM = true, AFTER_DRAIN = false;
    bf16* U; bf16* GB;
    __device__ __forceinline__ void operator()(const pg8::f32x4 (&acc)[2][2][4][2], const pg8::Unit& u, int wr, int wc, int fr, int fq) const {
        const int row0 = u.pm * 256 + wr * 64 + fr;
        if (u.pn < 8) {
            const int ch0 = u.pn * 128 + wc * 32 + 8 * fq;
#pragma unroll
            for (int ai = 0; ai < 2; ++ai)
#pragma unroll
                for (int m = 0; m < 4; ++m) { const f32x4 p0 = acc[ai][0][m][0] * acc[ai][1][m][0], p1 = acc[ai][0][m][1] * acc[ai][1][m][1];
                    v4u w; w.x = pk2(p0[0], p0[1]); w.y = pk2(p0[2], p0[3]); w.z = pk2(p1[0], p1[1]); w.w = pk2(p1[2], p1[3]);
                    *(v4u*)(U + (size_t)(row0 + ai * 128 + m * 16) * D + ch0) = w; }
        } else {
            const int col0 = (u.pn - 8) * 256 + wc * 32 + 8 * fq;
#pragma unroll
            for (int ai = 0; ai < 2; ++ai)
#pragma unroll
                for (int m = 0; m < 4; ++m)
#pragma unroll
                    for (int bj = 0; bj < 2; ++bj) { const f32x4 v0 = acc[ai][bj][m][0], v1 = acc[ai][bj][m][1];
                        v4u w; w.x = pk2(v0[0], v0[1]); w.y = pk2(v0[2], v0[3]); w.z = pk2(v1[0], v1[1]); w.w = pk2(v1[2], v1[3]);
                        *(v4u*)(GB + (size_t)(row0 + ai * 128 + m * 16) * D + col0 + bj * 128) = w; }
        }
    }
};
struct EpiF32 {
    static constexpr bool PERM = false, AFTER_DRAIN = false;
    float* O; int ldc;
    __device__ __forceinline__ void operator()(const pg8::f32x4 (&acc)[2][2][4][2], const pg8::Unit& u, int wr, int wc, int fr, int fq) const {
        const int col0 = u.pn * 256 + wc * 32 + 4 * fq;
#pragma unroll
        for (int ai = 0; ai < 2; ++ai)
#pragma unroll
            for (int m = 0; m < 4; ++m) { float* rowp = O + (size_t)(u.pm * 256 + ai * 128 + wr * 64 + m * 16 + fr) * ldc + col0;
#pragma unroll
                for (int bj = 0; bj < 2; ++bj)
#pragma unroll
                    for (int n = 0; n < 2; ++n) *(f32x4*)(rowp + bj * 128 + n * 16) = acc[ai][bj][m][n]; }
    }
};
struct EpiTopK {
    static constexpr bool PERM = false, AFTER_DRAIN = true;
    int* seli; float* selg; const float* rss;
    __device__ __forceinline__ void operator()(const pg8::f32x4 (&)[2][2][4][2], const pg8::Unit&, int, int, int, int) const {}
    __device__ __forceinline__ void fused(pg8::f32x4 (&acc)[2][2][4][2], const pg8::Unit& u, int wr, int wc, int fr, int fq, LAS unsigned char* lds, int wid, int lane) const {
        LAS float* S = (LAS float*)lds;
        LAS int* L = (LAS int*)lds;
        const int tid = wid * 64 + lane;
#pragma unroll 1
        for (int ai = 0; ai < 2; ++ai) {
#pragma unroll
            for (int m = 0; m < 4; ++m)
#pragma unroll
                for (int bj = 0; bj < 2; ++bj)
#pragma unroll
                    for (int n = 0; n < 2; ++n) {
                        const int row = wr * 64 + m * 16 + fr, col = bj * 128 + wc * 32 + n * 16 + 4 * fq;
                        *(LAS f32x4*)(S + row * 260 + col) = ai == 0 ? acc[0][bj][m][n] : acc[1][bj][m][n];
                    }
            BLOCK_BAR();
            const int row = tid & 127, q = tid >> 7;
            int best[16];
            {
                const LAS f32x4* sp = (const LAS f32x4*)(S + row * 260 + q * 64);
#pragma unroll
                for (int c = 0; c < 4; ++c) {
                    int x[16];
#pragma unroll
                    for (int e4 = 0; e4 < 4; ++e4) { const f32x4 v = sp[c * 4 + e4];
#pragma unroll
                        for (int e = 0; e < 4; ++e) x[e4 * 4 + e] = (tk_map(v[e]) & ~127) | (127 - ((q & 1) * 64 + c * 16 + e4 * 4 + e)); }
                    tk_sort_desc(x);
                    if (c == 0) {
#pragma unroll
                        for (int e = 0; e < 16; ++e) best[e] = x[e];
                    } else tk_merge_top(best, x);
                }
            }
            BLOCK_BAR();
#pragma unroll
            for (int e4 = 0; e4 < 4; ++e4) *(LAS v4u*)(L + row * 68 + q * 16 + e4 * 4) = (v4u){(unsigned)best[e4 * 4], (unsigned)best[e4 * 4 + 1], (unsigned)best[e4 * 4 + 2], (unsigned)best[e4 * 4 + 3]};
            BLOCK_BAR();
            if (tid < 128) {
                int a[16], b[16], t[16];
                LAS int* Lr = L + tid * 68;
#pragma unroll
                for (int e4 = 0; e4 < 4; ++e4) { const v4u va = *(LAS v4u*)(Lr + e4 * 4), vt = *(LAS v4u*)(Lr + 16 + e4 * 4);
#pragma unroll
                    for (int e = 0; e < 4; ++e) { a[e4 * 4 + e] = (int)va[e]; t[e4 * 4 + e] = (int)vt[e]; } }
                tk_merge_top(a, t);
#pragma unroll
                for (int e4 = 0; e4 < 4; ++e4) { const v4u vb = *(LAS v4u*)(Lr + 32 + e4 * 4), vt = *(LAS v4u*)(Lr + 48 + e4 * 4);
#pragma unroll
                    for (int e = 0; e < 4; ++e) { b[e4 * 4 + e] = (int)vb[e]; t[e4 * 4 + e] = (int)vt[e]; } }
                tk_merge_top(b, t);
                const int trow = u.pm * 256 + ai * 128 + tid;
                const f32x4 q0 = *(const f32x4*)(rss + (size_t)trow * 16), q1 = *(const f32x4*)(rss + (size_t)trow * 16 + 4), q2 = *(const f32x4*)(rss + (size_t)trow * 16 + 8), q3 = *(const f32x4*)(rss + (size_t)trow * 16 + 12);
                const float ssq = (((q0.x + q0.y) + (q0.z + q0.w)) + ((q1.x + q1.y) + (q1.z + q1.w))) + (((q2.x + q2.y) + (q2.z + q2.w)) + ((q3.x + q3.y) + (q3.z + q3.w)));
                const float rstd = 1.0f / sqrtf(ssq * (1.f / D) + RMS_EPS);
                const size_t o = ((size_t)trow * 8 + u.pn) * 16;
                tk_stage2(a, b, Lr, (__attribute__((address_space(1))) int*)(seli + o), (__attribute__((address_space(1))) float*)(selg + o), rstd);
            }
            BLOCK_BAR();
        }
    }
};
struct OneUnit {
    pg8::Unit u;
    __device__ __forceinline__ bool next(int i, pg8::Unit& o) const { if (i != 0) return false; o = u; return true; }
    __device__ __forceinline__ void a_ready(const pg8::Unit&) const {}
    __device__ __forceinline__ void done(const pg8::Unit&) const {}
};

__device__ __forceinline__ void p0_transpose_item(const float* W, int ldw, int ncols, bf16* WT, float scale, LAS float* scr, int item, int lane) {
    const int nblk = ncols / 64, kb = item / nblk, nb = item % nblk, k0 = 64 * kb, n0 = 64 * nb;
    f32x4 v[16];
#pragma unroll
    for (int i = 0; i < 16; ++i) v[i] = __builtin_nontemporal_load((const f32x4*)(W + (size_t)(k0 + 4 * i + (lane >> 4)) * ldw + n0 + 4 * (lane & 15)));
#pragma unroll
    for (int i = 0; i < 16; ++i) { LAS float* p = scr + (4 * i + (lane >> 4)) * 65 + 4 * (lane & 15); p[0] = v[i].x * scale; p[1] = v[i].y * scale; p[2] = v[i].z * scale; p[3] = v[i].w * scale; }
    LDS_WAIT(); asm volatile("" ::: "memory");
    const int c = lane & 7;
#pragma unroll
    for (int j = 0; j < 8; ++j) { const int n = (lane >> 3) + 8 * j; const LAS float* s = scr + (8 * c) * 65 + n;
        v4u o; o.x = pk2(s[0 * 65], s[1 * 65]); o.y = pk2(s[2 * 65], s[3 * 65]); o.z = pk2(s[4 * 65], s[5 * 65]); o.w = pk2(s[6 * 65], s[7 * 65]);
        *(v4u*)(WT + (size_t)(n0 + n) * 1024 + k0 + 8 * c) = o; }
    LDS_WAIT(); asm volatile("" ::: "memory");
}
__device__ __forceinline__ void rms_row_to_bf16(const float* xrow, const float* gain, bf16* orow, float* hcopy, int lane) {
    const f32x4* xr = (const f32x4*)xrow + lane; const f32x4* gr = (const f32x4*)gain + lane;
    f32x4 v[4]; float s = 0.f;
#pragma unroll
    for (int j = 0; j < 4; ++j) { v[j] = xr[64 * j]; s += (v[j].x * v[j].x + v[j].y * v[j].y) + (v[j].z * v[j].z + v[j].w * v[j].w); }
    if (hcopy) {
#pragma unroll
        for (int j = 0; j < 4; ++j) ((f32x4*)hcopy + lane)[64 * j] = v[j];
    }
    const float rstd = 1.0f / sqrtf(wave_sum(s) * (1.f / D) + RMS_EPS);
    unsigned long long* o8 = (unsigned long long*)orow + lane;
#pragma unroll
    for (int j = 0; j < 4; ++j) { const f32x4 g = gr[64 * j]; const f32x4 y = v[j] * rstd * g;
        o8[64 * j] = (unsigned long long)pk2(y.x, y.y) | ((unsigned long long)pk2(y.z, y.w) << 32); }
}
__device__ __forceinline__ void p0_dense(Frame& F, bool dry) {
    if (!(dry && PROBE_PMODE == 1)) {
        LAS float* KL = (LAS float*)F.lds;
        LAS float* WL = (LAS float*)(F.lds + 128 * 132 * 4);
        const float* in10 = F.in(10); const float* in11 = F.in(11); const float* in2 = F.in(2);
        f32x4 kreg[8], wreg[4];
#define FOLD_LOAD(it_) do { const int l_ = (it_) >> 8, hp_ = ((it_) >> 4) & 15, k0_ = ((it_) & 15) * 64; \
            const float* kg_ = in11 + (size_t)(l_ * 16 + hp_) * 128 * 128; const float* wg_ = in10 + (size_t)l_ * 1024 * 2048 + (size_t)k0_ * 2048 + hp_ * 128; \
            _Pragma("unroll") for (int i = 0; i < 8; ++i) kreg[i] = *(const f32x4*)(kg_ + 4 * (F.tid + 512 * i)); \
            _Pragma("unroll") for (int i = 0; i < 4; ++i) { const int e = 4 * (F.tid + 512 * i); wreg[i] = __builtin_nontemporal_load((const f32x4*)(wg_ + (size_t)(e >> 7) * 2048 + (e & 127))); } } while (0)
        if (F.vcu < DEPTH * 16 * 16) FOLD_LOAD(F.vcu);
        for (int it = F.vcu; it < DEPTH * 16 * 16; it += F.G) {
            const int l = it >> 8, hp = (it >> 4) & 15, k0 = (it & 15) * 64;
#pragma unroll
            for (int i = 0; i < 8; ++i) { const int e = 4 * (F.tid + 512 * i), n = e >> 7, d = e & 127; *(LAS f32x4*)(KL + n * 132 + d) = kreg[i]; }
#pragma unroll
            for (int i = 0; i < 4; ++i) { const int e = 4 * (F.tid + 512 * i), kk = e >> 7, d = e & 127; *(LAS f32x4*)(WL + kk * 132 + d) = wreg[i]; }
            if (it + F.G < DEPTH * 16 * 16) FOLD_LOAD(it + F.G);
            BLOCK_BAR();
            {
                const int i16 = F.lane & 15, g4 = F.lane >> 4, nt = F.wave;
                f32x4 facc[4];
#pragma unroll
                for (int mt = 0; mt < 4; ++mt) facc[mt] = (f32x4){0.f, 0.f, 0.f, 0.f};
#pragma unroll 2
                for (int s8 = 0; s8 < 8; ++s8) {
                    const f32x4 bq = *(const LAS f32x4*)(KL + (nt * 16 + i16) * 132 + 16 * s8 + 4 * g4);
                    f32x4 aq[4];
#pragma unroll
                    for (int mt = 0; mt < 4; ++mt) aq[mt] = *(const LAS f32x4*)(WL + (mt * 16 + i16) * 132 + 16 * s8 + 4 * g4);
#pragma unroll
                    for (int t = 0; t < 4; ++t)
#pragma unroll
                        for (int mt = 0; mt < 4; ++mt) facc[mt] = __builtin_amdgcn_mfma_f32_16x16x4f32(aq[mt][t], bq[t], facc[mt], 0, 0, 0);
                }
                bf16* o = (bf16*)(F.ws + WS_WP) + (size_t)l * 2048 * 1024 + (size_t)(hp * 128 + nt * 16 + i16) * 1024 + k0 + 4 * g4;
#pragma unroll
                for (int mt = 0; mt < 4; ++mt) { const f32x4 gf = *(const f32x4*)(in2 + (size_t)l * D + k0 + mt * 16 + 4 * g4); v2u w; w.x = pk2(facc[mt][0] * gf.x, facc[mt][1] * gf.y); w.y = pk2(facc[mt][2] * gf.z, facc[mt][3] * gf.w); *(v2u*)(o + mt * 16) = w; }
            }
            BLOCK_BAR();
        }
#undef FOLD_LOAD
    }
    LAS float* scr = (LAS float*)(F.lds + F.wave * 16640);
    const int gw = F.vcu * NWAVES + F.wave, NGW = F.G * NWAVES;
    constexpr int I_SQ = 16 * 16, I_IN = 16 * 48, PER_J = 3 * I_SQ + I_SQ + I_IN + I_SQ;
    if (!(dry && PROBE_PMODE == 2)) for (int it = gw; it < 2 * PER_J; it += NGW) {
        const int j = it / PER_J; int r = it % PER_J;
        const float* wqkv = F.in(4) + (size_t)j * 1024 * 3072;
        if (r < I_SQ) { p0_transpose_item(wqkv, 3072, 1024, (bf16*)(F.ws + WS_WQK) + (size_t)j * 2048 * 1024, 0.125f, scr, r, F.lane); continue; } r -= I_SQ;
        if (r < I_SQ) { p0_transpose_item(wqkv + 1024, 3072, 1024, (bf16*)(F.ws + WS_WQK) + (size_t)j * 2048 * 1024 + (size_t)1024 * 1024, 1.f, scr, r, F.lane); continue; } r -= I_SQ;
        if (r < I_SQ) { p0_transpose_item(wqkv + 2048, 3072, 1024, (bf16*)(F.ws + WS_WV) + (size_t)j * 1024 * 1024, 1.f, scr, r, F.lane); continue; } r -= I_SQ;
        if (r < I_SQ) { p0_transpose_item(F.in(5) + (size_t)j * 1024 * 1024, 1024, 1024, (bf16*)(F.ws + WS_WO) + (size_t)j * 1024 * 1024, 1.f, scr, r, F.lane); continue; } r -= I_SQ;
        if (r < I_IN) {
            const float* win = F.in(7) + (size_t)j * 1024 * 3072; bf16* wt = (bf16*)(F.ws + WS_WIN) + (size_t)j * 3072 * 1024;
            if (r < 512) { const int blk = r >> 5, pn = blk >> 1, which = blk & 1; p0_transpose_item(win + (which ? 2048 : 1024) + 128 * pn, 3072, 128, wt + (size_t)(256 * pn + 128 * which) * 1024, 1.f, scr, r & 31, F.lane); }
            else p0_transpose_item(win, 3072, 1024, wt + (size_t)2048 * 1024, 1.f, scr, r - 512, F.lane);
            continue; } r -= I_IN;
        p0_transpose_item(F.in(9) + (size_t)j * 1024 * 1024, 1024, 1024, (bf16*)(F.ws + WS_WOUT) + (size_t)j * 1024 * 1024, 1.f, scr, r, F.lane);
    }
}
__device__ __forceinline__ void p0_tables(Frame& F, bool dry) {
    const int gw = F.vcu * NWAVES + F.wave, NGW = F.G * NWAVES;
    if (!(dry && PROBE_PMODE == 3)) {
        constexpr int NROW = DEPTH * 16384;
        const float* in12 = F.in(12); const float* in13 = F.in(13);
#define XC_LOAD(v, r0_) do { const int tb_ = (r0_) >= NROW ? 1 : 0, rr_ = (r0_) - tb_ * NROW; const float* src_ = (tb_ ? in13 : in12) + (size_t)rr_ * 1024 + 4 * F.lane; \
            _Pragma("unroll") for (int u = 0; u < 4; ++u) _Pragma("unroll") for (int i = 0; i < 4; ++i) v[u][i] = __builtin_nontemporal_load((const f32x4*)(src_ + (size_t)u * 1024 + 256 * i)); } while (0)
#if EXPERT_FP4
#define XC_PACK(v, u, q, dstp) do { v2u w_; _Pragma("unroll") for (int jj = 0; jj < 2; ++jj) { unsigned t_ = 0u; \
                    t_ = __builtin_amdgcn_cvt_scalef32_pk_fp4_f32(t_, v[u][2 * jj].x * q, v[u][2 * jj].y * q, 1.0f, 0); t_ = __builtin_amdgcn_cvt_scalef32_pk_fp4_f32(t_, v[u][2 * jj].z * q, v[u][2 * jj].w * q, 1.0f, 1); \
                    t_ = __builtin_amdgcn_cvt_scalef32_pk_fp4_f32(t_, v[u][2 * jj + 1].x * q, v[u][2 * jj + 1].y * q, 1.0f, 2); t_ = __builtin_amdgcn_cvt_scalef32_pk_fp4_f32(t_, v[u][2 * jj + 1].z * q, v[u][2 * jj + 1].w * q, 1.0f, 3); w_[jj] = t_; } \
                *(v2u*)(dstp) = w_; } while (0)
        constexpr float QMAX = 6.0f;
#else
#define XC_PACK(v, u, q, dstp) do { v4u w_; _Pragma("unroll") for (int i = 0; i < 4; ++i) { unsigned t_ = 0u; t_ = __builtin_amdgcn_cvt_pk_fp8_f32(v[u][i].x * q, v[u][i].y * q, t_, false); t_ = __builtin_amdgcn_cvt_pk_fp8_f32(v[u][i].z * q, v[u][i].w * q, t_, true); w_[i] = t_; } \
                *(v4u*)(dstp) = w_; } while (0)
        constexpr float QMAX = 256.0f;
#endif
#define XC_I4(x_) ((unsigned)__float2int_rn(x_) & 15u)
#define XC_PACK_I4(v, u, q, dstp) do { v2u w_; _Pragma("unroll") for (int jj = 0; jj < 2; ++jj) { const f32x4 a_ = v[u][2 * jj] * q, b_ = v[u][2 * jj + 1] * q; \
                    w_[jj] = XC_I4(a_.x) | (XC_I4(a_.y) << 4) | (XC_I4(a_.z) << 8) | (XC_I4(a_.w) << 12) | (XC_I4(b_.x) << 16) | (XC_I4(b_.y) << 20) | (XC_I4(b_.z) << 24) | (XC_I4(b_.w) << 28); } \
                *(v2u*)(dstp) = w_; } while (0)
#define XC_CONV(v, r0_) do { const int tb_ = (r0_) >= NROW ? 1 : 0, rr_ = (r0_) - tb_ * NROW; \
            unsigned char* dst_ = F.ws + (tb_ ? WS_DN : WS_UP) + (size_t)rr_ * ROWB + (ROWB / 64) * F.lane; float* sc_ = (float*)(F.ws + WS_SUP) + 2 * (size_t)rr_ + tb_; \
            _Pragma("unroll") for (int u = 0; u < 4; ++u) { float mx = 0.f; \
                _Pragma("unroll") for (int i = 0; i < 4; ++i) mx = fmaxf(fmaxf(mx, fmaxf(fabsf(v[u][i].x), fabsf(v[u][i].y))), fmaxf(fabsf(v[u][i].z), fabsf(v[u][i].w))); \
                _Pragma("unroll") for (int o = 1; o < 64; o <<= 1) mx = fmaxf(mx, __shfl_xor(mx, o)); \
                if (tb_) { const float q = mx > 0.f ? 7.0f / mx : 1.0f; XC_PACK_I4(v, u, q, dst_ + (size_t)u * ROWB); if (F.lane == 0) sc_[2 * u] = mx > 0.f ? mx * (1.0f / 7.0f) : 1.0f; } \
                else { const float q = mx > 0.f ? QMAX / mx : 1.0f; XC_PACK(v, u, q, dst_ + (size_t)u * ROWB); if (F.lane == 0) sc_[2 * u] = mx > 0.f ? mx * (1.0f / QMAX) : 1.0f; } } } while (0)
        const int stepr = NGW * 4;
        f32x4 va[4][4], vb[4][4];
        int r0 = gw * 4;
        if (r0 < 2 * NROW) XC_LOAD(va, r0);
#pragma unroll 1
        for (; r0 < 2 * NROW; r0 += 2 * stepr) {
            if (r0 + stepr < 2 * NROW) XC_LOAD(vb, r0 + stepr);
            XC_CONV(va, r0);
            if (r0 + 2 * stepr < 2 * NROW) XC_LOAD(va, r0 + 2 * stepr);
            if (r0 + stepr < 2 * NROW) XC_CONV(vb, r0 + stepr);
        }
#undef XC_LOAD
#undef XC_PACK
#undef XC_PACK_I4
#undef XC_I4
#undef XC_CONV
    }
}
__device__ __forceinline__ void p0_prologue(Frame& F, bool dry) {
    if (((int)blockIdx.x >> 3) & 1) { p0_tables(F, dry); p0_dense(F, dry); } else { p0_dense(F, dry); p0_tables(F, dry); }
    const int gw = F.vcu * NWAVES + F.wave, NGW = F.G * NWAVES;
    if (!(dry && PROBE_PMODE == 4)) {
        const float* x0 = F.in(0); const f32x4* gr = (const f32x4*)F.in(1) + F.lane;
        f32x4 gq[4];
#pragma unroll
        for (int j = 0; j < 4; ++j) gq[j] = gr[64 * j];
#pragma unroll 1
        for (int m0 = gw; m0 < M; m0 += 4 * NGW) {
            f32x4 v[4][4];
#pragma unroll
            for (int u = 0; u < 4; ++u) { const int m = m0 + u * NGW; if (m < M) {
#pragma unroll
                for (int j = 0; j < 4; ++j) v[u][j] = __builtin_nontemporal_load((const f32x4*)(x0 + (size_t)m * D) + F.lane + 64 * j); } }
#pragma unroll
            for (int u = 0; u < 4; ++u) { const int m = m0 + u * NGW; if (m < M) {
                float sq = 0.f;
#pragma unroll
                for (int j = 0; j < 4; ++j) { sq += (v[u][j].x * v[u][j].x + v[u][j].y * v[u][j].y) + (v[u][j].z * v[u][j].z + v[u][j].w * v[u][j].w); }
                const float rstd = 1.0f / sqrtf(wave_sum(sq) * (1.f / D) + RMS_EPS);
                unsigned long long* o8 = (unsigned long long*)((bf16*)(F.ws + WS_HN) + (size_t)m * D) + F.lane;
#pragma unroll
                for (int j = 0; j < 4; ++j) { const f32x4 y = v[u][j] * rstd * gq[j]; o8[64 * j] = (unsigned long long)pk2(y.x, y.y) | ((unsigned long long)pk2(y.z, y.w) << 32); } } }
        }
    }
}

__device__ __forceinline__ void conv_phase(Frame& F, int j) {
    const bf16* U = (const bf16*)(F.ws + WS_BIG); const bf16* GB = (const bf16*)(F.ws + WS_BIG + 32 * MiB); bf16* mix = (bf16*)(F.ws + WS_MIX);
    const float* wc = F.in(8) + (size_t)j * 3 * 1024;
    for (int idx = F.vcu * NTHR + F.tid; idx < M * 128; idx += F.G * NTHR) {
        const int t = idx >> 7, c8 = (idx & 127) * 8, s = t & (SEQ - 1);
        const v4u gb = *(const v4u*)(GB + (size_t)t * D + c8);
        float conv[8];
#pragma unroll
        for (int e = 0; e < 8; ++e) conv[e] = 0.f;
#pragma unroll
        for (int dj = -1; dj <= 1; ++dj) {
            if (s + dj >= 0 && s + dj < SEQ) {
                const v4u uu = *(const v4u*)(U + (size_t)(t + dj) * D + c8);
                const f32x4 w0 = *(const f32x4*)(wc + (dj + 1) * 1024 + c8), w1 = *(const f32x4*)(wc + (dj + 1) * 1024 + c8 + 4);
#pragma unroll
                for (int e2 = 0; e2 < 4; ++e2) {
                    const float wl = e2 < 2 ? w0[2 * e2] : w1[2 * e2 - 4], wh = e2 < 2 ? w0[2 * e2 + 1] : w1[2 * e2 - 3];
                    conv[2 * e2] += wl * bflo(uu[e2]); conv[2 * e2 + 1] += wh * bfhi(uu[e2]);
                }
            }
        }
        v4u o;
#pragma unroll
        for (int e2 = 0; e2 < 4; ++e2) o[e2] = pk2(bflo(gb[e2]) * conv[2 * e2], bfhi(gb[e2]) * conv[2 * e2 + 1]);
        *(v4u*)(mix + (size_t)t * 1024 + c8) = o;
    }
}

constexpr int AT_KSTR = 144, AT_VSTR = 1168, AT_KOFF = 0, AT_VOFF = 576 * AT_KSTR, AT_BOFF = AT_VOFF + 64 * AT_VSTR;
static_assert(AT_BOFF + 1860 <= PTAB_OFF, "attention LDS map");
__device__ __forceinline__ void attn_phase(Frame& F, int j) {
    const bf16* QK = (const bf16*)(F.ws + WS_BIG); const bf16* VT = (const bf16*)(F.ws + WS_VT); bf16* mix = (bf16*)(F.ws + WS_MIX);
    const float* biasl = F.in(6) + (size_t)j * NH * 15 * 31;
    const int lane = F.lane, q = lane & 15, g = lane >> 4, tid = F.tid;
    LAS unsigned char* KL = F.lds + AT_KOFF; LAS unsigned char* VL = F.lds + AT_VOFF; LAS float* btab = (LAS float*)(F.lds + AT_BOFF);
    v4u kreg[9], vreg[9];
    int cur_hh = -1;
#define AT_DECODE(it, b_, hh_, r0_, R0_) const int hh_ = (it) & 15, rp_##it = ((it) >> 4) & 63, b_ = (it) >> 10, r0_ = 2 * rp_##it; int R0_ = r0_ - 4; R0_ = R0_ < 0 ? 0 : (R0_ > NROWS - 8 ? NROWS - 8 : R0_);
#define AT_PREFETCH(it) do { AT_DECODE(it, pb, phh, pr0, pR0) \
        _Pragma("unroll") for (int i = 0; i < 9; ++i) { const int c = tid + 512 * i; \
            { const int key = c >> 3, ch = c & 7; int row = pR0 + (key >> 6); row = row > NROWS - 1 ? NROWS - 1 : row; \
              kreg[i] = *(const v4u*)(QK + ((size_t)pb * SEQ + row * 64 + (key & 63)) * 2048 + 1024 + phh * 64 + ch * 8); } \
            { const int d = c / 72, kch = c - d * 72; vreg[i] = *(const v4u*)(VT + (size_t)(phh * 64 + d) * M + (size_t)pb * SEQ + pR0 * 64 + kch * 8); } } } while (0)
    int it = F.vcu;
    if (it < 2048) AT_PREFETCH(it);
    for (; it < 2048; it += F.G) {
        AT_DECODE(it, b, hh, r0, R0)
        BLOCK_BAR();
#pragma unroll
        for (int i = 0; i < 9; ++i) { const int c = tid + 512 * i;
            *(LAS v4u*)(KL + (c >> 3) * AT_KSTR + (c & 7) * 16) = kreg[i];
            const int d = c / 72, kch = c - d * 72; *(LAS v4u*)(VL + d * AT_VSTR + kch * 16) = vreg[i]; }
        if (hh != cur_hh) { if (tid < 465) btab[tid] = biasl[(size_t)hh * 465 + tid]; cur_hh = hh; }
        BLOCK_BAR();
        const int r = r0 + (F.wave >> 2), jb = F.wave & 3;
        int rs = r - 4; rs = rs < 0 ? 0 : (rs > NROWS - 8 ? NROWS - 8 : rs);
        const int lr0 = rs - R0;
        int bs = 16 * jb - 8; bs = bs < 0 ? 0 : (bs > 32 ? 32 : bs);
        const int qc = 16 * jb + q; int wst = qc - 8; wst = wst < 0 ? 0 : (wst > 48 ? 48 : wst);
        const size_t tokq = (size_t)b * SEQ + r * 64 + qc;
        bf16x8 qf[2];
#pragma unroll
        for (int ks = 0; ks < 2; ++ks) qf[ks] = *(const bf16x8*)(QK + tokq * 2048 + hh * 64 + ks * 32 + 8 * g);
        f32x4 S[8][2];
        const int kcl_a = 8 * (q >> 2) + (q & 3);
#pragma unroll
        for (int wr = 0; wr < 8; ++wr)
#pragma unroll
            for (int T = 0; T < 2; ++T) {
                const LAS unsigned char* kp = KL + ((lr0 + wr) * 64 + bs + kcl_a + 4 * T) * AT_KSTR + 16 * g;
                const bf16x8 k0 = *(const LAS bf16x8*)kp, k1 = *(const LAS bf16x8*)(kp + 64);
                f32x4 c = (f32x4){0.f, 0.f, 0.f, 0.f};
                c = __builtin_amdgcn_mfma_f32_16x16x32_bf16(k0, qf[0], c, 0, 0, 0);
                c = __builtin_amdgcn_mfma_f32_16x16x32_bf16(k1, qf[1], c, 0, 0, 0);
                S[wr][T] = c;
            }
        float mx = -3.0e38f;
#pragma unroll
        for (int wr = 0; wr < 8; ++wr) {
            const LAS float* brow = btab + (rs + wr - r + 7) * 31;
#pragma unroll
            for (int T = 0; T < 2; ++T)
#pragma unroll
                for (int i = 0; i < 4; ++i) {
                    const int kc = bs + 8 * g + 4 * T + i;
                    int co = kc - qc + 15; co = co < 0 ? 0 : (co > 30 ? 30 : co);
                    const bool valid = (kc >= wst) && (kc < wst + 16);
                    const float v = valid ? S[wr][T][i] + brow[co] : -1e30f;
                    S[wr][T][i] = v; mx = fmaxf(mx, v);
                }
        }
        mx = fmaxf(mx, __shfl_xor(mx, 16)); mx = fmaxf(mx, __shfl_xor(mx, 32));
        float sum = 0.f;
        bf16x8 pf[8];
#pragma unroll
        for (int wr = 0; wr < 8; ++wr) {
            float p[8];
#pragma unroll
            for (int T = 0; T < 2; ++T)
#pragma unroll
                for (int i = 0; i < 4; ++i) { p[4 * T + i] = __expf(S[wr][T][i] - mx); sum += p[4 * T + i]; }
            v4u w; w.x = pk2(p[0], p[1]); w.y = pk2(p[2], p[3]); w.z = pk2(p[4], p[5]); w.w = pk2(p[6], p[7]);
            pf[wr] = __builtin_bit_cast(bf16x8, w);
        }
        sum += __shfl_xor(sum, 16); sum += __shfl_xor(sum, 32);
        if (it + F.G < 2048) { const int nit = it + F.G; AT_PREFETCH(nit); }
        f32x4 O[4];
#pragma unroll
        for (int dt = 0; dt < 4; ++dt) O[dt] = (f32x4){0.f, 0.f, 0.f, 0.f};
#pragma unroll
        for (int wr = 0; wr < 8; ++wr)
#pragma unroll
            for (int dt = 0; dt < 4; ++dt) {
                const bf16x8 vf = *(const LAS bf16x8*)(VL + (dt * 16 + q) * AT_VSTR + ((lr0 + wr) * 64 + bs + 8 * g) * 2);
                O[dt] = __builtin_amdgcn_mfma_f32_16x16x32_bf16(vf, pf[wr], O[dt], 0, 0, 0);
            }
        const float inv = 1.0f / sum;
#pragma unroll
        for (int dt = 0; dt < 4; ++dt) { v2u w; w.x = pk2(O[dt][0] * inv, O[dt][1] * inv); w.y = pk2(O[dt][2] * inv, O[dt][3] * inv);
            *(v2u*)(mix + tokq * 1024 + hh * 64 + dt * 16 + 4 * g) = w; }
    }
#undef AT_DECODE
#undef AT_PREFETCH
    BLOCK_BAR();
}
#if NAIVE_ATTN
__device__ __forceinline__ void attn_naive_phase(Frame& F, int j) {
    const bf16* QK = (const bf16*)(F.ws + WS_BIG); const bf16* VT = (const bf16*)(F.ws + WS_VT); bf16* mix = (bf16*)(F.ws + WS_MIX);
    const float* biasl = F.in(6) + (size_t)j * NH * 15 * 31;
    for (int idx = F.vcu * NTHR + F.tid; idx < M * NH; idx += F.G * NTHR) {
        const int hh = idx & 15, t = idx >> 4, b = t >> 13, s = t & (SEQ - 1), r = s >> 6, qc = s & 63;
        int rs = r - 4; rs = rs < 0 ? 0 : (rs > NROWS - 8 ? NROWS - 8 : rs);
        int wst = qc - 8; wst = wst < 0 ? 0 : (wst > 48 ? 48 : wst);
        float qv[64];
#pragma unroll
        for (int c = 0; c < 8; ++c) { const v4u w = *(const v4u*)(QK + (size_t)t * 2048 + hh * 64 + c * 8);
#pragma unroll
            for (int e = 0; e < 4; ++e) { qv[c * 8 + 2 * e] = bflo(w[e]); qv[c * 8 + 2 * e + 1] = bfhi(w[e]); } }
        float mrun = -3.0e38f, lrun = 0.f, o[64];
#pragma unroll
        for (int d = 0; d < 64; ++d) o[d] = 0.f;
        for (int wr = 0; wr < 8; ++wr)
            for (int kk = 0; kk < 16; ++kk) {
                const int kc = wst + kk; const size_t tk = (size_t)b * SEQ + (rs + wr) * 64 + kc;
                float sd = 0.f;
#pragma unroll
                for (int c = 0; c < 8; ++c) { const v4u w = *(const v4u*)(QK + tk * 2048 + 1024 + hh * 64 + c * 8);
#pragma unroll
                    for (int e = 0; e < 4; ++e) sd += qv[c * 8 + 2 * e] * bflo(w[e]) + qv[c * 8 + 2 * e + 1] * bfhi(w[e]); }
                int co = kc - qc + 15; co = co < 0 ? 0 : (co > 30 ? 30 : co);
                sd += biasl[(size_t)hh * 465 + (rs + wr - r + 7) * 31 + co];
                const float mn = fmaxf(mrun, sd), al = __expf(mrun - mn), p = __expf(sd - mn);
                lrun = lrun * al + p; mrun = mn;
#pragma unroll
                for (int d = 0; d < 64; ++d) o[d] = o[d] * al + p * bflo((unsigned)VT[(size_t)(hh * 64 + d) * M + tk]);
            }
        const float inv = 1.0f / lrun;
#pragma unroll
        for (int c = 0; c < 8; ++c) { v4u w;
#pragma unroll
            for (int e = 0; e < 4; ++e) w[e] = pk2(o[c * 8 + 2 * e] * inv, o[c * 8 + 2 * e + 1] * inv);
            *(v4u*)(mix + (size_t)t * 1024 + hh * 64 + c * 8) = w; }
    }
}
#endif
#if NAIVE_TOPK
__device__ __forceinline__ void select_naive_phase(Frame& F) {
    const float* SC = (const float*)(F.ws + WS_SC); int* seli = (int*)(F.ws + WS_SELI); float* selg = (float*)(F.ws + WS_SELG);
    LAS int* AB = (LAS int*)F.lds + F.tid * 33;
    for (int idx = F.vcu * NTHR + F.tid; idx < M * 8; idx += F.G * NTHR) {
        const float* s = SC + (size_t)idx * 256;
        int a[16], b[16], t[16];
        tk_stage1<4>(s, 0, a); tk_stage1<4>(s + 64, 64, t); tk_merge_top(a, t);
        tk_stage1<4>(s + 128, 0, b); tk_stage1<4>(s + 192, 64, t); tk_merge_top(b, t);
        tk_stage2(a, b, AB, seli + (size_t)idx * 16, selg + (size_t)idx * 16);
    }
}
#endif

__device__ __forceinline__ float gelu_erf(float a) { return 0.5f * a * (1.0f + erff(a * 0.70710678118654752f)); }
typedef float f32x2g __attribute__((ext_vector_type(2)));
#if EXPERT_FP4
typedef v2u rowv;
__device__ __forceinline__ rowv row_load(const unsigned char* T, int e, int lane) { return *(const v2u*)(T + (size_t)e * ROWB + 8 * lane); }
#define ROW_PAIR(r, m) __builtin_amdgcn_cvt_scalef32_pk_f32_fp4((r)[(m) >> 2], 1.0f, (m) & 3)
#else
typedef v4u rowv;
__device__ __forceinline__ rowv row_load(const unsigned char* T, int e, int lane) { return *(const v4u*)(T + (size_t)e * ROWB + 16 * lane); }
#define ROW_PAIR(r, m) __builtin_amdgcn_cvt_pk_f32_fp8((r)[(m) >> 1], ((m) & 1) != 0)
#endif
__device__ __forceinline__ void row_axpy(f32x2g (&out)[8], const rowv d, float ak) {
    const f32x2g a2 = (f32x2g){ak, ak};
    out[0] = __builtin_elementwise_fma(a2, ROW_PAIR(d, 0), out[0]); out[1] = __builtin_elementwise_fma(a2, ROW_PAIR(d, 1), out[1]); out[2] = __builtin_elementwise_fma(a2, ROW_PAIR(d, 2), out[2]); out[3] = __builtin_elementwise_fma(a2, ROW_PAIR(d, 3), out[3]);
    out[4] = __builtin_elementwise_fma(a2, ROW_PAIR(d, 4), out[4]); out[5] = __builtin_elementwise_fma(a2, ROW_PAIR(d, 5), out[5]); out[6] = __builtin_elementwise_fma(a2, ROW_PAIR(d, 6), out[6]); out[7] = __builtin_elementwise_fma(a2, ROW_PAIR(d, 7), out[7]);
}
typedef int v8i_g __attribute__((ext_vector_type(8)));
typedef unsigned char u8x4g __attribute__((ext_vector_type(4)));
#define TR_SHUF(a, b, i0, i1, i2, i3) __builtin_amdgcn_perm((unsigned)(b), (unsigned)(a), (unsigned)((i0) | ((i1) << 8) | ((i2) << 16) | ((i3) << 24)))
__device__ __forceinline__ void tr8_nib(const unsigned (&w)[8], unsigned (&t)[8]) {
    unsigned x[8], y[8];
#pragma unroll
    for (int r = 0; r < 4; ++r) { x[r] = TR_SHUF(w[r], w[r + 4], 0, 1, 4, 5); x[r + 4] = TR_SHUF(w[r], w[r + 4], 2, 3, 6, 7); }
#pragma unroll
    for (int g = 0; g < 2; ++g)
#pragma unroll
        for (int r = 0; r < 2; ++r) { y[4 * g + r] = TR_SHUF(x[4 * g + r], x[4 * g + r + 2], 0, 4, 2, 6); y[4 * g + r + 2] = TR_SHUF(x[4 * g + r], x[4 * g + r + 2], 1, 5, 3, 7); }
#pragma unroll
    for (int p = 0; p < 4; ++p) { const unsigned e = y[2 * p], o = y[2 * p + 1];
        t[2 * p] = (e & 0x0F0F0F0Fu) | ((o << 4) & 0xF0F0F0F0u);
        t[2 * p + 1] = ((e >> 4) & 0x0F0F0F0Fu) | (o & 0xF0F0F0F0u); }
}
__device__ __forceinline__ int sel2(bool hf, int e0, int e1) { return hf ? e1 : e0; }
template <int PART> __device__ __forceinline__ void gather_phase(Frame& F, int layer, bool dry) {
    const unsigned char* UP = F.ws + WS_UP + (size_t)layer * 16384 * ROWB; const unsigned char* DN = F.ws + WS_DN + (size_t)layer * 16384 * ROWB;
    const f32x2g* SC2 = (const f32x2g*)(F.ws + WS_SUP) + (size_t)layer * 16384;
    const float* gain = F.in(2) + (size_t)layer * D; const float* gnext = layer < DEPTH - 1 ? F.in(1) + (size_t)(layer + 1) * D : F.in(3);
    float* outp = F.out();
    const int* seli = (const int*)(F.ws + WS_SELI); const float* selg = (const float*)(F.ws + WS_SELG);
    const float* ACTG = (const float*)(F.ws + WS_ACTG); float* ACTW = (float*)(F.ws + (dry ? WS_SC : WS_ACTG));
    const bf16* H = (const bf16*)(F.ws + WS_H); bf16* HN = (bf16*)(F.ws + (dry ? WS_SC + 64 * MiB : WS_HN)); bf16* HW = (bf16*)(F.ws + (dry ? WS_SC : WS_H)); if (dry) outp = (float*)(F.ws + WS_SC);
    const int lane = F.lane, gw = F.vcu * NWAVES + F.wave, NGW = F.G * NWAVES;
    const bool b5 = lane & 32, b4 = lane & 16, b3 = lane & 8, b2 = lane & 4;
    constexpr int G_RS = 528, G_RB = 32 * G_RS, G_NSLOT = 4;
    LAS unsigned char* RB = F.lds + F.wave * G_RB;
    LAS float* ACT = (LAS float*)(F.lds + 8 * G_RB + F.wave * 512);
    LAS int* SELB = (LAS int*)(F.lds + 8 * G_RB + 8 * 512 + 8 * 1024 + F.wave * 512);
    static_assert(8 * G_RB + 8 * 512 + 8 * 1024 + 8 * 512 <= PTAB_OFF, "gather LDS map");
#pragma unroll 1
    for (int base = gw; base < M; base += G_NSLOT * NGW) {
    LAS unsigned char* X8 = F.lds + 8 * G_RB + 8 * 512 + F.wave * 1024;
    const int n16 = lane & 15, g4 = lane >> 4;
    const bool hf = lane >> 5; const int c32 = lane & 31, sg = 2 * c32 + (hf ? 1 : 0);
    v2u nhb[4]; int nidx_lo = 0, nidx_hi = 0; float ng_lo = 0.f, ng_hi = 0.f, na_lo = 0.f, na_hi = 0.f;
#define TOK_LOAD(t_) do { const bf16* hr_ = H + (size_t)(t_) * D + 4 * sg; _Pragma("unroll") for (int i = 0; i < 4; ++i) nhb[i] = __builtin_nontemporal_load((const v2u*)(hr_ + 256 * i)); \
        nidx_lo = __builtin_nontemporal_load(seli + (size_t)(t_) * 128 + lane); nidx_hi = __builtin_nontemporal_load(seli + (size_t)(t_) * 128 + 64 + lane); ng_lo = __builtin_nontemporal_load(selg + (size_t)(t_) * 128 + lane); ng_hi = __builtin_nontemporal_load(selg + (size_t)(t_) * 128 + 64 + lane); if (PART == 2) { na_lo = __builtin_nontemporal_load(ACTG + (size_t)(t_) * 128 + lane); na_hi = __builtin_nontemporal_load(ACTG + (size_t)(t_) * 128 + 64 + lane); } } while (0)
    if (base < M) TOK_LOAD(base);
#pragma unroll 1
    for (int slot = 0; slot < G_NSLOT; ++slot) {
        const int t = base + slot * NGW; if (t >= M) break;
        f32x4 hv[4];
#pragma unroll
        for (int i = 0; i < 4; ++i) { const unsigned w0_ = nhb[i].x, w1_ = nhb[i].y; hv[i] = (f32x4){bflo(w0_), bfhi(w0_), bflo(w1_), bfhi(w1_)}; }
        const int idx_lo = nidx_lo, idx_hi = nidx_hi; const float g_lo = ng_lo, g_hi = ng_hi, pa_lo = na_lo, pa_hi = na_hi;
        if (slot + 1 < G_NSLOT && t + NGW < M) TOK_LOAD(t + NGW);
        float xinv = 1.0f;
        if (PART != 2) {
        float ss = 0.f;
#pragma unroll
        for (int i = 0; i < 4; ++i) ss += (hv[i].x * hv[i].x + hv[i].y * hv[i].y) + (hv[i].z * hv[i].z + hv[i].w * hv[i].w);
        const float rstd = 1.0f / sqrtf(wave_sum(ss) * (1.f / D) + RMS_EPS);
        float xmax = 0.f;
        f32x4 xv[4];
#pragma unroll
        for (int i = 0; i < 4; ++i) { const f32x4 g = *(const f32x4*)(gain + 256 * i + 4 * sg); xv[i] = hv[i] * rstd * g;
            xmax = fmaxf(fmaxf(xmax, fmaxf(fabsf(xv[i].x), fabsf(xv[i].y))), fmaxf(fabsf(xv[i].z), fabsf(xv[i].w))); }
#pragma unroll
        for (int o = 1; o < 64; o <<= 1) xmax = fmaxf(xmax, __shfl_xor(xmax, o));
        const float qx = xmax > 0.f ? 256.0f / xmax : 1.0f; xinv = xmax > 0.f ? xmax * (1.0f / 256.0f) : 1.0f;
        {
            v4u w;
#pragma unroll
            for (int i = 0; i < 4; ++i) { unsigned tt = 0u; tt = __builtin_amdgcn_cvt_pk_fp8_f32(xv[i].x * qx, xv[i].y * qx, tt, false); tt = __builtin_amdgcn_cvt_pk_fp8_f32(xv[i].z * qx, xv[i].w * qx, tt, true); w[i] = tt; }
            *(LAS v4u*)(X8 + 16 * sg) = w;
        }
        }
        SELB[(lane & 1) * 64 + (lane >> 1)] = idx_lo; SELB[(lane & 1) * 64 + 32 + (lane >> 1)] = idx_hi;
        LDS_WAIT(); asm volatile("" ::: "memory");
#define UP_LOAD(buf, hq) do { const LAS v4u* ip_ = (const LAS v4u*)(SELB + (hf ? 64 : 0) + 16 * (hq)); v4u i4_[4]; _Pragma("unroll") for (int k = 0; k < 4; ++k) i4_[k] = ip_[k]; \
        _Pragma("unroll") for (int k = 0; k < 16; ++k) buf[k] = *(const v4u*)(UP + (unsigned)(i4_[k >> 2][k & 3] * ROWB + 16 * c32)); } while (0)
#define DN_LOAD(buf, hb) do { const LAS v4u* ip_ = (const LAS v4u*)(SELB + (hf ? 64 : 0) + 8 * (hb)); v4u i4_[2]; i4_[0] = ip_[0]; i4_[1] = ip_[1]; \
        _Pragma("unroll") for (int k = 0; k < 8; ++k) buf[k] = *(const v4u*)(DN + (unsigned)(i4_[k >> 2][k & 3] * ROWB + 16 * c32)); } while (0)
        v4u da[8];
        if (PART != 2) {
            v4u ur[16];
            UP_LOAD(ur, 0);
#define UP_NEXT UP_LOAD(ur, hq + 1)
#pragma unroll 1
            for (int hq = 0; hq < 3; ++hq) {
                const int sel = hq < 2 ? idx_lo : idx_hi; const float gsel = hq < 2 ? g_lo : g_hi; const int lb0 = (hq & 1) * 32;
#pragma unroll
                for (int k = 0; k < 16; ++k) *(LAS v4u*)(RB + (2 * k + (hf ? 1 : 0)) * G_RS + 16 * c32) = ur[k];
                float sc[4];
#pragma unroll
                for (int hh_ = 0; hh_ < 2; ++hh_) { const int ek_ = __shfl(sel, lb0 + hh_ * 16 + 4 * g4 + (n16 & 3)); const f32x2g s2_ = SC2[ek_]; sc[2 * hh_] = s2_.x; sc[2 * hh_ + 1] = s2_.y; }
                LDS_WAIT(); asm volatile("" ::: "memory");
                UP_NEXT;
                f32x4 cc[2]; cc[0] = (f32x4){0.f, 0.f, 0.f, 0.f}; cc[1] = cc[0];
#pragma unroll
                for (int s8 = 0; s8 < 8; ++s8) { const v4u b0 = *(const LAS v4u*)(X8 + 128 * s8 + 16 * g4), b1 = *(const LAS v4u*)(X8 + 128 * s8 + 64 + 16 * g4);
                    const v8i_g bq = (v8i_g){(int)b0.x, (int)b0.y, (int)b0.z, (int)b0.w, (int)b1.x, (int)b1.y, (int)b1.z, (int)b1.w};
#pragma unroll
                    for (int hh_ = 0; hh_ < 2; ++hh_) { const v4u a4 = *(const LAS v4u*)(RB + (hh_ * 16 + n16) * G_RS + 64 * s8 + 16 * g4); const v8i_g a8 = (v8i_g){(int)a4.x, (int)a4.y, (int)a4.z, (int)a4.w, 0, 0, 0, 0};
                        cc[hh_] = __builtin_amdgcn_mfma_scale_f32_16x16x128_f8f6f4(a8, bq, cc[hh_], 4, 0, 0, 0x7f7f7f7f, 0, 0x7f7f7f7f); } }
#pragma unroll
                for (int hh_ = 0; hh_ < 2; ++hh_) { const int lb = lb0 + hh_ * 16; const f32x4 c = cc[hh_];
                    const int r_ = n16 & 3, k_ = 4 * g4 + r_;
                    const float my = r_ == 0 ? c[0] : (r_ == 1 ? c[1] : (r_ == 2 ? c[2] : c[3]));
                    const float gate = __shfl(gsel, lb + k_);
                    const float act = gelu_erf(my * sc[2 * hh_] * xinv) * gate * sc[2 * hh_ + 1];
                    if (n16 < 4) ACT[hq * 32 + hh_ * 16 + k_] = act; }
                LDS_WAIT(); asm volatile("" ::: "memory");
            }
#undef UP_NEXT
#define UP_NEXT do { if (PART == 0) DN_LOAD(da, 0); } while (0)
            { const int hq = 3;
                const int sel = hq < 2 ? idx_lo : idx_hi; const float gsel = hq < 2 ? g_lo : g_hi; const int lb0 = (hq & 1) * 32;
#pragma unroll
                for (int k = 0; k < 16; ++k) *(LAS v4u*)(RB + (2 * k + (hf ? 1 : 0)) * G_RS + 16 * c32) = ur[k];
                float sc[4];
#pragma unroll
                for (int hh_ = 0; hh_ < 2; ++hh_) { const int ek_ = __shfl(sel, lb0 + hh_ * 16 + 4 * g4 + (n16 & 3)); const f32x2g s2_ = SC2[ek_]; sc[2 * hh_] = s2_.x; sc[2 * hh_ + 1] = s2_.y; }
                LDS_WAIT(); asm volatile("" ::: "memory");
                UP_NEXT;
                f32x4 cc[2]; cc[0] = (f32x4){0.f, 0.f, 0.f, 0.f}; cc[1] = cc[0];
#pragma unroll
                for (int s8 = 0; s8 < 8; ++s8) { const v4u b0 = *(const LAS v4u*)(X8 + 128 * s8 + 16 * g4), b1 = *(const LAS v4u*)(X8 + 128 * s8 + 64 + 16 * g4);
                    const v8i_g bq = (v8i_g){(int)b0.x, (int)b0.y, (int)b0.z, (int)b0.w, (int)b1.x, (int)b1.y, (int)b1.z, (int)b1.w};
#pragma unroll
                    for (int hh_ = 0; hh_ < 2; ++hh_) { const v4u a4 = *(const LAS v4u*)(RB + (hh_ * 16 + n16) * G_RS + 64 * s8 + 16 * g4); const v8i_g a8 = (v8i_g){(int)a4.x, (int)a4.y, (int)a4.z, (int)a4.w, 0, 0, 0, 0};
                        cc[hh_] = __builtin_amdgcn_mfma_scale_f32_16x16x128_f8f6f4(a8, bq, cc[hh_], 4, 0, 0, 0x7f7f7f7f, 0, 0x7f7f7f7f); } }
#pragma unroll
                for (int hh_ = 0; hh_ < 2; ++hh_) { const int lb = lb0 + hh_ * 16; const f32x4 c = cc[hh_];
                    const int r_ = n16 & 3, k_ = 4 * g4 + r_;
                    const float my = r_ == 0 ? c[0] : (r_ == 1 ? c[1] : (r_ == 2 ? c[2] : c[3]));
                    const float gate = __shfl(gsel, lb + k_);
                    const float act = gelu_erf(my * sc[2 * hh_] * xinv) * gate * sc[2 * hh_ + 1];
                    if (n16 < 4) ACT[hq * 32 + hh_ * 16 + k_] = act; }
                LDS_WAIT(); asm volatile("" ::: "memory");
            }
#undef UP_NEXT
        }
#undef UP_LOAD
        LDS_WAIT(); asm volatile("" ::: "memory");
        if (PART == 1) { const float w_lo = ACT[lane], w_hi = ACT[64 + lane]; ACTW[(size_t)t * 128 + lane] = w_lo; ACTW[(size_t)t * 128 + 64 + lane] = w_hi; continue; }
        if (PART == 2) DN_LOAD(da, 0);
        const float a_lo = PART == 2 ? pa_lo : ACT[lane], a_hi = PART == 2 ? pa_hi : ACT[64 + lane];
        float amax = fmaxf(fabsf(a_lo), fabsf(a_hi));
#pragma unroll
        for (int o = 1; o < 64; o <<= 1) amax = fmaxf(amax, __shfl_xor(amax, o));
        const float ainv = amax > 0.f ? 119.0f / amax : 0.f, tscale = amax * (1.0f / 119.0f);
        unsigned pd[4];
        {
            const int A0 = __float2int_rn(a_lo * ainv), A1 = __float2int_rn(a_hi * ainv);
            const int h0 = (A0 + 8) >> 4, l0 = A0 - 16 * h0, h1 = (A1 + 8) >> 4, l1 = A1 - 16 * h1;
            const int sh = 4 * ((lane >> 1) & 7);
            pd[0] = ((unsigned)l0 & 15u) << sh; pd[1] = ((unsigned)h0 & 15u) << sh; pd[2] = ((unsigned)l1 & 15u) << sh; pd[3] = ((unsigned)h1 & 15u) << sh;
#pragma unroll
            for (int q = 0; q < 4; ++q) { pd[q] |= (unsigned)__shfl_xor((int)pd[q], 2); pd[q] |= (unsigned)__shfl_xor((int)pd[q], 4); pd[q] |= (unsigned)__shfl_xor((int)pd[q], 8); }
        }
        int acc0[32], acc1[32];
#pragma unroll
        for (int e = 0; e < 32; ++e) { acc0[e] = 0; acc1[e] = 0; }
#define DN_STEP(buf, hb) do { const unsigned plo_ = (hb) < 4 ? pd[0] : pd[2], phi_ = (hb) < 4 ? pd[1] : pd[3]; \
            const int alo_ = sel2(hf, __builtin_amdgcn_readlane((int)plo_, ((hb) & 3) * 16), __builtin_amdgcn_readlane((int)plo_, ((hb) & 3) * 16 + 1)), ahi_ = sel2(hf, __builtin_amdgcn_readlane((int)phi_, ((hb) & 3) * 16), __builtin_amdgcn_readlane((int)phi_, ((hb) & 3) * 16 + 1)); \
            _Pragma("unroll") for (int w = 0; w < 4; ++w) { unsigned w_[8], t_[8]; \
                _Pragma("unroll") for (int r = 0; r < 8; ++r) w_[r] = buf[r][w]; \
                tr8_nib(w_, t_); \
                _Pragma("unroll") for (int c = 0; c < 8; ++c) { acc0[8 * w + c] = __builtin_amdgcn_sdot8((int)t_[c], alo_, acc0[8 * w + c], false); acc1[8 * w + c] = __builtin_amdgcn_sdot8((int)t_[c], ahi_, acc1[8 * w + c], false); } } } while (0)
        {
            v4u db[8];
            DN_LOAD(db, 1); DN_STEP(da, 0);
            DN_LOAD(da, 2); DN_STEP(db, 1);
            DN_LOAD(db, 3); DN_STEP(da, 2);
            DN_LOAD(da, 4); DN_STEP(db, 3);
            DN_LOAD(db, 5); DN_STEP(da, 4);
            DN_LOAD(da, 6); DN_STEP(db, 5);
            DN_LOAD(db, 7); DN_STEP(da, 6);
            DN_STEP(db, 7);
        }
#undef DN_LOAD
#undef DN_STEP
        int os[16];
#pragma unroll
        for (int k = 0; k < 16; ++k) { const int lo_ = acc0[k] + (acc1[k] << 4), hi_ = acc0[16 + k] + (acc1[16 + k] << 4); os[k] = (hf ? hi_ : lo_) + __shfl_xor(hf ? lo_ : hi_, 32); }
        f32x2g out[8];
#pragma unroll
        for (int e = 0; e < 8; ++e) out[e] = (f32x2g){(float)os[2 * e] * tscale, (float)os[2 * e + 1] * tscale};
        float ss2 = 0.f;
#pragma unroll
        for (int i = 0; i < 4; ++i) { hv[i].x += out[2 * i].x; hv[i].y += out[2 * i].y; hv[i].z += out[2 * i + 1].x; hv[i].w += out[2 * i + 1].y;
            ss2 += (hv[i].x * hv[i].x + hv[i].y * hv[i].y) + (hv[i].z * hv[i].z + hv[i].w * hv[i].w); }
        const float rstd2 = 1.0f / sqrtf(wave_sum(ss2) * (1.f / D) + RMS_EPS);
        f32x4 y[4];
#pragma unroll
        for (int i = 0; i < 4; ++i) y[i] = hv[i] * rstd2 * *(const f32x4*)(gnext + 256 * i + 4 * sg);
        if (layer < DEPTH - 1) {
            bf16* hw_ = HW + (size_t)t * D + 4 * sg; bf16* hn = HN + (size_t)t * D + 4 * sg;
#pragma unroll
            for (int i = 0; i < 4; ++i) { v2u a_, b_; a_.x = pk2(hv[i].x, hv[i].y); a_.y = pk2(hv[i].z, hv[i].w); b_.x = pk2(y[i].x, y[i].y); b_.y = pk2(y[i].z, y[i].w);
                *(v2u*)(hw_ + 256 * i) = a_; *(v2u*)(hn + 256 * i) = b_; }
        } else {
            float* orow = outp + (size_t)t * D + 4 * sg;
#pragma unroll
            for (int i = 0; i < 4; ++i) *(f32x4*)(orow + 256 * i) = y[i];
        }
    }
    LDS_WAIT(); asm volatile("" ::: "memory");
    }
#undef TOK_LOAD
}

struct Args { const float* in[14]; float* out; unsigned char* ws; int ph_lo, ph_hi; };
__global__ void __launch_bounds__(NTHR, 2) mega_fwd(Args args) {
    extern __shared__ __attribute__((aligned(16))) unsigned char lds[];
    Frame F;
    F.lds = (LAS unsigned char*)lds;
    F.tid = threadIdx.x; F.lane = F.tid & 63; F.wave = __builtin_amdgcn_readfirstlane(F.tid >> 6);
    F.G = gridDim.x; { const int bx = blockIdx.x; F.vcu = (F.G % 8 == 0) ? (bx % 8) * (F.G / 8) + bx / 8 : bx; }
    F.ws = args.ws;
    volatile LAS unsigned* MISC = (volatile LAS unsigned*)(F.lds + MISC_OFF);
    if (F.tid < 64) MISC[F.tid] = 0u;
    if (F.tid < 15) { const unsigned long long p = F.tid < 14 ? (unsigned long long)args.in[F.tid] : (unsigned long long)args.out;
        volatile LAS unsigned* t = (volatile LAS unsigned*)(F.lds + PTAB_OFF); t[2 * F.tid] = (unsigned)p; t[2 * F.tid + 1] = (unsigned)(p >> 32); }
    __syncthreads();
    XcdBarrier bar; bar.bar = (unsigned*)(F.ws + WS_CTL) + CW_BAR; bar.x = 0; bar.st = nullptr;
    if (MK_N_LAUNCHES == 1) bar = xcd_barrier_post((unsigned*)(F.ws + WS_CTL) + CW_BAR, MISC + 8);

#pragma unroll 1
    for (int ph = args.ph_lo; ph < args.ph_hi; ++ph) {
        bool did = true;
        const int kind_ = ph == 0 ? 7 : (ph - 1) % PH_PER_LAYER; const int nrep = (PROBE_REP >= 0 && kind_ == PROBE_REP && (ph == 0 || ((PROBE_LMASK >> ((ph - 1) / PH_PER_LAYER)) & 1))) ? 2 : 1;
#pragma unroll 1
        for (int rep = 0; rep < nrep; ++rep) {
        const bool dry = (nrep == 2 && rep == 0);
        { int t_ = threadIdx.x; asm volatile("" : "+v"(t_)); F.tid = t_; F.lane = t_ & 63; F.wave = __builtin_amdgcn_readfirstlane(t_ >> 6);
          unsigned long long ws_ = (unsigned long long)args.ws; asm volatile("" : "+s"(ws_)); F.ws = (unsigned char*)(__attribute__((address_space(1))) unsigned char*)ws_; }
#ifndef DIS_PRO
        if (ph == 0) p0_prologue(F, dry);
#else
        if (ph == 0) {}
#endif
        else {
            const int layer = (ph - 1) / PH_PER_LAYER, k = (ph - 1) % PH_PER_LAYER, j = layer >> 1; const bool is_attn = (layer & 1) == 0;
            if (k == 0) {
                if (!is_attn) {
                    pg8::Gemm g{(const pg8::bf16_t*)(F.ws + WS_HN), (const pg8::bf16_t*)(F.ws + WS_WIN) + (size_t)j * 3072 * 1024, M, 3072, D};
                    pg8::StaticOrder S; S.init(g.M, g.N, F.G, (int)blockIdx.x);
                    EpiConvIn E{(bf16*)(F.ws + WS_BIG), (bf16*)(F.ws + WS_BIG + 32 * MiB)};
                    pg8::gemm_phase<EpiConvIn, pg8::StaticOrder, true, true>(F.lds, g, S, E);
                }
                const int ng = is_attn ? 2 : 0;
#pragma unroll 1
                for (int gi = 0; gi < ng; ++gi) {
                    pg8::Gemm g; pg8::EpiBf16<0> E; E.bias = nullptr; E.split_cols = 0; E.split_stride = 0; E.scale0 = 1.f;
                    if (is_attn && gi == 0) { g = pg8::Gemm{(const pg8::bf16_t*)(F.ws + WS_HN), (const pg8::bf16_t*)(F.ws + WS_WQK) + (size_t)j * 2048 * 1024, M, 2048, D}; E.O = (pg8::bf16_t*)(F.ws + WS_BIG); E.ldc = 2048; }
                    else if (is_attn) { g = pg8::Gemm{(const pg8::bf16_t*)(F.ws + WS_WV) + (size_t)j * 1024 * 1024, (const pg8::bf16_t*)(F.ws + WS_HN), D, M, D}; E.O = (pg8::bf16_t*)(F.ws + WS_VT); E.ldc = M; }
                    else { g = pg8::Gemm{(const pg8::bf16_t*)(F.ws + WS_HN), (const pg8::bf16_t*)(F.ws + WS_WIN) + (size_t)j * 3072 * 1024, M, 3072, D}; E.O = (pg8::bf16_t*)(F.ws + WS_BIG); E.ldc = 3072; }
                    pg8::StaticOrder S; S.init(g.M, g.N, F.G, (int)blockIdx.x);
                    pg8::gemm_phase<pg8::EpiBf16<0>, pg8::StaticOrder, true, true>(F.lds, g, S, E);
                }
            } else if (k == 1) {
                if (is_attn) {
#if NAIVE_ATTN
                    attn_naive_phase(F, j);
#elif !defined(DIS_ATTN)
                    attn_phase(F, j);
#endif
                } else {
#ifndef DIS_CONV
                    conv_phase(F, j);
#endif
                }
            } else if (k == 2) {
                pg8::Gemm g{(const pg8::bf16_t*)(F.ws + WS_MIX), (const pg8::bf16_t*)(F.ws + (is_attn ? WS_WO : WS_WOUT)) + (size_t)j * 1024 * 1024, M, D, D};
                pg8::StaticOrder S; S.init(M, D, F.G, (int)blockIdx.x);
                float* rssp = (float*)(F.ws + (dry ? WS_SC + 96 * MiB : WS_RSS)); bf16* hout = (bf16*)(F.ws + (dry ? WS_SC : WS_H));
                if (layer == 0) { EpiRes<true> E{(const void*)F.in(0), hout, rssp}; pg8::gemm_phase<EpiRes<true>, pg8::StaticOrder, false, true>(F.lds, g, S, E); }
                else { EpiRes<false> E{(const void*)(F.ws + WS_H), hout, rssp}; pg8::gemm_phase<EpiRes<false>, pg8::StaticOrder, false, true>(F.lds, g, S, E); }
            } else if (k == 3) {
                did = false;
            } else if (k == 4) {
                pg8::Gemm g{(const pg8::bf16_t*)(F.ws + WS_H), (const pg8::bf16_t*)(F.ws + WS_WP) + (size_t)layer * 2048 * 1024, M, 2048, D};
                pg8::StaticOrder S; S.init(M, 2048, F.G, (int)blockIdx.x);
#if NAIVE_TOPK
                EpiF32 E{(float*)(F.ws + WS_SC), 2048};
                pg8::gemm_phase<EpiF32, pg8::StaticOrder, true, true>(F.lds, g, S, E);
#else
#ifndef DIS_TOPK
                EpiTopK E{(int*)(F.ws + WS_SELI), (float*)(F.ws + WS_SELG), (const float*)(F.ws + WS_RSS)};
#pragma unroll 1
                for (int i = 0;; ++i) { OneUnit O1; if (!S.next(i, O1.u)) break; pg8::gemm_phase<EpiTopK, OneUnit, false, true>(F.lds, g, O1, E); }
#endif
#endif
            } else if (k == 5) {
                gather_phase<1>(F, layer, dry);
            } else {
                gather_phase<2>(F, layer, dry);
            }
        }
        if (MK_N_LAUNCHES == 1 && dry) xcd_barrier(bar);
        }
        if (MK_N_LAUNCHES == 1 && did && ph + 1 < args.ph_hi) { xcd_barrier(bar);
#ifdef PROBE_BAR2
            xcd_barrier(bar);
#endif
        }
    }
}

extern "C" void kernel_launch(void* const* d_in, const int* in_sizes, int n_in, void* d_out, int out_size, void* d_ws, size_t ws_size, hipStream_t stream) {
    static int grid = 0;
    if (grid == 0) {
        if (n_in != 14 || out_size != M * D || ws_size < WS_END) { fprintf(stderr, "kernel_launch: unexpected shapes (n_in %d, out %d, ws %zu); nothing launched\n", n_in, out_size, ws_size); grid = -1; return; }
        int dev = 0, cus = 0, per_cu = 0;
        if (hipGetDevice(&dev) != hipSuccess || hipDeviceGetAttribute(&cus, hipDeviceAttributeMultiprocessorCount, dev) != hipSuccess) { grid = -1; return; }
        if (hipFuncSetAttribute((const void*)mega_fwd, hipFuncAttributeMaxDynamicSharedMemorySize, LDS_BYTES) != hipSuccess) { fprintf(stderr, "kernel_launch: hipFuncSetAttribute failed\n"); grid = -1; return; }
        if (hipOccupancyMaxActiveBlocksPerMultiprocessor(&per_cu, (const void*)mega_fwd, NTHR, LDS_BYTES) != hipSuccess || per_cu < 1) fprintf(stderr, "kernel_launch: note: occupancy query reports %d\n", per_cu);
        (void)hipGetLastError();
        grid = cus;
    }
    if (grid < 0) return;
    if (hipMemsetAsync((char*)d_ws + WS_CTL, 0, CTL_ZERO_BYTES, stream) != hipSuccess) return;
    Args a{};
    for (int i = 0; i < 14; ++i) a.in[i] = (const float*)d_in[i];
    a.out = (float*)d_out; a.ws = (unsigned char*)d_ws;
    if (MK_N_LAUNCHES == 1) { a.ph_lo = 0; a.ph_hi = N_PHASES; hipLaunchKernelGGL(mega_fwd, dim3(grid), dim3(NTHR), LDS_BYTES, stream, a); }
    else for (int ph = 0; ph < N_PHASES; ++ph) {
        if (ph > 0 && (ph - 1) % PH_PER_LAYER == 3) continue;
        a.ph_lo = ph; a.ph_hi = ph + 1; hipLaunchKernelGGL(mega_fwd, dim3(grid), dim3(NTHR), LDS_BYTES, stream, a);
    }
}
```

```cpp
#include <hip/hip_runtime.h>
#include <cstdio>
#include <cstdint>
namespace pg8 {
#define PG8_LAS __attribute__((address_space(3)))
typedef unsigned short bf16_t;
typedef short bf16x8 __attribute__((ext_vector_type(8)));
typedef float f32x4 __attribute__((ext_vector_type(4)));
typedef unsigned u32x4 __attribute__((ext_vector_type(4)));
constexpr int BM = 256, BK = 64, HALF = 128, HTB = HALF * BK * 2  , STAGE_BYTES = 8 * HTB, NXCD = 8, WGM = 8;

__host__ __device__ __forceinline__ int lds_byte(int r, int c) { const int st = (r >> 4) * 2 + (c >> 5), rr = r & 15, cc = c & 31, ob = rr * 64 + cc * 2; return st * 1024 + (ob ^ (((ob >> 9) & 1) << 5)); }
__host__ __device__ __forceinline__ void stage_rc(int b, int& R, int& C) { const int st = b / 1024, sb = b % 1024, swz = sb ^ (((sb >> 9) & 1) << 5); R = (st >> 1) * 16 + swz / 64; C = (st & 1) * 32 + (swz % 64) / 2; }
__host__ __device__ __forceinline__ int perm32(int rho) { const int n = rho >> 4, i = rho & 15; return 8 * (i >> 2) + 4 * n + (i & 3); }

struct Unit { int pm, pn; };
struct Gemm { const bf16_t* A; const bf16_t* Bt; int M, N, K; };

struct StaticOrder {
    int nM, nN, nwg, G, c;
    __host__ __device__ void init(int M, int N, int G_, int c_) { nM = M / BM; nN = N / BM; nwg = nM * nN; G = G_; c = c_; }
    __host__ __device__ bool next(int i, Unit& u) const {
        const long L = (long)i * G + c; if (L >= nwg) return false;
        int wgid = (int)L; { const int q = nwg / NXCD, r = nwg % NXCD, xcd = wgid % NXCD, off = wgid / NXCD; wgid = (xcd < r ? xcd * (q + 1) : r * (q + 1) + (xcd - r) * q) + off; }
        const int nig = WGM * nN, gid = wgid / nig, fm = gid * WGM, gsz = (nM - fm) < WGM ? (nM - fm) : WGM;
        u.pm = fm + ((wgid % nig) % gsz); u.pn = (wgid % nig) / gsz; return true;
    }
    __device__ __forceinline__ void a_ready(const Unit&) const {}
    __device__ __forceinline__ void done(const Unit&) const {}
};

__device__ __forceinline__ unsigned cvt_pk_bf16(float lo, float hi) { unsigned r; asm volatile("v_cvt_pk_bf16_f32 %0, %1, %2" : "=v"(r) : "v"(lo), "v"(hi)); return r; }
typedef float f32x2 __attribute__((ext_vector_type(2)));
__device__ __forceinline__ f32x2 gelu_pk(f32x2 v) {
    const f32x2 av = __builtin_elementwise_abs(v), d = av * 0.2316418882f + 1.0f;
    f32x2 t; t.x = __builtin_amdgcn_rcpf(d.x); t.y = __builtin_amdgcn_rcpf(d.y);
    f32x2 q = t * 0.5307027145f + (-0.7265760135f); q = q * t + 0.7107068705f; q = q * t + (-0.142248368f); q = q * t + 0.127414796f; q = q * t;
    const f32x2 s = (v * v) * (-0.72134752044f);
    f32x2 e; e.x = __builtin_amdgcn_exp2f(s.x); e.y = __builtin_amdgcn_exp2f(s.y);
    const f32x2 m = v * (q * e), r = v - m;
    f32x2 o; o.x = v.x < 0.f ? m.x : r.x; o.y = v.y < 0.f ? m.y : r.y; return o;
}

template <int ACT  > struct EpiBf16 {
    static constexpr bool PERM = true, AFTER_DRAIN = false; static_assert(ACT == 0 || ACT == 1, "EpiBf16: ACT is 0 (none) or 1 (gelu_pk)");
    bf16_t* O; int ldc; const float* bias; int split_cols; size_t split_stride; float scale0;
    __device__ __forceinline__ void operator()(const f32x4 (&acc)[2][2][4][2], const Unit& u, int wr, int wc, int fr, int fq) const {
        const int row0 = u.pm * BM + wr * 64 + fr; int colt = u.pn * BM; bf16_t* base = O;
        float sc = 1.f; if (split_cols) { const int t = colt / split_cols; base += (size_t)t * split_stride; colt -= t * split_cols; if (t == 0) sc = scale0; }
        const int col0 = colt + wc * 32 + 8 * fq, bcol0 = u.pn * BM + wc * 32 + 8 * fq;
        f32x4 bv[2][2];
#pragma unroll
        for (int bj = 0; bj < 2; ++bj)
#pragma unroll
            for (int n = 0; n < 2; ++n) bv[bj][n] = bias ? *(const f32x4*)(bias + bcol0 + bj * HALF + 4 * n) : (f32x4){0.f, 0.f, 0.f, 0.f};
#pragma unroll
        for (int ai = 0; ai < 2; ++ai)
#pragma unroll
            for (int m = 0; m < 4; ++m) { bf16_t* rowp = base + (size_t)(row0 + ai * HALF + m * 16) * ldc + col0;
#pragma unroll
                for (int bj = 0; bj < 2; ++bj) { f32x4 v0 = acc[ai][bj][m][0] + bv[bj][0], v1 = acc[ai][bj][m][1] + bv[bj][1];
                    if (ACT == 1) { f32x2 a = gelu_pk((f32x2){v0[0], v0[1]}), b = gelu_pk((f32x2){v0[2], v0[3]}), c = gelu_pk((f32x2){v1[0], v1[1]}), d = gelu_pk((f32x2){v1[2], v1[3]});
                        v0 = (f32x4){a.x, a.y, b.x, b.y}; v1 = (f32x4){c.x, c.y, d.x, d.y}; }
                    v0 = v0 * sc; v1 = v1 * sc; u32x4 w; w.x = cvt_pk_bf16(v0[0], v0[1]); w.y = cvt_pk_bf16(v0[2], v0[3]); w.z = cvt_pk_bf16(v1[0], v1[1]); w.w = cvt_pk_bf16(v1[2], v1[3]);
                    *(u32x4*)(rowp + bj * HALF) = w; } }
    }
};

template <class Epi, class Sched, bool ALIGN_EPI = false, bool SP2 = false>
__device__ __forceinline__ void gemm_phase(PG8_LAS unsigned char* lds, const Gemm g, const Sched& S, const Epi& E) {
    int tid_l = threadIdx.x; asm volatile("" : "+v"(tid_l));
    const int tid = tid_l, wid = __builtin_amdgcn_readfirstlane(tid >> 6), lane = tid & 63, wr = wid >> 2, wc = wid & 3, fr = lane & 15, fq = lane >> 4;
    const int K = g.K, nt = K / BK;
    unsigned voffA[2], voffB[2];
#pragma unroll
    for (int i = 0; i < 2; ++i) { int R, C; stage_rc(tid * 16 + i * 8192, R, C); const int Rb = Epi::PERM ? ((R & ~31) + perm32(R & 31)) : R;
        voffA[i] = (unsigned)(R * K + C) * 2u; voffB[i] = (unsigned)(Rb * K + C) * 2u; }
    const size_t kstep = (size_t)(BK * 2);
    const size_t hstep = (size_t)HALF * K * 2;
    const size_t tstep = 2 * hstep;
    const unsigned ldsw = (unsigned)wid * 1024u;
    const int aoff = lds_byte(wr * 64 + fr, fq * 8), boff = lds_byte(wc * 32 + fr, fq * 8);
#define PG8_SA(b, h) (((b) * 2 + (h)) * HTB)
#define PG8_SB(b, h) ((4 + (b) * 2 + (h)) * HTB)
#define PG8_STAGE(bufoff, gbase, voff) do { _Pragma("unroll") for (int _i = 0; _i < 2; ++_i) \
        __builtin_amdgcn_global_load_lds((const unsigned*)((const char*)(gbase) + (voff)[_i]), (PG8_LAS unsigned*)(lds + (bufoff) + ldsw + _i * 8192), 16, 0, 0); } while (0)
#define PG8_LDA(dst, b, h) do { _Pragma("unroll") for (int m = 0; m < 4; ++m) _Pragma("unroll") for (int k = 0; k < 2; ++k) dst[m][k] = *(const PG8_LAS bf16x8*)(lds + PG8_SA(b, h) + aoff + m * 2048 + k * 1024); } while (0)
#define PG8_LDB(dst, b, h) do { _Pragma("unroll") for (int n = 0; n < 2; ++n) _Pragma("unroll") for (int k = 0; k < 2; ++k) dst[n][k] = *(const PG8_LAS bf16x8*)(lds + PG8_SB(b, h) + boff + n * 2048 + k * 1024); } while (0)
#define PG8_MMA(ai, bj, At, Bt) do { __builtin_amdgcn_s_setprio(1); _Pragma("unroll") for (int m = 0; m < 4; ++m) _Pragma("unroll") for (int n = 0; n < 2; ++n) _Pragma("unroll") for (int k = 0; k < 2; ++k) \
        acc[ai][bj][m][n] = __builtin_amdgcn_mfma_f32_16x16x32_bf16(Bt[n][k], At[m][k], acc[ai][bj][m][n], 0, 0, 0); __builtin_amdgcn_s_setprio(0); } while (0)
#define PG8_WAIT_V(n) asm volatile("s_waitcnt vmcnt(" #n ")" ::: "memory")
#define PG8_WAIT_L(n) asm volatile("s_waitcnt lgkmcnt(" #n ")" ::: "memory")
#define PG8_BAR __builtin_amdgcn_s_barrier()
#define PG8_SCHED __builtin_amdgcn_sched_barrier(0)
    Unit cur, nxt; int ui = 0;
    if (!S.next(0, cur)) return;
    f32x4 acc[2][2][4][2];
#pragma unroll
    for (int a = 0; a < 2; ++a)
#pragma unroll
        for (int b = 0; b < 2; ++b)
#pragma unroll
            for (int m = 0; m < 4; ++m)
#pragma unroll
                for (int n = 0; n < 2; ++n) acc[a][b][m][n] = (f32x4){0.f, 0.f, 0.f, 0.f};
    bf16x8 At[4][2], B0[2][2], B1[2][2];
    const char* cA = (const char*)g.A + (size_t)cur.pm * tstep; const char* cB = (const char*)g.Bt + (size_t)cur.pn * tstep;
    S.a_ready(cur);
    if constexpr (SP2) {
        PG8_STAGE(PG8_SB(0, 0), cB, voffB); PG8_STAGE(PG8_SB(0, 1), cB + hstep, voffB); PG8_STAGE(PG8_SA(0, 0), cA, voffA); PG8_STAGE(PG8_SA(0, 1), cA + hstep, voffA);
        if (wr == 1) PG8_BAR;
        PG8_WAIT_V(2); PG8_BAR;
        PG8_STAGE(PG8_SB(1, 0), cB + kstep, voffB); PG8_STAGE(PG8_SA(1, 0), cA + kstep, voffA); PG8_STAGE(PG8_SB(1, 1), cB + hstep + kstep, voffB);
        PG8_WAIT_V(6); PG8_BAR;
    } else {
        PG8_STAGE(PG8_SB(0, 0), cB, voffB); PG8_STAGE(PG8_SA(0, 0), cA, voffA); PG8_STAGE(PG8_SB(0, 1), cB + hstep, voffB); PG8_STAGE(PG8_SA(0, 1), cA + hstep, voffA);
        if (wr == 1) PG8_BAR;
        PG8_WAIT_V(4); PG8_BAR;
        PG8_STAGE(PG8_SB(1, 0), cB + kstep, voffB); PG8_STAGE(PG8_SA(1, 0), cA + kstep, voffA); PG8_STAGE(PG8_SB(1, 1), cB + hstep + kstep, voffB);
        PG8_WAIT_V(6); PG8_BAR;
    }
    for (;;) {
        const bool has_next = S.next(ui + 1, nxt);
        const char* nA = has_next ? (const char*)g.A + (size_t)nxt.pm * tstep : cA; const char* nB = has_next ? (const char*)g.Bt + (size_t)nxt.pn * tstep : cB;
        for (int t = 0; t < nt; t += 2) {
            const bool last = (t == nt - 2);
            const char* a1 = cA + (size_t)(t + 1) * kstep;
            const char* a2 = last ? nA : cA + (size_t)(t + 2) * kstep; const char* b2 = last ? nB : cB + (size_t)(t + 2) * kstep;
            const char* a3 = a2 + kstep; const char* b3 = b2 + kstep;
            if (last && has_next) S.a_ready(nxt);
            if constexpr (SP2) {
            PG8_LDB(B0, 0, 0); PG8_LDB(B1, 0, 1); PG8_SCHED; PG8_LDA(At, 0, 0); PG8_STAGE(PG8_SA(1, 1), a1 + hstep, voffA);
            PG8_WAIT_V(8); PG8_WAIT_L(0); PG8_BAR; PG8_MMA(0, 0, At, B0); PG8_MMA(0, 1, At, B1); PG8_BAR; PG8_SCHED;
            PG8_LDA(At, 0, 1); PG8_STAGE(PG8_SB(0, 0), b2, voffB); PG8_STAGE(PG8_SB(0, 1), b2 + hstep, voffB); PG8_STAGE(PG8_SA(0, 0), a2, voffA);
            PG8_WAIT_V(8); PG8_WAIT_L(0); PG8_BAR; PG8_MMA(1, 0, At, B0); PG8_MMA(1, 1, At, B1); PG8_BAR; PG8_SCHED;
            PG8_LDB(B0, 1, 0); PG8_LDB(B1, 1, 1); PG8_SCHED; PG8_LDA(At, 1, 0); PG8_STAGE(PG8_SA(0, 1), a2 + hstep, voffA);
            PG8_WAIT_V(8); PG8_WAIT_L(0); PG8_BAR; PG8_MMA(0, 0, At, B0); PG8_MMA(0, 1, At, B1); PG8_BAR; PG8_SCHED;
            PG8_LDA(At, 1, 1); PG8_STAGE(PG8_SB(1, 0), b3, voffB); PG8_STAGE(PG8_SB(1, 1), b3 + hstep, voffB); PG8_STAGE(PG8_SA(1, 0), a3, voffA);
            PG8_WAIT_V(8); PG8_WAIT_L(0); PG8_BAR; PG8_MMA(1, 0, At, B0); PG8_MMA(1, 1, At, B1); PG8_BAR; PG8_SCHED;
            } else {
            PG8_LDB(B0, 0, 0); PG8_SCHED; PG8_LDA(At, 0, 0); PG8_STAGE(PG8_SA(1, 1), a1 + hstep, voffA);
            PG8_WAIT_L(8); PG8_BAR; PG8_WAIT_L(0); PG8_MMA(0, 0, At, B0); PG8_BAR; PG8_SCHED;
            PG8_LDB(B1, 0, 1); PG8_STAGE(PG8_SB(0, 0), b2, voffB);
            PG8_BAR; PG8_WAIT_L(0); PG8_MMA(0, 1, At, B1); PG8_BAR;
            PG8_LDA(At, 0, 1); PG8_STAGE(PG8_SA(0, 0), a2, voffA);
            PG8_BAR; PG8_WAIT_L(0); PG8_MMA(1, 0, At, B0); PG8_BAR; PG8_SCHED;
            PG8_STAGE(PG8_SB(0, 1), b2 + hstep, voffB);
            PG8_WAIT_V(6); PG8_BAR; PG8_MMA(1, 1, At, B1); PG8_BAR;
            PG8_LDB(B0, 1, 0); PG8_SCHED; PG8_LDA(At, 1, 0); PG8_STAGE(PG8_SA(0, 1), a2 + hstep, voffA);
            PG8_WAIT_L(8); PG8_BAR; PG8_WAIT_L(0); PG8_MMA(0, 0, At, B0); PG8_BAR; PG8_SCHED;
            PG8_LDB(B1, 1, 1); PG8_STAGE(PG8_SB(1, 0), b3, voffB);
            PG8_BAR; PG8_WAIT_L(0); PG8_MMA(0, 1, At, B1); PG8_BAR;
            PG8_LDA(At, 1, 1); PG8_STAGE(PG8_SA(1, 0), a3, voffA);
            PG8_BAR; PG8_WAIT_L(0); PG8_MMA(1, 0, At, B0); PG8_BAR; PG8_SCHED;
            PG8_STAGE(PG8_SB(1, 1), b3 + hstep, voffB);
            PG8_WAIT_V(6); PG8_BAR; PG8_MMA(1, 1, At, B1); PG8_BAR;
            }
        }
        if constexpr (ALIGN_EPI) { if (wr == 0) PG8_BAR; }
        if constexpr (!Epi::AFTER_DRAIN) { E(acc, cur, wr, wc, fr, fq); S.done(cur); }
        if (!has_next) break;
#pragma unroll
        for (int a = 0; a < 2; ++a)
#pragma unroll
            for (int b = 0; b < 2; ++b)
#pragma unroll
                for (int m = 0; m < 4; ++m)
#pragma unroll
                    for (int n = 0; n < 2; ++n) acc[a][b][m][n] = (f32x4){0.f, 0.f, 0.f, 0.f};
        cur = nxt; cA = nA; cB = nB; ++ui;
        if constexpr (ALIGN_EPI) { if (wr == 1) PG8_BAR; }
    }
    PG8_WAIT_V(0);
    if constexpr (!ALIGN_EPI) { if (wr == 0) PG8_BAR; }
    PG8_BAR;
    if constexpr (Epi::AFTER_DRAIN) { E.fused(acc, cur, wr, wc, fr, fq, lds, wid, lane); S.done(cur); }
#undef PG8_SA
#undef PG8_SB
#undef PG8_STAGE
#undef PG8_LDA
#undef PG8_LDB
#undef PG8_MMA
#undef PG8_WAIT_V
#undef PG8_WAIT_L
#undef PG8_BAR
#undef PG8_SCHED
}
}
#ifndef HD
#define HD __host__ __device__ __forceinline__
#endif
HD int tk_map(float f) { int b = __builtin_bit_cast(int, f); return b ^ ((b >> 31) & 0x7fffffff); }
HD float tk_unmap(int k) { int b = k ^ ((k >> 31) & 0x7fffffff); return __builtin_bit_cast(float, b); }
HD void tk_cx(int& a, int& b) { const int hi = a > b ? a : b, lo = a > b ? b : a; a = hi; b = lo; }
template <int N> HD void tk_sort_desc(int (&v)[N]) {
#pragma unroll
    for (int k = 2; k <= N; k <<= 1)
#pragma unroll
        for (int j = k >> 1; j > 0; j >>= 1)
#pragma unroll
            for (int i = 0; i < N; ++i) { const int l = i ^ j; if (l > i) { if ((i & k) == 0) tk_cx(v[i], v[l]); else tk_cx(v[l], v[i]); } }
}
template <int N> HD void tk_merge_top(int (&a)[N], const int (&b)[N]) {
#pragma unroll
    for (int i = 0; i < N; ++i) a[i] = a[i] > b[N - 1 - i] ? a[i] : b[N - 1 - i];
#pragma unroll
    for (int j = N >> 1; j > 0; j >>= 1)
#pragma unroll
        for (int i = 0; i < N; ++i) { const int l = i ^ j; if (l > i) tk_cx(a[i], a[l]); }
}
template <int NCH, class FP> HD void tk_stage1(FP s, int n_base, int (&best)[16]) {
#pragma unroll
    for (int c = 0; c < NCH; ++c) {
        int x[16];
#pragma unroll
        for (int e = 0; e < 16; ++e) x[e] = (tk_map(s[c * 16 + e]) & ~127) | (127 - (n_base + c * 16 + e));
        tk_sort_desc(x);
        if (c == 0) {
#pragma unroll
            for (int e = 0; e < 16; ++e) best[e] = x[e];
        } else tk_merge_top(best, x);
    }
}
template <class IP, class OI, class OG> HD void tk_stage2(int (&a)[16], int (&b)[16], IP AB, OI out_idx, OG out_g, float vscale = 1.0f) {
    float va[16], vb[16];
#pragma unroll
    for (int i = 0; i < 16; ++i) { AB[i] = a[i]; AB[16 + i] = b[i]; va[i] = tk_unmap(a[i] & ~127); vb[i] = tk_unmap(b[i] & ~127); }
    int best[16];
#pragma unroll
    for (int c = 0; c < 4; ++c) {
        int x[16];
#pragma unroll
        for (int e = 0; e < 16; ++e) x[e] = (int)0x80000000;
        int n = 0;
#pragma unroll
        for (int i = 0; i < 16; ++i)
#pragma unroll
            for (int j = 0; j < 16; ++j)
                if ((i + 1) * (j + 1) <= 16) { if (n >= 16 * c && n < 16 * c + 16) x[n - 16 * c] = (tk_map(va[i] + vb[j]) & ~255) | (255 - (i * 16 + j)); ++n; }
        tk_sort_desc(x);
        if (c == 0) {
#pragma unroll
            for (int e = 0; e < 16; ++e) best[e] = x[e];
        } else tk_merge_top(best, x);
    }
    int ka[16], kb[16];
#pragma unroll
    for (int k = 0; k < 16; ++k) { const int flat = 255 - (best[k] & 255); ka[k] = AB[flat >> 4]; kb[k] = AB[16 + (flat & 15)]; }
    float sv[16]; int ei[16]; float sum = 0.f;
#pragma unroll
    for (int k = 0; k < 16; ++k) { ei[k] = (127 - (ka[k] & 127)) * 128 + (127 - (kb[k] & 127)); sv[k] = (tk_unmap(ka[k] & ~127) + tk_unmap(kb[k] & ~127)) * vscale; }
    const float m = sv[0];
#pragma unroll
    for (int k = 0; k < 16; ++k) { sv[k] = __expf(sv[k] - m); sum += sv[k]; }
    const float inv = 1.0f / sum;
#pragma unroll
    for (int k = 0; k < 16; ++k) { out_idx[k] = ei[k]; out_g[k] = sv[k] * inv; }
}
constexpr int NWAVES = 8, NTHR = 512;
constexpr int BATCH = 2, SEQ = 8192, D = 1024, M = BATCH * SEQ, DEPTH = 4;
constexpr int NH = 16, HDIM = 64, GRIDW = 64, NROWS = 128;
constexpr float RMS_EPS = 1e-6f;
#ifndef MK_N_LAUNCHES
#define MK_N_LAUNCHES 1
#endif
#ifndef NAIVE_ATTN
#define NAIVE_ATTN 0
#endif
#ifndef NAIVE_TOPK
#define NAIVE_TOPK 0
#endif
#ifndef EXPERT_FP4
#define EXPERT_FP4 1
#endif
constexpr int ROWB = EXPERT_FP4 ? 512 : 1024;
#ifndef PROBE_GMODE
#define PROBE_GMODE 0
#endif
#ifndef PROBE_IMASK
#define PROBE_IMASK 16383
#endif
#ifndef PROBE_PMODE
#define PROBE_PMODE 0
#endif
#ifndef PROBE_LMASK
#define PROBE_LMASK 15
#endif
#ifndef PROBE_REP
#define PROBE_REP -1
#endif
constexpr int PH_PER_LAYER = 7, N_PHASES = 1 + DEPTH * PH_PER_LAYER;

constexpr size_t MiB = 1u << 20;
constexpr size_t WS_CTL = 0, CTL_ZERO_BYTES = 32 * 1024;
constexpr size_t WS_WQK = 2 * MiB;
constexpr size_t WS_WV = 10 * MiB;
constexpr size_t WS_WO = 14 * MiB;
constexpr size_t WS_WIN = 18 * MiB;
constexpr size_t WS_WOUT = 30 * MiB;
constexpr size_t WS_WP = 34 * MiB;
constexpr size_t WS_H = 64 * MiB;
constexpr size_t WS_HN = 128 * MiB;
constexpr size_t WS_BIG = 160 * MiB;
constexpr size_t WS_VT = 224 * MiB;
constexpr size_t WS_MIX = 256 * MiB;
constexpr size_t WS_SELI = 288 * MiB;
constexpr size_t WS_SELG = 296 * MiB;
constexpr size_t WS_UP = 320 * MiB;
constexpr size_t WS_DN = 384 * MiB;
constexpr size_t WS_SUP = 448 * MiB;
constexpr size_t WS_ACTG = 452 * MiB;
constexpr size_t WS_RSS = 450 * MiB;
constexpr size_t WS_SC = 576 * MiB;
constexpr size_t WS_END = 704 * MiB;
constexpr int CW_BAR = 4096;
static_assert((CW_BAR + 3456) * 4 <= (int)CTL_ZERO_BYTES, "barrier words inside the per-call memset");

constexpr int LDS_BYTES = 163840, MISC_OFF = LDS_BYTES - 256, PTAB_OFF = LDS_BYTES - 512;

#define LAS __attribute__((address_space(3)))
typedef unsigned short bf16;
typedef unsigned v4u __attribute__((ext_vector_type(4)));
typedef unsigned v2u __attribute__((ext_vector_type(2)));
typedef float f32x4 __attribute__((ext_vector_type(4)));
typedef short bf16x8 __attribute__((ext_vector_type(8)));
#define LDS_WAIT() asm volatile("s_waitcnt lgkmcnt(0)" ::: "memory")
#define BLOCK_BAR() do { asm volatile("s_waitcnt vmcnt(0) lgkmcnt(0)" ::: "memory"); __builtin_amdgcn_s_barrier(); asm volatile("" ::: "memory"); } while (0)
__device__ __forceinline__ unsigned f2bf(float f) { unsigned u = __builtin_bit_cast(unsigned, f); return (u + 0x7fffu + ((u >> 16) & 1u)) >> 16; }
typedef float f32x2p __attribute__((ext_vector_type(2))); typedef __bf16 bf16x2p __attribute__((ext_vector_type(2)));
__device__ __forceinline__ unsigned pk2(float lo, float hi) { const f32x2p v = {lo, hi}; return __builtin_bit_cast(unsigned, __builtin_convertvector(v, bf16x2p)); }
__device__ __forceinline__ float bflo(unsigned u) { return __builtin_bit_cast(float, u << 16); }
__device__ __forceinline__ float bfhi(unsigned u) { return __builtin_bit_cast(float, u & 0xffff0000u); }
#define DPP_F(v_, ctrl_) __builtin_bit_cast(float, __builtin_amdgcn_update_dpp(0, __builtin_bit_cast(int, (v_)), (ctrl_), 0xf, 0xf, false))
__device__ __forceinline__ float wave_sum_dpp(float v) {
    v += DPP_F(v, 0xB1); v += DPP_F(v, 0x4E); v += DPP_F(v, 0x141); v += DPP_F(v, 0x140);
    const float r0 = __builtin_bit_cast(float, __builtin_amdgcn_readlane(__builtin_bit_cast(int, v), 0)), r1 = __builtin_bit_cast(float, __builtin_amdgcn_readlane(__builtin_bit_cast(int, v), 16)),
                r2 = __builtin_bit_cast(float, __builtin_amdgcn_readlane(__builtin_bit_cast(int, v), 32)), r3 = __builtin_bit_cast(float, __builtin_amdgcn_readlane(__builtin_bit_cast(int, v), 48));
    return (r0 + r1) + (r2 + r3);
}
__device__ __forceinline__ float wave_max_dpp(float v) {
    v = fmaxf(v, DPP_F(v, 0xB1)); v = fmaxf(v, DPP_F(v, 0x4E)); v = fmaxf(v, DPP_F(v, 0x141)); v = fmaxf(v, DPP_F(v, 0x140));
    const float r0 = __builtin_bit_cast(float, __builtin_amdgcn_readlane(__builtin_bit_cast(int, v), 0)), r1 = __builtin_bit_cast(float, __builtin_amdgcn_readlane(__builtin_bit_cast(int, v), 16)),
                r2 = __builtin_bit_cast(float, __builtin_amdgcn_readlane(__builtin_bit_cast(int, v), 32)), r3 = __builtin_bit_cast(float, __builtin_amdgcn_readlane(__builtin_bit_cast(int, v), 48));
    return fmaxf(fmaxf(r0, r1), fmaxf(r2, r3));
}
__device__ __forceinline__ float wave_sum(float v) {
#pragma unroll
    for (int o = 1; o < 64; o <<= 1) v += __shfl_xor(v, o);
    return v;
}

#define XB_TMO      128
#define XB_XCNT(j)  (256  + 64 * (j))
#define XB_XSUB(j)  (1280 + 64 * (j))
#define XB_XGEN(j)  (2304 + 64 * (j))
#define XB_TOP      3328
#define XB_TOPGEN   3392
#define XCD_BAR_WORDS 3456
#define XB_SPIN_CAP (1u << 20)
__device__ __forceinline__ unsigned xb_ld(unsigned* p)              { return __hip_atomic_load(p, __ATOMIC_RELAXED, __HIP_MEMORY_SCOPE_AGENT); }
__device__ __forceinline__ unsigned xb_add(unsigned* p, unsigned v) { return __hip_atomic_fetch_add(p, v, __ATOMIC_RELAXED, __HIP_MEMORY_SCOPE_AGENT); }
__device__ __forceinline__ unsigned xb_xcc_id() { return (unsigned)__builtin_amdgcn_s_getreg((3 << 11) | 20) & 0xFu; }
#define XB_SPIN(cond, bar) do { unsigned _sp = 0; while (cond) { __builtin_amdgcn_s_sleep(1); \
    if ((++_sp & 255u) == 0u) { if (xb_ld(&(bar)[XB_TMO])) break; if (_sp > XB_SPIN_CAP) { atomicAdd(&(bar)[XB_TMO], 1u); break; } } } } while (0)
struct XcdBarrier { unsigned* bar; unsigned x; volatile LAS unsigned* st; };
__device__ __forceinline__ XcdBarrier xcd_barrier_post(unsigned* bar, volatile LAS unsigned* st) {
    XcdBarrier b; b.bar = bar; b.x = xb_xcc_id(); b.st = st;
    if (threadIdx.x == 0) (void)xb_add(&bar[XB_XCNT(b.x)], 1u);
    return b;
}
__device__ __forceinline__ void xcd_barrier_complete(unsigned* bar, unsigned x, unsigned& nloc, unsigned& nx) {
    const unsigned G = gridDim.x * gridDim.y * gridDim.z;
    unsigned sum, cnt, mine, sp = 0u;
    for (;;) {
        sum = 0u; cnt = 0u; mine = 0u;
#pragma unroll
        for (unsigned j = 0; j < 16; ++j) { const unsigned c = xb_ld(&bar[XB_XCNT(j)]); sum += c; cnt += (c > 0u) ? 1u : 0u; mine = (j == x) ? c : mine; }
        if (sum == G) break;
        __builtin_amdgcn_s_sleep(1);
        if ((++sp & 255u) == 0u) { if (xb_ld(&bar[XB_TMO])) break; if (sp > XB_SPIN_CAP) { atomicAdd(&bar[XB_TMO], 1u); break; } }
    }
    nloc = mine > 0u ? mine : 1u; nx = cnt > 0u ? cnt : 1u;
}
__device__ __forceinline__ void xcd_barrier(const XcdBarrier& b) {
    asm volatile("s_waitcnt vmcnt(0)" ::: "memory");
    __syncthreads();
    if (threadIdx.x == 0) {
        unsigned* bar = b.bar;
        __builtin_amdgcn_s_waitcnt(0);
        unsigned nloc = b.st[0], nx = b.st[1];
        if (nloc == 0u) { xcd_barrier_complete(bar, b.x, nloc, nx); b.st[0] = nloc; b.st[1] = nx; }
        const unsigned old = xb_add(&bar[XB_XSUB(b.x)], 1u);
        const unsigned gen = old / nloc;
        if (old + 1u == (gen + 1u) * nloc) {
            __builtin_amdgcn_fence(__ATOMIC_RELEASE, "agent");
            asm volatile("s_waitcnt vmcnt(0)" ::: "memory");
            const unsigned og = xb_add(&bar[XB_TOP], 1u);
            const unsigned tg = og / nx;
            if (og + 1u == (tg + 1u) * nx) xb_add(&bar[XB_TOPGEN], 1u);
            else XB_SPIN(xb_ld(&bar[XB_TOPGEN]) == tg, bar);
            __builtin_amdgcn_fence(__ATOMIC_ACQUIRE, "agent");
            xb_add(&bar[XB_XGEN(b.x)], 1u);
            asm volatile("s_waitcnt vmcnt(0)" ::: "memory");
        } else {
            XB_SPIN(xb_ld(&bar[XB_XGEN(b.x)]) == gen, bar);
            __builtin_amdgcn_fence(__ATOMIC_ACQUIRE, "agent");
            asm volatile("s_waitcnt vmcnt(0)" ::: "memory");
        }
    }
    __syncthreads();
}

struct Frame {
    LAS unsigned char* lds;
    int tid, lane, wave, vcu, G;
    unsigned char* ws;
    __device__ __forceinline__ const float* in(int i) const {
        const volatile LAS unsigned* t = (const volatile LAS unsigned*)(lds + PTAB_OFF);
        const unsigned lo = __builtin_amdgcn_readfirstlane(t[2 * i]), hi = __builtin_amdgcn_readfirstlane(t[2 * i + 1]);
        return (const float*)(const __attribute__((address_space(1))) float*)(((unsigned long long)hi << 32) | lo);
    }
    __device__ __forceinline__ float* out() const { return (float*)in(14); }
};

template <bool FIRST> struct EpiRes {
    static constexpr bool PERM = true, AFTER_DRAIN = false;
    const void* hin; bf16* h; float* rss;
    __device__ __forceinline__ void operator()(const pg8::f32x4 (&acc)[2][2][4][2], const pg8::Unit& u, int wr, int wc, int fr, int fq) const {
        const int col0 = u.pn * 256 + wc * 32 + 8 * fq;
#pragma unroll
        for (int ai = 0; ai < 2; ++ai)
#pragma unroll
            for (int m = 0; m < 4; ++m) { const int row = u.pm * 256 + ai * 128 + wr * 64 + m * 16 + fr; bf16* rowp = h + (size_t)row * D + col0;
                float ss = 0.f;
#pragma unroll
                for (int bj = 0; bj < 2; ++bj) { f32x4 v0, v1;
                    if (FIRST) { const float* xp = (const float*)hin + (size_t)row * D + col0 + bj * 128; v0 = *(const f32x4*)xp; v1 = *(const f32x4*)(xp + 4); }
                    else { const v4u hw = *(const v4u*)((const bf16*)hin + (size_t)row * D + col0 + bj * 128); v0 = (f32x4){bflo(hw.x), bfhi(hw.x), bflo(hw.y), bfhi(hw.y)}; v1 = (f32x4){bflo(hw.z), bfhi(hw.z), bflo(hw.w), bfhi(hw.w)}; }
                    v0 += acc[ai][bj][m][0]; v1 += acc[ai][bj][m][1];
                    ss += ((v0.x * v0.x + v0.y * v0.y) + (v0.z * v0.z + v0.w * v0.w)) + ((v1.x * v1.x + v1.y * v1.y) + (v1.z * v1.z + v1.w * v1.w));
                    v4u w; w.x = pk2(v0.x, v0.y); w.y = pk2(v0.z, v0.w); w.z = pk2(v1.x, v1.y); w.w = pk2(v1.z, v1.w); *(v4u*)(rowp + bj * 128) = w; }
                ss += __shfl_xor(ss, 16); ss += __shfl_xor(ss, 32);
                if (fq == 0) rss[(size_t)row * 16 + u.pn * 4 + wc] = ss; }
    }
};
struct EpiConvIn {
    static constexpr bool PERM = true, AFTER_DRAIN = false;
    bf16* U; bf16* GB;
    __device__ __forceinline__ void operator()(const pg8::f32x4 (&acc)[2][2][4][2], const pg8::Unit& u, int wr, int wc, int fr, int fq) const {
        const int row0 = u.pm * 256 + wr * 64 + fr;
        if (u.pn < 8) {
            const int ch0 = u.pn * 128 + wc * 32 + 8 * fq;
#pragma unroll
            for (int ai = 0; ai < 2; ++ai)
#pragma unroll
                for (int m = 0; m < 4; ++m) { const f32x4 p0 = acc[ai][0][m][0] * acc[ai][1][m][0], p1 = acc[ai][0][m][1] * acc[ai][1][m][1];
                    v4u w; w.x = pk2(p0[0], p0[1]); w.y = pk2(p0[2], p0[3]); w.z = pk2(p1[0], p1[1]); w.w = pk2(p1[2], p1[3]);
                    *(v4u*)(U + (size_t)(row0 + ai * 128 + m * 16) * D + ch0) = w; }
        } else {
            const int col0 = (u.pn - 8) * 256 + wc * 32 + 8 * fq;
#pragma unroll
            for (int ai = 0; ai < 2; ++ai)
#pragma unroll
                for (int m = 0; m < 4; ++m)
#pragma unroll
                    for (int bj = 0; bj < 2; ++bj) { const f32x4 v0 = acc[ai][bj][m][0], v1 = acc[ai][bj][m][1];
                        v4u w; w.x = pk2(v0[0], v0[1]); w.y = pk2(v0[2], v0[3]); w.z = pk2(v1[0], v1[1]); w.w = pk2(v1[2], v1[3]);
                        *(v4u*)(GB + (size_t)(row0 + ai * 128 + m * 16) * D + col0 + bj * 128) = w; }
        }
    }
};
struct EpiF32 {
    static constexpr bool PERM = false, AFTER_DRAIN = false;
    float* O; int ldc;
    __device__ __forceinline__ void operator()(const pg8::f32x4 (&acc)[2][2][4][2], const pg8::Unit& u, int wr, int wc, int fr, int fq) const {
        const int col0 = u.pn * 256 + wc * 32 + 4 * fq;
#pragma unroll
        for (int ai = 0; ai < 2; ++ai)
#pragma unroll
            for (int m = 0; m < 4; ++m) { float* rowp = O + (size_t)(u.pm * 256 + ai * 128 + wr * 64 + m * 16 + fr) * ldc + col0;
#pragma unroll
                for (int bj = 0; bj < 2; ++bj)
#pragma unroll
                    for (int n = 0; n < 2; ++n) *(f32x4*)(rowp + bj * 128 + n * 16) = acc[ai][bj][m][n]; }
    }
};
struct EpiTopK {
    static constexpr bool PERM = false, AFTER_DRAIN = true;
    int* seli; float* selg; const float* rss;
    __device__ __forceinline__ void operator()(const pg8::f32x4 (&)[2][2][4][2], const pg8::Unit&, int, int, int, int) const {}
    __device__ __forceinline__ void fused(pg8::f32x4 (&acc)[2][2][4][2], const pg8::Unit& u, int wr, int wc, int fr, int fq, LAS unsigned char* lds, int wid, int lane) const {
        LAS float* S = (LAS float*)lds;
        LAS int* L = (LAS int*)lds;
        static_assert(128 * 260 * 4 + 128 * 33 * 4 <= PTAB_OFF, "top-k LDS map");
        const int tid = wid * 64 + lane;
#pragma unroll 1
        for (int ai = 0; ai < 2; ++ai) {
#pragma unroll
            for (int m = 0; m < 4; ++m)
#pragma unroll
                for (int bj = 0; bj < 2; ++bj)
#pragma unroll
                    for (int n = 0; n < 2; ++n) {
                        const int row = wr * 64 + m * 16 + fr, col = bj * 128 + wc * 32 + n * 16 + 4 * fq;
                        *(LAS f32x4*)(S + row * 260 + col) = ai == 0 ? acc[0][bj][m][n] : acc[1][bj][m][n];
                    }
            BLOCK_BAR();
            const int row = tid & 127, q = tid >> 7;
            int best[16];
            {
                const LAS f32x4* sp = (const LAS f32x4*)(S + row * 260 + q * 64);
#pragma unroll
                for (int c = 0; c < 4; ++c) {
                    int x[16];
#pragma unroll
                    for (int e4 = 0; e4 < 4; ++e4) { const f32x4 v = sp[c * 4 + e4];
#pragma unroll
                        for (int e = 0; e < 4; ++e) x[e4 * 4 + e] = (tk_map(v[e]) & ~127) | (127 - ((q & 1) * 64 + c * 16 + e4 * 4 + e)); }
                    tk_sort_desc(x);
                    if (c == 0) {
#pragma unroll
                        for (int e = 0; e < 16; ++e) best[e] = x[e];
                    } else tk_merge_top(best, x);
                }
            }
            BLOCK_BAR();
#pragma unroll
            for (int e4 = 0; e4 < 4; ++e4) *(LAS v4u*)(L + row * 68 + q * 16 + e4 * 4) = (v4u){(unsigned)best[e4 * 4], (unsigned)best[e4 * 4 + 1], (unsigned)best[e4 * 4 + 2], (unsigned)best[e4 * 4 + 3]};
            BLOCK_BAR();
            int mg[16];
            if (tid < 256) {
                int t[16];
                LAS int* Lr = L + (tid & 127) * 68 + (tid >> 7) * 32;
#pragma unroll
                for (int e4 = 0; e4 < 4; ++e4) { const v4u va = *(LAS v4u*)(Lr + e4 * 4), vt = *(LAS v4u*)(Lr + 16 + e4 * 4);
#pragma unroll
                    for (int e = 0; e < 4; ++e) { mg[e4 * 4 + e] = (int)va[e]; t[e4 * 4 + e] = (int)vt[e]; } }
                tk_merge_top(mg, t);
            }
            BLOCK_BAR();
            if (tid < 256) {
                LAS int* K = (ai == 0 ? (LAS int*)(lds + 128 * 260 * 4) : L) + (tid & 127) * 33 + (tid >> 7) * 16;
#pragma unroll
                for (int e = 0; e < 16; ++e) K[e] = mg[e];
            }
        }
        BLOCK_BAR();
        if (tid < 256) {
            int a[16], b[16];
            LAS int* Kr = ((tid >> 7) == 0 ? (LAS int*)(lds + 128 * 260 * 4) : L) + (tid & 127) * 33;
#pragma unroll
            for (int e = 0; e < 16; ++e) { a[e] = Kr[e]; b[e] = Kr[16 + e]; }
            const int trow = u.pm * 256 + tid;
            const f32x4 q0 = *(const f32x4*)(rss + (size_t)trow * 16), q1 = *(const f32x4*)(rss + (size_t)trow * 16 + 4), q2 = *(const f32x4*)(rss + (size_t)trow * 16 + 8), q3 = *(const f32x4*)(rss + (size_t)trow * 16 + 12);
            const float ssq = (((q0.x + q0.y) + (q0.z + q0.w)) + ((q1.x + q1.y) + (q1.z + q1.w))) + (((q2.x + q2.y) + (q2.z + q2.w)) + ((q3.x + q3.y) + (q3.z + q3.w)));
            const float rstd = 1.0f / sqrtf(ssq * (1.f / D) + RMS_EPS);
            const size_t o = ((size_t)trow * 8 + u.pn) * 16;
            tk_stage2(a, b, Kr, (__attribute__((address_space(1))) int*)(seli + o), (__attribute__((address_space(1))) float*)(selg + o), rstd);
        }
        BLOCK_BAR();
    }
};
struct OneUnit {
    pg8::Unit u;
    __device__ __forceinline__ bool next(int i, pg8::Unit& o) const { if (i != 0) return false; o = u; return true; }
    __device__ __forceinline__ void a_ready(const pg8::Unit&) const {}
    __device__ __forceinline__ void done(const pg8::Unit&) const {}
};

__device__ __forceinline__ void p0_transpose_item(const float* W, int ldw, int ncols, bf16* WT, float scale, LAS float* scr, int item, int lane) {
    const int nblk = ncols / 64, kb = item / nblk, nb = item % nblk, k0 = 64 * kb, n0 = 64 * nb;
    f32x4 v[16];
#pragma unroll
    for (int i = 0; i < 16; ++i) v[i] = __builtin_nontemporal_load((const f32x4*)(W + (size_t)(k0 + 4 * i + (lane >> 4)) * ldw + n0 + 4 * (lane & 15)));
#pragma unroll
    for (int i = 0; i < 16; ++i) { LAS float* p = scr + (4 * i + (lane >> 4)) * 65 + 4 * (lane & 15); p[0] = v[i].x * scale; p[1] = v[i].y * scale; p[2] = v[i].z * scale; p[3] = v[i].w * scale; }
    LDS_WAIT(); asm volatile("" ::: "memory");
    const int c = lane & 7;
#pragma unroll
    for (int j = 0; j < 8; ++j) { const int n = (lane >> 3) + 8 * j; const LAS float* s = scr + (8 * c) * 65 + n;
        v4u o; o.x = pk2(s[0 * 65], s[1 * 65]); o.y = pk2(s[2 * 65], s[3 * 65]); o.z = pk2(s[4 * 65], s[5 * 65]); o.w = pk2(s[6 * 65], s[7 * 65]);
        *(v4u*)(WT + (size_t)(n0 + n) * 1024 + k0 + 8 * c) = o; }
    LDS_WAIT(); asm volatile("" ::: "memory");
}
__device__ __forceinline__ void rms_row_to_bf16(const float* xrow, const float* gain, bf16* orow, float* hcopy, int lane) {
    const f32x4* xr = (const f32x4*)xrow + lane; const f32x4* gr = (const f32x4*)gain + lane;
    f32x4 v[4]; float s = 0.f;
#pragma unroll
    for (int j = 0; j < 4; ++j) { v[j] = xr[64 * j]; s += (v[j].x * v[j].x + v[j].y * v[j].y) + (v[j].z * v[j].z + v[j].w * v[j].w); }
    if (hcopy) {
#pragma unroll
        for (int j = 0; j < 4; ++j) ((f32x4*)hcopy + lane)[64 * j] = v[j];
    }
    const float rstd = 1.0f / sqrtf(wave_sum(s) * (1.f / D) + RMS_EPS);
    unsigned long long* o8 = (unsigned long long*)orow + lane;
#pragma unroll
    for (int j = 0; j < 4; ++j) { const f32x4 g = gr[64 * j]; const f32x4 y = v[j] * rstd * g;
        o8[64 * j] = (unsigned long long)pk2(y.x, y.y) | ((unsigned long long)pk2(y.z, y.w) << 32); }
}
__device__ __forceinline__ void p0_dense(Frame& F, bool dry) {
    if (!(dry && PROBE_PMODE == 1)) {
        LAS float* KL = (LAS float*)F.lds;
        LAS float* WL = (LAS float*)(F.lds + 128 * 132 * 4);
        const float* in10 = F.in(10); const float* in11 = F.in(11); const float* in2 = F.in(2);
        f32x4 kreg[8], wreg[4];
#define FOLD_LOAD(it_) do { const int l_ = (it_) >> 8, hp_ = ((it_) >> 4) & 15, k0_ = ((it_) & 15) * 64; \
            const float* kg_ = in11 + (size_t)(l_ * 16 + hp_) * 128 * 128; const float* wg_ = in10 + (size_t)l_ * 1024 * 2048 + (size_t)k0_ * 2048 + hp_ * 128; \
            _Pragma("unroll") for (int i = 0; i < 8; ++i) kreg[i] = *(const f32x4*)(kg_ + 4 * (F.tid + 512 * i)); \
            _Pragma("unroll") for (int i = 0; i < 4; ++i) { const int e = 4 * (F.tid + 512 * i); wreg[i] = __builtin_nontemporal_load((const f32x4*)(wg_ + (size_t)(e >> 7) * 2048 + (e & 127))); } } while (0)
        if (F.vcu < DEPTH * 16 * 16) FOLD_LOAD(F.vcu);
        for (int it = F.vcu; it < DEPTH * 16 * 16; it += F.G) {
            const int l = it >> 8, hp = (it >> 4) & 15, k0 = (it & 15) * 64;
#pragma unroll
            for (int i = 0; i < 8; ++i) { const int e = 4 * (F.tid + 512 * i), n = e >> 7, d = e & 127; *(LAS f32x4*)(KL + n * 132 + d) = kreg[i]; }
#pragma unroll
            for (int i = 0; i < 4; ++i) { const int e = 4 * (F.tid + 512 * i), kk = e >> 7, d = e & 127; *(LAS f32x4*)(WL + kk * 132 + d) = wreg[i]; }
            if (it + F.G < DEPTH * 16 * 16) FOLD_LOAD(it + F.G);
            BLOCK_BAR();
            {
                const int i16 = F.lane & 15, g4 = F.lane >> 4, nt = F.wave;
                f32x4 facc[4];
#pragma unroll
                for (int mt = 0; mt < 4; ++mt) facc[mt] = (f32x4){0.f, 0.f, 0.f, 0.f};
#pragma unroll 2
                for (int s8 = 0; s8 < 8; ++s8) {
                    const f32x4 bq = *(const LAS f32x4*)(KL + (nt * 16 + i16) * 132 + 16 * s8 + 4 * g4);
                    f32x4 aq[4];
#pragma unroll
                    for (int mt = 0; mt < 4; ++mt) aq[mt] = *(const LAS f32x4*)(WL + (mt * 16 + i16) * 132 + 16 * s8 + 4 * g4);
#pragma unroll
                    for (int t = 0; t < 4; ++t)
#pragma unroll
                        for (int mt = 0; mt < 4; ++mt) facc[mt] = __builtin_amdgcn_mfma_f32_16x16x4f32(aq[mt][t], bq[t], facc[mt], 0, 0, 0);
                }
                bf16* o = (bf16*)(F.ws + WS_WP) + (size_t)l * 2048 * 1024 + (size_t)(hp * 128 + nt * 16 + i16) * 1024 + k0 + 4 * g4;
#pragma unroll
                for (int mt = 0; mt < 4; ++mt) { const f32x4 gf = *(const f32x4*)(in2 + (size_t)l * D + k0 + mt * 16 + 4 * g4); v2u w; w.x = pk2(facc[mt][0] * gf.x, facc[mt][1] * gf.y); w.y = pk2(facc[mt][2] * gf.z, facc[mt][3] * gf.w); *(v2u*)(o + mt * 16) = w; }
            }
            BLOCK_BAR();
        }
#undef FOLD_LOAD
    }
    LAS float* scr = (LAS float*)(F.lds + F.wave * 16640);
    const int gw = F.vcu * NWAVES + F.wave, NGW = F.G * NWAVES;
    constexpr int I_SQ = 16 * 16, I_IN = 16 * 48, PER_J = 3 * I_SQ + I_SQ + I_IN + I_SQ;
    if (!(dry && PROBE_PMODE == 2)) for (int it = gw; it < 2 * PER_J; it += NGW) {
        const int j = it / PER_J; int r = it % PER_J;
        const float* wqkv = F.in(4) + (size_t)j * 1024 * 3072;
        if (r < I_SQ) { p0_transpose_item(wqkv, 3072, 1024, (bf16*)(F.ws + WS_WQK) + (size_t)j * 2048 * 1024, 0.125f, scr, r, F.lane); continue; } r -= I_SQ;
        if (r < I_SQ) { p0_transpose_item(wqkv + 1024, 3072, 1024, (bf16*)(F.ws + WS_WQK) + (size_t)j * 2048 * 1024 + (size_t)1024 * 1024, 1.f, scr, r, F.lane); continue; } r -= I_SQ;
        if (r < I_SQ) { p0_transpose_item(wqkv + 2048, 3072, 1024, (bf16*)(F.ws + WS_WV) + (size_t)j * 1024 * 1024, 1.f, scr, r, F.lane); continue; } r -= I_SQ;
        if (r < I_SQ) { p0_transpose_item(F.in(5) + (size_t)j * 1024 * 1024, 1024, 1024, (bf16*)(F.ws + WS_WO) + (size_t)j * 1024 * 1024, 1.f, scr, r, F.lane); continue; } r -= I_SQ;
        if (r < I_IN) {
            const float* win = F.in(7) + (size_t)j * 1024 * 3072; bf16* wt = (bf16*)(F.ws + WS_WIN) + (size_t)j * 3072 * 1024;
            if (r < 512) { const int blk = r >> 5, pn = blk >> 1, which = blk & 1; p0_transpose_item(win + (which ? 2048 : 1024) + 128 * pn, 3072, 128, wt + (size_t)(256 * pn + 128 * which) * 1024, 1.f, scr, r & 31, F.lane); }
            else p0_transpose_item(win, 3072, 1024, wt + (size_t)2048 * 1024, 1.f, scr, r - 512, F.lane);
            continue; } r -= I_IN;
        p0_transpose_item(F.in(9) + (size_t)j * 1024 * 1024, 1024, 1024, (bf16*)(F.ws + WS_WOUT) + (size_t)j * 1024 * 1024, 1.f, scr, r, F.lane);
    }
}
__device__ __forceinline__ void p0_tables(Frame& F, bool dry) {
    const int gw = F.vcu * NWAVES + F.wave, NGW = F.G * NWAVES;
    if (!(dry && PROBE_PMODE == 3)) {
        constexpr int NROW = DEPTH * 16384;
        const float* in12 = F.in(12); const float* in13 = F.in(13);
#define XC_LOAD(v, r0_) do { const int tb_ = (r0_) >= NROW ? 1 : 0, rr_ = (r0_) - tb_ * NROW; const float* src_ = (tb_ ? in13 : in12) + (size_t)rr_ * 1024 + 4 * F.lane; \
            _Pragma("unroll") for (int u = 0; u < 4; ++u) _Pragma("unroll") for (int i = 0; i < 4; ++i) v[u][i] = __builtin_nontemporal_load((const f32x4*)(src_ + (size_t)u * 1024 + 256 * i)); } while (0)
#if EXPERT_FP4
#define XC_PACK(v, u, q, dstp) do { v2u w_; _Pragma("unroll") for (int jj = 0; jj < 2; ++jj) { unsigned t_ = 0u; \
                    t_ = __builtin_amdgcn_cvt_scalef32_pk_fp4_f32(t_, v[u][2 * jj].x * q, v[u][2 * jj].y * q, 1.0f, 0); t_ = __builtin_amdgcn_cvt_scalef32_pk_fp4_f32(t_, v[u][2 * jj].z * q, v[u][2 * jj].w * q, 1.0f, 1); \
                    t_ = __builtin_amdgcn_cvt_scalef32_pk_fp4_f32(t_, v[u][2 * jj + 1].x * q, v[u][2 * jj + 1].y * q, 1.0f, 2); t_ = __builtin_amdgcn_cvt_scalef32_pk_fp4_f32(t_, v[u][2 * jj + 1].z * q, v[u][2 * jj + 1].w * q, 1.0f, 3); w_[jj] = t_; } \
                *(v2u*)(dstp) = w_; } while (0)
        constexpr float QMAX = 6.0f;
#else
#define XC_PACK(v, u, q, dstp) do { v4u w_; _Pragma("unroll") for (int i = 0; i < 4; ++i) { unsigned t_ = 0u; t_ = __builtin_amdgcn_cvt_pk_fp8_f32(v[u][i].x * q, v[u][i].y * q, t_, false); t_ = __builtin_amdgcn_cvt_pk_fp8_f32(v[u][i].z * q, v[u][i].w * q, t_, true); w_[i] = t_; } \
                *(v4u*)(dstp) = w_; } while (0)
        constexpr float QMAX = 256.0f;
#endif
#define XC_I4(x_) ((unsigned)__float2int_rn(x_) & 15u)
#define XC_PACK_I4(v, u, q, dstp) do { v2u w_; _Pragma("unroll") for (int jj = 0; jj < 2; ++jj) { const f32x4 a_ = v[u][2 * jj] * q, b_ = v[u][2 * jj + 1] * q; \
                    w_[jj] = XC_I4(a_.x) | (XC_I4(a_.y) << 4) | (XC_I4(a_.z) << 8) | (XC_I4(a_.w) << 12) | (XC_I4(b_.x) << 16) | (XC_I4(b_.y) << 20) | (XC_I4(b_.z) << 24) | (XC_I4(b_.w) << 28); } \
                *(v2u*)(dstp) = w_; } while (0)
#define XC_CONV(v, r0_) do { const int tb_ = (r0_) >= NROW ? 1 : 0, rr_ = (r0_) - tb_ * NROW; \
            unsigned char* dst_ = F.ws + (tb_ ? WS_DN : WS_UP) + (size_t)rr_ * ROWB + (tb_ ? 8 * F.lane : up_off_); float* sc_ = (float*)(F.ws + WS_SUP) + 2 * (size_t)rr_ + tb_; \
            _Pragma("unroll") for (int u = 0; u < 4; ++u) { float mx = 0.f; \
                _Pragma("unroll") for (int i = 0; i < 4; ++i) mx = fmaxf(fmaxf(mx, fmaxf(fabsf(v[u][i].x), fabsf(v[u][i].y))), fmaxf(fabsf(v[u][i].z), fabsf(v[u][i].w))); \
                _Pragma("unroll") for (int o = 1; o < 64; o <<= 1) mx = fmaxf(mx, __shfl_xor(mx, o)); \
                if (tb_) { const float q = mx > 0.f ? 7.0f / mx : 1.0f; XC_PACK_I4(v, u, q, dst_ + (size_t)u * ROWB); if (F.lane == 0) sc_[2 * u] = mx > 0.f ? mx * (1.0f / 7.0f) : 1.0f; } \
                else { const float q = mx > 0.f ? QMAX / mx : 1.0f; XC_PACK(v, u, q, dst_ + (size_t)u * ROWB); if (F.lane == 0) sc_[2 * u] = mx > 0.f ? mx * (1.0f / QMAX) : 1.0f; } } } while (0)
        const int c16_ = F.lane >> 1, up_off_ = 16 * (16 * (c16_ >> 4) + 4 * (c16_ & 3) + ((c16_ >> 2) & 3)) + 8 * (F.lane & 1);
        const int stepr = NGW * 4;
        f32x4 va[4][4], vb[4][4];
        int r0 = gw * 4;
        if (r0 < 2 * NROW) XC_LOAD(va, r0);
#pragma unroll 1
        for (; r0 < 2 * NROW; r0 += 2 * stepr) {
            if (r0 + stepr < 2 * NROW) XC_LOAD(vb, r0 + stepr);
            XC_CONV(va, r0);
            if (r0 + 2 * stepr < 2 * NROW) XC_LOAD(va, r0 + 2 * stepr);
            if (r0 + stepr < 2 * NROW) XC_CONV(vb, r0 + stepr);
        }
#undef XC_LOAD
#undef XC_PACK
#undef XC_PACK_I4
#undef XC_I4
#undef XC_CONV
    }
}
__device__ __forceinline__ void p0_prologue(Frame& F, bool dry) {
    if (((int)blockIdx.x >> 3) & 1) { p0_tables(F, dry); p0_dense(F, dry); } else { p0_dense(F, dry); p0_tables(F, dry); }
    const int gw = F.vcu * NWAVES + F.wave, NGW = F.G * NWAVES;
    if (!(dry && PROBE_PMODE == 4)) {
        const float* x0 = F.in(0); const f32x4* gr = (const f32x4*)F.in(1) + F.lane;
        f32x4 gq[4];
#pragma unroll
        for (int j = 0; j < 4; ++j) gq[j] = gr[64 * j];
#pragma unroll 1
        for (int m0 = gw; m0 < M; m0 += 4 * NGW) {
            f32x4 v[4][4];
#pragma unroll
            for (int u = 0; u < 4; ++u) { const int m = m0 + u * NGW; if (m < M) {
#pragma unroll
                for (int j = 0; j < 4; ++j) v[u][j] = __builtin_nontemporal_load((const f32x4*)(x0 + (size_t)m * D) + F.lane + 64 * j); } }
#pragma unroll
            for (int u = 0; u < 4; ++u) { const int m = m0 + u * NGW; if (m < M) {
                float sq = 0.f;
#pragma unroll
                for (int j = 0; j < 4; ++j) { sq += (v[u][j].x * v[u][j].x + v[u][j].y * v[u][j].y) + (v[u][j].z * v[u][j].z + v[u][j].w * v[u][j].w); }
                const float rstd = 1.0f / sqrtf(wave_sum(sq) * (1.f / D) + RMS_EPS);
                unsigned long long* o8 = (unsigned long long*)((bf16*)(F.ws + WS_HN) + (size_t)m * D) + F.lane;
#pragma unroll
                for (int j = 0; j < 4; ++j) { const f32x4 y = v[u][j] * rstd * gq[j]; o8[64 * j] = (unsigned long long)pk2(y.x, y.y) | ((unsigned long long)pk2(y.z, y.w) << 32); } } }
        }
    }
}

__device__ __forceinline__ void conv_phase(Frame& F, int j) {
    const bf16* U = (const bf16*)(F.ws + WS_BIG); const bf16* GB = (const bf16*)(F.ws + WS_BIG + 32 * MiB); bf16* mix = (bf16*)(F.ws + WS_MIX);
    const float* wc = F.in(8) + (size_t)j * 3 * 1024;
    constexpr int RUN = 16;
    for (int idx = F.vcu * NTHR + F.tid; idx < (M / RUN) * 128; idx += F.G * NTHR) {
        const int t0 = (idx >> 7) * RUN, c8 = (idx & 127) * 8, s0 = t0 & (SEQ - 1);
        f32x4 w[3][2];
#pragma unroll
        for (int dj = 0; dj < 3; ++dj) { w[dj][0] = *(const f32x4*)(wc + dj * 1024 + c8); w[dj][1] = *(const f32x4*)(wc + dj * 1024 + c8 + 4); }
        const v4u zero = (v4u){0u, 0u, 0u, 0u};
        v4u up = s0 > 0 ? *(const v4u*)(U + (size_t)(t0 - 1) * D + c8) : zero;
        v4u uc = *(const v4u*)(U + (size_t)t0 * D + c8);
#pragma unroll 4
        for (int k = 0; k < RUN; ++k) {
            const int t = t0 + k;
            const v4u un = (s0 + k + 1 < SEQ) ? *(const v4u*)(U + (size_t)(t + 1) * D + c8) : zero;
            const v4u gb = *(const v4u*)(GB + (size_t)t * D + c8);
            v4u o;
#pragma unroll
            for (int e2 = 0; e2 < 4; ++e2) {
                const float w0l = e2 < 2 ? w[0][0][2 * e2] : w[0][1][2 * e2 - 4], w0h = e2 < 2 ? w[0][0][2 * e2 + 1] : w[0][1][2 * e2 - 3];
                const float w1l = e2 < 2 ? w[1][0][2 * e2] : w[1][1][2 * e2 - 4], w1h = e2 < 2 ? w[1][0][2 * e2 + 1] : w[1][1][2 * e2 - 3];
                const float w2l = e2 < 2 ? w[2][0][2 * e2] : w[2][1][2 * e2 - 4], w2h = e2 < 2 ? w[2][0][2 * e2 + 1] : w[2][1][2 * e2 - 3];
                const float cl = (w0l * bflo(up[e2]) + w1l * bflo(uc[e2])) + w2l * bflo(un[e2]);
                const float chh = (w0h * bfhi(up[e2]) + w1h * bfhi(uc[e2])) + w2h * bfhi(un[e2]);
                o[e2] = pk2(bflo(gb[e2]) * cl, bfhi(gb[e2]) * chh);
            }
            *(v4u*)(mix + (size_t)t * 1024 + c8) = o;
            up = uc; uc = un;
        }
    }
}

constexpr int AT_KSTR = 144, AT_VSTR = 1168, AT_KOFF = 0, AT_VOFF = 576 * AT_KSTR, AT_BOFF = AT_VOFF + 64 * AT_VSTR;
static_assert(AT_BOFF + 1860 <= PTAB_OFF, "attention LDS map");
__device__ __forceinline__ void attn_phase(Frame& F, int j) {
    const bf16* QK = (const bf16*)(F.ws + WS_BIG); const bf16* VT = (const bf16*)(F.ws + WS_VT); bf16* mix = (bf16*)(F.ws + WS_MIX);
    const float* biasl = F.in(6) + (size_t)j * NH * 15 * 31;
    const int lane = F.lane, q = lane & 15, g = lane >> 4, tid = F.tid;
    LAS unsigned char* KL = F.lds + AT_KOFF; LAS unsigned char* VL = F.lds + AT_VOFF; LAS float* btab = (LAS float*)(F.lds + AT_BOFF);
#define AT_R0(rp_) ({ int R_ = 2 * (rp_) - 4; R_ < 0 ? 0 : (R_ > NROWS - 8 ? NROWS - 8 : R_); })
#pragma unroll 1
    for (int ch = F.vcu; ch < 256; ch += F.G) {
        const int hh = ch & 15, rp0 = 8 * ((ch >> 4) & 7), b = ch >> 7;
        BLOCK_BAR();
        {
            const int R0 = AT_R0(rp0);
#pragma unroll
            for (int i = 0; i < 9; ++i) { const int c = tid + 512 * i;
                { const int key = c >> 3, cc = c & 7; int row = R0 + (key >> 6); row = row > NROWS - 1 ? NROWS - 1 : row;
                  const v4u kv = *(const v4u*)(QK + ((size_t)b * SEQ + row * 64 + (key & 63)) * 2048 + 1024 + hh * 64 + cc * 8);
                  *(LAS v4u*)(KL + ((row % 9) * 64 + (key & 63)) * AT_KSTR + cc * 16) = kv; }
                { const int d = c / 72, kch = c - d * 72; int row = R0 + (kch >> 3); row = row > NROWS - 1 ? NROWS - 1 : row; const int col8 = (kch & 7) * 8;
                  const v4u vv = *(const v4u*)(VT + (size_t)(hh * 64 + d) * M + (size_t)b * SEQ + row * 64 + col8);
                  *(LAS v4u*)(VL + d * AT_VSTR + ((row % 9) * 64 + col8) * 2) = vv; } }
            if (tid < 465) btab[tid] = biasl[(size_t)hh * 465 + tid];
        }
        v4u kreg[2], vreg[2]; int newrow = -1;
#pragma unroll 1
        for (int ii = 0; ii < 8; ++ii) {
            const int rp = rp0 + ii, r0 = 2 * rp; const int R0 = AT_R0(rp);
            BLOCK_BAR();
            if (ii > 0 && newrow >= 0) {
#pragma unroll
                for (int i = 0; i < 2; ++i) { const int c = tid + 512 * i;
                    { const int key = c >> 3, cc = c & 7; const int row = newrow + (key >> 6); *(LAS v4u*)(KL + ((row % 9) * 64 + (key & 63)) * AT_KSTR + cc * 16) = kreg[i]; }
                    { const int d = c >> 4, kch = c & 15; const int row = newrow + (kch >> 3), col8 = (kch & 7) * 8; *(LAS v4u*)(VL + d * AT_VSTR + ((row % 9) * 64 + col8) * 2) = vreg[i]; } }
            }
            BLOCK_BAR();
            newrow = -1;
            if (ii < 7) { const int Rn = AT_R0(rp + 1); if (Rn != R0) { newrow = Rn + 7;
#pragma unroll
                for (int i = 0; i < 2; ++i) { const int c = tid + 512 * i;
                    { const int key = c >> 3, cc = c & 7; int row = newrow + (key >> 6); row = row > NROWS - 1 ? NROWS - 1 : row;
                      kreg[i] = *(const v4u*)(QK + ((size_t)b * SEQ + row * 64 + (key & 63)) * 2048 + 1024 + hh * 64 + cc * 8); }
                    { const int d = c >> 4, kch = c & 15; int row = newrow + (kch >> 3); row = row > NROWS - 1 ? NROWS - 1 : row; const int col8 = (kch & 7) * 8;
                      vreg[i] = *(const v4u*)(VT + (size_t)(hh * 64 + d) * M + (size_t)b * SEQ + row * 64 + col8); } } } }
            const int r = r0 + (F.wave >> 2), jb = F.wave & 3;
            int rs = r - 4; rs = rs < 0 ? 0 : (rs > NROWS - 8 ? NROWS - 8 : rs);
            const int sl0 = rs % 9;
            int bs = 16 * jb - 8; bs = bs < 0 ? 0 : (bs > 32 ? 32 : bs);
            const int qc = 16 * jb + q; int wst = qc - 8; wst = wst < 0 ? 0 : (wst > 48 ? 48 : wst);
            const size_t tokq = (size_t)b * SEQ + r * 64 + qc;
            bf16x8 qf[2];
#pragma unroll
            for (int ks = 0; ks < 2; ++ks) qf[ks] = *(const bf16x8*)(QK + tokq * 2048 + hh * 64 + ks * 32 + 8 * g);
            f32x4 S[8][2];
            const int kcl_a = 8 * (q >> 2) + (q & 3);
#pragma unroll
            for (int wr = 0; wr < 8; ++wr) { const int sl = sl0 + wr >= 9 ? sl0 + wr - 9 : sl0 + wr;
#pragma unroll
                for (int T = 0; T < 2; ++T) {
                    const LAS unsigned char* kp = KL + (sl * 64 + bs + kcl_a + 4 * T) * AT_KSTR + 16 * g;
                    const bf16x8 k0 = *(const LAS bf16x8*)kp, k1 = *(const LAS bf16x8*)(kp + 64);
                    f32x4 c = (f32x4){0.f, 0.f, 0.f, 0.f};
                    c = __builtin_amdgcn_mfma_f32_16x16x32_bf16(k0, qf[0], c, 0, 0, 0);
                    c = __builtin_amdgcn_mfma_f32_16x16x32_bf16(k1, qf[1], c, 0, 0, 0);
                    S[wr][T] = c;
                } }
            float mx = -3.0e38f;
#pragma unroll
            for (int wr = 0; wr < 8; ++wr) {
                const LAS float* brow = btab + (rs + wr - r + 7) * 31;
#pragma unroll
                for (int T = 0; T < 2; ++T)
#pragma unroll
                    for (int i = 0; i < 4; ++i) {
                        const int kc = bs + 8 * g + 4 * T + i;
                        int co = kc - qc + 15; co = co < 0 ? 0 : (co > 30 ? 30 : co);
                        const bool valid = (kc >= wst) && (kc < wst + 16);
                        const float v = valid ? S[wr][T][i] + brow[co] : -1e30f;
                        S[wr][T][i] = v; mx = fmaxf(mx, v);
                    }
            }
            mx = fmaxf(mx, __shfl_xor(mx, 16)); mx = fmaxf(mx, __shfl_xor(mx, 32));
            float sum = 0.f;
            bf16x8 pf[8];
#pragma unroll
            for (int wr = 0; wr < 8; ++wr) {
                float p[8];
#pragma unroll
                for (int T = 0; T < 2; ++T)
#pragma unroll
                    for (int i = 0; i < 4; ++i) { p[4 * T + i] = __expf(S[wr][T][i] - mx); sum += p[4 * T + i]; }
                v4u w; w.x = pk2(p[0], p[1]); w.y = pk2(p[2], p[3]); w.z = pk2(p[4], p[5]); w.w = pk2(p[6], p[7]);
                pf[wr] = __builtin_bit_cast(bf16x8, w);
            }
            sum += __shfl_xor(sum, 16); sum += __shfl_xor(sum, 32);
            f32x4 O[4];
#pragma unroll
            for (int dt = 0; dt < 4; ++dt) O[dt] = (f32x4){0.f, 0.f, 0.f, 0.f};
#pragma unroll
            for (int wr = 0; wr < 8; ++wr) { const int sl = sl0 + wr >= 9 ? sl0 + wr - 9 : sl0 + wr;
#pragma unroll
                for (int dt = 0; dt < 4; ++dt) {
                    const bf16x8 vf = *(const LAS bf16x8*)(VL + (dt * 16 + q) * AT_VSTR + (sl * 64 + bs + 8 * g) * 2);
                    O[dt] = __builtin_amdgcn_mfma_f32_16x16x32_bf16(vf, pf[wr], O[dt], 0, 0, 0);
                } }
            const float inv = 1.0f / sum;
#pragma unroll
            for (int dt = 0; dt < 4; ++dt) { v2u w; w.x = pk2(O[dt][0] * inv, O[dt][1] * inv); w.y = pk2(O[dt][2] * inv, O[dt][3] * inv);
                *(v2u*)(mix + tokq * 1024 + hh * 64 + dt * 16 + 4 * g) = w; }
        }
    }
#undef AT_R0
    BLOCK_BAR();
}
#if NAIVE_ATTN
__device__ __forceinline__ void attn_naive_phase(Frame& F, int j) {
    const bf16* QK = (const bf16*)(F.ws + WS_BIG); const bf16* VT = (const bf16*)(F.ws + WS_VT); bf16* mix = (bf16*)(F.ws + WS_MIX);
    const float* biasl = F.in(6) + (size_t)j * NH * 15 * 31;
    for (int idx = F.vcu * NTHR + F.tid; idx < M * NH; idx += F.G * NTHR) {
        const int hh = idx & 15, t = idx >> 4, b = t >> 13, s = t & (SEQ - 1), r = s >> 6, qc = s & 63;
        int rs = r - 4; rs = rs < 0 ? 0 : (rs > NROWS - 8 ? NROWS - 8 : rs);
        int wst = qc - 8; wst = wst < 0 ? 0 : (wst > 48 ? 48 : wst);
        float qv[64];
#pragma unroll
        for (int c = 0; c < 8; ++c) { const v4u w = *(const v4u*)(QK + (size_t)t * 2048 + hh * 64 + c * 8);
#pragma unroll
            for (int e = 0; e < 4; ++e) { qv[c * 8 + 2 * e] = bflo(w[e]); qv[c * 8 + 2 * e + 1] = bfhi(w[e]); } }
        float mrun = -3.0e38f, lrun = 0.f, o[64];
#pragma unroll
        for (int d = 0; d < 64; ++d) o[d] = 0.f;
        for (int wr = 0; wr < 8; ++wr)
            for (int kk = 0; kk < 16; ++kk) {
                const int kc = wst + kk; const size_t tk = (size_t)b * SEQ + (rs + wr) * 64 + kc;
                float sd = 0.f;
#pragma unroll
                for (int c = 0; c < 8; ++c) { const v4u w = *(const v4u*)(QK + tk * 2048 + 1024 + hh * 64 + c * 8);
#pragma unroll
                    for (int e = 0; e < 4; ++e) sd += qv[c * 8 + 2 * e] * bflo(w[e]) + qv[c * 8 + 2 * e + 1] * bfhi(w[e]); }
                int co = kc - qc + 15; co = co < 0 ? 0 : (co > 30 ? 30 : co);
                sd += biasl[(size_t)hh * 465 + (rs + wr - r + 7) * 31 + co];
                const float mn = fmaxf(mrun, sd), al = __expf(mrun - mn), p = __expf(sd - mn);
                lrun = lrun * al + p; mrun = mn;
#pragma unroll
                for (int d = 0; d < 64; ++d) o[d] = o[d] * al + p * bflo((unsigned)VT[(size_t)(hh * 64 + d) * M + tk]);
            }
        const float inv = 1.0f / lrun;
#pragma unroll
        for (int c = 0; c < 8; ++c) { v4u w;
#pragma unroll
            for (int e = 0; e < 4; ++e) w[e] = pk2(o[c * 8 + 2 * e] * inv, o[c * 8 + 2 * e + 1] * inv);
            *(v4u*)(mix + (size_t)t * 1024 + hh * 64 + c * 8) = w; }
    }
}
#endif
#if NAIVE_TOPK
__device__ __forceinline__ void select_naive_phase(Frame& F) {
    const float* SC = (const float*)(F.ws + WS_SC); int* seli = (int*)(F.ws + WS_SELI); float* selg = (float*)(F.ws + WS_SELG);
    LAS int* AB = (LAS int*)F.lds + F.tid * 33;
    for (int idx = F.vcu * NTHR + F.tid; idx < M * 8; idx += F.G * NTHR) {
        const float* s = SC + (size_t)idx * 256;
        int a[16], b[16], t[16];
        tk_stage1<4>(s, 0, a); tk_stage1<4>(s + 64, 64, t); tk_merge_top(a, t);
        tk_stage1<4>(s + 128, 0, b); tk_stage1<4>(s + 192, 64, t); tk_merge_top(b, t);
        tk_stage2(a, b, AB, seli + (size_t)idx * 16, selg + (size_t)idx * 16);
    }
}
#endif

__device__ __forceinline__ float gelu_erf(float a) { return 0.5f * a * (1.0f + erff(a * 0.70710678118654752f)); }
typedef float f32x2g __attribute__((ext_vector_type(2)));
#if EXPERT_FP4
typedef v2u rowv;
__device__ __forceinline__ rowv row_load(const unsigned char* T, int e, int lane) { return *(const v2u*)(T + (size_t)e * ROWB + 8 * lane); }
#define ROW_PAIR(r, m) __builtin_amdgcn_cvt_scalef32_pk_f32_fp4((r)[(m) >> 2], 1.0f, (m) & 3)
#else
typedef v4u rowv;
__device__ __forceinline__ rowv row_load(const unsigned char* T, int e, int lane) { return *(const v4u*)(T + (size_t)e * ROWB + 16 * lane); }
#define ROW_PAIR(r, m) __builtin_amdgcn_cvt_pk_f32_fp8((r)[(m) >> 1], ((m) & 1) != 0)
#endif
__device__ __forceinline__ void row_axpy(f32x2g (&out)[8], const rowv d, float ak) {
    const f32x2g a2 = (f32x2g){ak, ak};
    out[0] = __builtin_elementwise_fma(a2, ROW_PAIR(d, 0), out[0]); out[1] = __builtin_elementwise_fma(a2, ROW_PAIR(d, 1), out[1]); out[2] = __builtin_elementwise_fma(a2, ROW_PAIR(d, 2), out[2]); out[3] = __builtin_elementwise_fma(a2, ROW_PAIR(d, 3), out[3]);
    out[4] = __builtin_elementwise_fma(a2, ROW_PAIR(d, 4), out[4]); out[5] = __builtin_elementwise_fma(a2, ROW_PAIR(d, 5), out[5]); out[6] = __builtin_elementwise_fma(a2, ROW_PAIR(d, 6), out[6]); out[7] = __builtin_elementwise_fma(a2, ROW_PAIR(d, 7), out[7]);
}
typedef int v8i_g __attribute__((ext_vector_type(8)));
typedef unsigned char u8x4g __attribute__((ext_vector_type(4)));
#define TR_SHUF(a, b, i0, i1, i2, i3) __builtin_amdgcn_perm((unsigned)(b), (unsigned)(a), (unsigned)((i0) | ((i1) << 8) | ((i2) << 16) | ((i3) << 24)))
__device__ __forceinline__ void tr8_nib(const unsigned (&w)[8], unsigned (&t)[8]) {
    unsigned x[8], y[8];
#pragma unroll
    for (int r = 0; r < 4; ++r) { x[r] = TR_SHUF(w[r], w[r + 4], 0, 1, 4, 5); x[r + 4] = TR_SHUF(w[r], w[r + 4], 2, 3, 6, 7); }
#pragma unroll
    for (int g = 0; g < 2; ++g)
#pragma unroll
        for (int r = 0; r < 2; ++r) { y[4 * g + r] = TR_SHUF(x[4 * g + r], x[4 * g + r + 2], 0, 4, 2, 6); y[4 * g + r + 2] = TR_SHUF(x[4 * g + r], x[4 * g + r + 2], 1, 5, 3, 7); }
#pragma unroll
    for (int p = 0; p < 4; ++p) { const unsigned e = y[2 * p], o = y[2 * p + 1];
        t[2 * p] = (e & 0x0F0F0F0Fu) | ((o << 4) & 0xF0F0F0F0u);
        t[2 * p + 1] = ((e >> 4) & 0x0F0F0F0Fu) | (o & 0xF0F0F0F0u); }
}
__device__ __forceinline__ int sel2(bool hf, int e0, int e1) { return hf ? e1 : e0; }
template <int PART> __device__ __forceinline__ void gather_phase(Frame& F, int layer, bool dry) {
    const unsigned char* UP = F.ws + WS_UP + (size_t)layer * 16384 * ROWB; const unsigned char* DN = F.ws + WS_DN + (size_t)layer * 16384 * ROWB;
    const f32x2g* SC2 = (const f32x2g*)(F.ws + WS_SUP) + (size_t)layer * 16384;
    const float* gain = F.in(2) + (size_t)layer * D; const float* gnext = layer < DEPTH - 1 ? F.in(1) + (size_t)(layer + 1) * D : F.in(3);
    float* outp = F.out();
    const int* seli = (const int*)(F.ws + WS_SELI); const float* selg = (const float*)(F.ws + WS_SELG);
    const float* ACTG = (const float*)(F.ws + WS_ACTG); float* ACTW = (float*)(F.ws + (dry ? WS_SC : WS_ACTG));
    const bf16* H = (const bf16*)(F.ws + WS_H); bf16* HN = (bf16*)(F.ws + (dry ? WS_SC + 64 * MiB : WS_HN)); bf16* HW = (bf16*)(F.ws + (dry ? WS_SC : WS_H)); if (dry) outp = (float*)(F.ws + WS_SC);
    const int lane = F.lane, gw = F.vcu * NWAVES + F.wave, NGW = F.G * NWAVES;
    const bool b5 = lane & 32, b4 = lane & 16, b3 = lane & 8, b2 = lane & 4;
    constexpr int G_RS = 528, G_RB = 32 * G_RS, G_NSLOT = 4;
    LAS unsigned char* RB = F.lds + F.wave * G_RB;
    LAS float* ACT = (LAS float*)(F.lds + 8 * G_RB + F.wave * 512);
    LAS int* SELB = (LAS int*)(F.lds + 8 * G_RB + 8 * 512 + 8 * 1024 + F.wave * 512);
    static_assert(8 * G_RB + 8 * 512 + 8 * 1024 + 8 * 512 <= PTAB_OFF, "gather LDS map");
    const bool lh = (PART == 2) && (M <= 8 * NGW);
    const LAS int* HSEL = (const LAS int*)(F.lds + 65536 + F.wave * 4096); const LAS float* HACT = (const LAS float*)(F.lds + 98304 + F.wave * 4096);
    int kc = 0;
#pragma unroll 1
    for (int base = gw; base < M; base += G_NSLOT * NGW) {
    LAS unsigned char* X8 = F.lds + 8 * G_RB + 8 * 512 + F.wave * 1024;
    const int n16 = lane & 15, g4 = lane >> 4;
    const bool hf = lane >> 5; const int c32 = lane & 31, sg = 2 * c32 + (hf ? 1 : 0);
    v4u nh4[2]; int nidx_lo = 0, nidx_hi = 0; float ng_lo = 0.f, ng_hi = 0.f, na_lo = 0.f, na_hi = 0.f;
#define TOK_LOAD(t_) do { const bf16* hr_ = H + (size_t)(t_) * D + 8 * c32 + (hf ? 256 : 0); _Pragma("unroll") for (int p = 0; p < 2; ++p) nh4[p] = __builtin_nontemporal_load((const v4u*)(hr_ + 512 * p)); \
        if (!(PART == 2 && lh)) { nidx_lo = __builtin_nontemporal_load(seli + (size_t)(t_) * 128 + lane); nidx_hi = __builtin_nontemporal_load(seli + (size_t)(t_) * 128 + 64 + lane); } ng_lo = __builtin_nontemporal_load(selg + (size_t)(t_) * 128 + lane); ng_hi = __builtin_nontemporal_load(selg + (size_t)(t_) * 128 + 64 + lane); if (PART == 2 && !lh) { na_lo = __builtin_nontemporal_load(ACTG + (size_t)(t_) * 128 + lane); na_hi = __builtin_nontemporal_load(ACTG + (size_t)(t_) * 128 + 64 + lane); } } while (0)
    if (base < M) TOK_LOAD(base);
    f32x4 gq[4];
#pragma unroll
    for (int i = 0; i < 4; ++i) gq[i] = *(const f32x4*)((PART == 2 ? gnext : gain) + 256 * i + 4 * sg);
#pragma unroll 1
    for (int slot = 0; slot < G_NSLOT; ++slot) {
        const int t = base + slot * NGW; if (t >= M) break;
        f32x4 hv[4];
#pragma unroll
        for (int p = 0; p < 2; ++p) {
            const auto s0_ = __builtin_amdgcn_permlane32_swap(nh4[p].x, nh4[p].z, false, false), s1_ = __builtin_amdgcn_permlane32_swap(nh4[p].y, nh4[p].w, false, false);
            hv[2 * p] = (f32x4){bflo(s0_[0]), bfhi(s0_[0]), bflo(s1_[0]), bfhi(s1_[0])}; hv[2 * p + 1] = (f32x4){bflo(s0_[1]), bfhi(s0_[1]), bflo(s1_[1]), bfhi(s1_[1])}; }
        const int imask_ = dry ? PROBE_IMASK : 16383; const int idx_lo = (lh ? (HSEL[kc * 128 + lane] >> 7) : nidx_lo) & imask_, idx_hi = (lh ? (HSEL[kc * 128 + 64 + lane] >> 7) : nidx_hi) & imask_; const float g_lo = ng_lo, g_hi = ng_hi, pa_lo = lh ? HACT[kc * 128 + lane] : na_lo, pa_hi = lh ? HACT[kc * 128 + 64 + lane] : na_hi; ++kc;
        f32x2g s2lo = (f32x2g){0.f, 0.f}, s2hi = s2lo; if (PART != 2) { s2lo = SC2[idx_lo]; s2hi = SC2[idx_hi]; }
        if (slot + 1 < G_NSLOT && t + NGW < M) TOK_LOAD(t + NGW);
        float xinv = 1.0f;
        if (PART != 2) {
        float ss = 0.f;
#pragma unroll
        for (int i = 0; i < 4; ++i) ss += (hv[i].x * hv[i].x + hv[i].y * hv[i].y) + (hv[i].z * hv[i].z + hv[i].w * hv[i].w);
        const float rstd = 1.0f / sqrtf(wave_sum_dpp(ss) * (1.f / D) + RMS_EPS);
        float xmax = 0.f;
        f32x4 xv[4];
#pragma unroll
        for (int i = 0; i < 4; ++i) { const f32x4 g = gq[i]; xv[i] = hv[i] * rstd * g;
            xmax = fmaxf(fmaxf(xmax, fmaxf(fabsf(xv[i].x), fabsf(xv[i].y))), fmaxf(fabsf(xv[i].z), fabsf(xv[i].w))); }
        xmax = wave_max_dpp(xmax);
        const float qx = xmax > 0.f ? 256.0f / xmax : 1.0f; xinv = xmax > 0.f ? xmax * (1.0f / 256.0f) : 1.0f;
        {
            v4u w;
#pragma unroll
            for (int i = 0; i < 4; ++i) { unsigned tt = 0u; tt = __builtin_amdgcn_cvt_pk_fp8_f32(xv[i].x * qx, xv[i].y * qx, tt, false); tt = __builtin_amdgcn_cvt_pk_fp8_f32(xv[i].z * qx, xv[i].w * qx, tt, true); w[i] = tt; }
            *(LAS v4u*)(X8 + 16 * sg) = w;
        }
        }
        SELB[lane] = idx_lo; SELB[64 + lane] = idx_hi;
        asm volatile("" ::: "memory");
        v8i_g bx[8];
        v8i_g bq2[2];
        if (PART == 1) {
#pragma unroll
            for (int m = 0; m < 2; ++m) { const LAS unsigned char* xp_ = X8 + 128 * (4 * m + (n16 & 3)) + 16 * g4; const v4u b0 = *(const LAS v4u*)xp_, b1 = *(const LAS v4u*)(xp_ + 64);
                bq2[m] = (v8i_g){(int)b0.x, (int)b0.y, (int)b0.z, (int)b0.w, (int)b1.x, (int)b1.y, (int)b1.z, (int)b1.w}; }
        }
#define UP_LOAD(buf, hq) do { const LAS v4u* ip_ = (const LAS v4u*)(SELB + 32 * (hq) + (hf ? 16 : 0));        v4u i4_[4]; _Pragma("unroll") for (int k = 0; k < 4; ++k) i4_[k] = ip_[k]; \
        _Pragma("unroll") for (int k = 0; k < 16; ++k) buf[k] = *(const v4u*)(UP + (unsigned)(i4_[k >> 2][k & 3] * ROWB + 16 * c32)); } while (0)
#define DN_LOAD(buf, hb) do { const LAS v4u* ip_ = (const LAS v4u*)(SELB + 16 * (hb) + (hf ? 8 : 0));        v4u i4_[2]; i4_[0] = ip_[0]; i4_[1] = ip_[1]; \
        _Pragma("unroll") for (int k = 0; k < 8; ++k) buf[k] = *(const v4u*)(DN + (unsigned)(i4_[k >> 2][k & 3] * ROWB + 16 * c32)); } while (0)
        v4u da[8];
        if (PART == 1) {
            v4u gb[8][2];
#define GRP_LOAD(buf, grp) do { const unsigned char* rp_ = UP + (unsigned)(SELB[4 * (grp) + (n16 >> 2)] * ROWB + 64 * g4 + 16 * (n16 & 3));        buf[0] = *(const v4u*)rp_; buf[1] = *(const v4u*)(rp_ + 256); } while (0)
#define GRP_COMP(buf, grp) do { f32x4 c = (f32x4){0.f, 0.f, 0.f, 0.f}; \
                { const v8i_g a8 = (v8i_g){(int)buf[0].x, (int)buf[0].y, (int)buf[0].z, (int)buf[0].w, 0, 0, 0, 0}; c = __builtin_amdgcn_mfma_scale_f32_16x16x128_f8f6f4(a8, bq2[0], c, 4, 0, 0, 0x7f7f7f7f, 0, 0x7f7f7f7f); } \
                { const v8i_g a8 = (v8i_g){(int)buf[1].x, (int)buf[1].y, (int)buf[1].z, (int)buf[1].w, 0, 0, 0, 0}; c = __builtin_amdgcn_mfma_scale_f32_16x16x128_f8f6f4(a8, bq2[1], c, 4, 0, 0, 0x7f7f7f7f, 0, 0x7f7f7f7f); } \
                const int r_ = n16 & 3; float v_ = r_ == 0 ? c[0] : (r_ == 1 ? c[1] : (r_ == 2 ? c[2] : c[3])); \
                v_ += DPP_F(v_, 0xB1); v_ += DPP_F(v_, 0x4E);                           \
                if (n16 == 0) ACT[4 * (grp) + g4] = v_; } while (0)
#pragma unroll
            for (int gi = 0; gi < 8; ++gi) GRP_LOAD(gb[gi], gi);
#pragma unroll
            for (int gi = 0; gi < 32; ++gi) { GRP_COMP(gb[gi & 7], gi); if (gi + 8 < 32) GRP_LOAD(gb[gi & 7], gi + 8); }
#undef GRP_LOAD
#undef GRP_COMP
        } else if (PART != 2) {
            v4u ur[16];
            UP_LOAD(ur, 0);
#define UP_NEXT UP_LOAD(ur, hq + 1)
#pragma unroll 1
            for (int hq = 0; hq < 3; ++hq) {
                const int sel = hq < 2 ? idx_lo : idx_hi; const float gsel = hq < 2 ? g_lo : g_hi; const int lb0 = (hq & 1) * 32;
#pragma unroll
                for (int k = 0; k < 16; ++k) *(LAS v4u*)(RB + (k + (hf ? 16 : 0)) * G_RS + 16 * c32) = ur[k];
                asm volatile("" ::: "memory");
                UP_NEXT;
                f32x4 cc[2]; cc[0] = (f32x4){0.f, 0.f, 0.f, 0.f}; cc[1] = cc[0];
#pragma unroll
                for (int s8 = 0; s8 < 8; ++s8) { v8i_g bq;
                    if (PART == 1) bq = bx[s8]; else { const v4u b0 = *(const LAS v4u*)(X8 + 128 * s8 + 16 * g4), b1 = *(const LAS v4u*)(X8 + 128 * s8 + 64 + 16 * g4);
                        bq = (v8i_g){(int)b0.x, (int)b0.y, (int)b0.z, (int)b0.w, (int)b1.x, (int)b1.y, (int)b1.z, (int)b1.w}; }
#pragma unroll
                    for (int hh_ = 0; hh_ < 2; ++hh_) { const v4u a4 = *(const LAS v4u*)(RB + (hh_ * 16 + n16) * G_RS + 64 * s8 + 16 * g4); const v8i_g a8 = (v8i_g){(int)a4.x, (int)a4.y, (int)a4.z, (int)a4.w, 0, 0, 0, 0};
                        cc[hh_] = __builtin_amdgcn_mfma_scale_f32_16x16x128_f8f6f4(a8, bq, cc[hh_], 4, 0, 0, 0x7f7f7f7f, 0, 0x7f7f7f7f); } }
#pragma unroll
                for (int hh_ = 0; hh_ < 2; ++hh_) { const int lb = lb0 + hh_ * 16; const f32x4 c = cc[hh_];
                    const int r_ = n16 & 3, k_ = 4 * g4 + r_;
                    const float my = r_ == 0 ? c[0] : (r_ == 1 ? c[1] : (r_ == 2 ? c[2] : c[3]));
                    if (n16 < 4) ACT[hq * 32 + hh_ * 16 + k_] = my; }
                asm volatile("" ::: "memory");
            }
#undef UP_NEXT
#define UP_NEXT do { if (PART == 0) DN_LOAD(da, 0); } while (0)
            { const int hq = 3;
                const int sel = hq < 2 ? idx_lo : idx_hi; const float gsel = hq < 2 ? g_lo : g_hi; const int lb0 = (hq & 1) * 32;
#pragma unroll
                for (int k = 0; k < 16; ++k) *(LAS v4u*)(RB + (k + (hf ? 16 : 0)) * G_RS + 16 * c32) = ur[k];
                asm volatile("" ::: "memory");
                UP_NEXT;
                f32x4 cc[2]; cc[0] = (f32x4){0.f, 0.f, 0.f, 0.f}; cc[1] = cc[0];
#pragma unroll
                for (int s8 = 0; s8 < 8; ++s8) { v8i_g bq;
                    if (PART == 1) bq = bx[s8]; else { const v4u b0 = *(const LAS v4u*)(X8 + 128 * s8 + 16 * g4), b1 = *(const LAS v4u*)(X8 + 128 * s8 + 64 + 16 * g4);
                        bq = (v8i_g){(int)b0.x, (int)b0.y, (int)b0.z, (int)b0.w, (int)b1.x, (int)b1.y, (int)b1.z, (int)b1.w}; }
#pragma unroll
                    for (int hh_ = 0; hh_ < 2; ++hh_) { const v4u a4 = *(const LAS v4u*)(RB + (hh_ * 16 + n16) * G_RS + 64 * s8 + 16 * g4); const v8i_g a8 = (v8i_g){(int)a4.x, (int)a4.y, (int)a4.z, (int)a4.w, 0, 0, 0, 0};
                        cc[hh_] = __builtin_amdgcn_mfma_scale_f32_16x16x128_f8f6f4(a8, bq, cc[hh_], 4, 0, 0, 0x7f7f7f7f, 0, 0x7f7f7f7f); } }
#pragma unroll
                for (int hh_ = 0; hh_ < 2; ++hh_) { const int lb = lb0 + hh_ * 16; const f32x4 c = cc[hh_];
                    const int r_ = n16 & 3, k_ = 4 * g4 + r_;
                    const float my = r_ == 0 ? c[0] : (r_ == 1 ? c[1] : (r_ == 2 ? c[2] : c[3]));
                    if (n16 < 4) ACT[hq * 32 + hh_ * 16 + k_] = my; }
                asm volatile("" ::: "memory");
            }
#undef UP_NEXT
        }
#undef UP_LOAD
        asm volatile("" ::: "memory");
        if (PART == 1) { const float w_lo = gelu_erf(ACT[lane] * s2lo.x * xinv) * g_lo * s2lo.y, w_hi = gelu_erf(ACT[64 + lane] * s2hi.x * xinv) * g_hi * s2hi.y; ACTW[(size_t)t * 128 + lane] = w_lo; ACTW[(size_t)t * 128 + 64 + lane] = w_hi; continue; }
        if (PART == 2) DN_LOAD(da, 0);
        const float a_lo = PART == 2 ? pa_lo : gelu_erf(ACT[lane] * s2lo.x * xinv) * g_lo * s2lo.y, a_hi = PART == 2 ? pa_hi : gelu_erf(ACT[64 + lane] * s2hi.x * xinv) * g_hi * s2hi.y;
        float amax = fmaxf(fabsf(a_lo), fabsf(a_hi));
        amax = wave_max_dpp(amax);
        const float ainv = amax > 0.f ? 119.0f / amax : 0.f, tscale = amax * (1.0f / 119.0f);
        unsigned pd[4];
        {
            const int A0 = __float2int_rn(a_lo * ainv), A1 = __float2int_rn(a_hi * ainv);
            const int h0 = (A0 + 8) >> 4, l0 = A0 - 16 * h0, h1 = (A1 + 8) >> 4, l1 = A1 - 16 * h1;
            const int sh = 4 * (lane & 7);
            pd[0] = ((unsigned)l0 & 15u) << sh; pd[1] = ((unsigned)h0 & 15u) << sh; pd[2] = ((unsigned)l1 & 15u) << sh; pd[3] = ((unsigned)h1 & 15u) << sh;
#define DPP_U(v_, ctrl_) ((unsigned)__builtin_amdgcn_update_dpp(0, (int)(v_), (ctrl_), 0xf, 0xf, false))
#pragma unroll
            for (int q = 0; q < 4; ++q) { pd[q] |= DPP_U(pd[q], 0xB1); pd[q] |= DPP_U(pd[q], 0x4E); pd[q] |= DPP_U(pd[q], 0x141); }
#undef DPP_U
        }
        int acc0[32], acc1[32];
#pragma unroll
        for (int e = 0; e < 32; ++e) { acc0[e] = 0; acc1[e] = 0; }
#define DN_STEP(buf, hb) do { const unsigned plo_ = (hb) < 4 ? pd[0] : pd[2], phi_ = (hb) < 4 ? pd[1] : pd[3]; \
            const int alo_ = sel2(hf, __builtin_amdgcn_readlane((int)plo_, ((hb) & 3) * 16), __builtin_amdgcn_readlane((int)plo_, ((hb) & 3) * 16 + 8)), ahi_ = sel2(hf, __builtin_amdgcn_readlane((int)phi_, ((hb) & 3) * 16), __builtin_amdgcn_readlane((int)phi_, ((hb) & 3) * 16 + 8)); \
            _Pragma("unroll") for (int w = 0; w < 4; ++w) { unsigned w_[8], t_[8]; \
                _Pragma("unroll") for (int r = 0; r < 8; ++r) w_[r] = buf[r][w]; \
                tr8_nib(w_, t_); \
                _Pragma("unroll") for (int c = 0; c < 8; ++c) { acc0[8 * w + c] = __builtin_amdgcn_sdot8((int)t_[c], alo_, acc0[8 * w + c], false); acc1[8 * w + c] = __builtin_amdgcn_sdot8((int)t_[c], ahi_, acc1[8 * w + c], false); } } } while (0)
        {
            v4u db[8];
            DN_LOAD(db, 1); DN_STEP(da, 0);
            DN_LOAD(da, 2); DN_STEP(db, 1);
            DN_LOAD(db, 3); DN_STEP(da, 2);
            DN_LOAD(da, 4); DN_STEP(db, 3);
            DN_LOAD(db, 5); DN_STEP(da, 4);
            DN_LOAD(da, 6); DN_STEP(db, 5);
            DN_LOAD(db, 7); DN_STEP(da, 6);
            DN_STEP(db, 7);
        }
#undef DN_LOAD
#undef DN_STEP
        int os[16];
#pragma unroll
        for (int k = 0; k < 16; ++k) { const int lo_ = acc0[k] + (acc1[k] << 4), hi_ = acc0[16 + k] + (acc1[16 + k] << 4); const auto sw_ = __builtin_amdgcn_permlane32_swap((unsigned)lo_, (unsigned)hi_, false, false); os[k] = (int)sw_[0] + (int)sw_[1]; }
        f32x2g out[8];
#pragma unroll
        for (int e = 0; e < 8; ++e) out[e] = (f32x2g){(float)os[2 * e] * tscale, (float)os[2 * e + 1] * tscale};
        float ss2 = 0.f;
#pragma unroll
        for (int i = 0; i < 4; ++i) { hv[i].x += out[2 * i].x; hv[i].y += out[2 * i].y; hv[i].z += out[2 * i + 1].x; hv[i].w += out[2 * i + 1].y;
            ss2 += (hv[i].x * hv[i].x + hv[i].y * hv[i].y) + (hv[i].z * hv[i].z + hv[i].w * hv[i].w); }
        const float rstd2 = 1.0f / sqrtf(wave_sum_dpp(ss2) * (1.f / D) + RMS_EPS);
        f32x4 y[4];
#pragma unroll
        for (int i = 0; i < 4; ++i) y[i] = hv[i] * rstd2 * gq[i];
        if (layer < DEPTH - 1) {
            bf16* hw_ = HW + (size_t)t * D + 8 * c32 + (hf ? 256 : 0); bf16* hn = HN + (size_t)t * D + 8 * c32 + (hf ? 256 : 0);
#pragma unroll
            for (int p = 0; p < 2; ++p) {
                const auto a0_ = __builtin_amdgcn_permlane32_swap(pk2(hv[2 * p].x, hv[2 * p].y), pk2(hv[2 * p + 1].x, hv[2 * p + 1].y), false, false), a1_ = __builtin_amdgcn_permlane32_swap(pk2(hv[2 * p].z, hv[2 * p].w), pk2(hv[2 * p + 1].z, hv[2 * p + 1].w), false, false);
                const auto b0_ = __builtin_amdgcn_permlane32_swap(pk2(y[2 * p].x, y[2 * p].y), pk2(y[2 * p + 1].x, y[2 * p + 1].y), false, false), b1_ = __builtin_amdgcn_permlane32_swap(pk2(y[2 * p].z, y[2 * p].w), pk2(y[2 * p + 1].z, y[2 * p + 1].w), false, false);
                *(v4u*)(hw_ + 512 * p) = (v4u){a0_[0], a1_[0], a0_[1], a1_[1]}; *(v4u*)(hn + 512 * p) = (v4u){b0_[0], b1_[0], b0_[1], b1_[1]}; }
        } else {
            float* orow = outp + (size_t)t * D + 4 * sg;
#pragma unroll
            for (int i = 0; i < 4; ++i) *(f32x4*)(orow + 256 * i) = y[i];
        }
    }
    LDS_WAIT(); asm volatile("" ::: "memory");
    }
#undef TOK_LOAD
}

__device__ __forceinline__ void peer_up3(Frame& F, int layer, bool dry) {
    const unsigned char* UP = F.ws + WS_UP + (size_t)layer * 16384 * ROWB;
    const f32x2g* SC2 = (const f32x2g*)(F.ws + WS_SUP) + (size_t)layer * 16384;
    const float* gain = F.in(2) + (size_t)layer * D;
    const int* seli = (const int*)(F.ws + WS_SELI); const float* selg = (const float*)(F.ws + WS_SELG);
    float* ACTW = (float*)(F.ws + (dry ? WS_SC : WS_ACTG));
    const bf16* H = (const bf16*)(F.ws + WS_H);
    const int lane = F.lane, gw = F.vcu * NWAVES + F.wave, NGW = F.G * NWAVES;
    const int n16 = lane & 15, g4 = lane >> 4; const bool hf = lane >> 5; const int c32 = lane & 31, sg = 2 * c32 + (hf ? 1 : 0);
    constexpr int NTW = 8;
    LAS unsigned char* X8S = F.lds + F.wave * 8192;
    LAS int* SELS = (LAS int*)(F.lds + 65536 + F.wave * 4096);
    LAS float* ACTP = (LAS float*)(F.lds + 98304 + F.wave * 4096);
    LAS float* XI = (LAS float*)(F.lds + 131072 + F.wave * 32);
    static_assert(131072 + 8 * 32 <= PTAB_OFF, "up3 LDS map");
    f32x4 gq[4];
#pragma unroll
    for (int i = 0; i < 4; ++i) gq[i] = *(const f32x4*)(gain + 256 * i + 4 * sg);
    const unsigned lofs = (unsigned)(64 * g4 + 16 * (n16 & 3));
#define U3_LOAD(buf, selp_, gi_) do { const unsigned char* rp_ = UP + (((unsigned)((selp_)[4 * (gi_) + (n16 >> 2)]) >> 7) * ROWB + lofs); buf[0] = *(const v4u*)rp_; buf[1] = *(const v4u*)(rp_ + 256); } while (0)
#define U3_BQ(bq_, k_, m_) do { const LAS unsigned char* xp_ = X8S + (k_) * 1024 + 128 * (4 * (m_) + (n16 & 3)) + 16 * g4; const v4u b0 = *(const LAS v4u*)xp_, b1 = *(const LAS v4u*)(xp_ + 64); \
        bq_ = (v8i_g){(int)b0.x, (int)b0.y, (int)b0.z, (int)b0.w, (int)b1.x, (int)b1.y, (int)b1.z, (int)b1.w}; } while (0)
#pragma unroll 1
    for (int base = gw; base < M; base += NTW * NGW) {
        int ntok = (M - base + NGW - 1) / NGW; ntok = ntok > NTW ? NTW : ntok;
        v4u nh4[2];
        { const bf16* hr_ = H + (size_t)base * D + 8 * c32 + (hf ? 256 : 0); nh4[0] = __builtin_nontemporal_load((const v4u*)hr_); nh4[1] = __builtin_nontemporal_load((const v4u*)(hr_ + 512)); }
#pragma unroll 1
        for (int k = 0; k < ntok; ++k) { const size_t t = (size_t)(base + k * NGW);
            int ka = (__builtin_nontemporal_load(seli + t * 128 + lane) << 7) | lane, kb = (__builtin_nontemporal_load(seli + t * 128 + 64 + lane) << 7) | (64 + lane);
            f32x4 hv[4];
#pragma unroll
            for (int p = 0; p < 2; ++p) {
                const auto s0_ = __builtin_amdgcn_permlane32_swap(nh4[p].x, nh4[p].z, false, false), s1_ = __builtin_amdgcn_permlane32_swap(nh4[p].y, nh4[p].w, false, false);
                hv[2 * p] = (f32x4){bflo(s0_[0]), bfhi(s0_[0]), bflo(s1_[0]), bfhi(s1_[0])}; hv[2 * p + 1] = (f32x4){bflo(s0_[1]), bfhi(s0_[1]), bflo(s1_[1]), bfhi(s1_[1])}; }
            if (k + 1 < ntok) { const bf16* hr_ = H + (size_t)(base + (k + 1) * NGW) * D + 8 * c32 + (hf ? 256 : 0); nh4[0] = __builtin_nontemporal_load((const v4u*)hr_); nh4[1] = __builtin_nontemporal_load((const v4u*)(hr_ + 512)); }
            float ss = 0.f;
#pragma unroll
            for (int i = 0; i < 4; ++i) ss += (hv[i].x * hv[i].x + hv[i].y * hv[i].y) + (hv[i].z * hv[i].z + hv[i].w * hv[i].w);
            const float rstd = 1.0f / sqrtf(wave_sum_dpp(ss) * (1.f / D) + RMS_EPS);
            float xmax = 0.f; f32x4 xv[4];
#pragma unroll
            for (int i = 0; i < 4; ++i) { xv[i] = hv[i] * rstd * gq[i];
                xmax = fmaxf(fmaxf(xmax, fmaxf(fabsf(xv[i].x), fabsf(xv[i].y))), fmaxf(fabsf(xv[i].z), fabsf(xv[i].w))); }
            xmax = wave_max_dpp(xmax);
            const float qx = xmax > 0.f ? 256.0f / xmax : 1.0f, xinv = xmax > 0.f ? xmax * (1.0f / 256.0f) : 1.0f;
            { v4u w;
#pragma unroll
              for (int i = 0; i < 4; ++i) { unsigned tt = 0u; tt = __builtin_amdgcn_cvt_pk_fp8_f32(xv[i].x * qx, xv[i].y * qx, tt, false); tt = __builtin_amdgcn_cvt_pk_fp8_f32(xv[i].z * qx, xv[i].w * qx, tt, true); w[i] = tt; }
              *(LAS v4u*)(X8S + k * 1024 + 16 * sg) = w; }
            if (lane == 0) XI[k] = xinv;
#pragma unroll
            for (int kk = 2; kk <= 128; kk <<= 1)
#pragma unroll
                for (int j = kk >> 1; j >= 1; j >>= 1) {
                    if (j == 64) { const int lo_ = ka < kb ? ka : kb, hi_ = ka < kb ? kb : ka; ka = lo_; kb = hi_; }
                    else { const int pa = __shfl_xor(ka, j), pb = __shfl_xor(kb, j);
                        const bool lower = (lane & j) == 0, up_a = (lane & kk) == 0, up_b = ((64 + lane) & kk) == 0;
                        const int mna = ka < pa ? ka : pa, mxa = ka < pa ? pa : ka, mnb = kb < pb ? kb : pb, mxb = kb < pb ? pb : kb;
                        ka = (lower == up_a) ? mna : mxa; kb = (lower == up_b) ? mnb : mxb; }
                }
            SELS[k * 128 + lane] = ka; SELS[k * 128 + 64 + lane] = kb;
        }
        asm volatile("" ::: "memory");
        v4u gb[8][2];
#pragma unroll
        for (int li = 0; li < 8; ++li) U3_LOAD(gb[li], SELS, li);
#pragma unroll 1
        for (int q = 0; q < 4; ++q) {
#pragma unroll 1
            for (int k = 0; k < ntok; ++k) {
                v8i_g bq0, bq1; U3_BQ(bq0, k, 0); U3_BQ(bq1, k, 1);
                const LAS int* seln = (k + 1 < ntok) ? SELS + (k + 1) * 128 + 32 * q : SELS + 32 * ((q + 1) & 3);
                LAS float* ap = ACTP + k * 128 + 32 * q;
#pragma unroll
                for (int li = 0; li < 8; ++li) {
                    f32x4 c = (f32x4){0.f, 0.f, 0.f, 0.f};
                    { const v8i_g a8 = (v8i_g){(int)gb[li][0].x, (int)gb[li][0].y, (int)gb[li][0].z, (int)gb[li][0].w, 0, 0, 0, 0}; c = __builtin_amdgcn_mfma_scale_f32_16x16x128_f8f6f4(a8, bq0, c, 4, 0, 0, 0x7f7f7f7f, 0, 0x7f7f7f7f); }
                    { const v8i_g a8 = (v8i_g){(int)gb[li][1].x, (int)gb[li][1].y, (int)gb[li][1].z, (int)gb[li][1].w, 0, 0, 0, 0}; c = __builtin_amdgcn_mfma_scale_f32_16x16x128_f8f6f4(a8, bq1, c, 4, 0, 0, 0x7f7f7f7f, 0, 0x7f7f7f7f); }
                    const int r_ = n16 & 3; float v_ = r_ == 0 ? c[0] : (r_ == 1 ? c[1] : (r_ == 2 ? c[2] : c[3]));
                    v_ += DPP_F(v_, 0xB1); v_ += DPP_F(v_, 0x4E);
                    if (n16 == 0) ap[4 * li + g4] = v_;
                    U3_LOAD(gb[li], seln, li);
                }
            }
        }
        asm volatile("" ::: "memory");
#pragma unroll 1
        for (int k = 0; k < ntok; ++k) { const size_t t = (size_t)(base + k * NGW);
            const int k_lo = SELS[k * 128 + lane], k_hi = SELS[k * 128 + 64 + lane];
            const f32x2g s2lo = SC2[k_lo >> 7], s2hi = SC2[k_hi >> 7];
            const float g_lo = selg[t * 128 + (k_lo & 127)], g_hi = selg[t * 128 + (k_hi & 127)];
            const float xinv = XI[k];
            const float w_lo = gelu_erf(ACTP[k * 128 + lane] * s2lo.x * xinv) * g_lo * s2lo.y, w_hi = gelu_erf(ACTP[k * 128 + 64 + lane] * s2hi.x * xinv) * g_hi * s2hi.y;
            ACTP[k * 128 + lane] = w_lo; ACTP[k * 128 + 64 + lane] = w_hi;
            if (!(M <= NTW * NGW)) { ACTW[t * 128 + (k_lo & 127)] = w_lo; ACTW[t * 128 + (k_hi & 127)] = w_hi; }
        }
        asm volatile("s_waitcnt vmcnt(0) lgkmcnt(0)" ::: "memory");
    }
#undef U3_LOAD
#undef U3_BQ
}

struct Args { const float* in[14]; float* out; unsigned char* ws; int ph_lo, ph_hi; };
__global__ void __launch_bounds__(NTHR, 2) mega_fwd(Args args) {
    extern __shared__ __attribute__((aligned(16))) unsigned char lds[];
    Frame F;
    F.lds = (LAS unsigned char*)lds;
    F.tid = threadIdx.x; F.lane = F.tid & 63; F.wave = __builtin_amdgcn_readfirstlane(F.tid >> 6);
    F.G = gridDim.x; { const int bx = blockIdx.x; F.vcu = (F.G % 8 == 0) ? (bx % 8) * (F.G / 8) + bx / 8 : bx; }
    F.ws = args.ws;
    volatile LAS unsigned* MISC = (volatile LAS unsigned*)(F.lds + MISC_OFF);
    if (F.tid < 64) MISC[F.tid] = 0u;
    if (F.tid < 15) { const unsigned long long p = F.tid < 14 ? (unsigned long long)args.in[F.tid] : (unsigned long long)args.out;
        volatile LAS unsigned* t = (volatile LAS unsigned*)(F.lds + PTAB_OFF); t[2 * F.tid] = (unsigned)p; t[2 * F.tid + 1] = (unsigned)(p >> 32); }
    __syncthreads();
    XcdBarrier bar; bar.bar = (unsigned*)(F.ws + WS_CTL) + CW_BAR; bar.x = 0; bar.st = nullptr;
    if (MK_N_LAUNCHES == 1) bar = xcd_barrier_post((unsigned*)(F.ws + WS_CTL) + CW_BAR, MISC + 8);

#pragma unroll 1
    for (int ph = args.ph_lo; ph < args.ph_hi; ++ph) {
        bool did = true;
        const int kind_ = ph == 0 ? 7 : (ph - 1) % PH_PER_LAYER; const int nrep = (PROBE_REP >= 0 && kind_ == PROBE_REP && (ph == 0 || ((PROBE_LMASK >> ((ph - 1) / PH_PER_LAYER)) & 1))) ? 2 : 1;
#pragma unroll 1
        for (int rep = 0; rep < nrep; ++rep) {
        const bool dry = (nrep == 2 && rep == 0);
        { int t_ = threadIdx.x; asm volatile("" : "+v"(t_)); F.tid = t_; F.lane = t_ & 63; F.wave = __builtin_amdgcn_readfirstlane(t_ >> 6);
          unsigned long long ws_ = (unsigned long long)args.ws; asm volatile("" : "+s"(ws_)); F.ws = (unsigned char*)(__attribute__((address_space(1))) unsigned char*)ws_; }
#ifndef DIS_PRO
        if (ph == 0) p0_prologue(F, dry);
#else
        if (ph == 0) {}
#endif
        else {
            const int layer = (ph - 1) / PH_PER_LAYER, k = (ph - 1) % PH_PER_LAYER, j = layer >> 1; const bool is_attn = (layer & 1) == 0;
            if (k == 0) {
                if (!is_attn) {
                    pg8::Gemm g{(const pg8::bf16_t*)(F.ws + WS_HN), (const pg8::bf16_t*)(F.ws + WS_WIN) + (size_t)j * 3072 * 1024, M, 3072, D};
                    pg8::StaticOrder S; S.init(g.M, g.N, F.G, (int)blockIdx.x);
                    EpiConvIn E{(bf16*)(F.ws + WS_BIG), (bf16*)(F.ws + WS_BIG + 32 * MiB)};
                    pg8::gemm_phase<EpiConvIn, pg8::StaticOrder, true, true>(F.lds, g, S, E);
                }
                const int ng = is_attn ? 2 : 0;
#pragma unroll 1
                for (int gi = 0; gi < ng; ++gi) {
                    pg8::Gemm g; pg8::EpiBf16<0> E; E.bias = nullptr; E.split_cols = 0; E.split_stride = 0; E.scale0 = 1.f;
                    if (is_attn && gi == 0) { g = pg8::Gemm{(const pg8::bf16_t*)(F.ws + WS_HN), (const pg8::bf16_t*)(F.ws + WS_WQK) + (size_t)j * 2048 * 1024, M, 2048, D}; E.O = (pg8::bf16_t*)(F.ws + WS_BIG); E.ldc = 2048; }
                    else if (is_attn) { g = pg8::Gemm{(const pg8::bf16_t*)(F.ws + WS_WV) + (size_t)j * 1024 * 1024, (const pg8::bf16_t*)(F.ws + WS_HN), D, M, D}; E.O = (pg8::bf16_t*)(F.ws + WS_VT); E.ldc = M; }
                    else { g = pg8::Gemm{(const pg8::bf16_t*)(F.ws + WS_HN), (const pg8::bf16_t*)(F.ws + WS_WIN) + (size_t)j * 3072 * 1024, M, 3072, D}; E.O = (pg8::bf16_t*)(F.ws + WS_BIG); E.ldc = 3072; }
                    pg8::StaticOrder S; S.init(g.M, g.N, F.G, (int)blockIdx.x);
                    pg8::gemm_phase<pg8::EpiBf16<0>, pg8::StaticOrder, true, true>(F.lds, g, S, E);
                }
            } else if (k == 1) {
                if (is_attn) {
#if NAIVE_ATTN
                    attn_naive_phase(F, j);
#elif !defined(DIS_ATTN)
                    attn_phase(F, j);
#endif
                } else {
#ifndef DIS_CONV
                    conv_phase(F, j);
#endif
                }
            } else if (k == 2) {
                pg8::Gemm g{(const pg8::bf16_t*)(F.ws + WS_MIX), (const pg8::bf16_t*)(F.ws + (is_attn ? WS_WO : WS_WOUT)) + (size_t)j * 1024 * 1024, M, D, D};
                pg8::StaticOrder S; S.init(M, D, F.G, (int)blockIdx.x);
                float* rssp = (float*)(F.ws + (dry ? WS_SC + 96 * MiB : WS_RSS)); bf16* hout = (bf16*)(F.ws + (dry ? WS_SC : WS_H));
                if (layer == 0) { EpiRes<true> E{(const void*)F.in(0), hout, rssp}; pg8::gemm_phase<EpiRes<true>, pg8::StaticOrder, true, true>(F.lds, g, S, E); }
                else { EpiRes<false> E{(const void*)(F.ws + WS_H), hout, rssp}; pg8::gemm_phase<EpiRes<false>, pg8::StaticOrder, true, true>(F.lds, g, S, E); }
            } else if (k == 3) {
                did = false;
            } else if (k == 4) {
                pg8::Gemm g{(const pg8::bf16_t*)(F.ws + WS_H), (const pg8::bf16_t*)(F.ws + WS_WP) + (size_t)layer * 2048 * 1024, M, 2048, D};
                pg8::StaticOrder S; S.init(M, 2048, F.G, (int)blockIdx.x);
#if NAIVE_TOPK
                EpiF32 E{(float*)(F.ws + WS_SC), 2048};
                pg8::gemm_phase<EpiF32, pg8::StaticOrder, true, true>(F.lds, g, S, E);
#else
#ifndef DIS_TOPK
                EpiTopK E{(int*)(F.ws + WS_SELI), (float*)(F.ws + WS_SELG), (const float*)(F.ws + WS_RSS)};
#pragma unroll 1
                for (int i = 0;; ++i) { OneUnit O1; if (!S.next(i, O1.u)) break; pg8::gemm_phase<EpiTopK, OneUnit, false, true>(F.lds, g, O1, E); }
#endif
#endif
            } else if (k == 5) {
                peer_up3(F, layer, dry);
                did = false; asm volatile("s_waitcnt vmcnt(0) lgkmcnt(0)" ::: "memory");
            } else {
                gather_phase<2>(F, layer, dry);
            }
        }
        if (MK_N_LAUNCHES == 1 && dry) xcd_barrier(bar);
        }
        if (MK_N_LAUNCHES == 1 && did && ph + 1 < args.ph_hi) { xcd_barrier(bar);
#ifdef PROBE_BAR2
            xcd_barrier(bar);
#endif
        }
    }
}

extern "C" void kernel_launch(void* const* d_in, const int* in_sizes, int n_in, void* d_out, int out_size, void* d_ws, size_t ws_size, hipStream_t stream) {
    static int grid = 0;
    if (grid == 0) {
        if (n_in != 14 || out_size != M * D || ws_size < WS_END) { fprintf(stderr, "kernel_launch: unexpected shapes (n_in %d, out %d, ws %zu); nothing launched\n", n_in, out_size, ws_size); grid = -1; return; }
        int dev = 0, cus = 0, per_cu = 0;
        if (hipGetDevice(&dev) != hipSuccess || hipDeviceGetAttribute(&cus, hipDeviceAttributeMultiprocessorCount, dev) != hipSuccess) { grid = -1; return; }
        if (hipFuncSetAttribute((const void*)mega_fwd, hipFuncAttributeMaxDynamicSharedMemorySize, LDS_BYTES) != hipSuccess) { fprintf(stderr, "kernel_launch: hipFuncSetAttribute failed\n"); grid = -1; return; }
        if (hipOccupancyMaxActiveBlocksPerMultiprocessor(&per_cu, (const void*)mega_fwd, NTHR, LDS_BYTES) != hipSuccess || per_cu < 1) fprintf(stderr, "kernel_launch: note: occupancy query reports %d\n", per_cu);
        (void)hipGetLastError();
        grid = cus;
    }
    if (grid < 0) return;
    if (hipMemsetAsync((char*)d_ws + WS_CTL, 0, CTL_ZERO_BYTES, stream) != hipSuccess) return;
    Args a{};
    for (int i = 0; i < 14; ++i) a.in[i] = (const float*)d_in[i];
    a.out = (float*)d_out; a.ws = (unsigned char*)d_ws;
    if (MK_N_LAUNCHES == 1) { a.ph_lo = 0; a.ph_hi = N_PHASES; hipLaunchKernelGGL(mega_fwd, dim3(grid), dim3(NTHR), LDS_BYTES, stream, a); }
    else for (int ph = 0; ph < N_PHASES; ++ph) {
        if (ph > 0 && (ph - 1) % PH_PER_LAYER == 3) continue;
        a.ph_lo = ph; a.ph_hi = ph + 1; hipLaunchKernelGGL(mega_fwd, dim3(grid), dim3(NTHR), LDS_BYTES, stream, a);
    }
}
```
